# Optimizing an MI355X kernel written in HIP

```python
import jax
import jax.numpy as jnp
from jax import lax
import numpy as np

D_MODEL = 1024
BATCH = 2
SEQ = 8192
DEPTH = 1

CHUNK = 64
Q_BLOCK = 128
EPS = 1e-6
ROPE_THETA = 10000.0

MLA_HEADS = 8
MLA_Q_RANK = 384
MLA_KV_RANK = 256
MLA_NOPE = 64
MLA_ROPE = 32
MLA_V = 64

GLA_HEADS = 4
GLA_DK = 64
GLA_DV = 128
GLA_GATE_RANK = 16
GLA_TAU = 16.0

N_BRANCH = 2

PEER_HEADS = 8
PEER_NKEYS = 128
PEER_HALF = 128
PEER_TOPK = 16
PEER_BLOCK = 128
PEER_EXPERTS = PEER_NKEYS * PEER_NKEYS

IN_SIZES = (MLA_Q_RANK, MLA_KV_RANK, MLA_ROPE, GLA_HEADS * GLA_DK, GLA_HEADS * GLA_DK, GLA_HEADS * GLA_DV, GLA_GATE_RANK, GLA_HEADS * GLA_DV, N_BRANCH * D_MODEL)
IN_WIDTH = sum(IN_SIZES)

kernel_name = 'hybrid_mla_gla_peer_block'


def _split_points():
    return [int(s) for s in np.cumsum(IN_SIZES)[:-1]]


def rms_norm(x, g):
    xf = x.astype(jnp.float32)
    y = xf * lax.rsqrt(jnp.mean(xf * xf, axis=-1, keepdims=True) + EPS)
    return (y * g.astype(jnp.float32)).astype(x.dtype)


def apply_rope(x, positions):
    half = x.shape[-1] // 2
    inv_freq = ROPE_THETA ** (-jnp.arange(half, dtype=jnp.float32) / half)
    ang = positions.astype(jnp.float32)[:, :, None, None] * inv_freq
    cos, sin = jnp.cos(ang), jnp.sin(ang)
    xf = x.astype(jnp.float32)
    x1, x2 = xf[..., :half], xf[..., half:]
    return jnp.concatenate([x1 * cos - x2 * sin, x2 * cos + x1 * sin], axis=-1).astype(x.dtype)


def mla_attention(q_lat, kv_lat, k_rope, positions, g_q, w_qb, g_kv, w_kvb):
    B, S, _ = q_lat.shape
    H = MLA_HEADS
    dqk = MLA_NOPE + MLA_ROPE
    q = (rms_norm(q_lat, g_q) @ w_qb).reshape(B, S, H, dqk)
    q = jnp.concatenate([q[..., :MLA_NOPE], apply_rope(q[..., MLA_NOPE:], positions)], axis=-1)
    kv = (rms_norm(kv_lat, g_kv) @ w_kvb).reshape(B, S, H, MLA_NOPE + MLA_V)
    k_nope, v = kv[..., :MLA_NOPE], kv[..., MLA_NOPE:]
    k_pe = apply_rope(k_rope[:, :, None, :], positions)
    k = jnp.concatenate([k_nope, jnp.broadcast_to(k_pe, (B, S, H, MLA_ROPE))], axis=-1)
    scale = dqk ** -0.5
    nb = S // Q_BLOCK
    qb = q.reshape(B, nb, Q_BLOCK, H, dqk).transpose(1, 0, 2, 3, 4)
    key_chunk = jnp.arange(S) // CHUNK

    def block(args):
        qi, i = args
        q_chunk = (i * Q_BLOCK + jnp.arange(Q_BLOCK)) // CHUNK
        s = jnp.einsum('bqhd,bkhd->bhqk', qi, k, preferred_element_type=jnp.float32) * scale
        mask = key_chunk[None, :] <= q_chunk[:, None]
        s = jnp.where(mask[None, None], s, -1e30)
        p = jax.nn.softmax(s, axis=-1)
        return jnp.einsum('bhqk,bkhd->bqhd', p.astype(v.dtype), v)

    out = lax.map(block, (qb, jnp.arange(nb)))
    return out.transpose(1, 0, 2, 3, 4).reshape(B, S, H * MLA_V)


def gla_mixer(q, k, v, gate_lr, out_gate, w_a2, b_a2, g_gn):
    B, S, _ = q.shape
    H, dk, dv = GLA_HEADS, GLA_DK, GLA_DV
    nc = S // CHUNK
    f32 = jnp.float32
    qc = q.astype(f32).reshape(B, nc, CHUNK, H, dk) * (dk ** -0.5)
    kc = k.astype(f32).reshape(B, nc, CHUNK, H, dk)
    vc = v.astype(f32).reshape(B, nc, CHUNK, H, dv)
    log_a = jax.nn.log_sigmoid((gate_lr @ w_a2 + b_a2).astype(f32)) / GLA_TAU
    log_a = log_a.reshape(B, nc, CHUNK, H, dk)
    cum = jnp.cumsum(log_a, axis=2)
    cum_last = cum[:, :, -1]
    k_dec = kc * jnp.exp(cum_last[:, :, None] - cum)
    d_state = jnp.einsum('bclhk,bclhv->bchkv', k_dec, vc)
    chunk_decay = jnp.exp(cum_last)

    def step(state, inp):
        dec, ds = inp
        new = dec[..., None] * state + ds
        return new, new

    s0 = jnp.zeros((B, H, dk, dv), f32)
    _, states = lax.scan(step, s0, (chunk_decay.transpose(1, 0, 2, 3), d_state.transpose(1, 0, 2, 3, 4)))
    o = jnp.einsum('bclhk,cbhkv->bclhv', qc, states)
    o = o * lax.rsqrt(jnp.mean(o * o, axis=-1, keepdims=True) + EPS) * g_gn.astype(f32)
    o = o.reshape(B, S, H * dv) * jax.nn.silu(out_gate.astype(f32))
    return o.astype(q.dtype)


def peer_ffn(h, w_q, sub_keys, u_tab, v_tab):
    B, S, D = h.shape
    T = B * S
    PH, K = PEER_HEADS, PEER_TOPK
    hf = h.reshape(T, D)
    q = (hf @ w_q).reshape(T, PH, 2, PEER_HALF)
    scores = jnp.einsum('thpd,hpnd->thpn', q, sub_keys, preferred_element_type=jnp.float32)
    s, idx = lax.top_k(scores, K)
    cand = (s[:, :, 0, :, None] + s[:, :, 1, None, :]).reshape(T, PH, K * K)
    cand_idx = (idx[:, :, 0, :, None] * PEER_NKEYS + idx[:, :, 1, None, :]).reshape(T, PH, K * K)
    best, pos = lax.top_k(cand, K)
    expert = jnp.take_along_axis(cand_idx, pos, axis=-1)
    gate = jax.nn.softmax(best, axis=-1)
    nb = T // PEER_BLOCK

    def block(args):
        xb, eb, gb = args
        u = jnp.take(u_tab, eb, axis=0)
        a = jax.nn.gelu(jnp.einsum('td,thkd->thk', xb, u, preferred_element_type=jnp.float32), approximate=False)
        c = (a * gb).astype(h.dtype)
        return jnp.einsum('thk,thkd->td', c, jnp.take(v_tab, eb, axis=0))

    y = lax.map(block, (hf.reshape(nb, PEER_BLOCK, D), expert.reshape(nb, PEER_BLOCK, PH, K), gate.reshape(nb, PEER_BLOCK, PH, K)))
    return y.reshape(B, S, D)


def setup_inputs(seed: int = 0) -> dict:
    key = jax.random.key(seed)
    ks = jax.random.split(key, 24)
    L, D = DEPTH, D_MODEL
    f32 = jnp.float32

    def nrm(k, shape, fan_in):
        return jax.random.normal(k, shape, f32) * (fan_in ** -0.5)

    def gain(k, shape):
        return 1.0 + 0.01 * jax.random.normal(k, shape, f32)

    x = jax.random.normal(ks[0], (BATCH, SEQ, D), f32)
    offset = jax.random.randint(ks[1], (BATCH, 1), 0, 4096, dtype=jnp.int32)
    positions = offset + jnp.arange(SEQ, dtype=jnp.int32)[None, :]
    return {
        'x': x,
        'positions': positions,
        'g_mix': gain(ks[2], (L, D)),
        'w_in': nrm(ks[3], (L, D, IN_WIDTH), D),
        'g_q_lat': gain(ks[4], (L, MLA_Q_RANK)),
        'w_qb': nrm(ks[5], (L, MLA_Q_RANK, MLA_HEADS * (MLA_NOPE + MLA_ROPE)), MLA_Q_RANK),
        'g_kv_lat': gain(ks[6], (L, MLA_KV_RANK)),
        'w_kvb': nrm(ks[7], (L, MLA_KV_RANK, MLA_HEADS * (MLA_NOPE + MLA_V)), MLA_KV_RANK),
        'w_a2': nrm(ks[8], (L, GLA_GATE_RANK, GLA_HEADS * GLA_DK), GLA_GATE_RANK),
        'b_a2': 0.1 * jax.random.normal(ks[9], (L, GLA_HEADS * GLA_DK), f32),
        'g_gla': gain(ks[10], (L, GLA_HEADS, GLA_DV)),
        'w_branch_a': nrm(ks[11], (L, MLA_HEADS * MLA_V, D), MLA_HEADS * MLA_V),
        'w_branch_b': nrm(ks[12], (L, GLA_HEADS * GLA_DV, D), GLA_HEADS * GLA_DV),
        'w_out': nrm(ks[13], (L, D, D), D),
        'g_ffn': gain(ks[14], (L, D)),
        'w_peer_q': nrm(ks[15], (L, D, PEER_HEADS * 2 * PEER_HALF), D),
        'peer_sub_keys': nrm(ks[16], (L, PEER_HEADS, 2, PEER_NKEYS, PEER_HALF), PEER_HALF),
        'peer_u': nrm(ks[17], (L, PEER_EXPERTS, D), D),
        'peer_v': nrm(ks[18], (L, PEER_EXPERTS, D), PEER_HEADS * PEER_TOPK),
        'g_final': gain(ks[19], (D,)),
    }


def reference(x, positions, g_mix, w_in, g_q_lat, w_qb, g_kv_lat, w_kvb, w_a2, b_a2, g_gla, w_branch_a, w_branch_b, w_out, g_ffn, w_peer_q, peer_sub_keys, peer_u, peer_v, g_final):
    B, S, D = x.shape
    pts = _split_points()
    for l in range(DEPTH):
        h = rms_norm(x, g_mix[l])
        proj = h @ w_in[l]
        q_lat, kv_lat, k_rope, gq, gk, gv, g_lr, g_out, br = jnp.split(proj, pts, axis=-1)
        y_a = mla_attention(q_lat, kv_lat, k_rope, positions, g_q_lat[l], w_qb[l], g_kv_lat[l], w_kvb[l])
        y_b = gla_mixer(gq, gk, gv, g_lr, g_out, w_a2[l], b_a2[l], g_gla[l])
        gates = jax.nn.sigmoid(br.astype(jnp.float32)).reshape(B, S, N_BRANCH, D)
        merged = gates[:, :, 0] * (y_a @ w_branch_a[l]) + gates[:, :, 1] * (y_b @ w_branch_b[l])
        x = x + merged.astype(x.dtype) @ w_out[l]
        x = x + peer_ffn(rms_norm(x, g_ffn[l]), w_peer_q[l], peer_sub_keys[l], peer_u[l], peer_v[l])
    return rms_norm(x, g_final)
```

```cpp
#include <hip/hip_runtime.h>
#include <stdint.h>
#include <math.h>

typedef unsigned short bf16_t;

constexpr int SEQ = 8192, DM = 1024, M_ = 16384;
constexpr int NCH = 128;
constexpr float EPS = 1e-6f;
constexpr int PB_LD = 2816, PA_LD = 1536;
constexpr int PB_BR = 0, PB_GOUT = 2048, PB_GQ = 2560;
constexpr int PA_GV = 0, PA_GK = 512, PA_QLAT = 768, PA_KVLAT = 1152, PA_KROPE = 1408, PA_GLR = 1440;
constexpr int NPROJ = 4352;

constexpr size_t MiB = 1u << 20;
constexpr size_t WS_SSQ = 1 * MiB, WS_SSKV = WS_SSQ + 65536, WS_SSX1 = WS_SSKV + 65536, WS_COS = 2 * MiB, WS_SIN = 3 * MiB;
constexpr size_t WS_DECAY = 1 * MiB + 512 * 1024;
constexpr size_t WS_WIN = 4 * MiB, WS_WQB = 13 * MiB, WS_WKVB = 14 * MiB, WS_WA = 15 * MiB, WS_WB = 16 * MiB, WS_WOUT = 17 * MiB, WS_WPQ = 19 * MiB, WS_KEYS = 23 * MiB;
constexpr size_t WS_PROJB = 24 * MiB, WS_PROJA = 112 * MiB, WS_XN = 160 * MiB, WS_Q = 160 * MiB, WS_K = 184 * MiB, WS_V = 208 * MiB, WS_DST = 224 * MiB;
constexpr size_t WS_YA = 112 * MiB, WS_YB = 128 * MiB, WS_MERGED = 160 * MiB, WS_X1B = 24 * MiB, WS_QP = 56 * MiB, WS_EIDX = 120 * MiB, WS_EGATE = 128 * MiB;
constexpr size_t WS_TOPS = 136 * MiB, WS_TOPI = 152 * MiB;

__device__ __forceinline__ float bf2f(bf16_t h) { return __uint_as_float(((unsigned)h) << 16); }
__device__ __forceinline__ bf16_t f2bf(float f) { unsigned u = __float_as_uint(f); return (bf16_t)((u + 0x7fffu + ((u >> 16) & 1u)) >> 16); }
__device__ __forceinline__ float wave_sum(float v) {
#pragma unroll
    for (int o = 1; o < 64; o <<= 1) v += __shfl_xor(v, o);
    return v;
}

__global__ __launch_bounds__(256) void k_xn(const float* __restrict__ x, const float* __restrict__ g, bf16_t* __restrict__ xn) {
    const int row = blockIdx.x * 4 + (threadIdx.x >> 6), lane = threadIdx.x & 63;
    const float4* xr = (const float4*)(x + (size_t)row * DM);
    float4 v[4]; float ss = 0.f;
#pragma unroll
    for (int j = 0; j < 4; ++j) { v[j] = xr[lane + 64 * j]; ss += v[j].x * v[j].x + v[j].y * v[j].y + v[j].z * v[j].z + v[j].w * v[j].w; }
    ss = wave_sum(ss);
    const float r = rsqrtf(ss * (1.f / DM) + EPS);
#pragma unroll
    for (int j = 0; j < 4; ++j) {
        const int c = 4 * (lane + 64 * j);
        const float4 gg = *(const float4*)(g + c);
        bf16_t* o = xn + (size_t)row * DM + c;
        o[0] = f2bf(v[j].x * r * gg.x); o[1] = f2bf(v[j].y * r * gg.y); o[2] = f2bf(v[j].z * r * gg.z); o[3] = f2bf(v[j].w * r * gg.w);
    }
}
__device__ __forceinline__ int win_srccol(int n) {
    if (n < 2048) return 2224 + n;
    if (n < 2560) return 1712 + (n - 2048);
    if (n < 2816) return 672 + (n - 2560);
    if (n < 3328) return 1184 + (n - 2816);
    if (n < 3584) return 928 + (n - 3328);
    if (n < 3968) return 0 + (n - 3584);
    if (n < 4224) return 384 + (n - 3968);
    if (n < 4256) return 640 + (n - 4224);
    if (n < 4272) return 1696 + (n - 4256);
    return -1;
}
__global__ __launch_bounds__(256) void k_wt(const float* __restrict__ W, bf16_t* __restrict__ out, const float* __restrict__ kscale, int K, int Nsrc, int Nout, int mode) {
    const size_t i = (size_t)blockIdx.x * 256 + threadIdx.x;
    if (i >= (size_t)Nout * K) return;
    const int n = (int)(i / K), k = (int)(i % K);
    const int sc = mode == 1 ? win_srccol(n) : n;
    float v = 0.f;
    if (sc >= 0) { v = W[(size_t)k * Nsrc + sc]; if (kscale) v *= kscale[k]; }
    out[i] = f2bf(v);
}
__global__ __launch_bounds__(256) void k_cvt(const float* __restrict__ in, bf16_t* __restrict__ out, int n) {
    const int i = blockIdx.x * 256 + threadIdx.x; if (i < n) out[i] = f2bf(in[i]);
}
__global__ __launch_bounds__(256) void k_ropetab(const int* __restrict__ pos, float* __restrict__ cs, float* __restrict__ sn) {
    const int i = blockIdx.x * 256 + threadIdx.x; if (i >= M_ * 16) return;
    const int m = i >> 4, f = i & 15;
    const double inv = pow(10000.0, -(double)f / 16.0);
    const double ang = (double)pos[m] * inv;
    cs[i] = (float)cos(ang); sn[i] = (float)sin(ang);
}

template <class Epi>
__global__ __launch_bounds__(256) void k_gemm(const bf16_t* __restrict__ A, const bf16_t* __restrict__ Bt, int lda, int ldb, int M, int N, int K, int pad_, Epi epi) {
    __shared__ float As[32][65];
    __shared__ float Bs[32][65];
    const int tid = threadIdx.x, tx = tid & 15, ty = tid >> 4;
    const int bm = blockIdx.y * 64, bn = blockIdx.x * 64;
    const int lrow = tid >> 2, lk = (tid & 3) * 8;
    float acc[4][4];
#pragma unroll
    for (int i = 0; i < 4; ++i)
#pragma unroll
        for (int j = 0; j < 4; ++j) acc[i][j] = 0.f;
    for (int k0 = 0; k0 < K; k0 += 32) {
        {
            const uint4 a = *(const uint4*)(A + (size_t)(bm + lrow) * lda + k0 + lk);
            const unsigned w[4] = {a.x, a.y, a.z, a.w};
#pragma unroll
            for (int i = 0; i < 4; ++i) { As[lk + 2 * i][lrow] = __uint_as_float(w[i] << 16); As[lk + 2 * i + 1][lrow] = __uint_as_float(w[i] & 0xffff0000u); }
            uint4 b = make_uint4(0, 0, 0, 0);
            if (bn + lrow < N) b = *(const uint4*)(Bt + (size_t)(bn + lrow) * ldb + k0 + lk);
            const unsigned wb[4] = {b.x, b.y, b.z, b.w};
#pragma unroll
            for (int i = 0; i < 4; ++i) { Bs[lk + 2 * i][lrow] = __uint_as_float(wb[i] << 16); Bs[lk + 2 * i + 1][lrow] = __uint_as_float(wb[i] & 0xffff0000u); }
        }
        __syncthreads();
#pragma unroll 8
        for (int kk = 0; kk < 32; ++kk) {
            float a[4], b[4];
#pragma unroll
            for (int i = 0; i < 4; ++i) { a[i] = As[kk][ty * 4 + i]; b[i] = Bs[kk][tx * 4 + i]; }
#pragma unroll
            for (int i = 0; i < 4; ++i)
#pragma unroll
                for (int j = 0; j < 4; ++j) acc[i][j] += a[i] * b[j];
        }
        __syncthreads();
    }
#pragma unroll
    for (int i = 0; i < 4; ++i)
#pragma unroll
        for (int j = 0; j < 4; ++j) { const int m = bm + ty * 4 + i, n = bn + tx * 4 + j; if (n < N) epi(m, n, acc[i][j]); }
}
struct EpiProj { bf16_t* pb; bf16_t* pa;
    __device__ void operator()(int m, int n, float v) const { if (n < PB_LD) pb[(size_t)m * PB_LD + n] = f2bf(v); else pa[(size_t)m * PA_LD + (n - PB_LD)] = f2bf(v); } };
struct EpiRowScaleF32 { float* out; const float* ss; int ld; float inv_n;
    __device__ void operator()(int m, int n, float v) const { out[(size_t)m * ld + n] = v * rsqrtf(ss[m] * inv_n + EPS); } };
struct EpiRowScaleBf16 { bf16_t* out; const float* ss; int ld; float inv_n;
    __device__ void operator()(int m, int n, float v) const { out[(size_t)m * ld + n] = f2bf(v * rsqrtf(ss[m] * inv_n + EPS)); } };
__device__ __forceinline__ float sigmoidf_(float x) { return 1.f / (1.f + __expf(-x)); }
struct EpiMergeA { float* tmp; const bf16_t* pb;
    __device__ void operator()(int m, int n, float v) const { tmp[(size_t)m * DM + n] = sigmoidf_(bf2f(pb[(size_t)m * PB_LD + PB_BR + n])) * v; } };
struct EpiMergeB { const float* tmp; const bf16_t* pb; bf16_t* merged;
    __device__ void operator()(int m, int n, float v) const { merged[(size_t)m * DM + n] = f2bf(tmp[(size_t)m * DM + n] + sigmoidf_(bf2f(pb[(size_t)m * PB_LD + PB_BR + 1024 + n])) * v); } };
struct EpiResid { const float* x; float* x1;
    __device__ void operator()(int m, int n, float v) const { x1[(size_t)m * DM + n] = x[(size_t)m * DM + n] + v; } };

__global__ __launch_bounds__(256) void k_ss(const bf16_t* __restrict__ pa, float* __restrict__ ssq, float* __restrict__ sskv) {
    const int row = blockIdx.x * 4 + (threadIdx.x >> 6), lane = threadIdx.x & 63;
    const bf16_t* r = pa + (size_t)row * PA_LD;
    float a = 0.f, b = 0.f;
    for (int c = lane; c < 384; c += 64) { const float v = bf2f(r[PA_QLAT + c]); a += v * v; }
    for (int c = lane; c < 256; c += 64) { const float v = bf2f(r[PA_KVLAT + c]); b += v * v; }
    a = wave_sum(a); b = wave_sum(b);
    if (lane == 0) { ssq[row] = a; sskv[row] = b; }
}
constexpr float CQ = 0.10206207261596577f * 1.4426950408889634f;
__global__ __launch_bounds__(256) void k_q_post(const float* __restrict__ qt, const float* __restrict__ cs, const float* __restrict__ sn, bf16_t* __restrict__ Q) {
    const int i = blockIdx.x * 256 + threadIdx.x; if (i >= M_ * 768) return;
    const int m = i / 768, col = i % 768, j = col % 96;
    float o;
    if (j < 64) o = qt[i];
    else { const int r = j - 64;
        if (r < 16) { const float x1 = qt[i], x2 = qt[i + 16]; o = x1 * cs[m * 16 + r] - x2 * sn[m * 16 + r]; }
        else { const int f = r - 16; const float x2 = qt[i], x1 = qt[i - 16]; o = x2 * cs[m * 16 + f] + x1 * sn[m * 16 + f]; } }
    Q[i] = f2bf(o * CQ);
}
__global__ __launch_bounds__(256) void k_kv_post(const float* __restrict__ kvt, const bf16_t* __restrict__ pa, const float* __restrict__ cs, const float* __restrict__ sn, bf16_t* __restrict__ K, bf16_t* __restrict__ V) {
    const int i = blockIdx.x * 256 + threadIdx.x; if (i >= M_ * 1024) return;
    const int m = i >> 10, col = i & 1023, h = col >> 7, j = col & 127;
    if (j < 64) K[(size_t)m * 768 + h * 96 + j] = f2bf(kvt[i]);
    else V[(size_t)m * 512 + h * 64 + (j - 64)] = f2bf(kvt[i]);
    if (j < 32) {
        const bf16_t* kr = pa + (size_t)m * PA_LD + PA_KROPE;
        float o;
        if (j < 16) { const float x1 = bf2f(kr[j]), x2 = bf2f(kr[j + 16]); o = x1 * cs[m * 16 + j] - x2 * sn[m * 16 + j]; }
        else { const int f = j - 16; const float x2 = bf2f(kr[j]), x1 = bf2f(kr[j - 16]); o = x2 * cs[m * 16 + f] + x1 * sn[m * 16 + f]; }
        K[(size_t)m * 768 + h * 96 + 64 + j] = f2bf(o);
    }
}

__global__ __launch_bounds__(256) void k_gla_local(const bf16_t* __restrict__ pa, const float* __restrict__ w_a2, const float* __restrict__ b_a2, float* __restrict__ dst, float* __restrict__ decay) {
    __shared__ float cum[64][64];
    __shared__ float kd[64][64];
    __shared__ float gvs[64][128];
    const int tid = threadIdx.x, h = blockIdx.x & 3, bc = blockIdx.x >> 2;
    const int t0 = bc * 64;
    {
        const int k = tid & 63;
        float w[16];
#pragma unroll
        for (int r = 0; r < 16; ++r) w[r] = w_a2[r * 256 + h * 64 + k];
        const float bias = b_a2[h * 64 + k];
        for (int l = tid >> 6; l < 64; l += 4) {
            const bf16_t* g = pa + (size_t)(t0 + l) * PA_LD + PA_GLR;
            float z = bias;
#pragma unroll
            for (int r = 0; r < 16; ++r) z += bf2f(g[r]) * w[r];
            const float ls = fminf(z, 0.f) - log1pf(expf(-fabsf(z)));
            cum[l][k] = ls * (1.f / 16.f);
        }
    }
    __syncthreads();
    if (tid < 64) { float s = 0.f; for (int l = 0; l < 64; ++l) { s += cum[l][tid]; cum[l][tid] = s; } }
    __syncthreads();
    for (int i = tid; i < 64 * 64; i += 256) { const int l = i >> 6, k = i & 63;
        kd[l][k] = bf2f(pa[(size_t)(t0 + l) * PA_LD + PA_GK + h * 64 + k]) * expf(cum[63][k] - cum[l][k]); }
    for (int i = tid; i < 64 * 128; i += 256) { const int l = i >> 7, v = i & 127;
        gvs[l][v] = bf2f(pa[(size_t)(t0 + l) * PA_LD + PA_GV + h * 128 + v]); }
    if (tid < 64) decay[((size_t)bc * 4 + h) * 64 + tid] = expf(cum[63][tid]);
    __syncthreads();
    const int v = tid & 127, kb = (tid >> 7) * 32;
    for (int kk = 0; kk < 32; ++kk) { const int k = kb + kk; float s = 0.f;
        for (int l = 0; l < 64; ++l) s += kd[l][k] * gvs[l][v];
        dst[(((size_t)bc * 4 + h) * 64 + k) * 128 + v] = s; }
}
__global__ __launch_bounds__(256) void k_gla_scan(float* __restrict__ dst, const float* __restrict__ decay) {
    const int i = blockIdx.x * 256 + threadIdx.x;
    const int v = i & 127, k = (i >> 7) & 63, h = (i >> 13) & 3, b = i >> 15;
    float s = 0.f;
    for (int c = 0; c < NCH; ++c) {
        const size_t bc = (size_t)b * NCH + c;
        const size_t idx = ((bc * 4 + h) * 64 + k) * 128 + v;
        s = decay[(bc * 4 + h) * 64 + k] * s + dst[idx];
        dst[idx] = s;
    }
}
__global__ __launch_bounds__(256) void k_gla_out(const float* __restrict__ st, const bf16_t* __restrict__ pb, const float* __restrict__ g_gla, bf16_t* __restrict__ yb) {
    __shared__ float ss[64][128];
    __shared__ float qs[64][65];
    const int tid = threadIdx.x, h = blockIdx.x & 3, bc = blockIdx.x >> 2, t0 = bc * 64;
    const float* sp = st + ((size_t)bc * 4 + h) * 64 * 128;
    for (int i = tid; i < 64 * 128; i += 256) ss[i >> 7][i & 127] = sp[i];
    for (int i = tid; i < 64 * 64; i += 256) { const int l = i >> 6, k = i & 63; qs[l][k] = bf2f(pb[(size_t)(t0 + l) * PB_LD + PB_GQ + h * 64 + k]) * 0.125f; }
    __syncthreads();
    const int l = tid >> 2, vg = tid & 3;
    float o[32];
#pragma unroll
    for (int j = 0; j < 32; ++j) o[j] = 0.f;
    for (int k = 0; k < 64; ++k) { const float q = qs[l][k];
#pragma unroll
        for (int j = 0; j < 32; ++j) o[j] += q * ss[k][vg * 32 + j]; }
    float s2 = 0.f;
#pragma unroll
    for (int j = 0; j < 32; ++j) s2 += o[j] * o[j];
    s2 += __shfl_xor(s2, 1); s2 += __shfl_xor(s2, 2);
    const float r = rsqrtf(s2 * (1.f / 128.f) + EPS);
#pragma unroll
    for (int j = 0; j < 32; ++j) { const int v = vg * 32 + j;
        const float go = bf2f(pb[(size_t)(t0 + l) * PB_LD + PB_GOUT + h * 128 + v]);
        const float silu = go / (1.f + __expf(-go));
        yb[(size_t)(t0 + l) * 512 + h * 128 + v] = f2bf(o[j] * r * g_gla[h * 128 + v] * silu); }
}

__global__ __launch_bounds__(64) void k_attn_naive(const bf16_t* __restrict__ Q, const bf16_t* __restrict__ K, const bf16_t* __restrict__ V, bf16_t* __restrict__ YA) {
    const int h = blockIdx.x & 7, bc = blockIdx.x >> 3, b = bc >> 7, c = bc & 127;
    const int m = bc * 64 + threadIdx.x;
    float q[96], acc[64];
#pragma unroll
    for (int d = 0; d < 96; ++d) q[d] = bf2f(Q[(size_t)m * 768 + h * 96 + d]);
#pragma unroll
    for (int d = 0; d < 64; ++d) acc[d] = 0.f;
    float mx = -1e30f, l = 0.f;
    const int nk = (c + 1) * 64;
    const bf16_t* Kb = K + (size_t)b * SEQ * 768 + h * 96;
    const bf16_t* Vb = V + (size_t)b * SEQ * 512 + h * 64;
    for (int j = 0; j < nk; ++j) {
        const bf16_t* kr = Kb + (size_t)j * 768;
        float s = 0.f;
#pragma unroll
        for (int d = 0; d < 96; ++d) s += q[d] * bf2f(kr[d]);
        if (s > mx) { const float f = exp2f(mx - s); l *= f;
#pragma unroll
            for (int d = 0; d < 64; ++d) acc[d] *= f;
            mx = s; }
        const float p = exp2f(s - mx); l += p;
        const bf16_t* vr = Vb + (size_t)j * 512;
#pragma unroll
        for (int d = 0; d < 64; ++d) acc[d] += p * bf2f(vr[d]);
    }
    const float il = 1.f / l;
#pragma unroll
    for (int d = 0; d < 64; ++d) YA[(size_t)m * 512 + h * 64 + d] = f2bf(acc[d] * il);
}

__global__ __launch_bounds__(256) void k_x1_post(const float* __restrict__ x1, bf16_t* __restrict__ x1b, float* __restrict__ ssx1) {
    const int row = blockIdx.x * 4 + (threadIdx.x >> 6), lane = threadIdx.x & 63;
    const float4* xr = (const float4*)(x1 + (size_t)row * DM);
    float ss = 0.f;
#pragma unroll
    for (int j = 0; j < 4; ++j) { const float4 v = xr[lane + 64 * j]; ss += v.x * v.x + v.y * v.y + v.z * v.z + v.w * v.w;
        bf16_t* o = x1b + (size_t)row * DM + 4 * (lane + 64 * j); o[0] = f2bf(v.x); o[1] = f2bf(v.y); o[2] = f2bf(v.z); o[3] = f2bf(v.w); }
    ss = wave_sum(ss);
    if (lane == 0) ssx1[row] = ss;
}

#define TOPK_INSERT(tv, ti, vv, ii) do { float v_ = (vv); int i_ = (ii); \
    _Pragma("unroll") for (int q_ = 0; q_ < 16; ++q_) { const bool gt_ = (v_ > tv[q_]) || (v_ == tv[q_] && i_ < ti[q_]); const float tv_ = tv[q_]; const int ti_ = ti[q_]; \
        tv[q_] = gt_ ? v_ : tv_; ti[q_] = gt_ ? i_ : ti_; v_ = gt_ ? tv_ : v_; i_ = gt_ ? ti_ : i_; } } while (0)
__global__ __launch_bounds__(64) void k_peer_topk1(const bf16_t* __restrict__ qp, const bf16_t* __restrict__ keys, float* __restrict__ tops, int* __restrict__ topi) {
    __shared__ float qs[64][129];
    const int hp = blockIdx.x & 15, m0 = (blockIdx.x >> 4) * 64, tid = threadIdx.x;
    for (int i = tid; i < 64 * 128; i += 64) { const int r = i >> 7, d = i & 127; qs[r][d] = bf2f(qp[(size_t)(m0 + r) * 2048 + hp * 128 + d]); }
    __syncthreads();
    float tv[16]; int ti[16];
#pragma unroll
    for (int i = 0; i < 16; ++i) { tv[i] = -INFINITY; ti[i] = 0x7fffffff; }
    for (int n = 0; n < 128; ++n) {
        const bf16_t* kr = keys + ((size_t)hp * 128 + n) * 128;
        float s = 0.f;
        for (int d = 0; d < 128; ++d) s += qs[tid][d] * bf2f(kr[d]);
        TOPK_INSERT(tv, ti, s, n);
    }
    const size_t o = ((size_t)(m0 + tid) * 16 + hp) * 16;
#pragma unroll
    for (int i = 0; i < 16; ++i) { tops[o + i] = tv[i]; topi[o + i] = ti[i]; }
}
__global__ __launch_bounds__(256) void k_peer_topk2(const float* __restrict__ tops, const int* __restrict__ topi, int* __restrict__ eidx, float* __restrict__ egate) {
    const int i = blockIdx.x * 256 + threadIdx.x; if (i >= M_ * 8) return;
    const int m = i >> 3, h = i & 7;
    const size_t o0 = ((size_t)m * 16 + 2 * h) * 16, o1 = o0 + 16;
    float s0[16], s1[16];
#pragma unroll
    for (int k = 0; k < 16; ++k) { s0[k] = tops[o0 + k]; s1[k] = tops[o1 + k]; }
    float tv[16]; int ti[16];
#pragma unroll
    for (int k = 0; k < 16; ++k) { tv[k] = -INFINITY; ti[k] = 0x7fffffff; }
#pragma unroll
    for (int a = 0; a < 16; ++a)
#pragma unroll
        for (int b = 0; b < 16; ++b) TOPK_INSERT(tv, ti, s0[a] + s1[b], a * 16 + b);
    float e[16], sum = 0.f;
#pragma unroll
    for (int k = 0; k < 16; ++k) { e[k] = __expf(tv[k] - tv[0]); sum += e[k]; }
    const float inv = 1.f / sum;
#pragma unroll
    for (int k = 0; k < 16; ++k) {
        const int pos = ti[k];
        eidx[(size_t)m * 128 + h * 16 + k] = topi[o0 + (pos >> 4)] * 128 + topi[o1 + (pos & 15)];
        egate[(size_t)m * 128 + h * 16 + k] = e[k] * inv;
    }
}
__global__ __launch_bounds__(256) void k_peer_out(const float* x1, const bf16_t* __restrict__ x1b, const float* __restrict__ ssx1, const float* __restrict__ g_ffn,
                                                  const int* __restrict__ eidx, const float* __restrict__ egate, const float* __restrict__ pu, const float* __restrict__ pv,
                                                  const float* __restrict__ g_final, float* out) {
    const int m = blockIdx.x * 4 + (threadIdx.x >> 6), lane = threadIdx.x & 63;
    float xg[16], y[16];
#pragma unroll
    for (int j = 0; j < 4; ++j) { const int c = 4 * (lane + 64 * j); const float4 gg = *(const float4*)(g_ffn + c); const bf16_t* xb = x1b + (size_t)m * DM + c;
        xg[4 * j] = bf2f(xb[0]) * gg.x; xg[4 * j + 1] = bf2f(xb[1]) * gg.y; xg[4 * j + 2] = bf2f(xb[2]) * gg.z; xg[4 * j + 3] = bf2f(xb[3]) * gg.w; }
#pragma unroll
    for (int j = 0; j < 16; ++j) y[j] = 0.f;
    const float r = rsqrtf(ssx1[m] * (1.f / DM) + EPS);
    for (int k = 0; k < 128; ++k) {
        const int e = eidx[(size_t)m * 128 + k]; const float gate = egate[(size_t)m * 128 + k];
        const float4* ur = (const float4*)(pu + (size_t)e * DM);
        float d = 0.f;
#pragma unroll
        for (int j = 0; j < 4; ++j) { const float4 u = ur[lane + 64 * j]; d += xg[4 * j] * u.x + xg[4 * j + 1] * u.y + xg[4 * j + 2] * u.z + xg[4 * j + 3] * u.w; }
        d = wave_sum(d) * r;
        const float a = 0.5f * d * (1.f + erff(d * 0.70710678118654752f)) * gate;
        const float4* vr = (const float4*)(pv + (size_t)e * DM);
#pragma unroll
        for (int j = 0; j < 4; ++j) { const float4 v = vr[lane + 64 * j]; y[4 * j] += a * v.x; y[4 * j + 1] += a * v.y; y[4 * j + 2] += a * v.z; y[4 * j + 3] += a * v.w; }
    }
    const float4* xr = (const float4*)(x1 + (size_t)m * DM);
    float ss = 0.f;
#pragma unroll
    for (int j = 0; j < 4; ++j) { const float4 v = xr[lane + 64 * j]; y[4 * j] += v.x; y[4 * j + 1] += v.y; y[4 * j + 2] += v.z; y[4 * j + 3] += v.w;
        ss += y[4 * j] * y[4 * j] + y[4 * j + 1] * y[4 * j + 1] + y[4 * j + 2] * y[4 * j + 2] + y[4 * j + 3] * y[4 * j + 3]; }
    ss = wave_sum(ss);
    const float r2 = rsqrtf(ss * (1.f / DM) + EPS);
#pragma unroll
    for (int j = 0; j < 4; ++j) { const int c = 4 * (lane + 64 * j); const float4 gg = *(const float4*)(g_final + c);
        float4 o; o.x = y[4 * j] * r2 * gg.x; o.y = y[4 * j + 1] * r2 * gg.y; o.z = y[4 * j + 2] * r2 * gg.z; o.w = y[4 * j + 3] * r2 * gg.w;
        *(float4*)(out + (size_t)m * DM + c) = o; }
}

template <class Epi>
static void gemm(hipStream_t s, const bf16_t* A, int lda, const bf16_t* Bt, int ldb, int M, int N, int K, Epi e) {
    dim3 g((N + 63) / 64, M / 64);
    hipLaunchKernelGGL((k_gemm<Epi>), g, dim3(256), 0, s, A, Bt, lda, ldb, M, N, K, 0, e);
}
static void wt(hipStream_t s, const float* W, int K, int Nsrc, bf16_t* out, int Nout, const float* ksc, int mode) {
    const size_t n = (size_t)Nout * K;
    hipLaunchKernelGGL(k_wt, dim3((unsigned)((n + 255) / 256)), dim3(256), 0, s, W, out, ksc, K, Nsrc, Nout, mode);
}

extern "C" void kernel_launch(void* const* d_in, const int* in_sizes, int n_in, void* d_out, int out_size, void* d_ws, size_t ws_size, hipStream_t stream) {
    const float* x = (const float*)d_in[0]; const int* positions = (const int*)d_in[1];
    const float* g_mix = (const float*)d_in[2]; const float* w_in = (const float*)d_in[3]; const float* g_q_lat = (const float*)d_in[4]; const float* w_qb = (const float*)d_in[5];
    const float* g_kv_lat = (const float*)d_in[6]; const float* w_kvb = (const float*)d_in[7]; const float* w_a2 = (const float*)d_in[8]; const float* b_a2 = (const float*)d_in[9];
    const float* g_gla = (const float*)d_in[10]; const float* w_branch_a = (const float*)d_in[11]; const float* w_branch_b = (const float*)d_in[12]; const float* w_out = (const float*)d_in[13];
    const float* g_ffn = (const float*)d_in[14]; const float* w_peer_q = (const float*)d_in[15]; const float* sub_keys = (const float*)d_in[16]; const float* peer_u = (const float*)d_in[17];
    const float* peer_v = (const float*)d_in[18]; const float* g_final = (const float*)d_in[19];
    float* out = (float*)d_out; char* ws = (char*)d_ws;
    float* SSQ = (float*)(ws + WS_SSQ); float* SSKV = (float*)(ws + WS_SSKV); float* SSX1 = (float*)(ws + WS_SSX1); float* COS = (float*)(ws + WS_COS); float* SIN = (float*)(ws + WS_SIN);
    float* DECAY = (float*)(ws + WS_DECAY);
    bf16_t* WIN = (bf16_t*)(ws + WS_WIN); bf16_t* WQB = (bf16_t*)(ws + WS_WQB); bf16_t* WKVB = (bf16_t*)(ws + WS_WKVB); bf16_t* WA = (bf16_t*)(ws + WS_WA); bf16_t* WB = (bf16_t*)(ws + WS_WB);
    bf16_t* WOUT = (bf16_t*)(ws + WS_WOUT); bf16_t* WPQ = (bf16_t*)(ws + WS_WPQ); bf16_t* KEYS = (bf16_t*)(ws + WS_KEYS);
    bf16_t* PROJB = (bf16_t*)(ws + WS_PROJB); bf16_t* PROJA = (bf16_t*)(ws + WS_PROJA); bf16_t* XN = (bf16_t*)(ws + WS_XN);
    bf16_t* Q = (bf16_t*)(ws + WS_Q); bf16_t* K = (bf16_t*)(ws + WS_K); bf16_t* V = (bf16_t*)(ws + WS_V); float* DST = (float*)(ws + WS_DST);
    bf16_t* YA = (bf16_t*)(ws + WS_YA); bf16_t* YB = (bf16_t*)(ws + WS_YB); bf16_t* MERGED = (bf16_t*)(ws + WS_MERGED); bf16_t* X1B = (bf16_t*)(ws + WS_X1B); bf16_t* QP = (bf16_t*)(ws + WS_QP);
    int* EIDX = (int*)(ws + WS_EIDX); float* EGATE = (float*)(ws + WS_EGATE); float* TOPS = (float*)(ws + WS_TOPS); int* TOPI = (int*)(ws + WS_TOPI);

    hipLaunchKernelGGL(k_xn, dim3(M_ / 4), dim3(256), 0, stream, x, g_mix, XN);
    wt(stream, w_in, 1024, 4272, WIN, NPROJ, nullptr, 1);
    wt(stream, w_qb, 384, 768, WQB, 768, g_q_lat, 0);
    wt(stream, w_kvb, 256, 1024, WKVB, 1024, g_kv_lat, 0);
    wt(stream, w_branch_a, 512, 1024, WA, 1024, nullptr, 0);
    wt(stream, w_branch_b, 512, 1024, WB, 1024, nullptr, 0);
    wt(stream, w_out, 1024, 1024, WOUT, 1024, nullptr, 0);
    wt(stream, w_peer_q, 1024, 2048, WPQ, 2048, g_ffn, 0);
    hipLaunchKernelGGL(k_cvt, dim3(16 * 128 * 128 / 256), dim3(256), 0, stream, sub_keys, KEYS, 16 * 128 * 128);
    hipLaunchKernelGGL(k_ropetab, dim3(M_ * 16 / 256), dim3(256), 0, stream, positions, COS, SIN);
    gemm(stream, XN, DM, WIN, DM, M_, NPROJ, DM, EpiProj{PROJB, PROJA});
    hipLaunchKernelGGL(k_ss, dim3(M_ / 4), dim3(256), 0, stream, PROJA, SSQ, SSKV);
    gemm(stream, PROJA + PA_QLAT, PA_LD, WQB, 384, M_, 768, 384, EpiRowScaleF32{out, SSQ, 768, 1.f / 384.f});
    hipLaunchKernelGGL(k_q_post, dim3(M_ * 768 / 256), dim3(256), 0, stream, out, COS, SIN, Q);
    gemm(stream, PROJA + PA_KVLAT, PA_LD, WKVB, 256, M_, 1024, 256, EpiRowScaleF32{out, SSKV, 1024, 1.f / 256.f});
    hipLaunchKernelGGL(k_kv_post, dim3(M_ * 1024 / 256), dim3(256), 0, stream, out, PROJA, COS, SIN, K, V);
    hipLaunchKernelGGL(k_gla_local, dim3(2 * NCH * 4), dim3(256), 0, stream, PROJA, w_a2, b_a2, DST, DECAY);
    hipLaunchKernelGGL(k_attn_naive, dim3(2 * NCH * 8), dim3(64), 0, stream, Q, K, V, YA);
    hipLaunchKernelGGL(k_gla_scan, dim3(65536 / 256), dim3(256), 0, stream, DST, DECAY);
    hipLaunchKernelGGL(k_gla_out, dim3(2 * NCH * 4), dim3(256), 0, stream, DST, PROJB, g_gla, YB);
    gemm(stream, YA, 512, WA, 512, M_, 1024, 512, EpiMergeA{out, PROJB});
    gemm(stream, YB, 512, WB, 512, M_, 1024, 512, EpiMergeB{out, PROJB, MERGED});
    gemm(stream, MERGED, DM, WOUT, DM, M_, 1024, 1024, EpiResid{x, out});
    hipLaunchKernelGGL(k_x1_post, dim3(M_ / 4), dim3(256), 0, stream, out, X1B, SSX1);
    gemm(stream, X1B, DM, WPQ, DM, M_, 2048, 1024, EpiRowScaleBf16{QP, SSX1, 2048, 1.f / 1024.f});
    hipLaunchKernelGGL(k_peer_topk1, dim3((M_ / 64) * 16), dim3(64), 0, stream, QP, KEYS, TOPS, TOPI);
    hipLaunchKernelGGL(k_peer_topk2, dim3(M_ * 8 / 256), dim3(256), 0, stream, TOPS, TOPI, EIDX, EGATE);
    hipLaunchKernelGGL(k_peer_out, dim3(M_ / 4), dim3(256), 0, stream, out, X1B, SSX1, g_ffn, EIDX, EGATE, peer_u, peer_v, g_final, out);
}
```

```cpp
#include <hip/hip_runtime.h>
#include <cstdio>
#include <cstdint>
#include <cstring>
#include <math.h>

#ifndef MK_N_LAUNCHES
#define MK_N_LAUNCHES 1
#endif
constexpr int N_PHASES = 10;

typedef unsigned short bf16_t;
constexpr int SEQ = 8192, DM = 1024, M_ = 16384, NCH = 128;
constexpr float EPS = 1e-6f;
constexpr int PB_LD = 2816, PA_LD = 1536;
constexpr int PB_BR = 0, PB_GOUT = 2048, PB_GQ = 2560;
constexpr int PA_GV = 0, PA_GK = 512, PA_QLAT = 768, PA_KVLAT = 1152, PA_KROPE = 1408, PA_GLR = 1440;
constexpr int NPROJ = 4352;
constexpr float CQ = 0.10206207261596577f * 1.4426950408889634f;

constexpr size_t MiB = 1u << 20;
constexpr size_t WS_CTL = 0, CTL_ZERO_BYTES = 256 * 1024;
constexpr size_t WS_SSQ = 1 * MiB, WS_SSKV = WS_SSQ + 65536, WS_SSX1 = WS_SSKV + 65536, WS_COS = 2 * MiB, WS_SIN = 3 * MiB;
constexpr size_t WS_DECAY = 1 * MiB + 512 * 1024;
constexpr size_t WS_WIN = 4 * MiB, WS_WQB = 13 * MiB, WS_WKVB = 14 * MiB, WS_WA = 15 * MiB, WS_WB = 16 * MiB, WS_WOUT = 17 * MiB, WS_WPQ = 19 * MiB, WS_KEYS = 23 * MiB;
constexpr size_t WS_PROJB = 24 * MiB, WS_PROJA = 112 * MiB, WS_XN = 160 * MiB, WS_Q = 160 * MiB, WS_K = 184 * MiB, WS_V = 208 * MiB, WS_DST = 224 * MiB;
constexpr size_t WS_YA = 112 * MiB, WS_YB = 128 * MiB, WS_MERGED = 160 * MiB, WS_X1B = 24 * MiB, WS_QP = 56 * MiB, WS_EIDX = 120 * MiB, WS_EGATE = 128 * MiB;
constexpr size_t WS_END = 256 * MiB;

#define GAS __attribute__((address_space(1)))
#define LAS __attribute__((address_space(3)))
typedef float f32x4 __attribute__((ext_vector_type(4)));
typedef unsigned u32x4 __attribute__((ext_vector_type(4)));
typedef unsigned u32x2 __attribute__((ext_vector_type(2)));

__device__ __forceinline__ float bf2f(bf16_t h) { return __uint_as_float(((unsigned)h) << 16); }
__device__ __forceinline__ unsigned f2bf_u(float f) { unsigned u = __float_as_uint(f); return (u + 0x7fffu + ((u >> 16) & 1u)) >> 16; }
__device__ __forceinline__ bf16_t f2bf(float f) { return (bf16_t)f2bf_u(f); }
__device__ __forceinline__ unsigned pk2(float lo, float hi) { return f2bf_u(lo) | (f2bf_u(hi) << 16); }
__device__ __forceinline__ float wave_sum(float v) {
#pragma unroll
    for (int o = 1; o < 64; o <<= 1) v += __shfl_xor(v, o);
    return v;
}
__device__ __forceinline__ float sigmoidf_(float x) { return 1.f / (1.f + __expf(-x)); }

namespace pg8 {
#define PG8_LAS __attribute__((address_space(3)))
typedef short bf16x8 __attribute__((ext_vector_type(8)));
constexpr int BM = 256, BK = 64, HALF = 128, HTB = HALF * BK * 2, STAGE_BYTES = 8 * HTB, NXCD = 8, WGM = 8;
__host__ __device__ __forceinline__ int lds_byte(int r, int c) { const int st = (r >> 4) * 2 + (c >> 5), rr = r & 15, cc = c & 31, ob = rr * 64 + cc * 2; return st * 1024 + (ob ^ (((ob >> 9) & 1) << 5)); }
__host__ __device__ __forceinline__ void stage_rc(int b, int& R, int& C) { const int st = b / 1024, sb = b % 1024, swz = sb ^ (((sb >> 9) & 1) << 5); R = (st >> 1) * 16 + swz / 64; C = (st & 1) * 32 + (swz % 64) / 2; }
__host__ __device__ __forceinline__ int perm32(int rho) { const int n = rho >> 4, i = rho & 15; return 8 * (i >> 2) + 4 * n + (i & 3); }

struct Unit { int pm, pn, sub; const char* A; const char* B; };
struct Gemm { const bf16_t* A; const bf16_t* Bt; const bf16_t* A2; const bf16_t* Bt2; int lda, ldb, M, N, K, chain; };
struct StaticOrder {
    int nM, nN, nwg, G, c, chain; const char *A, *B, *A2, *B2; size_t tsA, tsB;
    __device__ __forceinline__ void init(const Gemm& g, int G_, int c_) { nM = g.M / BM; nN = g.N / BM; nwg = nM * nN; G = G_; c = c_; chain = g.chain; A = (const char*)g.A; B = (const char*)g.Bt; A2 = (const char*)g.A2; B2 = (const char*)g.Bt2;
        tsA = (size_t)BM * g.lda * 2; tsB = (size_t)BM * g.ldb * 2; }
    __device__ __forceinline__ bool next(int i, Unit& u) const {
        const int r = (chain == 2) ? (i >> 1) : i, sub = (chain == 2) ? (i & 1) : 0;
        const long L = (long)r * G + c; if (L >= nwg) return false;
        int wgid = (int)L; { const int q = nwg / NXCD, rr = nwg % NXCD, xcd = wgid % NXCD, off = wgid / NXCD; wgid = (xcd < rr ? xcd * (q + 1) : rr * (q + 1) + (xcd - rr) * q) + off; }
        const int nig = WGM * nN, gid = wgid / nig, fm = gid * WGM, gsz = (nM - fm) < WGM ? (nM - fm) : WGM;
        u.pm = fm + ((wgid % nig) % gsz); u.pn = (wgid % nig) / gsz; u.sub = sub;
        u.A = (sub ? A2 : A) + (size_t)u.pm * tsA; u.B = (sub ? B2 : B) + (size_t)u.pn * tsB; return true;
    }
};
__device__ __forceinline__ unsigned cvt_pk_bf16(float lo, float hi) { unsigned r; asm volatile("v_cvt_pk_bf16_f32 %0, %1, %2" : "=v"(r) : "v"(lo), "v"(hi)); return r; }

typedef f32x4 AccT[2][2][4][2];
template <class Epi, class Sched, bool ALIGN_EPI>
__device__ __forceinline__ void gemm_phase(PG8_LAS unsigned char* lds, const Gemm g, const Sched& S, const Epi& E) {
    const int tid = threadIdx.x, wid = __builtin_amdgcn_readfirstlane(tid >> 6), lane = tid & 63, wr = wid >> 2, wc = wid & 3, fr = lane & 15, fq = lane >> 4;
    const int K = g.K, nt = K / BK;
    unsigned voffA[2], voffB[2];
#pragma unroll
    for (int i = 0; i < 2; ++i) { int R, C; stage_rc(tid * 16 + i * 8192, R, C); const int Rb = Epi::PERM ? ((R & ~31) + perm32(R & 31)) : R;
        voffA[i] = (unsigned)(R * g.lda + C) * 2u; voffB[i] = (unsigned)(Rb * g.ldb + C) * 2u; }
    const size_t kstep = (size_t)(BK * 2);
    const size_t hsA = (size_t)HALF * g.lda * 2, hsB = (size_t)HALF * g.ldb * 2;
    const unsigned ldsw = (unsigned)wid * 1024u;
    const int aoff = lds_byte(wr * 64 + fr, fq * 8), boff = lds_byte(wc * 32 + fr, fq * 8);
#define PG8_SA(b, h) (((b) * 2 + (h)) * HTB)
#define PG8_SB(b, h) ((4 + (b) * 2 + (h)) * HTB)
#define PG8_STAGE(bufoff, gbase, voff) do { _Pragma("unroll") for (int _i = 0; _i < 2; ++_i) \
        __builtin_amdgcn_global_load_lds((const unsigned*)((const char*)(gbase) + (voff)[_i]), (PG8_LAS unsigned*)(lds + (bufoff) + ldsw + _i * 8192), 16, 0, 0); } while (0)
#define PG8_LDA(dst, b, h) do { _Pragma("unroll") for (int m = 0; m < 4; ++m) _Pragma("unroll") for (int k = 0; k < 2; ++k) dst[m][k] = *(const PG8_LAS bf16x8*)(lds + PG8_SA(b, h) + aoff + m * 2048 + k * 1024); } while (0)
#define PG8_LDB(dst, b, h) do { _Pragma("unroll") for (int n = 0; n < 2; ++n) _Pragma("unroll") for (int k = 0; k < 2; ++k) dst[n][k] = *(const PG8_LAS bf16x8*)(lds + PG8_SB(b, h) + boff + n * 2048 + k * 1024); } while (0)
#define PG8_MMA(ai, bj, At, Bt) do { __builtin_amdgcn_s_setprio(1); _Pragma("unroll") for (int m = 0; m < 4; ++m) _Pragma("unroll") for (int n = 0; n < 2; ++n) _Pragma("unroll") for (int k = 0; k < 2; ++k) \
        acc[ai][bj][m][n] = __builtin_amdgcn_mfma_f32_16x16x32_bf16(Bt[n][k], At[m][k], acc[ai][bj][m][n], 0, 0, 0); __builtin_amdgcn_s_setprio(0); } while (0)
#define PG8_WAIT_V(n) asm volatile("s_waitcnt vmcnt(" #n ")" ::: "memory")
#define PG8_WAIT_L(n) asm volatile("s_waitcnt lgkmcnt(" #n ")" ::: "memory")
#define PG8_BAR __builtin_amdgcn_s_barrier()
#define PG8_SCHED __builtin_amdgcn_sched_barrier(0)
    Unit cur, nxt; int ui = 0;
    if (!S.next(0, cur)) return;
    f32x4 acc[2][2][4][2];
#pragma unroll
    for (int a = 0; a < 2; ++a)
#pragma unroll
        for (int b = 0; b < 2; ++b)
#pragma unroll
            for (int m = 0; m < 4; ++m)
#pragma unroll
                for (int n = 0; n < 2; ++n) acc[a][b][m][n] = (f32x4){0.f, 0.f, 0.f, 0.f};
    bf16x8 At[4][2], B0[2][2], B1[2][2];
    const char* cA = cur.A; const char* cB = cur.B;
    PG8_STAGE(PG8_SB(0, 0), cB, voffB); PG8_STAGE(PG8_SB(0, 1), cB + hsB, voffB); PG8_STAGE(PG8_SA(0, 0), cA, voffA); PG8_STAGE(PG8_SA(0, 1), cA + hsA, voffA);
    if (wr == 1) PG8_BAR;
    PG8_WAIT_V(2); PG8_BAR;
    PG8_STAGE(PG8_SB(1, 0), cB + kstep, voffB); PG8_STAGE(PG8_SA(1, 0), cA + kstep, voffA); PG8_STAGE(PG8_SB(1, 1), cB + hsB + kstep, voffB);
    PG8_WAIT_V(6); PG8_BAR;
    for (;;) {
        const bool has_next = S.next(ui + 1, nxt);
        const char* nA = has_next ? nxt.A : cA; const char* nB = has_next ? nxt.B : cB;
        for (int t = 0; t < nt; t += 2) {
            const bool last = (t == nt - 2);
            const char* a1 = cA + (size_t)(t + 1) * kstep;
            const char* a2 = last ? nA : cA + (size_t)(t + 2) * kstep; const char* b2 = last ? nB : cB + (size_t)(t + 2) * kstep;
            const char* a3 = a2 + kstep; const char* b3 = b2 + kstep;
            PG8_LDB(B0, 0, 0); PG8_LDB(B1, 0, 1); PG8_SCHED; PG8_LDA(At, 0, 0); PG8_STAGE(PG8_SA(1, 1), a1 + hsA, voffA);
            PG8_WAIT_V(8); PG8_WAIT_L(0); PG8_BAR; PG8_MMA(0, 0, At, B0); PG8_MMA(0, 1, At, B1); PG8_BAR; PG8_SCHED;
            PG8_LDA(At, 0, 1); PG8_STAGE(PG8_SB(0, 0), b2, voffB); PG8_STAGE(PG8_SB(0, 1), b2 + hsB, voffB); PG8_STAGE(PG8_SA(0, 0), a2, voffA);
            PG8_WAIT_V(8); PG8_WAIT_L(0); PG8_BAR; PG8_MMA(1, 0, At, B0); PG8_MMA(1, 1, At, B1); PG8_BAR; PG8_SCHED;
            PG8_LDB(B0, 1, 0); PG8_LDB(B1, 1, 1); PG8_SCHED; PG8_LDA(At, 1, 0); PG8_STAGE(PG8_SA(0, 1), a2 + hsA, voffA);
            PG8_WAIT_V(8); PG8_WAIT_L(0); PG8_BAR; PG8_MMA(0, 0, At, B0); PG8_MMA(0, 1, At, B1); PG8_BAR; PG8_SCHED;
            PG8_LDA(At, 1, 1); PG8_STAGE(PG8_SB(1, 0), b3, voffB); PG8_STAGE(PG8_SB(1, 1), b3 + hsB, voffB); PG8_STAGE(PG8_SA(1, 0), a3, voffA);
            PG8_WAIT_V(8); PG8_WAIT_L(0); PG8_BAR; PG8_MMA(1, 0, At, B0); PG8_MMA(1, 1, At, B1); PG8_BAR; PG8_SCHED;
        }
        if constexpr (ALIGN_EPI) { if (wr == 0) PG8_BAR; }
        E(acc, cur, wr, wc, fr, fq);
        if (!has_next) break;
        if (!(Epi::CHAIN && nxt.sub != 0)) {
#pragma unroll
            for (int a = 0; a < 2; ++a)
#pragma unroll
                for (int b = 0; b < 2; ++b)
#pragma unroll
                    for (int m = 0; m < 4; ++m)
#pragma unroll
                        for (int n = 0; n < 2; ++n) acc[a][b][m][n] = (f32x4){0.f, 0.f, 0.f, 0.f};
        }
        cur = nxt; cA = nA; cB = nB; ++ui;
        if constexpr (ALIGN_EPI) { if (wr == 1) PG8_BAR; }
    }
    PG8_WAIT_V(0);
    if constexpr (!ALIGN_EPI) { if (wr == 0) PG8_BAR; }
    PG8_BAR;
#undef PG8_SA
#undef PG8_SB
#undef PG8_STAGE
#undef PG8_LDA
#undef PG8_LDB
#undef PG8_MMA
#undef PG8_WAIT_V
#undef PG8_WAIT_L
#undef PG8_BAR
#undef PG8_SCHED
}

struct EpiProj {
    static constexpr bool PERM = true, CHAIN = false;
    bf16_t* pb; bf16_t* pa; float* ssq; float* sskv;
    __device__ __forceinline__ void operator()(AccT& acc, const Unit& u, int wr, int wc, int fr, int fq) const {
        const int row0 = u.pm * BM + wr * 64 + fr;
#pragma unroll
        for (int bj = 0; bj < 2; ++bj) {
            const int hk = u.pn * 2 + bj;
            bf16_t* base; int ld; float* ss = nullptr;
            if (hk < 22) { base = pb + hk * 128; ld = PB_LD; } else { const int ha = hk - 22; base = pa + ha * 128; ld = PA_LD; if (ha >= 6 && ha <= 8) ss = ssq; else if (ha == 9 || ha == 10) ss = sskv; }
            base += wc * 32 + 8 * fq;
#pragma unroll
            for (int ai = 0; ai < 2; ++ai)
#pragma unroll
                for (int m = 0; m < 4; ++m) { const int row = row0 + ai * HALF + m * 16; const f32x4 v0 = acc[ai][bj][m][0], v1 = acc[ai][bj][m][1];
                    u32x4 w; w.x = cvt_pk_bf16(v0[0], v0[1]); w.y = cvt_pk_bf16(v0[2], v0[3]); w.z = cvt_pk_bf16(v1[0], v1[1]); w.w = cvt_pk_bf16(v1[2], v1[3]);
                    *(u32x4*)(base + (size_t)row * ld) = w;
                    if (ss) { float s = (v0[0] * v0[0] + v0[1] * v0[1]) + (v0[2] * v0[2] + v0[3] * v0[3]) + (v1[0] * v1[0] + v1[1] * v1[1]) + (v1[2] * v1[2] + v1[3] * v1[3]);
                        s += __shfl_xor(s, 16); s += __shfl_xor(s, 32); if (fq == 0) atomicAdd(ss + row, s); } }
        }
    }
};
struct EpiQ {
    static constexpr bool PERM = false, CHAIN = false;
    bf16_t* Q; const float* ssq; const float* cs; const float* sn;
    __device__ __forceinline__ void operator()(AccT& acc, const Unit& u, int wr, int wc, int fr, int fq) const {
        const int row0 = u.pm * BM + wr * 64 + fr;
#pragma unroll
        for (int ai = 0; ai < 2; ++ai)
#pragma unroll
            for (int m = 0; m < 4; ++m) { const int row = row0 + ai * HALF + m * 16; const float rr = rsqrtf(ssq[row] * (1.f / 384.f) + EPS) * CQ;
#pragma unroll
                for (int bj = 0; bj < 2; ++bj) { const int G = u.pn * 8 + bj * 4 + wc;
                    f32x4 x0 = acc[ai][bj][m][0], x1 = acc[ai][bj][m][1];
                    if (G % 3 == 2) { const f32x4 c = *(const f32x4*)(cs + (size_t)row * 16 + 4 * fq), s = *(const f32x4*)(sn + (size_t)row * 16 + 4 * fq);
                        const f32x4 o0 = x0 * c - x1 * s, o1 = x1 * c + x0 * s; x0 = o0; x1 = o1; }
                    x0 = x0 * rr; x1 = x1 * rr;
                    bf16_t* p = Q + (size_t)row * 768 + G * 32 + 4 * fq;
                    u32x2 w0, w1; w0.x = cvt_pk_bf16(x0[0], x0[1]); w0.y = cvt_pk_bf16(x0[2], x0[3]); w1.x = cvt_pk_bf16(x1[0], x1[1]); w1.y = cvt_pk_bf16(x1[2], x1[3]);
                    *(u32x2*)p = w0; *(u32x2*)(p + 16) = w1; } }
    }
};
struct EpiKV {
    static constexpr bool PERM = true, CHAIN = false;
    bf16_t* Kb; bf16_t* Vb; const float* sskv;
    __device__ __forceinline__ void operator()(AccT& acc, const Unit& u, int wr, int wc, int fr, int fq) const {
        const int row0 = u.pm * BM + wr * 64 + fr;
#pragma unroll
        for (int ai = 0; ai < 2; ++ai)
#pragma unroll
            for (int m = 0; m < 4; ++m) { const int row = row0 + ai * HALF + m * 16; const float rr = rsqrtf(sskv[row] * (1.f / 256.f) + EPS);
#pragma unroll
                for (int bj = 0; bj < 2; ++bj) { const int head = u.pn * 2 + bj; const f32x4 v0 = acc[ai][bj][m][0] * rr, v1 = acc[ai][bj][m][1] * rr;
                    u32x4 w; w.x = cvt_pk_bf16(v0[0], v0[1]); w.y = cvt_pk_bf16(v0[2], v0[3]); w.z = cvt_pk_bf16(v1[0], v1[1]); w.w = cvt_pk_bf16(v1[2], v1[3]);
                    bf16_t* p = (wc < 2) ? Kb + (size_t)row * 768 + head * 96 + wc * 32 + 8 * fq : Vb + (size_t)row * 512 + head * 64 + (wc - 2) * 32 + 8 * fq;
                    *(u32x4*)p = w; } }
    }
};
struct EpiMerge {
    static constexpr bool PERM = true, CHAIN = true;
    const bf16_t* pb; bf16_t* merged;
    __device__ __forceinline__ void operator()(AccT& acc, const Unit& u, int wr, int wc, int fr, int fq) const {
        const int row0 = u.pm * BM + wr * 64 + fr, col0 = u.pn * BM + wc * 32 + 8 * fq;
#pragma unroll
        for (int ai = 0; ai < 2; ++ai)
#pragma unroll
            for (int m = 0; m < 4; ++m) { const int row = row0 + ai * HALF + m * 16;
#pragma unroll
                for (int bj = 0; bj < 2; ++bj) { const int col = col0 + bj * HALF;
                    const u32x4 gb = *(const u32x4*)(pb + (size_t)row * PB_LD + PB_BR + 1024 + col);
                    float sb[8];
#pragma unroll
                    for (int e = 0; e < 4; ++e) { sb[2 * e] = sigmoidf_(__uint_as_float(gb[e] << 16)); sb[2 * e + 1] = sigmoidf_(__uint_as_float(gb[e] & 0xffff0000u)); }
                    if (u.sub == 0) {
                        const u32x4 ga = *(const u32x4*)(pb + (size_t)row * PB_LD + PB_BR + col);
                        float sa[8];
#pragma unroll
                        for (int e = 0; e < 4; ++e) { sa[2 * e] = sigmoidf_(__uint_as_float(ga[e] << 16)); sa[2 * e + 1] = sigmoidf_(__uint_as_float(ga[e] & 0xffff0000u)); }
#pragma unroll
                        for (int e = 0; e < 4; ++e) { acc[ai][bj][m][0][e] *= sa[e] / sb[e]; acc[ai][bj][m][1][e] *= sa[4 + e] / sb[4 + e]; }
                    } else {
                        const f32x4 v0 = acc[ai][bj][m][0], v1 = acc[ai][bj][m][1];
                        u32x4 w; w.x = cvt_pk_bf16(v0[0] * sb[0], v0[1] * sb[1]); w.y = cvt_pk_bf16(v0[2] * sb[2], v0[3] * sb[3]); w.z = cvt_pk_bf16(v1[0] * sb[4], v1[1] * sb[5]); w.w = cvt_pk_bf16(v1[2] * sb[6], v1[3] * sb[7]);
                        *(u32x4*)(merged + (size_t)row * DM + col) = w; } } }
    }
};
struct EpiX1 {
    static constexpr bool PERM = false, CHAIN = false;
    const float* x; float* x1; bf16_t* x1b; float* ssx1;
    __device__ __forceinline__ void operator()(AccT& acc, const Unit& u, int wr, int wc, int fr, int fq) const {
        const int row0 = u.pm * BM + wr * 64 + fr, col0 = u.pn * BM + wc * 32 + 4 * fq;
#pragma unroll
        for (int ai = 0; ai < 2; ++ai)
#pragma unroll
            for (int m = 0; m < 4; ++m) { const int row = row0 + ai * HALF + m * 16; const size_t off = (size_t)row * DM + col0; float s = 0.f;
#pragma unroll
                for (int bj = 0; bj < 2; ++bj)
#pragma unroll
                    for (int n = 0; n < 2; ++n) { const size_t o = off + bj * HALF + n * 16; const f32x4 v = *(const f32x4*)(x + o) + acc[ai][bj][m][n];
                        *(f32x4*)(x1 + o) = v; u32x2 w; w.x = cvt_pk_bf16(v[0], v[1]); w.y = cvt_pk_bf16(v[2], v[3]); *(u32x2*)(x1b + o) = w;
                        s += (v[0] * v[0] + v[1] * v[1]) + (v[2] * v[2] + v[3] * v[3]); }
                s += __shfl_xor(s, 16); s += __shfl_xor(s, 32); if (fq == 0) atomicAdd(ssx1 + row, s); }
    }
};
struct EpiQP {
    static constexpr bool PERM = true, CHAIN = false;
    bf16_t* qp; const float* ssx1;
    __device__ __forceinline__ void operator()(AccT& acc, const Unit& u, int wr, int wc, int fr, int fq) const {
        const int row0 = u.pm * BM + wr * 64 + fr, col0 = u.pn * BM + wc * 32 + 8 * fq;
#pragma unroll
        for (int ai = 0; ai < 2; ++ai)
#pragma unroll
            for (int m = 0; m < 4; ++m) { const int row = row0 + ai * HALF + m * 16; const float rr = rsqrtf(ssx1[row] * (1.f / 1024.f) + EPS);
#pragma unroll
                for (int bj = 0; bj < 2; ++bj) { const f32x4 v0 = acc[ai][bj][m][0] * rr, v1 = acc[ai][bj][m][1] * rr;
                    u32x4 w; w.x = cvt_pk_bf16(v0[0], v0[1]); w.y = cvt_pk_bf16(v0[2], v0[3]); w.z = cvt_pk_bf16(v1[0], v1[1]); w.w = cvt_pk_bf16(v1[2], v1[3]);
                    *(u32x4*)(qp + (size_t)row * 2048 + col0 + bj * HALF) = w; } }
    }
};
}

#define XB_TMO      128
#define XB_XCNT(j)  (256  + 64 * (j))
#define XB_XSUB(j)  (1280 + 64 * (j))
#define XB_XGEN(j)  (2304 + 64 * (j))
#define XB_TOP      3328
#define XB_TOPGEN   3392
#define XCD_BAR_WORDS 3456
#define XB_SPIN_CAP (1u << 18)
__device__ __forceinline__ unsigned xb_ld(unsigned* p)              { return __hip_atomic_load(p, __ATOMIC_RELAXED, __HIP_MEMORY_SCOPE_AGENT); }
__device__ __forceinline__ unsigned xb_add(unsigned* p, unsigned v) { return __hip_atomic_fetch_add(p, v, __ATOMIC_RELAXED, __HIP_MEMORY_SCOPE_AGENT); }
__device__ __forceinline__ unsigned xb_xcc_id() { return (unsigned)__builtin_amdgcn_s_getreg((3 << 11) | 20) & 0xFu; }
#define XB_SPIN(cond, bar) do { unsigned _sp = 0; while (cond) { __builtin_amdgcn_s_sleep(1); \
    if ((++_sp & 255u) == 0u) { if (xb_ld(&(bar)[XB_TMO])) break; if (_sp > XB_SPIN_CAP) { atomicAdd(&(bar)[XB_TMO], 1u); break; } } } } while (0)
struct XcdBarrier { unsigned* bar; unsigned x; volatile LAS unsigned* st; };
__device__ __forceinline__ XcdBarrier xcd_barrier_post(unsigned* bar, volatile LAS unsigned* st) {
    XcdBarrier b; b.bar = bar; b.x = xb_xcc_id(); b.st = st;
    if (threadIdx.x == 0) (void)xb_add(&bar[XB_XCNT(b.x)], 1u);
    return b;
}
__device__ __forceinline__ void xcd_barrier_complete(unsigned* bar, unsigned x, unsigned& nloc, unsigned& nx) {
    const unsigned G = gridDim.x * gridDim.y * gridDim.z;
    unsigned sum, cnt, mine, sp = 0u;
    for (;;) {
        sum = 0u; cnt = 0u; mine = 0u;
#pragma unroll
        for (unsigned j = 0; j < 16; ++j) { const unsigned c = xb_ld(&bar[XB_XCNT(j)]); sum += c; cnt += (c > 0u) ? 1u : 0u; mine = (j == x) ? c : mine; }
        if (sum == G) break;
        __builtin_amdgcn_s_sleep(1);
        if ((++sp & 255u) == 0u) { if (xb_ld(&bar[XB_TMO])) break; if (sp > XB_SPIN_CAP) { atomicAdd(&bar[XB_TMO], 1u); break; } }
    }
    nloc = mine > 0u ? mine : 1u; nx = cnt > 0u ? cnt : 1u;
}
__device__ __forceinline__ void xcd_barrier(const XcdBarrier& b) {
    asm volatile("s_waitcnt vmcnt(0)" ::: "memory");
    __syncthreads();
    if (threadIdx.x == 0) {
        unsigned* bar = b.bar;
        __builtin_amdgcn_s_waitcnt(0);
        unsigned nloc = b.st[0], nx = b.st[1];
        if (nloc == 0u) { xcd_barrier_complete(bar, b.x, nloc, nx); b.st[0] = nloc; b.st[1] = nx; }
        const unsigned old = xb_add(&bar[XB_XSUB(b.x)], 1u);
        const unsigned gen = old / nloc;
        if (old + 1u == (gen + 1u) * nloc) {
            __builtin_amdgcn_fence(__ATOMIC_RELEASE, "agent");
            asm volatile("s_waitcnt vmcnt(0)" ::: "memory");
            const unsigned og = xb_add(&bar[XB_TOP], 1u);
            const unsigned tg = og / nx;
            if (og + 1u == (tg + 1u) * nx) xb_add(&bar[XB_TOPGEN], 1u);
            else XB_SPIN(xb_ld(&bar[XB_TOPGEN]) == tg, bar);
            __builtin_amdgcn_fence(__ATOMIC_ACQUIRE, "agent");
            xb_add(&bar[XB_XGEN(b.x)], 1u);
            asm volatile("s_waitcnt vmcnt(0)" ::: "memory");
        } else {
            XB_SPIN(xb_ld(&bar[XB_XGEN(b.x)]) == gen, bar);
            __builtin_amdgcn_fence(__ATOMIC_ACQUIRE, "agent");
            asm volatile("s_waitcnt vmcnt(0)" ::: "memory");
        }
    }
    __syncthreads();
}

constexpr int NWAVES = 8;
constexpr int RING_BYTES = 131072, LDSCTL_OFF = RING_BYTES, MISC_OFF = LDSCTL_OFF + 320, LDS_BYTES = 147456;
constexpr int CW_BAR = 4096;

struct Args { const void* in[20]; float* out; unsigned char* ws; int ph_lo, ph_hi; };

__device__ __forceinline__ int win_srccol(int n) {
    if (n < 2048) return 2224 + n;
    if (n < 2560) return 1712 + (n - 2048);
    if (n < 2816) return 672 + (n - 2560);
    if (n < 3328) return 1184 + (n - 2816);
    if (n < 3584) return 928 + (n - 3328);
    if (n < 3968) return 0 + (n - 3584);
    if (n < 4224) return 384 + (n - 3968);
    if (n < 4256) return 640 + (n - 4224);
    if (n < 4272) return 1696 + (n - 4256);
    return -1;
}
__device__ __forceinline__ void transpose_item(const float* __restrict__ W, int K, int Nsrc, bf16_t* __restrict__ WT, int Nout, const float* __restrict__ kscale, bool winperm, float* scr, int item, int lane) {
    const int nblk = Nout / 32, kb = item / nblk, nb = item % nblk, k0 = 64 * kb, n0 = 32 * nb;
    const int n = n0 + (lane & 31); const int sc = winperm ? win_srccol(n) : n;
#pragma unroll 8
    for (int i = 0; i < 32; ++i) { const int kk = 2 * i + (lane >> 5); float v = 0.f; if (sc >= 0) { v = W[(size_t)(k0 + kk) * Nsrc + sc]; if (kscale) v *= kscale[k0 + kk]; } scr[kk * 33 + (lane & 31)] = v; }
    asm volatile("s_waitcnt lgkmcnt(0)" ::: "memory");
    const int c = lane & 7;
#pragma unroll
    for (int j = 0; j < 4; ++j) { const int nn = (lane >> 3) + 8 * j; const float* s = scr + (8 * c) * 33 + nn;
        u32x4 o; o.x = pk2(s[0 * 33], s[1 * 33]); o.y = pk2(s[2 * 33], s[3 * 33]); o.z = pk2(s[4 * 33], s[5 * 33]); o.w = pk2(s[6 * 33], s[7 * 33]);
        *(u32x4*)(WT + (size_t)(n0 + nn) * K + k0 + 8 * c) = o; }
    asm volatile("s_waitcnt lgkmcnt(0)" ::: "memory");
}

#define TOPK_INSERT(tv, ti, vv, ii) do { float v_ = (vv); int i_ = (ii); \
    _Pragma("unroll") for (int q_ = 0; q_ < 16; ++q_) { const bool gt_ = (v_ > tv[q_]) || (v_ == tv[q_] && i_ < ti[q_]); const float tv_ = tv[q_]; const int ti_ = ti[q_]; \
        tv[q_] = gt_ ? v_ : tv_; ti[q_] = gt_ ? i_ : ti_; v_ = gt_ ? tv_ : v_; i_ = gt_ ? ti_ : i_; } } while (0)

__global__ void __launch_bounds__(NWAVES * 64, 2) fwd(Args args) {
    extern __shared__ __attribute__((aligned(16))) unsigned char lds[];
    const int tid = threadIdx.x, lane = tid & 63, wave = __builtin_amdgcn_readfirstlane(tid >> 6);
    const int G = gridDim.x; int vcu; { const int bx = blockIdx.x; vcu = (G % 8 == 0) ? (bx % 8) * (G / 8) + bx / 8 : bx; }
    const int gw = vcu * NWAVES + wave, NGW = G * NWAVES, gtid = vcu * 512 + tid, NT = G * 512;
    unsigned char* ws = args.ws;
    const float* x = (const float*)args.in[0]; const int* positions = (const int*)args.in[1];
    const float* g_mix = (const float*)args.in[2]; const float* w_in = (const float*)args.in[3]; const float* g_q_lat = (const float*)args.in[4]; const float* w_qb = (const float*)args.in[5];
    const float* g_kv_lat = (const float*)args.in[6]; const float* w_kvb = (const float*)args.in[7]; const float* w_a2 = (const float*)args.in[8]; const float* b_a2 = (const float*)args.in[9];
    const float* g_gla = (const float*)args.in[10]; const float* w_branch_a = (const float*)args.in[11]; const float* w_branch_b = (const float*)args.in[12]; const float* w_out = (const float*)args.in[13];
    const float* g_ffn = (const float*)args.in[14]; const float* w_peer_q = (const float*)args.in[15]; const float* sub_keys = (const float*)args.in[16]; const float* peer_u = (const float*)args.in[17];
    const float* peer_v = (const float*)args.in[18]; const float* g_final = (const float*)args.in[19];
    float* out = args.out;
    float* SSQ = (float*)(ws + WS_SSQ); float* SSKV = (float*)(ws + WS_SSKV); float* SSX1 = (float*)(ws + WS_SSX1); float* COS = (float*)(ws + WS_COS); float* SIN = (float*)(ws + WS_SIN);
    float* DECAY = (float*)(ws + WS_DECAY);
    bf16_t* WIN = (bf16_t*)(ws + WS_WIN); bf16_t* WQB = (bf16_t*)(ws + WS_WQB); bf16_t* WKVB = (bf16_t*)(ws + WS_WKVB); bf16_t* WA = (bf16_t*)(ws + WS_WA); bf16_t* WB = (bf16_t*)(ws + WS_WB);
    bf16_t* WOUT = (bf16_t*)(ws + WS_WOUT); bf16_t* WPQ = (bf16_t*)(ws + WS_WPQ); bf16_t* KEYS = (bf16_t*)(ws + WS_KEYS);
    bf16_t* PROJB = (bf16_t*)(ws + WS_PROJB); bf16_t* PROJA = (bf16_t*)(ws + WS_PROJA); bf16_t* XN = (bf16_t*)(ws + WS_XN);
    bf16_t* Q = (bf16_t*)(ws + WS_Q); bf16_t* K = (bf16_t*)(ws + WS_K); bf16_t* V = (bf16_t*)(ws + WS_V); float* DST = (float*)(ws + WS_DST);
    bf16_t* YA = (bf16_t*)(ws + WS_YA); bf16_t* YB = (bf16_t*)(ws + WS_YB); bf16_t* MERGED = (bf16_t*)(ws + WS_MERGED); bf16_t* X1B = (bf16_t*)(ws + WS_X1B); bf16_t* QP = (bf16_t*)(ws + WS_QP);
    int* EIDX = (int*)(ws + WS_EIDX); float* EGATE = (float*)(ws + WS_EGATE);

    for (int u = tid; u < (LDS_BYTES - LDSCTL_OFF) / 4; u += NWAVES * 64) ((unsigned*)(lds + LDSCTL_OFF))[u] = 0u;
    __syncthreads();
    XcdBarrier bar; bar.bar = (unsigned*)(ws + WS_CTL) + CW_BAR; bar.x = 0; bar.st = nullptr;
    if (MK_N_LAUNCHES == 1) bar = xcd_barrier_post((unsigned*)(ws + WS_CTL) + CW_BAR, (volatile LAS unsigned*)(lds + MISC_OFF) + 8);
    const int lo = args.ph_lo, hi = args.ph_hi;
#define IN(k) (lo <= (k) && (k) < hi)
#define SEAM(k) do { if (MK_N_LAUNCHES == 1) { if (IN(k) && IN((k) + 1)) xcd_barrier(bar); } } while (0)
    PG8_LAS unsigned char* ring = (PG8_LAS unsigned char*)lds;

    if (IN(0)) {
        for (int i = gtid; i < 3 * M_; i += NT) SSQ[i] = 0.f;
        float* scr = (float*)(lds + wave * 16384);
        constexpr int I_WIN = 16 * (NPROJ / 32), I_QB = 6 * 24, I_KVB = 4 * 32, I_A = 8 * 32, I_OUT = 16 * 32, I_PQ = 16 * 64;
        constexpr int NITEMS = I_WIN + I_QB + I_KVB + 2 * I_A + I_OUT + I_PQ;
        for (int it = gw; it < NITEMS; it += NGW) {
            int r = it;
            if (r < I_WIN) { transpose_item(w_in, 1024, 4272, WIN, NPROJ, nullptr, true, scr, r, lane); continue; } r -= I_WIN;
            if (r < I_QB) { transpose_item(w_qb, 384, 768, WQB, 768, g_q_lat, false, scr, r, lane); continue; } r -= I_QB;
            if (r < I_KVB) { transpose_item(w_kvb, 256, 1024, WKVB, 1024, g_kv_lat, false, scr, r, lane); continue; } r -= I_KVB;
            if (r < I_A) { transpose_item(w_branch_a, 512, 1024, WA, 1024, nullptr, false, scr, r, lane); continue; } r -= I_A;
            if (r < I_A) { transpose_item(w_branch_b, 512, 1024, WB, 1024, nullptr, false, scr, r, lane); continue; } r -= I_A;
            if (r < I_OUT) { transpose_item(w_out, 1024, 1024, WOUT, 1024, nullptr, false, scr, r, lane); continue; } r -= I_OUT;
            transpose_item(w_peer_q, 1024, 2048, WPQ, 2048, g_ffn, false, scr, r, lane);
        }
        for (int i = gtid; i < 16 * 128 * 128; i += NT) KEYS[i] = f2bf(sub_keys[i]);
        for (int i = gtid; i < M_ * 16; i += NT) { const int m = i >> 4, f = i & 15;
            const double inv = pow(10000.0, -(double)f / 16.0); const double ang = (double)positions[m] * inv;
            COS[i] = (float)cos(ang); SIN[i] = (float)sin(ang); }
        for (int row = gw; row < M_; row += NGW) {
            const f32x4* xr = (const f32x4*)(x + (size_t)row * DM); f32x4 v[4]; float ss = 0.f;
#pragma unroll
            for (int j = 0; j < 4; ++j) { v[j] = xr[lane + 64 * j]; ss += (v[j][0] * v[j][0] + v[j][1] * v[j][1]) + (v[j][2] * v[j][2] + v[j][3] * v[j][3]); }
            ss = wave_sum(ss); const float r = rsqrtf(ss * (1.f / DM) + EPS);
#pragma unroll
            for (int j = 0; j < 4; ++j) { const int c = 4 * (lane + 64 * j); const f32x4 gg = *(const f32x4*)(g_mix + c);
                u32x2 w; w.x = pk2(v[j][0] * r * gg[0], v[j][1] * r * gg[1]); w.y = pk2(v[j][2] * r * gg[2], v[j][3] * r * gg[3]);
                *(u32x2*)(XN + (size_t)row * DM + c) = w; }
        }
    }
    SEAM(0);
    if (IN(1)) {
        pg8::Gemm g{XN, WIN, nullptr, nullptr, DM, DM, M_, NPROJ, DM, 1}; pg8::StaticOrder S; S.init(g, G, (int)blockIdx.x);
        pg8::EpiProj E{PROJB, PROJA, SSQ, SSKV};
        pg8::gemm_phase<pg8::EpiProj, pg8::StaticOrder, true>(ring, g, S, E);
    }
    SEAM(1);
    if (IN(2)) {
        { pg8::Gemm g{PROJA + PA_QLAT, WQB, nullptr, nullptr, PA_LD, 384, M_, 768, 384, 1}; pg8::StaticOrder S; S.init(g, G, (int)blockIdx.x);
          pg8::EpiQ E{Q, SSQ, COS, SIN}; pg8::gemm_phase<pg8::EpiQ, pg8::StaticOrder, true>(ring, g, S, E); }
        { pg8::Gemm g{PROJA + PA_KVLAT, WKVB, nullptr, nullptr, PA_LD, 256, M_, 1024, 256, 1}; pg8::StaticOrder S; S.init(g, G, (int)blockIdx.x);
          pg8::EpiKV E{K, V, SSKV}; pg8::gemm_phase<pg8::EpiKV, pg8::StaticOrder, true>(ring, g, S, E); }
        for (int i = gtid; i < M_ * 32; i += NT) { const int m = i >> 5, j = i & 31; const bf16_t* kr = PROJA + (size_t)m * PA_LD + PA_KROPE; float o;
            if (j < 16) { const float x1 = bf2f(kr[j]), x2 = bf2f(kr[j + 16]); o = x1 * COS[m * 16 + j] - x2 * SIN[m * 16 + j]; }
            else { const int f = j - 16; const float x2 = bf2f(kr[j]), x1 = bf2f(kr[j - 16]); o = x2 * COS[m * 16 + f] + x1 * SIN[m * 16 + f]; }
            const bf16_t ob = f2bf(o);
#pragma unroll
            for (int h = 0; h < 8; ++h) K[(size_t)m * 768 + h * 96 + 64 + j] = ob; }
        __syncthreads();
        {
            const int half = tid >> 8, t256 = tid & 255;
            float* lb = (float*)(lds + half * 65536);
            float (*cum)[64] = (float (*)[64])lb; float (*kd)[64] = (float (*)[64])(lb + 4096); float (*gvs)[128] = (float (*)[128])(lb + 8192);
            for (int vb0 = vcu * 2; vb0 < 2 * NCH * 4; vb0 += 2 * G) {
                const int vb = vb0 + half; const int h = vb & 3, bc = vb >> 2, t0 = bc * 64;
                { const int k = t256 & 63; float w[16];
#pragma unroll
                  for (int r = 0; r < 16; ++r) w[r] = w_a2[r * 256 + h * 64 + k];
                  const float bias = b_a2[h * 64 + k];
#pragma unroll 1
                  for (int l = t256 >> 6; l < 64; l += 4) { const bf16_t* gl = PROJA + (size_t)(t0 + l) * PA_LD + PA_GLR; float z = bias;
#pragma unroll
                      for (int r = 0; r < 16; ++r) z += bf2f(gl[r]) * w[r];
                      const float ls = fminf(z, 0.f) - log1pf(expf(-fabsf(z))); cum[l][k] = ls * (1.f / 16.f); } }
                __syncthreads();
                if (t256 < 64) { float s = 0.f; for (int l = 0; l < 64; ++l) { s += cum[l][t256]; cum[l][t256] = s; } }
                __syncthreads();
#pragma unroll 2
                for (int i = t256; i < 64 * 64; i += 256) { const int l = i >> 6, k = i & 63; kd[l][k] = bf2f(PROJA[(size_t)(t0 + l) * PA_LD + PA_GK + h * 64 + k]) * expf(cum[63][k] - cum[l][k]); }
#pragma unroll 4
                for (int i = t256; i < 64 * 128; i += 256) { const int l = i >> 7, v = i & 127; gvs[l][v] = bf2f(PROJA[(size_t)(t0 + l) * PA_LD + PA_GV + h * 128 + v]); }
                if (t256 < 64) DECAY[((size_t)bc * 4 + h) * 64 + t256] = expf(cum[63][t256]);
                __syncthreads();
                { const int v = t256 & 127, kb = (t256 >> 7) * 32;
                  for (int kk = 0; kk < 32; ++kk) { const int k = kb + kk; float s = 0.f;
                      for (int l = 0; l < 64; ++l) s += kd[l][k] * gvs[l][v];
                      DST[(((size_t)bc * 4 + h) * 64 + k) * 128 + v] = s; } }
                __syncthreads();
            }
        }
    }
    SEAM(2);
    if (IN(3)) {
        for (int i = gtid; i < 65536; i += NT) { const int v = i & 127, k = (i >> 7) & 63, h = (i >> 13) & 3, b = i >> 15; float s = 0.f;
            for (int c = 0; c < NCH; ++c) { const size_t bc = (size_t)b * NCH + c; const size_t idx = ((bc * 4 + h) * 64 + k) * 128 + v;
                s = DECAY[(bc * 4 + h) * 64 + k] * s + DST[idx]; DST[idx] = s; } }
        for (int u = gw; u < 2 * NCH * 8; u += NGW) {
            const int h = u & 7, bcx = (u >> 3); const int bc = (bcx + 32 * h) & 255; const int b = bc >> 7, c = bc & 127;
            const int m = bc * 64 + lane;
            float q[96], acc[64];
#pragma unroll
            for (int d = 0; d < 96; ++d) q[d] = bf2f(Q[(size_t)m * 768 + h * 96 + d]);
#pragma unroll
            for (int d = 0; d < 64; ++d) acc[d] = 0.f;
            float mx = -1e30f, l = 0.f; const int nk = (c + 1) * 64;
            const bf16_t* Kb = K + (size_t)b * SEQ * 768 + h * 96; const bf16_t* Vb = V + (size_t)b * SEQ * 512 + h * 64;
            for (int j = 0; j < nk; ++j) { const bf16_t* kr = Kb + (size_t)j * 768; float s = 0.f;
#pragma unroll
                for (int d = 0; d < 96; ++d) s += q[d] * bf2f(kr[d]);
                if (s > mx) { const float f = exp2f(mx - s); l *= f;
#pragma unroll
                    for (int d = 0; d < 64; ++d) acc[d] *= f;
                    mx = s; }
                const float p = exp2f(s - mx); l += p; const bf16_t* vr = Vb + (size_t)j * 512;
#pragma unroll
                for (int d = 0; d < 64; ++d) acc[d] += p * bf2f(vr[d]); }
            const float il = 1.f / l;
#pragma unroll
            for (int d = 0; d < 64; ++d) YA[(size_t)m * 512 + h * 64 + d] = f2bf(acc[d] * il);
        }
    }
    SEAM(3);
    if (IN(4)) {
        const int half = tid >> 8, t256 = tid & 255;
        float* lb = (float*)(lds + half * 65536);
        float (*ss)[128] = (float (*)[128])lb; float (*qs)[65] = (float (*)[65])(lb + 8192);
        for (int vb0 = vcu * 2; vb0 < 2 * NCH * 4; vb0 += 2 * G) {
            const int vb = vb0 + half; const int h = vb & 3, bc = vb >> 2, t0 = bc * 64;
            const float* sp = DST + ((size_t)bc * 4 + h) * 64 * 128;
            for (int i = t256; i < 64 * 128; i += 256) ss[i >> 7][i & 127] = sp[i];
            for (int i = t256; i < 64 * 64; i += 256) { const int l = i >> 6, k = i & 63; qs[l][k] = bf2f(PROJB[(size_t)(t0 + l) * PB_LD + PB_GQ + h * 64 + k]) * 0.125f; }
            __syncthreads();
            { const int l = t256 >> 2, vg = t256 & 3; float o[32];
#pragma unroll
              for (int j = 0; j < 32; ++j) o[j] = 0.f;
              for (int k = 0; k < 64; ++k) { const float qv = qs[l][k];
#pragma unroll
                  for (int j = 0; j < 32; ++j) o[j] += qv * ss[k][vg * 32 + j]; }
              float s2 = 0.f;
#pragma unroll
              for (int j = 0; j < 32; ++j) s2 += o[j] * o[j];
              s2 += __shfl_xor(s2, 1); s2 += __shfl_xor(s2, 2);
              const float r = rsqrtf(s2 * (1.f / 128.f) + EPS);
#pragma unroll
              for (int j = 0; j < 32; ++j) { const int v = vg * 32 + j; const float go = bf2f(PROJB[(size_t)(t0 + l) * PB_LD + PB_GOUT + h * 128 + v]); const float silu = go / (1.f + __expf(-go));
                  YB[(size_t)(t0 + l) * 512 + h * 128 + v] = f2bf(o[j] * r * g_gla[h * 128 + v] * silu); } }
            __syncthreads();
        }
    }
    SEAM(4);
    if (IN(5)) {
        pg8::Gemm g{YA, WA, YB, WB, 512, 512, M_, 1024, 512, 2}; pg8::StaticOrder S; S.init(g, G, (int)blockIdx.x);
        pg8::EpiMerge E{PROJB, MERGED}; pg8::gemm_phase<pg8::EpiMerge, pg8::StaticOrder, false>(ring, g, S, E);
    }
    SEAM(5);
    if (IN(6)) {
        pg8::Gemm g{MERGED, WOUT, nullptr, nullptr, DM, DM, M_, 1024, DM, 1}; pg8::StaticOrder S; S.init(g, G, (int)blockIdx.x);
        pg8::EpiX1 E{x, out, X1B, SSX1}; pg8::gemm_phase<pg8::EpiX1, pg8::StaticOrder, false>(ring, g, S, E);
    }
    SEAM(6);
    if (IN(7)) {
        pg8::Gemm g{X1B, WPQ, nullptr, nullptr, DM, DM, M_, 2048, DM, 1}; pg8::StaticOrder S; S.init(g, G, (int)blockIdx.x);
        pg8::EpiQP E{QP, SSX1}; pg8::gemm_phase<pg8::EpiQP, pg8::StaticOrder, true>(ring, g, S, E);
    }
    SEAM(7);
    if (IN(8)) {
        for (int W = gw; W < 2048; W += NGW) {
            const int h = W & 7, m = (W >> 3) * 64 + lane;
            float tv[2][16]; int ti[2][16];
#pragma unroll
            for (int p = 0; p < 2; ++p) {
#pragma unroll
                for (int i = 0; i < 16; ++i) { tv[p][i] = -INFINITY; ti[p][i] = 0x7fffffff; }
                unsigned qpk[64];
                const u32x4* qr = (const u32x4*)(QP + (size_t)m * 2048 + (h * 2 + p) * 128);
#pragma unroll
                for (int i = 0; i < 16; ++i) { const u32x4 t = qr[i]; qpk[4 * i] = t.x; qpk[4 * i + 1] = t.y; qpk[4 * i + 2] = t.z; qpk[4 * i + 3] = t.w; }
                const unsigned* kb = (const unsigned*)(KEYS + (size_t)(h * 2 + p) * 128 * 128);
                for (int n = 0; n < 128; ++n) { const unsigned* kr = kb + n * 64; float s = 0.f;
#pragma unroll
                    for (int d = 0; d < 64; ++d) { const unsigned kk = kr[d]; s += __uint_as_float(qpk[d] << 16) * __uint_as_float(kk << 16); s += __uint_as_float(qpk[d] & 0xffff0000u) * __uint_as_float(kk & 0xffff0000u); }
                    TOPK_INSERT(tv[p], ti[p], s, n); }
            }
            float bv[16]; int bi[16];
#pragma unroll
            for (int i = 0; i < 16; ++i) { bv[i] = -INFINITY; bi[i] = 0x7fffffff; }
#define CAND_(a, b) TOPK_INSERT(bv, bi, tv[0][a] + tv[1][b], (ti[0][a] * 128 + ti[1][b]) | (((a) * 16 + (b)) << 16))
#pragma unroll
            for (int b = 0; b < 16; ++b) CAND_(0, b);
#pragma unroll
            for (int b = 0; b < 8; ++b) CAND_(1, b);
#pragma unroll
            for (int b = 0; b < 5; ++b) CAND_(2, b);
#pragma unroll
            for (int b = 0; b < 4; ++b) CAND_(3, b);
#pragma unroll
            for (int b = 0; b < 3; ++b) CAND_(4, b);
#pragma unroll
            for (int b = 0; b < 2; ++b) CAND_(5, b);
#pragma unroll
            for (int b = 0; b < 2; ++b) CAND_(6, b);
#pragma unroll
            for (int b = 0; b < 2; ++b) CAND_(7, b);
#pragma unroll
            for (int b = 0; b < 1; ++b) CAND_(8, b);
#pragma unroll
            for (int b = 0; b < 1; ++b) CAND_(9, b);
#pragma unroll
            for (int b = 0; b < 1; ++b) CAND_(10, b);
#pragma unroll
            for (int b = 0; b < 1; ++b) CAND_(11, b);
#pragma unroll
            for (int b = 0; b < 1; ++b) CAND_(12, b);
#pragma unroll
            for (int b = 0; b < 1; ++b) CAND_(13, b);
#pragma unroll
            for (int b = 0; b < 1; ++b) CAND_(14, b);
#pragma unroll
            for (int b = 0; b < 1; ++b) CAND_(15, b);
#undef CAND_
            float e[16], sum = 0.f;
#pragma unroll
            for (int k = 0; k < 16; ++k) { e[k] = __expf(bv[k] - bv[0]); sum += e[k]; }
            const float inv = 1.f / sum;
#pragma unroll
            for (int k = 0; k < 16; ++k) { EIDX[(size_t)m * 128 + h * 16 + k] = bi[k] & 0xffff; EGATE[(size_t)m * 128 + h * 16 + k] = e[k] * inv; }
        }
    }
    SEAM(8);
    if (IN(9)) {
        for (int m = gw; m < M_; m += NGW) {
            float xg[16], y[16];
#pragma unroll
            for (int j = 0; j < 4; ++j) { const int c = 4 * (lane + 64 * j); const f32x4 gg = *(const f32x4*)(g_ffn + c); const u32x2 xb = *(const u32x2*)(X1B + (size_t)m * DM + c);
                xg[4 * j] = __uint_as_float(xb.x << 16) * gg[0]; xg[4 * j + 1] = __uint_as_float(xb.x & 0xffff0000u) * gg[1]; xg[4 * j + 2] = __uint_as_float(xb.y << 16) * gg[2]; xg[4 * j + 3] = __uint_as_float(xb.y & 0xffff0000u) * gg[3]; }
#pragma unroll
            for (int j = 0; j < 16; ++j) y[j] = 0.f;
            const float r = rsqrtf(SSX1[m] * (1.f / DM) + EPS);
            for (int k = 0; k < 128; ++k) {
                const int e = EIDX[(size_t)m * 128 + k]; const float gate = EGATE[(size_t)m * 128 + k];
                const f32x4* ur = (const f32x4*)(peer_u + (size_t)e * DM); float d = 0.f;
#pragma unroll
                for (int j = 0; j < 4; ++j) { const f32x4 u = ur[lane + 64 * j]; d += (xg[4 * j] * u[0] + xg[4 * j + 1] * u[1]) + (xg[4 * j + 2] * u[2] + xg[4 * j + 3] * u[3]); }
                d = wave_sum(d) * r;
                const float a = 0.5f * d * (1.f + erff(d * 0.70710678118654752f)) * gate;
                const f32x4* vr = (const f32x4*)(peer_v + (size_t)e * DM);
#pragma unroll
                for (int j = 0; j < 4; ++j) { const f32x4 v = vr[lane + 64 * j]; y[4 * j] += a * v[0]; y[4 * j + 1] += a * v[1]; y[4 * j + 2] += a * v[2]; y[4 * j + 3] += a * v[3]; }
            }
            const f32x4* xr = (const f32x4*)(out + (size_t)m * DM); float ss = 0.f;
#pragma unroll
            for (int j = 0; j < 4; ++j) { const f32x4 v = xr[lane + 64 * j]; y[4 * j] += v[0]; y[4 * j + 1] += v[1]; y[4 * j + 2] += v[2]; y[4 * j + 3] += v[3];
                ss += (y[4 * j] * y[4 * j] + y[4 * j + 1] * y[4 * j + 1]) + (y[4 * j + 2] * y[4 * j + 2] + y[4 * j + 3] * y[4 * j + 3]); }
            ss = wave_sum(ss); const float r2 = rsqrtf(ss * (1.f / DM) + EPS);
#pragma unroll
            for (int j = 0; j < 4; ++j) { const int c = 4 * (lane + 64 * j); const f32x4 gg = *(const f32x4*)(g_final + c);
                f32x4 o; o[0] = y[4 * j] * r2 * gg[0]; o[1] = y[4 * j + 1] * r2 * gg[1]; o[2] = y[4 * j + 2] * r2 * gg[2]; o[3] = y[4 * j + 3] * r2 * gg[3];
                *(f32x4*)(out + (size_t)m * DM + c) = o; }
        }
    }
#undef IN
#undef SEAM
}

extern "C" void kernel_launch(void* const* d_in, const int* in_sizes, int n_in, void* d_out, int out_size, void* d_ws, size_t ws_size, hipStream_t stream) {
    static int grid = 0;
    if (grid == 0) {
        if (n_in != 20 || out_size != M_ * DM || ws_size < WS_END) { fprintf(stderr, "kernel_launch: unexpected shapes (n_in %d out %d ws %zu); nothing launched\n", n_in, out_size, ws_size); grid = -1; return; }
        int dev = 0, cus = 0;
        if (hipGetDevice(&dev) != hipSuccess || hipDeviceGetAttribute(&cus, hipDeviceAttributeMultiprocessorCount, dev) != hipSuccess) { grid = -1; return; }
        if (hipFuncSetAttribute((const void*)fwd, hipFuncAttributeMaxDynamicSharedMemorySize, LDS_BYTES) != hipSuccess) { fprintf(stderr, "kernel_launch: hipFuncSetAttribute failed\n"); grid = -1; return; }
        int per_cu = 0;
        if (hipOccupancyMaxActiveBlocksPerMultiprocessor(&per_cu, (const void*)fwd, NWAVES * 64, LDS_BYTES) != hipSuccess || per_cu < 1) fprintf(stderr, "kernel_launch: occupancy query reports %d\n", per_cu);
        (void)hipGetLastError();
        grid = cus;
    }
    if (grid < 0) return;
    (void)hipMemsetAsync((char*)d_ws + WS_CTL, 0, CTL_ZERO_BYTES, stream);
    Args a; memset(&a, 0, sizeof(a));
    for (int i = 0; i < 20; ++i) a.in[i] = d_in[i];
    a.out = (float*)d_out; a.ws = (unsigned char*)d_ws;
    if (MK_N_LAUNCHES == 1) { a.ph_lo = 0; a.ph_hi = N_PHASES; hipLaunchKernelGGL(fwd, dim3(grid), dim3(NWAVES * 64), LDS_BYTES, stream, a); }
    else for (int p = 0; p < N_PHASES; ++p) { a.ph_lo = p; a.ph_hi = p + 1; hipLaunchKernelGGL(fwd, dim3(grid), dim3(NWAVES * 64), LDS_BYTES, stream, a); }
}
```

```cpp
#include <hip/hip_runtime.h>
#include <cstdio>
#include <cstdint>
#include <cstring>
#include <math.h>

#ifndef MK_N_LAUNCHES
#define MK_N_LAUNCHES 1
#endif
constexpr int N_PHASES = 10;

typedef unsigned short bf16_t;
constexpr int SEQ = 8192, DM = 1024, M_ = 16384, NCH = 128;
constexpr float EPS = 1e-6f;
constexpr int PB_LD = 2816, PA_LD = 1536;
constexpr int PB_BR = 0, PB_GOUT = 2048, PB_GQ = 2560;
constexpr int PA_GV = 0, PA_GK = 512, PA_QLAT = 768, PA_KVLAT = 1152, PA_KROPE = 1408, PA_GLR = 1440;
constexpr int NPROJ = 4352;
constexpr float CQ = 0.10206207261596577f * 1.4426950408889634f;

constexpr size_t MiB = 1u << 20;
constexpr size_t WS_CTL = 0, CTL_ZERO_BYTES = 256 * 1024;
constexpr size_t WS_SSQ = 1 * MiB, WS_SSKV = WS_SSQ + 65536, WS_SSX1 = WS_SSKV + 65536, WS_COS = 2 * MiB, WS_SIN = 3 * MiB;
constexpr size_t WS_DECAY = 1 * MiB + 512 * 1024;
constexpr size_t WS_WIN = 4 * MiB, WS_WQB = 13 * MiB, WS_WKVB = 14 * MiB, WS_WA = 15 * MiB, WS_WB = 16 * MiB, WS_WOUT = 17 * MiB, WS_WPQ = 19 * MiB, WS_KEYS = 23 * MiB;
constexpr size_t WS_PROJB = 24 * MiB, WS_PROJA = 112 * MiB, WS_XN = 160 * MiB, WS_Q = 160 * MiB, WS_K = 184 * MiB, WS_V = 208 * MiB, WS_DST = 224 * MiB;
constexpr size_t WS_YA = 112 * MiB, WS_YB = 128 * MiB, WS_MERGED = 160 * MiB, WS_X1B = 24 * MiB, WS_QP = 56 * MiB, WS_EIDX = 120 * MiB, WS_EGATE = 128 * MiB;
constexpr size_t WS_END = 256 * MiB;

#define GAS __attribute__((address_space(1)))
#define LAS __attribute__((address_space(3)))
typedef float f32x4 __attribute__((ext_vector_type(4)));
typedef unsigned u32x4 __attribute__((ext_vector_type(4)));
typedef unsigned u32x2 __attribute__((ext_vector_type(2)));

__device__ __forceinline__ float bf2f(bf16_t h) { return __uint_as_float(((unsigned)h) << 16); }
__device__ __forceinline__ unsigned f2bf_u(float f) { unsigned u = __float_as_uint(f); return (u + 0x7fffu + ((u >> 16) & 1u)) >> 16; }
__device__ __forceinline__ bf16_t f2bf(float f) { return (bf16_t)f2bf_u(f); }
__device__ __forceinline__ unsigned pk2(float lo, float hi) { return f2bf_u(lo) | (f2bf_u(hi) << 16); }
__device__ __forceinline__ float wave_sum(float v) {
#pragma unroll
    for (int o = 1; o < 64; o <<= 1) v += __shfl_xor(v, o);
    return v;
}
__device__ __forceinline__ float sigmoidf_(float x) { return 1.f / (1.f + __expf(-x)); }

namespace pg8 {
#define PG8_LAS __attribute__((address_space(3)))
typedef short bf16x8 __attribute__((ext_vector_type(8)));
constexpr int BM = 256, BK = 64, HALF = 128, HTB = HALF * BK * 2, STAGE_BYTES = 8 * HTB, NXCD = 8, WGM = 8;
__host__ __device__ __forceinline__ int lds_byte(int r, int c) { const int st = (r >> 4) * 2 + (c >> 5), rr = r & 15, cc = c & 31, ob = rr * 64 + cc * 2; return st * 1024 + (ob ^ (((ob >> 9) & 1) << 5)); }
__host__ __device__ __forceinline__ void stage_rc(int b, int& R, int& C) { const int st = b / 1024, sb = b % 1024, swz = sb ^ (((sb >> 9) & 1) << 5); R = (st >> 1) * 16 + swz / 64; C = (st & 1) * 32 + (swz % 64) / 2; }
__host__ __device__ __forceinline__ int perm32(int rho) { const int n = rho >> 4, i = rho & 15; return 8 * (i >> 2) + 4 * n + (i & 3); }

struct Unit { int pm, pn, sub; const char* A; const char* B; };
struct Gemm { const bf16_t* A; const bf16_t* Bt; const bf16_t* A2; const bf16_t* Bt2; int lda, ldb, M, N, K, chain; };
struct StaticOrder {
    int nM, nN, nwg, G, c, chain; const char *A, *B, *A2, *B2; size_t tsA, tsB;
    __device__ __forceinline__ void init(const Gemm& g, int G_, int c_) { nM = g.M / BM; nN = g.N / BM; nwg = nM * nN; G = G_; c = c_; chain = g.chain; A = (const char*)g.A; B = (const char*)g.Bt; A2 = (const char*)g.A2; B2 = (const char*)g.Bt2;
        tsA = (size_t)BM * g.lda * 2; tsB = (size_t)BM * g.ldb * 2; }
    __device__ __forceinline__ bool next(int i, Unit& u) const {
        const int r = (chain == 2) ? (i >> 1) : i, sub = (chain == 2) ? (i & 1) : 0;
        const long L = (long)r * G + c; if (L >= nwg) return false;
        int wgid = (int)L; { const int q = nwg / NXCD, rr = nwg % NXCD, xcd = wgid % NXCD, off = wgid / NXCD; wgid = (xcd < rr ? xcd * (q + 1) : rr * (q + 1) + (xcd - rr) * q) + off; }
        const int nig = WGM * nN, gid = wgid / nig, fm = gid * WGM, gsz = (nM - fm) < WGM ? (nM - fm) : WGM;
        u.pm = fm + ((wgid % nig) % gsz); u.pn = (wgid % nig) / gsz; u.sub = sub;
        u.A = (sub ? A2 : A) + (size_t)u.pm * tsA; u.B = (sub ? B2 : B) + (size_t)u.pn * tsB; return true;
    }
};
__device__ __forceinline__ unsigned cvt_pk_bf16(float lo, float hi) { unsigned r; asm volatile("v_cvt_pk_bf16_f32 %0, %1, %2" : "=v"(r) : "v"(lo), "v"(hi)); return r; }

typedef f32x4 AccT[2][2][4][2];
template <class Epi, class Sched, bool ALIGN_EPI>
__device__ __forceinline__ void gemm_phase(PG8_LAS unsigned char* lds, const Gemm g, const Sched& S, const Epi& E) {
    const int tid = threadIdx.x, wid = __builtin_amdgcn_readfirstlane(tid >> 6), lane = tid & 63, wr = wid >> 2, wc = wid & 3, fr = lane & 15, fq = lane >> 4;
    const int K = g.K, nt = K / BK;
    unsigned voffA[2], voffB[2];
#pragma unroll
    for (int i = 0; i < 2; ++i) { int R, C; stage_rc(tid * 16 + i * 8192, R, C); const int Rb = Epi::PERM ? ((R & ~31) + perm32(R & 31)) : R;
        voffA[i] = (unsigned)(R * g.lda + C) * 2u; voffB[i] = (unsigned)(Rb * g.ldb + C) * 2u; }
    const size_t kstep = (size_t)(BK * 2);
    const size_t hsA = (size_t)HALF * g.lda * 2, hsB = (size_t)HALF * g.ldb * 2;
    const unsigned ldsw = (unsigned)wid * 1024u;
    const int aoff = lds_byte(wr * 64 + fr, fq * 8), boff = lds_byte(wc * 32 + fr, fq * 8);
#define PG8_SA(b, h) (((b) * 2 + (h)) * HTB)
#define PG8_SB(b, h) ((4 + (b) * 2 + (h)) * HTB)
#define PG8_STAGE(bufoff, gbase, voff) do { _Pragma("unroll") for (int _i = 0; _i < 2; ++_i) \
        __builtin_amdgcn_global_load_lds((const unsigned*)((const char*)(gbase) + (voff)[_i]), (PG8_LAS unsigned*)(lds + (bufoff) + ldsw + _i * 8192), 16, 0, 0); } while (0)
#define PG8_LDA(dst, b, h) do { _Pragma("unroll") for (int m = 0; m < 4; ++m) _Pragma("unroll") for (int k = 0; k < 2; ++k) dst[m][k] = *(const PG8_LAS bf16x8*)(lds + PG8_SA(b, h) + aoff + m * 2048 + k * 1024); } while (0)
#define PG8_LDB(dst, b, h) do { _Pragma("unroll") for (int n = 0; n < 2; ++n) _Pragma("unroll") for (int k = 0; k < 2; ++k) dst[n][k] = *(const PG8_LAS bf16x8*)(lds + PG8_SB(b, h) + boff + n * 2048 + k * 1024); } while (0)
#define PG8_MMA(ai, bj, At, Bt) do { __builtin_amdgcn_s_setprio(1); _Pragma("unroll") for (int m = 0; m < 4; ++m) _Pragma("unroll") for (int n = 0; n < 2; ++n) _Pragma("unroll") for (int k = 0; k < 2; ++k) \
        acc[ai][bj][m][n] = __builtin_amdgcn_mfma_f32_16x16x32_bf16(Bt[n][k], At[m][k], acc[ai][bj][m][n], 0, 0, 0); __builtin_amdgcn_s_setprio(0); } while (0)
#define PG8_WAIT_V(n) asm volatile("s_waitcnt vmcnt(" #n ")" ::: "memory")
#define PG8_WAIT_L(n) asm volatile("s_waitcnt lgkmcnt(" #n ")" ::: "memory")
#define PG8_BAR __builtin_amdgcn_s_barrier()
#define PG8_SCHED __builtin_amdgcn_sched_barrier(0)
    Unit cur, nxt; int ui = 0;
    if (!S.next(0, cur)) return;
    f32x4 acc[2][2][4][2];
#pragma unroll
    for (int a = 0; a < 2; ++a)
#pragma unroll
        for (int b = 0; b < 2; ++b)
#pragma unroll
            for (int m = 0; m < 4; ++m)
#pragma unroll
                for (int n = 0; n < 2; ++n) acc[a][b][m][n] = (f32x4){0.f, 0.f, 0.f, 0.f};
    bf16x8 At[4][2], B0[2][2], B1[2][2];
    const char* cA = cur.A; const char* cB = cur.B;
    PG8_STAGE(PG8_SB(0, 0), cB, voffB); PG8_STAGE(PG8_SB(0, 1), cB + hsB, voffB); PG8_STAGE(PG8_SA(0, 0), cA, voffA); PG8_STAGE(PG8_SA(0, 1), cA + hsA, voffA);
    if (wr == 1) PG8_BAR;
    PG8_WAIT_V(2); PG8_BAR;
    PG8_STAGE(PG8_SB(1, 0), cB + kstep, voffB); PG8_STAGE(PG8_SA(1, 0), cA + kstep, voffA); PG8_STAGE(PG8_SB(1, 1), cB + hsB + kstep, voffB);
    PG8_WAIT_V(6); PG8_BAR;
    for (;;) {
        const bool has_next = S.next(ui + 1, nxt);
        const char* nA = has_next ? nxt.A : cA; const char* nB = has_next ? nxt.B : cB;
        for (int t = 0; t < nt; t += 2) {
            const bool last = (t == nt - 2);
            const char* a1 = cA + (size_t)(t + 1) * kstep;
            const char* a2 = last ? nA : cA + (size_t)(t + 2) * kstep; const char* b2 = last ? nB : cB + (size_t)(t + 2) * kstep;
            const char* a3 = a2 + kstep; const char* b3 = b2 + kstep;
            PG8_LDB(B0, 0, 0); PG8_LDB(B1, 0, 1); PG8_SCHED; PG8_LDA(At, 0, 0); PG8_STAGE(PG8_SA(1, 1), a1 + hsA, voffA);
            PG8_WAIT_V(8); PG8_WAIT_L(0); PG8_BAR; PG8_MMA(0, 0, At, B0); PG8_MMA(0, 1, At, B1); PG8_BAR; PG8_SCHED;
            PG8_LDA(At, 0, 1); PG8_STAGE(PG8_SB(0, 0), b2, voffB); PG8_STAGE(PG8_SB(0, 1), b2 + hsB, voffB); PG8_STAGE(PG8_SA(0, 0), a2, voffA);
            PG8_WAIT_V(8); PG8_WAIT_L(0); PG8_BAR; PG8_MMA(1, 0, At, B0); PG8_MMA(1, 1, At, B1); PG8_BAR; PG8_SCHED;
            PG8_LDB(B0, 1, 0); PG8_LDB(B1, 1, 1); PG8_SCHED; PG8_LDA(At, 1, 0); PG8_STAGE(PG8_SA(0, 1), a2 + hsA, voffA);
            PG8_WAIT_V(8); PG8_WAIT_L(0); PG8_BAR; PG8_MMA(0, 0, At, B0); PG8_MMA(0, 1, At, B1); PG8_BAR; PG8_SCHED;
            PG8_LDA(At, 1, 1); PG8_STAGE(PG8_SB(1, 0), b3, voffB); PG8_STAGE(PG8_SB(1, 1), b3 + hsB, voffB); PG8_STAGE(PG8_SA(1, 0), a3, voffA);
            PG8_WAIT_V(8); PG8_WAIT_L(0); PG8_BAR; PG8_MMA(1, 0, At, B0); PG8_MMA(1, 1, At, B1); PG8_BAR; PG8_SCHED;
        }
        if constexpr (ALIGN_EPI) { if (wr == 0) PG8_BAR; }
        E(acc, cur, wr, wc, fr, fq);
        if (!has_next) break;
        if (!(Epi::CHAIN && nxt.sub != 0)) {
#pragma unroll
            for (int a = 0; a < 2; ++a)
#pragma unroll
                for (int b = 0; b < 2; ++b)
#pragma unroll
                    for (int m = 0; m < 4; ++m)
#pragma unroll
                        for (int n = 0; n < 2; ++n) acc[a][b][m][n] = (f32x4){0.f, 0.f, 0.f, 0.f};
        }
        cur = nxt; cA = nA; cB = nB; ++ui;
        if constexpr (ALIGN_EPI) { if (wr == 1) PG8_BAR; }
    }
    PG8_WAIT_V(0);
    if constexpr (!ALIGN_EPI) { if (wr == 0) PG8_BAR; }
    PG8_BAR;
#undef PG8_SA
#undef PG8_SB
#undef PG8_STAGE
#undef PG8_LDA
#undef PG8_LDB
#undef PG8_MMA
#undef PG8_WAIT_V
#undef PG8_WAIT_L
#undef PG8_BAR
#undef PG8_SCHED
}

struct EpiProj {
    static constexpr bool PERM = true, CHAIN = false;
    bf16_t* pb; bf16_t* pa; float* ssq; float* sskv;
    __device__ __forceinline__ void operator()(AccT& acc, const Unit& u, int wr, int wc, int fr, int fq) const {
        const int row0 = u.pm * BM + wr * 64 + fr;
#pragma unroll
        for (int bj = 0; bj < 2; ++bj) {
            const int hk = u.pn * 2 + bj;
            bf16_t* base; int ld; float* ss = nullptr;
            if (hk < 22) { base = pb + hk * 128; ld = PB_LD; } else { const int ha = hk - 22; base = pa + ha * 128; ld = PA_LD; if (ha >= 6 && ha <= 8) ss = ssq; else if (ha == 9 || ha == 10) ss = sskv; }
            base += wc * 32 + 8 * fq;
#pragma unroll
            for (int ai = 0; ai < 2; ++ai)
#pragma unroll
                for (int m = 0; m < 4; ++m) { const int row = row0 + ai * HALF + m * 16; const f32x4 v0 = acc[ai][bj][m][0], v1 = acc[ai][bj][m][1];
                    u32x4 w; w.x = cvt_pk_bf16(v0[0], v0[1]); w.y = cvt_pk_bf16(v0[2], v0[3]); w.z = cvt_pk_bf16(v1[0], v1[1]); w.w = cvt_pk_bf16(v1[2], v1[3]);
                    *(u32x4*)(base + (size_t)row * ld) = w;
                    if (ss) { float s = (v0[0] * v0[0] + v0[1] * v0[1]) + (v0[2] * v0[2] + v0[3] * v0[3]) + (v1[0] * v1[0] + v1[1] * v1[1]) + (v1[2] * v1[2] + v1[3] * v1[3]);
                        s += __shfl_xor(s, 16); s += __shfl_xor(s, 32); if (fq == 0) atomicAdd(ss + row, s); } }
        }
    }
};
struct EpiQ {
    static constexpr bool PERM = false, CHAIN = false;
    bf16_t* Q; const float* ssq; const float* cs; const float* sn;
    __device__ __forceinline__ void operator()(AccT& acc, const Unit& u, int wr, int wc, int fr, int fq) const {
        const int row0 = u.pm * BM + wr * 64 + fr;
#pragma unroll
        for (int ai = 0; ai < 2; ++ai)
#pragma unroll
            for (int m = 0; m < 4; ++m) { const int row = row0 + ai * HALF + m * 16; const float rr = rsqrtf(ssq[row] * (1.f / 384.f) + EPS) * CQ;
#pragma unroll
                for (int bj = 0; bj < 2; ++bj) { const int G = u.pn * 8 + bj * 4 + wc;
                    f32x4 x0 = acc[ai][bj][m][0], x1 = acc[ai][bj][m][1];
                    if (G % 3 == 2) { const f32x4 c = *(const f32x4*)(cs + (size_t)row * 16 + 4 * fq), s = *(const f32x4*)(sn + (size_t)row * 16 + 4 * fq);
                        const f32x4 o0 = x0 * c - x1 * s, o1 = x1 * c + x0 * s; x0 = o0; x1 = o1; }
                    x0 = x0 * rr; x1 = x1 * rr;
                    bf16_t* p = Q + (size_t)row * 768 + G * 32 + 4 * fq;
                    u32x2 w0, w1; w0.x = cvt_pk_bf16(x0[0], x0[1]); w0.y = cvt_pk_bf16(x0[2], x0[3]); w1.x = cvt_pk_bf16(x1[0], x1[1]); w1.y = cvt_pk_bf16(x1[2], x1[3]);
                    *(u32x2*)p = w0; *(u32x2*)(p + 16) = w1; } }
    }
};
struct EpiKV {
    static constexpr bool PERM = true, CHAIN = false;
    bf16_t* Kb; bf16_t* Vb; const float* sskv;
    __device__ __forceinline__ void operator()(AccT& acc, const Unit& u, int wr, int wc, int fr, int fq) const {
        const int row0 = u.pm * BM + wr * 64 + fr;
#pragma unroll
        for (int ai = 0; ai < 2; ++ai)
#pragma unroll
            for (int m = 0; m < 4; ++m) { const int row = row0 + ai * HALF + m * 16; const float rr = rsqrtf(sskv[row] * (1.f / 256.f) + EPS);
#pragma unroll
                for (int bj = 0; bj < 2; ++bj) { const int head = u.pn * 2 + bj; const f32x4 v0 = acc[ai][bj][m][0] * rr, v1 = acc[ai][bj][m][1] * rr;
                    u32x4 w; w.x = cvt_pk_bf16(v0[0], v0[1]); w.y = cvt_pk_bf16(v0[2], v0[3]); w.z = cvt_pk_bf16(v1[0], v1[1]); w.w = cvt_pk_bf16(v1[2], v1[3]);
                    bf16_t* p = (wc < 2) ? Kb + (size_t)row * 768 + head * 96 + wc * 32 + 8 * fq : Vb + (size_t)row * 512 + head * 64 + (wc - 2) * 32 + 8 * fq;
                    *(u32x4*)p = w; } }
    }
};
struct EpiMerge {
    static constexpr bool PERM = true, CHAIN = true;
    const bf16_t* pb; bf16_t* merged;
    __device__ __forceinline__ void operator()(AccT& acc, const Unit& u, int wr, int wc, int fr, int fq) const {
        const int row0 = u.pm * BM + wr * 64 + fr, col0 = u.pn * BM + wc * 32 + 8 * fq;
#pragma unroll
        for (int ai = 0; ai < 2; ++ai)
#pragma unroll
            for (int m = 0; m < 4; ++m) { const int row = row0 + ai * HALF + m * 16;
#pragma unroll
                for (int bj = 0; bj < 2; ++bj) { const int col = col0 + bj * HALF;
                    const u32x4 gb = *(const u32x4*)(pb + (size_t)row * PB_LD + PB_BR + 1024 + col);
                    float sb[8];
#pragma unroll
                    for (int e = 0; e < 4; ++e) { sb[2 * e] = sigmoidf_(__uint_as_float(gb[e] << 16)); sb[2 * e + 1] = sigmoidf_(__uint_as_float(gb[e] & 0xffff0000u)); }
                    if (u.sub == 0) {
                        const u32x4 ga = *(const u32x4*)(pb + (size_t)row * PB_LD + PB_BR + col);
                        float sa[8];
#pragma unroll
                        for (int e = 0; e < 4; ++e) { sa[2 * e] = sigmoidf_(__uint_as_float(ga[e] << 16)); sa[2 * e + 1] = sigmoidf_(__uint_as_float(ga[e] & 0xffff0000u)); }
#pragma unroll
                        for (int e = 0; e < 4; ++e) { acc[ai][bj][m][0][e] *= sa[e] / sb[e]; acc[ai][bj][m][1][e] *= sa[4 + e] / sb[4 + e]; }
                    } else {
                        const f32x4 v0 = acc[ai][bj][m][0], v1 = acc[ai][bj][m][1];
                        u32x4 w; w.x = cvt_pk_bf16(v0[0] * sb[0], v0[1] * sb[1]); w.y = cvt_pk_bf16(v0[2] * sb[2], v0[3] * sb[3]); w.z = cvt_pk_bf16(v1[0] * sb[4], v1[1] * sb[5]); w.w = cvt_pk_bf16(v1[2] * sb[6], v1[3] * sb[7]);
                        *(u32x4*)(merged + (size_t)row * DM + col) = w; } } }
    }
};
struct EpiX1 {
    static constexpr bool PERM = false, CHAIN = false;
    const float* x; float* x1; bf16_t* x1b; float* ssx1;
    __device__ __forceinline__ void operator()(AccT& acc, const Unit& u, int wr, int wc, int fr, int fq) const {
        const int row0 = u.pm * BM + wr * 64 + fr, col0 = u.pn * BM + wc * 32 + 4 * fq;
#pragma unroll
        for (int ai = 0; ai < 2; ++ai)
#pragma unroll
            for (int m = 0; m < 4; ++m) { const int row = row0 + ai * HALF + m * 16; const size_t off = (size_t)row * DM + col0; float s = 0.f;
#pragma unroll
                for (int bj = 0; bj < 2; ++bj)
#pragma unroll
                    for (int n = 0; n < 2; ++n) { const size_t o = off + bj * HALF + n * 16; const f32x4 v = *(const f32x4*)(x + o) + acc[ai][bj][m][n];
                        *(f32x4*)(x1 + o) = v; u32x2 w; w.x = cvt_pk_bf16(v[0], v[1]); w.y = cvt_pk_bf16(v[2], v[3]); *(u32x2*)(x1b + o) = w;
                        s += (v[0] * v[0] + v[1] * v[1]) + (v[2] * v[2] + v[3] * v[3]); }
                s += __shfl_xor(s, 16); s += __shfl_xor(s, 32); if (fq == 0) atomicAdd(ssx1 + row, s); }
    }
};
struct EpiQP {
    static constexpr bool PERM = true, CHAIN = false;
    bf16_t* qp; const float* ssx1;
    __device__ __forceinline__ void operator()(AccT& acc, const Unit& u, int wr, int wc, int fr, int fq) const {
        const int row0 = u.pm * BM + wr * 64 + fr, col0 = u.pn * BM + wc * 32 + 8 * fq;
#pragma unroll
        for (int ai = 0; ai < 2; ++ai)
#pragma unroll
            for (int m = 0; m < 4; ++m) { const int row = row0 + ai * HALF + m * 16; const float rr = rsqrtf(ssx1[row] * (1.f / 1024.f) + EPS);
#pragma unroll
                for (int bj = 0; bj < 2; ++bj) { const f32x4 v0 = acc[ai][bj][m][0] * rr, v1 = acc[ai][bj][m][1] * rr;
                    u32x4 w; w.x = cvt_pk_bf16(v0[0], v0[1]); w.y = cvt_pk_bf16(v0[2], v0[3]); w.z = cvt_pk_bf16(v1[0], v1[1]); w.w = cvt_pk_bf16(v1[2], v1[3]);
                    *(u32x4*)(qp + (size_t)row * 2048 + col0 + bj * HALF) = w; } }
    }
};
}


namespace att {
typedef short bf16x8 __attribute__((ext_vector_type(8)));
typedef short s16x4 __attribute__((ext_vector_type(4)));
typedef float f32x16 __attribute__((ext_vector_type(16)));
constexpr int NW = 8, QBLK = 32, KVBLK = 64, QB = NW * QBLK;
constexpr int QS = 768, KS = 768, VS = 512, OS = 512;
constexpr int SHM_V = KVBLK * 64 * 2, SHM_K = KVBLK * 256;
constexpr int LDS_BYTES = 2 * SHM_V + 2 * SHM_K + NW * 64 * 4;
constexpr float THR = 8.f;
#define KSWZ(row, colB) ((row) * 256 + ((colB) ^ (((row) & 7) << 4)))
#define SBAR() __builtin_amdgcn_sched_barrier(0)
__device__ __forceinline__ int v_st(int k, int c) { const int kk = (k & ~0xC) | ((k & 4) << 1) | ((k & 8) >> 1); return ((kk >> 3) * 2 + (c >> 5)) * 512 + ((kk & 7) * 32 + (c & 31)) * 2; }
__device__ __forceinline__ int v_rd_base(int lane) { return ((lane & 3) << 3) | (((lane >> 2) & 3) << 6) | (((lane >> 4) & 1) << 5) | (((lane >> 5) & 1) << 8); }
constexpr int v_rd_off(int d0, int ks, int half) { return d0 * 512 + ks * 2048 + half * 1024; }
__device__ __forceinline__ int crow(int r, int hi) { return (r & 3) + 8 * (r >> 2) + 4 * hi; }
__device__ __forceinline__ unsigned cvtpk(float lo, float hi) { unsigned r; asm volatile("v_cvt_pk_bf16_f32 %0, %1, %2" : "=v"(r) : "v"(lo), "v"(hi)); return r; }
__device__ __forceinline__ bf16x8 load8(const bf16_t* p) { return *reinterpret_cast<const bf16x8*>(p); }
__device__ __forceinline__ void partialSM(f32x16& p0, f32x16& p1, float& m_reg, float& mn, float& alpha) {
    float pmax = p0[0]; for (int r = 1; r < 16; ++r) pmax = fmaxf(pmax, p0[r]); for (int r = 0; r < 16; ++r) pmax = fmaxf(pmax, p1[r]);
    { auto rr = __builtin_amdgcn_permlane32_swap(__float_as_uint(pmax), __float_as_uint(pmax), false, false);
      pmax = fmaxf(__uint_as_float(rr[0]), __uint_as_float(rr[1])); }
    if (__builtin_expect(__all((pmax - m_reg) <= THR), 1)) { mn = m_reg; alpha = 1.f; }
    else { mn = fmaxf(m_reg, pmax); alpha = __builtin_amdgcn_exp2f(m_reg - mn); m_reg = mn; }
    for (int r = 0; r < 16; ++r) p0[r] = p0[r] - mn; for (int r = 0; r < 16; ++r) p1[r] = p1[r] - mn;
    for (int r = 0; r < 16; ++r) p0[r] = __builtin_amdgcn_exp2f(p0[r]);
}
__device__ __forceinline__ void finishSM(f32x16& p0, f32x16& p1, float alpha, float& l_reg, bf16x8& pa0, bf16x8& pa1, bf16x8& pa2, bf16x8& pa3) {
    for (int r = 0; r < 16; ++r) p1[r] = __builtin_amdgcn_exp2f(p1[r]);
    float ps = 0; for (int r = 0; r < 16; ++r) ps += p0[r]; for (int r = 0; r < 16; ++r) ps += p1[r];
    { auto rr = __builtin_amdgcn_permlane32_swap(__float_as_uint(ps), __float_as_uint(ps), false, false);
      ps = __uint_as_float(rr[0]) + __uint_as_float(rr[1]); }
    l_reg = l_reg * alpha + ps;
#define PK4(P, B_, OUT) do { unsigned a0 = cvtpk(P[B_+0], P[B_+1]), a1 = cvtpk(P[B_+2], P[B_+3]);                          \
        unsigned b0 = cvtpk(P[B_+4], P[B_+5]), b1 = cvtpk(P[B_+6], P[B_+7]);                                             \
        auto r0 = __builtin_amdgcn_permlane32_swap(a0, b0, false, false); auto r1 = __builtin_amdgcn_permlane32_swap(a1, b1, false, false); \
        u32x4 w = {r0[0], r1[0], r0[1], r1[1]}; OUT = *reinterpret_cast<bf16x8*>(&w); } while (0)
    PK4(p0, 0, pa0); PK4(p0, 8, pa1); PK4(p1, 0, pa2); PK4(p1, 8, pa3);
#undef PK4
}
template <int KB>
__device__ __forceinline__ void qkt(f32x16& p0, f32x16& p1, const char* K_lds, int r32, int hi, const bf16x8* qr) {
    p0 = f32x16{}; p1 = f32x16{};
    const char* kb[4];
#pragma unroll
    for (int dd = 0; dd < 4; ++dd) kb[dd] = K_lds + KB * SHM_K + KSWZ(r32, (dd * 16 + hi * 8) * 2);
#pragma unroll
    for (int d0 = 0; d0 < 6; ++d0) { const char* a = kb[d0 & 3] + (d0 >> 2) * 128;
        bf16x8 b0 = *reinterpret_cast<const bf16x8*>(a);
        bf16x8 b1 = *reinterpret_cast<const bf16x8*>(a + 32 * 256);
        p0 = __builtin_amdgcn_mfma_f32_32x32x16_bf16(b0, qr[d0], p0, 0, 0, 0);
        p1 = __builtin_amdgcn_mfma_f32_32x32x16_bf16(b1, qr[d0], p1, 0, 0, 0); }
}
template <int VB>
__device__ __forceinline__ void pv_tile(f32x16* o, int vb0, bf16x8 pa0, bf16x8 pa1, bf16x8 pa2, bf16x8 pa3) {
#define TRRD(dst, off) asm volatile("ds_read_b64_tr_b16 %0, %1 offset:%2" : "=&v"(dst) : "v"(vb0), "i"(off) : "memory")
#define PV_D0(d0) do { s16x4 l0, l1, l2, l3, h0, h1, h2, h3; constexpr int b_ = VB * SHM_V + v_rd_off(d0, 0, 0);   \
        TRRD(l0, b_); TRRD(h0, b_ + 1024); TRRD(l1, b_ + 2048); TRRD(h1, b_ + 3072); TRRD(l2, b_ + 4096); TRRD(h2, b_ + 5120); TRRD(l3, b_ + 6144); TRRD(h3, b_ + 7168); \
        asm volatile("s_waitcnt lgkmcnt(0)" ::: "memory"); SBAR();   \
        o[d0] = __builtin_amdgcn_mfma_f32_32x32x16_bf16(pa0, (bf16x8){l0[0], l0[1], l0[2], l0[3], h0[0], h0[1], h0[2], h0[3]}, o[d0], 0, 0, 0);   \
        o[d0] = __builtin_amdgcn_mfma_f32_32x32x16_bf16(pa1, (bf16x8){l1[0], l1[1], l1[2], l1[3], h1[0], h1[1], h1[2], h1[3]}, o[d0], 0, 0, 0);   \
        o[d0] = __builtin_amdgcn_mfma_f32_32x32x16_bf16(pa2, (bf16x8){l2[0], l2[1], l2[2], l2[3], h2[0], h2[1], h2[2], h2[3]}, o[d0], 0, 0, 0);   \
        o[d0] = __builtin_amdgcn_mfma_f32_32x32x16_bf16(pa3, (bf16x8){l3[0], l3[1], l3[2], l3[3], h3[0], h3[1], h3[2], h3[3]}, o[d0], 0, 0, 0); } while (0)
    PV_D0(0); PV_D0(1);
#undef PV_D0
#undef TRRD
}
struct BlockRef { const bf16_t* Q; const bf16_t* K; const bf16_t* V; bf16_t* O; int P0; };
struct Seam { bf16x8 qr[6]; bf16x8 st_v0, st_v1, st_k0, st_k1; };
#define ROWK(p, k0, rr) ((p) + (size_t)((k0) + (rr)) * KS + sc)
#define ROWV(p, k0, rr) ((p) + (size_t)((k0) + (rr)) * VS + sc)
#define VMW() asm volatile("s_waitcnt vmcnt(0)" ::: "memory")
#define VMWN(n) asm volatile("s_waitcnt vmcnt(%0)" :: "i"(n) : "memory")
#define SLOAD_H(Kp, Vp, k0) do { if (vact) { S.st_v0 = load8(ROWV(Vp, k0, sr)); S.st_v1 = load8(ROWV(Vp, k0, 32 + sr)); }              \
                                 if (kact) { S.st_k0 = load8(ROWK(Kp, k0, sr)); S.st_k1 = load8(ROWK(Kp, k0, 32 + sr)); } } while (0)
#define SWRITE_HK(bf) do { if (kact) { *(bf16x8*)(K_lds + (bf) * SHM_K + kws) = S.st_k0; *(bf16x8*)(K_lds + (bf) * SHM_K + kws + 32 * 256) = S.st_k1; } } while (0)
#define SWRITE_HV(bf) do { if (vact) { *(bf16x8*)(V_lds + (bf) * SHM_V + vst0) = S.st_v0; *(bf16x8*)(V_lds + (bf) * SHM_V + vst1) = S.st_v1; } } while (0)
#define SWRITE_H(bf) do { SWRITE_HV(bf); SWRITE_HK(bf); } while (0)
__device__ __forceinline__ void attn_prime(const BlockRef& cur, char* lds, Seam& S) {
    const int tid = threadIdx.x, wid = __builtin_amdgcn_readfirstlane(tid >> 6), lane = tid & 63, r32 = lane & 31, hi = lane >> 5;
    const int sr = tid >> 4, sc = (tid & 15) * 8, kws = KSWZ(sr, sc * 2); char* K_lds = lds + 2 * SHM_V;
    const bool kact = (tid & 15) < 12, vact = (tid & 15) < 8;
#pragma unroll
    for (int d0 = 0; d0 < 6; ++d0) S.qr[d0] = load8(cur.Q + (size_t)(wid * QBLK + r32) * QS + d0 * 16 + hi * 8);
    SLOAD_H(cur.K, cur.V, 0); VMW(); SWRITE_HK(0);
    __syncthreads();
}
__device__ __forceinline__ void attn_block(const BlockRef& cur, const BlockRef& nxt, char* lds, Seam& S) {
    const int tid = threadIdx.x, wid = __builtin_amdgcn_readfirstlane(tid >> 6), lane = tid & 63, r32 = lane & 31, hi = lane >> 5;
    const int NT = (cur.P0 + QB - 1) / KVBLK + 1;
    const int qlo = cur.P0 + wid * QBLK;
    const int qvis = qlo | 63;
    char* V_lds = lds; char* K_lds = lds + 2 * SHM_V;
    float* ws = (float*)(lds + 2 * SHM_V + 2 * SHM_K) + wid * 64; float* li_l = ws, * al_l = ws + 32;
    float m_reg = -1e30f, l_reg = 0; f32x16 o[2] = {};
    const int sr = tid >> 4, sc = (tid & 15) * 8, vst0 = v_st(sr, sc & 63), vst1 = v_st(32 + sr, sc & 63), kws = KSWZ(sr, sc * 2);
    const bool kact = (tid & 15) < 12, vact = (tid & 15) < 8;
    const int vb0 = (int)(uintptr_t)V_lds + v_rd_base(lane);
    const bf16_t* Kh = cur.K; const bf16_t* Vh = cur.V;
#define RESC(a) do { if (__any((a) < 1.f)) { if (hi == 0) al_l[r32] = (a); asm volatile("s_waitcnt lgkmcnt(0)" ::: "memory");              \
                     for (int d_ = 0; d_ < 2; ++d_) for (int r = 0; r < 16; ++r) o[d_][r] *= al_l[crow(r, hi)]; } } while (0)
#define KBASE(t) ((t) * KVBLK)
#define MASKT(P0_, P1_, t) do { if (KBASE(t) > qvis) { const float NEG_ = -__builtin_inff(); _Pragma("unroll") for (int r = 0; r < 16; ++r) { P0_[r] = NEG_; P1_[r] = NEG_; } } } while (0)
    constexpr int NQL = 6;
#define SEAM_K0() do { VMWN(NQL); SWRITE_HK(0); SBAR(); } while (0)
    f32x16 pA0, pA1, pB0, pB1; float mnA, mnB, alA, alB; bf16x8 pa0, pa1, pa2, pa3;
    SWRITE_HV(0); SBAR();
    if (NT > 1) { SLOAD_H(Kh, Vh, KBASE(1)); }
    SBAR(); qkt<0>(pA0, pA1, K_lds, r32, hi, S.qr);
    MASKT(pA0, pA1, 0); partialSM(pA0, pA1, m_reg, mnA, alA);
    if (NT > 1) { VMW(); SWRITE_H(1); }
    __syncthreads();
#define HALF_STEP(PX0, PX1, mnX, alX, PY0, PY1, alY, t, KB, VB, SB) do {                                                      \
        SBAR(); qkt<KB>(PX0, PX1, K_lds, r32, hi, S.qr);                                             \
        finishSM(PY0, PY1, alY, l_reg, pa0, pa1, pa2, pa3); SBAR();                                                           \
        if ((t) + 1 < NT) { SLOAD_H(Kh, Vh, KBASE((t) + 1)); SBAR(); }                                               \
        pv_tile<VB>(o, vb0, pa0, pa1, pa2, pa3); MASKT(PX0, PX1, (t)); partialSM(PX0, PX1, m_reg, mnX, alX);                                        \
        __syncthreads();                                                                                                      \
        if ((t) + 1 < NT) { VMW(); SWRITE_H(SB); }                                                                          \
        RESC(alX); __syncthreads(); } while (0)
    for (int t = 1; t + 1 < NT; t += 2) {
        HALF_STEP(pB0, pB1, mnB, alB, pA0, pA1, alA, t, 1, 0, 0);
        HALF_STEP(pA0, pA1, mnA, alA, pB0, pB1, alB, t + 1, 0, 1, 1);
    }
    const bool even = (NT & 1) == 0;
    if (even) { SBAR(); qkt<1>(pB0, pB1, K_lds, r32, hi, S.qr); SBAR(); }
    SLOAD_H(nxt.K, nxt.V, 0); SBAR();
#pragma unroll
    for (int d0 = 0; d0 < 6; ++d0) S.qr[d0] = load8(nxt.Q + (size_t)(wid * QBLK + r32) * QS + d0 * 16 + hi * 8);
    SBAR();
    finishSM(pA0, pA1, alA, l_reg, pa0, pa1, pa2, pa3); SBAR();
    pv_tile<0>(o, vb0, pa0, pa1, pa2, pa3);
    if (even) { MASKT(pB0, pB1, NT - 1); partialSM(pB0, pB1, m_reg, mnB, alB); __syncthreads(); RESC(alB);
        finishSM(pB0, pB1, alB, l_reg, pa0, pa1, pa2, pa3); SBAR(); pv_tile<1>(o, vb0, pa0, pa1, pa2, pa3); }
    SBAR(); SEAM_K0();
    if (hi == 0) li_l[r32] = l_reg; asm volatile("s_waitcnt lgkmcnt(0)" ::: "memory");
    float rli[16];
#pragma unroll
    for (int r = 0; r < 16; ++r) rli[r] = __builtin_amdgcn_rcpf(li_l[crow(r, hi)]);
    bf16_t* Ow = cur.O + (size_t)(wid * QBLK) * OS;
#pragma unroll
    for (int r = 0; r < 16; ++r) { const int orow = crow(r, hi);
#pragma unroll
        for (int d0 = 0; d0 < 2; ++d0) { const float v = o[d0][r] * rli[r];
            const float vn = __shfl_xor(v, 1);
            if ((r32 & 1) == 0) *(unsigned*)(Ow + (size_t)orow * OS + d0 * 32 + r32) = cvtpk(v, vn); } }
    __syncthreads();
#undef RESC
#undef KBASE
#undef MASKT
#undef SEAM_K0
#undef HALF_STEP
}
#undef ROWK
#undef ROWV
#undef VMW
#undef VMWN
#undef SLOAD_H
#undef SWRITE_HK
#undef SWRITE_HV
#undef SWRITE_H
#undef KSWZ
#undef SBAR
}

#define XB_TMO      128
#define XB_XCNT(j)  (256  + 64 * (j))
#define XB_XSUB(j)  (1280 + 64 * (j))
#define XB_XGEN(j)  (2304 + 64 * (j))
#define XB_TOP      3328
#define XB_TOPGEN   3392
#define XCD_BAR_WORDS 3456
#define XB_SPIN_CAP (1u << 18)
__device__ __forceinline__ unsigned xb_ld(unsigned* p)              { return __hip_atomic_load(p, __ATOMIC_RELAXED, __HIP_MEMORY_SCOPE_AGENT); }
__device__ __forceinline__ unsigned xb_add(unsigned* p, unsigned v) { return __hip_atomic_fetch_add(p, v, __ATOMIC_RELAXED, __HIP_MEMORY_SCOPE_AGENT); }
__device__ __forceinline__ unsigned xb_xcc_id() { return (unsigned)__builtin_amdgcn_s_getreg((3 << 11) | 20) & 0xFu; }
#define XB_SPIN(cond, bar) do { unsigned _sp = 0; while (cond) { __builtin_amdgcn_s_sleep(1); \
    if ((++_sp & 255u) == 0u) { if (xb_ld(&(bar)[XB_TMO])) break; if (_sp > XB_SPIN_CAP) { atomicAdd(&(bar)[XB_TMO], 1u); break; } } } } while (0)
struct XcdBarrier { unsigned* bar; unsigned x; volatile LAS unsigned* st; };
__device__ __forceinline__ XcdBarrier xcd_barrier_post(unsigned* bar, volatile LAS unsigned* st) {
    XcdBarrier b; b.bar = bar; b.x = xb_xcc_id(); b.st = st;
    if (threadIdx.x == 0) (void)xb_add(&bar[XB_XCNT(b.x)], 1u);
    return b;
}
__device__ __forceinline__ void xcd_barrier_complete(unsigned* bar, unsigned x, unsigned& nloc, unsigned& nx) {
    const unsigned G = gridDim.x * gridDim.y * gridDim.z;
    unsigned sum, cnt, mine, sp = 0u;
    for (;;) {
        sum = 0u; cnt = 0u; mine = 0u;
#pragma unroll
        for (unsigned j = 0; j < 16; ++j) { const unsigned c = xb_ld(&bar[XB_XCNT(j)]); sum += c; cnt += (c > 0u) ? 1u : 0u; mine = (j == x) ? c : mine; }
        if (sum == G) break;
        __builtin_amdgcn_s_sleep(1);
        if ((++sp & 255u) == 0u) { if (xb_ld(&bar[XB_TMO])) break; if (sp > XB_SPIN_CAP) { atomicAdd(&bar[XB_TMO], 1u); break; } }
    }
    nloc = mine > 0u ? mine : 1u; nx = cnt > 0u ? cnt : 1u;
}
__device__ __forceinline__ void xcd_barrier(const XcdBarrier& b) {
    asm volatile("s_waitcnt vmcnt(0)" ::: "memory");
    __syncthreads();
    if (threadIdx.x == 0) {
        unsigned* bar = b.bar;
        __builtin_amdgcn_s_waitcnt(0);
        unsigned nloc = b.st[0], nx = b.st[1];
        if (nloc == 0u) { xcd_barrier_complete(bar, b.x, nloc, nx); b.st[0] = nloc; b.st[1] = nx; }
        const unsigned old = xb_add(&bar[XB_XSUB(b.x)], 1u);
        const unsigned gen = old / nloc;
        if (old + 1u == (gen + 1u) * nloc) {
            __builtin_amdgcn_fence(__ATOMIC_RELEASE, "agent");
            asm volatile("s_waitcnt vmcnt(0)" ::: "memory");
            const unsigned og = xb_add(&bar[XB_TOP], 1u);
            const unsigned tg = og / nx;
            if (og + 1u == (tg + 1u) * nx) xb_add(&bar[XB_TOPGEN], 1u);
            else XB_SPIN(xb_ld(&bar[XB_TOPGEN]) == tg, bar);
            __builtin_amdgcn_fence(__ATOMIC_ACQUIRE, "agent");
            xb_add(&bar[XB_XGEN(b.x)], 1u);
            asm volatile("s_waitcnt vmcnt(0)" ::: "memory");
        } else {
            XB_SPIN(xb_ld(&bar[XB_XGEN(b.x)]) == gen, bar);
            __builtin_amdgcn_fence(__ATOMIC_ACQUIRE, "agent");
            asm volatile("s_waitcnt vmcnt(0)" ::: "memory");
        }
    }
    __syncthreads();
}

constexpr int NWAVES = 8;
constexpr int RING_BYTES = 131072, LDSCTL_OFF = RING_BYTES, MISC_OFF = LDSCTL_OFF + 320, LDS_BYTES = 147456;
constexpr int CW_BAR = 4096;

struct Args { const void* in[20]; float* out; unsigned char* ws; int ph_lo, ph_hi; };

__device__ __forceinline__ int win_srccol(int n) {
    if (n < 2048) return 2224 + n;
    if (n < 2560) return 1712 + (n - 2048);
    if (n < 2816) return 672 + (n - 2560);
    if (n < 3328) return 1184 + (n - 2816);
    if (n < 3584) return 928 + (n - 3328);
    if (n < 3968) return 0 + (n - 3584);
    if (n < 4224) return 384 + (n - 3968);
    if (n < 4256) return 640 + (n - 4224);
    if (n < 4272) return 1696 + (n - 4256);
    return -1;
}
__device__ __forceinline__ void transpose_item(const float* __restrict__ W, int K, int Nsrc, bf16_t* __restrict__ WT, int Nout, const float* __restrict__ kscale, bool winperm, float* scr, int item, int lane) {
    const int nblk = Nout / 32, kb = item / nblk, nb = item % nblk, k0 = 64 * kb, n0 = 32 * nb;
    const int n = n0 + (lane & 31); const int sc = winperm ? win_srccol(n) : n;
#pragma unroll 8
    for (int i = 0; i < 32; ++i) { const int kk = 2 * i + (lane >> 5); float v = 0.f; if (sc >= 0) { v = W[(size_t)(k0 + kk) * Nsrc + sc]; if (kscale) v *= kscale[k0 + kk]; } scr[kk * 33 + (lane & 31)] = v; }
    asm volatile("s_waitcnt lgkmcnt(0)" ::: "memory");
    const int c = lane & 7;
#pragma unroll
    for (int j = 0; j < 4; ++j) { const int nn = (lane >> 3) + 8 * j; const float* s = scr + (8 * c) * 33 + nn;
        u32x4 o; o.x = pk2(s[0 * 33], s[1 * 33]); o.y = pk2(s[2 * 33], s[3 * 33]); o.z = pk2(s[4 * 33], s[5 * 33]); o.w = pk2(s[6 * 33], s[7 * 33]);
        *(u32x4*)(WT + (size_t)(n0 + nn) * K + k0 + 8 * c) = o; }
    asm volatile("s_waitcnt lgkmcnt(0)" ::: "memory");
}

#define TOPK_INSERT(tv, ti, vv, ii) do { float v_ = (vv); int i_ = (ii); \
    _Pragma("unroll") for (int q_ = 0; q_ < 16; ++q_) { const bool gt_ = (v_ > tv[q_]) || (v_ == tv[q_] && i_ < ti[q_]); const float tv_ = tv[q_]; const int ti_ = ti[q_]; \
        tv[q_] = gt_ ? v_ : tv_; ti[q_] = gt_ ? i_ : ti_; v_ = gt_ ? tv_ : v_; i_ = gt_ ? ti_ : i_; } } while (0)

__global__ void __launch_bounds__(NWAVES * 64, 2) fwd(Args args) {
    extern __shared__ __attribute__((aligned(16))) unsigned char lds[];
    const int tid = threadIdx.x, lane = tid & 63, wave = __builtin_amdgcn_readfirstlane(tid >> 6);
    const int G = gridDim.x; int vcu; { const int bx = blockIdx.x; vcu = (G % 8 == 0) ? (bx % 8) * (G / 8) + bx / 8 : bx; }
    const int gw = vcu * NWAVES + wave, NGW = G * NWAVES, gtid = vcu * 512 + tid, NT = G * 512;
    unsigned char* ws = args.ws;
    const float* x = (const float*)args.in[0]; const int* positions = (const int*)args.in[1];
    const float* g_mix = (const float*)args.in[2]; const float* w_in = (const float*)args.in[3]; const float* g_q_lat = (const float*)args.in[4]; const float* w_qb = (const float*)args.in[5];
    const float* g_kv_lat = (const float*)args.in[6]; const float* w_kvb = (const float*)args.in[7]; const float* w_a2 = (const float*)args.in[8]; const float* b_a2 = (const float*)args.in[9];
    const float* g_gla = (const float*)args.in[10]; const float* w_branch_a = (const float*)args.in[11]; const float* w_branch_b = (const float*)args.in[12]; const float* w_out = (const float*)args.in[13];
    const float* g_ffn = (const float*)args.in[14]; const float* w_peer_q = (const float*)args.in[15]; const float* sub_keys = (const float*)args.in[16]; const float* peer_u = (const float*)args.in[17];
    const float* peer_v = (const float*)args.in[18]; const float* g_final = (const float*)args.in[19];
    float* out = args.out;
    float* SSQ = (float*)(ws + WS_SSQ); float* SSKV = (float*)(ws + WS_SSKV); float* SSX1 = (float*)(ws + WS_SSX1); float* COS = (float*)(ws + WS_COS); float* SIN = (float*)(ws + WS_SIN);
    float* DECAY = (float*)(ws + WS_DECAY);
    bf16_t* WIN = (bf16_t*)(ws + WS_WIN); bf16_t* WQB = (bf16_t*)(ws + WS_WQB); bf16_t* WKVB = (bf16_t*)(ws + WS_WKVB); bf16_t* WA = (bf16_t*)(ws + WS_WA); bf16_t* WB = (bf16_t*)(ws + WS_WB);
    bf16_t* WOUT = (bf16_t*)(ws + WS_WOUT); bf16_t* WPQ = (bf16_t*)(ws + WS_WPQ); bf16_t* KEYS = (bf16_t*)(ws + WS_KEYS);
    bf16_t* PROJB = (bf16_t*)(ws + WS_PROJB); bf16_t* PROJA = (bf16_t*)(ws + WS_PROJA); bf16_t* XN = (bf16_t*)(ws + WS_XN);
    bf16_t* Q = (bf16_t*)(ws + WS_Q); bf16_t* K = (bf16_t*)(ws + WS_K); bf16_t* V = (bf16_t*)(ws + WS_V); float* DST = (float*)(ws + WS_DST);
    bf16_t* YA = (bf16_t*)(ws + WS_YA); bf16_t* YB = (bf16_t*)(ws + WS_YB); bf16_t* MERGED = (bf16_t*)(ws + WS_MERGED); bf16_t* X1B = (bf16_t*)(ws + WS_X1B); bf16_t* QP = (bf16_t*)(ws + WS_QP);
    int* EIDX = (int*)(ws + WS_EIDX); float* EGATE = (float*)(ws + WS_EGATE);

    for (int u = tid; u < (LDS_BYTES - LDSCTL_OFF) / 4; u += NWAVES * 64) ((unsigned*)(lds + LDSCTL_OFF))[u] = 0u;
    __syncthreads();
    XcdBarrier bar; bar.bar = (unsigned*)(ws + WS_CTL) + CW_BAR; bar.x = 0; bar.st = nullptr;
    if (MK_N_LAUNCHES == 1) bar = xcd_barrier_post((unsigned*)(ws + WS_CTL) + CW_BAR, (volatile LAS unsigned*)(lds + MISC_OFF) + 8);
    const int lo = args.ph_lo, hi = args.ph_hi;
#define IN(k) (lo <= (k) && (k) < hi)
#define SEAM(k) do { if (MK_N_LAUNCHES == 1) { if (IN(k) && IN((k) + 1)) xcd_barrier(bar); } } while (0)
    PG8_LAS unsigned char* ring = (PG8_LAS unsigned char*)lds;

    if (IN(0)) {
        for (int i = gtid; i < 3 * M_; i += NT) SSQ[i] = 0.f;
        float* scr = (float*)(lds + wave * 16384);
        constexpr int I_WIN = 16 * (NPROJ / 32), I_QB = 6 * 24, I_KVB = 4 * 32, I_A = 8 * 32, I_OUT = 16 * 32, I_PQ = 16 * 64;
        constexpr int NITEMS = I_WIN + I_QB + I_KVB + 2 * I_A + I_OUT + I_PQ;
        for (int it = gw; it < NITEMS; it += NGW) {
            int r = it;
            if (r < I_WIN) { transpose_item(w_in, 1024, 4272, WIN, NPROJ, nullptr, true, scr, r, lane); continue; } r -= I_WIN;
            if (r < I_QB) { transpose_item(w_qb, 384, 768, WQB, 768, g_q_lat, false, scr, r, lane); continue; } r -= I_QB;
            if (r < I_KVB) { transpose_item(w_kvb, 256, 1024, WKVB, 1024, g_kv_lat, false, scr, r, lane); continue; } r -= I_KVB;
            if (r < I_A) { transpose_item(w_branch_a, 512, 1024, WA, 1024, nullptr, false, scr, r, lane); continue; } r -= I_A;
            if (r < I_A) { transpose_item(w_branch_b, 512, 1024, WB, 1024, nullptr, false, scr, r, lane); continue; } r -= I_A;
            if (r < I_OUT) { transpose_item(w_out, 1024, 1024, WOUT, 1024, nullptr, false, scr, r, lane); continue; } r -= I_OUT;
            transpose_item(w_peer_q, 1024, 2048, WPQ, 2048, g_ffn, false, scr, r, lane);
        }
        for (int i = gtid; i < 16 * 128 * 128; i += NT) KEYS[i] = f2bf(sub_keys[i]);
        for (int i = gtid; i < M_ * 16; i += NT) { const int m = i >> 4, f = i & 15;
            const double inv = pow(10000.0, -(double)f / 16.0); const double ang = (double)positions[m] * inv;
            COS[i] = (float)cos(ang); SIN[i] = (float)sin(ang); }
        for (int row = gw; row < M_; row += NGW) {
            const f32x4* xr = (const f32x4*)(x + (size_t)row * DM); f32x4 v[4]; float ss = 0.f;
#pragma unroll
            for (int j = 0; j < 4; ++j) { v[j] = xr[lane + 64 * j]; ss += (v[j][0] * v[j][0] + v[j][1] * v[j][1]) + (v[j][2] * v[j][2] + v[j][3] * v[j][3]); }
            ss = wave_sum(ss); const float r = rsqrtf(ss * (1.f / DM) + EPS);
#pragma unroll
            for (int j = 0; j < 4; ++j) { const int c = 4 * (lane + 64 * j); const f32x4 gg = *(const f32x4*)(g_mix + c);
                u32x2 w; w.x = pk2(v[j][0] * r * gg[0], v[j][1] * r * gg[1]); w.y = pk2(v[j][2] * r * gg[2], v[j][3] * r * gg[3]);
                *(u32x2*)(XN + (size_t)row * DM + c) = w; }
        }
    }
    SEAM(0);
    if (IN(1)) {
        pg8::Gemm g{XN, WIN, nullptr, nullptr, DM, DM, M_, NPROJ, DM, 1}; pg8::StaticOrder S; S.init(g, G, (int)blockIdx.x);
        pg8::EpiProj E{PROJB, PROJA, SSQ, SSKV};
        pg8::gemm_phase<pg8::EpiProj, pg8::StaticOrder, true>(ring, g, S, E);
    }
    SEAM(1);
    if (IN(2)) {
        { pg8::Gemm g{PROJA + PA_QLAT, WQB, nullptr, nullptr, PA_LD, 384, M_, 768, 384, 1}; pg8::StaticOrder S; S.init(g, G, (int)blockIdx.x);
          pg8::EpiQ E{Q, SSQ, COS, SIN}; pg8::gemm_phase<pg8::EpiQ, pg8::StaticOrder, true>(ring, g, S, E); }
        { pg8::Gemm g{PROJA + PA_KVLAT, WKVB, nullptr, nullptr, PA_LD, 256, M_, 1024, 256, 1}; pg8::StaticOrder S; S.init(g, G, (int)blockIdx.x);
          pg8::EpiKV E{K, V, SSKV}; pg8::gemm_phase<pg8::EpiKV, pg8::StaticOrder, true>(ring, g, S, E); }
        for (int i = gtid; i < M_ * 32; i += NT) { const int m = i >> 5, j = i & 31; const bf16_t* kr = PROJA + (size_t)m * PA_LD + PA_KROPE; float o;
            if (j < 16) { const float x1 = bf2f(kr[j]), x2 = bf2f(kr[j + 16]); o = x1 * COS[m * 16 + j] - x2 * SIN[m * 16 + j]; }
            else { const int f = j - 16; const float x2 = bf2f(kr[j]), x1 = bf2f(kr[j - 16]); o = x2 * COS[m * 16 + f] + x1 * SIN[m * 16 + f]; }
            const bf16_t ob = f2bf(o);
#pragma unroll
            for (int h = 0; h < 8; ++h) K[(size_t)m * 768 + h * 96 + 64 + j] = ob; }
        __syncthreads();
        {
            const int half = tid >> 8, t256 = tid & 255;
            float* lb = (float*)(lds + half * 65536);
            float (*cum)[64] = (float (*)[64])lb; float (*kd)[64] = (float (*)[64])(lb + 4096); float (*gvs)[128] = (float (*)[128])(lb + 8192);
            for (int vb0 = vcu * 2; vb0 < 2 * NCH * 4; vb0 += 2 * G) {
                const int vb = vb0 + half; const int h = vb & 3, bc = vb >> 2, t0 = bc * 64;
                { const int k = t256 & 63; float w[16];
#pragma unroll
                  for (int r = 0; r < 16; ++r) w[r] = w_a2[r * 256 + h * 64 + k];
                  const float bias = b_a2[h * 64 + k];
#pragma unroll 1
                  for (int l = t256 >> 6; l < 64; l += 4) { const bf16_t* gl = PROJA + (size_t)(t0 + l) * PA_LD + PA_GLR; float z = bias;
#pragma unroll
                      for (int r = 0; r < 16; ++r) z += bf2f(gl[r]) * w[r];
                      const float ls = fminf(z, 0.f) - log1pf(expf(-fabsf(z))); cum[l][k] = ls * (1.f / 16.f); } }
                __syncthreads();
                if (t256 < 64) { float s = 0.f; for (int l = 0; l < 64; ++l) { s += cum[l][t256]; cum[l][t256] = s; } }
                __syncthreads();
#pragma unroll 2
                for (int i = t256; i < 64 * 64; i += 256) { const int l = i >> 6, k = i & 63; kd[l][k] = bf2f(PROJA[(size_t)(t0 + l) * PA_LD + PA_GK + h * 64 + k]) * expf(cum[63][k] - cum[l][k]); }
#pragma unroll 4
                for (int i = t256; i < 64 * 128; i += 256) { const int l = i >> 7, v = i & 127; gvs[l][v] = bf2f(PROJA[(size_t)(t0 + l) * PA_LD + PA_GV + h * 128 + v]); }
                if (t256 < 64) DECAY[((size_t)bc * 4 + h) * 64 + t256] = expf(cum[63][t256]);
                __syncthreads();
                { const int v = t256 & 127, kb = (t256 >> 7) * 32;
                  for (int kk = 0; kk < 32; ++kk) { const int k = kb + kk; float s = 0.f;
                      for (int l = 0; l < 64; ++l) s += kd[l][k] * gvs[l][v];
                      DST[(((size_t)bc * 4 + h) * 64 + k) * 128 + v] = s; } }
                __syncthreads();
            }
        }
    }
    SEAM(2);
    if (IN(3)) {
        if (tid < 256) for (int i = vcu * 256 + tid; i < 65536; i += G * 256) {
            const int v = i & 127, k = (i >> 7) & 63, h = (i >> 13) & 3, b = i >> 15; float s = 0.f;
            float* dp = DST + (((size_t)b * NCH * 4 + h) * 64 + k) * 128 + v; const float* gp = DECAY + ((size_t)b * NCH * 4 + h) * 64 + k;
            for (int c0 = 0; c0 < NCH; c0 += 8) { float d[8], g[8];
#pragma unroll
                for (int j = 0; j < 8; ++j) { d[j] = dp[(size_t)(c0 + j) * 32768]; g[j] = gp[(size_t)(c0 + j) * 256]; }
#pragma unroll
                for (int j = 0; j < 8; ++j) { s = g[j] * s + d[j]; d[j] = s; }
#pragma unroll
                for (int j = 0; j < 8; ++j) dp[(size_t)(c0 + j) * 32768] = d[j]; } }
        __syncthreads();
        {
            for (int pr = vcu; pr < 256; pr += G) {
                const int bh = pr >> 4, s16 = pr & 15, b = bh >> 3, h = bh & 7;
                att::BlockRef r0, r1;
                const bf16_t* Kh = K + (size_t)b * SEQ * att::KS + h * 96; const bf16_t* Vh = V + (size_t)b * SEQ * att::VS + h * 64;
                const int qb0 = 31 - s16, qb1 = s16;
                r0.Q = Q + ((size_t)b * SEQ + qb0 * 256) * att::QS + h * 96; r0.O = YA + ((size_t)b * SEQ + qb0 * 256) * att::OS + h * 64; r0.K = Kh; r0.V = Vh; r0.P0 = qb0 * 256;
                r1.Q = Q + ((size_t)b * SEQ + qb1 * 256) * att::QS + h * 96; r1.O = YA + ((size_t)b * SEQ + qb1 * 256) * att::OS + h * 64; r1.K = Kh; r1.V = Vh; r1.P0 = qb1 * 256;
                att::Seam S;
                att::attn_prime(r0, (char*)lds, S);
                att::attn_block(r0, r1, (char*)lds, S);
                att::attn_block(r1, r1, (char*)lds, S);
            }
        }
    }
    SEAM(3);
    if (IN(4)) {
        const int half = tid >> 8, t256 = tid & 255;
        float* lb = (float*)(lds + half * 65536);
        float (*ss)[128] = (float (*)[128])lb; float (*qs)[65] = (float (*)[65])(lb + 8192);
        for (int vb0 = vcu * 2; vb0 < 2 * NCH * 4; vb0 += 2 * G) {
            const int vb = vb0 + half; const int h = vb & 3, bc = vb >> 2, t0 = bc * 64;
            const float* sp = DST + ((size_t)bc * 4 + h) * 64 * 128;
            for (int i = t256; i < 64 * 128; i += 256) ss[i >> 7][i & 127] = sp[i];
            for (int i = t256; i < 64 * 64; i += 256) { const int l = i >> 6, k = i & 63; qs[l][k] = bf2f(PROJB[(size_t)(t0 + l) * PB_LD + PB_GQ + h * 64 + k]) * 0.125f; }
            __syncthreads();
            { const int l = t256 >> 2, vg = t256 & 3; float o[32];
#pragma unroll
              for (int j = 0; j < 32; ++j) o[j] = 0.f;
              for (int k = 0; k < 64; ++k) { const float qv = qs[l][k];
#pragma unroll
                  for (int j = 0; j < 32; ++j) o[j] += qv * ss[k][vg * 32 + j]; }
              float s2 = 0.f;
#pragma unroll
              for (int j = 0; j < 32; ++j) s2 += o[j] * o[j];
              s2 += __shfl_xor(s2, 1); s2 += __shfl_xor(s2, 2);
              const float r = rsqrtf(s2 * (1.f / 128.f) + EPS);
#pragma unroll
              for (int j = 0; j < 32; ++j) { const int v = vg * 32 + j; const float go = bf2f(PROJB[(size_t)(t0 + l) * PB_LD + PB_GOUT + h * 128 + v]); const float silu = go / (1.f + __expf(-go));
                  YB[(size_t)(t0 + l) * 512 + h * 128 + v] = f2bf(o[j] * r * g_gla[h * 128 + v] * silu); } }
            __syncthreads();
        }
    }
    SEAM(4);
    if (IN(5)) {
        pg8::Gemm g{YA, WA, YB, WB, 512, 512, M_, 1024, 512, 2}; pg8::StaticOrder S; S.init(g, G, (int)blockIdx.x);
        pg8::EpiMerge E{PROJB, MERGED}; pg8::gemm_phase<pg8::EpiMerge, pg8::StaticOrder, false>(ring, g, S, E);
    }
    SEAM(5);
    if (IN(6)) {
        pg8::Gemm g{MERGED, WOUT, nullptr, nullptr, DM, DM, M_, 1024, DM, 1}; pg8::StaticOrder S; S.init(g, G, (int)blockIdx.x);
        pg8::EpiX1 E{x, out, X1B, SSX1}; pg8::gemm_phase<pg8::EpiX1, pg8::StaticOrder, false>(ring, g, S, E);
    }
    SEAM(6);
    if (IN(7)) {
        pg8::Gemm g{X1B, WPQ, nullptr, nullptr, DM, DM, M_, 2048, DM, 1}; pg8::StaticOrder S; S.init(g, G, (int)blockIdx.x);
        pg8::EpiQP E{QP, SSX1}; pg8::gemm_phase<pg8::EpiQP, pg8::StaticOrder, true>(ring, g, S, E);
    }
    SEAM(7);
    if (IN(8)) {
        for (int W = gw; W < 2048; W += NGW) {
            const int h = W & 7, m = (W >> 3) * 64 + lane;
            float tv[2][16]; int ti[2][16];
#pragma unroll
            for (int p = 0; p < 2; ++p) {
#pragma unroll
                for (int i = 0; i < 16; ++i) { tv[p][i] = -INFINITY; ti[p][i] = 0x7fffffff; }
                unsigned qpk[64];
                const u32x4* qr = (const u32x4*)(QP + (size_t)m * 2048 + (h * 2 + p) * 128);
#pragma unroll
                for (int i = 0; i < 16; ++i) { const u32x4 t = qr[i]; qpk[4 * i] = t.x; qpk[4 * i + 1] = t.y; qpk[4 * i + 2] = t.z; qpk[4 * i + 3] = t.w; }
                const unsigned* kb = (const unsigned*)(KEYS + (size_t)(h * 2 + p) * 128 * 128);
                for (int n = 0; n < 128; ++n) { const unsigned* kr = kb + n * 64; float s = 0.f;
#pragma unroll
                    for (int d = 0; d < 64; ++d) { const unsigned kk = kr[d]; s += __uint_as_float(qpk[d] << 16) * __uint_as_float(kk << 16); s += __uint_as_float(qpk[d] & 0xffff0000u) * __uint_as_float(kk & 0xffff0000u); }
                    TOPK_INSERT(tv[p], ti[p], s, n); }
            }
            float bv[16]; int bi[16];
#pragma unroll
            for (int i = 0; i < 16; ++i) { bv[i] = -INFINITY; bi[i] = 0x7fffffff; }
#define CAND_(a, b) TOPK_INSERT(bv, bi, tv[0][a] + tv[1][b], (ti[0][a] * 128 + ti[1][b]) | (((a) * 16 + (b)) << 16))
#pragma unroll
            for (int b = 0; b < 16; ++b) CAND_(0, b);
#pragma unroll
            for (int b = 0; b < 8; ++b) CAND_(1, b);
#pragma unroll
            for (int b = 0; b < 5; ++b) CAND_(2, b);
#pragma unroll
            for (int b = 0; b < 4; ++b) CAND_(3, b);
#pragma unroll
            for (int b = 0; b < 3; ++b) CAND_(4, b);
#pragma unroll
            for (int b = 0; b < 2; ++b) CAND_(5, b);
#pragma unroll
            for (int b = 0; b < 2; ++b) CAND_(6, b);
#pragma unroll
            for (int b = 0; b < 2; ++b) CAND_(7, b);
#pragma unroll
            for (int b = 0; b < 1; ++b) CAND_(8, b);
#pragma unroll
            for (int b = 0; b < 1; ++b) CAND_(9, b);
#pragma unroll
            for (int b = 0; b < 1; ++b) CAND_(10, b);
#pragma unroll
            for (int b = 0; b < 1; ++b) CAND_(11, b);
#pragma unroll
            for (int b = 0; b < 1; ++b) CAND_(12, b);
#pragma unroll
            for (int b = 0; b < 1; ++b) CAND_(13, b);
#pragma unroll
            for (int b = 0; b < 1; ++b) CAND_(14, b);
#pragma unroll
            for (int b = 0; b < 1; ++b) CAND_(15, b);
#undef CAND_
            float e[16], sum = 0.f;
#pragma unroll
            for (int k = 0; k < 16; ++k) { e[k] = __expf(bv[k] - bv[0]); sum += e[k]; }
            const float inv = 1.f / sum;
#pragma unroll
            for (int k = 0; k < 16; ++k) { EIDX[(size_t)m * 128 + h * 16 + k] = bi[k] & 0xffff; EGATE[(size_t)m * 128 + h * 16 + k] = e[k] * inv; }
        }
    }
    SEAM(8);
    if (IN(9)) {
        for (int m = gw; m < M_; m += NGW) {
            float xg[16], y[16];
#pragma unroll
            for (int j = 0; j < 4; ++j) { const int c = 4 * (lane + 64 * j); const f32x4 gg = *(const f32x4*)(g_ffn + c); const u32x2 xb = *(const u32x2*)(X1B + (size_t)m * DM + c);
                xg[4 * j] = __uint_as_float(xb.x << 16) * gg[0]; xg[4 * j + 1] = __uint_as_float(xb.x & 0xffff0000u) * gg[1]; xg[4 * j + 2] = __uint_as_float(xb.y << 16) * gg[2]; xg[4 * j + 3] = __uint_as_float(xb.y & 0xffff0000u) * gg[3]; }
#pragma unroll
            for (int j = 0; j < 16; ++j) y[j] = 0.f;
            const float r = rsqrtf(SSX1[m] * (1.f / DM) + EPS);
            for (int k = 0; k < 128; ++k) {
                const int e = EIDX[(size_t)m * 128 + k]; const float gate = EGATE[(size_t)m * 128 + k];
                const f32x4* ur = (const f32x4*)(peer_u + (size_t)e * DM); float d = 0.f;
#pragma unroll
                for (int j = 0; j < 4; ++j) { const f32x4 u = ur[lane + 64 * j]; d += (xg[4 * j] * u[0] + xg[4 * j + 1] * u[1]) + (xg[4 * j + 2] * u[2] + xg[4 * j + 3] * u[3]); }
                d = wave_sum(d) * r;
                const float a = 0.5f * d * (1.f + erff(d * 0.70710678118654752f)) * gate;
                const f32x4* vr = (const f32x4*)(peer_v + (size_t)e * DM);
#pragma unroll
                for (int j = 0; j < 4; ++j) { const f32x4 v = vr[lane + 64 * j]; y[4 * j] += a * v[0]; y[4 * j + 1] += a * v[1]; y[4 * j + 2] += a * v[2]; y[4 * j + 3] += a * v[3]; }
            }
            const f32x4* xr = (const f32x4*)(out + (size_t)m * DM); float ss = 0.f;
#pragma unroll
            for (int j = 0; j < 4; ++j) { const f32x4 v = xr[lane + 64 * j]; y[4 * j] += v[0]; y[4 * j + 1] += v[1]; y[4 * j + 2] += v[2]; y[4 * j + 3] += v[3];
                ss += (y[4 * j] * y[4 * j] + y[4 * j + 1] * y[4 * j + 1]) + (y[4 * j + 2] * y[4 * j + 2] + y[4 * j + 3] * y[4 * j + 3]); }
            ss = wave_sum(ss); const float r2 = rsqrtf(ss * (1.f / DM) + EPS);
#pragma unroll
            for (int j = 0; j < 4; ++j) { const int c = 4 * (lane + 64 * j); const f32x4 gg = *(const f32x4*)(g_final + c);
                f32x4 o; o[0] = y[4 * j] * r2 * gg[0]; o[1] = y[4 * j + 1] * r2 * gg[1]; o[2] = y[4 * j + 2] * r2 * gg[2]; o[3] = y[4 * j + 3] * r2 * gg[3];
                *(f32x4*)(out + (size_t)m * DM + c) = o; }
        }
    }
#undef IN
#undef SEAM
}

extern "C" void kernel_launch(void* const* d_in, const int* in_sizes, int n_in, void* d_out, int out_size, void* d_ws, size_t ws_size, hipStream_t stream) {
    static int grid = 0;
    if (grid == 0) {
        if (n_in != 20 || out_size != M_ * DM || ws_size < WS_END) { fprintf(stderr, "kernel_launch: unexpected shapes (n_in %d out %d ws %zu); nothing launched\n", n_in, out_size, ws_size); grid = -1; return; }
        int dev = 0, cus = 0;
        if (hipGetDevice(&dev) != hipSuccess || hipDeviceGetAttribute(&cus, hipDeviceAttributeMultiprocessorCount, dev) != hipSuccess) { grid = -1; return; }
        if (hipFuncSetAttribute((const void*)fwd, hipFuncAttributeMaxDynamicSharedMemorySize, LDS_BYTES) != hipSuccess) { fprintf(stderr, "kernel_launch: hipFuncSetAttribute failed\n"); grid = -1; return; }
        int per_cu = 0;
        if (hipOccupancyMaxActiveBlocksPerMultiprocessor(&per_cu, (const void*)fwd, NWAVES * 64, LDS_BYTES) != hipSuccess || per_cu < 1) fprintf(stderr, "kernel_launch: occupancy query reports %d\n", per_cu);
        (void)hipGetLastError();
        grid = cus;
    }
    if (grid < 0) return;
    (void)hipMemsetAsync((char*)d_ws + WS_CTL, 0, CTL_ZERO_BYTES, stream);
    Args a; memset(&a, 0, sizeof(a));
    for (int i = 0; i < 20; ++i) a.in[i] = d_in[i];
    a.out = (float*)d_out; a.ws = (unsigned char*)d_ws;
    if (MK_N_LAUNCHES == 1) { a.ph_lo = 0; a.ph_hi = N_PHASES; hipLaunchKernelGGL(fwd, dim3(grid), dim3(NWAVES * 64), LDS_BYTES, stream, a); }
    else for (int p = 0; p < N_PHASES; ++p) { a.ph_lo = p; a.ph_hi = p + 1; hipLaunchKernelGGL(fwd, dim3(grid), dim3(NWAVES * 64), LDS_BYTES, stream, a); }
}
```

```cpp
#include <hip/hip_runtime.h>
#include <cstdio>
#include <cstdint>
#include <cstring>
#include <math.h>

#ifndef MK_N_LAUNCHES
#define MK_N_LAUNCHES 1
#endif
constexpr int N_PHASES = 10;

typedef unsigned short bf16_t;
constexpr int SEQ = 8192, DM = 1024, M_ = 16384, NCH = 128;
constexpr float EPS = 1e-6f;
constexpr int PB_LD = 2816, PA_LD = 1536;
constexpr int PB_BR = 0, PB_GOUT = 2048, PB_GQ = 2560;
constexpr int PA_GV = 0, PA_GK = 512, PA_QLAT = 768, PA_KVLAT = 1152, PA_KROPE = 1408, PA_GLR = 1440;
constexpr int NPROJ = 4352;
constexpr float CQ = 0.10206207261596577f * 1.4426950408889634f;

constexpr size_t MiB = 1u << 20;
constexpr size_t WS_CTL = 0, CTL_ZERO_BYTES = 256 * 1024;
constexpr size_t WS_SSQ = 1 * MiB, WS_SSKV = WS_SSQ + 65536, WS_SSX1 = WS_SSKV + 65536, WS_COS = 2 * MiB, WS_SIN = 3 * MiB;
constexpr size_t WS_DECAY = 1 * MiB + 512 * 1024;
constexpr size_t WS_WIN = 4 * MiB, WS_WQB = 13 * MiB, WS_WKVB = 14 * MiB, WS_WA = 15 * MiB, WS_WB = 16 * MiB, WS_WOUT = 17 * MiB, WS_WPQ = 19 * MiB, WS_KEYS = 23 * MiB;
constexpr size_t WS_PROJB = 24 * MiB, WS_PROJA = 112 * MiB, WS_XN = 160 * MiB, WS_Q = 160 * MiB, WS_K = 184 * MiB, WS_V = 208 * MiB, WS_DST = 224 * MiB;
constexpr size_t WS_YA = 112 * MiB, WS_YB = 128 * MiB, WS_MERGED = 160 * MiB, WS_X1B = 24 * MiB, WS_QP = 56 * MiB, WS_EIDX = 120 * MiB, WS_EGATE = 128 * MiB;
constexpr size_t WS_UT = 192 * MiB, WS_VT = 224 * MiB;
constexpr size_t WS_END = 256 * MiB;

#define GAS __attribute__((address_space(1)))
#define LAS __attribute__((address_space(3)))
typedef float f32x4 __attribute__((ext_vector_type(4)));
typedef unsigned u32x4 __attribute__((ext_vector_type(4)));
typedef unsigned u32x2 __attribute__((ext_vector_type(2)));

__device__ __forceinline__ float bf2f(bf16_t h) { return __uint_as_float(((unsigned)h) << 16); }
__device__ __forceinline__ unsigned f2bf_u(float f) { unsigned u = __float_as_uint(f); return (u + 0x7fffu + ((u >> 16) & 1u)) >> 16; }
__device__ __forceinline__ bf16_t f2bf(float f) { return (bf16_t)f2bf_u(f); }
__device__ __forceinline__ unsigned pk2(float lo, float hi) { return f2bf_u(lo) | (f2bf_u(hi) << 16); }
__device__ __forceinline__ float wave_sum(float v) {
#pragma unroll
    for (int o = 1; o < 64; o <<= 1) v += __shfl_xor(v, o);
    return v;
}
__device__ __forceinline__ float sigmoidf_(float x) { return 1.f / (1.f + __expf(-x)); }

namespace pg8 {
#define PG8_LAS __attribute__((address_space(3)))
typedef short bf16x8 __attribute__((ext_vector_type(8)));
constexpr int BM = 256, BK = 64, HALF = 128, HTB = HALF * BK * 2, STAGE_BYTES = 8 * HTB, NXCD = 8, WGM = 8;
__host__ __device__ __forceinline__ int lds_byte(int r, int c) { const int st = (r >> 4) * 2 + (c >> 5), rr = r & 15, cc = c & 31, ob = rr * 64 + cc * 2; return st * 1024 + (ob ^ (((ob >> 9) & 1) << 5)); }
__host__ __device__ __forceinline__ void stage_rc(int b, int& R, int& C) { const int st = b / 1024, sb = b % 1024, swz = sb ^ (((sb >> 9) & 1) << 5); R = (st >> 1) * 16 + swz / 64; C = (st & 1) * 32 + (swz % 64) / 2; }
__host__ __device__ __forceinline__ int perm32(int rho) { const int n = rho >> 4, i = rho & 15; return 8 * (i >> 2) + 4 * n + (i & 3); }

struct Unit { int pm, pn, sub; const char* A; const char* B; };
struct Gemm { const bf16_t* A; const bf16_t* Bt; const bf16_t* A2; const bf16_t* Bt2; int lda, ldb, M, N, K, chain; };
struct StaticOrder {
    int nM, nN, nwg, G, c, chain; const char *A, *B, *A2, *B2; size_t tsA, tsB;
    __device__ __forceinline__ void init(const Gemm& g, int G_, int c_) { nM = g.M / BM; nN = g.N / BM; nwg = nM * nN; G = G_; c = c_; chain = g.chain; A = (const char*)g.A; B = (const char*)g.Bt; A2 = (const char*)g.A2; B2 = (const char*)g.Bt2;
        tsA = (size_t)BM * g.lda * 2; tsB = (size_t)BM * g.ldb * 2; }
    __device__ __forceinline__ bool next(int i, Unit& u) const {
        const int r = (chain == 2) ? (i >> 1) : i, sub = (chain == 2) ? (i & 1) : 0;
        const long L = (long)r * G + c; if (L >= nwg) return false;
        int wgid = (int)L; { const int q = nwg / NXCD, rr = nwg % NXCD, xcd = wgid % NXCD, off = wgid / NXCD; wgid = (xcd < rr ? xcd * (q + 1) : rr * (q + 1) + (xcd - rr) * q) + off; }
        const int nig = WGM * nN, gid = wgid / nig, fm = gid * WGM, gsz = (nM - fm) < WGM ? (nM - fm) : WGM;
        u.pm = fm + ((wgid % nig) % gsz); u.pn = (wgid % nig) / gsz; u.sub = sub;
        u.A = (sub ? A2 : A) + (size_t)u.pm * tsA; u.B = (sub ? B2 : B) + (size_t)u.pn * tsB; return true;
    }
};
__device__ __forceinline__ unsigned cvt_pk_bf16(float lo, float hi) { unsigned r; asm volatile("v_cvt_pk_bf16_f32 %0, %1, %2" : "=v"(r) : "v"(lo), "v"(hi)); return r; }

typedef f32x4 AccT[2][2][4][2];
template <class Epi, class Sched, bool ALIGN_EPI>
__device__ __forceinline__ void gemm_phase(PG8_LAS unsigned char* lds, const Gemm g, const Sched& S, const Epi& E) {
    const int tid = threadIdx.x, wid = __builtin_amdgcn_readfirstlane(tid >> 6), lane = tid & 63, wr = wid >> 2, wc = wid & 3, fr = lane & 15, fq = lane >> 4;
    const int K = g.K, nt = K / BK;
    unsigned voffA[2], voffB[2];
#pragma unroll
    for (int i = 0; i < 2; ++i) { int R, C; stage_rc(tid * 16 + i * 8192, R, C); const int Rb = Epi::PERM ? ((R & ~31) + perm32(R & 31)) : R;
        voffA[i] = (unsigned)(R * g.lda + C) * 2u; voffB[i] = (unsigned)(Rb * g.ldb + C) * 2u; }
    const size_t kstep = (size_t)(BK * 2);
    const size_t hsA = (size_t)HALF * g.lda * 2, hsB = (size_t)HALF * g.ldb * 2;
    const unsigned ldsw = (unsigned)wid * 1024u;
    const int aoff = lds_byte(wr * 64 + fr, fq * 8), boff = lds_byte(wc * 32 + fr, fq * 8);
#define PG8_SA(b, h) (((b) * 2 + (h)) * HTB)
#define PG8_SB(b, h) ((4 + (b) * 2 + (h)) * HTB)
#define PG8_STAGE(bufoff, gbase, voff) do { _Pragma("unroll") for (int _i = 0; _i < 2; ++_i) \
        __builtin_amdgcn_global_load_lds((const unsigned*)((const char*)(gbase) + (voff)[_i]), (PG8_LAS unsigned*)(lds + (bufoff) + ldsw + _i * 8192), 16, 0, 0); } while (0)
#define PG8_LDA(dst, b, h) do { _Pragma("unroll") for (int m = 0; m < 4; ++m) _Pragma("unroll") for (int k = 0; k < 2; ++k) dst[m][k] = *(const PG8_LAS bf16x8*)(lds + PG8_SA(b, h) + aoff + m * 2048 + k * 1024); } while (0)
#define PG8_LDB(dst, b, h) do { _Pragma("unroll") for (int n = 0; n < 2; ++n) _Pragma("unroll") for (int k = 0; k < 2; ++k) dst[n][k] = *(const PG8_LAS bf16x8*)(lds + PG8_SB(b, h) + boff + n * 2048 + k * 1024); } while (0)
#define PG8_MMA(ai, bj, At, Bt) do { __builtin_amdgcn_s_setprio(1); _Pragma("unroll") for (int m = 0; m < 4; ++m) _Pragma("unroll") for (int n = 0; n < 2; ++n) _Pragma("unroll") for (int k = 0; k < 2; ++k) \
        acc[ai][bj][m][n] = __builtin_amdgcn_mfma_f32_16x16x32_bf16(Bt[n][k], At[m][k], acc[ai][bj][m][n], 0, 0, 0); __builtin_amdgcn_s_setprio(0); } while (0)
#define PG8_WAIT_V(n) asm volatile("s_waitcnt vmcnt(" #n ")" ::: "memory")
#define PG8_WAIT_L(n) asm volatile("s_waitcnt lgkmcnt(" #n ")" ::: "memory")
#define PG8_BAR __builtin_amdgcn_s_barrier()
#define PG8_SCHED __builtin_amdgcn_sched_barrier(0)
    Unit cur, nxt; int ui = 0;
    if (!S.next(0, cur)) return;
    f32x4 acc[2][2][4][2];
#pragma unroll
    for (int a = 0; a < 2; ++a)
#pragma unroll
        for (int b = 0; b < 2; ++b)
#pragma unroll
            for (int m = 0; m < 4; ++m)
#pragma unroll
                for (int n = 0; n < 2; ++n) acc[a][b][m][n] = (f32x4){0.f, 0.f, 0.f, 0.f};
    bf16x8 At[4][2], B0[2][2], B1[2][2];
    const char* cA = cur.A; const char* cB = cur.B;
    PG8_STAGE(PG8_SB(0, 0), cB, voffB); PG8_STAGE(PG8_SB(0, 1), cB + hsB, voffB); PG8_STAGE(PG8_SA(0, 0), cA, voffA); PG8_STAGE(PG8_SA(0, 1), cA + hsA, voffA);
    if (wr == 1) PG8_BAR;
    PG8_WAIT_V(2); PG8_BAR;
    PG8_STAGE(PG8_SB(1, 0), cB + kstep, voffB); PG8_STAGE(PG8_SA(1, 0), cA + kstep, voffA); PG8_STAGE(PG8_SB(1, 1), cB + hsB + kstep, voffB);
    PG8_WAIT_V(6); PG8_BAR;
    for (;;) {
        const bool has_next = S.next(ui + 1, nxt);
        const char* nA = has_next ? nxt.A : cA; const char* nB = has_next ? nxt.B : cB;
        for (int t = 0; t < nt; t += 2) {
            const bool last = (t == nt - 2);
            const char* a1 = cA + (size_t)(t + 1) * kstep;
            const char* a2 = last ? nA : cA + (size_t)(t + 2) * kstep; const char* b2 = last ? nB : cB + (size_t)(t + 2) * kstep;
            const char* a3 = a2 + kstep; const char* b3 = b2 + kstep;
            PG8_LDB(B0, 0, 0); PG8_LDB(B1, 0, 1); PG8_SCHED; PG8_LDA(At, 0, 0); PG8_STAGE(PG8_SA(1, 1), a1 + hsA, voffA);
            PG8_WAIT_V(8); PG8_WAIT_L(0); PG8_BAR; PG8_MMA(0, 0, At, B0); PG8_MMA(0, 1, At, B1); PG8_BAR; PG8_SCHED;
            PG8_LDA(At, 0, 1); PG8_STAGE(PG8_SB(0, 0), b2, voffB); PG8_STAGE(PG8_SB(0, 1), b2 + hsB, voffB); PG8_STAGE(PG8_SA(0, 0), a2, voffA);
            PG8_WAIT_V(8); PG8_WAIT_L(0); PG8_BAR; PG8_MMA(1, 0, At, B0); PG8_MMA(1, 1, At, B1); PG8_BAR; PG8_SCHED;
            PG8_LDB(B0, 1, 0); PG8_LDB(B1, 1, 1); PG8_SCHED; PG8_LDA(At, 1, 0); PG8_STAGE(PG8_SA(0, 1), a2 + hsA, voffA);
            PG8_WAIT_V(8); PG8_WAIT_L(0); PG8_BAR; PG8_MMA(0, 0, At, B0); PG8_MMA(0, 1, At, B1); PG8_BAR; PG8_SCHED;
            PG8_LDA(At, 1, 1); PG8_STAGE(PG8_SB(1, 0), b3, voffB); PG8_STAGE(PG8_SB(1, 1), b3 + hsB, voffB); PG8_STAGE(PG8_SA(1, 0), a3, voffA);
            PG8_WAIT_V(8); PG8_WAIT_L(0); PG8_BAR; PG8_MMA(1, 0, At, B0); PG8_MMA(1, 1, At, B1); PG8_BAR; PG8_SCHED;
        }
        if constexpr (ALIGN_EPI) { if (wr == 0) PG8_BAR; }
        E(acc, cur, wr, wc, fr, fq);
        if (!has_next) break;
        if (!(Epi::CHAIN && nxt.sub != 0)) {
#pragma unroll
            for (int a = 0; a < 2; ++a)
#pragma unroll
                for (int b = 0; b < 2; ++b)
#pragma unroll
                    for (int m = 0; m < 4; ++m)
#pragma unroll
                        for (int n = 0; n < 2; ++n) acc[a][b][m][n] = (f32x4){0.f, 0.f, 0.f, 0.f};
        }
        cur = nxt; cA = nA; cB = nB; ++ui;
        if constexpr (ALIGN_EPI) { if (wr == 1) PG8_BAR; }
    }
    PG8_WAIT_V(0);
    if constexpr (!ALIGN_EPI) { if (wr == 0) PG8_BAR; }
    PG8_BAR;
#undef PG8_SA
#undef PG8_SB
#undef PG8_STAGE
#undef PG8_LDA
#undef PG8_LDB
#undef PG8_MMA
#undef PG8_WAIT_V
#undef PG8_WAIT_L
#undef PG8_BAR
#undef PG8_SCHED
}

struct EpiProj {
    static constexpr bool PERM = true, CHAIN = false;
    bf16_t* pb; bf16_t* pa; float* ssq; float* sskv;
    __device__ __forceinline__ void operator()(AccT& acc, const Unit& u, int wr, int wc, int fr, int fq) const {
        const int row0 = u.pm * BM + wr * 64 + fr;
#pragma unroll
        for (int bj = 0; bj < 2; ++bj) {
            const int hk = u.pn * 2 + bj;
            bf16_t* base; int ld; float* ss = nullptr;
            if (hk < 22) { base = pb + hk * 128; ld = PB_LD; } else { const int ha = hk - 22; base = pa + ha * 128; ld = PA_LD; if (ha >= 6 && ha <= 8) ss = ssq; else if (ha == 9 || ha == 10) ss = sskv; }
            base += wc * 32 + 8 * fq;
#pragma unroll
            for (int ai = 0; ai < 2; ++ai)
#pragma unroll
                for (int m = 0; m < 4; ++m) { const int row = row0 + ai * HALF + m * 16; const f32x4 v0 = acc[ai][bj][m][0], v1 = acc[ai][bj][m][1];
                    u32x4 w; w.x = cvt_pk_bf16(v0[0], v0[1]); w.y = cvt_pk_bf16(v0[2], v0[3]); w.z = cvt_pk_bf16(v1[0], v1[1]); w.w = cvt_pk_bf16(v1[2], v1[3]);
                    *(u32x4*)(base + (size_t)row * ld) = w;
                    if (ss) { float s = (v0[0] * v0[0] + v0[1] * v0[1]) + (v0[2] * v0[2] + v0[3] * v0[3]) + (v1[0] * v1[0] + v1[1] * v1[1]) + (v1[2] * v1[2] + v1[3] * v1[3]);
                        s += __shfl_xor(s, 16); s += __shfl_xor(s, 32); if (fq == 0) atomicAdd(ss + row, s); } }
        }
    }
};
struct EpiQ {
    static constexpr bool PERM = false, CHAIN = false;
    bf16_t* Q; const float* ssq; const float* cs; const float* sn;
    __device__ __forceinline__ void operator()(AccT& acc, const Unit& u, int wr, int wc, int fr, int fq) const {
        const int row0 = u.pm * BM + wr * 64 + fr;
#pragma unroll
        for (int ai = 0; ai < 2; ++ai)
#pragma unroll
            for (int m = 0; m < 4; ++m) { const int row = row0 + ai * HALF + m * 16; const float rr = rsqrtf(ssq[row] * (1.f / 384.f) + EPS) * CQ;
#pragma unroll
                for (int bj = 0; bj < 2; ++bj) { const int G = u.pn * 8 + bj * 4 + wc;
                    f32x4 x0 = acc[ai][bj][m][0], x1 = acc[ai][bj][m][1];
                    if (G % 3 == 2) { const f32x4 c = *(const f32x4*)(cs + (size_t)row * 16 + 4 * fq), s = *(const f32x4*)(sn + (size_t)row * 16 + 4 * fq);
                        const f32x4 o0 = x0 * c - x1 * s, o1 = x1 * c + x0 * s; x0 = o0; x1 = o1; }
                    x0 = x0 * rr; x1 = x1 * rr;
                    bf16_t* p = Q + (size_t)row * 768 + G * 32 + 4 * fq;
                    u32x2 w0, w1; w0.x = cvt_pk_bf16(x0[0], x0[1]); w0.y = cvt_pk_bf16(x0[2], x0[3]); w1.x = cvt_pk_bf16(x1[0], x1[1]); w1.y = cvt_pk_bf16(x1[2], x1[3]);
                    *(u32x2*)p = w0; *(u32x2*)(p + 16) = w1; } }
    }
};
struct EpiKV {
    static constexpr bool PERM = true, CHAIN = false;
    bf16_t* Kb; bf16_t* Vb; const float* sskv;
    __device__ __forceinline__ void operator()(AccT& acc, const Unit& u, int wr, int wc, int fr, int fq) const {
        const int row0 = u.pm * BM + wr * 64 + fr;
#pragma unroll
        for (int ai = 0; ai < 2; ++ai)
#pragma unroll
            for (int m = 0; m < 4; ++m) { const int row = row0 + ai * HALF + m * 16; const float rr = rsqrtf(sskv[row] * (1.f / 256.f) + EPS);
#pragma unroll
                for (int bj = 0; bj < 2; ++bj) { const int head = u.pn * 2 + bj; const f32x4 v0 = acc[ai][bj][m][0] * rr, v1 = acc[ai][bj][m][1] * rr;
                    u32x4 w; w.x = cvt_pk_bf16(v0[0], v0[1]); w.y = cvt_pk_bf16(v0[2], v0[3]); w.z = cvt_pk_bf16(v1[0], v1[1]); w.w = cvt_pk_bf16(v1[2], v1[3]);
                    bf16_t* p = (wc < 2) ? Kb + (size_t)row * 768 + head * 96 + wc * 32 + 8 * fq : Vb + (size_t)row * 512 + head * 64 + (wc - 2) * 32 + 8 * fq;
                    *(u32x4*)p = w; } }
    }
};
struct EpiMerge {
    static constexpr bool PERM = true, CHAIN = true;
    const bf16_t* pb; bf16_t* merged;
    __device__ __forceinline__ void operator()(AccT& acc, const Unit& u, int wr, int wc, int fr, int fq) const {
        const int row0 = u.pm * BM + wr * 64 + fr, col0 = u.pn * BM + wc * 32 + 8 * fq;
#pragma unroll
        for (int ai = 0; ai < 2; ++ai)
#pragma unroll
            for (int m = 0; m < 4; ++m) { const int row = row0 + ai * HALF + m * 16;
#pragma unroll
                for (int bj = 0; bj < 2; ++bj) { const int col = col0 + bj * HALF;
                    const u32x4 gb = *(const u32x4*)(pb + (size_t)row * PB_LD + PB_BR + 1024 + col);
                    float sb[8];
#pragma unroll
                    for (int e = 0; e < 4; ++e) { sb[2 * e] = sigmoidf_(__uint_as_float(gb[e] << 16)); sb[2 * e + 1] = sigmoidf_(__uint_as_float(gb[e] & 0xffff0000u)); }
                    if (u.sub == 0) {
                        const u32x4 ga = *(const u32x4*)(pb + (size_t)row * PB_LD + PB_BR + col);
                        float sa[8];
#pragma unroll
                        for (int e = 0; e < 4; ++e) { sa[2 * e] = sigmoidf_(__uint_as_float(ga[e] << 16)); sa[2 * e + 1] = sigmoidf_(__uint_as_float(ga[e] & 0xffff0000u)); }
#pragma unroll
                        for (int e = 0; e < 4; ++e) { acc[ai][bj][m][0][e] *= sa[e] / sb[e]; acc[ai][bj][m][1][e] *= sa[4 + e] / sb[4 + e]; }
                    } else {
                        const f32x4 v0 = acc[ai][bj][m][0], v1 = acc[ai][bj][m][1];
                        u32x4 w; w.x = cvt_pk_bf16(v0[0] * sb[0], v0[1] * sb[1]); w.y = cvt_pk_bf16(v0[2] * sb[2], v0[3] * sb[3]); w.z = cvt_pk_bf16(v1[0] * sb[4], v1[1] * sb[5]); w.w = cvt_pk_bf16(v1[2] * sb[6], v1[3] * sb[7]);
                        *(u32x4*)(merged + (size_t)row * DM + col) = w; } } }
    }
};
struct EpiX1 {
    static constexpr bool PERM = false, CHAIN = false;
    const float* x; float* x1; bf16_t* x1b; float* ssx1;
    __device__ __forceinline__ void operator()(AccT& acc, const Unit& u, int wr, int wc, int fr, int fq) const {
        const int row0 = u.pm * BM + wr * 64 + fr, col0 = u.pn * BM + wc * 32 + 4 * fq;
#pragma unroll
        for (int ai = 0; ai < 2; ++ai)
#pragma unroll
            for (int m = 0; m < 4; ++m) { const int row = row0 + ai * HALF + m * 16; const size_t off = (size_t)row * DM + col0; float s = 0.f;
#pragma unroll
                for (int bj = 0; bj < 2; ++bj)
#pragma unroll
                    for (int n = 0; n < 2; ++n) { const size_t o = off + bj * HALF + n * 16; const f32x4 v = *(const f32x4*)(x + o) + acc[ai][bj][m][n];
                        *(f32x4*)(x1 + o) = v; u32x2 w; w.x = cvt_pk_bf16(v[0], v[1]); w.y = cvt_pk_bf16(v[2], v[3]); *(u32x2*)(x1b + o) = w;
                        s += (v[0] * v[0] + v[1] * v[1]) + (v[2] * v[2] + v[3] * v[3]); }
                s += __shfl_xor(s, 16); s += __shfl_xor(s, 32); if (fq == 0) atomicAdd(ssx1 + row, s); }
    }
};
struct EpiQP {
    static constexpr bool PERM = true, CHAIN = false;
    bf16_t* qp; const float* ssx1;
    __device__ __forceinline__ void operator()(AccT& acc, const Unit& u, int wr, int wc, int fr, int fq) const {
        const int row0 = u.pm * BM + wr * 64 + fr, col0 = u.pn * BM + wc * 32 + 8 * fq;
#pragma unroll
        for (int ai = 0; ai < 2; ++ai)
#pragma unroll
            for (int m = 0; m < 4; ++m) { const int row = row0 + ai * HALF + m * 16; const float rr = rsqrtf(ssx1[row] * (1.f / 1024.f) + EPS);
#pragma unroll
                for (int bj = 0; bj < 2; ++bj) { const f32x4 v0 = acc[ai][bj][m][0] * rr, v1 = acc[ai][bj][m][1] * rr;
                    u32x4 w; w.x = cvt_pk_bf16(v0[0], v0[1]); w.y = cvt_pk_bf16(v0[2], v0[3]); w.z = cvt_pk_bf16(v1[0], v1[1]); w.w = cvt_pk_bf16(v1[2], v1[3]);
                    *(u32x4*)(qp + (size_t)row * 2048 + col0 + bj * HALF) = w; } }
    }
};
}


namespace att {
typedef short bf16x8 __attribute__((ext_vector_type(8)));
typedef short s16x4 __attribute__((ext_vector_type(4)));
typedef float f32x16 __attribute__((ext_vector_type(16)));
constexpr int NW = 8, QBLK = 32, KVBLK = 64, QB = NW * QBLK;
constexpr int QS = 768, KS = 768, VS = 512, OS = 512;
constexpr int SHM_V = KVBLK * 64 * 2, SHM_K = KVBLK * 256;
constexpr int LDS_BYTES = 2 * SHM_V + 2 * SHM_K + NW * 64 * 4;
constexpr float THR = 8.f;
#define KSWZ(row, colB) ((row) * 256 + ((colB) ^ (((row) & 7) << 4)))
#define SBAR() __builtin_amdgcn_sched_barrier(0)
__device__ __forceinline__ int v_st(int k, int c) { const int kk = (k & ~0xC) | ((k & 4) << 1) | ((k & 8) >> 1); return ((kk >> 3) * 2 + (c >> 5)) * 512 + ((kk & 7) * 32 + (c & 31)) * 2; }
__device__ __forceinline__ int v_rd_base(int lane) { return ((lane & 3) << 3) | (((lane >> 2) & 3) << 6) | (((lane >> 4) & 1) << 5) | (((lane >> 5) & 1) << 8); }
constexpr int v_rd_off(int d0, int ks, int half) { return d0 * 512 + ks * 2048 + half * 1024; }
__device__ __forceinline__ int crow(int r, int hi) { return (r & 3) + 8 * (r >> 2) + 4 * hi; }
__device__ __forceinline__ unsigned cvtpk(float lo, float hi) { unsigned r; asm volatile("v_cvt_pk_bf16_f32 %0, %1, %2" : "=v"(r) : "v"(lo), "v"(hi)); return r; }
__device__ __forceinline__ bf16x8 load8(const bf16_t* p) { return *reinterpret_cast<const bf16x8*>(p); }
__device__ __forceinline__ void partialSM(f32x16& p0, f32x16& p1, float& m_reg, float& mn, float& alpha) {
    float pmax = p0[0]; for (int r = 1; r < 16; ++r) pmax = fmaxf(pmax, p0[r]); for (int r = 0; r < 16; ++r) pmax = fmaxf(pmax, p1[r]);
    { auto rr = __builtin_amdgcn_permlane32_swap(__float_as_uint(pmax), __float_as_uint(pmax), false, false);
      pmax = fmaxf(__uint_as_float(rr[0]), __uint_as_float(rr[1])); }
    if (__builtin_expect(__all((pmax - m_reg) <= THR), 1)) { mn = m_reg; alpha = 1.f; }
    else { mn = fmaxf(m_reg, pmax); alpha = __builtin_amdgcn_exp2f(m_reg - mn); m_reg = mn; }
    for (int r = 0; r < 16; ++r) p0[r] = p0[r] - mn; for (int r = 0; r < 16; ++r) p1[r] = p1[r] - mn;
    for (int r = 0; r < 16; ++r) p0[r] = __builtin_amdgcn_exp2f(p0[r]);
}
__device__ __forceinline__ void finishSM(f32x16& p0, f32x16& p1, float alpha, float& l_reg, bf16x8& pa0, bf16x8& pa1, bf16x8& pa2, bf16x8& pa3) {
    for (int r = 0; r < 16; ++r) p1[r] = __builtin_amdgcn_exp2f(p1[r]);
    float ps = 0; for (int r = 0; r < 16; ++r) ps += p0[r]; for (int r = 0; r < 16; ++r) ps += p1[r];
    { auto rr = __builtin_amdgcn_permlane32_swap(__float_as_uint(ps), __float_as_uint(ps), false, false);
      ps = __uint_as_float(rr[0]) + __uint_as_float(rr[1]); }
    l_reg = l_reg * alpha + ps;
#define PK4(P, B_, OUT) do { unsigned a0 = cvtpk(P[B_+0], P[B_+1]), a1 = cvtpk(P[B_+2], P[B_+3]);                          \
        unsigned b0 = cvtpk(P[B_+4], P[B_+5]), b1 = cvtpk(P[B_+6], P[B_+7]);                                             \
        auto r0 = __builtin_amdgcn_permlane32_swap(a0, b0, false, false); auto r1 = __builtin_amdgcn_permlane32_swap(a1, b1, false, false); \
        u32x4 w = {r0[0], r1[0], r0[1], r1[1]}; OUT = *reinterpret_cast<bf16x8*>(&w); } while (0)
    PK4(p0, 0, pa0); PK4(p0, 8, pa1); PK4(p1, 0, pa2); PK4(p1, 8, pa3);
#undef PK4
}
template <int KB>
__device__ __forceinline__ void qkt(f32x16& p0, f32x16& p1, const char* K_lds, int r32, int hi, const bf16x8* qr) {
    p0 = f32x16{}; p1 = f32x16{};
    const char* kb[4];
#pragma unroll
    for (int dd = 0; dd < 4; ++dd) kb[dd] = K_lds + KB * SHM_K + KSWZ(r32, (dd * 16 + hi * 8) * 2);
#pragma unroll
    for (int d0 = 0; d0 < 6; ++d0) { const char* a = kb[d0 & 3] + (d0 >> 2) * 128;
        bf16x8 b0 = *reinterpret_cast<const bf16x8*>(a);
        bf16x8 b1 = *reinterpret_cast<const bf16x8*>(a + 32 * 256);
        p0 = __builtin_amdgcn_mfma_f32_32x32x16_bf16(b0, qr[d0], p0, 0, 0, 0);
        p1 = __builtin_amdgcn_mfma_f32_32x32x16_bf16(b1, qr[d0], p1, 0, 0, 0); }
}
template <int VB>
__device__ __forceinline__ void pv_tile(f32x16* o, int vb0, bf16x8 pa0, bf16x8 pa1, bf16x8 pa2, bf16x8 pa3) {
#define TRRD(dst, off) asm volatile("ds_read_b64_tr_b16 %0, %1 offset:%2" : "=&v"(dst) : "v"(vb0), "i"(off) : "memory")
#define PV_D0(d0) do { s16x4 l0, l1, l2, l3, h0, h1, h2, h3; constexpr int b_ = VB * SHM_V + v_rd_off(d0, 0, 0);   \
        TRRD(l0, b_); TRRD(h0, b_ + 1024); TRRD(l1, b_ + 2048); TRRD(h1, b_ + 3072); TRRD(l2, b_ + 4096); TRRD(h2, b_ + 5120); TRRD(l3, b_ + 6144); TRRD(h3, b_ + 7168); \
        asm volatile("s_waitcnt lgkmcnt(0)" ::: "memory"); SBAR();   \
        o[d0] = __builtin_amdgcn_mfma_f32_32x32x16_bf16(pa0, (bf16x8){l0[0], l0[1], l0[2], l0[3], h0[0], h0[1], h0[2], h0[3]}, o[d0], 0, 0, 0);   \
        o[d0] = __builtin_amdgcn_mfma_f32_32x32x16_bf16(pa1, (bf16x8){l1[0], l1[1], l1[2], l1[3], h1[0], h1[1], h1[2], h1[3]}, o[d0], 0, 0, 0);   \
        o[d0] = __builtin_amdgcn_mfma_f32_32x32x16_bf16(pa2, (bf16x8){l2[0], l2[1], l2[2], l2[3], h2[0], h2[1], h2[2], h2[3]}, o[d0], 0, 0, 0);   \
        o[d0] = __builtin_amdgcn_mfma_f32_32x32x16_bf16(pa3, (bf16x8){l3[0], l3[1], l3[2], l3[3], h3[0], h3[1], h3[2], h3[3]}, o[d0], 0, 0, 0); } while (0)
    PV_D0(0); PV_D0(1);
#undef PV_D0
#undef TRRD
}
struct BlockRef { const bf16_t* Q; const bf16_t* K; const bf16_t* V; bf16_t* O; int P0; };
struct Seam { bf16x8 qr[6]; bf16x8 st_v0, st_v1, st_k0, st_k1; };
#define ROWK(p, k0, rr) ((p) + (size_t)((k0) + (rr)) * KS + sc)
#define ROWV(p, k0, rr) ((p) + (size_t)((k0) + (rr)) * VS + sc)
#define VMW() asm volatile("s_waitcnt vmcnt(0)" ::: "memory")
#define VMWN(n) asm volatile("s_waitcnt vmcnt(%0)" :: "i"(n) : "memory")
#define SLOAD_H(Kp, Vp, k0) do { if (vact) { S.st_v0 = load8(ROWV(Vp, k0, sr)); S.st_v1 = load8(ROWV(Vp, k0, 32 + sr)); }              \
                                 if (kact) { S.st_k0 = load8(ROWK(Kp, k0, sr)); S.st_k1 = load8(ROWK(Kp, k0, 32 + sr)); } } while (0)
#define SWRITE_HK(bf) do { if (kact) { *(bf16x8*)(K_lds + (bf) * SHM_K + kws) = S.st_k0; *(bf16x8*)(K_lds + (bf) * SHM_K + kws + 32 * 256) = S.st_k1; } } while (0)
#define SWRITE_HV(bf) do { if (vact) { *(bf16x8*)(V_lds + (bf) * SHM_V + vst0) = S.st_v0; *(bf16x8*)(V_lds + (bf) * SHM_V + vst1) = S.st_v1; } } while (0)
#define SWRITE_H(bf) do { SWRITE_HV(bf); SWRITE_HK(bf); } while (0)
__device__ __forceinline__ void attn_prime(const BlockRef& cur, char* lds, Seam& S) {
    const int tid = threadIdx.x, wid = __builtin_amdgcn_readfirstlane(tid >> 6), lane = tid & 63, r32 = lane & 31, hi = lane >> 5;
    const int sr = tid >> 4, sc = (tid & 15) * 8, kws = KSWZ(sr, sc * 2); char* K_lds = lds + 2 * SHM_V;
    const bool kact = (tid & 15) < 12, vact = (tid & 15) < 8;
#pragma unroll
    for (int d0 = 0; d0 < 6; ++d0) S.qr[d0] = load8(cur.Q + (size_t)(wid * QBLK + r32) * QS + d0 * 16 + hi * 8);
    SLOAD_H(cur.K, cur.V, 0); VMW(); SWRITE_HK(0);
    __syncthreads();
}
__device__ __forceinline__ void attn_block(const BlockRef& cur, const BlockRef& nxt, char* lds, Seam& S) {
    const int tid = threadIdx.x, wid = __builtin_amdgcn_readfirstlane(tid >> 6), lane = tid & 63, r32 = lane & 31, hi = lane >> 5;
    const int NT = (cur.P0 + QB - 1) / KVBLK + 1;
    const int qlo = cur.P0 + wid * QBLK;
    const int qvis = qlo | 63;
    char* V_lds = lds; char* K_lds = lds + 2 * SHM_V;
    float* ws = (float*)(lds + 2 * SHM_V + 2 * SHM_K) + wid * 64; float* li_l = ws, * al_l = ws + 32;
    float m_reg = -1e30f, l_reg = 0; f32x16 o[2] = {};
    const int sr = tid >> 4, sc = (tid & 15) * 8, vst0 = v_st(sr, sc & 63), vst1 = v_st(32 + sr, sc & 63), kws = KSWZ(sr, sc * 2);
    const bool kact = (tid & 15) < 12, vact = (tid & 15) < 8;
    const int vb0 = (int)(uintptr_t)V_lds + v_rd_base(lane);
    const bf16_t* Kh = cur.K; const bf16_t* Vh = cur.V;
#define RESC(a) do { if (__any((a) < 1.f)) { if (hi == 0) al_l[r32] = (a); asm volatile("s_waitcnt lgkmcnt(0)" ::: "memory");              \
                     for (int d_ = 0; d_ < 2; ++d_) for (int r = 0; r < 16; ++r) o[d_][r] *= al_l[crow(r, hi)]; } } while (0)
#define KBASE(t) ((t) * KVBLK)
#define MASKT(P0_, P1_, t) do { if (KBASE(t) > qvis) { const float NEG_ = -__builtin_inff(); _Pragma("unroll") for (int r = 0; r < 16; ++r) { P0_[r] = NEG_; P1_[r] = NEG_; } } } while (0)
    constexpr int NQL = 6;
#define SEAM_K0() do { VMWN(NQL); SWRITE_HK(0); SBAR(); } while (0)
    f32x16 pA0, pA1, pB0, pB1; float mnA, mnB, alA, alB; bf16x8 pa0, pa1, pa2, pa3;
    SWRITE_HV(0); SBAR();
    if (NT > 1) { SLOAD_H(Kh, Vh, KBASE(1)); }
    SBAR(); qkt<0>(pA0, pA1, K_lds, r32, hi, S.qr);
    MASKT(pA0, pA1, 0); partialSM(pA0, pA1, m_reg, mnA, alA);
    if (NT > 1) { VMW(); SWRITE_H(1); }
    __syncthreads();
#define HALF_STEP(PX0, PX1, mnX, alX, PY0, PY1, alY, t, KB, VB, SB) do {                                                      \
        SBAR(); qkt<KB>(PX0, PX1, K_lds, r32, hi, S.qr);                                             \
        finishSM(PY0, PY1, alY, l_reg, pa0, pa1, pa2, pa3); SBAR();                                                           \
        if ((t) + 1 < NT) { SLOAD_H(Kh, Vh, KBASE((t) + 1)); SBAR(); }                                               \
        pv_tile<VB>(o, vb0, pa0, pa1, pa2, pa3); MASKT(PX0, PX1, (t)); partialSM(PX0, PX1, m_reg, mnX, alX);                                        \
        __syncthreads();                                                                                                      \
        if ((t) + 1 < NT) { VMW(); SWRITE_H(SB); }                                                                          \
        RESC(alX); __syncthreads(); } while (0)
    for (int t = 1; t + 1 < NT; t += 2) {
        HALF_STEP(pB0, pB1, mnB, alB, pA0, pA1, alA, t, 1, 0, 0);
        HALF_STEP(pA0, pA1, mnA, alA, pB0, pB1, alB, t + 1, 0, 1, 1);
    }
    const bool even = (NT & 1) == 0;
    if (even) { SBAR(); qkt<1>(pB0, pB1, K_lds, r32, hi, S.qr); SBAR(); }
    SLOAD_H(nxt.K, nxt.V, 0); SBAR();
#pragma unroll
    for (int d0 = 0; d0 < 6; ++d0) S.qr[d0] = load8(nxt.Q + (size_t)(wid * QBLK + r32) * QS + d0 * 16 + hi * 8);
    SBAR();
    finishSM(pA0, pA1, alA, l_reg, pa0, pa1, pa2, pa3); SBAR();
    pv_tile<0>(o, vb0, pa0, pa1, pa2, pa3);
    if (even) { MASKT(pB0, pB1, NT - 1); partialSM(pB0, pB1, m_reg, mnB, alB); __syncthreads(); RESC(alB);
        finishSM(pB0, pB1, alB, l_reg, pa0, pa1, pa2, pa3); SBAR(); pv_tile<1>(o, vb0, pa0, pa1, pa2, pa3); }
    SBAR(); SEAM_K0();
    if (hi == 0) li_l[r32] = l_reg; asm volatile("s_waitcnt lgkmcnt(0)" ::: "memory");
    float rli[16];
#pragma unroll
    for (int r = 0; r < 16; ++r) rli[r] = __builtin_amdgcn_rcpf(li_l[crow(r, hi)]);
    bf16_t* Ow = cur.O + (size_t)(wid * QBLK) * OS;
#pragma unroll
    for (int r = 0; r < 16; ++r) { const int orow = crow(r, hi);
#pragma unroll
        for (int d0 = 0; d0 < 2; ++d0) { const float v = o[d0][r] * rli[r];
            const float vn = __shfl_xor(v, 1);
            if ((r32 & 1) == 0) *(unsigned*)(Ow + (size_t)orow * OS + d0 * 32 + r32) = cvtpk(v, vn); } }
    __syncthreads();
#undef RESC
#undef KBASE
#undef MASKT
#undef SEAM_K0
#undef HALF_STEP
}
#undef ROWK
#undef ROWV
#undef VMW
#undef VMWN
#undef SLOAD_H
#undef SWRITE_HK
#undef SWRITE_HV
#undef SWRITE_H
#undef KSWZ
#undef SBAR
}

#define XB_TMO      128
#define XB_XCNT(j)  (256  + 64 * (j))
#define XB_XSUB(j)  (1280 + 64 * (j))
#define XB_XGEN(j)  (2304 + 64 * (j))
#define XB_TOP      3328
#define XB_TOPGEN   3392
#define XCD_BAR_WORDS 3456
#define XB_SPIN_CAP (1u << 18)
__device__ __forceinline__ unsigned xb_ld(unsigned* p)              { return __hip_atomic_load(p, __ATOMIC_RELAXED, __HIP_MEMORY_SCOPE_AGENT); }
__device__ __forceinline__ unsigned xb_add(unsigned* p, unsigned v) { return __hip_atomic_fetch_add(p, v, __ATOMIC_RELAXED, __HIP_MEMORY_SCOPE_AGENT); }
__device__ __forceinline__ unsigned xb_xcc_id() { return (unsigned)__builtin_amdgcn_s_getreg((3 << 11) | 20) & 0xFu; }
#define XB_SPIN(cond, bar) do { unsigned _sp = 0; while (cond) { __builtin_amdgcn_s_sleep(1); \
    if ((++_sp & 255u) == 0u) { if (xb_ld(&(bar)[XB_TMO])) break; if (_sp > XB_SPIN_CAP) { atomicAdd(&(bar)[XB_TMO], 1u); break; } } } } while (0)
struct XcdBarrier { unsigned* bar; unsigned x; volatile LAS unsigned* st; };
__device__ __forceinline__ XcdBarrier xcd_barrier_post(unsigned* bar, volatile LAS unsigned* st) {
    XcdBarrier b; b.bar = bar; b.x = xb_xcc_id(); b.st = st;
    if (threadIdx.x == 0) (void)xb_add(&bar[XB_XCNT(b.x)], 1u);
    return b;
}
__device__ __forceinline__ void xcd_barrier_complete(unsigned* bar, unsigned x, unsigned& nloc, unsigned& nx) {
    const unsigned G = gridDim.x * gridDim.y * gridDim.z;
    unsigned sum, cnt, mine, sp = 0u;
    for (;;) {
        sum = 0u; cnt = 0u; mine = 0u;
#pragma unroll
        for (unsigned j = 0; j < 16; ++j) { const unsigned c = xb_ld(&bar[XB_XCNT(j)]); sum += c; cnt += (c > 0u) ? 1u : 0u; mine = (j == x) ? c : mine; }
        if (sum == G) break;
        __builtin_amdgcn_s_sleep(1);
        if ((++sp & 255u) == 0u) { if (xb_ld(&bar[XB_TMO])) break; if (sp > XB_SPIN_CAP) { atomicAdd(&bar[XB_TMO], 1u); break; } }
    }
    nloc = mine > 0u ? mine : 1u; nx = cnt > 0u ? cnt : 1u;
}
__device__ __forceinline__ void xcd_barrier(const XcdBarrier& b) {
    asm volatile("s_waitcnt vmcnt(0)" ::: "memory");
    __syncthreads();
    if (threadIdx.x == 0) {
        unsigned* bar = b.bar;
        __builtin_amdgcn_s_waitcnt(0);
        unsigned nloc = b.st[0], nx = b.st[1];
        if (nloc == 0u) { xcd_barrier_complete(bar, b.x, nloc, nx); b.st[0] = nloc; b.st[1] = nx; }
        const unsigned old = xb_add(&bar[XB_XSUB(b.x)], 1u);
        const unsigned gen = old / nloc;
        if (old + 1u == (gen + 1u) * nloc) {
            __builtin_amdgcn_fence(__ATOMIC_RELEASE, "agent");
            asm volatile("s_waitcnt vmcnt(0)" ::: "memory");
            const unsigned og = xb_add(&bar[XB_TOP], 1u);
            const unsigned tg = og / nx;
            if (og + 1u == (tg + 1u) * nx) xb_add(&bar[XB_TOPGEN], 1u);
            else XB_SPIN(xb_ld(&bar[XB_TOPGEN]) == tg, bar);
            __builtin_amdgcn_fence(__ATOMIC_ACQUIRE, "agent");
            xb_add(&bar[XB_XGEN(b.x)], 1u);
            asm volatile("s_waitcnt vmcnt(0)" ::: "memory");
        } else {
            XB_SPIN(xb_ld(&bar[XB_XGEN(b.x)]) == gen, bar);
            __builtin_amdgcn_fence(__ATOMIC_ACQUIRE, "agent");
            asm volatile("s_waitcnt vmcnt(0)" ::: "memory");
        }
    }
    __syncthreads();
}

constexpr int NWAVES = 8;
constexpr int RING_BYTES = 131072, LDSCTL_OFF = RING_BYTES, MISC_OFF = LDSCTL_OFF + 320, LDS_BYTES = 147456;
constexpr int CW_BAR = 4096;

struct Args { const void* in[20]; float* out; unsigned char* ws; int ph_lo, ph_hi; };

__device__ __forceinline__ int win_srccol(int n) {
    if (n < 2048) return 2224 + n;
    if (n < 2560) return 1712 + (n - 2048);
    if (n < 2816) return 672 + (n - 2560);
    if (n < 3328) return 1184 + (n - 2816);
    if (n < 3584) return 928 + (n - 3328);
    if (n < 3968) return 0 + (n - 3584);
    if (n < 4224) return 384 + (n - 3968);
    if (n < 4256) return 640 + (n - 4224);
    if (n < 4272) return 1696 + (n - 4256);
    return -1;
}
__device__ __forceinline__ void transpose_item(const float* __restrict__ W, int K, int Nsrc, bf16_t* __restrict__ WT, int Nout, const float* __restrict__ kscale, bool winperm, float* scr, int item, int lane) {
    const int nblk = Nout / 32, kb = item / nblk, nb = item % nblk, k0 = 64 * kb, n0 = 32 * nb;
    const int n = n0 + (lane & 31); const int sc = winperm ? win_srccol(n) : n;
#pragma unroll 8
    for (int i = 0; i < 32; ++i) { const int kk = 2 * i + (lane >> 5); float v = 0.f; if (sc >= 0) { v = W[(size_t)(k0 + kk) * Nsrc + sc]; if (kscale) v *= kscale[k0 + kk]; } scr[kk * 33 + (lane & 31)] = v; }
    asm volatile("s_waitcnt lgkmcnt(0)" ::: "memory");
    const int c = lane & 7;
#pragma unroll
    for (int j = 0; j < 4; ++j) { const int nn = (lane >> 3) + 8 * j; const float* s = scr + (8 * c) * 33 + nn;
        u32x4 o; o.x = pk2(s[0 * 33], s[1 * 33]); o.y = pk2(s[2 * 33], s[3 * 33]); o.z = pk2(s[4 * 33], s[5 * 33]); o.w = pk2(s[6 * 33], s[7 * 33]);
        *(u32x4*)(WT + (size_t)(n0 + nn) * K + k0 + 8 * c) = o; }
    asm volatile("s_waitcnt lgkmcnt(0)" ::: "memory");
}

#define TOPK_INSERT(tv, ti, vv, ii) do { float v_ = (vv); int i_ = (ii); \
    _Pragma("unroll") for (int q_ = 0; q_ < 16; ++q_) { const bool gt_ = (v_ > tv[q_]) || (v_ == tv[q_] && i_ < ti[q_]); const float tv_ = tv[q_]; const int ti_ = ti[q_]; \
        tv[q_] = gt_ ? v_ : tv_; ti[q_] = gt_ ? i_ : ti_; v_ = gt_ ? tv_ : v_; i_ = gt_ ? ti_ : i_; } } while (0)

typedef __bf16 bf2_t __attribute__((ext_vector_type(2)));
__device__ __forceinline__ float dot2_bf16(unsigned a, unsigned b, float acc) { return __builtin_amdgcn_fdot2_f32_bf16(__builtin_bit_cast(bf2_t, a), __builtin_bit_cast(bf2_t, b), acc, false); }
__global__ void __launch_bounds__(NWAVES * 64, 2) fwd(Args args) {
    extern __shared__ __attribute__((aligned(16))) unsigned char lds[];
    const int tid = threadIdx.x, lane = tid & 63, wave = __builtin_amdgcn_readfirstlane(tid >> 6);
    const int G = gridDim.x; int vcu; { const int bx = blockIdx.x; vcu = (G % 8 == 0) ? (bx % 8) * (G / 8) + bx / 8 : bx; }
    const int gw = vcu * NWAVES + wave, NGW = G * NWAVES, gtid = vcu * 512 + tid, NT = G * 512;
    unsigned char* ws = args.ws;
    const float* x = (const float*)args.in[0]; const int* positions = (const int*)args.in[1];
    const float* g_mix = (const float*)args.in[2]; const float* w_in = (const float*)args.in[3]; const float* g_q_lat = (const float*)args.in[4]; const float* w_qb = (const float*)args.in[5];
    const float* g_kv_lat = (const float*)args.in[6]; const float* w_kvb = (const float*)args.in[7]; const float* w_a2 = (const float*)args.in[8]; const float* b_a2 = (const float*)args.in[9];
    const float* g_gla = (const float*)args.in[10]; const float* w_branch_a = (const float*)args.in[11]; const float* w_branch_b = (const float*)args.in[12]; const float* w_out = (const float*)args.in[13];
    const float* g_ffn = (const float*)args.in[14]; const float* w_peer_q = (const float*)args.in[15]; const float* sub_keys = (const float*)args.in[16]; const float* peer_u = (const float*)args.in[17];
    const float* peer_v = (const float*)args.in[18]; const float* g_final = (const float*)args.in[19];
    float* out = args.out;
    float* SSQ = (float*)(ws + WS_SSQ); float* SSKV = (float*)(ws + WS_SSKV); float* SSX1 = (float*)(ws + WS_SSX1); float* COS = (float*)(ws + WS_COS); float* SIN = (float*)(ws + WS_SIN);
    float* DECAY = (float*)(ws + WS_DECAY);
    bf16_t* WIN = (bf16_t*)(ws + WS_WIN); bf16_t* WQB = (bf16_t*)(ws + WS_WQB); bf16_t* WKVB = (bf16_t*)(ws + WS_WKVB); bf16_t* WA = (bf16_t*)(ws + WS_WA); bf16_t* WB = (bf16_t*)(ws + WS_WB);
    bf16_t* WOUT = (bf16_t*)(ws + WS_WOUT); bf16_t* WPQ = (bf16_t*)(ws + WS_WPQ); bf16_t* KEYS = (bf16_t*)(ws + WS_KEYS);
    bf16_t* PROJB = (bf16_t*)(ws + WS_PROJB); bf16_t* PROJA = (bf16_t*)(ws + WS_PROJA); bf16_t* XN = (bf16_t*)(ws + WS_XN);
    bf16_t* Q = (bf16_t*)(ws + WS_Q); bf16_t* K = (bf16_t*)(ws + WS_K); bf16_t* V = (bf16_t*)(ws + WS_V); float* DST = (float*)(ws + WS_DST);
    bf16_t* YA = (bf16_t*)(ws + WS_YA); bf16_t* YB = (bf16_t*)(ws + WS_YB); bf16_t* MERGED = (bf16_t*)(ws + WS_MERGED); bf16_t* X1B = (bf16_t*)(ws + WS_X1B); bf16_t* QP = (bf16_t*)(ws + WS_QP);
    int* EIDX = (int*)(ws + WS_EIDX); float* EGATE = (float*)(ws + WS_EGATE); bf16_t* UT = (bf16_t*)(ws + WS_UT); bf16_t* VT = (bf16_t*)(ws + WS_VT);

    for (int u = tid; u < (LDS_BYTES - LDSCTL_OFF) / 4; u += NWAVES * 64) ((unsigned*)(lds + LDSCTL_OFF))[u] = 0u;
    __syncthreads();
    XcdBarrier bar; bar.bar = (unsigned*)(ws + WS_CTL) + CW_BAR; bar.x = 0; bar.st = nullptr;
    if (MK_N_LAUNCHES == 1) bar = xcd_barrier_post((unsigned*)(ws + WS_CTL) + CW_BAR, (volatile LAS unsigned*)(lds + MISC_OFF) + 8);
    const int lo = args.ph_lo, hi = args.ph_hi;
#define IN(k) (lo <= (k) && (k) < hi)
#define SEAM(k) do { if (MK_N_LAUNCHES == 1) { if (IN(k) && IN((k) + 1)) xcd_barrier(bar); } } while (0)
    PG8_LAS unsigned char* ring = (PG8_LAS unsigned char*)lds;

    if (IN(0)) {
        for (int i = gtid; i < 3 * M_; i += NT) SSQ[i] = 0.f;
        float* scr = (float*)(lds + wave * 16384);
        constexpr int I_WIN = 16 * (NPROJ / 32), I_QB = 6 * 24, I_KVB = 4 * 32, I_A = 8 * 32, I_OUT = 16 * 32, I_PQ = 16 * 64;
        constexpr int NITEMS = I_WIN + I_QB + I_KVB + 2 * I_A + I_OUT + I_PQ;
        for (int it = gw; it < NITEMS; it += NGW) {
            int r = it;
            if (r < I_WIN) { transpose_item(w_in, 1024, 4272, WIN, NPROJ, nullptr, true, scr, r, lane); continue; } r -= I_WIN;
            if (r < I_QB) { transpose_item(w_qb, 384, 768, WQB, 768, g_q_lat, false, scr, r, lane); continue; } r -= I_QB;
            if (r < I_KVB) { transpose_item(w_kvb, 256, 1024, WKVB, 1024, g_kv_lat, false, scr, r, lane); continue; } r -= I_KVB;
            if (r < I_A) { transpose_item(w_branch_a, 512, 1024, WA, 1024, nullptr, false, scr, r, lane); continue; } r -= I_A;
            if (r < I_A) { transpose_item(w_branch_b, 512, 1024, WB, 1024, nullptr, false, scr, r, lane); continue; } r -= I_A;
            if (r < I_OUT) { transpose_item(w_out, 1024, 1024, WOUT, 1024, nullptr, false, scr, r, lane); continue; } r -= I_OUT;
            transpose_item(w_peer_q, 1024, 2048, WPQ, 2048, g_ffn, false, scr, r, lane);
        }
        for (int i = gtid; i < 16 * 128 * 128; i += NT) KEYS[i] = f2bf(sub_keys[i]);
        for (int i = gtid; i < M_ * 16; i += NT) { const int m = i >> 4, f = i & 15;
            const double inv = pow(10000.0, -(double)f / 16.0); const double ang = (double)positions[m] * inv;
            COS[i] = (float)cos(ang); SIN[i] = (float)sin(ang); }
        for (int row = gw; row < M_; row += NGW) {
            const f32x4* xr = (const f32x4*)(x + (size_t)row * DM); f32x4 v[4]; float ss = 0.f;
#pragma unroll
            for (int j = 0; j < 4; ++j) { v[j] = xr[lane + 64 * j]; ss += (v[j][0] * v[j][0] + v[j][1] * v[j][1]) + (v[j][2] * v[j][2] + v[j][3] * v[j][3]); }
            ss = wave_sum(ss); const float r = rsqrtf(ss * (1.f / DM) + EPS);
#pragma unroll
            for (int j = 0; j < 4; ++j) { const int c = 4 * (lane + 64 * j); const f32x4 gg = *(const f32x4*)(g_mix + c);
                u32x2 w; w.x = pk2(v[j][0] * r * gg[0], v[j][1] * r * gg[1]); w.y = pk2(v[j][2] * r * gg[2], v[j][3] * r * gg[3]);
                *(u32x2*)(XN + (size_t)row * DM + c) = w; }
        }
    }
    SEAM(0);
    if (IN(1)) {
        pg8::Gemm g{XN, WIN, nullptr, nullptr, DM, DM, M_, NPROJ, DM, 1}; pg8::StaticOrder S; S.init(g, G, (int)blockIdx.x);
        pg8::EpiProj E{PROJB, PROJA, SSQ, SSKV};
        pg8::gemm_phase<pg8::EpiProj, pg8::StaticOrder, true>(ring, g, S, E);
    }
    SEAM(1);
    if (IN(2)) {
        { pg8::Gemm g{PROJA + PA_QLAT, WQB, nullptr, nullptr, PA_LD, 384, M_, 768, 384, 1}; pg8::StaticOrder S; S.init(g, G, (int)blockIdx.x);
          pg8::EpiQ E{Q, SSQ, COS, SIN}; pg8::gemm_phase<pg8::EpiQ, pg8::StaticOrder, true>(ring, g, S, E); }
        { pg8::Gemm g{PROJA + PA_KVLAT, WKVB, nullptr, nullptr, PA_LD, 256, M_, 1024, 256, 1}; pg8::StaticOrder S; S.init(g, G, (int)blockIdx.x);
          pg8::EpiKV E{K, V, SSKV}; pg8::gemm_phase<pg8::EpiKV, pg8::StaticOrder, true>(ring, g, S, E); }
        for (int i = gtid; i < M_ * 32; i += NT) { const int m = i >> 5, j = i & 31; const bf16_t* kr = PROJA + (size_t)m * PA_LD + PA_KROPE; float o;
            if (j < 16) { const float x1 = bf2f(kr[j]), x2 = bf2f(kr[j + 16]); o = x1 * COS[m * 16 + j] - x2 * SIN[m * 16 + j]; }
            else { const int f = j - 16; const float x2 = bf2f(kr[j]), x1 = bf2f(kr[j - 16]); o = x2 * COS[m * 16 + f] + x1 * SIN[m * 16 + f]; }
            const bf16_t ob = f2bf(o);
#pragma unroll
            for (int h = 0; h < 8; ++h) K[(size_t)m * 768 + h * 96 + 64 + j] = ob; }
        __syncthreads();
        {
            const int half = tid >> 8, t256 = tid & 255;
            float* lb = (float*)(lds + half * 65536);
            float (*cum)[64] = (float (*)[64])lb; float (*kd)[64] = (float (*)[64])(lb + 4096); float (*gvs)[128] = (float (*)[128])(lb + 8192);
            for (int vb0 = vcu * 2; vb0 < 2 * NCH * 4; vb0 += 2 * G) {
                const int vb = vb0 + half; const int h = vb & 3, bc = vb >> 2, t0 = bc * 64;
                { const int k = t256 & 63; float w[16];
#pragma unroll
                  for (int r = 0; r < 16; ++r) w[r] = w_a2[r * 256 + h * 64 + k];
                  const float bias = b_a2[h * 64 + k];
#pragma unroll 1
                  for (int l = t256 >> 6; l < 64; l += 4) { const bf16_t* gl = PROJA + (size_t)(t0 + l) * PA_LD + PA_GLR; float z = bias;
#pragma unroll
                      for (int r = 0; r < 16; ++r) z += bf2f(gl[r]) * w[r];
                      const float ls = fminf(z, 0.f) - log1pf(expf(-fabsf(z))); cum[l][k] = ls * (1.f / 16.f); } }
                __syncthreads();
                if (t256 < 64) { float s = 0.f; for (int l = 0; l < 64; ++l) { s += cum[l][t256]; cum[l][t256] = s; } }
                __syncthreads();
#pragma unroll 2
                for (int i = t256; i < 64 * 64; i += 256) { const int l = i >> 6, k = i & 63; kd[l][k] = bf2f(PROJA[(size_t)(t0 + l) * PA_LD + PA_GK + h * 64 + k]) * expf(cum[63][k] - cum[l][k]); }
#pragma unroll 4
                for (int i = t256; i < 64 * 128; i += 256) { const int l = i >> 7, v = i & 127; gvs[l][v] = bf2f(PROJA[(size_t)(t0 + l) * PA_LD + PA_GV + h * 128 + v]); }
                if (t256 < 64) DECAY[((size_t)bc * 4 + h) * 64 + t256] = expf(cum[63][t256]);
                __syncthreads();
                { const int v = t256 & 127, kb = (t256 >> 7) * 32;
                  for (int kk = 0; kk < 32; ++kk) { const int k = kb + kk; float s = 0.f;
                      for (int l = 0; l < 64; ++l) s += kd[l][k] * gvs[l][v];
                      DST[(((size_t)bc * 4 + h) * 64 + k) * 128 + v] = s; } }
                __syncthreads();
            }
        }
    }
    SEAM(2);
    if (IN(3)) {
        if (tid < 256) for (int i = vcu * 256 + tid; i < 65536; i += G * 256) {
            const int v = i & 127, k = (i >> 7) & 63, h = (i >> 13) & 3, b = i >> 15; float s = 0.f;
            float* dp = DST + (((size_t)b * NCH * 4 + h) * 64 + k) * 128 + v; const float* gp = DECAY + ((size_t)b * NCH * 4 + h) * 64 + k;
            for (int c0 = 0; c0 < NCH; c0 += 8) { float d[8], g[8];
#pragma unroll
                for (int j = 0; j < 8; ++j) { d[j] = dp[(size_t)(c0 + j) * 32768]; g[j] = gp[(size_t)(c0 + j) * 256]; }
#pragma unroll
                for (int j = 0; j < 8; ++j) { s = g[j] * s + d[j]; d[j] = s; }
#pragma unroll
                for (int j = 0; j < 8; ++j) dp[(size_t)(c0 + j) * 32768] = d[j]; } }
        __syncthreads();
        {
            for (int pr = vcu; pr < 256; pr += G) {
                const int bh = pr >> 4, s16 = pr & 15, b = bh >> 3, h = bh & 7;
                att::BlockRef r0, r1;
                const bf16_t* Kh = K + (size_t)b * SEQ * att::KS + h * 96; const bf16_t* Vh = V + (size_t)b * SEQ * att::VS + h * 64;
                const int qb0 = 31 - s16, qb1 = s16;
                r0.Q = Q + ((size_t)b * SEQ + qb0 * 256) * att::QS + h * 96; r0.O = YA + ((size_t)b * SEQ + qb0 * 256) * att::OS + h * 64; r0.K = Kh; r0.V = Vh; r0.P0 = qb0 * 256;
                r1.Q = Q + ((size_t)b * SEQ + qb1 * 256) * att::QS + h * 96; r1.O = YA + ((size_t)b * SEQ + qb1 * 256) * att::OS + h * 64; r1.K = Kh; r1.V = Vh; r1.P0 = qb1 * 256;
                att::Seam S;
                att::attn_prime(r0, (char*)lds, S);
                att::attn_block(r0, r1, (char*)lds, S);
                att::attn_block(r1, r1, (char*)lds, S);
            }
        }
    }
    SEAM(3);
    if (IN(4)) {
        const int half = tid >> 8, t256 = tid & 255;
        float* lb = (float*)(lds + half * 65536);
        float (*ss)[128] = (float (*)[128])lb; float (*qs)[65] = (float (*)[65])(lb + 8192);
        for (int vb0 = vcu * 2; vb0 < 2 * NCH * 4; vb0 += 2 * G) {
            const int vb = vb0 + half; const int h = vb & 3, bc = vb >> 2, t0 = bc * 64;
            const float* sp = DST + ((size_t)bc * 4 + h) * 64 * 128;
            for (int i = t256; i < 64 * 128; i += 256) ss[i >> 7][i & 127] = sp[i];
            for (int i = t256; i < 64 * 64; i += 256) { const int l = i >> 6, k = i & 63; qs[l][k] = bf2f(PROJB[(size_t)(t0 + l) * PB_LD + PB_GQ + h * 64 + k]) * 0.125f; }
            __syncthreads();
            { const int l = t256 >> 2, vg = t256 & 3; float o[32];
#pragma unroll
              for (int j = 0; j < 32; ++j) o[j] = 0.f;
              for (int k = 0; k < 64; ++k) { const float qv = qs[l][k];
#pragma unroll
                  for (int j = 0; j < 32; ++j) o[j] += qv * ss[k][vg * 32 + j]; }
              float s2 = 0.f;
#pragma unroll
              for (int j = 0; j < 32; ++j) s2 += o[j] * o[j];
              s2 += __shfl_xor(s2, 1); s2 += __shfl_xor(s2, 2);
              const float r = rsqrtf(s2 * (1.f / 128.f) + EPS);
#pragma unroll
              for (int j = 0; j < 32; ++j) { const int v = vg * 32 + j; const float go = bf2f(PROJB[(size_t)(t0 + l) * PB_LD + PB_GOUT + h * 128 + v]); const float silu = go / (1.f + __expf(-go));
                  YB[(size_t)(t0 + l) * 512 + h * 128 + v] = f2bf(o[j] * r * g_gla[h * 128 + v] * silu); } }
            __syncthreads();
        }
    }
    if (IN(4)) {
        for (size_t i = (size_t)gtid * 8; i < (size_t)16384 * 1024; i += (size_t)NT * 8) { const int d = (int)(i & 1023);
            const f32x4 a = *(const f32x4*)(peer_u + i), b = *(const f32x4*)(peer_u + i + 4), ga = *(const f32x4*)(g_ffn + d), gb = *(const f32x4*)(g_ffn + d + 4);
            u32x4 w; w.x = pk2(a[0] * ga[0], a[1] * ga[1]); w.y = pk2(a[2] * ga[2], a[3] * ga[3]); w.z = pk2(b[0] * gb[0], b[1] * gb[1]); w.w = pk2(b[2] * gb[2], b[3] * gb[3]);
            *(u32x4*)(UT + i) = w; }
    }
    SEAM(4);
    if (IN(5)) {
        for (size_t i = (size_t)gtid * 8; i < (size_t)16384 * 1024; i += (size_t)NT * 8) {
            const f32x4 a = *(const f32x4*)(peer_v + i), b = *(const f32x4*)(peer_v + i + 4);
            u32x4 w; w.x = pk2(a[0], a[1]); w.y = pk2(a[2], a[3]); w.z = pk2(b[0], b[1]); w.w = pk2(b[2], b[3]);
            *(u32x4*)(VT + i) = w; }
        __syncthreads();
        pg8::Gemm g{YA, WA, YB, WB, 512, 512, M_, 1024, 512, 2}; pg8::StaticOrder S; S.init(g, G, (int)blockIdx.x);
        pg8::EpiMerge E{PROJB, MERGED}; pg8::gemm_phase<pg8::EpiMerge, pg8::StaticOrder, false>(ring, g, S, E);
    }
    SEAM(5);
    if (IN(6)) {
        pg8::Gemm g{MERGED, WOUT, nullptr, nullptr, DM, DM, M_, 1024, DM, 1}; pg8::StaticOrder S; S.init(g, G, (int)blockIdx.x);
        pg8::EpiX1 E{x, out, X1B, SSX1}; pg8::gemm_phase<pg8::EpiX1, pg8::StaticOrder, false>(ring, g, S, E);
    }
    SEAM(6);
    if (IN(7)) {
        pg8::Gemm g{X1B, WPQ, nullptr, nullptr, DM, DM, M_, 2048, DM, 1}; pg8::StaticOrder S; S.init(g, G, (int)blockIdx.x);
        pg8::EpiQP E{QP, SSX1}; pg8::gemm_phase<pg8::EpiQP, pg8::StaticOrder, true>(ring, g, S, E);
    }
    SEAM(7);
    if (IN(8)) {
        typedef short bf16x8_t __attribute__((ext_vector_type(8)));
        typedef float f32x16_t __attribute__((ext_vector_type(16)));
        const int r32 = lane & 31, hi = lane >> 5;
#define P8_SORTABLE(f) ({ const unsigned b_ = __float_as_uint(f); b_ ^ ((unsigned)((int)b_ >> 31) | 0x80000000u); })
#define P8_UNSORT(u) ({ const unsigned u_ = (u); __uint_as_float(u_ ^ (~(unsigned)((int)u_ >> 31) | 0x80000000u)); })
#define P8_INSERT(t, v) do { unsigned v_ = (v); _Pragma("unroll") for (int q_ = 0; q_ < 16; ++q_) { const unsigned a_ = t[q_] > v_ ? t[q_] : v_; v_ = t[q_] > v_ ? v_ : t[q_]; t[q_] = a_; } } while (0)
        for (int item = vcu; item < 256; item += G) {
            const int h = item & 7, tr = item >> 3;
            for (int c = tid; c < 2 * 128 * 16; c += 512) { const int p = c >> 11, row = (c >> 4) & 127, ch = c & 15;
                const u32x4 v = *(const u32x4*)(KEYS + ((size_t)(h * 2 + p) * 128 + row) * 128 + ch * 8);
                *(u32x4*)(lds + p * 32768 + row * 256 + ((ch * 16) ^ ((row & 7) << 4))) = v; }
            __syncthreads();
#pragma unroll 1
            for (int step = 0; step < 2; ++step) {
                const int m = tr * 512 + wave * 64 + step * 32 + r32;
                unsigned top[2][16];
#pragma unroll
                for (int p = 0; p < 2; ++p) {
                    bf16x8_t qf[8];
#pragma unroll
                    for (int ks = 0; ks < 8; ++ks) qf[ks] = *(const bf16x8_t*)(QP + (size_t)m * 2048 + (h * 2 + p) * 128 + ks * 16 + hi * 8);
                    f32x16_t acc[4];
#pragma unroll
                    for (int kt = 0; kt < 4; ++kt) { acc[kt] = f32x16_t{};
                        const int row = kt * 32 + r32; const unsigned char* rb = lds + p * 32768 + row * 256;
#pragma unroll
                        for (int ks = 0; ks < 8; ++ks) { const bf16x8_t a = *(const bf16x8_t*)(rb + (((2 * ks + hi) * 16) ^ ((row & 7) << 4)));
                            acc[kt] = __builtin_amdgcn_mfma_f32_32x32x16_bf16(a, qf[ks], acc[kt], 0, 0, 0); } }
                    unsigned t[16];
#pragma unroll
                    for (int i = 0; i < 16; ++i) t[i] = 0u;
#pragma unroll
                    for (int kt = 0; kt < 4; ++kt)
#pragma unroll
                        for (int r = 0; r < 16; ++r) { const unsigned base = 32 * kt + (r & 3) + 8 * (r >> 2);
                            const unsigned pk = (P8_SORTABLE(acc[kt][r]) | 127u) ^ base; P8_INSERT(t, pk); }
#pragma unroll
                    for (int i = 0; i < 16; ++i) t[i] ^= (unsigned)(hi << 2);
                    unsigned mm[16];
#pragma unroll
                    for (int i = 0; i < 16; ++i) { auto rr = __builtin_amdgcn_permlane32_swap(t[15 - i], t[15 - i], false, false); const unsigned pt = hi ? rr[0] : rr[1]; mm[i] = t[i] > pt ? t[i] : pt; }
#pragma unroll
                    for (int sft = 8; sft >= 1; sft >>= 1)
#pragma unroll
                        for (int i = 0; i < 16; ++i) if ((i & sft) == 0) { const unsigned a_ = mm[i] > mm[i + sft] ? mm[i] : mm[i + sft], b_ = mm[i] > mm[i + sft] ? mm[i + sft] : mm[i]; mm[i] = a_; mm[i + sft] = b_; }
#pragma unroll
                    for (int i = 0; i < 16; ++i) top[p][i] = mm[i];
                }
                float f0[16], f1[16];
#pragma unroll
                for (int i = 0; i < 16; ++i) { f0[i] = P8_UNSORT(top[0][i] & 0xFFFFFF80u); f1[i] = P8_UNSORT(top[1][i] & 0xFFFFFF80u); }
                unsigned cb[16];
#pragma unroll
                for (int i = 0; i < 16; ++i) cb[i] = 0u;
#define P8_CAND(a, b) do { const float sv_ = f0[a] + f1[b]; const unsigned pk_ = (P8_SORTABLE(sv_) | 255u) ^ (unsigned)((a) * 16 + (b)); P8_INSERT(cb, pk_); } while (0)
#pragma unroll
                for (int b = 0; b < 16; ++b) P8_CAND(0, b);
#pragma unroll
                for (int b = 0; b < 8; ++b) P8_CAND(1, b);
#pragma unroll
                for (int b = 0; b < 5; ++b) P8_CAND(2, b);
#pragma unroll
                for (int b = 0; b < 4; ++b) P8_CAND(3, b);
#pragma unroll
                for (int b = 0; b < 3; ++b) P8_CAND(4, b);
#pragma unroll
                for (int b = 0; b < 2; ++b) { P8_CAND(5, b); P8_CAND(6, b); P8_CAND(7, b); }
                P8_CAND(8, 0); P8_CAND(9, 0); P8_CAND(10, 0); P8_CAND(11, 0); P8_CAND(12, 0); P8_CAND(13, 0); P8_CAND(14, 0); P8_CAND(15, 0);
#undef P8_CAND
                unsigned char* slot = lds + 65536 + wave * 2048 + lane * 32;
                { u32x4 w0, w1;
#define P8_IDX4(T, i) ((127u - (T[i] & 127u)) | ((127u - (T[(i) + 1] & 127u)) << 8) | ((127u - (T[(i) + 2] & 127u)) << 16) | ((127u - (T[(i) + 3] & 127u)) << 24))
                  w0.x = P8_IDX4(top[0], 0); w0.y = P8_IDX4(top[0], 4); w0.z = P8_IDX4(top[0], 8); w0.w = P8_IDX4(top[0], 12);
                  w1.x = P8_IDX4(top[1], 0); w1.y = P8_IDX4(top[1], 4); w1.z = P8_IDX4(top[1], 8); w1.w = P8_IDX4(top[1], 12);
#undef P8_IDX4
                  *(u32x4*)slot = w0; *(u32x4*)(slot + 16) = w1; }
                asm volatile("s_waitcnt lgkmcnt(0)" ::: "memory");
                float bv[16]; int be[16];
#pragma unroll
                for (int k = 0; k < 16; ++k) { const unsigned pos = (~cb[k]) & 255u; bv[k] = P8_UNSORT(cb[k] & 0xFFFFFF00u);
                    be[k] = (int)slot[pos >> 4] * 128 + (int)slot[16 + (pos & 15)]; }
                { const float b0 = bv[0];
#pragma unroll
                  for (int k = 0; k < 16; ++k) bv[k] = __expf(bv[k] - b0); }
                asm volatile("s_waitcnt lgkmcnt(0)" ::: "memory");
                if (hi == 0) { int* ep = EIDX + (size_t)m * 128 + h * 16;
#pragma unroll
                    for (int q = 0; q < 4; ++q) { u32x4 w; w.x = (unsigned)be[4 * q]; w.y = (unsigned)be[4 * q + 1]; w.z = (unsigned)be[4 * q + 2]; w.w = (unsigned)be[4 * q + 3]; *(u32x4*)(ep + 4 * q) = w; } }
                else { float* gp = EGATE + (size_t)m * 128 + h * 16; float s2 = 0.f;
#pragma unroll
                    for (int k = 0; k < 16; ++k) s2 += bv[k];
                    const float inv = 1.f / s2;
#pragma unroll
                    for (int q = 0; q < 4; ++q) { f32x4 w; w[0] = bv[4 * q] * inv; w[1] = bv[4 * q + 1] * inv; w[2] = bv[4 * q + 2] * inv; w[3] = bv[4 * q + 3] * inv; *(f32x4*)(gp + 4 * q) = w; } }
            }
            __syncthreads();
        }
#undef P8_SORTABLE
#undef P8_UNSORT
#undef P8_INSERT
    }
    SEAM(8);
    if (IN(9)) {
#define DOT2(acc, a, b) acc = dot2_bf16((a), (b), acc)
#define ROR_ADD(v, n) v += __builtin_bit_cast(float, __builtin_amdgcn_update_dpp(0, __builtin_bit_cast(int, v), 0x120 + (n), 0xf, 0xf, false))
        const int hi = lane >> 5;
        for (int m = gw; m < M_; m += NGW) {
            const u32x4 xa = *(const u32x4*)(X1B + (size_t)m * DM + 8 * lane), xb = *(const u32x4*)(X1B + (size_t)m * DM + 512 + 8 * lane);
            const float r = rsqrtf(SSX1[m] * (1.f / DM) + EPS);
            const int e_lo = EIDX[(size_t)m * 128 + lane], e_hi = EIDX[(size_t)m * 128 + 64 + lane];
            const float g_lo = EGATE[(size_t)m * 128 + lane], g_hi = EGATE[(size_t)m * 128 + 64 + lane];
            float y[16];
#pragma unroll
            for (int j = 0; j < 16; ++j) y[j] = 0.f;
#pragma unroll 1
            for (int h = 0; h < 8; ++h) {
                const int ev = (h < 4) ? e_lo : e_hi; const float gv = (h < 4) ? g_lo : g_hi; const int l0 = (h & 3) * 16;
                float p[16];
#pragma unroll
                for (int k = 0; k < 16; ++k) { const int e = __builtin_amdgcn_readlane(ev, l0 + k); const bf16_t* row = UT + (size_t)e * DM;
                    const u32x4 ua = *(const u32x4*)(row + 8 * lane), ub = *(const u32x4*)(row + 512 + 8 * lane);
                    float a = 0.f; DOT2(a, xa.x, ua.x); DOT2(a, xa.y, ua.y); DOT2(a, xa.z, ua.z); DOT2(a, xa.w, ua.w);
                    DOT2(a, xb.x, ub.x); DOT2(a, xb.y, ub.y); DOT2(a, xb.z, ub.z); DOT2(a, xb.w, ub.w); p[k] = a; }
                float w[8];
#pragma unroll
                for (int j = 0; j < 8; ++j) { auto rr = __builtin_amdgcn_permlane32_swap(__float_as_uint(p[j]), __float_as_uint(p[j + 8]), false, false); w[j] = __uint_as_float(rr[0]) + __uint_as_float(rr[1]); }
#pragma unroll
                for (int j = 0; j < 8; ++j) { w[j] += __shfl_xor(w[j], 16); ROR_ADD(w[j], 8); ROR_ADD(w[j], 4); ROR_ADD(w[j], 2); ROR_ADD(w[j], 1); }
                float z = w[0];
#pragma unroll
                for (int j = 1; j < 8; ++j) z = ((lane & 7) == j) ? w[j] : z;
                z *= r;
                const float gate = __shfl(gv, l0 + (lane & 7) + 8 * hi);
                const float a = 0.5f * z * (1.f + erff(z * 0.70710678118654752f)) * gate;
#pragma unroll
                for (int k = 0; k < 16; ++k) { const int e = __builtin_amdgcn_readlane(ev, l0 + k); const float c = __builtin_bit_cast(float, __builtin_amdgcn_readlane(__builtin_bit_cast(int, a), (k & 7) + 32 * (k >> 3)));
                    const bf16_t* row = VT + (size_t)e * DM;
                    const u32x4 va = *(const u32x4*)(row + 8 * lane), vb = *(const u32x4*)(row + 512 + 8 * lane);
#pragma unroll
                    for (int q = 0; q < 4; ++q) { y[2 * q] += c * __uint_as_float(va[q] << 16); y[2 * q + 1] += c * __uint_as_float(va[q] & 0xffff0000u);
                        y[8 + 2 * q] += c * __uint_as_float(vb[q] << 16); y[8 + 2 * q + 1] += c * __uint_as_float(vb[q] & 0xffff0000u); } }
            }
            const float* xr = out + (size_t)m * DM; float ss = 0.f;
            { const f32x4 t0 = *(const f32x4*)(xr + 8 * lane), t1 = *(const f32x4*)(xr + 8 * lane + 4), t2 = *(const f32x4*)(xr + 512 + 8 * lane), t3 = *(const f32x4*)(xr + 512 + 8 * lane + 4);
#pragma unroll
              for (int q = 0; q < 4; ++q) { y[q] += t0[q]; y[4 + q] += t1[q]; y[8 + q] += t2[q]; y[12 + q] += t3[q]; } }
#pragma unroll
            for (int j = 0; j < 16; ++j) ss += y[j] * y[j];
            ss = wave_sum(ss); const float r2 = rsqrtf(ss * (1.f / DM) + EPS);
            float* orow = out + (size_t)m * DM;
#pragma unroll
            for (int q = 0; q < 4; ++q) { const int c = (q < 2 ? 0 : 512) + 8 * lane + 4 * (q & 1); const f32x4 gg = *(const f32x4*)(g_final + c);
                f32x4 o; o[0] = y[4 * q] * r2 * gg[0]; o[1] = y[4 * q + 1] * r2 * gg[1]; o[2] = y[4 * q + 2] * r2 * gg[2]; o[3] = y[4 * q + 3] * r2 * gg[3];
                *(f32x4*)(orow + c) = o; }
        }
#undef DOT2
#undef ROR_ADD
    }
#undef IN
#undef SEAM
}

extern "C" void kernel_launch(void* const* d_in, const int* in_sizes, int n_in, void* d_out, int out_size, void* d_ws, size_t ws_size, hipStream_t stream) {
    static int grid = 0;
    if (grid == 0) {
        if (n_in != 20 || out_size != M_ * DM || ws_size < WS_END) { fprintf(stderr, "kernel_launch: unexpected shapes (n_in %d out %d ws %zu); nothing launched\n", n_in, out_size, ws_size); grid = -1; return; }
        int dev = 0, cus = 0;
        if (hipGetDevice(&dev) != hipSuccess || hipDeviceGetAttribute(&cus, hipDeviceAttributeMultiprocessorCount, dev) != hipSuccess) { grid = -1; return; }
        if (hipFuncSetAttribute((const void*)fwd, hipFuncAttributeMaxDynamicSharedMemorySize, LDS_BYTES) != hipSuccess) { fprintf(stderr, "kernel_launch: hipFuncSetAttribute failed\n"); grid = -1; return; }
        int per_cu = 0;
        if (hipOccupancyMaxActiveBlocksPerMultiprocessor(&per_cu, (const void*)fwd, NWAVES * 64, LDS_BYTES) != hipSuccess || per_cu < 1) fprintf(stderr, "kernel_launch: occupancy query reports %d\n", per_cu);
        (void)hipGetLastError();
        grid = cus;
    }
    if (grid < 0) return;
    (void)hipMemsetAsync((char*)d_ws + WS_CTL, 0, CTL_ZERO_BYTES, stream);
    Args a; memset(&a, 0, sizeof(a));
    for (int i = 0; i < 20; ++i) a.in[i] = d_in[i];
    a.out = (float*)d_out; a.ws = (unsigned char*)d_ws;
    if (MK_N_LAUNCHES == 1) { a.ph_lo = 0; a.ph_hi = N_PHASES; hipLaunchKernelGGL(fwd, dim3(grid), dim3(NWAVES * 64), LDS_BYTES, stream, a); }
    else for (int p = 0; p < N_PHASES; ++p) { a.ph_lo = p; a.ph_hi = p + 1; hipLaunchKernelGGL(fwd, dim3(grid), dim3(NWAVES * 64), LDS_BYTES, stream, a); }
}
```

```cpp
#include <hip/hip_runtime.h>
#include <cstdio>
#include <cstdint>
#include <cstring>
#include <math.h>

#ifndef MK_N_LAUNCHES
#define MK_N_LAUNCHES 1
#endif
constexpr int N_PHASES = 10;

typedef unsigned short bf16_t;
constexpr int SEQ = 8192, DM = 1024, M_ = 16384, NCH = 128;
constexpr float EPS = 1e-6f;
constexpr int PB_LD = 2816, PA_LD = 1536;
constexpr int PB_BR = 0, PB_GOUT = 2048, PB_GQ = 2560;
constexpr int PA_GV = 0, PA_GK = 512, PA_QLAT = 768, PA_KVLAT = 1152, PA_KROPE = 1408, PA_GLR = 1440;
constexpr int NPROJ = 4352;
constexpr float CQ = 0.10206207261596577f * 1.4426950408889634f;

constexpr size_t MiB = 1u << 20;
constexpr size_t WS_CTL = 0, CTL_ZERO_BYTES = 256 * 1024;
constexpr size_t WS_SSQ = 1 * MiB, WS_SSKV = WS_SSQ + 65536, WS_SSX1 = WS_SSKV + 65536, WS_COS = 2 * MiB, WS_SIN = 3 * MiB;
constexpr size_t WS_DECAY = 1 * MiB + 512 * 1024;
constexpr size_t WS_WIN = 4 * MiB, WS_WQB = 13 * MiB, WS_WKVB = 14 * MiB, WS_WA = 15 * MiB, WS_WB = 16 * MiB, WS_WOUT = 17 * MiB, WS_WPQ = 19 * MiB, WS_KEYS = 23 * MiB;
constexpr size_t WS_PROJB = 24 * MiB, WS_PROJA = 112 * MiB, WS_XN = 160 * MiB, WS_Q = 160 * MiB, WS_K = 184 * MiB, WS_V = 208 * MiB, WS_DST = 224 * MiB;
constexpr size_t WS_YA = 112 * MiB, WS_YB = 128 * MiB, WS_MERGED = 160 * MiB, WS_X1B = 24 * MiB, WS_QP = 56 * MiB, WS_EIDX = 120 * MiB, WS_EGATE = 128 * MiB;
constexpr size_t WS_UT = 192 * MiB, WS_VT = 224 * MiB, WS_SU = 1 * MiB + 768 * 1024, WS_SV = WS_SU + 65536;
constexpr size_t WS_END = 256 * MiB;

#define GAS __attribute__((address_space(1)))
#define LAS __attribute__((address_space(3)))
typedef float f32x4 __attribute__((ext_vector_type(4)));
typedef unsigned u32x4 __attribute__((ext_vector_type(4)));
typedef unsigned u32x2 __attribute__((ext_vector_type(2)));

__device__ __forceinline__ float bf2f(bf16_t h) { return __uint_as_float(((unsigned)h) << 16); }
__device__ __forceinline__ unsigned f2bf_u(float f) { unsigned u = __float_as_uint(f); return (u + 0x7fffu + ((u >> 16) & 1u)) >> 16; }
__device__ __forceinline__ bf16_t f2bf(float f) { return (bf16_t)f2bf_u(f); }
__device__ __forceinline__ unsigned pk2(float lo, float hi) { return f2bf_u(lo) | (f2bf_u(hi) << 16); }
__device__ __forceinline__ float wave_sum(float v) {
#pragma unroll
    for (int o = 1; o < 64; o <<= 1) v += __shfl_xor(v, o);
    return v;
}
__device__ __forceinline__ float sigmoidf_(float x) { return 1.f / (1.f + __expf(-x)); }

namespace pg8 {
#define PG8_LAS __attribute__((address_space(3)))
typedef short bf16x8 __attribute__((ext_vector_type(8)));
constexpr int BM = 256, BK = 64, HALF = 128, HTB = HALF * BK * 2, STAGE_BYTES = 8 * HTB, NXCD = 8, WGM = 8;
__host__ __device__ __forceinline__ int lds_byte(int r, int c) { const int st = (r >> 4) * 2 + (c >> 5), rr = r & 15, cc = c & 31, ob = rr * 64 + cc * 2; return st * 1024 + (ob ^ (((ob >> 9) & 1) << 5)); }
__host__ __device__ __forceinline__ void stage_rc(int b, int& R, int& C) { const int st = b / 1024, sb = b % 1024, swz = sb ^ (((sb >> 9) & 1) << 5); R = (st >> 1) * 16 + swz / 64; C = (st & 1) * 32 + (swz % 64) / 2; }
__host__ __device__ __forceinline__ int perm32(int rho) { const int n = rho >> 4, i = rho & 15; return 8 * (i >> 2) + 4 * n + (i & 3); }

struct Unit { int pm, pn, sub; const char* A; const char* B; };
struct Gemm { const bf16_t* A; const bf16_t* Bt; const bf16_t* A2; const bf16_t* Bt2; int lda, ldb, M, N, K, chain; };
struct StaticOrder {
    int nM, nN, nwg, G, c, chain; const char *A, *B, *A2, *B2; size_t tsA, tsB;
    __device__ __forceinline__ void init(const Gemm& g, int G_, int c_) { nM = g.M / BM; nN = g.N / BM; nwg = nM * nN; G = G_; c = c_; chain = g.chain; A = (const char*)g.A; B = (const char*)g.Bt; A2 = (const char*)g.A2; B2 = (const char*)g.Bt2;
        tsA = (size_t)BM * g.lda * 2; tsB = (size_t)BM * g.ldb * 2; }
    __device__ __forceinline__ bool next(int i, Unit& u) const {
        const int r = (chain == 2) ? (i >> 1) : i, sub = (chain == 2) ? (i & 1) : 0;
        const long L = (long)r * G + c; if (L >= nwg) return false;
        int wgid = (int)L; { const int q = nwg / NXCD, rr = nwg % NXCD, xcd = wgid % NXCD, off = wgid / NXCD; wgid = (xcd < rr ? xcd * (q + 1) : rr * (q + 1) + (xcd - rr) * q) + off; }
        const int nig = WGM * nN, gid = wgid / nig, fm = gid * WGM, gsz = (nM - fm) < WGM ? (nM - fm) : WGM;
        u.pm = fm + ((wgid % nig) % gsz); u.pn = (wgid % nig) / gsz; u.sub = sub;
        u.A = (sub ? A2 : A) + (size_t)u.pm * tsA; u.B = (sub ? B2 : B) + (size_t)u.pn * tsB; return true;
    }
};
__device__ __forceinline__ unsigned cvt_pk_bf16(float lo, float hi) { unsigned r; asm volatile("v_cvt_pk_bf16_f32 %0, %1, %2" : "=v"(r) : "v"(lo), "v"(hi)); return r; }

typedef f32x4 AccT[2][2][4][2];
template <class Epi, class Sched, bool ALIGN_EPI>
__device__ __forceinline__ void gemm_phase(PG8_LAS unsigned char* lds, const Gemm g, const Sched& S, const Epi& E) {
    const int tid = threadIdx.x, wid = __builtin_amdgcn_readfirstlane(tid >> 6), lane = tid & 63, wr = wid >> 2, wc = wid & 3, fr = lane & 15, fq = lane >> 4;
    const int K = g.K, nt = K / BK;
    unsigned voffA[2], voffB[2];
#pragma unroll
    for (int i = 0; i < 2; ++i) { int R, C; stage_rc(tid * 16 + i * 8192, R, C); const int Rb = Epi::PERM ? ((R & ~31) + perm32(R & 31)) : R;
        voffA[i] = (unsigned)(R * g.lda + C) * 2u; voffB[i] = (unsigned)(Rb * g.ldb + C) * 2u; }
    const size_t kstep = (size_t)(BK * 2);
    const size_t hsA = (size_t)HALF * g.lda * 2, hsB = (size_t)HALF * g.ldb * 2;
    const unsigned ldsw = (unsigned)wid * 1024u;
    const int aoff = lds_byte(wr * 64 + fr, fq * 8), boff = lds_byte(wc * 32 + fr, fq * 8);
#define PG8_SA(b, h) (((b) * 2 + (h)) * HTB)
#define PG8_SB(b, h) ((4 + (b) * 2 + (h)) * HTB)
#define PG8_STAGE(bufoff, gbase, voff) do { _Pragma("unroll") for (int _i = 0; _i < 2; ++_i) \
        __builtin_amdgcn_global_load_lds((const unsigned*)((const char*)(gbase) + (voff)[_i]), (PG8_LAS unsigned*)(lds + (bufoff) + ldsw + _i * 8192), 16, 0, 0); } while (0)
#define PG8_LDA(dst, b, h) do { _Pragma("unroll") for (int m = 0; m < 4; ++m) _Pragma("unroll") for (int k = 0; k < 2; ++k) dst[m][k] = *(const PG8_LAS bf16x8*)(lds + PG8_SA(b, h) + aoff + m * 2048 + k * 1024); } while (0)
#define PG8_LDB(dst, b, h) do { _Pragma("unroll") for (int n = 0; n < 2; ++n) _Pragma("unroll") for (int k = 0; k < 2; ++k) dst[n][k] = *(const PG8_LAS bf16x8*)(lds + PG8_SB(b, h) + boff + n * 2048 + k * 1024); } while (0)
#define PG8_MMA(ai, bj, At, Bt) do { __builtin_amdgcn_s_setprio(1); _Pragma("unroll") for (int m = 0; m < 4; ++m) _Pragma("unroll") for (int n = 0; n < 2; ++n) _Pragma("unroll") for (int k = 0; k < 2; ++k) \
        acc[ai][bj][m][n] = __builtin_amdgcn_mfma_f32_16x16x32_bf16(Bt[n][k], At[m][k], acc[ai][bj][m][n], 0, 0, 0); __builtin_amdgcn_s_setprio(0); } while (0)
#define PG8_WAIT_V(n) asm volatile("s_waitcnt vmcnt(" #n ")" ::: "memory")
#define PG8_WAIT_L(n) asm volatile("s_waitcnt lgkmcnt(" #n ")" ::: "memory")
#define PG8_BAR __builtin_amdgcn_s_barrier()
#define PG8_SCHED __builtin_amdgcn_sched_barrier(0)
    Unit cur, nxt; int ui = 0;
    if (!S.next(0, cur)) return;
    f32x4 acc[2][2][4][2];
#pragma unroll
    for (int a = 0; a < 2; ++a)
#pragma unroll
        for (int b = 0; b < 2; ++b)
#pragma unroll
            for (int m = 0; m < 4; ++m)
#pragma unroll
                for (int n = 0; n < 2; ++n) acc[a][b][m][n] = (f32x4){0.f, 0.f, 0.f, 0.f};
    bf16x8 At[4][2], B0[2][2], B1[2][2];
    const char* cA = cur.A; const char* cB = cur.B;
    PG8_STAGE(PG8_SB(0, 0), cB, voffB); PG8_STAGE(PG8_SB(0, 1), cB + hsB, voffB); PG8_STAGE(PG8_SA(0, 0), cA, voffA); PG8_STAGE(PG8_SA(0, 1), cA + hsA, voffA);
    if (wr == 1) PG8_BAR;
    PG8_WAIT_V(2); PG8_BAR;
    PG8_STAGE(PG8_SB(1, 0), cB + kstep, voffB); PG8_STAGE(PG8_SA(1, 0), cA + kstep, voffA); PG8_STAGE(PG8_SB(1, 1), cB + hsB + kstep, voffB);
    PG8_WAIT_V(6); PG8_BAR;
    for (;;) {
        const bool has_next = S.next(ui + 1, nxt);
        const char* nA = has_next ? nxt.A : cA; const char* nB = has_next ? nxt.B : cB;
        for (int t = 0; t < nt; t += 2) {
            const bool last = (t == nt - 2);
            const char* a1 = cA + (size_t)(t + 1) * kstep;
            const char* a2 = last ? nA : cA + (size_t)(t + 2) * kstep; const char* b2 = last ? nB : cB + (size_t)(t + 2) * kstep;
            const char* a3 = a2 + kstep; const char* b3 = b2 + kstep;
            PG8_LDB(B0, 0, 0); PG8_LDB(B1, 0, 1); PG8_SCHED; PG8_LDA(At, 0, 0); PG8_STAGE(PG8_SA(1, 1), a1 + hsA, voffA);
            PG8_WAIT_V(8); PG8_WAIT_L(0); PG8_BAR; PG8_MMA(0, 0, At, B0); PG8_MMA(0, 1, At, B1); PG8_BAR; PG8_SCHED;
            PG8_LDA(At, 0, 1); PG8_STAGE(PG8_SB(0, 0), b2, voffB); PG8_STAGE(PG8_SB(0, 1), b2 + hsB, voffB); PG8_STAGE(PG8_SA(0, 0), a2, voffA);
            PG8_WAIT_V(8); PG8_WAIT_L(0); PG8_BAR; PG8_MMA(1, 0, At, B0); PG8_MMA(1, 1, At, B1); PG8_BAR; PG8_SCHED;
            PG8_LDB(B0, 1, 0); PG8_LDB(B1, 1, 1); PG8_SCHED; PG8_LDA(At, 1, 0); PG8_STAGE(PG8_SA(0, 1), a2 + hsA, voffA);
            PG8_WAIT_V(8); PG8_WAIT_L(0); PG8_BAR; PG8_MMA(0, 0, At, B0); PG8_MMA(0, 1, At, B1); PG8_BAR; PG8_SCHED;
            PG8_LDA(At, 1, 1); PG8_STAGE(PG8_SB(1, 0), b3, voffB); PG8_STAGE(PG8_SB(1, 1), b3 + hsB, voffB); PG8_STAGE(PG8_SA(1, 0), a3, voffA);
            PG8_WAIT_V(8); PG8_WAIT_L(0); PG8_BAR; PG8_MMA(1, 0, At, B0); PG8_MMA(1, 1, At, B1); PG8_BAR; PG8_SCHED;
        }
        if constexpr (ALIGN_EPI) { if (wr == 0) PG8_BAR; }
        E(acc, cur, wr, wc, fr, fq);
        if (!has_next) break;
        if (!(Epi::CHAIN && nxt.sub != 0)) {
#pragma unroll
            for (int a = 0; a < 2; ++a)
#pragma unroll
                for (int b = 0; b < 2; ++b)
#pragma unroll
                    for (int m = 0; m < 4; ++m)
#pragma unroll
                        for (int n = 0; n < 2; ++n) acc[a][b][m][n] = (f32x4){0.f, 0.f, 0.f, 0.f};
        }
        cur = nxt; cA = nA; cB = nB; ++ui;
        if constexpr (ALIGN_EPI) { if (wr == 1) PG8_BAR; }
    }
    PG8_WAIT_V(0);
    if constexpr (!ALIGN_EPI) { if (wr == 0) PG8_BAR; }
    PG8_BAR;
#undef PG8_SA
#undef PG8_SB
#undef PG8_STAGE
#undef PG8_LDA
#undef PG8_LDB
#undef PG8_MMA
#undef PG8_WAIT_V
#undef PG8_WAIT_L
#undef PG8_BAR
#undef PG8_SCHED
}

struct EpiProj {
    static constexpr bool PERM = true, CHAIN = false;
    bf16_t* pb; bf16_t* pa; float* ssq; float* sskv;
    __device__ __forceinline__ void operator()(AccT& acc, const Unit& u, int wr, int wc, int fr, int fq) const {
        const int row0 = u.pm * BM + wr * 64 + fr;
#pragma unroll
        for (int bj = 0; bj < 2; ++bj) {
            const int hk = u.pn * 2 + bj;
            bf16_t* base; int ld; float* ss = nullptr;
            if (hk < 22) { base = pb + hk * 128; ld = PB_LD; } else { const int ha = hk - 22; base = pa + ha * 128; ld = PA_LD; if (ha >= 6 && ha <= 8) ss = ssq; else if (ha == 9 || ha == 10) ss = sskv; }
            base += wc * 32 + 8 * fq;
#pragma unroll
            for (int ai = 0; ai < 2; ++ai)
#pragma unroll
                for (int m = 0; m < 4; ++m) { const int row = row0 + ai * HALF + m * 16; const f32x4 v0 = acc[ai][bj][m][0], v1 = acc[ai][bj][m][1];
                    u32x4 w; w.x = cvt_pk_bf16(v0[0], v0[1]); w.y = cvt_pk_bf16(v0[2], v0[3]); w.z = cvt_pk_bf16(v1[0], v1[1]); w.w = cvt_pk_bf16(v1[2], v1[3]);
                    *(u32x4*)(base + (size_t)row * ld) = w;
                    if (ss) { float s = (v0[0] * v0[0] + v0[1] * v0[1]) + (v0[2] * v0[2] + v0[3] * v0[3]) + (v1[0] * v1[0] + v1[1] * v1[1]) + (v1[2] * v1[2] + v1[3] * v1[3]);
                        s += __shfl_xor(s, 16); s += __shfl_xor(s, 32); if (fq == 0) atomicAdd(ss + row, s); } }
        }
    }
};
struct EpiQ {
    static constexpr bool PERM = false, CHAIN = false;
    bf16_t* Q; const float* ssq; const float* cs; const float* sn;
    __device__ __forceinline__ void operator()(AccT& acc, const Unit& u, int wr, int wc, int fr, int fq) const {
        const int row0 = u.pm * BM + wr * 64 + fr;
#pragma unroll
        for (int ai = 0; ai < 2; ++ai)
#pragma unroll
            for (int m = 0; m < 4; ++m) { const int row = row0 + ai * HALF + m * 16; const float rr = rsqrtf(ssq[row] * (1.f / 384.f) + EPS) * CQ;
#pragma unroll
                for (int bj = 0; bj < 2; ++bj) { const int G = u.pn * 8 + bj * 4 + wc;
                    f32x4 x0 = acc[ai][bj][m][0], x1 = acc[ai][bj][m][1];
                    if (G % 3 == 2) { const f32x4 c = *(const f32x4*)(cs + (size_t)row * 16 + 4 * fq), s = *(const f32x4*)(sn + (size_t)row * 16 + 4 * fq);
                        const f32x4 o0 = x0 * c - x1 * s, o1 = x1 * c + x0 * s; x0 = o0; x1 = o1; }
                    x0 = x0 * rr; x1 = x1 * rr;
                    bf16_t* p = Q + (size_t)row * 768 + G * 32 + 4 * fq;
                    u32x2 w0, w1; w0.x = cvt_pk_bf16(x0[0], x0[1]); w0.y = cvt_pk_bf16(x0[2], x0[3]); w1.x = cvt_pk_bf16(x1[0], x1[1]); w1.y = cvt_pk_bf16(x1[2], x1[3]);
                    *(u32x2*)p = w0; *(u32x2*)(p + 16) = w1; } }
    }
};
struct EpiKV {
    static constexpr bool PERM = true, CHAIN = false;
    bf16_t* Kb; bf16_t* Vb; const float* sskv;
    __device__ __forceinline__ void operator()(AccT& acc, const Unit& u, int wr, int wc, int fr, int fq) const {
        const int row0 = u.pm * BM + wr * 64 + fr;
#pragma unroll
        for (int ai = 0; ai < 2; ++ai)
#pragma unroll
            for (int m = 0; m < 4; ++m) { const int row = row0 + ai * HALF + m * 16; const float rr = rsqrtf(sskv[row] * (1.f / 256.f) + EPS);
#pragma unroll
                for (int bj = 0; bj < 2; ++bj) { const int head = u.pn * 2 + bj; const f32x4 v0 = acc[ai][bj][m][0] * rr, v1 = acc[ai][bj][m][1] * rr;
                    u32x4 w; w.x = cvt_pk_bf16(v0[0], v0[1]); w.y = cvt_pk_bf16(v0[2], v0[3]); w.z = cvt_pk_bf16(v1[0], v1[1]); w.w = cvt_pk_bf16(v1[2], v1[3]);
                    bf16_t* p = (wc < 2) ? Kb + (size_t)row * 768 + head * 96 + wc * 32 + 8 * fq : Vb + (size_t)row * 512 + head * 64 + (wc - 2) * 32 + 8 * fq;
                    *(u32x4*)p = w; } }
    }
};
struct EpiMerge {
    static constexpr bool PERM = true, CHAIN = true;
    const bf16_t* pb; bf16_t* merged;
    __device__ __forceinline__ void operator()(AccT& acc, const Unit& u, int wr, int wc, int fr, int fq) const {
        const int row0 = u.pm * BM + wr * 64 + fr, col0 = u.pn * BM + wc * 32 + 8 * fq;
#pragma unroll
        for (int ai = 0; ai < 2; ++ai)
#pragma unroll
            for (int m = 0; m < 4; ++m) { const int row = row0 + ai * HALF + m * 16;
#pragma unroll
                for (int bj = 0; bj < 2; ++bj) { const int col = col0 + bj * HALF;
                    const u32x4 gb = *(const u32x4*)(pb + (size_t)row * PB_LD + PB_BR + 1024 + col);
                    float sb[8];
#pragma unroll
                    for (int e = 0; e < 4; ++e) { sb[2 * e] = sigmoidf_(__uint_as_float(gb[e] << 16)); sb[2 * e + 1] = sigmoidf_(__uint_as_float(gb[e] & 0xffff0000u)); }
                    if (u.sub == 0) {
                        const u32x4 ga = *(const u32x4*)(pb + (size_t)row * PB_LD + PB_BR + col);
                        float sa[8];
#pragma unroll
                        for (int e = 0; e < 4; ++e) { sa[2 * e] = sigmoidf_(__uint_as_float(ga[e] << 16)); sa[2 * e + 1] = sigmoidf_(__uint_as_float(ga[e] & 0xffff0000u)); }
#pragma unroll
                        for (int e = 0; e < 4; ++e) { acc[ai][bj][m][0][e] *= sa[e] / sb[e]; acc[ai][bj][m][1][e] *= sa[4 + e] / sb[4 + e]; }
                    } else {
                        const f32x4 v0 = acc[ai][bj][m][0], v1 = acc[ai][bj][m][1];
                        u32x4 w; w.x = cvt_pk_bf16(v0[0] * sb[0], v0[1] * sb[1]); w.y = cvt_pk_bf16(v0[2] * sb[2], v0[3] * sb[3]); w.z = cvt_pk_bf16(v1[0] * sb[4], v1[1] * sb[5]); w.w = cvt_pk_bf16(v1[2] * sb[6], v1[3] * sb[7]);
                        *(u32x4*)(merged + (size_t)row * DM + col) = w; } } }
    }
};
struct EpiX1 {
    static constexpr bool PERM = false, CHAIN = false;
    const float* x; float* x1; bf16_t* x1b; float* ssx1;
    __device__ __forceinline__ void operator()(AccT& acc, const Unit& u, int wr, int wc, int fr, int fq) const {
        const int row0 = u.pm * BM + wr * 64 + fr, col0 = u.pn * BM + wc * 32 + 4 * fq;
#pragma unroll
        for (int ai = 0; ai < 2; ++ai)
#pragma unroll
            for (int m = 0; m < 4; ++m) { const int row = row0 + ai * HALF + m * 16; const size_t off = (size_t)row * DM + col0; float s = 0.f;
#pragma unroll
                for (int bj = 0; bj < 2; ++bj)
#pragma unroll
                    for (int n = 0; n < 2; ++n) { const size_t o = off + bj * HALF + n * 16; const f32x4 v = *(const f32x4*)(x + o) + acc[ai][bj][m][n];
                        *(f32x4*)(x1 + o) = v; u32x2 w; w.x = cvt_pk_bf16(v[0], v[1]); w.y = cvt_pk_bf16(v[2], v[3]); *(u32x2*)(x1b + o) = w;
                        s += (v[0] * v[0] + v[1] * v[1]) + (v[2] * v[2] + v[3] * v[3]); }
                s += __shfl_xor(s, 16); s += __shfl_xor(s, 32); if (fq == 0) atomicAdd(ssx1 + row, s); }
    }
};
struct EpiQP {
    static constexpr bool PERM = true, CHAIN = false;
    bf16_t* qp; const float* ssx1;
    __device__ __forceinline__ void operator()(AccT& acc, const Unit& u, int wr, int wc, int fr, int fq) const {
        const int row0 = u.pm * BM + wr * 64 + fr, col0 = u.pn * BM + wc * 32 + 8 * fq;
#pragma unroll
        for (int ai = 0; ai < 2; ++ai)
#pragma unroll
            for (int m = 0; m < 4; ++m) { const int row = row0 + ai * HALF + m * 16; const float rr = rsqrtf(ssx1[row] * (1.f / 1024.f) + EPS);
#pragma unroll
                for (int bj = 0; bj < 2; ++bj) { const f32x4 v0 = acc[ai][bj][m][0] * rr, v1 = acc[ai][bj][m][1] * rr;
                    u32x4 w; w.x = cvt_pk_bf16(v0[0], v0[1]); w.y = cvt_pk_bf16(v0[2], v0[3]); w.z = cvt_pk_bf16(v1[0], v1[1]); w.w = cvt_pk_bf16(v1[2], v1[3]);
                    *(u32x4*)(qp + (size_t)row * 2048 + col0 + bj * HALF) = w; } }
    }
};
}


namespace att {
typedef short bf16x8 __attribute__((ext_vector_type(8)));
typedef short s16x4 __attribute__((ext_vector_type(4)));
typedef float f32x16 __attribute__((ext_vector_type(16)));
constexpr int NW = 8, QBLK = 32, KVBLK = 64, QB = NW * QBLK;
constexpr int QS = 768, KS = 768, VS = 512, OS = 512;
constexpr int SHM_V = KVBLK * 64 * 2, SHM_K = KVBLK * 256;
constexpr int LDS_BYTES = 2 * SHM_V + 2 * SHM_K + NW * 64 * 4;
constexpr float THR = 8.f;
#define KSWZ(row, colB) ((row) * 256 + ((colB) ^ (((row) & 7) << 4)))
#define SBAR() __builtin_amdgcn_sched_barrier(0)
__device__ __forceinline__ int v_st(int k, int c) { const int kk = (k & ~0xC) | ((k & 4) << 1) | ((k & 8) >> 1); return ((kk >> 3) * 2 + (c >> 5)) * 512 + ((kk & 7) * 32 + (c & 31)) * 2; }
__device__ __forceinline__ int v_rd_base(int lane) { return ((lane & 3) << 3) | (((lane >> 2) & 3) << 6) | (((lane >> 4) & 1) << 5) | (((lane >> 5) & 1) << 8); }
constexpr int v_rd_off(int d0, int ks, int half) { return d0 * 512 + ks * 2048 + half * 1024; }
__device__ __forceinline__ int crow(int r, int hi) { return (r & 3) + 8 * (r >> 2) + 4 * hi; }
__device__ __forceinline__ unsigned cvtpk(float lo, float hi) { unsigned r; asm volatile("v_cvt_pk_bf16_f32 %0, %1, %2" : "=v"(r) : "v"(lo), "v"(hi)); return r; }
__device__ __forceinline__ bf16x8 load8(const bf16_t* p) { return *reinterpret_cast<const bf16x8*>(p); }
__device__ __forceinline__ void partialSM(f32x16& p0, f32x16& p1, float& m_reg, float& mn, float& alpha) {
    float pmax = p0[0]; for (int r = 1; r < 16; ++r) pmax = fmaxf(pmax, p0[r]); for (int r = 0; r < 16; ++r) pmax = fmaxf(pmax, p1[r]);
    { auto rr = __builtin_amdgcn_permlane32_swap(__float_as_uint(pmax), __float_as_uint(pmax), false, false);
      pmax = fmaxf(__uint_as_float(rr[0]), __uint_as_float(rr[1])); }
    if (__builtin_expect(__all((pmax - m_reg) <= THR), 1)) { mn = m_reg; alpha = 1.f; }
    else { mn = fmaxf(m_reg, pmax); alpha = __builtin_amdgcn_exp2f(m_reg - mn); m_reg = mn; }
    for (int r = 0; r < 16; ++r) p0[r] = p0[r] - mn; for (int r = 0; r < 16; ++r) p1[r] = p1[r] - mn;
    for (int r = 0; r < 16; ++r) p0[r] = __builtin_amdgcn_exp2f(p0[r]);
}
__device__ __forceinline__ void finishSM(f32x16& p0, f32x16& p1, float alpha, float& l_reg, bf16x8& pa0, bf16x8& pa1, bf16x8& pa2, bf16x8& pa3) {
    for (int r = 0; r < 16; ++r) p1[r] = __builtin_amdgcn_exp2f(p1[r]);
    float ps = 0; for (int r = 0; r < 16; ++r) ps += p0[r]; for (int r = 0; r < 16; ++r) ps += p1[r];
    { auto rr = __builtin_amdgcn_permlane32_swap(__float_as_uint(ps), __float_as_uint(ps), false, false);
      ps = __uint_as_float(rr[0]) + __uint_as_float(rr[1]); }
    l_reg = l_reg * alpha + ps;
#define PK4(P, B_, OUT) do { unsigned a0 = cvtpk(P[B_+0], P[B_+1]), a1 = cvtpk(P[B_+2], P[B_+3]);                          \
        unsigned b0 = cvtpk(P[B_+4], P[B_+5]), b1 = cvtpk(P[B_+6], P[B_+7]);                                             \
        auto r0 = __builtin_amdgcn_permlane32_swap(a0, b0, false, false); auto r1 = __builtin_amdgcn_permlane32_swap(a1, b1, false, false); \
        u32x4 w = {r0[0], r1[0], r0[1], r1[1]}; OUT = *reinterpret_cast<bf16x8*>(&w); } while (0)
    PK4(p0, 0, pa0); PK4(p0, 8, pa1); PK4(p1, 0, pa2); PK4(p1, 8, pa3);
#undef PK4
}
template <int KB>
__device__ __forceinline__ void qkt(f32x16& p0, f32x16& p1, const char* K_lds, int r32, int hi, const bf16x8* qr) {
    p0 = f32x16{}; p1 = f32x16{};
    const char* kb[4];
#pragma unroll
    for (int dd = 0; dd < 4; ++dd) kb[dd] = K_lds + KB * SHM_K + KSWZ(r32, (dd * 16 + hi * 8) * 2);
#pragma unroll
    for (int d0 = 0; d0 < 6; ++d0) { const char* a = kb[d0 & 3] + (d0 >> 2) * 128;
        bf16x8 b0 = *reinterpret_cast<const bf16x8*>(a);
        bf16x8 b1 = *reinterpret_cast<const bf16x8*>(a + 32 * 256);
        p0 = __builtin_amdgcn_mfma_f32_32x32x16_bf16(b0, qr[d0], p0, 0, 0, 0);
        p1 = __builtin_amdgcn_mfma_f32_32x32x16_bf16(b1, qr[d0], p1, 0, 0, 0); }
}
template <int VB>
__device__ __forceinline__ void pv_tile(f32x16* o, int vb0, bf16x8 pa0, bf16x8 pa1, bf16x8 pa2, bf16x8 pa3) {
#define TRRD(dst, off) asm volatile("ds_read_b64_tr_b16 %0, %1 offset:%2" : "=&v"(dst) : "v"(vb0), "i"(off) : "memory")
#define PV_D0(d0) do { s16x4 l0, l1, l2, l3, h0, h1, h2, h3; constexpr int b_ = VB * SHM_V + v_rd_off(d0, 0, 0);   \
        TRRD(l0, b_); TRRD(h0, b_ + 1024); TRRD(l1, b_ + 2048); TRRD(h1, b_ + 3072); TRRD(l2, b_ + 4096); TRRD(h2, b_ + 5120); TRRD(l3, b_ + 6144); TRRD(h3, b_ + 7168); \
        asm volatile("s_waitcnt lgkmcnt(0)" ::: "memory"); SBAR();   \
        o[d0] = __builtin_amdgcn_mfma_f32_32x32x16_bf16(pa0, (bf16x8){l0[0], l0[1], l0[2], l0[3], h0[0], h0[1], h0[2], h0[3]}, o[d0], 0, 0, 0);   \
        o[d0] = __builtin_amdgcn_mfma_f32_32x32x16_bf16(pa1, (bf16x8){l1[0], l1[1], l1[2], l1[3], h1[0], h1[1], h1[2], h1[3]}, o[d0], 0, 0, 0);   \
        o[d0] = __builtin_amdgcn_mfma_f32_32x32x16_bf16(pa2, (bf16x8){l2[0], l2[1], l2[2], l2[3], h2[0], h2[1], h2[2], h2[3]}, o[d0], 0, 0, 0);   \
        o[d0] = __builtin_amdgcn_mfma_f32_32x32x16_bf16(pa3, (bf16x8){l3[0], l3[1], l3[2], l3[3], h3[0], h3[1], h3[2], h3[3]}, o[d0], 0, 0, 0); } while (0)
    PV_D0(0); PV_D0(1);
#undef PV_D0
#undef TRRD
}
struct BlockRef { const bf16_t* Q; const bf16_t* K; const bf16_t* V; bf16_t* O; int P0; };
struct Seam { bf16x8 qr[6]; bf16x8 st_v0, st_v1, st_k0, st_k1; };
#define ROWK(p, k0, rr) ((p) + (size_t)((k0) + (rr)) * KS + sc)
#define ROWV(p, k0, rr) ((p) + (size_t)((k0) + (rr)) * VS + sc)
#define VMW() asm volatile("s_waitcnt vmcnt(0)" ::: "memory")
#define VMWN(n) asm volatile("s_waitcnt vmcnt(%0)" :: "i"(n) : "memory")
#define SLOAD_H(Kp, Vp, k0) do { if (vact) { S.st_v0 = load8(ROWV(Vp, k0, sr)); S.st_v1 = load8(ROWV(Vp, k0, 32 + sr)); }              \
                                 if (kact) { S.st_k0 = load8(ROWK(Kp, k0, sr)); S.st_k1 = load8(ROWK(Kp, k0, 32 + sr)); } } while (0)
#define SWRITE_HK(bf) do { if (kact) { *(bf16x8*)(K_lds + (bf) * SHM_K + kws) = S.st_k0; *(bf16x8*)(K_lds + (bf) * SHM_K + kws + 32 * 256) = S.st_k1; } } while (0)
#define SWRITE_HV(bf) do { if (vact) { *(bf16x8*)(V_lds + (bf) * SHM_V + vst0) = S.st_v0; *(bf16x8*)(V_lds + (bf) * SHM_V + vst1) = S.st_v1; } } while (0)
#define SWRITE_H(bf) do { SWRITE_HV(bf); SWRITE_HK(bf); } while (0)
__device__ __forceinline__ void attn_prime(const BlockRef& cur, char* lds, Seam& S) {
    const int tid = threadIdx.x, wid = __builtin_amdgcn_readfirstlane(tid >> 6), lane = tid & 63, r32 = lane & 31, hi = lane >> 5;
    const int sr = tid >> 4, sc = (tid & 15) * 8, kws = KSWZ(sr, sc * 2); char* K_lds = lds + 2 * SHM_V;
    const bool kact = (tid & 15) < 12, vact = (tid & 15) < 8;
#pragma unroll
    for (int d0 = 0; d0 < 6; ++d0) S.qr[d0] = load8(cur.Q + (size_t)(wid * QBLK + r32) * QS + d0 * 16 + hi * 8);
    SLOAD_H(cur.K, cur.V, 0); VMW(); SWRITE_HK(0);
    __syncthreads();
}
__device__ __forceinline__ void attn_block(const BlockRef& cur, const BlockRef& nxt, char* lds, Seam& S) {
    const int tid = threadIdx.x, wid = __builtin_amdgcn_readfirstlane(tid >> 6), lane = tid & 63, r32 = lane & 31, hi = lane >> 5;
    const int NT = (cur.P0 + QB - 1) / KVBLK + 1;
    const int qlo = cur.P0 + wid * QBLK;
    const int qvis = qlo | 63;
    char* V_lds = lds; char* K_lds = lds + 2 * SHM_V;
    float* ws = (float*)(lds + 2 * SHM_V + 2 * SHM_K) + wid * 64; float* li_l = ws, * al_l = ws + 32;
    float m_reg = -1e30f, l_reg = 0; f32x16 o[2] = {};
    const int sr = tid >> 4, sc = (tid & 15) * 8, vst0 = v_st(sr, sc & 63), vst1 = v_st(32 + sr, sc & 63), kws = KSWZ(sr, sc * 2);
    const bool kact = (tid & 15) < 12, vact = (tid & 15) < 8;
    const int vb0 = (int)(uintptr_t)V_lds + v_rd_base(lane);
    const bf16_t* Kh = cur.K; const bf16_t* Vh = cur.V;
#define RESC(a) do { if (__any((a) < 1.f)) { if (hi == 0) al_l[r32] = (a); asm volatile("s_waitcnt lgkmcnt(0)" ::: "memory");              \
                     for (int d_ = 0; d_ < 2; ++d_) for (int r = 0; r < 16; ++r) o[d_][r] *= al_l[crow(r, hi)]; } } while (0)
#define KBASE(t) ((t) * KVBLK)
#define MASKT(P0_, P1_, t) do { if (KBASE(t) > qvis) { const float NEG_ = -__builtin_inff(); _Pragma("unroll") for (int r = 0; r < 16; ++r) { P0_[r] = NEG_; P1_[r] = NEG_; } } } while (0)
    constexpr int NQL = 6;
#define SEAM_K0() do { VMWN(NQL); SWRITE_HK(0); SBAR(); } while (0)
    f32x16 pA0, pA1, pB0, pB1; float mnA, mnB, alA, alB; bf16x8 pa0, pa1, pa2, pa3;
    SWRITE_HV(0); SBAR();
    if (NT > 1) { SLOAD_H(Kh, Vh, KBASE(1)); }
    SBAR(); qkt<0>(pA0, pA1, K_lds, r32, hi, S.qr);
    MASKT(pA0, pA1, 0); partialSM(pA0, pA1, m_reg, mnA, alA);
    if (NT > 1) { VMW(); SWRITE_H(1); }
    __syncthreads();
#define HALF_STEP(PX0, PX1, mnX, alX, PY0, PY1, alY, t, KB, VB, SB) do {                                                      \
        SBAR(); qkt<KB>(PX0, PX1, K_lds, r32, hi, S.qr);                                             \
        finishSM(PY0, PY1, alY, l_reg, pa0, pa1, pa2, pa3); SBAR();                                                           \
        if ((t) + 1 < NT) { SLOAD_H(Kh, Vh, KBASE((t) + 1)); SBAR(); }                                               \
        pv_tile<VB>(o, vb0, pa0, pa1, pa2, pa3); MASKT(PX0, PX1, (t)); partialSM(PX0, PX1, m_reg, mnX, alX);                                        \
        __syncthreads();                                                                                                      \
        if ((t) + 1 < NT) { VMW(); SWRITE_H(SB); }                                                                          \
        RESC(alX); __syncthreads(); } while (0)
    for (int t = 1; t + 1 < NT; t += 2) {
        HALF_STEP(pB0, pB1, mnB, alB, pA0, pA1, alA, t, 1, 0, 0);
        HALF_STEP(pA0, pA1, mnA, alA, pB0, pB1, alB, t + 1, 0, 1, 1);
    }
    const bool even = (NT & 1) == 0;
    if (even) { SBAR(); qkt<1>(pB0, pB1, K_lds, r32, hi, S.qr); SBAR(); }
    SLOAD_H(nxt.K, nxt.V, 0); SBAR();
#pragma unroll
    for (int d0 = 0; d0 < 6; ++d0) S.qr[d0] = load8(nxt.Q + (size_t)(wid * QBLK + r32) * QS + d0 * 16 + hi * 8);
    SBAR();
    finishSM(pA0, pA1, alA, l_reg, pa0, pa1, pa2, pa3); SBAR();
    pv_tile<0>(o, vb0, pa0, pa1, pa2, pa3);
    if (even) { MASKT(pB0, pB1, NT - 1); partialSM(pB0, pB1, m_reg, mnB, alB); __syncthreads(); RESC(alB);
        finishSM(pB0, pB1, alB, l_reg, pa0, pa1, pa2, pa3); SBAR(); pv_tile<1>(o, vb0, pa0, pa1, pa2, pa3); }
    SBAR(); SEAM_K0();
    if (hi == 0) li_l[r32] = l_reg; asm volatile("s_waitcnt lgkmcnt(0)" ::: "memory");
    float rli[16];
#pragma unroll
    for (int r = 0; r < 16; ++r) rli[r] = __builtin_amdgcn_rcpf(li_l[crow(r, hi)]);
    bf16_t* Ow = cur.O + (size_t)(wid * QBLK) * OS;
#pragma unroll
    for (int r = 0; r < 16; ++r) { const int orow = crow(r, hi);
#pragma unroll
        for (int d0 = 0; d0 < 2; ++d0) { const float v = o[d0][r] * rli[r];
            const float vn = __shfl_xor(v, 1);
            if ((r32 & 1) == 0) *(unsigned*)(Ow + (size_t)orow * OS + d0 * 32 + r32) = cvtpk(v, vn); } }
    __syncthreads();
#undef RESC
#undef KBASE
#undef MASKT
#undef SEAM_K0
#undef HALF_STEP
}
#undef ROWK
#undef ROWV
#undef VMW
#undef VMWN
#undef SLOAD_H
#undef SWRITE_HK
#undef SWRITE_HV
#undef SWRITE_H
#undef KSWZ
#undef SBAR
}

#define XB_TMO      128
#define XB_XCNT(j)  (256  + 64 * (j))
#define XB_XSUB(j)  (1280 + 64 * (j))
#define XB_XGEN(j)  (2304 + 64 * (j))
#define XB_TOP      3328
#define XB_TOPGEN   3392
#define XCD_BAR_WORDS 3456
#define XB_SPIN_CAP (1u << 18)
__device__ __forceinline__ unsigned xb_ld(unsigned* p)              { return __hip_atomic_load(p, __ATOMIC_RELAXED, __HIP_MEMORY_SCOPE_AGENT); }
__device__ __forceinline__ unsigned xb_add(unsigned* p, unsigned v) { return __hip_atomic_fetch_add(p, v, __ATOMIC_RELAXED, __HIP_MEMORY_SCOPE_AGENT); }
__device__ __forceinline__ unsigned xb_xcc_id() { return (unsigned)__builtin_amdgcn_s_getreg((3 << 11) | 20) & 0xFu; }
#define XB_SPIN(cond, bar) do { unsigned _sp = 0; while (cond) { __builtin_amdgcn_s_sleep(1); \
    if ((++_sp & 255u) == 0u) { if (xb_ld(&(bar)[XB_TMO])) break; if (_sp > XB_SPIN_CAP) { atomicAdd(&(bar)[XB_TMO], 1u); break; } } } } while (0)
struct XcdBarrier { unsigned* bar; unsigned x; volatile LAS unsigned* st; };
__device__ __forceinline__ XcdBarrier xcd_barrier_post(unsigned* bar, volatile LAS unsigned* st) {
    XcdBarrier b; b.bar = bar; b.x = xb_xcc_id(); b.st = st;
    if (threadIdx.x == 0) (void)xb_add(&bar[XB_XCNT(b.x)], 1u);
    return b;
}
__device__ __forceinline__ void xcd_barrier_complete(unsigned* bar, unsigned x, unsigned& nloc, unsigned& nx) {
    const unsigned G = gridDim.x * gridDim.y * gridDim.z;
    unsigned sum, cnt, mine, sp = 0u;
    for (;;) {
        sum = 0u; cnt = 0u; mine = 0u;
#pragma unroll
        for (unsigned j = 0; j < 16; ++j) { const unsigned c = xb_ld(&bar[XB_XCNT(j)]); sum += c; cnt += (c > 0u) ? 1u : 0u; mine = (j == x) ? c : mine; }
        if (sum == G) break;
        __builtin_amdgcn_s_sleep(1);
        if ((++sp & 255u) == 0u) { if (xb_ld(&bar[XB_TMO])) break; if (sp > XB_SPIN_CAP) { atomicAdd(&bar[XB_TMO], 1u); break; } }
    }
    nloc = mine > 0u ? mine : 1u; nx = cnt > 0u ? cnt : 1u;
}
__device__ __forceinline__ void xcd_barrier(const XcdBarrier& b) {
    asm volatile("s_waitcnt vmcnt(0)" ::: "memory");
    __syncthreads();
    if (threadIdx.x == 0) {
        unsigned* bar = b.bar;
        __builtin_amdgcn_s_waitcnt(0);
        unsigned nloc = b.st[0], nx = b.st[1];
        if (nloc == 0u) { xcd_barrier_complete(bar, b.x, nloc, nx); b.st[0] = nloc; b.st[1] = nx; }
        const unsigned old = xb_add(&bar[XB_XSUB(b.x)], 1u);
        const unsigned gen = old / nloc;
        if (old + 1u == (gen + 1u) * nloc) {
            __builtin_amdgcn_fence(__ATOMIC_RELEASE, "agent");
            asm volatile("s_waitcnt vmcnt(0)" ::: "memory");
            const unsigned og = xb_add(&bar[XB_TOP], 1u);
            const unsigned tg = og / nx;
            if (og + 1u == (tg + 1u) * nx) xb_add(&bar[XB_TOPGEN], 1u);
            else XB_SPIN(xb_ld(&bar[XB_TOPGEN]) == tg, bar);
            __builtin_amdgcn_fence(__ATOMIC_ACQUIRE, "agent");
            xb_add(&bar[XB_XGEN(b.x)], 1u);
            asm volatile("s_waitcnt vmcnt(0)" ::: "memory");
        } else {
            XB_SPIN(xb_ld(&bar[XB_XGEN(b.x)]) == gen, bar);
            __builtin_amdgcn_fence(__ATOMIC_ACQUIRE, "agent");
            asm volatile("s_waitcnt vmcnt(0)" ::: "memory");
        }
    }
    __syncthreads();
}

constexpr int NWAVES = 8;
constexpr int RING_BYTES = 131072, LDSCTL_OFF = RING_BYTES, MISC_OFF = LDSCTL_OFF + 320, LDS_BYTES = 147456;
constexpr int CW_BAR = 4096;

struct Args { const void* in[20]; float* out; unsigned char* ws; int ph_lo, ph_hi; };

__device__ __forceinline__ int win_srccol(int n) {
    if (n < 2048) return 2224 + n;
    if (n < 2560) return 1712 + (n - 2048);
    if (n < 2816) return 672 + (n - 2560);
    if (n < 3328) return 1184 + (n - 2816);
    if (n < 3584) return 928 + (n - 3328);
    if (n < 3968) return 0 + (n - 3584);
    if (n < 4224) return 384 + (n - 3968);
    if (n < 4256) return 640 + (n - 4224);
    if (n < 4272) return 1696 + (n - 4256);
    return -1;
}
__device__ __forceinline__ void transpose_item(const float* __restrict__ W, int K, int Nsrc, bf16_t* __restrict__ WT, int Nout, const float* __restrict__ kscale, bool winperm, float* scr, int item, int lane) {
    const int nblk = Nout / 32, kb = item / nblk, nb = item % nblk, k0 = 64 * kb, n0 = 32 * nb;
    const int n = n0 + (lane & 31); const int sc = winperm ? win_srccol(n) : n;
#pragma unroll 8
    for (int i = 0; i < 32; ++i) { const int kk = 2 * i + (lane >> 5); float v = 0.f; if (sc >= 0) { v = W[(size_t)(k0 + kk) * Nsrc + sc]; if (kscale) v *= kscale[k0 + kk]; } scr[kk * 33 + (lane & 31)] = v; }
    asm volatile("s_waitcnt lgkmcnt(0)" ::: "memory");
    const int c = lane & 7;
#pragma unroll
    for (int j = 0; j < 4; ++j) { const int nn = (lane >> 3) + 8 * j; const float* s = scr + (8 * c) * 33 + nn;
        u32x4 o; o.x = pk2(s[0 * 33], s[1 * 33]); o.y = pk2(s[2 * 33], s[3 * 33]); o.z = pk2(s[4 * 33], s[5 * 33]); o.w = pk2(s[6 * 33], s[7 * 33]);
        *(u32x4*)(WT + (size_t)(n0 + nn) * K + k0 + 8 * c) = o; }
    asm volatile("s_waitcnt lgkmcnt(0)" ::: "memory");
}

#define TOPK_INSERT(tv, ti, vv, ii) do { float v_ = (vv); int i_ = (ii); \
    _Pragma("unroll") for (int q_ = 0; q_ < 16; ++q_) { const bool gt_ = (v_ > tv[q_]) || (v_ == tv[q_] && i_ < ti[q_]); const float tv_ = tv[q_]; const int ti_ = ti[q_]; \
        tv[q_] = gt_ ? v_ : tv_; ti[q_] = gt_ ? i_ : ti_; v_ = gt_ ? tv_ : v_; i_ = gt_ ? ti_ : i_; } } while (0)

__device__ __forceinline__ void quant_rows2(const float* __restrict__ tab, const float* __restrict__ g, unsigned char* __restrict__ qt, float* __restrict__ sc, int row0, int lane) {
    f32x4 v[2][4];
#pragma unroll
    for (int rr = 0; rr < 2; ++rr)
#pragma unroll
        for (int j = 0; j < 4; ++j) v[rr][j] = *(const f32x4*)(tab + (size_t)(row0 + rr) * 1024 + 16 * lane + 4 * j);
#pragma unroll
    for (int rr = 0; rr < 2; ++rr) {
        float mx = 0.f;
#pragma unroll
        for (int j = 0; j < 4; ++j) { if (g) v[rr][j] = v[rr][j] * *(const f32x4*)(g + 16 * lane + 4 * j);
            mx = fmaxf(mx, fmaxf(fmaxf(fabsf(v[rr][j][0]), fabsf(v[rr][j][1])), fmaxf(fabsf(v[rr][j][2]), fabsf(v[rr][j][3])))); }
#pragma unroll
        for (int o = 1; o < 64; o <<= 1) mx = fmaxf(mx, __shfl_xor(mx, o));
        mx = fmaxf(mx, 1e-30f);
        const float inv = 127.f / mx;
        u32x4 w;
#pragma unroll
        for (int j = 0; j < 4; ++j) { unsigned b = 0;
#pragma unroll
            for (int e = 0; e < 4; ++e) { const int q = (int)rintf(v[rr][j][e] * inv) + 128; b |= (unsigned)q << (8 * e); }
            w[j] = b; }
        *(u32x4*)(qt + (size_t)(row0 + rr) * 1024 + 16 * lane) = w;
        if (lane == 0) sc[row0 + rr] = mx * (1.f / 127.f);
    }
}
typedef __bf16 bf2_t __attribute__((ext_vector_type(2)));
__device__ __forceinline__ float dot2_bf16(unsigned a, unsigned b, float acc) { return __builtin_amdgcn_fdot2_f32_bf16(__builtin_bit_cast(bf2_t, a), __builtin_bit_cast(bf2_t, b), acc, false); }
__global__ void __launch_bounds__(NWAVES * 64, 2) fwd(Args args) {
    extern __shared__ __attribute__((aligned(16))) unsigned char lds[];
    const int tid = threadIdx.x, lane = tid & 63, wave = __builtin_amdgcn_readfirstlane(tid >> 6);
    const int G = gridDim.x; int vcu; { const int bx = blockIdx.x; vcu = (G % 8 == 0) ? (bx % 8) * (G / 8) + bx / 8 : bx; }
    const int gw = vcu * NWAVES + wave, NGW = G * NWAVES, gtid = vcu * 512 + tid, NT = G * 512;
    unsigned char* ws = args.ws;
    const float* x = (const float*)args.in[0]; const int* positions = (const int*)args.in[1];
    const float* g_mix = (const float*)args.in[2]; const float* w_in = (const float*)args.in[3]; const float* g_q_lat = (const float*)args.in[4]; const float* w_qb = (const float*)args.in[5];
    const float* g_kv_lat = (const float*)args.in[6]; const float* w_kvb = (const float*)args.in[7]; const float* w_a2 = (const float*)args.in[8]; const float* b_a2 = (const float*)args.in[9];
    const float* g_gla = (const float*)args.in[10]; const float* w_branch_a = (const float*)args.in[11]; const float* w_branch_b = (const float*)args.in[12]; const float* w_out = (const float*)args.in[13];
    const float* g_ffn = (const float*)args.in[14]; const float* w_peer_q = (const float*)args.in[15]; const float* sub_keys = (const float*)args.in[16]; const float* peer_u = (const float*)args.in[17];
    const float* peer_v = (const float*)args.in[18]; const float* g_final = (const float*)args.in[19];
    float* out = args.out;
    float* SSQ = (float*)(ws + WS_SSQ); float* SSKV = (float*)(ws + WS_SSKV); float* SSX1 = (float*)(ws + WS_SSX1); float* COS = (float*)(ws + WS_COS); float* SIN = (float*)(ws + WS_SIN);
    float* DECAY = (float*)(ws + WS_DECAY);
    bf16_t* WIN = (bf16_t*)(ws + WS_WIN); bf16_t* WQB = (bf16_t*)(ws + WS_WQB); bf16_t* WKVB = (bf16_t*)(ws + WS_WKVB); bf16_t* WA = (bf16_t*)(ws + WS_WA); bf16_t* WB = (bf16_t*)(ws + WS_WB);
    bf16_t* WOUT = (bf16_t*)(ws + WS_WOUT); bf16_t* WPQ = (bf16_t*)(ws + WS_WPQ); bf16_t* KEYS = (bf16_t*)(ws + WS_KEYS);
    bf16_t* PROJB = (bf16_t*)(ws + WS_PROJB); bf16_t* PROJA = (bf16_t*)(ws + WS_PROJA); bf16_t* XN = (bf16_t*)(ws + WS_XN);
    bf16_t* Q = (bf16_t*)(ws + WS_Q); bf16_t* K = (bf16_t*)(ws + WS_K); bf16_t* V = (bf16_t*)(ws + WS_V); float* DST = (float*)(ws + WS_DST);
    bf16_t* YA = (bf16_t*)(ws + WS_YA); bf16_t* YB = (bf16_t*)(ws + WS_YB); bf16_t* MERGED = (bf16_t*)(ws + WS_MERGED); bf16_t* X1B = (bf16_t*)(ws + WS_X1B); bf16_t* QP = (bf16_t*)(ws + WS_QP);
    int* EIDX = (int*)(ws + WS_EIDX); float* EGATE = (float*)(ws + WS_EGATE); unsigned char* UT = ws + WS_UT; unsigned char* VT = ws + WS_VT; float* SU = (float*)(ws + WS_SU); float* SV = (float*)(ws + WS_SV);

    for (int u = tid; u < (LDS_BYTES - LDSCTL_OFF) / 4; u += NWAVES * 64) ((unsigned*)(lds + LDSCTL_OFF))[u] = 0u;
    __syncthreads();
    XcdBarrier bar; bar.bar = (unsigned*)(ws + WS_CTL) + CW_BAR; bar.x = 0; bar.st = nullptr;
    if (MK_N_LAUNCHES == 1) bar = xcd_barrier_post((unsigned*)(ws + WS_CTL) + CW_BAR, (volatile LAS unsigned*)(lds + MISC_OFF) + 8);
    const int lo = args.ph_lo, hi = args.ph_hi;
#define IN(k) (lo <= (k) && (k) < hi)
#define SEAM(k) do { if (MK_N_LAUNCHES == 1) { if (IN(k) && IN((k) + 1)) xcd_barrier(bar); } } while (0)
    PG8_LAS unsigned char* ring = (PG8_LAS unsigned char*)lds;

    if (IN(0)) {
        for (int i = gtid; i < 3 * M_; i += NT) SSQ[i] = 0.f;
        float* scr = (float*)(lds + wave * 16384);
        constexpr int I_WIN = 16 * (NPROJ / 32), I_QB = 6 * 24, I_KVB = 4 * 32, I_A = 8 * 32, I_OUT = 16 * 32, I_PQ = 16 * 64;
        constexpr int NITEMS = I_WIN + I_QB + I_KVB + 2 * I_A + I_OUT + I_PQ;
        for (int it = gw; it < NITEMS; it += NGW) {
            int r = it;
            if (r < I_WIN) { transpose_item(w_in, 1024, 4272, WIN, NPROJ, nullptr, true, scr, r, lane); continue; } r -= I_WIN;
            if (r < I_QB) { transpose_item(w_qb, 384, 768, WQB, 768, g_q_lat, false, scr, r, lane); continue; } r -= I_QB;
            if (r < I_KVB) { transpose_item(w_kvb, 256, 1024, WKVB, 1024, g_kv_lat, false, scr, r, lane); continue; } r -= I_KVB;
            if (r < I_A) { transpose_item(w_branch_a, 512, 1024, WA, 1024, nullptr, false, scr, r, lane); continue; } r -= I_A;
            if (r < I_A) { transpose_item(w_branch_b, 512, 1024, WB, 1024, nullptr, false, scr, r, lane); continue; } r -= I_A;
            if (r < I_OUT) { transpose_item(w_out, 1024, 1024, WOUT, 1024, nullptr, false, scr, r, lane); continue; } r -= I_OUT;
            transpose_item(w_peer_q, 1024, 2048, WPQ, 2048, g_ffn, false, scr, r, lane);
        }
        for (int i = gtid; i < 16 * 128 * 128; i += NT) KEYS[i] = f2bf(sub_keys[i]);
        for (int i = gtid; i < M_ * 16; i += NT) { const int m = i >> 4, f = i & 15;
            const double inv = pow(10000.0, -(double)f / 16.0); const double ang = (double)positions[m] * inv;
            COS[i] = (float)cos(ang); SIN[i] = (float)sin(ang); }
        for (int row = gw; row < M_; row += NGW) {
            const f32x4* xr = (const f32x4*)(x + (size_t)row * DM); f32x4 v[4]; float ss = 0.f;
#pragma unroll
            for (int j = 0; j < 4; ++j) { v[j] = xr[lane + 64 * j]; ss += (v[j][0] * v[j][0] + v[j][1] * v[j][1]) + (v[j][2] * v[j][2] + v[j][3] * v[j][3]); }
            ss = wave_sum(ss); const float r = rsqrtf(ss * (1.f / DM) + EPS);
#pragma unroll
            for (int j = 0; j < 4; ++j) { const int c = 4 * (lane + 64 * j); const f32x4 gg = *(const f32x4*)(g_mix + c);
                u32x2 w; w.x = pk2(v[j][0] * r * gg[0], v[j][1] * r * gg[1]); w.y = pk2(v[j][2] * r * gg[2], v[j][3] * r * gg[3]);
                *(u32x2*)(XN + (size_t)row * DM + c) = w; }
        }
    }
    SEAM(0);
    if (IN(1)) {
        pg8::Gemm g{XN, WIN, nullptr, nullptr, DM, DM, M_, NPROJ, DM, 1}; pg8::StaticOrder S; S.init(g, G, (int)blockIdx.x);
        pg8::EpiProj E{PROJB, PROJA, SSQ, SSKV};
        pg8::gemm_phase<pg8::EpiProj, pg8::StaticOrder, true>(ring, g, S, E);
    }
    SEAM(1);
    if (IN(2)) {
        { pg8::Gemm g{PROJA + PA_QLAT, WQB, nullptr, nullptr, PA_LD, 384, M_, 768, 384, 1}; pg8::StaticOrder S; S.init(g, G, (int)blockIdx.x);
          pg8::EpiQ E{Q, SSQ, COS, SIN}; pg8::gemm_phase<pg8::EpiQ, pg8::StaticOrder, true>(ring, g, S, E); }
        { pg8::Gemm g{PROJA + PA_KVLAT, WKVB, nullptr, nullptr, PA_LD, 256, M_, 1024, 256, 1}; pg8::StaticOrder S; S.init(g, G, (int)blockIdx.x);
          pg8::EpiKV E{K, V, SSKV}; pg8::gemm_phase<pg8::EpiKV, pg8::StaticOrder, true>(ring, g, S, E); }
        for (int i = gtid; i < M_ * 32; i += NT) { const int m = i >> 5, j = i & 31; const bf16_t* kr = PROJA + (size_t)m * PA_LD + PA_KROPE; float o;
            if (j < 16) { const float x1 = bf2f(kr[j]), x2 = bf2f(kr[j + 16]); o = x1 * COS[m * 16 + j] - x2 * SIN[m * 16 + j]; }
            else { const int f = j - 16; const float x2 = bf2f(kr[j]), x1 = bf2f(kr[j - 16]); o = x2 * COS[m * 16 + f] + x1 * SIN[m * 16 + f]; }
            const bf16_t ob = f2bf(o);
#pragma unroll
            for (int h = 0; h < 8; ++h) K[(size_t)m * 768 + h * 96 + 64 + j] = ob; }
        __syncthreads();
        {
            const int half = tid >> 8, t256 = tid & 255;
            float* lb = (float*)(lds + half * 65536);
            float (*cum)[64] = (float (*)[64])lb; float (*kd)[64] = (float (*)[64])(lb + 4096); float (*gvs)[128] = (float (*)[128])(lb + 8192);
            for (int vb0 = vcu * 2; vb0 < 2 * NCH * 4; vb0 += 2 * G) {
                const int vb = vb0 + half; const int h = vb & 3, bc = vb >> 2, t0 = bc * 64;
                { const int k = t256 & 63; float w[16];
#pragma unroll
                  for (int r = 0; r < 16; ++r) w[r] = w_a2[r * 256 + h * 64 + k];
                  const float bias = b_a2[h * 64 + k];
#pragma unroll 1
                  for (int l = t256 >> 6; l < 64; l += 4) { const bf16_t* gl = PROJA + (size_t)(t0 + l) * PA_LD + PA_GLR; float z = bias;
#pragma unroll
                      for (int r = 0; r < 16; ++r) z += bf2f(gl[r]) * w[r];
                      const float ls = fminf(z, 0.f) - log1pf(expf(-fabsf(z))); cum[l][k] = ls * (1.f / 16.f); } }
                __syncthreads();
                if (t256 < 64) { float s = 0.f; for (int l = 0; l < 64; ++l) { s += cum[l][t256]; cum[l][t256] = s; } }
                __syncthreads();
#pragma unroll 2
                for (int i = t256; i < 64 * 64; i += 256) { const int l = i >> 6, k = i & 63; kd[l][k] = bf2f(PROJA[(size_t)(t0 + l) * PA_LD + PA_GK + h * 64 + k]) * expf(cum[63][k] - cum[l][k]); }
#pragma unroll 4
                for (int i = t256; i < 64 * 128; i += 256) { const int l = i >> 7, v = i & 127; gvs[l][v] = bf2f(PROJA[(size_t)(t0 + l) * PA_LD + PA_GV + h * 128 + v]); }
                if (t256 < 64) DECAY[((size_t)bc * 4 + h) * 64 + t256] = expf(cum[63][t256]);
                __syncthreads();
                { const int v = t256 & 127, kb = (t256 >> 7) * 32;
                  for (int kk = 0; kk < 32; ++kk) { const int k = kb + kk; float s = 0.f;
                      for (int l = 0; l < 64; ++l) s += kd[l][k] * gvs[l][v];
                      DST[(((size_t)bc * 4 + h) * 64 + k) * 128 + v] = s; } }
                __syncthreads();
            }
        }
    }
    SEAM(2);
    if (IN(3)) {
        if (tid < 256) for (int i = vcu * 256 + tid; i < 65536; i += G * 256) {
            const int v = i & 127, k = (i >> 7) & 63, h = (i >> 13) & 3, b = i >> 15; float s = 0.f;
            float* dp = DST + (((size_t)b * NCH * 4 + h) * 64 + k) * 128 + v; const float* gp = DECAY + ((size_t)b * NCH * 4 + h) * 64 + k;
            for (int c0 = 0; c0 < NCH; c0 += 8) { float d[8], g[8];
#pragma unroll
                for (int j = 0; j < 8; ++j) { d[j] = dp[(size_t)(c0 + j) * 32768]; g[j] = gp[(size_t)(c0 + j) * 256]; }
#pragma unroll
                for (int j = 0; j < 8; ++j) { s = g[j] * s + d[j]; d[j] = s; }
#pragma unroll
                for (int j = 0; j < 8; ++j) dp[(size_t)(c0 + j) * 32768] = d[j]; } }
        __syncthreads();
        {
            for (int pr = vcu; pr < 256; pr += G) {
                const int bh = pr >> 4, s16 = pr & 15, b = bh >> 3, h = bh & 7;
                att::BlockRef r0, r1;
                const bf16_t* Kh = K + (size_t)b * SEQ * att::KS + h * 96; const bf16_t* Vh = V + (size_t)b * SEQ * att::VS + h * 64;
                const int qb0 = 31 - s16, qb1 = s16;
                r0.Q = Q + ((size_t)b * SEQ + qb0 * 256) * att::QS + h * 96; r0.O = YA + ((size_t)b * SEQ + qb0 * 256) * att::OS + h * 64; r0.K = Kh; r0.V = Vh; r0.P0 = qb0 * 256;
                r1.Q = Q + ((size_t)b * SEQ + qb1 * 256) * att::QS + h * 96; r1.O = YA + ((size_t)b * SEQ + qb1 * 256) * att::OS + h * 64; r1.K = Kh; r1.V = Vh; r1.P0 = qb1 * 256;
                att::Seam S;
                att::attn_prime(r0, (char*)lds, S);
                att::attn_block(r0, r1, (char*)lds, S);
                att::attn_block(r1, r1, (char*)lds, S);
            }
        }
    }
    SEAM(3);
    if (IN(4)) {
        const int half = tid >> 8, t256 = tid & 255;
        float* lb = (float*)(lds + half * 65536);
        float (*ss)[128] = (float (*)[128])lb; float (*qs)[65] = (float (*)[65])(lb + 8192);
        for (int vb0 = vcu * 2; vb0 < 2 * NCH * 4; vb0 += 2 * G) {
            const int vb = vb0 + half; const int h = vb & 3, bc = vb >> 2, t0 = bc * 64;
            const float* sp = DST + ((size_t)bc * 4 + h) * 64 * 128;
            for (int i = t256; i < 64 * 128; i += 256) ss[i >> 7][i & 127] = sp[i];
            for (int i = t256; i < 64 * 64; i += 256) { const int l = i >> 6, k = i & 63; qs[l][k] = bf2f(PROJB[(size_t)(t0 + l) * PB_LD + PB_GQ + h * 64 + k]) * 0.125f; }
            __syncthreads();
            { const int l = t256 >> 2, vg = t256 & 3; float o[32];
#pragma unroll
              for (int j = 0; j < 32; ++j) o[j] = 0.f;
              for (int k = 0; k < 64; ++k) { const float qv = qs[l][k];
#pragma unroll
                  for (int j = 0; j < 32; ++j) o[j] += qv * ss[k][vg * 32 + j]; }
              float s2 = 0.f;
#pragma unroll
              for (int j = 0; j < 32; ++j) s2 += o[j] * o[j];
              s2 += __shfl_xor(s2, 1); s2 += __shfl_xor(s2, 2);
              const float r = rsqrtf(s2 * (1.f / 128.f) + EPS);
#pragma unroll
              for (int j = 0; j < 32; ++j) { const int v = vg * 32 + j; const float go = bf2f(PROJB[(size_t)(t0 + l) * PB_LD + PB_GOUT + h * 128 + v]); const float silu = go / (1.f + __expf(-go));
                  YB[(size_t)(t0 + l) * 512 + h * 128 + v] = f2bf(o[j] * r * g_gla[h * 128 + v] * silu); } }
            __syncthreads();
        }
    }
    if (IN(4)) {
        for (int row = gw * 2; row < 16384; row += NGW * 2) quant_rows2(peer_u, g_ffn, UT, SU, row, lane);
    }
    SEAM(4);
    if (IN(5)) {
        for (int row = gw * 2; row < 16384; row += NGW * 2) quant_rows2(peer_v, nullptr, VT, SV, row, lane);
        __syncthreads();
        pg8::Gemm g{YA, WA, YB, WB, 512, 512, M_, 1024, 512, 2}; pg8::StaticOrder S; S.init(g, G, (int)blockIdx.x);
        pg8::EpiMerge E{PROJB, MERGED}; pg8::gemm_phase<pg8::EpiMerge, pg8::StaticOrder, false>(ring, g, S, E);
    }
    SEAM(5);
    if (IN(6)) {
        pg8::Gemm g{MERGED, WOUT, nullptr, nullptr, DM, DM, M_, 1024, DM, 1}; pg8::StaticOrder S; S.init(g, G, (int)blockIdx.x);
        pg8::EpiX1 E{x, out, X1B, SSX1}; pg8::gemm_phase<pg8::EpiX1, pg8::StaticOrder, false>(ring, g, S, E);
    }
    SEAM(6);
    if (IN(7)) {
        pg8::Gemm g{X1B, WPQ, nullptr, nullptr, DM, DM, M_, 2048, DM, 1}; pg8::StaticOrder S; S.init(g, G, (int)blockIdx.x);
        pg8::EpiQP E{QP, SSX1}; pg8::gemm_phase<pg8::EpiQP, pg8::StaticOrder, true>(ring, g, S, E);
    }
    SEAM(7);
    if (IN(8)) {
        typedef short bf16x8_t __attribute__((ext_vector_type(8)));
        typedef float f32x16_t __attribute__((ext_vector_type(16)));
        const int r32 = lane & 31, hi = lane >> 5;
#define P8_SORTABLE(f) ({ const unsigned b_ = __float_as_uint(f); b_ ^ ((unsigned)((int)b_ >> 31) | 0x80000000u); })
#define P8_UNSORT(u) ({ const unsigned u_ = (u); __uint_as_float(u_ ^ (~(unsigned)((int)u_ >> 31) | 0x80000000u)); })
#define P8_INSERT(t, v) do { unsigned v_ = (v); _Pragma("unroll") for (int q_ = 0; q_ < 16; ++q_) { const unsigned a_ = t[q_] > v_ ? t[q_] : v_; v_ = t[q_] > v_ ? v_ : t[q_]; t[q_] = a_; } } while (0)
        for (int item = vcu; item < 256; item += G) {
            const int h = item & 7, tr = item >> 3;
            for (int c = tid; c < 2 * 128 * 16; c += 512) { const int p = c >> 11, row = (c >> 4) & 127, ch = c & 15;
                const u32x4 v = *(const u32x4*)(KEYS + ((size_t)(h * 2 + p) * 128 + row) * 128 + ch * 8);
                *(u32x4*)(lds + p * 32768 + row * 256 + ((ch * 16) ^ ((row & 7) << 4))) = v; }
            __syncthreads();
#pragma unroll 1
            for (int step = 0; step < 2; ++step) {
                const int m = tr * 512 + wave * 64 + step * 32 + r32;
                unsigned top[2][16];
#pragma unroll
                for (int p = 0; p < 2; ++p) {
                    bf16x8_t qf[8];
#pragma unroll
                    for (int ks = 0; ks < 8; ++ks) qf[ks] = *(const bf16x8_t*)(QP + (size_t)m * 2048 + (h * 2 + p) * 128 + ks * 16 + hi * 8);
                    f32x16_t acc[4];
#pragma unroll
                    for (int kt = 0; kt < 4; ++kt) { acc[kt] = f32x16_t{};
                        const int row = kt * 32 + r32; const unsigned char* rb = lds + p * 32768 + row * 256;
#pragma unroll
                        for (int ks = 0; ks < 8; ++ks) { const bf16x8_t a = *(const bf16x8_t*)(rb + (((2 * ks + hi) * 16) ^ ((row & 7) << 4)));
                            acc[kt] = __builtin_amdgcn_mfma_f32_32x32x16_bf16(a, qf[ks], acc[kt], 0, 0, 0); } }
                    unsigned t[16];
#pragma unroll
                    for (int i = 0; i < 16; ++i) t[i] = 0u;
#pragma unroll
                    for (int kt = 0; kt < 4; ++kt)
#pragma unroll
                        for (int r = 0; r < 16; ++r) { const unsigned base = 32 * kt + (r & 3) + 8 * (r >> 2);
                            const unsigned pk = (P8_SORTABLE(acc[kt][r]) | 127u) ^ base; P8_INSERT(t, pk); }
#pragma unroll
                    for (int i = 0; i < 16; ++i) t[i] ^= (unsigned)(hi << 2);
                    unsigned mm[16];
#pragma unroll
                    for (int i = 0; i < 16; ++i) { auto rr = __builtin_amdgcn_permlane32_swap(t[15 - i], t[15 - i], false, false); const unsigned pt = hi ? rr[0] : rr[1]; mm[i] = t[i] > pt ? t[i] : pt; }
#pragma unroll
                    for (int sft = 8; sft >= 1; sft >>= 1)
#pragma unroll
                        for (int i = 0; i < 16; ++i) if ((i & sft) == 0) { const unsigned a_ = mm[i] > mm[i + sft] ? mm[i] : mm[i + sft], b_ = mm[i] > mm[i + sft] ? mm[i + sft] : mm[i]; mm[i] = a_; mm[i + sft] = b_; }
#pragma unroll
                    for (int i = 0; i < 16; ++i) top[p][i] = mm[i];
                }
                float f0[16], f1[16];
#pragma unroll
                for (int i = 0; i < 16; ++i) { f0[i] = P8_UNSORT(top[0][i] & 0xFFFFFF80u); f1[i] = P8_UNSORT(top[1][i] & 0xFFFFFF80u); }
                unsigned cb[16];
#pragma unroll
                for (int i = 0; i < 16; ++i) cb[i] = 0u;
#define P8_CAND(a, b) do { const float sv_ = f0[a] + f1[b]; const unsigned pk_ = (P8_SORTABLE(sv_) | 255u) ^ (unsigned)((a) * 16 + (b)); P8_INSERT(cb, pk_); } while (0)
#pragma unroll
                for (int b = 0; b < 16; ++b) P8_CAND(0, b);
#pragma unroll
                for (int b = 0; b < 8; ++b) P8_CAND(1, b);
#pragma unroll
                for (int b = 0; b < 5; ++b) P8_CAND(2, b);
#pragma unroll
                for (int b = 0; b < 4; ++b) P8_CAND(3, b);
#pragma unroll
                for (int b = 0; b < 3; ++b) P8_CAND(4, b);
#pragma unroll
                for (int b = 0; b < 2; ++b) { P8_CAND(5, b); P8_CAND(6, b); P8_CAND(7, b); }
                P8_CAND(8, 0); P8_CAND(9, 0); P8_CAND(10, 0); P8_CAND(11, 0); P8_CAND(12, 0); P8_CAND(13, 0); P8_CAND(14, 0); P8_CAND(15, 0);
#undef P8_CAND
                unsigned char* slot = lds + 65536 + wave * 2048 + lane * 32;
                { u32x4 w0, w1;
#define P8_IDX4(T, i) ((127u - (T[i] & 127u)) | ((127u - (T[(i) + 1] & 127u)) << 8) | ((127u - (T[(i) + 2] & 127u)) << 16) | ((127u - (T[(i) + 3] & 127u)) << 24))
                  w0.x = P8_IDX4(top[0], 0); w0.y = P8_IDX4(top[0], 4); w0.z = P8_IDX4(top[0], 8); w0.w = P8_IDX4(top[0], 12);
                  w1.x = P8_IDX4(top[1], 0); w1.y = P8_IDX4(top[1], 4); w1.z = P8_IDX4(top[1], 8); w1.w = P8_IDX4(top[1], 12);
#undef P8_IDX4
                  *(u32x4*)slot = w0; *(u32x4*)(slot + 16) = w1; }
                asm volatile("s_waitcnt lgkmcnt(0)" ::: "memory");
                float bv[16]; int be[16];
#pragma unroll
                for (int k = 0; k < 16; ++k) { const unsigned pos = (~cb[k]) & 255u; bv[k] = P8_UNSORT(cb[k] & 0xFFFFFF00u);
                    be[k] = (int)slot[pos >> 4] * 128 + (int)slot[16 + (pos & 15)]; }
                { const float b0 = bv[0];
#pragma unroll
                  for (int k = 0; k < 16; ++k) bv[k] = __expf(bv[k] - b0); }
                asm volatile("s_waitcnt lgkmcnt(0)" ::: "memory");
                if (hi == 0) { int* ep = EIDX + (size_t)m * 128 + h * 16;
#pragma unroll
                    for (int q = 0; q < 4; ++q) { u32x4 w; w.x = (unsigned)be[4 * q]; w.y = (unsigned)be[4 * q + 1]; w.z = (unsigned)be[4 * q + 2]; w.w = (unsigned)be[4 * q + 3]; *(u32x4*)(ep + 4 * q) = w; } }
                else { float* gp = EGATE + (size_t)m * 128 + h * 16; float s2 = 0.f;
#pragma unroll
                    for (int k = 0; k < 16; ++k) s2 += bv[k];
                    const float inv = 1.f / s2;
#pragma unroll
                    for (int q = 0; q < 4; ++q) { f32x4 w; w[0] = bv[4 * q] * inv; w[1] = bv[4 * q + 1] * inv; w[2] = bv[4 * q + 2] * inv; w[3] = bv[4 * q + 3] * inv; *(f32x4*)(gp + 4 * q) = w; } }
            }
            __syncthreads();
        }
#undef P8_SORTABLE
#undef P8_UNSORT
#undef P8_INSERT
    }
    SEAM(8);
    if (IN(9)) {
#define ROR_ADD(v, n) v += __builtin_bit_cast(float, __builtin_amdgcn_update_dpp(0, __builtin_bit_cast(int, v), 0x120 + (n), 0xf, 0xf, false))
#define UB(w, e) ((float)(((w) >> (8 * (e))) & 0xffu))
        const int hi = lane >> 5;
        for (int m = gw; m < M_; m += NGW) {
            float xf[16];
            { const u32x4 xa = *(const u32x4*)(X1B + (size_t)m * DM + 16 * lane), xb = *(const u32x4*)(X1B + (size_t)m * DM + 16 * lane + 8);
#pragma unroll
              for (int q = 0; q < 4; ++q) { xf[2 * q] = __uint_as_float(xa[q] << 16); xf[2 * q + 1] = __uint_as_float(xa[q] & 0xffff0000u); xf[8 + 2 * q] = __uint_as_float(xb[q] << 16); xf[8 + 2 * q + 1] = __uint_as_float(xb[q] & 0xffff0000u); } }
            float xs = 0.f;
#pragma unroll
            for (int j = 0; j < 16; ++j) xs += xf[j];
            const float X128 = 128.f * wave_sum(xs);
            const float r = rsqrtf(SSX1[m] * (1.f / DM) + EPS);
            const int e_lo = EIDX[(size_t)m * 128 + lane], e_hi = EIDX[(size_t)m * 128 + 64 + lane];
            const float g_lo = EGATE[(size_t)m * 128 + lane], g_hi = EGATE[(size_t)m * 128 + 64 + lane];
            const float su_lo = SU[e_lo], su_hi = SU[e_hi], sv_lo = SV[e_lo], sv_hi = SV[e_hi];
            float y[16]; float asum = 0.f;
#pragma unroll
            for (int j = 0; j < 16; ++j) y[j] = 0.f;
#pragma unroll 1
            for (int h = 0; h < 8; ++h) {
                const int ev = (h < 4) ? e_lo : e_hi; const float gv = (h < 4) ? g_lo : g_hi, suv = (h < 4) ? su_lo : su_hi, svv = (h < 4) ? sv_lo : sv_hi; const int l0 = (h & 3) * 16;
                float p[16];
#pragma unroll
                for (int k = 0; k < 16; ++k) { const int e = __builtin_amdgcn_readlane(ev, l0 + k);
                    const u32x4 u = *(const u32x4*)(UT + (size_t)e * 1024 + 16 * lane);
                    float a = 0.f;
#pragma unroll
                    for (int q = 0; q < 4; ++q) { const unsigned w_ = u[q]; a += xf[4 * q] * UB(w_, 0); a += xf[4 * q + 1] * UB(w_, 1); a += xf[4 * q + 2] * UB(w_, 2); a += xf[4 * q + 3] * UB(w_, 3); }
                    p[k] = a; }
                float w[8];
#pragma unroll
                for (int j = 0; j < 8; ++j) { auto rr = __builtin_amdgcn_permlane32_swap(__float_as_uint(p[j]), __float_as_uint(p[j + 8]), false, false); w[j] = __uint_as_float(rr[0]) + __uint_as_float(rr[1]); }
#pragma unroll
                for (int j = 0; j < 8; ++j) { w[j] += __shfl_xor(w[j], 16); ROR_ADD(w[j], 8); ROR_ADD(w[j], 4); ROR_ADD(w[j], 2); ROR_ADD(w[j], 1); }
                float z = w[0];
#pragma unroll
                for (int j = 1; j < 8; ++j) z = ((lane & 7) == j) ? w[j] : z;
                const int src = l0 + (lane & 7) + 8 * hi;
                z = (z - X128) * __shfl(suv, src) * r;
                const float a = 0.5f * z * (1.f + erff(z * 0.70710678118654752f)) * __shfl(gv, src) * __shfl(svv, src);
                asum += a;
#pragma unroll
                for (int k = 0; k < 16; ++k) { const int e = __builtin_amdgcn_readlane(ev, l0 + k); const float c = __builtin_bit_cast(float, __builtin_amdgcn_readlane(__builtin_bit_cast(int, a), (k & 7) + 32 * (k >> 3)));
                    const u32x4 v = *(const u32x4*)(VT + (size_t)e * 1024 + 16 * lane);
#pragma unroll
                    for (int q = 0; q < 4; ++q) { const unsigned w_ = v[q]; y[4 * q] += c * UB(w_, 0); y[4 * q + 1] += c * UB(w_, 1); y[4 * q + 2] += c * UB(w_, 2); y[4 * q + 3] += c * UB(w_, 3); } }
            }
            const float c128 = 128.f * wave_sum((lane & 24) == 0 ? asum : 0.f);
            const float* xr = out + (size_t)m * DM + 16 * lane; float ss = 0.f;
#pragma unroll
            for (int q = 0; q < 4; ++q) { const f32x4 t = *(const f32x4*)(xr + 4 * q);
#pragma unroll
                for (int e = 0; e < 4; ++e) { y[4 * q + e] += t[e] - c128; ss += y[4 * q + e] * y[4 * q + e]; } }
            ss = wave_sum(ss); const float r2 = rsqrtf(ss * (1.f / DM) + EPS);
            float* orow = out + (size_t)m * DM + 16 * lane;
#pragma unroll
            for (int q = 0; q < 4; ++q) { const f32x4 gg = *(const f32x4*)(g_final + 16 * lane + 4 * q);
                f32x4 o; o[0] = y[4 * q] * r2 * gg[0]; o[1] = y[4 * q + 1] * r2 * gg[1]; o[2] = y[4 * q + 2] * r2 * gg[2]; o[3] = y[4 * q + 3] * r2 * gg[3];
                *(f32x4*)(orow + 4 * q) = o; }
        }
#undef ROR_ADD
#undef UB
    }
#undef IN
#undef SEAM
}

extern "C" void kernel_launch(void* const* d_in, const int* in_sizes, int n_in, void* d_out, int out_size, void* d_ws, size_t ws_size, hipStream_t stream) {
    static int grid = 0;
    if (grid == 0) {
        if (n_in != 20 || out_size != M_ * DM || ws_size < WS_END) { fprintf(stderr, "kernel_launch: unexpected shapes (n_in %d out %d ws %zu); nothing launched\n", n_in, out_size, ws_size); grid = -1; return; }
        int dev = 0, cus = 0;
        if (hipGetDevice(&dev) != hipSuccess || hipDeviceGetAttribute(&cus, hipDeviceAttributeMultiprocessorCount, dev) != hipSuccess) { grid = -1; return; }
        if (hipFuncSetAttribute((const void*)fwd, hipFuncAttributeMaxDynamicSharedMemorySize, LDS_BYTES) != hipSuccess) { fprintf(stderr, "kernel_launch: hipFuncSetAttribute failed\n"); grid = -1; return; }
        int per_cu = 0;
        if (hipOccupancyMaxActiveBlocksPerMultiprocessor(&per_cu, (const void*)fwd, NWAVES * 64, LDS_BYTES) != hipSuccess || per_cu < 1) fprintf(stderr, "kernel_launch: occupancy query reports %d\n", per_cu);
        (void)hipGetLastError();
        grid = cus;
    }
    if (grid < 0) return;
    (void)hipMemsetAsync((char*)d_ws + WS_CTL, 0, CTL_ZERO_BYTES, stream);
    Args a; memset(&a, 0, sizeof(a));
    for (int i = 0; i < 20; ++i) a.in[i] = d_in[i];
    a.out = (float*)d_out; a.ws = (unsigned char*)d_ws;
    if (MK_N_LAUNCHES == 1) { a.ph_lo = 0; a.ph_hi = N_PHASES; hipLaunchKernelGGL(fwd, dim3(grid), dim3(NWAVES * 64), LDS_BYTES, stream, a); }
    else for (int p = 0; p < N_PHASES; ++p) { a.ph_lo = p; a.ph_hi = p + 1; hipLaunchKernelGGL(fwd, dim3(grid), dim3(NWAVES * 64), LDS_BYTES, stream, a); }
}
```

```cpp
#include <hip/hip_runtime.h>
#include <cstdio>
#include <cstdint>
#include <cstring>
#include <math.h>

#ifndef MK_N_LAUNCHES
#define MK_N_LAUNCHES 1
#endif
constexpr int N_PHASES = 10;

typedef unsigned short bf16_t;
constexpr int SEQ = 8192, DM = 1024, M_ = 16384, NCH = 128;
constexpr float EPS = 1e-6f;
constexpr int PB_LD = 2816, PA_LD = 1536;
constexpr int PB_BR = 0, PB_GOUT = 2048, PB_GQ = 2560;
constexpr int PA_GV = 0, PA_GK = 512, PA_QLAT = 768, PA_KVLAT = 1152, PA_KROPE = 1408, PA_GLR = 1440;
constexpr int NPROJ = 4352;
constexpr float CQ = 0.10206207261596577f * 1.4426950408889634f;

constexpr size_t MiB = 1u << 20;
constexpr size_t WS_CTL = 0, CTL_ZERO_BYTES = 256 * 1024;
constexpr size_t WS_SSQ = 1 * MiB, WS_SSKV = WS_SSQ + 65536, WS_SSX1 = WS_SSKV + 65536, WS_COS = 2 * MiB, WS_SIN = 3 * MiB;
constexpr size_t WS_DECAY = 1 * MiB + 512 * 1024;
constexpr size_t WS_WIN = 4 * MiB, WS_WQB = 13 * MiB, WS_WKVB = 14 * MiB, WS_WA = 15 * MiB, WS_WB = 16 * MiB, WS_WOUT = 17 * MiB, WS_WPQ = 19 * MiB, WS_KEYS = 23 * MiB;
constexpr size_t WS_PROJB = 24 * MiB, WS_PROJA = 112 * MiB, WS_XN = 160 * MiB, WS_Q = 160 * MiB, WS_K = 184 * MiB, WS_V = 208 * MiB, WS_DST = 224 * MiB;
constexpr size_t WS_YA = 112 * MiB, WS_YB = 128 * MiB, WS_MERGED = 160 * MiB, WS_X1B = 24 * MiB, WS_QP = 56 * MiB, WS_EIDX = 120 * MiB, WS_EGATE = 128 * MiB;
constexpr size_t WS_UT = 192 * MiB, WS_VT = 224 * MiB, WS_SU = 1 * MiB + 768 * 1024, WS_SV = WS_SU + 65536;
constexpr size_t WS_END = 256 * MiB;

#define GAS __attribute__((address_space(1)))
#define LAS __attribute__((address_space(3)))
typedef float f32x4 __attribute__((ext_vector_type(4)));
typedef unsigned u32x4 __attribute__((ext_vector_type(4)));
typedef unsigned u32x2 __attribute__((ext_vector_type(2)));

__device__ __forceinline__ float bf2f(bf16_t h) { return __uint_as_float(((unsigned)h) << 16); }
__device__ __forceinline__ unsigned f2bf_u(float f) { unsigned u = __float_as_uint(f); return (u + 0x7fffu + ((u >> 16) & 1u)) >> 16; }
__device__ __forceinline__ bf16_t f2bf(float f) { return (bf16_t)f2bf_u(f); }
__device__ __forceinline__ unsigned pk2(float lo, float hi) { return f2bf_u(lo) | (f2bf_u(hi) << 16); }
__device__ __forceinline__ float wave_sum(float v) {
#pragma unroll
    for (int o = 1; o < 64; o <<= 1) v += __shfl_xor(v, o);
    return v;
}
__device__ __forceinline__ float sigmoidf_(float x) { return 1.f / (1.f + __expf(-x)); }

namespace pg8 {
#define PG8_LAS __attribute__((address_space(3)))
typedef short bf16x8 __attribute__((ext_vector_type(8)));
constexpr int BM = 256, BK = 64, HALF = 128, HTB = HALF * BK * 2, STAGE_BYTES = 8 * HTB, NXCD = 8, WGM = 8;
__host__ __device__ __forceinline__ int lds_byte(int r, int c) { const int st = (r >> 4) * 2 + (c >> 5), rr = r & 15, cc = c & 31, ob = rr * 64 + cc * 2; return st * 1024 + (ob ^ (((ob >> 9) & 1) << 5)); }
__host__ __device__ __forceinline__ void stage_rc(int b, int& R, int& C) { const int st = b / 1024, sb = b % 1024, swz = sb ^ (((sb >> 9) & 1) << 5); R = (st >> 1) * 16 + swz / 64; C = (st & 1) * 32 + (swz % 64) / 2; }
__host__ __device__ __forceinline__ int perm32(int rho) { const int n = rho >> 4, i = rho & 15; return 8 * (i >> 2) + 4 * n + (i & 3); }

struct Unit { int pm, pn, sub; const char* A; const char* B; };
struct Gemm { const bf16_t* A; const bf16_t* Bt; const bf16_t* A2; const bf16_t* Bt2; int lda, ldb, M, N, K, chain; };
struct StaticOrder {
    int nM, nN, nwg, G, c, chain; const char *A, *B, *A2, *B2; size_t tsA, tsB;
    __device__ __forceinline__ void init(const Gemm& g, int G_, int c_) { nM = g.M / BM; nN = g.N / BM; nwg = nM * nN; G = G_; c = c_; chain = g.chain; A = (const char*)g.A; B = (const char*)g.Bt; A2 = (const char*)g.A2; B2 = (const char*)g.Bt2;
        tsA = (size_t)BM * g.lda * 2; tsB = (size_t)BM * g.ldb * 2; }
    __device__ __forceinline__ bool next(int i, Unit& u) const {
        const int r = (chain == 2) ? (i >> 1) : i, sub = (chain == 2) ? (i & 1) : 0;
        const long L = (long)r * G + c; if (L >= nwg) return false;
        int wgid = (int)L; { const int q = nwg / NXCD, rr = nwg % NXCD, xcd = wgid % NXCD, off = wgid / NXCD; wgid = (xcd < rr ? xcd * (q + 1) : rr * (q + 1) + (xcd - rr) * q) + off; }
        const int nig = WGM * nN, gid = wgid / nig, fm = gid * WGM, gsz = (nM - fm) < WGM ? (nM - fm) : WGM;
        u.pm = fm + ((wgid % nig) % gsz); u.pn = (wgid % nig) / gsz; u.sub = sub;
        u.A = (sub ? A2 : A) + (size_t)u.pm * tsA; u.B = (sub ? B2 : B) + (size_t)u.pn * tsB; return true;
    }
};
__device__ __forceinline__ unsigned cvt_pk_bf16(float lo, float hi) { unsigned r; asm volatile("v_cvt_pk_bf16_f32 %0, %1, %2" : "=v"(r) : "v"(lo), "v"(hi)); return r; }

typedef f32x4 AccT[2][2][4][2];
template <class Epi, class Sched, bool ALIGN_EPI>
__device__ __forceinline__ void gemm_phase(PG8_LAS unsigned char* lds, const Gemm g, const Sched& S, const Epi& E) {
    const int tid = threadIdx.x, wid = __builtin_amdgcn_readfirstlane(tid >> 6), lane = tid & 63, wr = wid >> 2, wc = wid & 3, fr = lane & 15, fq = lane >> 4;
    const int K = g.K, nt = K / BK;
    unsigned voffA[2], voffB[2];
#pragma unroll
    for (int i = 0; i < 2; ++i) { int R, C; stage_rc(tid * 16 + i * 8192, R, C); const int Rb = Epi::PERM ? ((R & ~31) + perm32(R & 31)) : R;
        voffA[i] = (unsigned)(R * g.lda + C) * 2u; voffB[i] = (unsigned)(Rb * g.ldb + C) * 2u; }
    const size_t kstep = (size_t)(BK * 2);
    const size_t hsA = (size_t)HALF * g.lda * 2, hsB = (size_t)HALF * g.ldb * 2;
    const unsigned ldsw = (unsigned)wid * 1024u;
    const int aoff = lds_byte(wr * 64 + fr, fq * 8), boff = lds_byte(wc * 32 + fr, fq * 8);
#define PG8_SA(b, h) (((b) * 2 + (h)) * HTB)
#define PG8_SB(b, h) ((4 + (b) * 2 + (h)) * HTB)
#define PG8_STAGE(bufoff, gbase, voff) do { _Pragma("unroll") for (int _i = 0; _i < 2; ++_i) \
        __builtin_amdgcn_global_load_lds((const unsigned*)((const char*)(gbase) + (voff)[_i]), (PG8_LAS unsigned*)(lds + (bufoff) + ldsw + _i * 8192), 16, 0, 0); } while (0)
#define PG8_LDA(dst, b, h) do { _Pragma("unroll") for (int m = 0; m < 4; ++m) _Pragma("unroll") for (int k = 0; k < 2; ++k) dst[m][k] = *(const PG8_LAS bf16x8*)(lds + PG8_SA(b, h) + aoff + m * 2048 + k * 1024); } while (0)
#define PG8_LDB(dst, b, h) do { _Pragma("unroll") for (int n = 0; n < 2; ++n) _Pragma("unroll") for (int k = 0; k < 2; ++k) dst[n][k] = *(const PG8_LAS bf16x8*)(lds + PG8_SB(b, h) + boff + n * 2048 + k * 1024); } while (0)
#define PG8_MMA(ai, bj, At, Bt) do { __builtin_amdgcn_s_setprio(1); _Pragma("unroll") for (int m = 0; m < 4; ++m) _Pragma("unroll") for (int n = 0; n < 2; ++n) _Pragma("unroll") for (int k = 0; k < 2; ++k) \
        acc[ai][bj][m][n] = __builtin_amdgcn_mfma_f32_16x16x32_bf16(Bt[n][k], At[m][k], acc[ai][bj][m][n], 0, 0, 0); __builtin_amdgcn_s_setprio(0); } while (0)
#define PG8_WAIT_V(n) asm volatile("s_waitcnt vmcnt(" #n ")" ::: "memory")
#define PG8_WAIT_L(n) asm volatile("s_waitcnt lgkmcnt(" #n ")" ::: "memory")
#define PG8_BAR __builtin_amdgcn_s_barrier()
#define PG8_SCHED __builtin_amdgcn_sched_barrier(0)
    Unit cur, nxt; int ui = 0;
    if (!S.next(0, cur)) return;
    f32x4 acc[2][2][4][2];
#pragma unroll
    for (int a = 0; a < 2; ++a)
#pragma unroll
        for (int b = 0; b < 2; ++b)
#pragma unroll
            for (int m = 0; m < 4; ++m)
#pragma unroll
                for (int n = 0; n < 2; ++n) acc[a][b][m][n] = (f32x4){0.f, 0.f, 0.f, 0.f};
    bf16x8 At[4][2], B0[2][2], B1[2][2];
    const char* cA = cur.A; const char* cB = cur.B;
    PG8_STAGE(PG8_SB(0, 0), cB, voffB); PG8_STAGE(PG8_SB(0, 1), cB + hsB, voffB); PG8_STAGE(PG8_SA(0, 0), cA, voffA); PG8_STAGE(PG8_SA(0, 1), cA + hsA, voffA);
    if (wr == 1) PG8_BAR;
    PG8_WAIT_V(2); PG8_BAR;
    PG8_STAGE(PG8_SB(1, 0), cB + kstep, voffB); PG8_STAGE(PG8_SA(1, 0), cA + kstep, voffA); PG8_STAGE(PG8_SB(1, 1), cB + hsB + kstep, voffB);
    PG8_WAIT_V(6); PG8_BAR;
    for (;;) {
        const bool has_next = S.next(ui + 1, nxt);
        const char* nA = has_next ? nxt.A : cA; const char* nB = has_next ? nxt.B : cB;
        for (int t = 0; t < nt; t += 2) {
            const bool last = (t == nt - 2);
            const char* a1 = cA + (size_t)(t + 1) * kstep;
            const char* a2 = last ? nA : cA + (size_t)(t + 2) * kstep; const char* b2 = last ? nB : cB + (size_t)(t + 2) * kstep;
            const char* a3 = a2 + kstep; const char* b3 = b2 + kstep;
            PG8_LDB(B0, 0, 0); PG8_LDB(B1, 0, 1); PG8_SCHED; PG8_LDA(At, 0, 0); PG8_STAGE(PG8_SA(1, 1), a1 + hsA, voffA);
            PG8_WAIT_V(8); PG8_WAIT_L(0); PG8_BAR; PG8_MMA(0, 0, At, B0); PG8_MMA(0, 1, At, B1); PG8_BAR; PG8_SCHED;
            PG8_LDA(At, 0, 1); PG8_STAGE(PG8_SB(0, 0), b2, voffB); PG8_STAGE(PG8_SB(0, 1), b2 + hsB, voffB); PG8_STAGE(PG8_SA(0, 0), a2, voffA);
            PG8_WAIT_V(8); PG8_WAIT_L(0); PG8_BAR; PG8_MMA(1, 0, At, B0); PG8_MMA(1, 1, At, B1); PG8_BAR; PG8_SCHED;
            PG8_LDB(B0, 1, 0); PG8_LDB(B1, 1, 1); PG8_SCHED; PG8_LDA(At, 1, 0); PG8_STAGE(PG8_SA(0, 1), a2 + hsA, voffA);
            PG8_WAIT_V(8); PG8_WAIT_L(0); PG8_BAR; PG8_MMA(0, 0, At, B0); PG8_MMA(0, 1, At, B1); PG8_BAR; PG8_SCHED;
            PG8_LDA(At, 1, 1); PG8_STAGE(PG8_SB(1, 0), b3, voffB); PG8_STAGE(PG8_SB(1, 1), b3 + hsB, voffB); PG8_STAGE(PG8_SA(1, 0), a3, voffA);
            PG8_WAIT_V(8); PG8_WAIT_L(0); PG8_BAR; PG8_MMA(1, 0, At, B0); PG8_MMA(1, 1, At, B1); PG8_BAR; PG8_SCHED;
        }
        if constexpr (ALIGN_EPI) { if (wr == 0) PG8_BAR; }
        E(acc, cur, wr, wc, fr, fq);
        if (!has_next) break;
        if (!(Epi::CHAIN && nxt.sub != 0)) {
#pragma unroll
            for (int a = 0; a < 2; ++a)
#pragma unroll
                for (int b = 0; b < 2; ++b)
#pragma unroll
                    for (int m = 0; m < 4; ++m)
#pragma unroll
                        for (int n = 0; n < 2; ++n) acc[a][b][m][n] = (f32x4){0.f, 0.f, 0.f, 0.f};
        }
        cur = nxt; cA = nA; cB = nB; ++ui;
        if constexpr (ALIGN_EPI) { if (wr == 1) PG8_BAR; }
    }
    PG8_WAIT_V(0);
    if constexpr (!ALIGN_EPI) { if (wr == 0) PG8_BAR; }
    PG8_BAR;
#undef PG8_SA
#undef PG8_SB
#undef PG8_STAGE
#undef PG8_LDA
#undef PG8_LDB
#undef PG8_MMA
#undef PG8_WAIT_V
#undef PG8_WAIT_L
#undef PG8_BAR
#undef PG8_SCHED
}

struct EpiProj {
    static constexpr bool PERM = true, CHAIN = false;
    bf16_t* pb; bf16_t* pa; float* ssq; float* sskv;
    __device__ __forceinline__ void operator()(AccT& acc, const Unit& u, int wr, int wc, int fr, int fq) const {
        const int row0 = u.pm * BM + wr * 64 + fr;
#pragma unroll
        for (int bj = 0; bj < 2; ++bj) {
            const int hk = u.pn * 2 + bj;
            bf16_t* base; int ld; float* ss = nullptr;
            if (hk < 22) { base = pb + hk * 128; ld = PB_LD; } else { const int ha = hk - 22; base = pa + ha * 128; ld = PA_LD; if (ha >= 6 && ha <= 8) ss = ssq; else if (ha == 9 || ha == 10) ss = sskv; }
            base += wc * 32 + 8 * fq;
#pragma unroll
            for (int ai = 0; ai < 2; ++ai)
#pragma unroll
                for (int m = 0; m < 4; ++m) { const int row = row0 + ai * HALF + m * 16; const f32x4 v0 = acc[ai][bj][m][0], v1 = acc[ai][bj][m][1];
                    u32x4 w; w.x = cvt_pk_bf16(v0[0], v0[1]); w.y = cvt_pk_bf16(v0[2], v0[3]); w.z = cvt_pk_bf16(v1[0], v1[1]); w.w = cvt_pk_bf16(v1[2], v1[3]);
                    *(u32x4*)(base + (size_t)row * ld) = w;
                    if (ss) { float s = (v0[0] * v0[0] + v0[1] * v0[1]) + (v0[2] * v0[2] + v0[3] * v0[3]) + (v1[0] * v1[0] + v1[1] * v1[1]) + (v1[2] * v1[2] + v1[3] * v1[3]);
                        s += __shfl_xor(s, 16); s += __shfl_xor(s, 32); if (fq == 0) atomicAdd(ss + row, s); } }
        }
    }
};
struct EpiQ {
    static constexpr bool PERM = false, CHAIN = false;
    bf16_t* Q; const float* ssq; const float* cs; const float* sn;
    __device__ __forceinline__ void operator()(AccT& acc, const Unit& u, int wr, int wc, int fr, int fq) const {
        const int row0 = u.pm * BM + wr * 64 + fr;
#pragma unroll
        for (int ai = 0; ai < 2; ++ai)
#pragma unroll
            for (int m = 0; m < 4; ++m) { const int row = row0 + ai * HALF + m * 16; const float rr = rsqrtf(ssq[row] * (1.f / 384.f) + EPS) * CQ;
#pragma unroll
                for (int bj = 0; bj < 2; ++bj) { const int G = u.pn * 8 + bj * 4 + wc;
                    f32x4 x0 = acc[ai][bj][m][0], x1 = acc[ai][bj][m][1];
                    if (G % 3 == 2) { const f32x4 c = *(const f32x4*)(cs + (size_t)row * 16 + 4 * fq), s = *(const f32x4*)(sn + (size_t)row * 16 + 4 * fq);
                        const f32x4 o0 = x0 * c - x1 * s, o1 = x1 * c + x0 * s; x0 = o0; x1 = o1; }
                    x0 = x0 * rr; x1 = x1 * rr;
                    bf16_t* p = Q + (size_t)row * 768 + G * 32 + 4 * fq;
                    u32x2 w0, w1; w0.x = cvt_pk_bf16(x0[0], x0[1]); w0.y = cvt_pk_bf16(x0[2], x0[3]); w1.x = cvt_pk_bf16(x1[0], x1[1]); w1.y = cvt_pk_bf16(x1[2], x1[3]);
                    *(u32x2*)p = w0; *(u32x2*)(p + 16) = w1; } }
    }
};
struct EpiKV {
    static constexpr bool PERM = true, CHAIN = false;
    bf16_t* Kb; bf16_t* Vb; const float* sskv;
    __device__ __forceinline__ void operator()(AccT& acc, const Unit& u, int wr, int wc, int fr, int fq) const {
        const int row0 = u.pm * BM + wr * 64 + fr;
#pragma unroll
        for (int ai = 0; ai < 2; ++ai)
#pragma unroll
            for (int m = 0; m < 4; ++m) { const int row = row0 + ai * HALF + m * 16; const float rr = rsqrtf(sskv[row] * (1.f / 256.f) + EPS);
#pragma unroll
                for (int bj = 0; bj < 2; ++bj) { const int head = u.pn * 2 + bj; const f32x4 v0 = acc[ai][bj][m][0] * rr, v1 = acc[ai][bj][m][1] * rr;
                    u32x4 w; w.x = cvt_pk_bf16(v0[0], v0[1]); w.y = cvt_pk_bf16(v0[2], v0[3]); w.z = cvt_pk_bf16(v1[0], v1[1]); w.w = cvt_pk_bf16(v1[2], v1[3]);
                    bf16_t* p = (wc < 2) ? Kb + (size_t)row * 768 + head * 96 + wc * 32 + 8 * fq : Vb + (size_t)row * 512 + head * 64 + (wc - 2) * 32 + 8 * fq;
                    *(u32x4*)p = w; } }
    }
};
struct EpiMerge {
    static constexpr bool PERM = true, CHAIN = true;
    const bf16_t* pb; bf16_t* merged;
    __device__ __forceinline__ void operator()(AccT& acc, const Unit& u, int wr, int wc, int fr, int fq) const {
        const int row0 = u.pm * BM + wr * 64 + fr, col0 = u.pn * BM + wc * 32 + 8 * fq;
#pragma unroll
        for (int ai = 0; ai < 2; ++ai)
#pragma unroll
            for (int m = 0; m < 4; ++m) { const int row = row0 + ai * HALF + m * 16;
#pragma unroll
                for (int bj = 0; bj < 2; ++bj) { const int col = col0 + bj * HALF;
                    const u32x4 gb = *(const u32x4*)(pb + (size_t)row * PB_LD + PB_BR + 1024 + col);
                    float eb[8];
#pragma unroll
                    for (int e = 0; e < 4; ++e) { eb[2 * e] = 1.f + __builtin_amdgcn_exp2f(__uint_as_float(gb[e] << 16) * -1.4426950408889634f); eb[2 * e + 1] = 1.f + __builtin_amdgcn_exp2f(__uint_as_float(gb[e] & 0xffff0000u) * -1.4426950408889634f); }
                    if (u.sub == 0) {
                        const u32x4 ga = *(const u32x4*)(pb + (size_t)row * PB_LD + PB_BR + col);
#pragma unroll
                        for (int e = 0; e < 4; ++e) { const float ea0 = 1.f + __builtin_amdgcn_exp2f(__uint_as_float(ga[e] << 16) * -1.4426950408889634f), ea1 = 1.f + __builtin_amdgcn_exp2f(__uint_as_float(ga[e] & 0xffff0000u) * -1.4426950408889634f);
                            const int i0 = 2 * e, i1 = 2 * e + 1;
                            acc[ai][bj][m][i0 >> 2][i0 & 3] *= eb[i0] * __builtin_amdgcn_rcpf(ea0); acc[ai][bj][m][i1 >> 2][i1 & 3] *= eb[i1] * __builtin_amdgcn_rcpf(ea1); }
                    } else {
                        const f32x4 v0 = acc[ai][bj][m][0], v1 = acc[ai][bj][m][1];
                        float sb[8];
#pragma unroll
                        for (int e = 0; e < 8; ++e) sb[e] = __builtin_amdgcn_rcpf(eb[e]);
                        u32x4 w; w.x = cvt_pk_bf16(v0[0] * sb[0], v0[1] * sb[1]); w.y = cvt_pk_bf16(v0[2] * sb[2], v0[3] * sb[3]); w.z = cvt_pk_bf16(v1[0] * sb[4], v1[1] * sb[5]); w.w = cvt_pk_bf16(v1[2] * sb[6], v1[3] * sb[7]);
                        *(u32x4*)(merged + (size_t)row * DM + col) = w; } } }
    }
};
struct EpiX1 {
    static constexpr bool PERM = false, CHAIN = false;
    const float* x; float* x1; bf16_t* x1b; float* ssx1;
    __device__ __forceinline__ void operator()(AccT& acc, const Unit& u, int wr, int wc, int fr, int fq) const {
        const int row0 = u.pm * BM + wr * 64 + fr, col0 = u.pn * BM + wc * 32 + 4 * fq;
#pragma unroll
        for (int ai = 0; ai < 2; ++ai)
#pragma unroll
            for (int m = 0; m < 4; ++m) { const int row = row0 + ai * HALF + m * 16; const size_t off = (size_t)row * DM + col0; float s = 0.f;
#pragma unroll
                for (int bj = 0; bj < 2; ++bj)
#pragma unroll
                    for (int n = 0; n < 2; ++n) { const size_t o = off + bj * HALF + n * 16; const f32x4 v = *(const f32x4*)(x + o) + acc[ai][bj][m][n];
                        *(f32x4*)(x1 + o) = v; u32x2 w; w.x = cvt_pk_bf16(v[0], v[1]); w.y = cvt_pk_bf16(v[2], v[3]); *(u32x2*)(x1b + o) = w;
                        s += (v[0] * v[0] + v[1] * v[1]) + (v[2] * v[2] + v[3] * v[3]); }
                s += __shfl_xor(s, 16); s += __shfl_xor(s, 32); if (fq == 0) atomicAdd(ssx1 + row, s); }
    }
};
struct EpiQP {
    static constexpr bool PERM = true, CHAIN = false;
    bf16_t* qp; const float* ssx1;
    __device__ __forceinline__ void operator()(AccT& acc, const Unit& u, int wr, int wc, int fr, int fq) const {
        const int row0 = u.pm * BM + wr * 64 + fr, col0 = u.pn * BM + wc * 32 + 8 * fq;
#pragma unroll
        for (int ai = 0; ai < 2; ++ai)
#pragma unroll
            for (int m = 0; m < 4; ++m) { const int row = row0 + ai * HALF + m * 16; const float rr = rsqrtf(ssx1[row] * (1.f / 1024.f) + EPS);
#pragma unroll
                for (int bj = 0; bj < 2; ++bj) { const f32x4 v0 = acc[ai][bj][m][0] * rr, v1 = acc[ai][bj][m][1] * rr;
                    u32x4 w; w.x = cvt_pk_bf16(v0[0], v0[1]); w.y = cvt_pk_bf16(v0[2], v0[3]); w.z = cvt_pk_bf16(v1[0], v1[1]); w.w = cvt_pk_bf16(v1[2], v1[3]);
                    *(u32x4*)(qp + (size_t)row * 2048 + col0 + bj * HALF) = w; } }
    }
};
}


namespace att {
typedef short bf16x8 __attribute__((ext_vector_type(8)));
typedef short s16x4 __attribute__((ext_vector_type(4)));
typedef float f32x16 __attribute__((ext_vector_type(16)));
constexpr int NW = 8, QBLK = 32, KVBLK = 64, QB = NW * QBLK;
constexpr int QS = 768, KS = 768, VS = 512, OS = 512;
constexpr int SHM_V = KVBLK * 64 * 2, SHM_K = KVBLK * 256;
constexpr int LDS_BYTES = 2 * SHM_V + 2 * SHM_K + NW * 64 * 4;
constexpr float THR = 8.f;
#define KSWZ(row, colB) ((row) * 256 + ((colB) ^ (((row) & 7) << 4)))
#define SBAR() __builtin_amdgcn_sched_barrier(0)
__device__ __forceinline__ int v_st(int k, int c) { const int kk = (k & ~0xC) | ((k & 4) << 1) | ((k & 8) >> 1); return ((kk >> 3) * 2 + (c >> 5)) * 512 + ((kk & 7) * 32 + (c & 31)) * 2; }
__device__ __forceinline__ int v_rd_base(int lane) { return ((lane & 3) << 3) | (((lane >> 2) & 3) << 6) | (((lane >> 4) & 1) << 5) | (((lane >> 5) & 1) << 8); }
constexpr int v_rd_off(int d0, int ks, int half) { return d0 * 512 + ks * 2048 + half * 1024; }
__device__ __forceinline__ int crow(int r, int hi) { return (r & 3) + 8 * (r >> 2) + 4 * hi; }
__device__ __forceinline__ unsigned cvtpk(float lo, float hi) { unsigned r; asm volatile("v_cvt_pk_bf16_f32 %0, %1, %2" : "=v"(r) : "v"(lo), "v"(hi)); return r; }
__device__ __forceinline__ bf16x8 load8(const bf16_t* p) { return *reinterpret_cast<const bf16x8*>(p); }
__device__ __forceinline__ void partialSM(f32x16& p0, f32x16& p1, float& m_reg, float& mn, float& alpha) {
    float pmax = p0[0]; for (int r = 1; r < 16; ++r) pmax = fmaxf(pmax, p0[r]); for (int r = 0; r < 16; ++r) pmax = fmaxf(pmax, p1[r]);
    { auto rr = __builtin_amdgcn_permlane32_swap(__float_as_uint(pmax), __float_as_uint(pmax), false, false);
      pmax = fmaxf(__uint_as_float(rr[0]), __uint_as_float(rr[1])); }
    if (__builtin_expect(__all((pmax - m_reg) <= THR), 1)) { mn = m_reg; alpha = 1.f; }
    else { mn = fmaxf(m_reg, pmax); alpha = __builtin_amdgcn_exp2f(m_reg - mn); m_reg = mn; }
    for (int r = 0; r < 16; ++r) p0[r] = p0[r] - mn; for (int r = 0; r < 16; ++r) p1[r] = p1[r] - mn;
    for (int r = 0; r < 16; ++r) p0[r] = __builtin_amdgcn_exp2f(p0[r]);
}
__device__ __forceinline__ void finishSM(f32x16& p0, f32x16& p1, float alpha, float& l_reg, bf16x8& pa0, bf16x8& pa1, bf16x8& pa2, bf16x8& pa3) {
    for (int r = 0; r < 16; ++r) p1[r] = __builtin_amdgcn_exp2f(p1[r]);
    float ps = 0; for (int r = 0; r < 16; ++r) ps += p0[r]; for (int r = 0; r < 16; ++r) ps += p1[r];
    { auto rr = __builtin_amdgcn_permlane32_swap(__float_as_uint(ps), __float_as_uint(ps), false, false);
      ps = __uint_as_float(rr[0]) + __uint_as_float(rr[1]); }
    l_reg = l_reg * alpha + ps;
#define PK4(P, B_, OUT) do { unsigned a0 = cvtpk(P[B_+0], P[B_+1]), a1 = cvtpk(P[B_+2], P[B_+3]);                          \
        unsigned b0 = cvtpk(P[B_+4], P[B_+5]), b1 = cvtpk(P[B_+6], P[B_+7]);                                             \
        auto r0 = __builtin_amdgcn_permlane32_swap(a0, b0, false, false); auto r1 = __builtin_amdgcn_permlane32_swap(a1, b1, false, false); \
        u32x4 w = {r0[0], r1[0], r0[1], r1[1]}; OUT = *reinterpret_cast<bf16x8*>(&w); } while (0)
    PK4(p0, 0, pa0); PK4(p0, 8, pa1); PK4(p1, 0, pa2); PK4(p1, 8, pa3);
#undef PK4
}
template <int KB>
__device__ __forceinline__ void qkt(f32x16& p0, f32x16& p1, const char* K_lds, int r32, int hi, const bf16x8* qr) {
    p0 = f32x16{}; p1 = f32x16{};
    const char* kb[4];
#pragma unroll
    for (int dd = 0; dd < 4; ++dd) kb[dd] = K_lds + KB * SHM_K + KSWZ(r32, (dd * 16 + hi * 8) * 2);
#pragma unroll
    for (int d0 = 0; d0 < 6; ++d0) { const char* a = kb[d0 & 3] + (d0 >> 2) * 128;
        bf16x8 b0 = *reinterpret_cast<const bf16x8*>(a);
        bf16x8 b1 = *reinterpret_cast<const bf16x8*>(a + 32 * 256);
        p0 = __builtin_amdgcn_mfma_f32_32x32x16_bf16(b0, qr[d0], p0, 0, 0, 0);
        p1 = __builtin_amdgcn_mfma_f32_32x32x16_bf16(b1, qr[d0], p1, 0, 0, 0); }
}
template <int VB>
__device__ __forceinline__ void pv_tile(f32x16* o, int vb0, bf16x8 pa0, bf16x8 pa1, bf16x8 pa2, bf16x8 pa3) {
#define TRRD(dst, off) asm volatile("ds_read_b64_tr_b16 %0, %1 offset:%2" : "=&v"(dst) : "v"(vb0), "i"(off) : "memory")
#define PV_D0(d0) do { s16x4 l0, l1, l2, l3, h0, h1, h2, h3; constexpr int b_ = VB * SHM_V + v_rd_off(d0, 0, 0);   \
        TRRD(l0, b_); TRRD(h0, b_ + 1024); TRRD(l1, b_ + 2048); TRRD(h1, b_ + 3072); TRRD(l2, b_ + 4096); TRRD(h2, b_ + 5120); TRRD(l3, b_ + 6144); TRRD(h3, b_ + 7168); \
        asm volatile("s_waitcnt lgkmcnt(0)" ::: "memory"); SBAR();   \
        o[d0] = __builtin_amdgcn_mfma_f32_32x32x16_bf16(pa0, (bf16x8){l0[0], l0[1], l0[2], l0[3], h0[0], h0[1], h0[2], h0[3]}, o[d0], 0, 0, 0);   \
        o[d0] = __builtin_amdgcn_mfma_f32_32x32x16_bf16(pa1, (bf16x8){l1[0], l1[1], l1[2], l1[3], h1[0], h1[1], h1[2], h1[3]}, o[d0], 0, 0, 0);   \
        o[d0] = __builtin_amdgcn_mfma_f32_32x32x16_bf16(pa2, (bf16x8){l2[0], l2[1], l2[2], l2[3], h2[0], h2[1], h2[2], h2[3]}, o[d0], 0, 0, 0);   \
        o[d0] = __builtin_amdgcn_mfma_f32_32x32x16_bf16(pa3, (bf16x8){l3[0], l3[1], l3[2], l3[3], h3[0], h3[1], h3[2], h3[3]}, o[d0], 0, 0, 0); } while (0)
    PV_D0(0); PV_D0(1);
#undef PV_D0
#undef TRRD
}
struct BlockRef { const bf16_t* Q; const bf16_t* K; const bf16_t* V; bf16_t* O; int P0; };
struct Seam { bf16x8 qr[6]; bf16x8 st_v0, st_v1, st_k0, st_k1; };
#define ROWK(p, k0, rr) ((p) + (size_t)((k0) + (rr)) * KS + sc)
#define ROWV(p, k0, rr) ((p) + (size_t)((k0) + (rr)) * VS + sc)
#define VMW() asm volatile("s_waitcnt vmcnt(0)" ::: "memory")
#define VMWN(n) asm volatile("s_waitcnt vmcnt(%0)" :: "i"(n) : "memory")
#define SLOAD_H(Kp, Vp, k0) do { if (vact) { S.st_v0 = load8(ROWV(Vp, k0, sr)); S.st_v1 = load8(ROWV(Vp, k0, 32 + sr)); }              \
                                 if (kact) { S.st_k0 = load8(ROWK(Kp, k0, sr)); S.st_k1 = load8(ROWK(Kp, k0, 32 + sr)); } } while (0)
#define SWRITE_HK(bf) do { if (kact) { *(bf16x8*)(K_lds + (bf) * SHM_K + kws) = S.st_k0; *(bf16x8*)(K_lds + (bf) * SHM_K + kws + 32 * 256) = S.st_k1; } } while (0)
#define SWRITE_HV(bf) do { if (vact) { *(bf16x8*)(V_lds + (bf) * SHM_V + vst0) = S.st_v0; *(bf16x8*)(V_lds + (bf) * SHM_V + vst1) = S.st_v1; } } while (0)
#define SWRITE_H(bf) do { SWRITE_HV(bf); SWRITE_HK(bf); } while (0)
__device__ __forceinline__ void attn_prime(const BlockRef& cur, char* lds, Seam& S) {
    const int tid = threadIdx.x, wid = __builtin_amdgcn_readfirstlane(tid >> 6), lane = tid & 63, r32 = lane & 31, hi = lane >> 5;
    const int sr = tid >> 4, sc = (tid & 15) * 8, kws = KSWZ(sr, sc * 2); char* K_lds = lds + 2 * SHM_V;
    const bool kact = (tid & 15) < 12, vact = (tid & 15) < 8;
#pragma unroll
    for (int d0 = 0; d0 < 6; ++d0) S.qr[d0] = load8(cur.Q + (size_t)(wid * QBLK + r32) * QS + d0 * 16 + hi * 8);
    SLOAD_H(cur.K, cur.V, 0); VMW(); SWRITE_HK(0);
    __syncthreads();
}
__device__ __forceinline__ void attn_block(const BlockRef& cur, const BlockRef& nxt, char* lds, Seam& S) {
    const int tid = threadIdx.x, wid = __builtin_amdgcn_readfirstlane(tid >> 6), lane = tid & 63, r32 = lane & 31, hi = lane >> 5;
    const int NT = (cur.P0 + QB - 1) / KVBLK + 1;
    const int qlo = cur.P0 + wid * QBLK;
    const int qvis = qlo | 63;
    char* V_lds = lds; char* K_lds = lds + 2 * SHM_V;
    float* ws = (float*)(lds + 2 * SHM_V + 2 * SHM_K) + wid * 64; float* li_l = ws, * al_l = ws + 32;
    float m_reg = -1e30f, l_reg = 0; f32x16 o[2] = {};
    const int sr = tid >> 4, sc = (tid & 15) * 8, vst0 = v_st(sr, sc & 63), vst1 = v_st(32 + sr, sc & 63), kws = KSWZ(sr, sc * 2);
    const bool kact = (tid & 15) < 12, vact = (tid & 15) < 8;
    const int vb0 = (int)(uintptr_t)V_lds + v_rd_base(lane);
    const bf16_t* Kh = cur.K; const bf16_t* Vh = cur.V;
#define RESC(a) do { if (__any((a) < 1.f)) { if (hi == 0) al_l[r32] = (a); asm volatile("s_waitcnt lgkmcnt(0)" ::: "memory");              \
                     for (int d_ = 0; d_ < 2; ++d_) for (int r = 0; r < 16; ++r) o[d_][r] *= al_l[crow(r, hi)]; } } while (0)
#define KBASE(t) ((t) * KVBLK)
#define MASKT(P0_, P1_, t) do { if (KBASE(t) > qvis) { const float NEG_ = -__builtin_inff(); _Pragma("unroll") for (int r = 0; r < 16; ++r) { P0_[r] = NEG_; P1_[r] = NEG_; } } } while (0)
    constexpr int NQL = 6;
#define SEAM_K0() do { VMWN(NQL); SWRITE_HK(0); SBAR(); } while (0)
    f32x16 pA0, pA1, pB0, pB1; float mnA, mnB, alA, alB; bf16x8 pa0, pa1, pa2, pa3;
    SWRITE_HV(0); SBAR();
    if (NT > 1) { SLOAD_H(Kh, Vh, KBASE(1)); }
    SBAR(); qkt<0>(pA0, pA1, K_lds, r32, hi, S.qr);
    MASKT(pA0, pA1, 0); partialSM(pA0, pA1, m_reg, mnA, alA);
    if (NT > 1) { VMW(); SWRITE_H(1); }
    __syncthreads();
#define HALF_STEP(PX0, PX1, mnX, alX, PY0, PY1, alY, t, KB, VB, SB) do {                                                      \
        SBAR(); qkt<KB>(PX0, PX1, K_lds, r32, hi, S.qr);                                             \
        finishSM(PY0, PY1, alY, l_reg, pa0, pa1, pa2, pa3); SBAR();                                                           \
        if ((t) + 1 < NT) { SLOAD_H(Kh, Vh, KBASE((t) + 1)); SBAR(); }                                               \
        pv_tile<VB>(o, vb0, pa0, pa1, pa2, pa3); MASKT(PX0, PX1, (t)); partialSM(PX0, PX1, m_reg, mnX, alX);                                        \
        __syncthreads();                                                                                                      \
        if ((t) + 1 < NT) { VMW(); SWRITE_H(SB); }                                                                          \
        RESC(alX); __syncthreads(); } while (0)
    for (int t = 1; t + 1 < NT; t += 2) {
        HALF_STEP(pB0, pB1, mnB, alB, pA0, pA1, alA, t, 1, 0, 0);
        HALF_STEP(pA0, pA1, mnA, alA, pB0, pB1, alB, t + 1, 0, 1, 1);
    }
    const bool even = (NT & 1) == 0;
    if (even) { SBAR(); qkt<1>(pB0, pB1, K_lds, r32, hi, S.qr); SBAR(); }
    SLOAD_H(nxt.K, nxt.V, 0); SBAR();
#pragma unroll
    for (int d0 = 0; d0 < 6; ++d0) S.qr[d0] = load8(nxt.Q + (size_t)(wid * QBLK + r32) * QS + d0 * 16 + hi * 8);
    SBAR();
    finishSM(pA0, pA1, alA, l_reg, pa0, pa1, pa2, pa3); SBAR();
    pv_tile<0>(o, vb0, pa0, pa1, pa2, pa3);
    if (even) { MASKT(pB0, pB1, NT - 1); partialSM(pB0, pB1, m_reg, mnB, alB); __syncthreads(); RESC(alB);
        finishSM(pB0, pB1, alB, l_reg, pa0, pa1, pa2, pa3); SBAR(); pv_tile<1>(o, vb0, pa0, pa1, pa2, pa3); }
    SBAR(); SEAM_K0();
    if (hi == 0) li_l[r32] = l_reg; asm volatile("s_waitcnt lgkmcnt(0)" ::: "memory");
    float rli[16];
#pragma unroll
    for (int r = 0; r < 16; ++r) rli[r] = __builtin_amdgcn_rcpf(li_l[crow(r, hi)]);
    bf16_t* Ow = cur.O + (size_t)(wid * QBLK) * OS;
#pragma unroll
    for (int r = 0; r < 16; ++r) { const int orow = crow(r, hi);
#pragma unroll
        for (int d0 = 0; d0 < 2; ++d0) { const float v = o[d0][r] * rli[r];
            const float vn = __shfl_xor(v, 1);
            if ((r32 & 1) == 0) *(unsigned*)(Ow + (size_t)orow * OS + d0 * 32 + r32) = cvtpk(v, vn); } }
    __syncthreads();
#undef RESC
#undef KBASE
#undef MASKT
#undef SEAM_K0
#undef HALF_STEP
}
#undef ROWK
#undef ROWV
#undef VMW
#undef VMWN
#undef SLOAD_H
#undef SWRITE_HK
#undef SWRITE_HV
#undef SWRITE_H
#undef KSWZ
#undef SBAR
}

namespace gla {
typedef short bf16x8 __attribute__((ext_vector_type(8)));
typedef short s16x4 __attribute__((ext_vector_type(4)));
typedef float f32x16 __attribute__((ext_vector_type(16)));
template <int NCB> __device__ __forceinline__ int t_st(int k, int c) { const int kk = (k & ~0xC) | ((k & 4) << 1) | ((k & 8) >> 1); return ((kk >> 3) * NCB + (c >> 5)) * 512 + ((kk & 7) * 32 + (c & 31)) * 2; }
__device__ __forceinline__ int t_rd_base(int lane) { return ((lane & 3) << 3) | (((lane >> 2) & 3) << 6) | (((lane >> 4) & 1) << 5) | (((lane >> 5) & 1) << 8); }
template <int NCB> constexpr int t_rd_off(int d0, int ks, int half) { return d0 * 512 + ks * (NCB * 1024) + half * (NCB * 512); }
#define GLA_TRRD(dst, addr, off) asm volatile("ds_read_b64_tr_b16 %0, %1 offset:%2" : "=&v"(dst) : "v"(addr), "i"(off) : "memory")
__device__ __forceinline__ int crow(int r, int hi) { return (r & 3) + 8 * (r >> 2) + 4 * hi; }
}

#define XB_TMO      128
#define XB_XCNT(j)  (256  + 64 * (j))
#define XB_XSUB(j)  (1280 + 64 * (j))
#define XB_XGEN(j)  (2304 + 64 * (j))
#define XB_TOP      3328
#define XB_TOPGEN   3392
#define XCD_BAR_WORDS 3456
#define XB_SPIN_CAP (1u << 18)
__device__ __forceinline__ unsigned xb_ld(unsigned* p)              { return __hip_atomic_load(p, __ATOMIC_RELAXED, __HIP_MEMORY_SCOPE_AGENT); }
__device__ __forceinline__ unsigned xb_add(unsigned* p, unsigned v) { return __hip_atomic_fetch_add(p, v, __ATOMIC_RELAXED, __HIP_MEMORY_SCOPE_AGENT); }
__device__ __forceinline__ unsigned xb_xcc_id() { return (unsigned)__builtin_amdgcn_s_getreg((3 << 11) | 20) & 0xFu; }
#define XB_SPIN(cond, bar) do { unsigned _sp = 0; while (cond) { __builtin_amdgcn_s_sleep(1); \
    if ((++_sp & 255u) == 0u) { if (xb_ld(&(bar)[XB_TMO])) break; if (_sp > XB_SPIN_CAP) { atomicAdd(&(bar)[XB_TMO], 1u); break; } } } } while (0)
struct XcdBarrier { unsigned* bar; unsigned x; volatile LAS unsigned* st; };
__device__ __forceinline__ XcdBarrier xcd_barrier_post(unsigned* bar, volatile LAS unsigned* st) {
    XcdBarrier b; b.bar = bar; b.x = xb_xcc_id(); b.st = st;
    if (threadIdx.x == 0) (void)xb_add(&bar[XB_XCNT(b.x)], 1u);
    return b;
}
__device__ __forceinline__ void xcd_barrier_complete(unsigned* bar, unsigned x, unsigned& nloc, unsigned& nx) {
    const unsigned G = gridDim.x * gridDim.y * gridDim.z;
    unsigned sum, cnt, mine, sp = 0u;
    for (;;) {
        sum = 0u; cnt = 0u; mine = 0u;
#pragma unroll
        for (unsigned j = 0; j < 16; ++j) { const unsigned c = xb_ld(&bar[XB_XCNT(j)]); sum += c; cnt += (c > 0u) ? 1u : 0u; mine = (j == x) ? c : mine; }
        if (sum == G) break;
        __builtin_amdgcn_s_sleep(1);
        if ((++sp & 255u) == 0u) { if (xb_ld(&bar[XB_TMO])) break; if (sp > XB_SPIN_CAP) { atomicAdd(&bar[XB_TMO], 1u); break; } }
    }
    nloc = mine > 0u ? mine : 1u; nx = cnt > 0u ? cnt : 1u;
}
__device__ __forceinline__ void xcd_barrier(const XcdBarrier& b) {
    asm volatile("s_waitcnt vmcnt(0)" ::: "memory");
    __syncthreads();
    if (threadIdx.x == 0) {
        unsigned* bar = b.bar;
        __builtin_amdgcn_s_waitcnt(0);
        unsigned nloc = b.st[0], nx = b.st[1];
        if (nloc == 0u) { xcd_barrier_complete(bar, b.x, nloc, nx); b.st[0] = nloc; b.st[1] = nx; }
        const unsigned old = xb_add(&bar[XB_XSUB(b.x)], 1u);
        const unsigned gen = old / nloc;
        if (old + 1u == (gen + 1u) * nloc) {
            __builtin_amdgcn_fence(__ATOMIC_RELEASE, "agent");
            asm volatile("s_waitcnt vmcnt(0)" ::: "memory");
            const unsigned og = xb_add(&bar[XB_TOP], 1u);
            const unsigned tg = og / nx;
            if (og + 1u == (tg + 1u) * nx) xb_add(&bar[XB_TOPGEN], 1u);
            else XB_SPIN(xb_ld(&bar[XB_TOPGEN]) == tg, bar);
            __builtin_amdgcn_fence(__ATOMIC_ACQUIRE, "agent");
            xb_add(&bar[XB_XGEN(b.x)], 1u);
            asm volatile("s_waitcnt vmcnt(0)" ::: "memory");
        } else {
            XB_SPIN(xb_ld(&bar[XB_XGEN(b.x)]) == gen, bar);
            __builtin_amdgcn_fence(__ATOMIC_ACQUIRE, "agent");
            asm volatile("s_waitcnt vmcnt(0)" ::: "memory");
        }
    }
    __syncthreads();
}

constexpr int NWAVES = 8;
constexpr int RING_BYTES = 131072, LDSCTL_OFF = RING_BYTES, MISC_OFF = LDSCTL_OFF + 320, LDS_BYTES = 147456;
constexpr int CW_BAR = 4096;

struct Args { const void* in[20]; float* out; unsigned char* ws; int ph_lo, ph_hi; };

__device__ __forceinline__ int win_srccol(int n) {
    if (n < 2048) return 2224 + n;
    if (n < 2560) return 1712 + (n - 2048);
    if (n < 2816) return 672 + (n - 2560);
    if (n < 3328) return 1184 + (n - 2816);
    if (n < 3584) return 928 + (n - 3328);
    if (n < 3968) return 0 + (n - 3584);
    if (n < 4224) return 384 + (n - 3968);
    if (n < 4256) return 640 + (n - 4224);
    if (n < 4272) return 1696 + (n - 4256);
    return -1;
}
__device__ __forceinline__ void transpose_item(const float* __restrict__ W, int K, int Nsrc, bf16_t* __restrict__ WT, int Nout, const float* __restrict__ kscale, bool winperm, float* scr, int item, int lane) {
    const int nblk = Nout / 32, kb = item / nblk, nb = item % nblk, k0 = 64 * kb, n0 = 32 * nb;
    const int n = n0 + (lane & 31); const int sc = winperm ? win_srccol(n) : n;
#pragma unroll 8
    for (int i = 0; i < 32; ++i) { const int kk = 2 * i + (lane >> 5); float v = 0.f; if (sc >= 0) { v = W[(size_t)(k0 + kk) * Nsrc + sc]; if (kscale) v *= kscale[k0 + kk]; } scr[kk * 33 + (lane & 31)] = v; }
    asm volatile("s_waitcnt lgkmcnt(0)" ::: "memory");
    const int c = lane & 7;
#pragma unroll
    for (int j = 0; j < 4; ++j) { const int nn = (lane >> 3) + 8 * j; const float* s = scr + (8 * c) * 33 + nn;
        u32x4 o; o.x = pk2(s[0 * 33], s[1 * 33]); o.y = pk2(s[2 * 33], s[3 * 33]); o.z = pk2(s[4 * 33], s[5 * 33]); o.w = pk2(s[6 * 33], s[7 * 33]);
        *(u32x4*)(WT + (size_t)(n0 + nn) * K + k0 + 8 * c) = o; }
    asm volatile("s_waitcnt lgkmcnt(0)" ::: "memory");
}

#define TOPK_INSERT(tv, ti, vv, ii) do { float v_ = (vv); int i_ = (ii); \
    _Pragma("unroll") for (int q_ = 0; q_ < 16; ++q_) { const bool gt_ = (v_ > tv[q_]) || (v_ == tv[q_] && i_ < ti[q_]); const float tv_ = tv[q_]; const int ti_ = ti[q_]; \
        tv[q_] = gt_ ? v_ : tv_; ti[q_] = gt_ ? i_ : ti_; v_ = gt_ ? tv_ : v_; i_ = gt_ ? ti_ : i_; } } while (0)

__device__ __forceinline__ void quant_rows2(const float* __restrict__ tab, const float* __restrict__ g, unsigned char* __restrict__ qt, float* __restrict__ sc, int row0, int lane) {
    f32x4 v[2][4];
#pragma unroll
    for (int rr = 0; rr < 2; ++rr)
#pragma unroll
        for (int j = 0; j < 4; ++j) v[rr][j] = *(const f32x4*)(tab + (size_t)(row0 + rr) * 1024 + 16 * lane + 4 * j);
#pragma unroll
    for (int rr = 0; rr < 2; ++rr) {
        float mx = 0.f;
#pragma unroll
        for (int j = 0; j < 4; ++j) { if (g) v[rr][j] = v[rr][j] * *(const f32x4*)(g + 16 * lane + 4 * j);
            mx = fmaxf(mx, fmaxf(fmaxf(fabsf(v[rr][j][0]), fabsf(v[rr][j][1])), fmaxf(fabsf(v[rr][j][2]), fabsf(v[rr][j][3])))); }
#pragma unroll
        for (int o = 1; o < 64; o <<= 1) mx = fmaxf(mx, __shfl_xor(mx, o));
        mx = fmaxf(mx, 1e-30f);
        const float inv = 127.f / mx;
        u32x4 w;
#pragma unroll
        for (int j = 0; j < 4; ++j) { unsigned b = 0;
#pragma unroll
            for (int e = 0; e < 4; ++e) { const int q = (int)rintf(v[rr][j][e] * inv) + 128; b |= (unsigned)q << (8 * e); }
            w[j] = b; }
        *(u32x4*)(qt + (size_t)(row0 + rr) * 1024 + 16 * lane) = w;
        if (lane == 0) sc[row0 + rr] = mx * (1.f / 127.f);
    }
}
typedef __bf16 bf2_t __attribute__((ext_vector_type(2)));
__device__ __forceinline__ float dot2_bf16(unsigned a, unsigned b, float acc) { return __builtin_amdgcn_fdot2_f32_bf16(__builtin_bit_cast(bf2_t, a), __builtin_bit_cast(bf2_t, b), acc, false); }
__global__ void __launch_bounds__(NWAVES * 64, 2) fwd(Args args) {
    extern __shared__ __attribute__((aligned(16))) unsigned char lds[];
    const int tid = threadIdx.x, lane = tid & 63, wave = __builtin_amdgcn_readfirstlane(tid >> 6);
    const int G = gridDim.x; int vcu; { const int bx = blockIdx.x; vcu = (G % 8 == 0) ? (bx % 8) * (G / 8) + bx / 8 : bx; }
    const int gw = vcu * NWAVES + wave, NGW = G * NWAVES, gtid = vcu * 512 + tid, NT = G * 512;
    unsigned char* ws = args.ws;
    const float* x = (const float*)args.in[0]; const int* positions = (const int*)args.in[1];
    const float* g_mix = (const float*)args.in[2]; const float* w_in = (const float*)args.in[3]; const float* g_q_lat = (const float*)args.in[4]; const float* w_qb = (const float*)args.in[5];
    const float* g_kv_lat = (const float*)args.in[6]; const float* w_kvb = (const float*)args.in[7]; const float* w_a2 = (const float*)args.in[8]; const float* b_a2 = (const float*)args.in[9];
    const float* g_gla = (const float*)args.in[10]; const float* w_branch_a = (const float*)args.in[11]; const float* w_branch_b = (const float*)args.in[12]; const float* w_out = (const float*)args.in[13];
    const float* g_ffn = (const float*)args.in[14]; const float* w_peer_q = (const float*)args.in[15]; const float* sub_keys = (const float*)args.in[16]; const float* peer_u = (const float*)args.in[17];
    const float* peer_v = (const float*)args.in[18]; const float* g_final = (const float*)args.in[19];
    float* out = args.out;
    float* SSQ = (float*)(ws + WS_SSQ); float* SSKV = (float*)(ws + WS_SSKV); float* SSX1 = (float*)(ws + WS_SSX1); float* COS = (float*)(ws + WS_COS); float* SIN = (float*)(ws + WS_SIN);
    float* DECAY = (float*)(ws + WS_DECAY);
    bf16_t* WIN = (bf16_t*)(ws + WS_WIN); bf16_t* WQB = (bf16_t*)(ws + WS_WQB); bf16_t* WKVB = (bf16_t*)(ws + WS_WKVB); bf16_t* WA = (bf16_t*)(ws + WS_WA); bf16_t* WB = (bf16_t*)(ws + WS_WB);
    bf16_t* WOUT = (bf16_t*)(ws + WS_WOUT); bf16_t* WPQ = (bf16_t*)(ws + WS_WPQ); bf16_t* KEYS = (bf16_t*)(ws + WS_KEYS);
    bf16_t* PROJB = (bf16_t*)(ws + WS_PROJB); bf16_t* PROJA = (bf16_t*)(ws + WS_PROJA); bf16_t* XN = (bf16_t*)(ws + WS_XN);
    bf16_t* Q = (bf16_t*)(ws + WS_Q); bf16_t* K = (bf16_t*)(ws + WS_K); bf16_t* V = (bf16_t*)(ws + WS_V); float* DST = (float*)(ws + WS_DST);
    bf16_t* YA = (bf16_t*)(ws + WS_YA); bf16_t* YB = (bf16_t*)(ws + WS_YB); bf16_t* MERGED = (bf16_t*)(ws + WS_MERGED); bf16_t* X1B = (bf16_t*)(ws + WS_X1B); bf16_t* QP = (bf16_t*)(ws + WS_QP);
    int* EIDX = (int*)(ws + WS_EIDX); float* EGATE = (float*)(ws + WS_EGATE); unsigned char* UT = ws + WS_UT; unsigned char* VT = ws + WS_VT; float* SU = (float*)(ws + WS_SU); float* SV = (float*)(ws + WS_SV);

    for (int u = tid; u < (LDS_BYTES - LDSCTL_OFF) / 4; u += NWAVES * 64) ((unsigned*)(lds + LDSCTL_OFF))[u] = 0u;
    __syncthreads();
    XcdBarrier bar; bar.bar = (unsigned*)(ws + WS_CTL) + CW_BAR; bar.x = 0; bar.st = nullptr;
    if (MK_N_LAUNCHES == 1) bar = xcd_barrier_post((unsigned*)(ws + WS_CTL) + CW_BAR, (volatile LAS unsigned*)(lds + MISC_OFF) + 8);
    const int ph_lo_ = args.ph_lo, ph_hi_ = args.ph_hi;
#define IN(k) (ph_lo_ <= (k) && (k) < ph_hi_)
#define SEAM(k) do { if (MK_N_LAUNCHES == 1) { if (IN(k) && IN((k) + 1)) xcd_barrier(bar); } } while (0)
    PG8_LAS unsigned char* ring = (PG8_LAS unsigned char*)lds;

    if (IN(0)) {
        for (int i = gtid; i < 3 * M_; i += NT) SSQ[i] = 0.f;
        float* scr = (float*)(lds + wave * 16384);
        constexpr int I_WIN = 16 * (NPROJ / 32), I_QB = 6 * 24, I_KVB = 4 * 32, I_A = 8 * 32, I_OUT = 16 * 32, I_PQ = 16 * 64;
        constexpr int NITEMS = I_WIN + I_QB + I_KVB + 2 * I_A + I_OUT + I_PQ;
        for (int it = gw; it < NITEMS; it += NGW) {
            int r = it;
            if (r < I_WIN) { transpose_item(w_in, 1024, 4272, WIN, NPROJ, nullptr, true, scr, r, lane); continue; } r -= I_WIN;
            if (r < I_QB) { transpose_item(w_qb, 384, 768, WQB, 768, g_q_lat, false, scr, r, lane); continue; } r -= I_QB;
            if (r < I_KVB) { transpose_item(w_kvb, 256, 1024, WKVB, 1024, g_kv_lat, false, scr, r, lane); continue; } r -= I_KVB;
            if (r < I_A) { transpose_item(w_branch_a, 512, 1024, WA, 1024, nullptr, false, scr, r, lane); continue; } r -= I_A;
            if (r < I_A) { transpose_item(w_branch_b, 512, 1024, WB, 1024, nullptr, false, scr, r, lane); continue; } r -= I_A;
            if (r < I_OUT) { transpose_item(w_out, 1024, 1024, WOUT, 1024, nullptr, false, scr, r, lane); continue; } r -= I_OUT;
            transpose_item(w_peer_q, 1024, 2048, WPQ, 2048, g_ffn, false, scr, r, lane);
        }
        for (int i = gtid; i < 16 * 128 * 128; i += NT) KEYS[i] = f2bf(sub_keys[i]);
        for (int i = gtid; i < M_ * 16; i += NT) { const int m = i >> 4, f = i & 15;
            const double inv = pow(10000.0, -(double)f / 16.0); const double ang = (double)positions[m] * inv;
            COS[i] = (float)cos(ang); SIN[i] = (float)sin(ang); }
        for (int row = gw; row < M_; row += NGW) {
            const f32x4* xr = (const f32x4*)(x + (size_t)row * DM); f32x4 v[4]; float ss = 0.f;
#pragma unroll
            for (int j = 0; j < 4; ++j) { v[j] = xr[lane + 64 * j]; ss += (v[j][0] * v[j][0] + v[j][1] * v[j][1]) + (v[j][2] * v[j][2] + v[j][3] * v[j][3]); }
            ss = wave_sum(ss); const float r = rsqrtf(ss * (1.f / DM) + EPS);
#pragma unroll
            for (int j = 0; j < 4; ++j) { const int c = 4 * (lane + 64 * j); const f32x4 gg = *(const f32x4*)(g_mix + c);
                u32x2 w; w.x = pk2(v[j][0] * r * gg[0], v[j][1] * r * gg[1]); w.y = pk2(v[j][2] * r * gg[2], v[j][3] * r * gg[3]);
                *(u32x2*)(XN + (size_t)row * DM + c) = w; }
        }
    }
    SEAM(0);
    if (IN(1)) {
        pg8::Gemm g{XN, WIN, nullptr, nullptr, DM, DM, M_, NPROJ, DM, 1}; pg8::StaticOrder S; S.init(g, G, (int)blockIdx.x);
        pg8::EpiProj E{PROJB, PROJA, SSQ, SSKV};
        pg8::gemm_phase<pg8::EpiProj, pg8::StaticOrder, true>(ring, g, S, E);
    }
    SEAM(1);
    if (IN(2)) {
        { pg8::Gemm g{PROJA + PA_QLAT, WQB, nullptr, nullptr, PA_LD, 384, M_, 768, 384, 1}; pg8::StaticOrder S; S.init(g, G, (int)blockIdx.x);
          pg8::EpiQ E{Q, SSQ, COS, SIN}; pg8::gemm_phase<pg8::EpiQ, pg8::StaticOrder, true>(ring, g, S, E); }
        { pg8::Gemm g{PROJA + PA_KVLAT, WKVB, nullptr, nullptr, PA_LD, 256, M_, 1024, 256, 1}; pg8::StaticOrder S; S.init(g, G, (int)blockIdx.x);
          pg8::EpiKV E{K, V, SSKV}; pg8::gemm_phase<pg8::EpiKV, pg8::StaticOrder, true>(ring, g, S, E); }
        for (int i = gtid; i < M_ * 32; i += NT) { const int m = i >> 5, j = i & 31; const bf16_t* kr = PROJA + (size_t)m * PA_LD + PA_KROPE; float o;
            if (j < 16) { const float x1 = bf2f(kr[j]), x2 = bf2f(kr[j + 16]); o = x1 * COS[m * 16 + j] - x2 * SIN[m * 16 + j]; }
            else { const int f = j - 16; const float x2 = bf2f(kr[j]), x1 = bf2f(kr[j - 16]); o = x2 * COS[m * 16 + f] + x1 * SIN[m * 16 + f]; }
            const bf16_t ob = f2bf(o);
#pragma unroll
            for (int h = 0; h < 8; ++h) K[(size_t)m * 768 + h * 96 + 64 + j] = ob; }
        __syncthreads();
        {
            const int r32 = lane & 31, hi5 = lane >> 5;
            unsigned char* gvt = lds; unsigned char* kdt = lds + 16384;
            const int tbase = (int)(uintptr_t)lds + gla::t_rd_base(lane);
            for (int unit = vcu; unit < 2 * NCH * 4; unit += G) {
                const int h = unit & 3, bc = unit >> 2, t0 = bc * 64;
                {
                    const int sr = tid >> 4, ch = tid & 15;
#pragma unroll
                    for (int rr = 0; rr < 2; ++rr) { const int row = sr + 32 * rr; const u32x4 v = *(const u32x4*)(PROJA + (size_t)(t0 + row) * PA_LD + PA_GV + h * 128 + ch * 8);
                        *(u32x4*)(gvt + gla::t_st<4>(row, ch * 8)) = v; }
                }
                {
                    const int k0 = wave * 8; const bf16_t* prow = PROJA + (size_t)(t0 + lane) * PA_LD;
                    const u32x4 ga = *(const u32x4*)(prow + PA_GLR), gb = *(const u32x4*)(prow + PA_GLR + 8), gkv = *(const u32x4*)(prow + PA_GK + h * 64 + k0);
                    float glr[16];
#pragma unroll
                    for (int q = 0; q < 4; ++q) { glr[2 * q] = __uint_as_float(ga[q] << 16); glr[2 * q + 1] = __uint_as_float(ga[q] & 0xffff0000u); glr[8 + 2 * q] = __uint_as_float(gb[q] << 16); glr[8 + 2 * q + 1] = __uint_as_float(gb[q] & 0xffff0000u); }
                    float kdv[8];
#pragma unroll
                    for (int j = 0; j < 8; ++j) { const int kc = h * 64 + k0 + j; float z = b_a2[kc];
#pragma unroll
                        for (int r = 0; r < 16; ++r) z += glr[r] * w_a2[r * 256 + kc];
                        float v = (fminf(z, 0.f) - log1pf(expf(-fabsf(z)))) * (1.f / 16.f);
#pragma unroll
                        for (int d = 1; d < 64; d <<= 1) { const float t = __shfl_up(v, d); v += (lane >= d) ? t : 0.f; }
                        const float cl = __builtin_bit_cast(float, __builtin_amdgcn_readlane(__builtin_bit_cast(int, v), 63));
                        const unsigned gw_ = gkv[j >> 1]; const float gk = (j & 1) ? __uint_as_float(gw_ & 0xffff0000u) : __uint_as_float(gw_ << 16);
                        kdv[j] = gk * expf(cl - v);
                        if (lane == 0) DECAY[((size_t)bc * 4 + h) * 64 + k0 + j] = expf(cl); }
                    u32x4 w; w.x = pk2(kdv[0], kdv[1]); w.y = pk2(kdv[2], kdv[3]); w.z = pk2(kdv[4], kdv[5]); w.w = pk2(kdv[6], kdv[7]);
                    *(u32x4*)(kdt + gla::t_st<2>(lane, k0)) = w;
                }
                __syncthreads();
                {
                    const int kt = wave >> 2, vt = wave & 3; gla::f32x16 acc = {};
                    gla::s16x4 al[4], ah[4], bl[4], bh[4];
#define GLA_KS(ks) do { GLA_TRRD(al[ks], tbase, 16384 + gla::t_rd_off<2>(0, ks, 0)); GLA_TRRD(ah[ks], tbase, 16384 + gla::t_rd_off<2>(0, ks, 1)); GLA_TRRD(bl[ks], tbase, gla::t_rd_off<4>(0, ks, 0)); GLA_TRRD(bh[ks], tbase, gla::t_rd_off<4>(0, ks, 1)); } while (0)
                    const int tb_ = tbase; (void)tb_;
                    const int abase = tbase + kt * 512, bbase = tbase + vt * 512;
#undef GLA_KS
#define GLA_KS(ks) do { GLA_TRRD(al[ks], abase, 16384 + gla::t_rd_off<2>(0, ks, 0)); GLA_TRRD(ah[ks], abase, 16384 + gla::t_rd_off<2>(0, ks, 1)); GLA_TRRD(bl[ks], bbase, gla::t_rd_off<4>(0, ks, 0)); GLA_TRRD(bh[ks], bbase, gla::t_rd_off<4>(0, ks, 1)); } while (0)
                    GLA_KS(0); GLA_KS(1); GLA_KS(2); GLA_KS(3);
#undef GLA_KS
                    asm volatile("s_waitcnt lgkmcnt(0)" ::: "memory"); __builtin_amdgcn_sched_barrier(0);
#pragma unroll
                    for (int ks = 0; ks < 4; ++ks) acc = __builtin_amdgcn_mfma_f32_32x32x16_bf16((gla::bf16x8){al[ks][0], al[ks][1], al[ks][2], al[ks][3], ah[ks][0], ah[ks][1], ah[ks][2], ah[ks][3]},
                                                                                                 (gla::bf16x8){bl[ks][0], bl[ks][1], bl[ks][2], bl[ks][3], bh[ks][0], bh[ks][1], bh[ks][2], bh[ks][3]}, acc, 0, 0, 0);
                    float* dp = DST + (((size_t)bc * 4 + h) * 64 + kt * 32) * 128 + vt * 32 + r32;
#pragma unroll
                    for (int r = 0; r < 16; ++r) dp[(size_t)gla::crow(r, hi5) * 128] = acc[r];
                }
                __syncthreads();
            }
        }
    }
    SEAM(2);
    if (IN(3)) {
        if (tid < 256) for (int i = vcu * 256 + tid; i < 65536; i += G * 256) {
            const int v = i & 127, k = (i >> 7) & 63, h = (i >> 13) & 3, b = i >> 15; float s = 0.f;
            float* dp = DST + (((size_t)b * NCH * 4 + h) * 64 + k) * 128 + v; const float* gp = DECAY + ((size_t)b * NCH * 4 + h) * 64 + k;
            for (int c0 = 0; c0 < NCH; c0 += 8) { float d[8], g[8];
#pragma unroll
                for (int j = 0; j < 8; ++j) { d[j] = dp[(size_t)(c0 + j) * 32768]; g[j] = gp[(size_t)(c0 + j) * 256]; }
#pragma unroll
                for (int j = 0; j < 8; ++j) { s = g[j] * s + d[j]; d[j] = s; }
#pragma unroll
                for (int j = 0; j < 8; ++j) dp[(size_t)(c0 + j) * 32768] = d[j]; } }
        __syncthreads();
        {
            for (int pr = vcu; pr < 256; pr += G) {
                const int bh = pr >> 4, s16 = pr & 15, b = bh >> 3, h = bh & 7;
                att::BlockRef r0, r1;
                const bf16_t* Kh = K + (size_t)b * SEQ * att::KS + h * 96; const bf16_t* Vh = V + (size_t)b * SEQ * att::VS + h * 64;
                const int qb0 = 31 - s16, qb1 = s16;
                r0.Q = Q + ((size_t)b * SEQ + qb0 * 256) * att::QS + h * 96; r0.O = YA + ((size_t)b * SEQ + qb0 * 256) * att::OS + h * 64; r0.K = Kh; r0.V = Vh; r0.P0 = qb0 * 256;
                r1.Q = Q + ((size_t)b * SEQ + qb1 * 256) * att::QS + h * 96; r1.O = YA + ((size_t)b * SEQ + qb1 * 256) * att::OS + h * 64; r1.K = Kh; r1.V = Vh; r1.P0 = qb1 * 256;
                att::Seam S;
                att::attn_prime(r0, (char*)lds, S);
                att::attn_block(r0, r1, (char*)lds, S);
                att::attn_block(r1, r1, (char*)lds, S);
            }
        }
    }
    SEAM(3);
    if (IN(4)) {
        const int r32 = lane & 31, hi5 = lane >> 5;
        unsigned char* stt = lds; float* part = (float*)(lds + 16384);
        const int lt = wave >> 2, vt = wave & 3;
        const int bbase = (int)(uintptr_t)lds + gla::t_rd_base(lane) + vt * 512;
        for (int unit = vcu; unit < 2 * NCH * 4; unit += G) {
            const int h = unit & 3, bc = unit >> 2, t0 = bc * 64;
            {   const int sr = tid >> 4, ch = tid & 15; const float* sp = DST + ((size_t)bc * 4 + h) * 64 * 128;
#pragma unroll
                for (int rr = 0; rr < 2; ++rr) { const int row = sr + 32 * rr; const f32x4 a = *(const f32x4*)(sp + row * 128 + ch * 8), b = *(const f32x4*)(sp + row * 128 + ch * 8 + 4);
                    u32x4 w; w.x = pk2(a[0], a[1]); w.y = pk2(a[2], a[3]); w.z = pk2(b[0], b[1]); w.w = pk2(b[2], b[3]);
                    *(u32x4*)(stt + gla::t_st<4>(row, ch * 8)) = w; } }
            gla::bf16x8 qa[4];
            { const bf16_t* qrow = PROJB + (size_t)(t0 + lt * 32 + r32) * PB_LD + PB_GQ + h * 64 + hi5 * 8;
#pragma unroll
              for (int ks = 0; ks < 4; ++ks) qa[ks] = *(const gla::bf16x8*)(qrow + ks * 16); }
            __syncthreads();
            gla::f32x16 acc = {};
            { gla::s16x4 bl[4], bh[4];
#define GLA_KS(ks) do { GLA_TRRD(bl[ks], bbase, gla::t_rd_off<4>(0, ks, 0)); GLA_TRRD(bh[ks], bbase, gla::t_rd_off<4>(0, ks, 1)); } while (0)
              GLA_KS(0); GLA_KS(1); GLA_KS(2); GLA_KS(3);
#undef GLA_KS
              asm volatile("s_waitcnt lgkmcnt(0)" ::: "memory"); __builtin_amdgcn_sched_barrier(0);
#pragma unroll
              for (int ks = 0; ks < 4; ++ks) acc = __builtin_amdgcn_mfma_f32_32x32x16_bf16(qa[ks], (gla::bf16x8){bl[ks][0], bl[ks][1], bl[ks][2], bl[ks][3], bh[ks][0], bh[ks][1], bh[ks][2], bh[ks][3]}, acc, 0, 0, 0); }
            float rs[16];
#pragma unroll
            for (int r = 0; r < 16; ++r) { acc[r] *= 0.125f; float s2 = acc[r] * acc[r];
                s2 += __builtin_bit_cast(float, __builtin_amdgcn_update_dpp(0, __builtin_bit_cast(int, s2), 0x128, 0xf, 0xf, false));
                s2 += __builtin_bit_cast(float, __builtin_amdgcn_update_dpp(0, __builtin_bit_cast(int, s2), 0x124, 0xf, 0xf, false));
                s2 += __builtin_bit_cast(float, __builtin_amdgcn_update_dpp(0, __builtin_bit_cast(int, s2), 0x122, 0xf, 0xf, false));
                s2 += __builtin_bit_cast(float, __builtin_amdgcn_update_dpp(0, __builtin_bit_cast(int, s2), 0x121, 0xf, 0xf, false));
                s2 += __shfl_xor(s2, 16); rs[r] = s2; }
            if (r32 == 0) {
#pragma unroll
                for (int r = 0; r < 16; ++r) part[(lt * 32 + gla::crow(r, hi5)) * 4 + vt] = rs[r]; }
            __syncthreads();
#pragma unroll
            for (int r = 0; r < 16; ++r) { const int l = lt * 32 + gla::crow(r, hi5); const f32x4 pp = *(const f32x4*)(part + l * 4);
                const float rn = rsqrtf(((pp[0] + pp[1]) + (pp[2] + pp[3])) * (1.f / 128.f) + EPS);
                const int v = vt * 32 + r32; const float go = bf2f(PROJB[(size_t)(t0 + l) * PB_LD + PB_GOUT + h * 128 + v]);
                const float silu = go * __builtin_amdgcn_rcpf(1.f + __expf(-go));
                YB[(size_t)(t0 + l) * 512 + h * 128 + v] = f2bf(acc[r] * rn * g_gla[h * 128 + v] * silu); }
            __syncthreads();
        }
    }
    if (IN(4)) {
        for (int row = gw * 2; row < 16384; row += NGW * 2) quant_rows2(peer_u, g_ffn, UT, SU, row, lane);
    }
    SEAM(4);
    if (IN(5)) {
        for (int row = gw * 2; row < 16384; row += NGW * 2) quant_rows2(peer_v, nullptr, VT, SV, row, lane);
        __syncthreads();
        pg8::Gemm g{YA, WA, YB, WB, 512, 512, M_, 1024, 512, 2}; pg8::StaticOrder S; S.init(g, G, (int)blockIdx.x);
        pg8::EpiMerge E{PROJB, MERGED}; pg8::gemm_phase<pg8::EpiMerge, pg8::StaticOrder, true>(ring, g, S, E);
    }
    SEAM(5);
    if (IN(6)) {
        pg8::Gemm g{MERGED, WOUT, nullptr, nullptr, DM, DM, M_, 1024, DM, 1}; pg8::StaticOrder S; S.init(g, G, (int)blockIdx.x);
        pg8::EpiX1 E{x, out, X1B, SSX1}; pg8::gemm_phase<pg8::EpiX1, pg8::StaticOrder, false>(ring, g, S, E);
    }
    SEAM(6);
    if (IN(7)) {
        pg8::Gemm g{X1B, WPQ, nullptr, nullptr, DM, DM, M_, 2048, DM, 1}; pg8::StaticOrder S; S.init(g, G, (int)blockIdx.x);
        pg8::EpiQP E{QP, SSX1}; pg8::gemm_phase<pg8::EpiQP, pg8::StaticOrder, true>(ring, g, S, E);
    }
    SEAM(7);
    if (IN(8)) {
        typedef short bf16x8_t __attribute__((ext_vector_type(8)));
        typedef float f32x16_t __attribute__((ext_vector_type(16)));
        const int r32 = lane & 31, hi = lane >> 5;
#define P8_SORTABLE(f) ({ const unsigned b_ = __float_as_uint(f); b_ ^ ((unsigned)((int)b_ >> 31) | 0x80000000u); })
#define P8_UNSORT(u) ({ const unsigned u_ = (u); __uint_as_float(u_ ^ (~(unsigned)((int)u_ >> 31) | 0x80000000u)); })
#define P8_INSERT(t, v) do { unsigned v_ = (v); _Pragma("unroll") for (int q_ = 0; q_ < 16; ++q_) { const unsigned a_ = t[q_] > v_ ? t[q_] : v_; v_ = t[q_] > v_ ? v_ : t[q_]; t[q_] = a_; } } while (0)
        for (int item = vcu; item < 256; item += G) {
            const int h = item & 7, tr = item >> 3;
            for (int c = tid; c < 2 * 128 * 16; c += 512) { const int p = c >> 11, row = (c >> 4) & 127, ch = c & 15;
                const u32x4 v = *(const u32x4*)(KEYS + ((size_t)(h * 2 + p) * 128 + row) * 128 + ch * 8);
                *(u32x4*)(lds + p * 32768 + row * 256 + ((ch * 16) ^ ((row & 7) << 4))) = v; }
            __syncthreads();
#pragma unroll 1
            for (int step = 0; step < 2; ++step) {
                const int m = tr * 512 + wave * 64 + step * 32 + r32;
                unsigned top[2][16];
#pragma unroll
                for (int p = 0; p < 2; ++p) {
                    bf16x8_t qf[8];
#pragma unroll
                    for (int ks = 0; ks < 8; ++ks) qf[ks] = *(const bf16x8_t*)(QP + (size_t)m * 2048 + (h * 2 + p) * 128 + ks * 16 + hi * 8);
                    f32x16_t acc[4];
#pragma unroll
                    for (int kt = 0; kt < 4; ++kt) { acc[kt] = f32x16_t{};
                        const int row = kt * 32 + r32; const unsigned char* rb = lds + p * 32768 + row * 256;
#pragma unroll
                        for (int ks = 0; ks < 8; ++ks) { const bf16x8_t a = *(const bf16x8_t*)(rb + (((2 * ks + hi) * 16) ^ ((row & 7) << 4)));
                            acc[kt] = __builtin_amdgcn_mfma_f32_32x32x16_bf16(a, qf[ks], acc[kt], 0, 0, 0); } }
                    unsigned t[16];
#pragma unroll
                    for (int i = 0; i < 16; ++i) t[i] = 0u;
#pragma unroll
                    for (int kt = 0; kt < 4; ++kt)
#pragma unroll
                        for (int r = 0; r < 16; ++r) { const unsigned base = 32 * kt + (r & 3) + 8 * (r >> 2);
                            const unsigned pk = (P8_SORTABLE(acc[kt][r]) | 127u) ^ base; P8_INSERT(t, pk); }
#pragma unroll
                    for (int i = 0; i < 16; ++i) t[i] ^= (unsigned)(hi << 2);
                    unsigned mm[16];
#pragma unroll
                    for (int i = 0; i < 16; ++i) { auto rr = __builtin_amdgcn_permlane32_swap(t[15 - i], t[15 - i], false, false); const unsigned pt = hi ? rr[0] : rr[1]; mm[i] = t[i] > pt ? t[i] : pt; }
#pragma unroll
                    for (int sft = 8; sft >= 1; sft >>= 1)
#pragma unroll
                        for (int i = 0; i < 16; ++i) if ((i & sft) == 0) { const unsigned a_ = mm[i] > mm[i + sft] ? mm[i] : mm[i + sft], b_ = mm[i] > mm[i + sft] ? mm[i + sft] : mm[i]; mm[i] = a_; mm[i + sft] = b_; }
#pragma unroll
                    for (int i = 0; i < 16; ++i) top[p][i] = mm[i];
                }
                float f0[16], f1[16];
#pragma unroll
                for (int i = 0; i < 16; ++i) { f0[i] = P8_UNSORT(top[0][i] & 0xFFFFFF80u); f1[i] = P8_UNSORT(top[1][i] & 0xFFFFFF80u); }
                unsigned cb[16];
#pragma unroll
                for (int i = 0; i < 16; ++i) cb[i] = 0u;
#define P8_CAND(a, b) do { const float sv_ = f0[a] + f1[b]; const unsigned pk_ = (P8_SORTABLE(sv_) | 255u) ^ (unsigned)((a) * 16 + (b)); P8_INSERT(cb, pk_); } while (0)
#pragma unroll
                for (int b = 0; b < 16; ++b) P8_CAND(0, b);
#pragma unroll
                for (int b = 0; b < 8; ++b) P8_CAND(1, b);
#pragma unroll
                for (int b = 0; b < 5; ++b) P8_CAND(2, b);
#pragma unroll
                for (int b = 0; b < 4; ++b) P8_CAND(3, b);
#pragma unroll
                for (int b = 0; b < 3; ++b) P8_CAND(4, b);
#pragma unroll
                for (int b = 0; b < 2; ++b) { P8_CAND(5, b); P8_CAND(6, b); P8_CAND(7, b); }
                P8_CAND(8, 0); P8_CAND(9, 0); P8_CAND(10, 0); P8_CAND(11, 0); P8_CAND(12, 0); P8_CAND(13, 0); P8_CAND(14, 0); P8_CAND(15, 0);
#undef P8_CAND
                unsigned char* slot = lds + 65536 + wave * 2048 + lane * 32;
                { u32x4 w0, w1;
#define P8_IDX4(T, i) ((127u - (T[i] & 127u)) | ((127u - (T[(i) + 1] & 127u)) << 8) | ((127u - (T[(i) + 2] & 127u)) << 16) | ((127u - (T[(i) + 3] & 127u)) << 24))
                  w0.x = P8_IDX4(top[0], 0); w0.y = P8_IDX4(top[0], 4); w0.z = P8_IDX4(top[0], 8); w0.w = P8_IDX4(top[0], 12);
                  w1.x = P8_IDX4(top[1], 0); w1.y = P8_IDX4(top[1], 4); w1.z = P8_IDX4(top[1], 8); w1.w = P8_IDX4(top[1], 12);
#undef P8_IDX4
                  *(u32x4*)slot = w0; *(u32x4*)(slot + 16) = w1; }
                asm volatile("s_waitcnt lgkmcnt(0)" ::: "memory");
                float bv[16]; int be[16];
#pragma unroll
                for (int k = 0; k < 16; ++k) { const unsigned pos = (~cb[k]) & 255u; bv[k] = P8_UNSORT(cb[k] & 0xFFFFFF00u);
                    be[k] = (int)slot[pos >> 4] * 128 + (int)slot[16 + (pos & 15)]; }
                { const float b0 = bv[0];
#pragma unroll
                  for (int k = 0; k < 16; ++k) bv[k] = __expf(bv[k] - b0); }
                asm volatile("s_waitcnt lgkmcnt(0)" ::: "memory");
                if (hi == 0) { int* ep = EIDX + (size_t)m * 128 + h * 16;
#pragma unroll
                    for (int q = 0; q < 4; ++q) { u32x4 w; w.x = (unsigned)be[4 * q]; w.y = (unsigned)be[4 * q + 1]; w.z = (unsigned)be[4 * q + 2]; w.w = (unsigned)be[4 * q + 3]; *(u32x4*)(ep + 4 * q) = w; } }
                else { float* gp = EGATE + (size_t)m * 128 + h * 16; float s2 = 0.f;
#pragma unroll
                    for (int k = 0; k < 16; ++k) s2 += bv[k];
                    const float inv = 1.f / s2;
#pragma unroll
                    for (int q = 0; q < 4; ++q) { f32x4 w; w[0] = bv[4 * q] * inv; w[1] = bv[4 * q + 1] * inv; w[2] = bv[4 * q + 2] * inv; w[3] = bv[4 * q + 3] * inv; *(f32x4*)(gp + 4 * q) = w; } }
            }
            __syncthreads();
        }
#undef P8_SORTABLE
#undef P8_UNSORT
#undef P8_INSERT
    }
    SEAM(8);
    if (IN(9)) {
#define ROR_ADD(v, n) v += __builtin_bit_cast(float, __builtin_amdgcn_update_dpp(0, __builtin_bit_cast(int, v), 0x120 + (n), 0xf, 0xf, false))
#define UB(w, e) ((float)(((w) >> (8 * (e))) & 0xffu))
        const int hi = lane >> 5;
        for (int m = gw; m < M_; m += NGW) {
            float xf[16];
            { const u32x4 xa = *(const u32x4*)(X1B + (size_t)m * DM + 16 * lane), xb = *(const u32x4*)(X1B + (size_t)m * DM + 16 * lane + 8);
#pragma unroll
              for (int q = 0; q < 4; ++q) { xf[2 * q] = __uint_as_float(xa[q] << 16); xf[2 * q + 1] = __uint_as_float(xa[q] & 0xffff0000u); xf[8 + 2 * q] = __uint_as_float(xb[q] << 16); xf[8 + 2 * q + 1] = __uint_as_float(xb[q] & 0xffff0000u); } }
            float xs = 0.f;
#pragma unroll
            for (int j = 0; j < 16; ++j) xs += xf[j];
            const float X128 = 128.f * wave_sum(xs);
            const float r = rsqrtf(SSX1[m] * (1.f / DM) + EPS);
            const int e_lo = EIDX[(size_t)m * 128 + lane], e_hi = EIDX[(size_t)m * 128 + 64 + lane];
            const float g_lo = EGATE[(size_t)m * 128 + lane], g_hi = EGATE[(size_t)m * 128 + 64 + lane];
            const float su_lo = SU[e_lo], su_hi = SU[e_hi], sv_lo = SV[e_lo], sv_hi = SV[e_hi];
            float y[16]; float asum = 0.f;
#pragma unroll
            for (int j = 0; j < 16; ++j) y[j] = 0.f;
#pragma unroll 1
            for (int h = 0; h < 8; ++h) {
                const int ev = (h < 4) ? e_lo : e_hi; const float gv = (h < 4) ? g_lo : g_hi, suv = (h < 4) ? su_lo : su_hi, svv = (h < 4) ? sv_lo : sv_hi; const int l0 = (h & 3) * 16;
                float p[16];
#pragma unroll
                for (int k = 0; k < 16; ++k) { const int e = __builtin_amdgcn_readlane(ev, l0 + k);
                    const u32x4 u = *(const u32x4*)(UT + (size_t)e * 1024 + 16 * lane);
                    float a = 0.f;
#pragma unroll
                    for (int q = 0; q < 4; ++q) { const unsigned w_ = u[q]; a += xf[4 * q] * UB(w_, 0); a += xf[4 * q + 1] * UB(w_, 1); a += xf[4 * q + 2] * UB(w_, 2); a += xf[4 * q + 3] * UB(w_, 3); }
                    p[k] = a; }
                float w[8];
#pragma unroll
                for (int j = 0; j < 8; ++j) { auto rr = __builtin_amdgcn_permlane32_swap(__float_as_uint(p[j]), __float_as_uint(p[j + 8]), false, false); w[j] = __uint_as_float(rr[0]) + __uint_as_float(rr[1]); }
#pragma unroll
                for (int j = 0; j < 8; ++j) { w[j] += __shfl_xor(w[j], 16); ROR_ADD(w[j], 8); ROR_ADD(w[j], 4); ROR_ADD(w[j], 2); ROR_ADD(w[j], 1); }
                float z = w[0];
#pragma unroll
                for (int j = 1; j < 8; ++j) z = ((lane & 7) == j) ? w[j] : z;
                const int src = l0 + (lane & 7) + 8 * hi;
                z = (z - X128) * __shfl(suv, src) * r;
                const float a = 0.5f * z * (1.f + erff(z * 0.70710678118654752f)) * __shfl(gv, src) * __shfl(svv, src);
                asum += a;
#pragma unroll
                for (int k = 0; k < 16; ++k) { const int e = __builtin_amdgcn_readlane(ev, l0 + k); const float c = __builtin_bit_cast(float, __builtin_amdgcn_readlane(__builtin_bit_cast(int, a), (k & 7) + 32 * (k >> 3)));
                    const u32x4 v = *(const u32x4*)(VT + (size_t)e * 1024 + 16 * lane);
#pragma unroll
                    for (int q = 0; q < 4; ++q) { const unsigned w_ = v[q]; y[4 * q] += c * UB(w_, 0); y[4 * q + 1] += c * UB(w_, 1); y[4 * q + 2] += c * UB(w_, 2); y[4 * q + 3] += c * UB(w_, 3); } }
            }
            const float c128 = 128.f * wave_sum((lane & 24) == 0 ? asum : 0.f);
            const float* xr = out + (size_t)m * DM + 16 * lane; float ss = 0.f;
#pragma unroll
            for (int q = 0; q < 4; ++q) { const f32x4 t = *(const f32x4*)(xr + 4 * q);
#pragma unroll
                for (int e = 0; e < 4; ++e) { y[4 * q + e] += t[e] - c128; ss += y[4 * q + e] * y[4 * q + e]; } }
            ss = wave_sum(ss); const float r2 = rsqrtf(ss * (1.f / DM) + EPS);
            float* orow = out + (size_t)m * DM + 16 * lane;
#pragma unroll
            for (int q = 0; q < 4; ++q) { const f32x4 gg = *(const f32x4*)(g_final + 16 * lane + 4 * q);
                f32x4 o; o[0] = y[4 * q] * r2 * gg[0]; o[1] = y[4 * q + 1] * r2 * gg[1]; o[2] = y[4 * q + 2] * r2 * gg[2]; o[3] = y[4 * q + 3] * r2 * gg[3];
                *(f32x4*)(orow + 4 * q) = o; }
        }
#undef ROR_ADD
#undef UB
    }
#undef IN
#undef SEAM
}

extern "C" void kernel_launch(void* const* d_in, const int* in_sizes, int n_in, void* d_out, int out_size, void* d_ws, size_t ws_size, hipStream_t stream) {
    static int grid = 0;
    if (grid == 0) {
        if (n_in != 20 || out_size != M_ * DM || ws_size < WS_END) { fprintf(stderr, "kernel_launch: unexpected shapes (n_in %d out %d ws %zu); nothing launched\n", n_in, out_size, ws_size); grid = -1; return; }
        int dev = 0, cus = 0;
        if (hipGetDevice(&dev) != hipSuccess || hipDeviceGetAttribute(&cus, hipDeviceAttributeMultiprocessorCount, dev) != hipSuccess) { grid = -1; return; }
        if (hipFuncSetAttribute((const void*)fwd, hipFuncAttributeMaxDynamicSharedMemorySize, LDS_BYTES) != hipSuccess) { fprintf(stderr, "kernel_launch: hipFuncSetAttribute failed\n"); grid = -1; return; }
        int per_cu = 0;
        if (hipOccupancyMaxActiveBlocksPerMultiprocessor(&per_cu, (const void*)fwd, NWAVES * 64, LDS_BYTES) != hipSuccess || per_cu < 1) fprintf(stderr, "kernel_launch: occupancy query reports %d\n", per_cu);
        (void)hipGetLastError();
        grid = cus;
    }
    if (grid < 0) return;
    (void)hipMemsetAsync((char*)d_ws + WS_CTL, 0, CTL_ZERO_BYTES, stream);
    Args a; memset(&a, 0, sizeof(a));
    for (int i = 0; i < 20; ++i) a.in[i] = d_in[i];
    a.out = (float*)d_out; a.ws = (unsigned char*)d_ws;
    if (MK_N_LAUNCHES == 1) { a.ph_lo = 0; a.ph_hi = N_PHASES; hipLaunchKernelGGL(fwd, dim3(grid), dim3(NWAVES * 64), LDS_BYTES, stream, a); }
    else for (int p = 0; p < N_PHASES; ++p) { a.ph_lo = p; a.ph_hi = p + 1; hipLaunchKernelGGL(fwd, dim3(grid), dim3(NWAVES * 64), LDS_BYTES, stream, a); }
}
```

```cpp
#include <hip/hip_runtime.h>
#include <cstdio>
#include <cstdint>
#include <cstring>
#include <math.h>

#ifndef MK_N_LAUNCHES
#define MK_N_LAUNCHES 1
#endif
constexpr int N_PHASES = 13;

typedef unsigned short bf16_t;
constexpr int SEQ = 8192, DM = 1024, M_ = 16384, NCH = 128;
constexpr float EPS = 1e-6f;
constexpr int PB_LD = 2816, PA_LD = 1536;
constexpr int PB_BR = 0, PB_GOUT = 2048, PB_GQ = 2560;
constexpr int PA_GV = 0, PA_GK = 512, PA_QLAT = 768, PA_KVLAT = 1152, PA_KROPE = 1408, PA_GLR = 1440;
constexpr int NPROJ = 4352;
constexpr float CQ = 0.10206207261596577f * 1.4426950408889634f;

constexpr size_t MiB = 1u << 20;
constexpr size_t WS_CTL = 0, CTL_ZERO_BYTES = 256 * 1024;
constexpr size_t WS_SSQ = 1 * MiB, WS_SSKV = WS_SSQ + 65536, WS_SSX1 = WS_SSKV + 65536, WS_SS2 = WS_SSX1 + 65536, WS_C128 = WS_SS2 + 65536  , WS_CB = 136 * MiB  , WS_ZP = 56 * MiB  , WS_COS = 2 * MiB, WS_SIN = 3 * MiB;
constexpr size_t WS_DECAY = 1 * MiB + 512 * 1024;
constexpr size_t WS_WIN = 4 * MiB, WS_WQB = 13 * MiB, WS_WKVB = 14 * MiB, WS_WA = 15 * MiB, WS_WB = 16 * MiB, WS_WOUT = 17 * MiB, WS_WPQ = 19 * MiB, WS_KEYS = 23 * MiB;
constexpr size_t WS_PROJB = 24 * MiB, WS_PROJA = 112 * MiB, WS_XN = 160 * MiB, WS_Q = 160 * MiB, WS_K = 184 * MiB, WS_V = 208 * MiB, WS_DST = 224 * MiB;
constexpr size_t WS_YA = 112 * MiB, WS_YB = 128 * MiB, WS_MERGED = 160 * MiB, WS_X1B = 24 * MiB, WS_QP = 56 * MiB, WS_EIDX = 120 * MiB, WS_EGATE = 128 * MiB;
constexpr size_t WS_UT = 192 * MiB, WS_VT = 224 * MiB, WS_SU = 1 * MiB + 768 * 1024, WS_SV = WS_SU + 65536;
constexpr size_t WS_END = 256 * MiB;

#define GAS __attribute__((address_space(1)))
#define LAS __attribute__((address_space(3)))
typedef float f32x4 __attribute__((ext_vector_type(4)));
typedef unsigned u32x4 __attribute__((ext_vector_type(4)));
typedef unsigned u32x2 __attribute__((ext_vector_type(2)));

__device__ __forceinline__ float bf2f(bf16_t h) { return __uint_as_float(((unsigned)h) << 16); }
__device__ __forceinline__ unsigned f2bf_u(float f) { unsigned u = __float_as_uint(f); return (u + 0x7fffu + ((u >> 16) & 1u)) >> 16; }
__device__ __forceinline__ bf16_t f2bf(float f) { return (bf16_t)f2bf_u(f); }
__device__ __forceinline__ unsigned pk2(float lo, float hi) { return f2bf_u(lo) | (f2bf_u(hi) << 16); }
__device__ __forceinline__ float wave_sum(float v) {
#pragma unroll
    for (int o = 1; o < 64; o <<= 1) v += __shfl_xor(v, o);
    return v;
}
__device__ __forceinline__ float sigmoidf_(float x) { return 1.f / (1.f + __expf(-x)); }

namespace pg8 {
#define PG8_LAS __attribute__((address_space(3)))
typedef short bf16x8 __attribute__((ext_vector_type(8)));
constexpr int BM = 256, BK = 64, HALF = 128, HTB = HALF * BK * 2, STAGE_BYTES = 8 * HTB, NXCD = 8, WGM = 8;
__host__ __device__ __forceinline__ int lds_byte(int r, int c) { const int st = (r >> 4) * 2 + (c >> 5), rr = r & 15, cc = c & 31, ob = rr * 64 + cc * 2; return st * 1024 + (ob ^ (((ob >> 9) & 1) << 5)); }
__host__ __device__ __forceinline__ void stage_rc(int b, int& R, int& C) { const int st = b / 1024, sb = b % 1024, swz = sb ^ (((sb >> 9) & 1) << 5); R = (st >> 1) * 16 + swz / 64; C = (st & 1) * 32 + (swz % 64) / 2; }
__host__ __device__ __forceinline__ int perm32(int rho) { const int n = rho >> 4, i = rho & 15; return 8 * (i >> 2) + 4 * n + (i & 3); }

struct Unit { int pm, pn, sub; const char* A; const char* B; };
struct Gemm { const bf16_t* A; const bf16_t* Bt; const bf16_t* A2; const bf16_t* Bt2; int lda, ldb, M, N, K, chain; };
struct StaticOrder {
    int nM, nN, nwg, G, c, chain; const char *A, *B, *A2, *B2; size_t tsA, tsB;
    __device__ __forceinline__ void init(const Gemm& g, int G_, int c_) { nM = g.M / BM; nN = g.N / BM; nwg = nM * nN; G = G_; c = c_; chain = g.chain; A = (const char*)g.A; B = (const char*)g.Bt; A2 = (const char*)g.A2; B2 = (const char*)g.Bt2;
        tsA = (size_t)BM * g.lda * 2; tsB = (size_t)BM * g.ldb * 2; }
    __device__ __forceinline__ bool next(int i, Unit& u) const {
        const int r = (chain == 2) ? (i >> 1) : i, sub = (chain == 2) ? (i & 1) : 0;
        const long L = (long)r * G + c; if (L >= nwg) return false;
        int wgid = (int)L; { const int q = nwg / NXCD, rr = nwg % NXCD, xcd = wgid % NXCD, off = wgid / NXCD; wgid = (xcd < rr ? xcd * (q + 1) : rr * (q + 1) + (xcd - rr) * q) + off; }
        const int nig = WGM * nN, gid = wgid / nig, fm = gid * WGM, gsz = (nM - fm) < WGM ? (nM - fm) : WGM;
        u.pm = fm + ((wgid % nig) % gsz); u.pn = (wgid % nig) / gsz; u.sub = sub;
        u.A = (sub ? A2 : A) + (size_t)u.pm * tsA; u.B = (sub ? B2 : B) + (size_t)u.pn * tsB; return true;
    }
};
__device__ __forceinline__ unsigned cvt_pk_bf16(float lo, float hi) { unsigned r; asm volatile("v_cvt_pk_bf16_f32 %0, %1, %2" : "=v"(r) : "v"(lo), "v"(hi)); return r; }

typedef f32x4 AccT[2][2][4][2];
template <class Epi, class Sched, bool ALIGN_EPI>
__device__ __forceinline__ void gemm_phase(PG8_LAS unsigned char* lds, const Gemm g, const Sched& S, const Epi& E) {
    const int tid = threadIdx.x, wid = __builtin_amdgcn_readfirstlane(tid >> 6), lane = tid & 63, wr = wid >> 2, wc = wid & 3, fr = lane & 15, fq = lane >> 4;
    const int K = g.K, nt = K / BK;
    unsigned voffA[2], voffB[2];
#pragma unroll
    for (int i = 0; i < 2; ++i) { int R, C; stage_rc(tid * 16 + i * 8192, R, C); const int Rb = Epi::PERM ? ((R & ~31) + perm32(R & 31)) : R;
        voffA[i] = (unsigned)(R * g.lda + C) * 2u; voffB[i] = (unsigned)(Rb * g.ldb + C) * 2u; }
    const size_t kstep = (size_t)(BK * 2);
    const size_t hsA = (size_t)HALF * g.lda * 2, hsB = (size_t)HALF * g.ldb * 2;
    const unsigned ldsw = (unsigned)wid * 1024u;
    const int aoff = lds_byte(wr * 64 + fr, fq * 8), boff = lds_byte(wc * 32 + fr, fq * 8);
#define PG8_SA(b, h) (((b) * 2 + (h)) * HTB)
#define PG8_SB(b, h) ((4 + (b) * 2 + (h)) * HTB)
#define PG8_STAGE(bufoff, gbase, voff) do { _Pragma("unroll") for (int _i = 0; _i < 2; ++_i) \
        __builtin_amdgcn_global_load_lds((const unsigned*)((const char*)(gbase) + (voff)[_i]), (PG8_LAS unsigned*)(lds + (bufoff) + ldsw + _i * 8192), 16, 0, 0); } while (0)
#define PG8_LDA(dst, b, h) do { _Pragma("unroll") for (int m = 0; m < 4; ++m) _Pragma("unroll") for (int k = 0; k < 2; ++k) dst[m][k] = *(const PG8_LAS bf16x8*)(lds + PG8_SA(b, h) + aoff + m * 2048 + k * 1024); } while (0)
#define PG8_LDB(dst, b, h) do { _Pragma("unroll") for (int n = 0; n < 2; ++n) _Pragma("unroll") for (int k = 0; k < 2; ++k) dst[n][k] = *(const PG8_LAS bf16x8*)(lds + PG8_SB(b, h) + boff + n * 2048 + k * 1024); } while (0)
#define PG8_MMA(ai, bj, At, Bt) do { __builtin_amdgcn_s_setprio(1); _Pragma("unroll") for (int m = 0; m < 4; ++m) _Pragma("unroll") for (int n = 0; n < 2; ++n) _Pragma("unroll") for (int k = 0; k < 2; ++k) \
        acc[ai][bj][m][n] = __builtin_amdgcn_mfma_f32_16x16x32_bf16(Bt[n][k], At[m][k], acc[ai][bj][m][n], 0, 0, 0); __builtin_amdgcn_s_setprio(0); } while (0)
#define PG8_WAIT_V(n) asm volatile("s_waitcnt vmcnt(" #n ")" ::: "memory")
#define PG8_WAIT_L(n) asm volatile("s_waitcnt lgkmcnt(" #n ")" ::: "memory")
#define PG8_BAR __builtin_amdgcn_s_barrier()
#define PG8_SCHED __builtin_amdgcn_sched_barrier(0)
    Unit cur, nxt; int ui = 0;
    if (!S.next(0, cur)) return;
    f32x4 acc[2][2][4][2];
#pragma unroll
    for (int a = 0; a < 2; ++a)
#pragma unroll
        for (int b = 0; b < 2; ++b)
#pragma unroll
            for (int m = 0; m < 4; ++m)
#pragma unroll
                for (int n = 0; n < 2; ++n) acc[a][b][m][n] = (f32x4){0.f, 0.f, 0.f, 0.f};
    bf16x8 At[4][2], B0[2][2], B1[2][2];
    const char* cA = cur.A; const char* cB = cur.B;
    PG8_STAGE(PG8_SB(0, 0), cB, voffB); PG8_STAGE(PG8_SB(0, 1), cB + hsB, voffB); PG8_STAGE(PG8_SA(0, 0), cA, voffA); PG8_STAGE(PG8_SA(0, 1), cA + hsA, voffA);
    if (wr == 1) PG8_BAR;
    PG8_WAIT_V(2); PG8_BAR;
    PG8_STAGE(PG8_SB(1, 0), cB + kstep, voffB); PG8_STAGE(PG8_SA(1, 0), cA + kstep, voffA); PG8_STAGE(PG8_SB(1, 1), cB + hsB + kstep, voffB);
    PG8_WAIT_V(6); PG8_BAR;
    for (;;) {
        const bool has_next = S.next(ui + 1, nxt);
        const char* nA = has_next ? nxt.A : cA; const char* nB = has_next ? nxt.B : cB;
        for (int t = 0; t < nt; t += 2) {
            const bool last = (t == nt - 2);
            const char* a1 = cA + (size_t)(t + 1) * kstep;
            const char* a2 = last ? nA : cA + (size_t)(t + 2) * kstep; const char* b2 = last ? nB : cB + (size_t)(t + 2) * kstep;
            const char* a3 = a2 + kstep; const char* b3 = b2 + kstep;
            PG8_LDB(B0, 0, 0); PG8_LDB(B1, 0, 1); PG8_SCHED; PG8_LDA(At, 0, 0); PG8_STAGE(PG8_SA(1, 1), a1 + hsA, voffA);
            PG8_WAIT_V(8); PG8_WAIT_L(0); PG8_BAR; PG8_MMA(0, 0, At, B0); PG8_MMA(0, 1, At, B1); PG8_BAR; PG8_SCHED;
            PG8_LDA(At, 0, 1); PG8_STAGE(PG8_SB(0, 0), b2, voffB); PG8_STAGE(PG8_SB(0, 1), b2 + hsB, voffB); PG8_STAGE(PG8_SA(0, 0), a2, voffA);
            PG8_WAIT_V(8); PG8_WAIT_L(0); PG8_BAR; PG8_MMA(1, 0, At, B0); PG8_MMA(1, 1, At, B1); PG8_BAR; PG8_SCHED;
            PG8_LDB(B0, 1, 0); PG8_LDB(B1, 1, 1); PG8_SCHED; PG8_LDA(At, 1, 0); PG8_STAGE(PG8_SA(0, 1), a2 + hsA, voffA);
            PG8_WAIT_V(8); PG8_WAIT_L(0); PG8_BAR; PG8_MMA(0, 0, At, B0); PG8_MMA(0, 1, At, B1); PG8_BAR; PG8_SCHED;
            PG8_LDA(At, 1, 1); PG8_STAGE(PG8_SB(1, 0), b3, voffB); PG8_STAGE(PG8_SB(1, 1), b3 + hsB, voffB); PG8_STAGE(PG8_SA(1, 0), a3, voffA);
            PG8_WAIT_V(8); PG8_WAIT_L(0); PG8_BAR; PG8_MMA(1, 0, At, B0); PG8_MMA(1, 1, At, B1); PG8_BAR; PG8_SCHED;
        }
        if constexpr (ALIGN_EPI) { if (wr == 0) PG8_BAR; }
        E(acc, cur, wr, wc, fr, fq);
        if (!has_next) break;
        if (!(Epi::CHAIN && nxt.sub != 0)) {
#pragma unroll
            for (int a = 0; a < 2; ++a)
#pragma unroll
                for (int b = 0; b < 2; ++b)
#pragma unroll
                    for (int m = 0; m < 4; ++m)
#pragma unroll
                        for (int n = 0; n < 2; ++n) acc[a][b][m][n] = (f32x4){0.f, 0.f, 0.f, 0.f};
        }
        cur = nxt; cA = nA; cB = nB; ++ui;
        if constexpr (ALIGN_EPI) { if (wr == 1) PG8_BAR; }
    }
    PG8_WAIT_V(0);
    if constexpr (!ALIGN_EPI) { if (wr == 0) PG8_BAR; }
    PG8_BAR;
#undef PG8_SA
#undef PG8_SB
#undef PG8_STAGE
#undef PG8_LDA
#undef PG8_LDB
#undef PG8_MMA
#undef PG8_WAIT_V
#undef PG8_WAIT_L
#undef PG8_BAR
#undef PG8_SCHED
}

struct EpiProj {
    static constexpr bool PERM = true, CHAIN = false;
    bf16_t* pb; bf16_t* pa; float* ssq; float* sskv;
    __device__ __forceinline__ void operator()(AccT& acc, const Unit& u, int wr, int wc, int fr, int fq) const {
        const int row0 = u.pm * BM + wr * 64 + fr;
#pragma unroll
        for (int bj = 0; bj < 2; ++bj) {
            const int hk = u.pn * 2 + bj;
            bf16_t* base; int ld; float* ss = nullptr;
            if (hk < 22) { base = pb + hk * 128; ld = PB_LD; } else { const int ha = hk - 22; base = pa + ha * 128; ld = PA_LD; if (ha >= 6 && ha <= 8) ss = ssq; else if (ha == 9 || ha == 10) ss = sskv; }
            base += wc * 32 + 8 * fq;
#pragma unroll
            for (int ai = 0; ai < 2; ++ai)
#pragma unroll
                for (int m = 0; m < 4; ++m) { const int row = row0 + ai * HALF + m * 16; const f32x4 v0 = acc[ai][bj][m][0], v1 = acc[ai][bj][m][1];
                    u32x4 w; w.x = cvt_pk_bf16(v0[0], v0[1]); w.y = cvt_pk_bf16(v0[2], v0[3]); w.z = cvt_pk_bf16(v1[0], v1[1]); w.w = cvt_pk_bf16(v1[2], v1[3]);
                    *(u32x4*)(base + (size_t)row * ld) = w;
                    if (ss) { float s = (v0[0] * v0[0] + v0[1] * v0[1]) + (v0[2] * v0[2] + v0[3] * v0[3]) + (v1[0] * v1[0] + v1[1] * v1[1]) + (v1[2] * v1[2] + v1[3] * v1[3]);
                        s += __shfl_xor(s, 16); s += __shfl_xor(s, 32); if (fq == 0) atomicAdd(ss + row, s); } }
        }
    }
};
struct EpiQ {
    static constexpr bool PERM = false, CHAIN = false;
    bf16_t* Q; const float* ssq; const float* cs; const float* sn;
    __device__ __forceinline__ void operator()(AccT& acc, const Unit& u, int wr, int wc, int fr, int fq) const {
        const int row0 = u.pm * BM + wr * 64 + fr;
#pragma unroll
        for (int ai = 0; ai < 2; ++ai)
#pragma unroll
            for (int m = 0; m < 4; ++m) { const int row = row0 + ai * HALF + m * 16; const float rr = rsqrtf(ssq[row] * (1.f / 384.f) + EPS) * CQ;
#pragma unroll
                for (int bj = 0; bj < 2; ++bj) { const int G = u.pn * 8 + bj * 4 + wc;
                    f32x4 x0 = acc[ai][bj][m][0], x1 = acc[ai][bj][m][1];
                    if (G % 3 == 2) { const f32x4 c = *(const f32x4*)(cs + (size_t)row * 16 + 4 * fq), s = *(const f32x4*)(sn + (size_t)row * 16 + 4 * fq);
                        const f32x4 o0 = x0 * c - x1 * s, o1 = x1 * c + x0 * s; x0 = o0; x1 = o1; }
                    x0 = x0 * rr; x1 = x1 * rr;
                    bf16_t* p = Q + (size_t)row * 768 + G * 32 + 4 * fq;
                    u32x2 w0, w1; w0.x = cvt_pk_bf16(x0[0], x0[1]); w0.y = cvt_pk_bf16(x0[2], x0[3]); w1.x = cvt_pk_bf16(x1[0], x1[1]); w1.y = cvt_pk_bf16(x1[2], x1[3]);
                    *(u32x2*)p = w0; *(u32x2*)(p + 16) = w1; } }
    }
};
struct EpiKV {
    static constexpr bool PERM = true, CHAIN = false;
    bf16_t* Kb; bf16_t* Vb; const float* sskv;
    __device__ __forceinline__ void operator()(AccT& acc, const Unit& u, int wr, int wc, int fr, int fq) const {
        const int row0 = u.pm * BM + wr * 64 + fr;
#pragma unroll
        for (int ai = 0; ai < 2; ++ai)
#pragma unroll
            for (int m = 0; m < 4; ++m) { const int row = row0 + ai * HALF + m * 16; const float rr = rsqrtf(sskv[row] * (1.f / 256.f) + EPS);
#pragma unroll
                for (int bj = 0; bj < 2; ++bj) { const int head = u.pn * 2 + bj; const f32x4 v0 = acc[ai][bj][m][0] * rr, v1 = acc[ai][bj][m][1] * rr;
                    u32x4 w; w.x = cvt_pk_bf16(v0[0], v0[1]); w.y = cvt_pk_bf16(v0[2], v0[3]); w.z = cvt_pk_bf16(v1[0], v1[1]); w.w = cvt_pk_bf16(v1[2], v1[3]);
                    bf16_t* p = (wc < 2) ? Kb + (size_t)row * 768 + head * 96 + wc * 32 + 8 * fq : Vb + (size_t)row * 512 + head * 64 + (wc - 2) * 32 + 8 * fq;
                    *(u32x4*)p = w; } }
    }
};
struct EpiMerge {
    static constexpr bool PERM = true, CHAIN = true;
    const bf16_t* pb; bf16_t* merged;
    __device__ __forceinline__ void operator()(AccT& acc, const Unit& u, int wr, int wc, int fr, int fq) const {
        const int row0 = u.pm * BM + wr * 64 + fr, col0 = u.pn * BM + wc * 32 + 8 * fq;
#pragma unroll
        for (int ai = 0; ai < 2; ++ai)
#pragma unroll
            for (int m = 0; m < 4; ++m) { const int row = row0 + ai * HALF + m * 16;
#pragma unroll
                for (int bj = 0; bj < 2; ++bj) { const int col = col0 + bj * HALF;
                    const u32x4 gb = *(const u32x4*)(pb + (size_t)row * PB_LD + PB_BR + 1024 + col);
                    float eb[8];
#pragma unroll
                    for (int e = 0; e < 4; ++e) { eb[2 * e] = 1.f + __builtin_amdgcn_exp2f(__uint_as_float(gb[e] << 16) * -1.4426950408889634f); eb[2 * e + 1] = 1.f + __builtin_amdgcn_exp2f(__uint_as_float(gb[e] & 0xffff0000u) * -1.4426950408889634f); }
                    if (u.sub == 0) {
                        const u32x4 ga = *(const u32x4*)(pb + (size_t)row * PB_LD + PB_BR + col);
#pragma unroll
                        for (int e = 0; e < 4; ++e) { const float ea0 = 1.f + __builtin_amdgcn_exp2f(__uint_as_float(ga[e] << 16) * -1.4426950408889634f), ea1 = 1.f + __builtin_amdgcn_exp2f(__uint_as_float(ga[e] & 0xffff0000u) * -1.4426950408889634f);
                            const int i0 = 2 * e, i1 = 2 * e + 1;
                            acc[ai][bj][m][i0 >> 2][i0 & 3] *= eb[i0] * __builtin_amdgcn_rcpf(ea0); acc[ai][bj][m][i1 >> 2][i1 & 3] *= eb[i1] * __builtin_amdgcn_rcpf(ea1); }
                    } else {
                        const f32x4 v0 = acc[ai][bj][m][0], v1 = acc[ai][bj][m][1];
                        float sb[8];
#pragma unroll
                        for (int e = 0; e < 8; ++e) sb[e] = __builtin_amdgcn_rcpf(eb[e]);
                        u32x4 w; w.x = cvt_pk_bf16(v0[0] * sb[0], v0[1] * sb[1]); w.y = cvt_pk_bf16(v0[2] * sb[2], v0[3] * sb[3]); w.z = cvt_pk_bf16(v1[0] * sb[4], v1[1] * sb[5]); w.w = cvt_pk_bf16(v1[2] * sb[6], v1[3] * sb[7]);
                        *(u32x4*)(merged + (size_t)row * DM + col) = w; } } }
    }
};
struct EpiX1 {
    static constexpr bool PERM = false, CHAIN = false;
    const float* x; float* x1; bf16_t* x1b; float* ssx1;
    __device__ __forceinline__ void operator()(AccT& acc, const Unit& u, int wr, int wc, int fr, int fq) const {
        const int row0 = u.pm * BM + wr * 64 + fr, col0 = u.pn * BM + wc * 32 + 4 * fq;
#pragma unroll
        for (int ai = 0; ai < 2; ++ai)
#pragma unroll
            for (int m = 0; m < 4; ++m) { const int row = row0 + ai * HALF + m * 16; const size_t off = (size_t)row * DM + col0; float s = 0.f;
#pragma unroll
                for (int bj = 0; bj < 2; ++bj)
#pragma unroll
                    for (int n = 0; n < 2; ++n) { const size_t o = off + bj * HALF + n * 16; const f32x4 v = *(const f32x4*)(x + o) + acc[ai][bj][m][n];
                        *(f32x4*)(x1 + o) = v; u32x2 w; w.x = cvt_pk_bf16(v[0], v[1]); w.y = cvt_pk_bf16(v[2], v[3]); *(u32x2*)(x1b + o) = w;
                        s += (v[0] * v[0] + v[1] * v[1]) + (v[2] * v[2] + v[3] * v[3]); }
                s += __shfl_xor(s, 16); s += __shfl_xor(s, 32); if (fq == 0) atomicAdd(ssx1 + row, s); }
    }
};
struct EpiQP {
    static constexpr bool PERM = true, CHAIN = false;
    bf16_t* qp; const float* ssx1;
    __device__ __forceinline__ void operator()(AccT& acc, const Unit& u, int wr, int wc, int fr, int fq) const {
        const int row0 = u.pm * BM + wr * 64 + fr, col0 = u.pn * BM + wc * 32 + 8 * fq;
#pragma unroll
        for (int ai = 0; ai < 2; ++ai)
#pragma unroll
            for (int m = 0; m < 4; ++m) { const int row = row0 + ai * HALF + m * 16; const float rr = rsqrtf(ssx1[row] * (1.f / 1024.f) + EPS);
#pragma unroll
                for (int bj = 0; bj < 2; ++bj) { const f32x4 v0 = acc[ai][bj][m][0] * rr, v1 = acc[ai][bj][m][1] * rr;
                    u32x4 w; w.x = cvt_pk_bf16(v0[0], v0[1]); w.y = cvt_pk_bf16(v0[2], v0[3]); w.z = cvt_pk_bf16(v1[0], v1[1]); w.w = cvt_pk_bf16(v1[2], v1[3]);
                    *(u32x4*)(qp + (size_t)row * 2048 + col0 + bj * HALF) = w; } }
    }
};
}


namespace att {
typedef short bf16x8 __attribute__((ext_vector_type(8)));
typedef short s16x4 __attribute__((ext_vector_type(4)));
typedef float f32x16 __attribute__((ext_vector_type(16)));
constexpr int NW = 8, QBLK = 32, KVBLK = 64, QB = NW * QBLK;
constexpr int QS = 768, KS = 768, VS = 512, OS = 512;
constexpr int SHM_V = KVBLK * 64 * 2, SHM_K = KVBLK * 256;
constexpr int LDS_BYTES = 2 * SHM_V + 2 * SHM_K + NW * 64 * 4;
constexpr float THR = 8.f;
#define KSWZ(row, colB) ((row) * 256 + ((colB) ^ (((row) & 7) << 4)))
#define SBAR() __builtin_amdgcn_sched_barrier(0)
__device__ __forceinline__ int v_st(int k, int c) { const int kk = (k & ~0xC) | ((k & 4) << 1) | ((k & 8) >> 1); return ((kk >> 3) * 2 + (c >> 5)) * 512 + ((kk & 7) * 32 + (c & 31)) * 2; }
__device__ __forceinline__ int v_rd_base(int lane) { return ((lane & 3) << 3) | (((lane >> 2) & 3) << 6) | (((lane >> 4) & 1) << 5) | (((lane >> 5) & 1) << 8); }
constexpr int v_rd_off(int d0, int ks, int half) { return d0 * 512 + ks * 2048 + half * 1024; }
__device__ __forceinline__ int crow(int r, int hi) { return (r & 3) + 8 * (r >> 2) + 4 * hi; }
__device__ __forceinline__ unsigned cvtpk(float lo, float hi) { unsigned r; asm volatile("v_cvt_pk_bf16_f32 %0, %1, %2" : "=v"(r) : "v"(lo), "v"(hi)); return r; }
__device__ __forceinline__ bf16x8 load8(const bf16_t* p) { return *reinterpret_cast<const bf16x8*>(p); }
__device__ __forceinline__ void partialSM(f32x16& p0, f32x16& p1, float& m_reg, float& mn, float& alpha) {
    float pmax = p0[0]; for (int r = 1; r < 16; ++r) pmax = fmaxf(pmax, p0[r]); for (int r = 0; r < 16; ++r) pmax = fmaxf(pmax, p1[r]);
    { auto rr = __builtin_amdgcn_permlane32_swap(__float_as_uint(pmax), __float_as_uint(pmax), false, false);
      pmax = fmaxf(__uint_as_float(rr[0]), __uint_as_float(rr[1])); }
    if (__builtin_expect(__all((pmax - m_reg) <= THR), 1)) { mn = m_reg; alpha = 1.f; }
    else { mn = fmaxf(m_reg, pmax); alpha = __builtin_amdgcn_exp2f(m_reg - mn); m_reg = mn; }
    for (int r = 0; r < 16; ++r) p0[r] = p0[r] - mn; for (int r = 0; r < 16; ++r) p1[r] = p1[r] - mn;
    for (int r = 0; r < 16; ++r) p0[r] = __builtin_amdgcn_exp2f(p0[r]);
}
__device__ __forceinline__ void finishSM(f32x16& p0, f32x16& p1, float alpha, float& l_reg, bf16x8& pa0, bf16x8& pa1, bf16x8& pa2, bf16x8& pa3) {
    for (int r = 0; r < 16; ++r) p1[r] = __builtin_amdgcn_exp2f(p1[r]);
    float ps = 0; for (int r = 0; r < 16; ++r) ps += p0[r]; for (int r = 0; r < 16; ++r) ps += p1[r];
    { auto rr = __builtin_amdgcn_permlane32_swap(__float_as_uint(ps), __float_as_uint(ps), false, false);
      ps = __uint_as_float(rr[0]) + __uint_as_float(rr[1]); }
    l_reg = l_reg * alpha + ps;
#define PK4(P, B_, OUT) do { unsigned a0 = cvtpk(P[B_+0], P[B_+1]), a1 = cvtpk(P[B_+2], P[B_+3]);                          \
        unsigned b0 = cvtpk(P[B_+4], P[B_+5]), b1 = cvtpk(P[B_+6], P[B_+7]);                                             \
        auto r0 = __builtin_amdgcn_permlane32_swap(a0, b0, false, false); auto r1 = __builtin_amdgcn_permlane32_swap(a1, b1, false, false); \
        u32x4 w = {r0[0], r1[0], r0[1], r1[1]}; OUT = *reinterpret_cast<bf16x8*>(&w); } while (0)
    PK4(p0, 0, pa0); PK4(p0, 8, pa1); PK4(p1, 0, pa2); PK4(p1, 8, pa3);
#undef PK4
}
template <int KB>
__device__ __forceinline__ void qkt(f32x16& p0, f32x16& p1, const char* K_lds, int r32, int hi, const bf16x8* qr) {
    p0 = f32x16{}; p1 = f32x16{};
    const char* kb[4];
#pragma unroll
    for (int dd = 0; dd < 4; ++dd) kb[dd] = K_lds + KB * SHM_K + KSWZ(r32, (dd * 16 + hi * 8) * 2);
#pragma unroll
    for (int d0 = 0; d0 < 6; ++d0) { const char* a = kb[d0 & 3] + (d0 >> 2) * 128;
        bf16x8 b0 = *reinterpret_cast<const bf16x8*>(a);
        bf16x8 b1 = *reinterpret_cast<const bf16x8*>(a + 32 * 256);
        p0 = __builtin_amdgcn_mfma_f32_32x32x16_bf16(b0, qr[d0], p0, 0, 0, 0);
        p1 = __builtin_amdgcn_mfma_f32_32x32x16_bf16(b1, qr[d0], p1, 0, 0, 0); }
}
template <int VB>
__device__ __forceinline__ void pv_tile(f32x16* o, int vb0, bf16x8 pa0, bf16x8 pa1, bf16x8 pa2, bf16x8 pa3) {
#define TRRD(dst, off) asm volatile("ds_read_b64_tr_b16 %0, %1 offset:%2" : "=&v"(dst) : "v"(vb0), "i"(off) : "memory")
#define PV_D0(d0) do { s16x4 l0, l1, l2, l3, h0, h1, h2, h3; constexpr int b_ = VB * SHM_V + v_rd_off(d0, 0, 0);   \
        TRRD(l0, b_); TRRD(h0, b_ + 1024); TRRD(l1, b_ + 2048); TRRD(h1, b_ + 3072); TRRD(l2, b_ + 4096); TRRD(h2, b_ + 5120); TRRD(l3, b_ + 6144); TRRD(h3, b_ + 7168); \
        asm volatile("s_waitcnt lgkmcnt(0)" ::: "memory"); SBAR();   \
        o[d0] = __builtin_amdgcn_mfma_f32_32x32x16_bf16(pa0, (bf16x8){l0[0], l0[1], l0[2], l0[3], h0[0], h0[1], h0[2], h0[3]}, o[d0], 0, 0, 0);   \
        o[d0] = __builtin_amdgcn_mfma_f32_32x32x16_bf16(pa1, (bf16x8){l1[0], l1[1], l1[2], l1[3], h1[0], h1[1], h1[2], h1[3]}, o[d0], 0, 0, 0);   \
        o[d0] = __builtin_amdgcn_mfma_f32_32x32x16_bf16(pa2, (bf16x8){l2[0], l2[1], l2[2], l2[3], h2[0], h2[1], h2[2], h2[3]}, o[d0], 0, 0, 0);   \
        o[d0] = __builtin_amdgcn_mfma_f32_32x32x16_bf16(pa3, (bf16x8){l3[0], l3[1], l3[2], l3[3], h3[0], h3[1], h3[2], h3[3]}, o[d0], 0, 0, 0); } while (0)
    PV_D0(0); PV_D0(1);
#undef PV_D0
#undef TRRD
}
struct BlockRef { const bf16_t* Q; const bf16_t* K; const bf16_t* V; bf16_t* O; int P0; };
struct Seam { bf16x8 qr[6]; bf16x8 st_v0, st_v1, st_k0, st_k1; };
#define ROWK(p, k0, rr) ((p) + (size_t)((k0) + (rr)) * KS + sc)
#define ROWV(p, k0, rr) ((p) + (size_t)((k0) + (rr)) * VS + sc)
#define VMW() asm volatile("s_waitcnt vmcnt(0)" ::: "memory")
#define VMWN(n) asm volatile("s_waitcnt vmcnt(%0)" :: "i"(n) : "memory")
#define SLOAD_H(Kp, Vp, k0) do { if (vact) { S.st_v0 = load8(ROWV(Vp, k0, sr)); S.st_v1 = load8(ROWV(Vp, k0, 32 + sr)); }              \
                                 if (kact) { S.st_k0 = load8(ROWK(Kp, k0, sr)); S.st_k1 = load8(ROWK(Kp, k0, 32 + sr)); } } while (0)
#define SWRITE_HK(bf) do { if (kact) { *(bf16x8*)(K_lds + (bf) * SHM_K + kws) = S.st_k0; *(bf16x8*)(K_lds + (bf) * SHM_K + kws + 32 * 256) = S.st_k1; } } while (0)
#define SWRITE_HV(bf) do { if (vact) { *(bf16x8*)(V_lds + (bf) * SHM_V + vst0) = S.st_v0; *(bf16x8*)(V_lds + (bf) * SHM_V + vst1) = S.st_v1; } } while (0)
#define SWRITE_H(bf) do { SWRITE_HV(bf); SWRITE_HK(bf); } while (0)
__device__ __forceinline__ void attn_prime(const BlockRef& cur, char* lds, Seam& S) {
    const int tid = threadIdx.x, wid = __builtin_amdgcn_readfirstlane(tid >> 6), lane = tid & 63, r32 = lane & 31, hi = lane >> 5;
    const int sr = tid >> 4, sc = (tid & 15) * 8, kws = KSWZ(sr, sc * 2); char* K_lds = lds + 2 * SHM_V;
    const bool kact = (tid & 15) < 12, vact = (tid & 15) < 8;
#pragma unroll
    for (int d0 = 0; d0 < 6; ++d0) S.qr[d0] = load8(cur.Q + (size_t)(wid * QBLK + r32) * QS + d0 * 16 + hi * 8);
    SLOAD_H(cur.K, cur.V, 0); VMW(); SWRITE_HK(0);
    __syncthreads();
}
__device__ __forceinline__ void attn_block(const BlockRef& cur, const BlockRef& nxt, char* lds, Seam& S) {
    const int tid = threadIdx.x, wid = __builtin_amdgcn_readfirstlane(tid >> 6), lane = tid & 63, r32 = lane & 31, hi = lane >> 5;
    const int NT = (cur.P0 + QB - 1) / KVBLK + 1;
    const int qlo = cur.P0 + wid * QBLK;
    const int qvis = qlo | 63;
    char* V_lds = lds; char* K_lds = lds + 2 * SHM_V;
    float* ws = (float*)(lds + 2 * SHM_V + 2 * SHM_K) + wid * 64; float* li_l = ws, * al_l = ws + 32;
    float m_reg = -1e30f, l_reg = 0; f32x16 o[2] = {};
    const int sr = tid >> 4, sc = (tid & 15) * 8, vst0 = v_st(sr, sc & 63), vst1 = v_st(32 + sr, sc & 63), kws = KSWZ(sr, sc * 2);
    const bool kact = (tid & 15) < 12, vact = (tid & 15) < 8;
    const int vb0 = (int)(uintptr_t)V_lds + v_rd_base(lane);
    const bf16_t* Kh = cur.K; const bf16_t* Vh = cur.V;
#define RESC(a) do { if (__any((a) < 1.f)) { if (hi == 0) al_l[r32] = (a); asm volatile("s_waitcnt lgkmcnt(0)" ::: "memory");              \
                     for (int d_ = 0; d_ < 2; ++d_) for (int r = 0; r < 16; ++r) o[d_][r] *= al_l[crow(r, hi)]; } } while (0)
#define KBASE(t) ((t) * KVBLK)
#define MASKT(P0_, P1_, t) do { if (KBASE(t) > qvis) { const float NEG_ = -__builtin_inff(); _Pragma("unroll") for (int r = 0; r < 16; ++r) { P0_[r] = NEG_; P1_[r] = NEG_; } } } while (0)
    constexpr int NQL = 6;
#define SEAM_K0() do { VMWN(NQL); SWRITE_HK(0); SBAR(); } while (0)
    f32x16 pA0, pA1, pB0, pB1; float mnA, mnB, alA, alB; bf16x8 pa0, pa1, pa2, pa3;
    SWRITE_HV(0); SBAR();
    if (NT > 1) { SLOAD_H(Kh, Vh, KBASE(1)); }
    SBAR(); qkt<0>(pA0, pA1, K_lds, r32, hi, S.qr);
    MASKT(pA0, pA1, 0); partialSM(pA0, pA1, m_reg, mnA, alA);
    if (NT > 1) { VMW(); SWRITE_H(1); }
    __syncthreads();
#define HALF_STEP(PX0, PX1, mnX, alX, PY0, PY1, alY, t, KB, VB, SB) do {                                                      \
        SBAR(); qkt<KB>(PX0, PX1, K_lds, r32, hi, S.qr);                                             \
        finishSM(PY0, PY1, alY, l_reg, pa0, pa1, pa2, pa3); SBAR();                                                           \
        if ((t) + 1 < NT) { SLOAD_H(Kh, Vh, KBASE((t) + 1)); SBAR(); }                                               \
        pv_tile<VB>(o, vb0, pa0, pa1, pa2, pa3); MASKT(PX0, PX1, (t)); partialSM(PX0, PX1, m_reg, mnX, alX);                                        \
        __syncthreads();                                                                                                      \
        if ((t) + 1 < NT) { VMW(); SWRITE_H(SB); }                                                                          \
        RESC(alX); __syncthreads(); } while (0)
    for (int t = 1; t + 1 < NT; t += 2) {
        HALF_STEP(pB0, pB1, mnB, alB, pA0, pA1, alA, t, 1, 0, 0);
        HALF_STEP(pA0, pA1, mnA, alA, pB0, pB1, alB, t + 1, 0, 1, 1);
    }
    const bool even = (NT & 1) == 0;
    if (even) { SBAR(); qkt<1>(pB0, pB1, K_lds, r32, hi, S.qr); SBAR(); }
    SLOAD_H(nxt.K, nxt.V, 0); SBAR();
#pragma unroll
    for (int d0 = 0; d0 < 6; ++d0) S.qr[d0] = load8(nxt.Q + (size_t)(wid * QBLK + r32) * QS + d0 * 16 + hi * 8);
    SBAR();
    finishSM(pA0, pA1, alA, l_reg, pa0, pa1, pa2, pa3); SBAR();
    pv_tile<0>(o, vb0, pa0, pa1, pa2, pa3);
    if (even) { MASKT(pB0, pB1, NT - 1); partialSM(pB0, pB1, m_reg, mnB, alB); __syncthreads(); RESC(alB);
        finishSM(pB0, pB1, alB, l_reg, pa0, pa1, pa2, pa3); SBAR(); pv_tile<1>(o, vb0, pa0, pa1, pa2, pa3); }
    SBAR(); SEAM_K0();
    if (hi == 0) li_l[r32] = l_reg; asm volatile("s_waitcnt lgkmcnt(0)" ::: "memory");
    float rli[16];
#pragma unroll
    for (int r = 0; r < 16; ++r) rli[r] = __builtin_amdgcn_rcpf(li_l[crow(r, hi)]);
    bf16_t* Ow = cur.O + (size_t)(wid * QBLK) * OS;
#pragma unroll
    for (int r = 0; r < 16; ++r) { const int orow = crow(r, hi);
#pragma unroll
        for (int d0 = 0; d0 < 2; ++d0) { const float v = o[d0][r] * rli[r];
            const float vn = __shfl_xor(v, 1);
            if ((r32 & 1) == 0) *(unsigned*)(Ow + (size_t)orow * OS + d0 * 32 + r32) = cvtpk(v, vn); } }
    __syncthreads();
#undef RESC
#undef KBASE
#undef MASKT
#undef SEAM_K0
#undef HALF_STEP
}
#undef ROWK
#undef ROWV
#undef VMW
#undef VMWN
#undef SLOAD_H
#undef SWRITE_HK
#undef SWRITE_HV
#undef SWRITE_H
#undef KSWZ
#undef SBAR
}

namespace gla {
typedef short bf16x8 __attribute__((ext_vector_type(8)));
typedef short s16x4 __attribute__((ext_vector_type(4)));
typedef float f32x16 __attribute__((ext_vector_type(16)));
template <int NCB> __device__ __forceinline__ int t_st(int k, int c) { const int kk = (k & ~0xC) | ((k & 4) << 1) | ((k & 8) >> 1); return ((kk >> 3) * NCB + (c >> 5)) * 512 + ((kk & 7) * 32 + (c & 31)) * 2; }
__device__ __forceinline__ int t_rd_base(int lane) { return ((lane & 3) << 3) | (((lane >> 2) & 3) << 6) | (((lane >> 4) & 1) << 5) | (((lane >> 5) & 1) << 8); }
template <int NCB> constexpr int t_rd_off(int d0, int ks, int half) { return d0 * 512 + ks * (NCB * 1024) + half * (NCB * 512); }
#define GLA_TRRD(dst, addr, off) asm volatile("ds_read_b64_tr_b16 %0, %1 offset:%2" : "=&v"(dst) : "v"(addr), "i"(off) : "memory")
__device__ __forceinline__ int crow(int r, int hi) { return (r & 3) + 8 * (r >> 2) + 4 * hi; }
}

#define XB_TMO      128
#define XB_XCNT(j)  (256  + 64 * (j))
#define XB_XSUB(j)  (1280 + 64 * (j))
#define XB_XGEN(j)  (2304 + 64 * (j))
#define XB_TOP      3328
#define XB_TOPGEN   3392
#define XCD_BAR_WORDS 3456
#define XB_SPIN_CAP (1u << 18)
__device__ __forceinline__ unsigned xb_ld(unsigned* p)              { return __hip_atomic_load(p, __ATOMIC_RELAXED, __HIP_MEMORY_SCOPE_AGENT); }
__device__ __forceinline__ unsigned xb_add(unsigned* p, unsigned v) { return __hip_atomic_fetch_add(p, v, __ATOMIC_RELAXED, __HIP_MEMORY_SCOPE_AGENT); }
__device__ __forceinline__ unsigned xb_xcc_id() { return (unsigned)__builtin_amdgcn_s_getreg((3 << 11) | 20) & 0xFu; }
#define XB_SPIN(cond, bar) do { unsigned _sp = 0; while (cond) { __builtin_amdgcn_s_sleep(1); \
    if ((++_sp & 255u) == 0u) { if (xb_ld(&(bar)[XB_TMO])) break; if (_sp > XB_SPIN_CAP) { atomicAdd(&(bar)[XB_TMO], 1u); break; } } } } while (0)
struct XcdBarrier { unsigned* bar; unsigned x; volatile LAS unsigned* st; };
__device__ __forceinline__ XcdBarrier xcd_barrier_post(unsigned* bar, volatile LAS unsigned* st) {
    XcdBarrier b; b.bar = bar; b.x = xb_xcc_id(); b.st = st;
    if (threadIdx.x == 0) st[2] = xb_add(&bar[XB_XCNT(b.x)], 1u);
    return b;
}
__device__ __forceinline__ void xcd_barrier_complete(unsigned* bar, unsigned x, unsigned& nloc, unsigned& nx) {
    const unsigned G = gridDim.x * gridDim.y * gridDim.z;
    unsigned sum, cnt, mine, sp = 0u;
    for (;;) {
        sum = 0u; cnt = 0u; mine = 0u;
#pragma unroll
        for (unsigned j = 0; j < 16; ++j) { const unsigned c = xb_ld(&bar[XB_XCNT(j)]); sum += c; cnt += (c > 0u) ? 1u : 0u; mine = (j == x) ? c : mine; }
        if (sum == G) break;
        __builtin_amdgcn_s_sleep(1);
        if ((++sp & 255u) == 0u) { if (xb_ld(&bar[XB_TMO])) break; if (sp > XB_SPIN_CAP) { atomicAdd(&bar[XB_TMO], 1u); break; } }
    }
    nloc = mine > 0u ? mine : 1u; nx = cnt > 0u ? cnt : 1u;
}
__device__ __forceinline__ void xcd_barrier(const XcdBarrier& b) {
    asm volatile("s_waitcnt vmcnt(0)" ::: "memory");
    __syncthreads();
    if (threadIdx.x == 0) {
        unsigned* bar = b.bar;
        __builtin_amdgcn_s_waitcnt(0);
        unsigned nloc = b.st[0], nx = b.st[1];
        if (nloc == 0u) { xcd_barrier_complete(bar, b.x, nloc, nx); b.st[0] = nloc; b.st[1] = nx; }
        const unsigned old = xb_add(&bar[XB_XSUB(b.x)], 1u);
        const unsigned gen = old / nloc;
        if (old + 1u == (gen + 1u) * nloc) {
            __builtin_amdgcn_fence(__ATOMIC_RELEASE, "agent");
            asm volatile("s_waitcnt vmcnt(0)" ::: "memory");
            const unsigned og = xb_add(&bar[XB_TOP], 1u);
            const unsigned tg = og / nx;
            if (og + 1u == (tg + 1u) * nx) xb_add(&bar[XB_TOPGEN], 1u);
            else XB_SPIN(xb_ld(&bar[XB_TOPGEN]) == tg, bar);
            __builtin_amdgcn_fence(__ATOMIC_ACQUIRE, "agent");
            xb_add(&bar[XB_XGEN(b.x)], 1u);
            asm volatile("s_waitcnt vmcnt(0)" ::: "memory");
        } else {
            XB_SPIN(xb_ld(&bar[XB_XGEN(b.x)]) == gen, bar);
            __builtin_amdgcn_fence(__ATOMIC_ACQUIRE, "agent");
            asm volatile("s_waitcnt vmcnt(0)" ::: "memory");
        }
    }
    __syncthreads();
}

constexpr int NWAVES = 8;
constexpr int RING_BYTES = 131072, LDSCTL_OFF = RING_BYTES, MISC_OFF = LDSCTL_OFF + 320, LDS_BYTES = 147456;
constexpr int CW_BAR = 4096;

struct Args { const void* in[20]; float* out; unsigned char* ws; int ph_lo, ph_hi; };

__device__ __forceinline__ int win_srccol(int n) {
    if (n < 2048) return 2224 + n;
    if (n < 2560) return 1712 + (n - 2048);
    if (n < 2816) return 672 + (n - 2560);
    if (n < 3328) return 1184 + (n - 2816);
    if (n < 3584) return 928 + (n - 3328);
    if (n < 3968) return 0 + (n - 3584);
    if (n < 4224) return 384 + (n - 3968);
    if (n < 4256) return 640 + (n - 4224);
    if (n < 4272) return 1696 + (n - 4256);
    return -1;
}
__device__ __forceinline__ void transpose_item(const float* __restrict__ W, int K, int Nsrc, bf16_t* __restrict__ WT, int Nout, const float* __restrict__ kscale, bool winperm, float* scr, int item, int lane) {
    const int nblk = Nout / 32, kb = item / nblk, nb = item % nblk, k0 = 64 * kb, n0 = 32 * nb;
    const int n = n0 + (lane & 31); const int sc = winperm ? win_srccol(n) : n;
#pragma unroll 8
    for (int i = 0; i < 32; ++i) { const int kk = 2 * i + (lane >> 5); float v = 0.f; if (sc >= 0) { v = W[(size_t)(k0 + kk) * Nsrc + sc]; if (kscale) v *= kscale[k0 + kk]; } scr[kk * 33 + (lane & 31)] = v; }
    asm volatile("s_waitcnt lgkmcnt(0)" ::: "memory");
    const int c = lane & 7;
#pragma unroll
    for (int j = 0; j < 4; ++j) { const int nn = (lane >> 3) + 8 * j; const float* s = scr + (8 * c) * 33 + nn;
        u32x4 o; o.x = pk2(s[0 * 33], s[1 * 33]); o.y = pk2(s[2 * 33], s[3 * 33]); o.z = pk2(s[4 * 33], s[5 * 33]); o.w = pk2(s[6 * 33], s[7 * 33]);
        *(u32x4*)(WT + (size_t)(n0 + nn) * K + k0 + 8 * c) = o; }
    asm volatile("s_waitcnt lgkmcnt(0)" ::: "memory");
}

#define TOPK_INSERT(tv, ti, vv, ii) do { float v_ = (vv); int i_ = (ii); \
    _Pragma("unroll") for (int q_ = 0; q_ < 16; ++q_) { const bool gt_ = (v_ > tv[q_]) || (v_ == tv[q_] && i_ < ti[q_]); const float tv_ = tv[q_]; const int ti_ = ti[q_]; \
        tv[q_] = gt_ ? v_ : tv_; ti[q_] = gt_ ? i_ : ti_; v_ = gt_ ? tv_ : v_; i_ = gt_ ? ti_ : i_; } } while (0)

template <int OFFS> __device__ __forceinline__ void quant_rows2(const float* __restrict__ tab, const float* __restrict__ g, unsigned char* __restrict__ qt, float* __restrict__ sc, int row0, int lane) {
    f32x4 v[2][4];
#pragma unroll
    for (int rr = 0; rr < 2; ++rr)
#pragma unroll
        for (int j = 0; j < 4; ++j) v[rr][j] = *(const f32x4*)(tab + (size_t)(row0 + rr) * 1024 + 16 * lane + 4 * j);
#pragma unroll
    for (int rr = 0; rr < 2; ++rr) {
        float mx = 0.f;
#pragma unroll
        for (int j = 0; j < 4; ++j) { if (g) v[rr][j] = v[rr][j] * *(const f32x4*)(g + 16 * lane + 4 * j);
            mx = fmaxf(mx, fmaxf(fmaxf(fabsf(v[rr][j][0]), fabsf(v[rr][j][1])), fmaxf(fabsf(v[rr][j][2]), fabsf(v[rr][j][3])))); }
#pragma unroll
        for (int o = 1; o < 64; o <<= 1) mx = fmaxf(mx, __shfl_xor(mx, o));
        mx = fmaxf(mx, 1e-30f);
        const float inv = 127.f / mx;
        u32x4 w;
#pragma unroll
        for (int j = 0; j < 4; ++j) { unsigned b = 0;
#pragma unroll
            for (int e = 0; e < 4; ++e) { const int q = (int)rintf(v[rr][j][e] * inv) + OFFS; b |= ((unsigned)q & 0xffu) << (8 * e); }
            w[j] = b; }
        *(u32x4*)(qt + (size_t)(lane >> 3) * (16384 * 128) + (size_t)(row0 + rr) * 128 + 16 * (lane & 7)) = w;
        if (lane == 0) sc[row0 + rr] = mx * (1.f / 127.f);
    }
}
typedef __bf16 bf2_t __attribute__((ext_vector_type(2)));
__device__ __forceinline__ float dot2_bf16(unsigned a, unsigned b, float acc) { return __builtin_amdgcn_fdot2_f32_bf16(__builtin_bit_cast(bf2_t, a), __builtin_bit_cast(bf2_t, b), acc, false); }
__global__ void __launch_bounds__(NWAVES * 64, 2) fwd(Args args) {
    extern __shared__ __attribute__((aligned(16))) unsigned char lds[];
    const int tid = threadIdx.x, lane = tid & 63, wave = __builtin_amdgcn_readfirstlane(tid >> 6);
    const int G = gridDim.x; int vcu; { const int bx = blockIdx.x; vcu = (G % 8 == 0) ? (bx % 8) * (G / 8) + bx / 8 : bx; }
    const int gw = vcu * NWAVES + wave, NGW = G * NWAVES, gtid = vcu * 512 + tid, NT = G * 512;
    unsigned char* ws = args.ws;
    const float* x = (const float*)args.in[0]; const int* positions = (const int*)args.in[1];
    const float* g_mix = (const float*)args.in[2]; const float* w_in = (const float*)args.in[3]; const float* g_q_lat = (const float*)args.in[4]; const float* w_qb = (const float*)args.in[5];
    const float* g_kv_lat = (const float*)args.in[6]; const float* w_kvb = (const float*)args.in[7]; const float* w_a2 = (const float*)args.in[8]; const float* b_a2 = (const float*)args.in[9];
    const float* g_gla = (const float*)args.in[10]; const float* w_branch_a = (const float*)args.in[11]; const float* w_branch_b = (const float*)args.in[12]; const float* w_out = (const float*)args.in[13];
    const float* g_ffn = (const float*)args.in[14]; const float* w_peer_q = (const float*)args.in[15]; const float* sub_keys = (const float*)args.in[16]; const float* peer_u = (const float*)args.in[17];
    const float* peer_v = (const float*)args.in[18]; const float* g_final = (const float*)args.in[19];
    float* out = args.out;
    float* SSQ = (float*)(ws + WS_SSQ); float* SSKV = (float*)(ws + WS_SSKV); float* SSX1 = (float*)(ws + WS_SSX1); float* COS = (float*)(ws + WS_COS); float* SIN = (float*)(ws + WS_SIN);
    float* DECAY = (float*)(ws + WS_DECAY);
    bf16_t* WIN = (bf16_t*)(ws + WS_WIN); bf16_t* WQB = (bf16_t*)(ws + WS_WQB); bf16_t* WKVB = (bf16_t*)(ws + WS_WKVB); bf16_t* WA = (bf16_t*)(ws + WS_WA); bf16_t* WB = (bf16_t*)(ws + WS_WB);
    bf16_t* WOUT = (bf16_t*)(ws + WS_WOUT); bf16_t* WPQ = (bf16_t*)(ws + WS_WPQ); bf16_t* KEYS = (bf16_t*)(ws + WS_KEYS);
    bf16_t* PROJB = (bf16_t*)(ws + WS_PROJB); bf16_t* PROJA = (bf16_t*)(ws + WS_PROJA); bf16_t* XN = (bf16_t*)(ws + WS_XN);
    bf16_t* Q = (bf16_t*)(ws + WS_Q); bf16_t* K = (bf16_t*)(ws + WS_K); bf16_t* V = (bf16_t*)(ws + WS_V); float* DST = (float*)(ws + WS_DST);
    bf16_t* YA = (bf16_t*)(ws + WS_YA); bf16_t* YB = (bf16_t*)(ws + WS_YB); bf16_t* MERGED = (bf16_t*)(ws + WS_MERGED); bf16_t* X1B = (bf16_t*)(ws + WS_X1B); bf16_t* QP = (bf16_t*)(ws + WS_QP);
    int* EIDX = (int*)(ws + WS_EIDX); float* EGATE = (float*)(ws + WS_EGATE); unsigned char* UT = ws + WS_UT; unsigned char* VT = ws + WS_VT; float* SU = (float*)(ws + WS_SU); float* SV = (float*)(ws + WS_SV); float* SS2 = (float*)(ws + WS_SS2); float* ZP = (float*)(ws + WS_ZP); float* CS = (float*)(ws + WS_C128); signed char* CQ = (signed char*)(ws + WS_CB);

    for (int u = tid; u < (LDS_BYTES - LDSCTL_OFF) / 4; u += NWAVES * 64) ((unsigned*)(lds + LDSCTL_OFF))[u] = 0u;
    __syncthreads();
    XcdBarrier bar; bar.bar = (unsigned*)(ws + WS_CTL) + CW_BAR; bar.x = 0; bar.st = nullptr;
    if (MK_N_LAUNCHES == 1) bar = xcd_barrier_post((unsigned*)(ws + WS_CTL) + CW_BAR, (volatile LAS unsigned*)(lds + MISC_OFF) + 8);
    const int ph_lo_ = args.ph_lo, ph_hi_ = args.ph_hi;
#define IN(k) (ph_lo_ <= (k) && (k) < ph_hi_)
#define SEAM(k) do { if (MK_N_LAUNCHES == 1) { if (IN(k) && IN((k) + 1)) xcd_barrier(bar); } } while (0)
    PG8_LAS unsigned char* ring = (PG8_LAS unsigned char*)lds;

    if (IN(0)) {
        for (int i = gtid; i < 4 * M_; i += NT) SSQ[i] = 0.f;
        float* scr = (float*)(lds + wave * 16384);
        constexpr int I_WIN = 16 * (NPROJ / 32), I_QB = 6 * 24, I_KVB = 4 * 32, I_A = 8 * 32, I_OUT = 16 * 32, I_PQ = 16 * 64;
        constexpr int NITEMS = I_WIN + I_QB + I_KVB + 2 * I_A + I_OUT + I_PQ;
        for (int it = gw; it < NITEMS; it += NGW) {
            int r = it;
            if (r < I_WIN) { transpose_item(w_in, 1024, 4272, WIN, NPROJ, nullptr, true, scr, r, lane); continue; } r -= I_WIN;
            if (r < I_QB) { transpose_item(w_qb, 384, 768, WQB, 768, g_q_lat, false, scr, r, lane); continue; } r -= I_QB;
            if (r < I_KVB) { transpose_item(w_kvb, 256, 1024, WKVB, 1024, g_kv_lat, false, scr, r, lane); continue; } r -= I_KVB;
            if (r < I_A) { transpose_item(w_branch_a, 512, 1024, WA, 1024, nullptr, false, scr, r, lane); continue; } r -= I_A;
            if (r < I_A) { transpose_item(w_branch_b, 512, 1024, WB, 1024, nullptr, false, scr, r, lane); continue; } r -= I_A;
            if (r < I_OUT) { transpose_item(w_out, 1024, 1024, WOUT, 1024, nullptr, false, scr, r, lane); continue; } r -= I_OUT;
            transpose_item(w_peer_q, 1024, 2048, WPQ, 2048, g_ffn, false, scr, r, lane);
        }
        for (int i = gtid; i < 16 * 128 * 128; i += NT) KEYS[i] = f2bf(sub_keys[i]);
        for (int i = gtid; i < M_ * 16; i += NT) { const int m = i >> 4, f = i & 15;
            const double inv = pow(10000.0, -(double)f / 16.0); const double ang = (double)positions[m] * inv;
            COS[i] = (float)cos(ang); SIN[i] = (float)sin(ang); }
        for (int row = gw; row < M_; row += NGW) {
            const f32x4* xr = (const f32x4*)(x + (size_t)row * DM); f32x4 v[4]; float ss = 0.f;
#pragma unroll
            for (int j = 0; j < 4; ++j) { v[j] = xr[lane + 64 * j]; ss += (v[j][0] * v[j][0] + v[j][1] * v[j][1]) + (v[j][2] * v[j][2] + v[j][3] * v[j][3]); }
            ss = wave_sum(ss); const float r = rsqrtf(ss * (1.f / DM) + EPS);
#pragma unroll
            for (int j = 0; j < 4; ++j) { const int c = 4 * (lane + 64 * j); const f32x4 gg = *(const f32x4*)(g_mix + c);
                u32x2 w; w.x = pk2(v[j][0] * r * gg[0], v[j][1] * r * gg[1]); w.y = pk2(v[j][2] * r * gg[2], v[j][3] * r * gg[3]);
                *(u32x2*)(XN + (size_t)row * DM + c) = w; }
        }
    }
    SEAM(0);
    if (MK_N_LAUNCHES == 1 && IN(0) && IN(1)) { if (tid == 0) { unsigned ord = 0; for (unsigned j = 0; j < 16; ++j) if (j < bar.x && xb_ld(&bar.bar[XB_XCNT(j)]) > 0u) ++ord; bar.st[3] = ord; } __syncthreads(); }
    if (IN(1)) {
        pg8::Gemm g{XN, WIN, nullptr, nullptr, DM, DM, M_, NPROJ, DM, 1}; pg8::StaticOrder S; S.init(g, G, (int)blockIdx.x);
        pg8::EpiProj E{PROJB, PROJA, SSQ, SSKV};
        pg8::gemm_phase<pg8::EpiProj, pg8::StaticOrder, true>(ring, g, S, E);
    }
    SEAM(1);
    if (IN(2)) {
        { pg8::Gemm g{PROJA + PA_QLAT, WQB, nullptr, nullptr, PA_LD, 384, M_, 768, 384, 1}; pg8::StaticOrder S; S.init(g, G, (int)blockIdx.x);
          pg8::EpiQ E{Q, SSQ, COS, SIN}; pg8::gemm_phase<pg8::EpiQ, pg8::StaticOrder, true>(ring, g, S, E); }
        { pg8::Gemm g{PROJA + PA_KVLAT, WKVB, nullptr, nullptr, PA_LD, 256, M_, 1024, 256, 1}; pg8::StaticOrder S; S.init(g, G, (int)blockIdx.x);
          pg8::EpiKV E{K, V, SSKV}; pg8::gemm_phase<pg8::EpiKV, pg8::StaticOrder, true>(ring, g, S, E); }
        for (int i = gtid; i < M_ * 32; i += NT) { const int m = i >> 5, j = i & 31; const bf16_t* kr = PROJA + (size_t)m * PA_LD + PA_KROPE; float o;
            if (j < 16) { const float x1 = bf2f(kr[j]), x2 = bf2f(kr[j + 16]); o = x1 * COS[m * 16 + j] - x2 * SIN[m * 16 + j]; }
            else { const int f = j - 16; const float x2 = bf2f(kr[j]), x1 = bf2f(kr[j - 16]); o = x2 * COS[m * 16 + f] + x1 * SIN[m * 16 + f]; }
            const bf16_t ob = f2bf(o);
#pragma unroll
            for (int h = 0; h < 8; ++h) K[(size_t)m * 768 + h * 96 + 64 + j] = ob; }
        __syncthreads();
        {
            const int r32 = lane & 31, hi5 = lane >> 5;
            unsigned char* gvt = lds; unsigned char* kdt = lds + 16384;
            const int tbase = (int)(uintptr_t)lds + gla::t_rd_base(lane);
            for (int unit = vcu; unit < 2 * NCH * 4; unit += G) {
                const int h = unit & 3, bc = unit >> 2, t0 = bc * 64;
                {
                    const int sr = tid >> 4, ch = tid & 15;
#pragma unroll
                    for (int rr = 0; rr < 2; ++rr) { const int row = sr + 32 * rr; const u32x4 v = *(const u32x4*)(PROJA + (size_t)(t0 + row) * PA_LD + PA_GV + h * 128 + ch * 8);
                        *(u32x4*)(gvt + gla::t_st<4>(row, ch * 8)) = v; }
                }
                {
                    const int k0 = wave * 8; const bf16_t* prow = PROJA + (size_t)(t0 + lane) * PA_LD;
                    const u32x4 ga = *(const u32x4*)(prow + PA_GLR), gb = *(const u32x4*)(prow + PA_GLR + 8), gkv = *(const u32x4*)(prow + PA_GK + h * 64 + k0);
                    float glr[16];
#pragma unroll
                    for (int q = 0; q < 4; ++q) { glr[2 * q] = __uint_as_float(ga[q] << 16); glr[2 * q + 1] = __uint_as_float(ga[q] & 0xffff0000u); glr[8 + 2 * q] = __uint_as_float(gb[q] << 16); glr[8 + 2 * q + 1] = __uint_as_float(gb[q] & 0xffff0000u); }
                    float kdv[8];
#pragma unroll
                    for (int j = 0; j < 8; ++j) { const int kc = h * 64 + k0 + j; float z = b_a2[kc];
#pragma unroll
                        for (int r = 0; r < 16; ++r) z += glr[r] * w_a2[r * 256 + kc];
                        float v = (fminf(z, 0.f) - log1pf(expf(-fabsf(z)))) * (1.f / 16.f);
#pragma unroll
                        for (int d = 1; d < 64; d <<= 1) { const float t = __shfl_up(v, d); v += (lane >= d) ? t : 0.f; }
                        const float cl = __builtin_bit_cast(float, __builtin_amdgcn_readlane(__builtin_bit_cast(int, v), 63));
                        const unsigned gw_ = gkv[j >> 1]; const float gk = (j & 1) ? __uint_as_float(gw_ & 0xffff0000u) : __uint_as_float(gw_ << 16);
                        kdv[j] = gk * expf(cl - v);
                        if (lane == 0) DECAY[((size_t)bc * 4 + h) * 64 + k0 + j] = expf(cl); }
                    u32x4 w; w.x = pk2(kdv[0], kdv[1]); w.y = pk2(kdv[2], kdv[3]); w.z = pk2(kdv[4], kdv[5]); w.w = pk2(kdv[6], kdv[7]);
                    *(u32x4*)(kdt + gla::t_st<2>(lane, k0)) = w;
                }
                __syncthreads();
                {
                    const int kt = wave >> 2, vt = wave & 3; gla::f32x16 acc = {};
                    gla::s16x4 al[4], ah[4], bl[4], bh[4];
                    const int abase = tbase + kt * 512, bbase = tbase + vt * 512;
#define GLA_KS(ks) do { GLA_TRRD(al[ks], abase, 16384 + gla::t_rd_off<2>(0, ks, 0)); GLA_TRRD(ah[ks], abase, 16384 + gla::t_rd_off<2>(0, ks, 1)); GLA_TRRD(bl[ks], bbase, gla::t_rd_off<4>(0, ks, 0)); GLA_TRRD(bh[ks], bbase, gla::t_rd_off<4>(0, ks, 1)); } while (0)
                    GLA_KS(0); GLA_KS(1); GLA_KS(2); GLA_KS(3);
#undef GLA_KS
                    asm volatile("s_waitcnt lgkmcnt(0)" ::: "memory"); __builtin_amdgcn_sched_barrier(0);
#pragma unroll
                    for (int ks = 0; ks < 4; ++ks) acc = __builtin_amdgcn_mfma_f32_32x32x16_bf16((gla::bf16x8){al[ks][0], al[ks][1], al[ks][2], al[ks][3], ah[ks][0], ah[ks][1], ah[ks][2], ah[ks][3]},
                                                                                                 (gla::bf16x8){bl[ks][0], bl[ks][1], bl[ks][2], bl[ks][3], bh[ks][0], bh[ks][1], bh[ks][2], bh[ks][3]}, acc, 0, 0, 0);
                    float* dp = DST + (((size_t)bc * 4 + h) * 64 + kt * 32) * 128 + vt * 32 + r32;
#pragma unroll
                    for (int r = 0; r < 16; ++r) dp[(size_t)gla::crow(r, hi5) * 128] = acc[r];
                }
                __syncthreads();
            }
        }
    }
    SEAM(2);
    if (IN(3)) {
        if (tid < 256) for (int i = vcu * 256 + tid; i < 65536; i += G * 256) {
            const int v = i & 127, k = (i >> 7) & 63, h = (i >> 13) & 3, b = i >> 15; float s = 0.f;
            float* dp = DST + (((size_t)b * NCH * 4 + h) * 64 + k) * 128 + v; const float* gp = DECAY + ((size_t)b * NCH * 4 + h) * 64 + k;
            for (int c0 = 0; c0 < NCH; c0 += 8) { float d[8], g[8];
#pragma unroll
                for (int j = 0; j < 8; ++j) { d[j] = dp[(size_t)(c0 + j) * 32768]; g[j] = gp[(size_t)(c0 + j) * 256]; }
#pragma unroll
                for (int j = 0; j < 8; ++j) { s = g[j] * s + d[j]; d[j] = s; }
#pragma unroll
                for (int j = 0; j < 8; ++j) dp[(size_t)(c0 + j) * 32768] = d[j]; } }
        __syncthreads();
        {
            for (int pr = vcu; pr < 256; pr += G) {
                const int bh = pr >> 4, s16 = pr & 15, b = bh >> 3, h = bh & 7;
                att::BlockRef r0, r1;
                const bf16_t* Kh = K + (size_t)b * SEQ * att::KS + h * 96; const bf16_t* Vh = V + (size_t)b * SEQ * att::VS + h * 64;
                const int qb0 = 31 - s16, qb1 = s16;
                r0.Q = Q + ((size_t)b * SEQ + qb0 * 256) * att::QS + h * 96; r0.O = YA + ((size_t)b * SEQ + qb0 * 256) * att::OS + h * 64; r0.K = Kh; r0.V = Vh; r0.P0 = qb0 * 256;
                r1.Q = Q + ((size_t)b * SEQ + qb1 * 256) * att::QS + h * 96; r1.O = YA + ((size_t)b * SEQ + qb1 * 256) * att::OS + h * 64; r1.K = Kh; r1.V = Vh; r1.P0 = qb1 * 256;
                att::Seam S;
                att::attn_prime(r0, (char*)lds, S);
                att::attn_block(r0, r1, (char*)lds, S);
                att::attn_block(r1, r1, (char*)lds, S);
            }
        }
    }
    SEAM(3);
    if (IN(4)) {
        const int r32 = lane & 31, hi5 = lane >> 5;
        unsigned char* stt = lds; float* part = (float*)(lds + 16384);
        const int lt = wave >> 2, vt = wave & 3;
        const int bbase = (int)(uintptr_t)lds + gla::t_rd_base(lane) + vt * 512;
        for (int unit = vcu; unit < 2 * NCH * 4; unit += G) {
            const int h = unit & 3, bc = unit >> 2, t0 = bc * 64;
            {   const int sr = tid >> 4, ch = tid & 15; const float* sp = DST + ((size_t)bc * 4 + h) * 64 * 128;
#pragma unroll
                for (int rr = 0; rr < 2; ++rr) { const int row = sr + 32 * rr; const f32x4 a = *(const f32x4*)(sp + row * 128 + ch * 8), b = *(const f32x4*)(sp + row * 128 + ch * 8 + 4);
                    u32x4 w; w.x = pk2(a[0], a[1]); w.y = pk2(a[2], a[3]); w.z = pk2(b[0], b[1]); w.w = pk2(b[2], b[3]);
                    *(u32x4*)(stt + gla::t_st<4>(row, ch * 8)) = w; } }
            gla::bf16x8 qa[4];
            { const bf16_t* qrow = PROJB + (size_t)(t0 + lt * 32 + r32) * PB_LD + PB_GQ + h * 64 + hi5 * 8;
#pragma unroll
              for (int ks = 0; ks < 4; ++ks) qa[ks] = *(const gla::bf16x8*)(qrow + ks * 16); }
            __syncthreads();
            gla::f32x16 acc = {};
            { gla::s16x4 bl[4], bh[4];
#define GLA_KS(ks) do { GLA_TRRD(bl[ks], bbase, gla::t_rd_off<4>(0, ks, 0)); GLA_TRRD(bh[ks], bbase, gla::t_rd_off<4>(0, ks, 1)); } while (0)
              GLA_KS(0); GLA_KS(1); GLA_KS(2); GLA_KS(3);
#undef GLA_KS
              asm volatile("s_waitcnt lgkmcnt(0)" ::: "memory"); __builtin_amdgcn_sched_barrier(0);
#pragma unroll
              for (int ks = 0; ks < 4; ++ks) acc = __builtin_amdgcn_mfma_f32_32x32x16_bf16(qa[ks], (gla::bf16x8){bl[ks][0], bl[ks][1], bl[ks][2], bl[ks][3], bh[ks][0], bh[ks][1], bh[ks][2], bh[ks][3]}, acc, 0, 0, 0); }
            float rs[16];
#pragma unroll
            for (int r = 0; r < 16; ++r) { acc[r] *= 0.125f; float s2 = acc[r] * acc[r];
                s2 += __builtin_bit_cast(float, __builtin_amdgcn_update_dpp(0, __builtin_bit_cast(int, s2), 0x128, 0xf, 0xf, false));
                s2 += __builtin_bit_cast(float, __builtin_amdgcn_update_dpp(0, __builtin_bit_cast(int, s2), 0x124, 0xf, 0xf, false));
                s2 += __builtin_bit_cast(float, __builtin_amdgcn_update_dpp(0, __builtin_bit_cast(int, s2), 0x122, 0xf, 0xf, false));
                s2 += __builtin_bit_cast(float, __builtin_amdgcn_update_dpp(0, __builtin_bit_cast(int, s2), 0x121, 0xf, 0xf, false));
                s2 += __shfl_xor(s2, 16); rs[r] = s2; }
            if (r32 == 0) {
#pragma unroll
                for (int r = 0; r < 16; ++r) part[(lt * 32 + gla::crow(r, hi5)) * 4 + vt] = rs[r]; }
            __syncthreads();
#pragma unroll
            for (int r = 0; r < 16; ++r) { const int l = lt * 32 + gla::crow(r, hi5); const f32x4 pp = *(const f32x4*)(part + l * 4);
                const float rn = rsqrtf(((pp[0] + pp[1]) + (pp[2] + pp[3])) * (1.f / 128.f) + EPS);
                const int v = vt * 32 + r32; const float go = bf2f(PROJB[(size_t)(t0 + l) * PB_LD + PB_GOUT + h * 128 + v]);
                const float silu = go * __builtin_amdgcn_rcpf(1.f + __expf(-go));
                YB[(size_t)(t0 + l) * 512 + h * 128 + v] = f2bf(acc[r] * rn * g_gla[h * 128 + v] * silu); }
            __syncthreads();
        }
    }
    if (IN(4)) {
        for (int row = gw * 2; row < 16384; row += NGW * 2) quant_rows2<0>(peer_u, g_ffn, UT, SU, row, lane);
    }
    SEAM(4);
    if (IN(5)) {
        for (int row = gw * 2; row < 16384; row += NGW * 2) quant_rows2<0>(peer_v, nullptr, VT, SV, row, lane);
        __syncthreads();
        pg8::Gemm g{YA, WA, YB, WB, 512, 512, M_, 1024, 512, 2}; pg8::StaticOrder S; S.init(g, G, (int)blockIdx.x);
        pg8::EpiMerge E{PROJB, MERGED}; pg8::gemm_phase<pg8::EpiMerge, pg8::StaticOrder, true>(ring, g, S, E);
    }
    SEAM(5);
    if (IN(6)) {
        pg8::Gemm g{MERGED, WOUT, nullptr, nullptr, DM, DM, M_, 1024, DM, 1}; pg8::StaticOrder S; S.init(g, G, (int)blockIdx.x);
        pg8::EpiX1 E{x, out, X1B, SSX1}; pg8::gemm_phase<pg8::EpiX1, pg8::StaticOrder, false>(ring, g, S, E);
    }
    SEAM(6);
    if (IN(7)) {
        pg8::Gemm g{X1B, WPQ, nullptr, nullptr, DM, DM, M_, 2048, DM, 1}; pg8::StaticOrder S; S.init(g, G, (int)blockIdx.x);
        pg8::EpiQP E{QP, SSX1}; pg8::gemm_phase<pg8::EpiQP, pg8::StaticOrder, true>(ring, g, S, E);
    }
    SEAM(7);
    if (IN(8)) {
        typedef short bf16x8_t __attribute__((ext_vector_type(8)));
        typedef float f32x16_t __attribute__((ext_vector_type(16)));
        const int r32 = lane & 31, hi = lane >> 5;
#define P8_SORTABLE(f) ({ const unsigned b_ = __float_as_uint(f); b_ ^ ((unsigned)((int)b_ >> 31) | 0x80000000u); })
#define P8_UNSORT(u) ({ const unsigned u_ = (u); __uint_as_float(u_ ^ (~(unsigned)((int)u_ >> 31) | 0x80000000u)); })
#define P8_INSERT(t, v) do { unsigned v_ = (v); _Pragma("unroll") for (int q_ = 0; q_ < 16; ++q_) { const unsigned a_ = t[q_] > v_ ? t[q_] : v_; v_ = t[q_] > v_ ? v_ : t[q_]; t[q_] = a_; } } while (0)
        for (int item = vcu; item < 256; item += G) {
            const int h = item & 7, tr = item >> 3;
            for (int c = tid; c < 2 * 128 * 16; c += 512) { const int p = c >> 11, row = (c >> 4) & 127, ch = c & 15;
                const u32x4 v = *(const u32x4*)(KEYS + ((size_t)(h * 2 + p) * 128 + row) * 128 + ch * 8);
                *(u32x4*)(lds + p * 32768 + row * 256 + ((ch * 16) ^ ((row & 7) << 4))) = v; }
            __syncthreads();
#pragma unroll 1
            for (int step = 0; step < 2; ++step) {
                const int m = tr * 512 + wave * 64 + step * 32 + r32;
                unsigned top[2][16];
#pragma unroll
                for (int p = 0; p < 2; ++p) {
                    bf16x8_t qf[8];
#pragma unroll
                    for (int ks = 0; ks < 8; ++ks) qf[ks] = *(const bf16x8_t*)(QP + (size_t)m * 2048 + (h * 2 + p) * 128 + ks * 16 + hi * 8);
                    f32x16_t acc[4];
#pragma unroll
                    for (int kt = 0; kt < 4; ++kt) { acc[kt] = f32x16_t{};
                        const int row = kt * 32 + r32; const unsigned char* rb = lds + p * 32768 + row * 256;
#pragma unroll
                        for (int ks = 0; ks < 8; ++ks) { const bf16x8_t a = *(const bf16x8_t*)(rb + (((2 * ks + hi) * 16) ^ ((row & 7) << 4)));
                            acc[kt] = __builtin_amdgcn_mfma_f32_32x32x16_bf16(a, qf[ks], acc[kt], 0, 0, 0); } }
                    unsigned t[16];
#pragma unroll
                    for (int i = 0; i < 16; ++i) t[i] = 0u;
#pragma unroll
                    for (int kt = 0; kt < 4; ++kt)
#pragma unroll
                        for (int r = 0; r < 16; ++r) { const unsigned base = 32 * kt + (r & 3) + 8 * (r >> 2);
                            const unsigned pk = (P8_SORTABLE(acc[kt][r]) | 127u) ^ base; P8_INSERT(t, pk); }
#pragma unroll
                    for (int i = 0; i < 16; ++i) t[i] ^= (unsigned)(hi << 2);
                    unsigned mm[16];
#pragma unroll
                    for (int i = 0; i < 16; ++i) { auto rr = __builtin_amdgcn_permlane32_swap(t[15 - i], t[15 - i], false, false); const unsigned pt = hi ? rr[0] : rr[1]; mm[i] = t[i] > pt ? t[i] : pt; }
#pragma unroll
                    for (int sft = 8; sft >= 1; sft >>= 1)
#pragma unroll
                        for (int i = 0; i < 16; ++i) if ((i & sft) == 0) { const unsigned a_ = mm[i] > mm[i + sft] ? mm[i] : mm[i + sft], b_ = mm[i] > mm[i + sft] ? mm[i + sft] : mm[i]; mm[i] = a_; mm[i + sft] = b_; }
#pragma unroll
                    for (int i = 0; i < 16; ++i) top[p][i] = mm[i];
                }
                float f0[16], f1[16];
#pragma unroll
                for (int i = 0; i < 16; ++i) { f0[i] = P8_UNSORT(top[0][i] & 0xFFFFFF80u); f1[i] = P8_UNSORT(top[1][i] & 0xFFFFFF80u); }
                unsigned cb[16];
#pragma unroll
                for (int i = 0; i < 16; ++i) cb[i] = 0u;
#define P8_CAND(a, b) do { const float sv_ = f0[a] + f1[b]; const unsigned pk_ = (P8_SORTABLE(sv_) | 255u) ^ (unsigned)((a) * 16 + (b)); P8_INSERT(cb, pk_); } while (0)
#pragma unroll
                for (int b = 0; b < 16; ++b) P8_CAND(0, b);
#pragma unroll
                for (int b = 0; b < 8; ++b) P8_CAND(1, b);
#pragma unroll
                for (int b = 0; b < 5; ++b) P8_CAND(2, b);
#pragma unroll
                for (int b = 0; b < 4; ++b) P8_CAND(3, b);
#pragma unroll
                for (int b = 0; b < 3; ++b) P8_CAND(4, b);
#pragma unroll
                for (int b = 0; b < 2; ++b) { P8_CAND(5, b); P8_CAND(6, b); P8_CAND(7, b); }
                P8_CAND(8, 0); P8_CAND(9, 0); P8_CAND(10, 0); P8_CAND(11, 0); P8_CAND(12, 0); P8_CAND(13, 0); P8_CAND(14, 0); P8_CAND(15, 0);
#undef P8_CAND
                unsigned char* slot = lds + 65536 + wave * 2048 + lane * 32;
                { u32x4 w0, w1;
#define P8_IDX4(T, i) ((127u - (T[i] & 127u)) | ((127u - (T[(i) + 1] & 127u)) << 8) | ((127u - (T[(i) + 2] & 127u)) << 16) | ((127u - (T[(i) + 3] & 127u)) << 24))
                  w0.x = P8_IDX4(top[0], 0); w0.y = P8_IDX4(top[0], 4); w0.z = P8_IDX4(top[0], 8); w0.w = P8_IDX4(top[0], 12);
                  w1.x = P8_IDX4(top[1], 0); w1.y = P8_IDX4(top[1], 4); w1.z = P8_IDX4(top[1], 8); w1.w = P8_IDX4(top[1], 12);
#undef P8_IDX4
                  *(u32x4*)slot = w0; *(u32x4*)(slot + 16) = w1; }
                asm volatile("s_waitcnt lgkmcnt(0)" ::: "memory");
                float bv[16]; int be[16];
#pragma unroll
                for (int k = 0; k < 16; ++k) { const unsigned pos = (~cb[k]) & 255u; bv[k] = P8_UNSORT(cb[k] & 0xFFFFFF00u);
                    be[k] = (int)slot[pos >> 4] * 128 + (int)slot[16 + (pos & 15)]; }
                { const float b0 = bv[0];
#pragma unroll
                  for (int k = 0; k < 16; ++k) bv[k] = __expf(bv[k] - b0); }
                asm volatile("s_waitcnt lgkmcnt(0)" ::: "memory");
                if (hi == 0) { int* ep = EIDX + (size_t)m * 128 + 2 * h;
#pragma unroll
                    for (int kk = 0; kk < 8; ++kk) { u32x2 w; w.x = (unsigned)be[kk]; w.y = (unsigned)be[kk + 8]; *(u32x2*)(ep + kk * 16) = w; } }
                else { float* gp = EGATE + (size_t)m * 128 + 2 * h; float s2 = 0.f;
#pragma unroll
                    for (int k = 0; k < 16; ++k) s2 += bv[k];
                    const float inv = 1.f / s2;
#pragma unroll
                    for (int kk = 0; kk < 8; ++kk) { u32x2 w; w.x = __float_as_uint(bv[kk] * inv); w.y = __float_as_uint(bv[kk + 8] * inv); *(u32x2*)(gp + kk * 16) = w; } }
            }
            __syncthreads();
        }
#undef P8_SORTABLE
#undef P8_UNSORT
#undef P8_INSERT
    }
    SEAM(8);
#define UB(w, e) ((float)(((w) >> (8 * (e))) & 0xffu))
#define DPP_ADD(v, ctrl) v += __builtin_bit_cast(float, __builtin_amdgcn_update_dpp(0, __builtin_bit_cast(int, v), (ctrl), 0xf, 0xf, false))
    volatile unsigned* MISCW = (volatile unsigned*)(lds + MISC_OFF);
    const int x_nloc = (MK_N_LAUNCHES == 1) ? (int)MISCW[8] : G, x_nx = (MK_N_LAUNCHES == 1) ? (int)MISCW[9] : 1, x_rank = (MK_N_LAUNCHES == 1) ? (int)MISCW[10] : (int)blockIdx.x, x_ord = (MK_N_LAUNCHES == 1) ? (int)MISCW[11] : 0;
    if (IN(9)) {
        const int g = lane >> 3, c = lane & 7;
        const int tstep = x_nloc * NWAVES;
        for (int sl = x_ord; sl < 8; sl += x_nx) {
            const unsigned char* ub = UT + (size_t)sl * (16384 * 128) + 16 * c;
            const bf16_t* xbase = X1B + sl * 128 + 16 * c;
#define P9_IDX(I4, XA, XB, tt) do { const int t_ = (tt) < M_ ? (tt) : M_ - 1; const u32x4* ep_ = (const u32x4*)(EIDX + (size_t)t_ * 128 + g * 16); \
            I4[0] = ep_[0]; I4[1] = ep_[1]; I4[2] = ep_[2]; I4[3] = ep_[3]; XA = *(const u32x4*)(xbase + (size_t)t_ * DM); XB = *(const u32x4*)(xbase + (size_t)t_ * DM + 8); } while (0)
#define P9_ROWS(U, I4, hf) do { _Pragma("unroll") for (int i = 0; i < 8; ++i) U[i] = *(const u32x4*)(ub + (size_t)I4[2 * (hf) + (i >> 2)][i & 3] * 128); } while (0)
#define P9_HALF(U, hf) do { _Pragma("unroll") for (int i = 0; i < 8; ++i) { int a = __builtin_amdgcn_sdot4((int)xq[0], (int)U[i][0], 0, false); a = __builtin_amdgcn_sdot4((int)xq[1], (int)U[i][1], a, false); \
                a = __builtin_amdgcn_sdot4((int)xq[2], (int)U[i][2], a, false); a = __builtin_amdgcn_sdot4((int)xq[3], (int)U[i][3], a, false); \
                a += __builtin_amdgcn_update_dpp(0, a, 0xB1, 0xf, 0xf, false); a += __builtin_amdgcn_update_dpp(0, a, 0x4E, 0xf, 0xf, false); a += __builtin_amdgcn_update_dpp(0, a, 0x141, 0xf, 0xf, false); \
                z0 = (8 * (hf) + i == 2 * c) ? a : z0; z1 = (8 * (hf) + i == 2 * c + 1) ? a : z1; } } while (0)
            u32x4 iC[4], iN[4], iNN[4], xaC, xbC, xaN, xbN, xaNN, xbNN, uA[8], uB[8];
            int t = x_rank * NWAVES + wave;
            P9_IDX(iC, xaC, xbC, t); P9_IDX(iN, xaN, xbN, t + tstep); P9_ROWS(uA, iC, 0);
            for (; t < M_; t += tstep) {
                P9_ROWS(uB, iC, 1); P9_IDX(iNN, xaNN, xbNN, t + 2 * tstep);
                float xf[16];
#pragma unroll
                for (int q = 0; q < 4; ++q) { xf[2 * q] = __uint_as_float(xaC[q] << 16); xf[2 * q + 1] = __uint_as_float(xaC[q] & 0xffff0000u); xf[8 + 2 * q] = __uint_as_float(xbC[q] << 16); xf[8 + 2 * q + 1] = __uint_as_float(xbC[q] & 0xffff0000u); }
                float mx = 1e-30f;
#pragma unroll
                for (int j = 0; j < 16; ++j) mx = fmaxf(mx, fabsf(xf[j]));
                mx = fmaxf(mx, __builtin_bit_cast(float, __builtin_amdgcn_update_dpp(0, __builtin_bit_cast(int, mx), 0xB1, 0xf, 0xf, false)));
                mx = fmaxf(mx, __builtin_bit_cast(float, __builtin_amdgcn_update_dpp(0, __builtin_bit_cast(int, mx), 0x4E, 0xf, 0xf, false)));
                mx = fmaxf(mx, __builtin_bit_cast(float, __builtin_amdgcn_update_dpp(0, __builtin_bit_cast(int, mx), 0x141, 0xf, 0xf, false)));
                const float xinv = 127.f * __builtin_amdgcn_rcpf(mx), xsc = mx * (1.f / 127.f);
                unsigned xq[4];
#pragma unroll
                for (int q = 0; q < 4; ++q) { unsigned b = 0;
#pragma unroll
                    for (int e = 0; e < 4; ++e) { const int qi = (int)rintf(xf[4 * q + e] * xinv); b |= ((unsigned)qi & 0xffu) << (8 * e); }
                    xq[q] = b; }
                int z0 = 0, z1 = 0;
                P9_HALF(uA, 0);
                P9_ROWS(uA, iN, 0);
                P9_HALF(uB, 1);
                { u32x2 w; w.x = __float_as_uint((float)z0 * xsc); w.y = __float_as_uint((float)z1 * xsc); *(u32x2*)(ZP + ((size_t)sl * M_ + t) * 128 + g * 16 + 2 * c) = w; }
#pragma unroll
                for (int q = 0; q < 4; ++q) { iC[q] = iN[q]; iN[q] = iNN[q]; }
                xaC = xaN; xbC = xbN; xaN = xaNN; xbN = xbNN;
            }
#undef P9_HALF
#undef P9_IDX
#undef P9_ROWS
        }
    }
    SEAM(9);
    if (IN(10)) {
        for (int t = gw; t < M_; t += NGW) { const float r = rsqrtf(SSX1[t] * (1.f / DM) + EPS); float av[2]; float mx = 1e-30f;
#pragma unroll
            for (int v = 0; v < 2; ++v) { const int p = lane + 64 * v; const int e = EIDX[(size_t)t * 128 + p]; float zs[8];
#pragma unroll
                for (int j = 0; j < 8; ++j) zs[j] = ZP[((size_t)j * M_ + t) * 128 + p];
                float z = ((zs[0] + zs[1]) + (zs[2] + zs[3])) + ((zs[4] + zs[5]) + (zs[6] + zs[7]));
                z *= SU[e] * r;
                av[v] = 0.5f * z * (1.f + erff(z * 0.70710678118654752f)) * EGATE[(size_t)t * 128 + p] * SV[e];
                mx = fmaxf(mx, fabsf(av[v])); }
#pragma unroll
            for (int o = 1; o < 64; o <<= 1) mx = fmaxf(mx, __shfl_xor(mx, o));
            const float inv = 127.f / mx;
            CQ[(size_t)t * 128 + lane] = (signed char)(int)rintf(av[0] * inv); CQ[(size_t)t * 128 + 64 + lane] = (signed char)(int)rintf(av[1] * inv);
            if (lane == 0) CS[t] = mx * (1.f / 127.f); }
    }
    SEAM(10);
    if (IN(11)) {
        const int g = lane >> 3, c = lane & 7;
        const int tstep = x_nloc * NWAVES;
        for (int sl = x_ord; sl < 8; sl += x_nx) {
            const unsigned char* vb = VT + (size_t)sl * (16384 * 128) + 16 * c;
#define P11_IDX(I4, C4, tt) do { const int t_ = (tt) < M_ ? (tt) : M_ - 1; const u32x4* ep_ = (const u32x4*)(EIDX + (size_t)t_ * 128 + g * 16); \
            I4[0] = ep_[0]; I4[1] = ep_[1]; I4[2] = ep_[2]; I4[3] = ep_[3]; C4 = *(const u32x4*)(CQ + (size_t)t_ * 128 + g * 16); } while (0)
#define P11_ROWS(U, I4, hf) do { _Pragma("unroll") for (int i = 0; i < 8; ++i) U[i] = *(const u32x4*)(vb + (size_t)I4[2 * (hf) + (i >> 2)][i & 3] * 128); } while (0)
#define P11_BLK(U, b0, q, CW) do { const unsigned d0_ = U[b0][q], d1_ = U[(b0) + 1][q], d2_ = U[(b0) + 2][q], d3_ = U[(b0) + 3][q]; \
            const unsigned t0_ = __builtin_amdgcn_perm(d1_, d0_, 0x05010400u), t1_ = __builtin_amdgcn_perm(d1_, d0_, 0x07030602u), t2_ = __builtin_amdgcn_perm(d3_, d2_, 0x05010400u), t3_ = __builtin_amdgcn_perm(d3_, d2_, 0x07030602u); \
            acc[4 * (q)] = __builtin_amdgcn_sdot4((int)__builtin_amdgcn_perm(t2_, t0_, 0x05040100u), (int)(CW), acc[4 * (q)], false); \
            acc[4 * (q) + 1] = __builtin_amdgcn_sdot4((int)__builtin_amdgcn_perm(t2_, t0_, 0x07060302u), (int)(CW), acc[4 * (q) + 1], false); \
            acc[4 * (q) + 2] = __builtin_amdgcn_sdot4((int)__builtin_amdgcn_perm(t3_, t1_, 0x05040100u), (int)(CW), acc[4 * (q) + 2], false); \
            acc[4 * (q) + 3] = __builtin_amdgcn_sdot4((int)__builtin_amdgcn_perm(t3_, t1_, 0x07060302u), (int)(CW), acc[4 * (q) + 3], false); } while (0)
#define P11_HALF(U, C4, hf) do { _Pragma("unroll") for (int bb = 0; bb < 2; ++bb) { const unsigned cw_ = C4[2 * (hf) + bb]; \
            _Pragma("unroll") for (int q = 0; q < 4; ++q) P11_BLK(U, 4 * bb, q, cw_); } } while (0)
            u32x4 iC[4], iN[4], iNN[4], uA[8], uB[8], cC, cN, cNN;
            const int hi5 = lane >> 5, b3 = (lane >> 3) & 1;
            int t = x_rank * NWAVES + wave;
            P11_IDX(iC, cC, t); P11_IDX(iN, cN, t + tstep); P11_ROWS(uA, iC, 0);
            for (; t < M_; t += tstep) {
                float* op = out + (size_t)t * DM + sl * 128 + 16 * c + 4 * b3 + 8 * hi5;
                const f32x4 x1v = *(const f32x4*)op; const float cs = CS[t];
                P11_ROWS(uB, iC, 1); P11_IDX(iNN, cNN, t + 2 * tstep);
                int acc[16];
#pragma unroll
                for (int j = 0; j < 16; ++j) acc[j] = 0;
                P11_HALF(uA, cC, 0);
                P11_ROWS(uA, iN, 0);
                P11_HALF(uB, cC, 1);
                int w8[8];
#pragma unroll
                for (int j = 0; j < 8; ++j) { auto rr = __builtin_amdgcn_permlane32_swap((unsigned)acc[j], (unsigned)acc[j + 8], false, false); w8[j] = (int)rr[0] + (int)rr[1]; }
#pragma unroll
                for (int j = 0; j < 8; ++j) w8[j] += __shfl_xor(w8[j], 16);
                f32x4 o; float ss = 0.f;
#pragma unroll
                for (int j = 0; j < 4; ++j) { const int keep = b3 ? w8[j + 4] : w8[j]; const int give = b3 ? w8[j] : w8[j + 4];
                    const int tot = keep + __builtin_amdgcn_update_dpp(0, give, 0x128, 0xf, 0xf, false);
                    o[j] = x1v[j] + (float)tot * cs; ss += o[j] * o[j]; }
                if (((lane >> 4) & 1) == 0) *(f32x4*)op = o;
                DPP_ADD(ss, 0x128); DPP_ADD(ss, 0x124); DPP_ADD(ss, 0x122); DPP_ADD(ss, 0x121);
                { const float s0 = __builtin_bit_cast(float, __builtin_amdgcn_readlane(__builtin_bit_cast(int, ss), 0)), s1 = __builtin_bit_cast(float, __builtin_amdgcn_readlane(__builtin_bit_cast(int, ss), 32));
                  if (lane == 0) atomicAdd(SS2 + t, s0 + s1); }
#pragma unroll
                for (int q = 0; q < 4; ++q) { iC[q] = iN[q]; iN[q] = iNN[q]; }
                cC = cN; cN = cNN;
            }
#undef P11_BLK
#undef P11_HALF
#undef P11_IDX
#undef P11_ROWS
        }
    }
    SEAM(11);
    if (IN(12)) {
        for (int m = gw; m < M_; m += NGW) { const float r2 = rsqrtf(SS2[m] * (1.f / DM) + EPS); float* orow = out + (size_t)m * DM;
#pragma unroll
            for (int j = 0; j < 4; ++j) { const int cix = 4 * (lane + 64 * j); const f32x4 gg = *(const f32x4*)(g_final + cix); f32x4 o = *(const f32x4*)(orow + cix);
                o[0] *= r2 * gg[0]; o[1] *= r2 * gg[1]; o[2] *= r2 * gg[2]; o[3] *= r2 * gg[3]; *(f32x4*)(orow + cix) = o; } }
    }
#undef UB
#undef DPP_ADD
#undef IN
#undef SEAM
}

extern "C" void kernel_launch(void* const* d_in, const int* in_sizes, int n_in, void* d_out, int out_size, void* d_ws, size_t ws_size, hipStream_t stream) {
    static int grid = 0;
    if (grid == 0) {
        if (n_in != 20 || out_size != M_ * DM || ws_size < WS_END) { fprintf(stderr, "kernel_launch: unexpected shapes (n_in %d out %d ws %zu); nothing launched\n", n_in, out_size, ws_size); grid = -1; return; }
        int dev = 0, cus = 0;
        if (hipGetDevice(&dev) != hipSuccess || hipDeviceGetAttribute(&cus, hipDeviceAttributeMultiprocessorCount, dev) != hipSuccess) { grid = -1; return; }
        if (hipFuncSetAttribute((const void*)fwd, hipFuncAttributeMaxDynamicSharedMemorySize, LDS_BYTES) != hipSuccess) { fprintf(stderr, "kernel_launch: hipFuncSetAttribute failed\n"); grid = -1; return; }
        int per_cu = 0;
        if (hipOccupancyMaxActiveBlocksPerMultiprocessor(&per_cu, (const void*)fwd, NWAVES * 64, LDS_BYTES) != hipSuccess || per_cu < 1) fprintf(stderr, "kernel_launch: occupancy query reports %d\n", per_cu);
        (void)hipGetLastError();
        grid = cus;
    }
    if (grid < 0) return;
    (void)hipMemsetAsync((char*)d_ws + WS_CTL, 0, CTL_ZERO_BYTES, stream);
    Args a; memset(&a, 0, sizeof(a));
    for (int i = 0; i < 20; ++i) a.in[i] = d_in[i];
    a.out = (float*)d_out; a.ws = (unsigned char*)d_ws;
    if (MK_N_LAUNCHES == 1) { a.ph_lo = 0; a.ph_hi = N_PHASES; hipLaunchKernelGGL(fwd, dim3(grid), dim3(NWAVES * 64), LDS_BYTES, stream, a); }
    else for (int p = 0; p < N_PHASES; ++p) { a.ph_lo = p; a.ph_hi = p + 1; hipLaunchKernelGGL(fwd, dim3(grid), dim3(NWAVES * 64), LDS_BYTES, stream, a); }
}
```

```cpp
#include <hip/hip_runtime.h>
#include <cstdio>
#include <cstdint>
#include <cstring>
#include <math.h>

#ifndef MK_N_LAUNCHES
#define MK_N_LAUNCHES 1
#endif
constexpr int N_PHASES = 13;

typedef unsigned short bf16_t;
constexpr int SEQ = 8192, DM = 1024, M_ = 16384, NCH = 128;
constexpr float EPS = 1e-6f;
constexpr int PB_LD = 2816, PA_LD = 1536;
constexpr int PB_BR = 0, PB_GOUT = 2048, PB_GQ = 2560;
constexpr int PA_GV = 0, PA_GK = 512, PA_QLAT = 768, PA_KVLAT = 1152, PA_KROPE = 1408, PA_GLR = 1440;
constexpr int NPROJ = 4352;
constexpr float CQ = 0.10206207261596577f * 1.4426950408889634f;

constexpr size_t MiB = 1u << 20;
constexpr size_t WS_CTL = 0, CTL_ZERO_BYTES = 256 * 1024;
constexpr size_t WS_SSQ = 1 * MiB, WS_SSKV = WS_SSQ + 65536, WS_SSX1 = WS_SSKV + 65536, WS_SS2 = WS_SSX1 + 65536, WS_C128 = WS_SS2 + 65536  , WS_CB = 136 * MiB  , WS_ZP = 56 * MiB  , WS_COS = 2 * MiB, WS_SIN = 3 * MiB;
constexpr size_t WS_DECAY = 1 * MiB + 512 * 1024;
constexpr size_t WS_WIN = 4 * MiB, WS_WQB = 13 * MiB, WS_WKVB = 14 * MiB, WS_WA = 15 * MiB, WS_WB = 16 * MiB, WS_WOUT = 17 * MiB, WS_WPQ = 19 * MiB, WS_KEYS = 23 * MiB;
constexpr size_t WS_PROJB = 24 * MiB, WS_PROJA = 112 * MiB, WS_XN = 160 * MiB, WS_Q = 160 * MiB, WS_K = 184 * MiB, WS_V = 208 * MiB, WS_DST = 224 * MiB;
constexpr size_t WS_YA = 112 * MiB, WS_YB = 128 * MiB, WS_MERGED = 160 * MiB, WS_X1B = 24 * MiB, WS_QP = 56 * MiB, WS_EIDX = 120 * MiB, WS_EGATE = 128 * MiB;
constexpr size_t WS_KPE = 208 * MiB  , WS_UT = 224 * MiB, WS_VT = 240 * MiB, WS_SU = 1 * MiB + 768 * 1024, WS_SV = WS_SU + 65536;
constexpr size_t WS_END = 256 * MiB;

#define GAS __attribute__((address_space(1)))
#define LAS __attribute__((address_space(3)))
typedef float f32x4 __attribute__((ext_vector_type(4)));
typedef unsigned u32x4 __attribute__((ext_vector_type(4)));
typedef unsigned u32x2 __attribute__((ext_vector_type(2)));

__device__ __forceinline__ float bf2f(bf16_t h) { return __uint_as_float(((unsigned)h) << 16); }
__device__ __forceinline__ unsigned f2bf_u(float f) { unsigned u = __float_as_uint(f); return (u + 0x7fffu + ((u >> 16) & 1u)) >> 16; }
__device__ __forceinline__ bf16_t f2bf(float f) { return (bf16_t)f2bf_u(f); }
__device__ __forceinline__ unsigned pk2(float lo, float hi) { return f2bf_u(lo) | (f2bf_u(hi) << 16); }
__device__ __forceinline__ float wave_sum(float v) {
#pragma unroll
    for (int o = 1; o < 64; o <<= 1) v += __shfl_xor(v, o);
    return v;
}
__device__ __forceinline__ float sigmoidf_(float x) { return 1.f / (1.f + __expf(-x)); }

namespace pg8 {
#define PG8_LAS __attribute__((address_space(3)))
typedef short bf16x8 __attribute__((ext_vector_type(8)));
constexpr int BM = 256, BK = 64, HALF = 128, HTB = HALF * BK * 2, STAGE_BYTES = 8 * HTB, NXCD = 8, WGM = 8;
__host__ __device__ __forceinline__ int lds_byte(int r, int c) { const int st = (r >> 4) * 2 + (c >> 5), rr = r & 15, cc = c & 31, ob = rr * 64 + cc * 2; return st * 1024 + (ob ^ (((ob >> 9) & 1) << 5)); }
__host__ __device__ __forceinline__ void stage_rc(int b, int& R, int& C) { const int st = b / 1024, sb = b % 1024, swz = sb ^ (((sb >> 9) & 1) << 5); R = (st >> 1) * 16 + swz / 64; C = (st & 1) * 32 + (swz % 64) / 2; }
__host__ __device__ __forceinline__ int perm32(int rho) { const int n = rho >> 4, i = rho & 15; return 8 * (i >> 2) + 4 * n + (i & 3); }

struct Unit { int pm, pn, sub; const char* A; const char* B; };
struct Gemm { const bf16_t* A; const bf16_t* Bt; const bf16_t* A2; const bf16_t* Bt2; int lda, ldb, M, N, K, chain; };
struct StaticOrder {
    int nM, nN, nwg, G, c, chain; const char *A, *B, *A2, *B2; size_t tsA, tsB;
    __device__ __forceinline__ void init(const Gemm& g, int G_, int c_) { nM = g.M / BM; nN = g.N / BM; nwg = nM * nN; G = G_; c = c_; chain = g.chain; A = (const char*)g.A; B = (const char*)g.Bt; A2 = (const char*)g.A2; B2 = (const char*)g.Bt2;
        tsA = (size_t)BM * g.lda * 2; tsB = (size_t)BM * g.ldb * 2; }
    __device__ __forceinline__ bool next(int i, Unit& u) const {
        const int r = (chain == 2) ? (i >> 1) : i, sub = (chain == 2) ? (i & 1) : 0;
        const long L = (long)r * G + c; if (L >= nwg) return false;
        int wgid = (int)L; { const int q = nwg / NXCD, rr = nwg % NXCD, xcd = wgid % NXCD, off = wgid / NXCD; wgid = (xcd < rr ? xcd * (q + 1) : rr * (q + 1) + (xcd - rr) * q) + off; }
        const int nig = WGM * nN, gid = wgid / nig, fm = gid * WGM, gsz = (nM - fm) < WGM ? (nM - fm) : WGM;
        u.pm = fm + ((wgid % nig) % gsz); u.pn = (wgid % nig) / gsz; u.sub = sub;
        u.A = (sub ? A2 : A) + (size_t)u.pm * tsA; u.B = (sub ? B2 : B) + (size_t)u.pn * tsB; return true;
    }
};
__device__ __forceinline__ unsigned cvt_pk_bf16(float lo, float hi) { unsigned r; asm volatile("v_cvt_pk_bf16_f32 %0, %1, %2" : "=v"(r) : "v"(lo), "v"(hi)); return r; }

typedef f32x4 AccT[2][2][4][2];
template <class Epi, class Sched, bool ALIGN_EPI>
__device__ __forceinline__ void gemm_phase(PG8_LAS unsigned char* lds, const Gemm g, const Sched& S, const Epi& E) {
    const int tid = threadIdx.x, wid = __builtin_amdgcn_readfirstlane(tid >> 6), lane = tid & 63, wr = wid >> 2, wc = wid & 3, fr = lane & 15, fq = lane >> 4;
    const int K = g.K, nt = K / BK;
    unsigned voffA[2], voffB[2];
#pragma unroll
    for (int i = 0; i < 2; ++i) { int R, C; stage_rc(tid * 16 + i * 8192, R, C); const int Rb = Epi::PERM ? ((R & ~31) + perm32(R & 31)) : R;
        voffA[i] = (unsigned)(R * g.lda + C) * 2u; voffB[i] = (unsigned)(Rb * g.ldb + C) * 2u; }
    const size_t kstep = (size_t)(BK * 2);
    const size_t hsA = (size_t)HALF * g.lda * 2, hsB = (size_t)HALF * g.ldb * 2;
    const unsigned ldsw = (unsigned)wid * 1024u;
    const int aoff = lds_byte(wr * 64 + fr, fq * 8), boff = lds_byte(wc * 32 + fr, fq * 8);
#define PG8_SA(b, h) (((b) * 2 + (h)) * HTB)
#define PG8_SB(b, h) ((4 + (b) * 2 + (h)) * HTB)
#define PG8_STAGE(bufoff, gbase, voff) do { _Pragma("unroll") for (int _i = 0; _i < 2; ++_i) \
        __builtin_amdgcn_global_load_lds((const unsigned*)((const char*)(gbase) + (voff)[_i]), (PG8_LAS unsigned*)(lds + (bufoff) + ldsw + _i * 8192), 16, 0, 0); } while (0)
#define PG8_LDA(dst, b, h) do { _Pragma("unroll") for (int m = 0; m < 4; ++m) _Pragma("unroll") for (int k = 0; k < 2; ++k) dst[m][k] = *(const PG8_LAS bf16x8*)(lds + PG8_SA(b, h) + aoff + m * 2048 + k * 1024); } while (0)
#define PG8_LDB(dst, b, h) do { _Pragma("unroll") for (int n = 0; n < 2; ++n) _Pragma("unroll") for (int k = 0; k < 2; ++k) dst[n][k] = *(const PG8_LAS bf16x8*)(lds + PG8_SB(b, h) + boff + n * 2048 + k * 1024); } while (0)
#define PG8_MMA(ai, bj, At, Bt) do { __builtin_amdgcn_s_setprio(1); _Pragma("unroll") for (int m = 0; m < 4; ++m) _Pragma("unroll") for (int n = 0; n < 2; ++n) _Pragma("unroll") for (int k = 0; k < 2; ++k) \
        acc[ai][bj][m][n] = __builtin_amdgcn_mfma_f32_16x16x32_bf16(Bt[n][k], At[m][k], acc[ai][bj][m][n], 0, 0, 0); __builtin_amdgcn_s_setprio(0); } while (0)
#define PG8_WAIT_V(n) asm volatile("s_waitcnt vmcnt(" #n ")" ::: "memory")
#define PG8_WAIT_L(n) asm volatile("s_waitcnt lgkmcnt(" #n ")" ::: "memory")
#define PG8_BAR __builtin_amdgcn_s_barrier()
#define PG8_SCHED __builtin_amdgcn_sched_barrier(0)
    Unit cur, nxt; int ui = 0;
    if (!S.next(0, cur)) return;
    f32x4 acc[2][2][4][2];
#pragma unroll
    for (int a = 0; a < 2; ++a)
#pragma unroll
        for (int b = 0; b < 2; ++b)
#pragma unroll
            for (int m = 0; m < 4; ++m)
#pragma unroll
                for (int n = 0; n < 2; ++n) acc[a][b][m][n] = (f32x4){0.f, 0.f, 0.f, 0.f};
    bf16x8 At[4][2], B0[2][2], B1[2][2];
    const char* cA = cur.A; const char* cB = cur.B;
    PG8_STAGE(PG8_SB(0, 0), cB, voffB); PG8_STAGE(PG8_SB(0, 1), cB + hsB, voffB); PG8_STAGE(PG8_SA(0, 0), cA, voffA); PG8_STAGE(PG8_SA(0, 1), cA + hsA, voffA);
    if (wr == 1) PG8_BAR;
    PG8_WAIT_V(2); PG8_BAR;
    PG8_STAGE(PG8_SB(1, 0), cB + kstep, voffB); PG8_STAGE(PG8_SA(1, 0), cA + kstep, voffA); PG8_STAGE(PG8_SB(1, 1), cB + hsB + kstep, voffB);
    PG8_WAIT_V(6); PG8_BAR;
    for (;;) {
        const bool has_next = S.next(ui + 1, nxt);
        const char* nA = has_next ? nxt.A : cA; const char* nB = has_next ? nxt.B : cB;
        for (int t = 0; t < nt; t += 2) {
            const bool last = (t == nt - 2);
            const char* a1 = cA + (size_t)(t + 1) * kstep;
            const char* a2 = last ? nA : cA + (size_t)(t + 2) * kstep; const char* b2 = last ? nB : cB + (size_t)(t + 2) * kstep;
            const char* a3 = a2 + kstep; const char* b3 = b2 + kstep;
            PG8_LDB(B0, 0, 0); PG8_LDB(B1, 0, 1); PG8_SCHED; PG8_LDA(At, 0, 0); PG8_STAGE(PG8_SA(1, 1), a1 + hsA, voffA);
            PG8_WAIT_V(8); PG8_WAIT_L(0); PG8_BAR; PG8_MMA(0, 0, At, B0); PG8_MMA(0, 1, At, B1); PG8_BAR; PG8_SCHED;
            PG8_LDA(At, 0, 1); PG8_STAGE(PG8_SB(0, 0), b2, voffB); PG8_STAGE(PG8_SB(0, 1), b2 + hsB, voffB); PG8_STAGE(PG8_SA(0, 0), a2, voffA);
            PG8_WAIT_V(8); PG8_WAIT_L(0); PG8_BAR; PG8_MMA(1, 0, At, B0); PG8_MMA(1, 1, At, B1); PG8_BAR; PG8_SCHED;
            PG8_LDB(B0, 1, 0); PG8_LDB(B1, 1, 1); PG8_SCHED; PG8_LDA(At, 1, 0); PG8_STAGE(PG8_SA(0, 1), a2 + hsA, voffA);
            PG8_WAIT_V(8); PG8_WAIT_L(0); PG8_BAR; PG8_MMA(0, 0, At, B0); PG8_MMA(0, 1, At, B1); PG8_BAR; PG8_SCHED;
            PG8_LDA(At, 1, 1); PG8_STAGE(PG8_SB(1, 0), b3, voffB); PG8_STAGE(PG8_SB(1, 1), b3 + hsB, voffB); PG8_STAGE(PG8_SA(1, 0), a3, voffA);
            PG8_WAIT_V(8); PG8_WAIT_L(0); PG8_BAR; PG8_MMA(1, 0, At, B0); PG8_MMA(1, 1, At, B1); PG8_BAR; PG8_SCHED;
        }
        if constexpr (ALIGN_EPI) { if (wr == 0) PG8_BAR; }
        E(acc, cur, wr, wc, fr, fq);
        if (!has_next) break;
        if (!(Epi::CHAIN && nxt.sub != 0)) {
#pragma unroll
            for (int a = 0; a < 2; ++a)
#pragma unroll
                for (int b = 0; b < 2; ++b)
#pragma unroll
                    for (int m = 0; m < 4; ++m)
#pragma unroll
                        for (int n = 0; n < 2; ++n) acc[a][b][m][n] = (f32x4){0.f, 0.f, 0.f, 0.f};
        }
        cur = nxt; cA = nA; cB = nB; ++ui;
        if constexpr (ALIGN_EPI) { if (wr == 1) PG8_BAR; }
    }
    PG8_WAIT_V(0);
    if constexpr (!ALIGN_EPI) { if (wr == 0) PG8_BAR; }
    PG8_BAR;
#undef PG8_SA
#undef PG8_SB
#undef PG8_STAGE
#undef PG8_LDA
#undef PG8_LDB
#undef PG8_MMA
#undef PG8_WAIT_V
#undef PG8_WAIT_L
#undef PG8_BAR
#undef PG8_SCHED
}

struct EpiProj {
    static constexpr bool PERM = true, CHAIN = false;
    bf16_t* pb; bf16_t* pa; float* ssq; float* sskv;
    __device__ __forceinline__ void operator()(AccT& acc, const Unit& u, int wr, int wc, int fr, int fq) const {
        const int row0 = u.pm * BM + wr * 64 + fr;
#pragma unroll
        for (int bj = 0; bj < 2; ++bj) {
            const int hk = u.pn * 2 + bj;
            bf16_t* base; int ld; float* ss = nullptr;
            if (hk < 22) { base = pb + hk * 128; ld = PB_LD; } else { const int ha = hk - 22; base = pa + ha * 128; ld = PA_LD; if (ha >= 6 && ha <= 8) ss = ssq; else if (ha == 9 || ha == 10) ss = sskv; }
            base += wc * 32 + 8 * fq;
#pragma unroll
            for (int ai = 0; ai < 2; ++ai)
#pragma unroll
                for (int m = 0; m < 4; ++m) { const int row = row0 + ai * HALF + m * 16; const f32x4 v0 = acc[ai][bj][m][0], v1 = acc[ai][bj][m][1];
                    u32x4 w; w.x = cvt_pk_bf16(v0[0], v0[1]); w.y = cvt_pk_bf16(v0[2], v0[3]); w.z = cvt_pk_bf16(v1[0], v1[1]); w.w = cvt_pk_bf16(v1[2], v1[3]);
                    *(u32x4*)(base + (size_t)row * ld) = w;
                    if (ss) { float s = (v0[0] * v0[0] + v0[1] * v0[1]) + (v0[2] * v0[2] + v0[3] * v0[3]) + (v1[0] * v1[0] + v1[1] * v1[1]) + (v1[2] * v1[2] + v1[3] * v1[3]);
                        s += __shfl_xor(s, 16); s += __shfl_xor(s, 32); if (fq == 0) atomicAdd(ss + row, s); } }
        }
    }
};
struct EpiQ {
    static constexpr bool PERM = false, CHAIN = false;
    bf16_t* Q; const float* ssq; const float* cs; const float* sn;
    __device__ __forceinline__ void operator()(AccT& acc, const Unit& u, int wr, int wc, int fr, int fq) const {
        const int row0 = u.pm * BM + wr * 64 + fr;
#pragma unroll
        for (int ai = 0; ai < 2; ++ai)
#pragma unroll
            for (int m = 0; m < 4; ++m) { const int row = row0 + ai * HALF + m * 16; const float rr = rsqrtf(ssq[row] * (1.f / 384.f) + EPS) * CQ;
#pragma unroll
                for (int bj = 0; bj < 2; ++bj) { const int G = u.pn * 8 + bj * 4 + wc;
                    f32x4 x0 = acc[ai][bj][m][0], x1 = acc[ai][bj][m][1];
                    if (G % 3 == 2) { const f32x4 c = *(const f32x4*)(cs + (size_t)row * 16 + 4 * fq), s = *(const f32x4*)(sn + (size_t)row * 16 + 4 * fq);
                        const f32x4 o0 = x0 * c - x1 * s, o1 = x1 * c + x0 * s; x0 = o0; x1 = o1; }
                    x0 = x0 * rr; x1 = x1 * rr;
                    bf16_t* p = Q + (size_t)row * 768 + G * 32 + 4 * fq;
                    u32x2 w0, w1; w0.x = cvt_pk_bf16(x0[0], x0[1]); w0.y = cvt_pk_bf16(x0[2], x0[3]); w1.x = cvt_pk_bf16(x1[0], x1[1]); w1.y = cvt_pk_bf16(x1[2], x1[3]);
                    *(u32x2*)p = w0; *(u32x2*)(p + 16) = w1; } }
    }
};
struct EpiKV {
    static constexpr bool PERM = true, CHAIN = false;
    bf16_t* Kb; bf16_t* Vb; const float* sskv;
    __device__ __forceinline__ void operator()(AccT& acc, const Unit& u, int wr, int wc, int fr, int fq) const {
        const int row0 = u.pm * BM + wr * 64 + fr;
#pragma unroll
        for (int ai = 0; ai < 2; ++ai)
#pragma unroll
            for (int m = 0; m < 4; ++m) { const int row = row0 + ai * HALF + m * 16; const float rr = rsqrtf(sskv[row] * (1.f / 256.f) + EPS);
#pragma unroll
                for (int bj = 0; bj < 2; ++bj) { const int head = u.pn * 2 + bj; const f32x4 v0 = acc[ai][bj][m][0] * rr, v1 = acc[ai][bj][m][1] * rr;
                    u32x4 w; w.x = cvt_pk_bf16(v0[0], v0[1]); w.y = cvt_pk_bf16(v0[2], v0[3]); w.z = cvt_pk_bf16(v1[0], v1[1]); w.w = cvt_pk_bf16(v1[2], v1[3]);
                    bf16_t* p = (wc < 2) ? Kb + (size_t)row * 768 + head * 96 + wc * 32 + 8 * fq : Vb + (size_t)row * 512 + head * 64 + (wc - 2) * 32 + 8 * fq;
                    *(u32x4*)p = w; } }
    }
};
struct EpiMerge {
    static constexpr bool PERM = true, CHAIN = true;
    const bf16_t* pb; bf16_t* merged;
    __device__ __forceinline__ void operator()(AccT& acc, const Unit& u, int wr, int wc, int fr, int fq) const {
        const int row0 = u.pm * BM + wr * 64 + fr, col0 = u.pn * BM + wc * 32 + 8 * fq;
#pragma unroll
        for (int ai = 0; ai < 2; ++ai)
#pragma unroll
            for (int m = 0; m < 4; ++m) { const int row = row0 + ai * HALF + m * 16;
#pragma unroll
                for (int bj = 0; bj < 2; ++bj) { const int col = col0 + bj * HALF;
                    const u32x4 gb = *(const u32x4*)(pb + (size_t)row * PB_LD + PB_BR + 1024 + col);
                    float eb[8];
#pragma unroll
                    for (int e = 0; e < 4; ++e) { eb[2 * e] = 1.f + __builtin_amdgcn_exp2f(__uint_as_float(gb[e] << 16) * -1.4426950408889634f); eb[2 * e + 1] = 1.f + __builtin_amdgcn_exp2f(__uint_as_float(gb[e] & 0xffff0000u) * -1.4426950408889634f); }
                    if (u.sub == 0) {
                        const u32x4 ga = *(const u32x4*)(pb + (size_t)row * PB_LD + PB_BR + col);
#pragma unroll
                        for (int e = 0; e < 4; ++e) { const float ea0 = 1.f + __builtin_amdgcn_exp2f(__uint_as_float(ga[e] << 16) * -1.4426950408889634f), ea1 = 1.f + __builtin_amdgcn_exp2f(__uint_as_float(ga[e] & 0xffff0000u) * -1.4426950408889634f);
                            const int i0 = 2 * e, i1 = 2 * e + 1;
                            acc[ai][bj][m][i0 >> 2][i0 & 3] *= eb[i0] * __builtin_amdgcn_rcpf(ea0); acc[ai][bj][m][i1 >> 2][i1 & 3] *= eb[i1] * __builtin_amdgcn_rcpf(ea1); }
                    } else {
                        const f32x4 v0 = acc[ai][bj][m][0], v1 = acc[ai][bj][m][1];
                        float sb[8];
#pragma unroll
                        for (int e = 0; e < 8; ++e) sb[e] = __builtin_amdgcn_rcpf(eb[e]);
                        u32x4 w; w.x = cvt_pk_bf16(v0[0] * sb[0], v0[1] * sb[1]); w.y = cvt_pk_bf16(v0[2] * sb[2], v0[3] * sb[3]); w.z = cvt_pk_bf16(v1[0] * sb[4], v1[1] * sb[5]); w.w = cvt_pk_bf16(v1[2] * sb[6], v1[3] * sb[7]);
                        *(u32x4*)(merged + (size_t)row * DM + col) = w; } } }
    }
};
struct EpiX1 {
    static constexpr bool PERM = false, CHAIN = false;
    const float* x; float* x1; bf16_t* x1b; float* ssx1;
    __device__ __forceinline__ void operator()(AccT& acc, const Unit& u, int wr, int wc, int fr, int fq) const {
        const int row0 = u.pm * BM + wr * 64 + fr, col0 = u.pn * BM + wc * 32 + 4 * fq;
#pragma unroll
        for (int ai = 0; ai < 2; ++ai)
#pragma unroll
            for (int m = 0; m < 4; ++m) { const int row = row0 + ai * HALF + m * 16; const size_t off = (size_t)row * DM + col0; float s = 0.f;
#pragma unroll
                for (int bj = 0; bj < 2; ++bj)
#pragma unroll
                    for (int n = 0; n < 2; ++n) { const size_t o = off + bj * HALF + n * 16; const f32x4 v = *(const f32x4*)(x + o) + acc[ai][bj][m][n];
                        *(f32x4*)(x1 + o) = v; u32x2 w; w.x = cvt_pk_bf16(v[0], v[1]); w.y = cvt_pk_bf16(v[2], v[3]); *(u32x2*)(x1b + o) = w;
                        s += (v[0] * v[0] + v[1] * v[1]) + (v[2] * v[2] + v[3] * v[3]); }
                s += __shfl_xor(s, 16); s += __shfl_xor(s, 32); if (fq == 0) atomicAdd(ssx1 + row, s); }
    }
};
struct EpiQP {
    static constexpr bool PERM = true, CHAIN = false;
    bf16_t* qp; const float* ssx1;
    __device__ __forceinline__ void operator()(AccT& acc, const Unit& u, int wr, int wc, int fr, int fq) const {
        const int row0 = u.pm * BM + wr * 64 + fr, col0 = u.pn * BM + wc * 32 + 8 * fq;
#pragma unroll
        for (int ai = 0; ai < 2; ++ai)
#pragma unroll
            for (int m = 0; m < 4; ++m) { const int row = row0 + ai * HALF + m * 16; const float rr = rsqrtf(ssx1[row] * (1.f / 1024.f) + EPS);
#pragma unroll
                for (int bj = 0; bj < 2; ++bj) { const f32x4 v0 = acc[ai][bj][m][0] * rr, v1 = acc[ai][bj][m][1] * rr;
                    u32x4 w; w.x = cvt_pk_bf16(v0[0], v0[1]); w.y = cvt_pk_bf16(v0[2], v0[3]); w.z = cvt_pk_bf16(v1[0], v1[1]); w.w = cvt_pk_bf16(v1[2], v1[3]);
                    *(u32x4*)(qp + (size_t)row * 2048 + col0 + bj * HALF) = w; } }
    }
};
}


namespace att {
typedef short bf16x8 __attribute__((ext_vector_type(8)));
typedef short s16x4 __attribute__((ext_vector_type(4)));
typedef float f32x16 __attribute__((ext_vector_type(16)));
constexpr int NW = 8, QBLK = 32, KVBLK = 64, QB = NW * QBLK;
constexpr int QS = 768, KS = 768, VS = 512, OS = 512;
constexpr int SHM_V = KVBLK * 64 * 2, SHM_K = KVBLK * 256;
constexpr int LDS_BYTES = 2 * SHM_V + 2 * SHM_K + NW * 64 * 4;
constexpr float THR = 8.f;
#define KSWZ(row, colB) ((row) * 256 + ((colB) ^ (((row) & 15) << 4)))
#define SBAR() __builtin_amdgcn_sched_barrier(0)
__device__ __forceinline__ int v_st(int k, int c) { const int kk = (k & ~0xC) | ((k & 4) << 1) | ((k & 8) >> 1); return ((kk >> 3) * 2 + (c >> 5)) * 512 + ((kk & 7) * 32 + (c & 31)) * 2; }
__device__ __forceinline__ int v_rd_base(int lane) { return ((lane & 3) << 3) | (((lane >> 2) & 3) << 6) | (((lane >> 4) & 1) << 5) | (((lane >> 5) & 1) << 8); }
constexpr int v_rd_off(int d0, int ks, int half) { return d0 * 512 + ks * 2048 + half * 1024; }
__device__ __forceinline__ int crow(int r, int hi) { return (r & 3) + 8 * (r >> 2) + 4 * hi; }
__device__ __forceinline__ unsigned cvtpk(float lo, float hi) { unsigned r; asm volatile("v_cvt_pk_bf16_f32 %0, %1, %2" : "=v"(r) : "v"(lo), "v"(hi)); return r; }
__device__ __forceinline__ bf16x8 load8(const bf16_t* p) { return *reinterpret_cast<const bf16x8*>(p); }
__device__ __forceinline__ void partialSM(f32x16& p0, f32x16& p1, float& m_reg, float& mn, float& alpha) {
    float pmax = p0[0]; for (int r = 1; r < 16; ++r) pmax = fmaxf(pmax, p0[r]); for (int r = 0; r < 16; ++r) pmax = fmaxf(pmax, p1[r]);
    { auto rr = __builtin_amdgcn_permlane32_swap(__float_as_uint(pmax), __float_as_uint(pmax), false, false);
      pmax = fmaxf(__uint_as_float(rr[0]), __uint_as_float(rr[1])); }
    if (__builtin_expect(__all((pmax - m_reg) <= THR), 1)) { mn = m_reg; alpha = 1.f; }
    else { mn = fmaxf(m_reg, pmax); alpha = __builtin_amdgcn_exp2f(m_reg - mn); m_reg = mn; }
    for (int r = 0; r < 16; ++r) p0[r] = p0[r] - mn; for (int r = 0; r < 16; ++r) p1[r] = p1[r] - mn;
    for (int r = 0; r < 16; ++r) p0[r] = __builtin_amdgcn_exp2f(p0[r]);
}
__device__ __forceinline__ void finishSM(f32x16& p0, f32x16& p1, float alpha, float& l_reg, bf16x8& pa0, bf16x8& pa1, bf16x8& pa2, bf16x8& pa3) {
    for (int r = 0; r < 16; ++r) p1[r] = __builtin_amdgcn_exp2f(p1[r]);
    float ps = 0; for (int r = 0; r < 16; ++r) ps += p0[r]; for (int r = 0; r < 16; ++r) ps += p1[r];
    { auto rr = __builtin_amdgcn_permlane32_swap(__float_as_uint(ps), __float_as_uint(ps), false, false);
      ps = __uint_as_float(rr[0]) + __uint_as_float(rr[1]); }
    l_reg = l_reg * alpha + ps;
#define PK4(P, B_, OUT) do { unsigned a0 = cvtpk(P[B_+0], P[B_+1]), a1 = cvtpk(P[B_+2], P[B_+3]);                          \
        unsigned b0 = cvtpk(P[B_+4], P[B_+5]), b1 = cvtpk(P[B_+6], P[B_+7]);                                             \
        auto r0 = __builtin_amdgcn_permlane32_swap(a0, b0, false, false); auto r1 = __builtin_amdgcn_permlane32_swap(a1, b1, false, false); \
        u32x4 w = {r0[0], r1[0], r0[1], r1[1]}; OUT = *reinterpret_cast<bf16x8*>(&w); } while (0)
    PK4(p0, 0, pa0); PK4(p0, 8, pa1); PK4(p1, 0, pa2); PK4(p1, 8, pa3);
#undef PK4
}
template <int KB>
__device__ __forceinline__ void qkt(f32x16& p0, f32x16& p1, const char* K_lds, int r32, int hi, const bf16x8* qr) {
    p0 = f32x16{}; p1 = f32x16{};
#pragma unroll
    for (int d0 = 0; d0 < 6; ++d0) { const char* a = K_lds + KB * SHM_K + KSWZ(r32, (d0 * 16 + hi * 8) * 2);
        bf16x8 b0 = *reinterpret_cast<const bf16x8*>(a);
        bf16x8 b1 = *reinterpret_cast<const bf16x8*>(a + 32 * 256);
        p0 = __builtin_amdgcn_mfma_f32_32x32x16_bf16(b0, qr[d0], p0, 0, 0, 0);
        p1 = __builtin_amdgcn_mfma_f32_32x32x16_bf16(b1, qr[d0], p1, 0, 0, 0); }
}
template <int VB>
__device__ __forceinline__ void pv_tile(f32x16* o, int vb0, bf16x8 pa0, bf16x8 pa1, bf16x8 pa2, bf16x8 pa3) {
#define TRRD(dst, off) asm volatile("ds_read_b64_tr_b16 %0, %1 offset:%2" : "=&v"(dst) : "v"(vb0), "i"(off) : "memory")
#define PV_D0(d0) do { s16x4 l0, l1, l2, l3, h0, h1, h2, h3; constexpr int b_ = VB * SHM_V + v_rd_off(d0, 0, 0);   \
        TRRD(l0, b_); TRRD(h0, b_ + 1024); TRRD(l1, b_ + 2048); TRRD(h1, b_ + 3072); TRRD(l2, b_ + 4096); TRRD(h2, b_ + 5120); TRRD(l3, b_ + 6144); TRRD(h3, b_ + 7168); \
        asm volatile("s_waitcnt lgkmcnt(0)" ::: "memory"); SBAR();   \
        o[d0] = __builtin_amdgcn_mfma_f32_32x32x16_bf16(pa0, (bf16x8){l0[0], l0[1], l0[2], l0[3], h0[0], h0[1], h0[2], h0[3]}, o[d0], 0, 0, 0);   \
        o[d0] = __builtin_amdgcn_mfma_f32_32x32x16_bf16(pa1, (bf16x8){l1[0], l1[1], l1[2], l1[3], h1[0], h1[1], h1[2], h1[3]}, o[d0], 0, 0, 0);   \
        o[d0] = __builtin_amdgcn_mfma_f32_32x32x16_bf16(pa2, (bf16x8){l2[0], l2[1], l2[2], l2[3], h2[0], h2[1], h2[2], h2[3]}, o[d0], 0, 0, 0);   \
        o[d0] = __builtin_amdgcn_mfma_f32_32x32x16_bf16(pa3, (bf16x8){l3[0], l3[1], l3[2], l3[3], h3[0], h3[1], h3[2], h3[3]}, o[d0], 0, 0, 0); } while (0)
    PV_D0(0); PV_D0(1);
#undef PV_D0
#undef TRRD
}
struct BlockRef { const bf16_t* Q; const bf16_t* K; const bf16_t* KPE; const bf16_t* V; bf16_t* O; int P0; };
struct Seam { bf16x8 qr[6]; bf16x8 st_v0, st_v1, st_k0, st_k1; };
#define ROWK(p, k0, rr) ((p) + (size_t)((k0) + (rr)) * kstr)
#define ROWV(p, k0, rr) ((p) + (size_t)((k0) + (rr)) * VS + sc)
#define VMW() asm volatile("s_waitcnt vmcnt(0)" ::: "memory")
#define VMWN(n) asm volatile("s_waitcnt vmcnt(%0)" :: "i"(n) : "memory")
#define SLOAD_H(Kp, Vp, k0) do { if (vact) { S.st_v0 = load8(ROWV(Vp, k0, sr)); S.st_v1 = load8(ROWV(Vp, k0, 32 + sr)); }              \
                                 if (kact) { S.st_k0 = load8(ROWK(Kp, k0, sr)); S.st_k1 = load8(ROWK(Kp, k0, 32 + sr)); } } while (0)
#define SWRITE_HK(bf) do { if (kact) { *(bf16x8*)(K_lds + (bf) * SHM_K + kws) = S.st_k0; *(bf16x8*)(K_lds + (bf) * SHM_K + kws + 32 * 256) = S.st_k1; } } while (0)
#define SWRITE_HV(bf) do { if (vact) { *(bf16x8*)(V_lds + (bf) * SHM_V + vst0) = S.st_v0; *(bf16x8*)(V_lds + (bf) * SHM_V + vst1) = S.st_v1; } } while (0)
#define SWRITE_H(bf) do { SWRITE_HV(bf); SWRITE_HK(bf); } while (0)
__device__ __forceinline__ void attn_prime(const BlockRef& cur, char* lds, Seam& S) {
    const int tid = threadIdx.x, wid = __builtin_amdgcn_readfirstlane(tid >> 6), lane = tid & 63, r32 = lane & 31, hi = lane >> 5;
    const int sr = tid >> 4, sc = (tid & 15) * 8, kws = KSWZ(sr, sc * 2); char* K_lds = lds + 2 * SHM_V;
    const bool kact = (tid & 15) < 12, vact = (tid & 15) < 8;
#pragma unroll
    for (int d0 = 0; d0 < 6; ++d0) S.qr[d0] = load8(cur.Q + (size_t)(wid * QBLK + r32) * QS + d0 * 16 + hi * 8);
    const bf16_t* kp0 = (tid & 15) < 8 ? cur.K + sc : cur.KPE + (sc - 64); const int kstr = (tid & 15) < 8 ? KS : 32;
    SLOAD_H(kp0, cur.V, 0); VMW(); SWRITE_HK(0);
    __syncthreads();
}
__device__ __forceinline__ void attn_block(const BlockRef& cur, const BlockRef& nxt, char* lds, Seam& S) {
    const int tid = threadIdx.x, wid = __builtin_amdgcn_readfirstlane(tid >> 6), lane = tid & 63, r32 = lane & 31, hi = lane >> 5;
    const int NT = (cur.P0 + QB - 1) / KVBLK + 1;
    const int qlo = cur.P0 + wid * QBLK;
    const int qvis = qlo | 63;
    char* V_lds = lds; char* K_lds = lds + 2 * SHM_V;
    float* ws = (float*)(lds + 2 * SHM_V + 2 * SHM_K) + wid * 64; float* li_l = ws, * al_l = ws + 32;
    float m_reg = -1e30f, l_reg = 0; f32x16 o[2] = {};
    const int sr = tid >> 4, sc = (tid & 15) * 8, vst0 = v_st(sr, sc & 63), vst1 = v_st(32 + sr, sc & 63), kws = KSWZ(sr, sc * 2);
    const bool kact = (tid & 15) < 12, vact = (tid & 15) < 8;
    const int vb0 = (int)(uintptr_t)V_lds + v_rd_base(lane);
    const int kstr = (tid & 15) < 8 ? KS : 32;
    const bf16_t* Kh = (tid & 15) < 8 ? cur.K + sc : cur.KPE + (sc - 64); const bf16_t* Vh = cur.V;
    const bf16_t* Knx = (tid & 15) < 8 ? nxt.K + sc : nxt.KPE + (sc - 64);
#define RESC(a) do { if (__any((a) < 1.f)) { if (hi == 0) al_l[r32] = (a); asm volatile("s_waitcnt lgkmcnt(0)" ::: "memory");              \
                     for (int d_ = 0; d_ < 2; ++d_) for (int r = 0; r < 16; ++r) o[d_][r] *= al_l[crow(r, hi)]; } } while (0)
#define KBASE(t) ((t) * KVBLK)
#define MASKT(P0_, P1_, t) do { if (__builtin_amdgcn_readfirstlane((int)(KBASE(t) > qvis))) { const float NEG_ = -__builtin_inff(); _Pragma("unroll") for (int r = 0; r < 16; ++r) { P0_[r] = NEG_; P1_[r] = NEG_; } asm volatile("" : "+v"(P0_), "+v"(P1_)); } } while (0)
    constexpr int NQL = 6;
#define SEAM_K0() do { VMWN(NQL); SWRITE_HK(0); SBAR(); } while (0)
    f32x16 pA0, pA1, pB0, pB1; float mnA, mnB, alA, alB; bf16x8 pa0, pa1, pa2, pa3;
    SWRITE_HV(0); SBAR();
    if (NT > 1) { SLOAD_H(Kh, Vh, KBASE(1)); }
    SBAR(); qkt<0>(pA0, pA1, K_lds, r32, hi, S.qr);
    MASKT(pA0, pA1, 0); partialSM(pA0, pA1, m_reg, mnA, alA);
    if (NT > 1) { VMW(); SWRITE_H(1); }
    __syncthreads();
#define HALF_STEP(PX0, PX1, mnX, alX, PY0, PY1, alY, t, KB, VB, SB) do {                                                      \
        SBAR(); qkt<KB>(PX0, PX1, K_lds, r32, hi, S.qr);                                             \
        finishSM(PY0, PY1, alY, l_reg, pa0, pa1, pa2, pa3); SBAR();                                                           \
        if ((t) + 1 < NT) { SLOAD_H(Kh, Vh, KBASE((t) + 1)); SBAR(); }                                               \
        pv_tile<VB>(o, vb0, pa0, pa1, pa2, pa3); MASKT(PX0, PX1, (t)); partialSM(PX0, PX1, m_reg, mnX, alX);                                        \
        __syncthreads();                                                                                                      \
        if ((t) + 1 < NT) { VMW(); SWRITE_H(SB); }                                                                          \
        RESC(alX); __syncthreads(); } while (0)
    for (int t = 1; t + 1 < NT; t += 2) {
        HALF_STEP(pB0, pB1, mnB, alB, pA0, pA1, alA, t, 1, 0, 0);
        HALF_STEP(pA0, pA1, mnA, alA, pB0, pB1, alB, t + 1, 0, 1, 1);
    }
    const bool even = (NT & 1) == 0;
    if (even) { SBAR(); qkt<1>(pB0, pB1, K_lds, r32, hi, S.qr); SBAR(); }
    SLOAD_H(Knx, nxt.V, 0); SBAR();
#pragma unroll
    for (int d0 = 0; d0 < 6; ++d0) S.qr[d0] = load8(nxt.Q + (size_t)(wid * QBLK + r32) * QS + d0 * 16 + hi * 8);
    SBAR();
    finishSM(pA0, pA1, alA, l_reg, pa0, pa1, pa2, pa3); SBAR();
    pv_tile<0>(o, vb0, pa0, pa1, pa2, pa3);
    if (even) { MASKT(pB0, pB1, NT - 1); partialSM(pB0, pB1, m_reg, mnB, alB); __syncthreads(); RESC(alB);
        finishSM(pB0, pB1, alB, l_reg, pa0, pa1, pa2, pa3); SBAR(); pv_tile<1>(o, vb0, pa0, pa1, pa2, pa3); }
    SBAR(); SEAM_K0();
    if (hi == 0) li_l[r32] = l_reg; asm volatile("s_waitcnt lgkmcnt(0)" ::: "memory");
    float rli[16];
#pragma unroll
    for (int r = 0; r < 16; ++r) rli[r] = __builtin_amdgcn_rcpf(li_l[crow(r, hi)]);
    bf16_t* Ow = cur.O + (size_t)(wid * QBLK) * OS;
#pragma unroll
    for (int r = 0; r < 16; ++r) { const int orow = crow(r, hi);
#pragma unroll
        for (int d0 = 0; d0 < 2; ++d0) { const float v = o[d0][r] * rli[r];
            const float vn = __shfl_xor(v, 1);
            if ((r32 & 1) == 0) *(unsigned*)(Ow + (size_t)orow * OS + d0 * 32 + r32) = cvtpk(v, vn); } }
    __syncthreads();
#undef RESC
#undef KBASE
#undef MASKT
#undef SEAM_K0
#undef HALF_STEP
}
#undef ROWK
#undef ROWV
#undef VMW
#undef VMWN
#undef SLOAD_H
#undef SWRITE_HK
#undef SWRITE_HV
#undef SWRITE_H
#undef KSWZ
#undef SBAR
}

namespace gla {
typedef short bf16x8 __attribute__((ext_vector_type(8)));
typedef short s16x4 __attribute__((ext_vector_type(4)));
typedef float f32x16 __attribute__((ext_vector_type(16)));
template <int NCB> __device__ __forceinline__ int t_st(int k, int c) { const int kk = (k & ~0xC) | ((k & 4) << 1) | ((k & 8) >> 1); return ((kk >> 3) * NCB + (c >> 5)) * 512 + ((kk & 7) * 32 + (c & 31)) * 2; }
__device__ __forceinline__ int t_rd_base(int lane) { return ((lane & 3) << 3) | (((lane >> 2) & 3) << 6) | (((lane >> 4) & 1) << 5) | (((lane >> 5) & 1) << 8); }
template <int NCB> constexpr int t_rd_off(int d0, int ks, int half) { return d0 * 512 + ks * (NCB * 1024) + half * (NCB * 512); }
#define GLA_TRRD(dst, addr, off) asm volatile("ds_read_b64_tr_b16 %0, %1 offset:%2" : "=&v"(dst) : "v"(addr), "i"(off) : "memory")
__device__ __forceinline__ int crow(int r, int hi) { return (r & 3) + 8 * (r >> 2) + 4 * hi; }
}

#define XB_TMO      128
#define XB_XCNT(j)  (256  + 64 * (j))
#define XB_XSUB(j)  (1280 + 64 * (j))
#define XB_XGEN(j)  (2304 + 64 * (j))
#define XB_TOP      3328
#define XB_TOPGEN   3392
#define XCD_BAR_WORDS 3456
#define XB_SPIN_CAP (1u << 18)
__device__ __forceinline__ unsigned xb_ld(unsigned* p)              { return __hip_atomic_load(p, __ATOMIC_RELAXED, __HIP_MEMORY_SCOPE_AGENT); }
__device__ __forceinline__ unsigned xb_add(unsigned* p, unsigned v) { return __hip_atomic_fetch_add(p, v, __ATOMIC_RELAXED, __HIP_MEMORY_SCOPE_AGENT); }
__device__ __forceinline__ unsigned xb_xcc_id() { return (unsigned)__builtin_amdgcn_s_getreg((3 << 11) | 20) & 0xFu; }
#define XB_SPIN(cond, bar) do { unsigned _sp = 0; while (cond) { __builtin_amdgcn_s_sleep(1); \
    if ((++_sp & 255u) == 0u) { if (xb_ld(&(bar)[XB_TMO])) break; if (_sp > XB_SPIN_CAP) { atomicAdd(&(bar)[XB_TMO], 1u); break; } } } } while (0)
struct XcdBarrier { unsigned* bar; unsigned x; volatile LAS unsigned* st; };
__device__ __forceinline__ XcdBarrier xcd_barrier_post(unsigned* bar, volatile LAS unsigned* st) {
    XcdBarrier b; b.bar = bar; b.x = xb_xcc_id(); b.st = st;
    if (threadIdx.x == 0) st[2] = xb_add(&bar[XB_XCNT(b.x)], 1u);
    return b;
}
__device__ __forceinline__ void xcd_barrier_complete(unsigned* bar, unsigned x, unsigned& nloc, unsigned& nx) {
    const unsigned G = gridDim.x * gridDim.y * gridDim.z;
    unsigned sum, cnt, mine, sp = 0u;
    for (;;) {
        sum = 0u; cnt = 0u; mine = 0u;
#pragma unroll
        for (unsigned j = 0; j < 16; ++j) { const unsigned c = xb_ld(&bar[XB_XCNT(j)]); sum += c; cnt += (c > 0u) ? 1u : 0u; mine = (j == x) ? c : mine; }
        if (sum == G) break;
        __builtin_amdgcn_s_sleep(1);
        if ((++sp & 255u) == 0u) { if (xb_ld(&bar[XB_TMO])) break; if (sp > XB_SPIN_CAP) { atomicAdd(&bar[XB_TMO], 1u); break; } }
    }
    nloc = mine > 0u ? mine : 1u; nx = cnt > 0u ? cnt : 1u;
}
__device__ __forceinline__ void xcd_barrier(const XcdBarrier& b) {
    asm volatile("s_waitcnt vmcnt(0)" ::: "memory");
    __syncthreads();
    if (threadIdx.x == 0) {
        unsigned* bar = b.bar;
        __builtin_amdgcn_s_waitcnt(0);
        unsigned nloc = b.st[0], nx = b.st[1];
        if (nloc == 0u) { xcd_barrier_complete(bar, b.x, nloc, nx); b.st[0] = nloc; b.st[1] = nx; }
        const unsigned old = xb_add(&bar[XB_XSUB(b.x)], 1u);
        const unsigned gen = old / nloc;
        if (old + 1u == (gen + 1u) * nloc) {
            __builtin_amdgcn_fence(__ATOMIC_RELEASE, "agent");
            asm volatile("s_waitcnt vmcnt(0)" ::: "memory");
            const unsigned og = xb_add(&bar[XB_TOP], 1u);
            const unsigned tg = og / nx;
            if (og + 1u == (tg + 1u) * nx) xb_add(&bar[XB_TOPGEN], 1u);
            else XB_SPIN(xb_ld(&bar[XB_TOPGEN]) == tg, bar);
            __builtin_amdgcn_fence(__ATOMIC_ACQUIRE, "agent");
            xb_add(&bar[XB_XGEN(b.x)], 1u);
            asm volatile("s_waitcnt vmcnt(0)" ::: "memory");
        } else {
            XB_SPIN(xb_ld(&bar[XB_XGEN(b.x)]) == gen, bar);
            __builtin_amdgcn_fence(__ATOMIC_ACQUIRE, "agent");
            asm volatile("s_waitcnt vmcnt(0)" ::: "memory");
        }
    }
    __syncthreads();
}

constexpr int NWAVES = 8;
constexpr int RING_BYTES = 131072, LDSCTL_OFF = RING_BYTES, MISC_OFF = LDSCTL_OFF + 320, LDS_BYTES = 147456;
constexpr int CW_BAR = 4096;
constexpr int CW_QCTR = 16384;

struct Args { const void* in[20]; float* out; unsigned char* ws; int ph_lo, ph_hi; };

__device__ __forceinline__ int win_srccol(int n) {
    if (n < 2048) return 2224 + n;
    if (n < 2560) return 1712 + (n - 2048);
    if (n < 2816) return 672 + (n - 2560);
    if (n < 3328) return 1184 + (n - 2816);
    if (n < 3584) return 928 + (n - 3328);
    if (n < 3968) return 0 + (n - 3584);
    if (n < 4224) return 384 + (n - 3968);
    if (n < 4256) return 640 + (n - 4224);
    if (n < 4272) return 1696 + (n - 4256);
    return -1;
}
__device__ __forceinline__ void transpose_item(const float* __restrict__ W, int K, int Nsrc, bf16_t* __restrict__ WT, int Nout, const float* __restrict__ kscale, bool winperm, float* scr, int item, int lane) {
    const int nblk = Nout / 32, kb = item / nblk, nb = item % nblk, k0 = 64 * kb, n0 = 32 * nb;
    const int n = n0 + (lane & 31); const int sc = winperm ? win_srccol(n) : n;
#pragma unroll 8
    for (int i = 0; i < 32; ++i) { const int kk = 2 * i + (lane >> 5); float v = 0.f; if (sc >= 0) { v = W[(size_t)(k0 + kk) * Nsrc + sc]; if (kscale) v *= kscale[k0 + kk]; } scr[kk * 33 + (lane & 31)] = v; }
    asm volatile("s_waitcnt lgkmcnt(0)" ::: "memory");
    const int c = lane & 7;
#pragma unroll
    for (int j = 0; j < 4; ++j) { const int nn = (lane >> 3) + 8 * j; const float* s = scr + (8 * c) * 33 + nn;
        u32x4 o; o.x = pk2(s[0 * 33], s[1 * 33]); o.y = pk2(s[2 * 33], s[3 * 33]); o.z = pk2(s[4 * 33], s[5 * 33]); o.w = pk2(s[6 * 33], s[7 * 33]);
        *(u32x4*)(WT + (size_t)(n0 + nn) * K + k0 + 8 * c) = o; }
    asm volatile("s_waitcnt lgkmcnt(0)" ::: "memory");
}

#define TOPK_INSERT(tv, ti, vv, ii) do { float v_ = (vv); int i_ = (ii); \
    _Pragma("unroll") for (int q_ = 0; q_ < 16; ++q_) { const bool gt_ = (v_ > tv[q_]) || (v_ == tv[q_] && i_ < ti[q_]); const float tv_ = tv[q_]; const int ti_ = ti[q_]; \
        tv[q_] = gt_ ? v_ : tv_; ti[q_] = gt_ ? i_ : ti_; v_ = gt_ ? tv_ : v_; i_ = gt_ ? ti_ : i_; } } while (0)

template <int OFFS> __device__ __forceinline__ void quant_rows2(const float* __restrict__ tab, const float* __restrict__ g, unsigned char* __restrict__ qt, float* __restrict__ sc, int row0, int lane) {
    f32x4 v[2][4];
#pragma unroll
    for (int rr = 0; rr < 2; ++rr)
#pragma unroll
        for (int j = 0; j < 4; ++j) v[rr][j] = *(const f32x4*)(tab + (size_t)(row0 + rr) * 1024 + 16 * lane + 4 * j);
#pragma unroll
    for (int rr = 0; rr < 2; ++rr) {
        float mx = 0.f;
#pragma unroll
        for (int j = 0; j < 4; ++j) { if (g) v[rr][j] = v[rr][j] * *(const f32x4*)(g + 16 * lane + 4 * j);
            mx = fmaxf(mx, fmaxf(fmaxf(fabsf(v[rr][j][0]), fabsf(v[rr][j][1])), fmaxf(fabsf(v[rr][j][2]), fabsf(v[rr][j][3])))); }
#pragma unroll
        for (int o = 1; o < 64; o <<= 1) mx = fmaxf(mx, __shfl_xor(mx, o));
        mx = fmaxf(mx, 1e-30f);
        const float inv = 127.f / mx;
        u32x4 w;
#pragma unroll
        for (int j = 0; j < 4; ++j) { unsigned b = 0;
#pragma unroll
            for (int e = 0; e < 4; ++e) { const int q = (int)rintf(v[rr][j][e] * inv) + OFFS; b |= ((unsigned)q & 0xffu) << (8 * e); }
            w[j] = b; }
        *(u32x4*)(qt + (size_t)(lane >> 3) * (16384 * 128) + (size_t)(row0 + rr) * 128 + 16 * (lane & 7)) = w;
        if (lane == 0) sc[row0 + rr] = mx * (1.f / 127.f);
    }
}
typedef __bf16 bf2_t __attribute__((ext_vector_type(2)));
__device__ __forceinline__ float dot2_bf16(unsigned a, unsigned b, float acc) { return __builtin_amdgcn_fdot2_f32_bf16(__builtin_bit_cast(bf2_t, a), __builtin_bit_cast(bf2_t, b), acc, false); }
__global__ void __launch_bounds__(NWAVES * 64, 2) fwd(Args args) {
    extern __shared__ __attribute__((aligned(16))) unsigned char lds[];
    const int tid = threadIdx.x, lane = tid & 63, wave = __builtin_amdgcn_readfirstlane(tid >> 6);
    const int G = gridDim.x; int vcu; { const int bx = blockIdx.x; vcu = (G % 8 == 0) ? (bx % 8) * (G / 8) + bx / 8 : bx; }
    const int gw = vcu * NWAVES + wave, NGW = G * NWAVES, gtid = vcu * 512 + tid, NT = G * 512;
    unsigned char* ws = args.ws;
    const float* x = (const float*)args.in[0]; const int* positions = (const int*)args.in[1];
    const float* g_mix = (const float*)args.in[2]; const float* w_in = (const float*)args.in[3]; const float* g_q_lat = (const float*)args.in[4]; const float* w_qb = (const float*)args.in[5];
    const float* g_kv_lat = (const float*)args.in[6]; const float* w_kvb = (const float*)args.in[7]; const float* w_a2 = (const float*)args.in[8]; const float* b_a2 = (const float*)args.in[9];
    const float* g_gla = (const float*)args.in[10]; const float* w_branch_a = (const float*)args.in[11]; const float* w_branch_b = (const float*)args.in[12]; const float* w_out = (const float*)args.in[13];
    const float* g_ffn = (const float*)args.in[14]; const float* w_peer_q = (const float*)args.in[15]; const float* sub_keys = (const float*)args.in[16]; const float* peer_u = (const float*)args.in[17];
    const float* peer_v = (const float*)args.in[18]; const float* g_final = (const float*)args.in[19];
    float* out = args.out;
    float* SSQ = (float*)(ws + WS_SSQ); float* SSKV = (float*)(ws + WS_SSKV); float* SSX1 = (float*)(ws + WS_SSX1); float* COS = (float*)(ws + WS_COS); float* SIN = (float*)(ws + WS_SIN);
    float* DECAY = (float*)(ws + WS_DECAY);
    bf16_t* WIN = (bf16_t*)(ws + WS_WIN); bf16_t* WQB = (bf16_t*)(ws + WS_WQB); bf16_t* WKVB = (bf16_t*)(ws + WS_WKVB); bf16_t* WA = (bf16_t*)(ws + WS_WA); bf16_t* WB = (bf16_t*)(ws + WS_WB);
    bf16_t* WOUT = (bf16_t*)(ws + WS_WOUT); bf16_t* WPQ = (bf16_t*)(ws + WS_WPQ); bf16_t* KEYS = (bf16_t*)(ws + WS_KEYS);
    bf16_t* PROJB = (bf16_t*)(ws + WS_PROJB); bf16_t* PROJA = (bf16_t*)(ws + WS_PROJA); bf16_t* XN = (bf16_t*)(ws + WS_XN);
    bf16_t* Q = (bf16_t*)(ws + WS_Q); bf16_t* K = (bf16_t*)(ws + WS_K); bf16_t* KPE = (bf16_t*)(ws + WS_KPE); float* DST = out; bf16_t* V = (bf16_t*)((unsigned char*)out + 32 * MiB);
    bf16_t* YA = (bf16_t*)(ws + WS_YA); bf16_t* YB = (bf16_t*)(ws + WS_YB); bf16_t* MERGED = (bf16_t*)(ws + WS_MERGED); bf16_t* X1B = (bf16_t*)(ws + WS_X1B); bf16_t* QP = (bf16_t*)(ws + WS_QP);
    int* EIDX = (int*)(ws + WS_EIDX); float* EGATE = (float*)(ws + WS_EGATE); unsigned char* UT = ws + WS_UT; unsigned char* VT = ws + WS_VT; float* SU = (float*)(ws + WS_SU); float* SV = (float*)(ws + WS_SV); float* SS2 = (float*)(ws + WS_SS2); float* ZP = (float*)(ws + WS_ZP); float* CS = (float*)(ws + WS_C128); signed char* CQ = (signed char*)(ws + WS_CB);

    for (int u = tid; u < (LDS_BYTES - LDSCTL_OFF) / 4; u += NWAVES * 64) ((unsigned*)(lds + LDSCTL_OFF))[u] = 0u;
    __syncthreads();
    XcdBarrier bar; bar.bar = (unsigned*)(ws + WS_CTL) + CW_BAR; bar.x = 0; bar.st = nullptr;
    if (MK_N_LAUNCHES == 1) bar = xcd_barrier_post((unsigned*)(ws + WS_CTL) + CW_BAR, (volatile LAS unsigned*)(lds + MISC_OFF) + 8);
    const int ph_lo_ = args.ph_lo, ph_hi_ = args.ph_hi;
#define IN(k) (ph_lo_ <= (k) && (k) < ph_hi_)
#define SEAM(k) do { if (MK_N_LAUNCHES == 1) { if (IN(k) && IN((k) + 1)) xcd_barrier(bar); } } while (0)
    PG8_LAS unsigned char* ring = (PG8_LAS unsigned char*)lds;

    if (IN(0)) {
        for (int i = gtid; i < 4 * M_; i += NT) SSQ[i] = 0.f;
        float* scr = (float*)(lds + wave * 16384);
        constexpr int I_WIN = 16 * (NPROJ / 32), I_QB = 6 * 24, I_KVB = 4 * 32, I_A = 8 * 32, I_OUT = 16 * 32, I_PQ = 16 * 64;
        constexpr int NITEMS = I_WIN + I_QB + I_KVB + 2 * I_A + I_OUT + I_PQ;
        for (int it = gw; it < NITEMS; it += NGW) {
            int r = it;
            if (r < I_WIN) { transpose_item(w_in, 1024, 4272, WIN, NPROJ, nullptr, true, scr, r, lane); continue; } r -= I_WIN;
            if (r < I_QB) { transpose_item(w_qb, 384, 768, WQB, 768, g_q_lat, false, scr, r, lane); continue; } r -= I_QB;
            if (r < I_KVB) { transpose_item(w_kvb, 256, 1024, WKVB, 1024, g_kv_lat, false, scr, r, lane); continue; } r -= I_KVB;
            if (r < I_A) { transpose_item(w_branch_a, 512, 1024, WA, 1024, nullptr, false, scr, r, lane); continue; } r -= I_A;
            if (r < I_A) { transpose_item(w_branch_b, 512, 1024, WB, 1024, nullptr, false, scr, r, lane); continue; } r -= I_A;
            if (r < I_OUT) { transpose_item(w_out, 1024, 1024, WOUT, 1024, nullptr, false, scr, r, lane); continue; } r -= I_OUT;
            transpose_item(w_peer_q, 1024, 2048, WPQ, 2048, g_ffn, false, scr, r, lane);
        }
        for (int i = gtid; i < 16 * 128 * 128; i += NT) KEYS[i] = f2bf(sub_keys[i]);
        for (int i = gtid; i < M_ * 16; i += NT) { const int m = i >> 4, f = i & 15;
            const double inv = pow(10000.0, -(double)f / 16.0); const double ang = (double)positions[m] * inv;
            COS[i] = (float)cos(ang); SIN[i] = (float)sin(ang); }
        for (int row = gw; row < M_; row += NGW) {
            const f32x4* xr = (const f32x4*)(x + (size_t)row * DM); f32x4 v[4]; float ss = 0.f;
#pragma unroll
            for (int j = 0; j < 4; ++j) { v[j] = xr[lane + 64 * j]; ss += (v[j][0] * v[j][0] + v[j][1] * v[j][1]) + (v[j][2] * v[j][2] + v[j][3] * v[j][3]); }
            ss = wave_sum(ss); const float r = rsqrtf(ss * (1.f / DM) + EPS);
#pragma unroll
            for (int j = 0; j < 4; ++j) { const int c = 4 * (lane + 64 * j); const f32x4 gg = *(const f32x4*)(g_mix + c);
                u32x2 w; w.x = pk2(v[j][0] * r * gg[0], v[j][1] * r * gg[1]); w.y = pk2(v[j][2] * r * gg[2], v[j][3] * r * gg[3]);
                *(u32x2*)(XN + (size_t)row * DM + c) = w; }
        }
    }
    SEAM(0);
    if (MK_N_LAUNCHES == 1 && IN(0) && IN(1)) { if (tid == 0) { unsigned ord = 0; for (unsigned j = 0; j < 16; ++j) if (j < bar.x && xb_ld(&bar.bar[XB_XCNT(j)]) > 0u) ++ord; bar.st[3] = ord; } __syncthreads(); }
    if (IN(1)) {
        pg8::Gemm g{XN, WIN, nullptr, nullptr, DM, DM, M_, NPROJ, DM, 1}; pg8::StaticOrder S; S.init(g, G, (int)blockIdx.x);
        pg8::EpiProj E{PROJB, PROJA, SSQ, SSKV};
        pg8::gemm_phase<pg8::EpiProj, pg8::StaticOrder, true>(ring, g, S, E);
        { const int nwg_ = (M_ / 256) * (NPROJ / 256), rem_ = nwg_ % G, c_ = (int)blockIdx.x; const int nq_ = rem_ ? G - rem_ : G, qi_ = rem_ ? c_ - rem_ : c_;
          if (qi_ >= 0) for (int row = 2 * (qi_ * NWAVES + wave); row < 32768; row += 2 * nq_ * NWAVES) {
              if (row < 16384) quant_rows2<0>(peer_u, g_ffn, UT, SU, row, lane); else quant_rows2<0>(peer_v, nullptr, VT, SV, row - 16384, lane); } }
    }
    SEAM(1);
    if (IN(2)) {
        { pg8::Gemm g{PROJA + PA_QLAT, WQB, nullptr, nullptr, PA_LD, 384, M_, 768, 384, 1}; pg8::StaticOrder S; S.init(g, G, (int)blockIdx.x);
          pg8::EpiQ E{Q, SSQ, COS, SIN}; pg8::gemm_phase<pg8::EpiQ, pg8::StaticOrder, true>(ring, g, S, E); }
        { pg8::Gemm g{PROJA + PA_KVLAT, WKVB, nullptr, nullptr, PA_LD, 256, M_, 1024, 256, 1}; pg8::StaticOrder S; S.init(g, G, (int)blockIdx.x);
          pg8::EpiKV E{K, V, SSKV}; pg8::gemm_phase<pg8::EpiKV, pg8::StaticOrder, true>(ring, g, S, E); }
        for (int i = gtid; i < M_ * 32; i += NT) { const int m = i >> 5, j = i & 31; const bf16_t* kr = PROJA + (size_t)m * PA_LD + PA_KROPE; float o;
            if (j < 16) { const float x1 = bf2f(kr[j]), x2 = bf2f(kr[j + 16]); o = x1 * COS[m * 16 + j] - x2 * SIN[m * 16 + j]; }
            else { const int f = j - 16; const float x2 = bf2f(kr[j]), x1 = bf2f(kr[j - 16]); o = x2 * COS[m * 16 + f] + x1 * SIN[m * 16 + f]; }
            KPE[i] = f2bf(o); }
        __syncthreads();
        {
            const int r32 = lane & 31, hi5 = lane >> 5;
            unsigned char* gvt = lds; unsigned char* kdt = lds + 16384;
            const int tbase = (int)(uintptr_t)lds + gla::t_rd_base(lane);
            for (int unit = vcu; unit < 2 * NCH * 4; unit += G) {
                const int h = unit & 3, bc = unit >> 2, t0 = bc * 64;
                {
                    const int sr = tid >> 4, ch = tid & 15;
#pragma unroll
                    for (int rr = 0; rr < 2; ++rr) { const int row = sr + 32 * rr; const u32x4 v = *(const u32x4*)(PROJA + (size_t)(t0 + row) * PA_LD + PA_GV + h * 128 + ch * 8);
                        *(u32x4*)(gvt + gla::t_st<4>(row, ch * 8)) = v; }
                }
                {
                    const int k0 = wave * 8; const bf16_t* prow = PROJA + (size_t)(t0 + lane) * PA_LD;
                    const u32x4 ga = *(const u32x4*)(prow + PA_GLR), gb = *(const u32x4*)(prow + PA_GLR + 8), gkv = *(const u32x4*)(prow + PA_GK + h * 64 + k0);
                    float glr[16];
#pragma unroll
                    for (int q = 0; q < 4; ++q) { glr[2 * q] = __uint_as_float(ga[q] << 16); glr[2 * q + 1] = __uint_as_float(ga[q] & 0xffff0000u); glr[8 + 2 * q] = __uint_as_float(gb[q] << 16); glr[8 + 2 * q + 1] = __uint_as_float(gb[q] & 0xffff0000u); }
                    float kdv[8];
#pragma unroll
                    for (int j = 0; j < 8; ++j) { const int kc = h * 64 + k0 + j; float z = b_a2[kc];
#pragma unroll
                        for (int r = 0; r < 16; ++r) z += glr[r] * w_a2[r * 256 + kc];
                        float v = (fminf(z, 0.f) - log1pf(expf(-fabsf(z)))) * (1.f / 16.f);
#pragma unroll
                        for (int d = 1; d < 64; d <<= 1) { const float t = __shfl_up(v, d); v += (lane >= d) ? t : 0.f; }
                        const float cl = __builtin_bit_cast(float, __builtin_amdgcn_readlane(__builtin_bit_cast(int, v), 63));
                        const unsigned gw_ = gkv[j >> 1]; const float gk = (j & 1) ? __uint_as_float(gw_ & 0xffff0000u) : __uint_as_float(gw_ << 16);
                        kdv[j] = gk * expf(cl - v);
                        if (lane == 0) DECAY[((size_t)bc * 4 + h) * 64 + k0 + j] = expf(cl); }
                    u32x4 w; w.x = pk2(kdv[0], kdv[1]); w.y = pk2(kdv[2], kdv[3]); w.z = pk2(kdv[4], kdv[5]); w.w = pk2(kdv[6], kdv[7]);
                    *(u32x4*)(kdt + gla::t_st<2>(lane, k0)) = w;
                }
                __syncthreads();
                {
                    const int kt = wave >> 2, vt = wave & 3; gla::f32x16 acc = {};
                    gla::s16x4 al[4], ah[4], bl[4], bh[4];
                    const int abase = tbase + kt * 512, bbase = tbase + vt * 512;
#define GLA_KS(ks) do { GLA_TRRD(al[ks], abase, 16384 + gla::t_rd_off<2>(0, ks, 0)); GLA_TRRD(ah[ks], abase, 16384 + gla::t_rd_off<2>(0, ks, 1)); GLA_TRRD(bl[ks], bbase, gla::t_rd_off<4>(0, ks, 0)); GLA_TRRD(bh[ks], bbase, gla::t_rd_off<4>(0, ks, 1)); } while (0)
                    GLA_KS(0); GLA_KS(1); GLA_KS(2); GLA_KS(3);
#undef GLA_KS
                    asm volatile("s_waitcnt lgkmcnt(0)" ::: "memory"); __builtin_amdgcn_sched_barrier(0);
#pragma unroll
                    for (int ks = 0; ks < 4; ++ks) acc = __builtin_amdgcn_mfma_f32_32x32x16_bf16((gla::bf16x8){al[ks][0], al[ks][1], al[ks][2], al[ks][3], ah[ks][0], ah[ks][1], ah[ks][2], ah[ks][3]},
                                                                                                 (gla::bf16x8){bl[ks][0], bl[ks][1], bl[ks][2], bl[ks][3], bh[ks][0], bh[ks][1], bh[ks][2], bh[ks][3]}, acc, 0, 0, 0);
                    float* dp = DST + (((size_t)bc * 4 + h) * 64 + kt * 32) * 128 + vt * 32 + r32;
#pragma unroll
                    for (int r = 0; r < 16; ++r) dp[(size_t)gla::crow(r, hi5) * 128] = acc[r];
                }
                __syncthreads();
            }
        }
    }
    SEAM(2);
    if (IN(3)) {
        if (tid < 256) for (int i = vcu * 256 + tid; i < 65536; i += G * 256) {
            const int v = i & 127, k = (i >> 7) & 63, h = (i >> 13) & 3, b = i >> 15; float s = 0.f;
            float* dp = DST + (((size_t)b * NCH * 4 + h) * 64 + k) * 128 + v; const float* gp = DECAY + ((size_t)b * NCH * 4 + h) * 64 + k;
            float d[8], g[8], dn[8], gn[8];
#pragma unroll
            for (int j = 0; j < 8; ++j) { d[j] = dp[(size_t)j * 32768]; g[j] = gp[(size_t)j * 256]; }
            for (int c0 = 0; c0 < NCH; c0 += 8) {
                const int cn = (c0 + 8 < NCH) ? c0 + 8 : c0;
#pragma unroll
                for (int j = 0; j < 8; ++j) { dn[j] = dp[(size_t)(cn + j) * 32768]; gn[j] = gp[(size_t)(cn + j) * 256]; }
#pragma unroll
                for (int j = 0; j < 8; ++j) { s = g[j] * s + d[j]; d[j] = s; }
#pragma unroll
                for (int j = 0; j < 8; ++j) dp[(size_t)(c0 + j) * 32768] = d[j];
#pragma unroll
                for (int j = 0; j < 8; ++j) { d[j] = dn[j]; g[j] = gn[j]; } } }
        __syncthreads();
        {
            for (int pr = vcu; pr < 256; pr += G) {
                const int bh = pr >> 4, s16 = pr & 15, b = bh >> 3, h = bh & 7;
                att::BlockRef r0, r1;
                const bf16_t* Kh = K + (size_t)b * SEQ * att::KS + h * 96; const bf16_t* Vh = V + (size_t)b * SEQ * att::VS + h * 64;
                const int qb0 = 31 - s16, qb1 = s16;
                r0.Q = Q + ((size_t)b * SEQ + qb0 * 256) * att::QS + h * 96; r0.O = YA + ((size_t)b * SEQ + qb0 * 256) * att::OS + h * 64; r0.K = Kh; r0.KPE = KPE + (size_t)b * SEQ * 32; r0.V = Vh; r0.P0 = qb0 * 256;
                r1.Q = Q + ((size_t)b * SEQ + qb1 * 256) * att::QS + h * 96; r1.O = YA + ((size_t)b * SEQ + qb1 * 256) * att::OS + h * 64; r1.K = Kh; r1.KPE = KPE + (size_t)b * SEQ * 32; r1.V = Vh; r1.P0 = qb1 * 256;
                att::Seam S;
                att::attn_prime(r0, (char*)lds, S);
                att::attn_block(r0, r1, (char*)lds, S);
                att::attn_block(r1, r1, (char*)lds, S);
            }
        }
    }
    SEAM(3);
    if (IN(4)) {
        const int r32 = lane & 31, hi5 = lane >> 5;
        unsigned char* stt = lds; float* part = (float*)(lds + 16384);
        const int lt = wave >> 2, vt = wave & 3;
        const int bbase = (int)(uintptr_t)lds + gla::t_rd_base(lane) + vt * 512;
        for (int unit = vcu; unit < 2 * NCH * 4; unit += G) {
            const int h = unit & 3, bc = unit >> 2, t0 = bc * 64;
            {   const int sr = tid >> 4, ch = tid & 15; const float* sp = DST + ((size_t)bc * 4 + h) * 64 * 128;
#pragma unroll
                for (int rr = 0; rr < 2; ++rr) { const int row = sr + 32 * rr; const f32x4 a = *(const f32x4*)(sp + row * 128 + ch * 8), b = *(const f32x4*)(sp + row * 128 + ch * 8 + 4);
                    u32x4 w; w.x = pk2(a[0], a[1]); w.y = pk2(a[2], a[3]); w.z = pk2(b[0], b[1]); w.w = pk2(b[2], b[3]);
                    *(u32x4*)(stt + gla::t_st<4>(row, ch * 8)) = w; } }
            gla::bf16x8 qa[4];
            { const bf16_t* qrow = PROJB + (size_t)(t0 + lt * 32 + r32) * PB_LD + PB_GQ + h * 64 + hi5 * 8;
#pragma unroll
              for (int ks = 0; ks < 4; ++ks) qa[ks] = *(const gla::bf16x8*)(qrow + ks * 16); }
            __syncthreads();
            gla::f32x16 acc = {};
            { gla::s16x4 bl[4], bh[4];
#define GLA_KS(ks) do { GLA_TRRD(bl[ks], bbase, gla::t_rd_off<4>(0, ks, 0)); GLA_TRRD(bh[ks], bbase, gla::t_rd_off<4>(0, ks, 1)); } while (0)
              GLA_KS(0); GLA_KS(1); GLA_KS(2); GLA_KS(3);
#undef GLA_KS
              asm volatile("s_waitcnt lgkmcnt(0)" ::: "memory"); __builtin_amdgcn_sched_barrier(0);
#pragma unroll
              for (int ks = 0; ks < 4; ++ks) acc = __builtin_amdgcn_mfma_f32_32x32x16_bf16(qa[ks], (gla::bf16x8){bl[ks][0], bl[ks][1], bl[ks][2], bl[ks][3], bh[ks][0], bh[ks][1], bh[ks][2], bh[ks][3]}, acc, 0, 0, 0); }
            float rs[16];
#pragma unroll
            for (int r = 0; r < 16; ++r) { acc[r] *= 0.125f; float s2 = acc[r] * acc[r];
                s2 += __builtin_bit_cast(float, __builtin_amdgcn_update_dpp(0, __builtin_bit_cast(int, s2), 0x128, 0xf, 0xf, false));
                s2 += __builtin_bit_cast(float, __builtin_amdgcn_update_dpp(0, __builtin_bit_cast(int, s2), 0x124, 0xf, 0xf, false));
                s2 += __builtin_bit_cast(float, __builtin_amdgcn_update_dpp(0, __builtin_bit_cast(int, s2), 0x122, 0xf, 0xf, false));
                s2 += __builtin_bit_cast(float, __builtin_amdgcn_update_dpp(0, __builtin_bit_cast(int, s2), 0x121, 0xf, 0xf, false));
                s2 += __shfl_xor(s2, 16); rs[r] = s2; }
            if (r32 == 0) {
#pragma unroll
                for (int r = 0; r < 16; ++r) part[(lt * 32 + gla::crow(r, hi5)) * 4 + vt] = rs[r]; }
            __syncthreads();
#pragma unroll
            for (int r = 0; r < 16; ++r) { const int l = lt * 32 + gla::crow(r, hi5); const f32x4 pp = *(const f32x4*)(part + l * 4);
                const float rn = rsqrtf(((pp[0] + pp[1]) + (pp[2] + pp[3])) * (1.f / 128.f) + EPS);
                const int v = vt * 32 + r32; const float go = bf2f(PROJB[(size_t)(t0 + l) * PB_LD + PB_GOUT + h * 128 + v]);
                const float silu = go * __builtin_amdgcn_rcpf(1.f + __expf(-go));
                YB[(size_t)(t0 + l) * 512 + h * 128 + v] = f2bf(acc[r] * rn * g_gla[h * 128 + v] * silu); }
            __syncthreads();
        }
    }
    SEAM(4);
    if (IN(5)) {
        pg8::Gemm g{YA, WA, YB, WB, 512, 512, M_, 1024, 512, 2}; pg8::StaticOrder S; S.init(g, G, (int)blockIdx.x);
        pg8::EpiMerge E{PROJB, MERGED}; pg8::gemm_phase<pg8::EpiMerge, pg8::StaticOrder, true>(ring, g, S, E);
    }
    SEAM(5);
    if (IN(6)) {
        pg8::Gemm g{MERGED, WOUT, nullptr, nullptr, DM, DM, M_, 1024, DM, 1}; pg8::StaticOrder S; S.init(g, G, (int)blockIdx.x);
        pg8::EpiX1 E{x, out, X1B, SSX1}; pg8::gemm_phase<pg8::EpiX1, pg8::StaticOrder, false>(ring, g, S, E);
    }
    SEAM(6);
    if (IN(7)) {
        pg8::Gemm g{X1B, WPQ, nullptr, nullptr, DM, DM, M_, 2048, DM, 1}; pg8::StaticOrder S; S.init(g, G, (int)blockIdx.x);
        pg8::EpiQP E{QP, SSX1}; pg8::gemm_phase<pg8::EpiQP, pg8::StaticOrder, true>(ring, g, S, E);
    }
    SEAM(7);
    if (IN(8)) {
        typedef short bf16x8_t __attribute__((ext_vector_type(8)));
        typedef float f32x16_t __attribute__((ext_vector_type(16)));
        const int r32 = lane & 31, hi = lane >> 5;
#define P8_SORTABLE(f) ({ const unsigned b_ = __float_as_uint(f); b_ ^ ((unsigned)((int)b_ >> 31) | 0x80000000u); })
#define P8_UNSORT(u) ({ const unsigned u_ = (u); __uint_as_float(u_ ^ (~(unsigned)((int)u_ >> 31) | 0x80000000u)); })
#define P8_CE(a, b) do { const unsigned hi_ = (a) > (b) ? (a) : (b), lo_ = (a) > (b) ? (b) : (a); (a) = hi_; (b) = lo_; } while (0)
#define P8_SORT16(x) do { P8_CE(x[0], x[1]); P8_CE(x[3], x[2]); P8_CE(x[4], x[5]); P8_CE(x[7], x[6]); P8_CE(x[8], x[9]); P8_CE(x[11], x[10]); P8_CE(x[12], x[13]); P8_CE(x[15], x[14]); P8_CE(x[0], x[2]); P8_CE(x[1], x[3]); P8_CE(x[6], x[4]); P8_CE(x[7], x[5]); P8_CE(x[8], x[10]); P8_CE(x[9], x[11]); P8_CE(x[14], x[12]); P8_CE(x[15], x[13]); P8_CE(x[0], x[1]); P8_CE(x[2], x[3]); P8_CE(x[5], x[4]); P8_CE(x[7], x[6]); P8_CE(x[8], x[9]); P8_CE(x[10], x[11]); P8_CE(x[13], x[12]); P8_CE(x[15], x[14]); P8_CE(x[0], x[4]); P8_CE(x[1], x[5]); P8_CE(x[2], x[6]); P8_CE(x[3], x[7]); P8_CE(x[12], x[8]); P8_CE(x[13], x[9]); P8_CE(x[14], x[10]); P8_CE(x[15], x[11]); P8_CE(x[0], x[2]); P8_CE(x[1], x[3]); P8_CE(x[4], x[6]); P8_CE(x[5], x[7]); P8_CE(x[10], x[8]); P8_CE(x[11], x[9]); P8_CE(x[14], x[12]); P8_CE(x[15], x[13]); P8_CE(x[0], x[1]); P8_CE(x[2], x[3]); P8_CE(x[4], x[5]); P8_CE(x[6], x[7]); P8_CE(x[9], x[8]); P8_CE(x[11], x[10]); P8_CE(x[13], x[12]); P8_CE(x[15], x[14]); P8_CE(x[0], x[8]); P8_CE(x[1], x[9]); P8_CE(x[2], x[10]); P8_CE(x[3], x[11]); P8_CE(x[4], x[12]); P8_CE(x[5], x[13]); P8_CE(x[6], x[14]); P8_CE(x[7], x[15]); P8_CE(x[0], x[4]); P8_CE(x[1], x[5]); P8_CE(x[2], x[6]); P8_CE(x[3], x[7]); P8_CE(x[8], x[12]); P8_CE(x[9], x[13]); P8_CE(x[10], x[14]); P8_CE(x[11], x[15]); P8_CE(x[0], x[2]); P8_CE(x[1], x[3]); P8_CE(x[4], x[6]); P8_CE(x[5], x[7]); P8_CE(x[8], x[10]); P8_CE(x[9], x[11]); P8_CE(x[12], x[14]); P8_CE(x[13], x[15]); P8_CE(x[0], x[1]); P8_CE(x[2], x[3]); P8_CE(x[4], x[5]); P8_CE(x[6], x[7]); P8_CE(x[8], x[9]); P8_CE(x[10], x[11]); P8_CE(x[12], x[13]); P8_CE(x[14], x[15]); } while (0)
#define P8_MERGE16(A, B, O) do { _Pragma("unroll") for (int i_ = 0; i_ < 16; ++i_) O[i_] = (A)[i_] > (B)[15 - i_] ? (A)[i_] : (B)[15 - i_]; \
        _Pragma("unroll") for (int s_ = 8; s_ >= 1; s_ >>= 1) _Pragma("unroll") for (int i_ = 0; i_ < 16; ++i_) if ((i_ & s_) == 0) P8_CE(O[i_], O[i_ + s_]); } while (0)
#define P8_INSERT(t, v) do { unsigned v_ = (v); _Pragma("unroll") for (int q_ = 0; q_ < 16; ++q_) { const unsigned a_ = t[q_] > v_ ? t[q_] : v_; v_ = t[q_] > v_ ? v_ : t[q_]; t[q_] = a_; } } while (0)
        for (int item = vcu; item < 256; item += G) {
            const int h = item & 7, tr = item >> 3;
            for (int c = tid; c < 2 * 128 * 16; c += 512) { const int p = c >> 11, row = (c >> 4) & 127, ch = c & 15;
                const u32x4 v = *(const u32x4*)(KEYS + ((size_t)(h * 2 + p) * 128 + row) * 128 + ch * 8);
                *(u32x4*)(lds + p * 32768 + row * 256 + ((ch * 16) ^ ((row & 7) << 4))) = v; }
            __syncthreads();
#pragma unroll 1
            for (int step = 0; step < 2; ++step) {
                const int m = tr * 512 + wave * 64 + step * 32 + r32;
                unsigned top[2][16];
#pragma unroll
                for (int p = 0; p < 2; ++p) {
                    bf16x8_t qf[8];
#pragma unroll
                    for (int ks = 0; ks < 8; ++ks) qf[ks] = *(const bf16x8_t*)(QP + (size_t)m * 2048 + (h * 2 + p) * 128 + ks * 16 + hi * 8);
                    f32x16_t acc[4];
#pragma unroll
                    for (int kt = 0; kt < 4; ++kt) { acc[kt] = f32x16_t{};
                        const int row = kt * 32 + r32; const unsigned char* rb = lds + p * 32768 + row * 256;
#pragma unroll
                        for (int ks = 0; ks < 8; ++ks) { const bf16x8_t a = *(const bf16x8_t*)(rb + (((2 * ks + hi) * 16) ^ ((row & 7) << 4)));
                            acc[kt] = __builtin_amdgcn_mfma_f32_32x32x16_bf16(a, qf[ks], acc[kt], 0, 0, 0); } }
                    unsigned xs[4][16];
#pragma unroll
                    for (int kt = 0; kt < 4; ++kt)
#pragma unroll
                        for (int r = 0; r < 16; ++r) { const unsigned base = 32 * kt + (r & 3) + 8 * (r >> 2);
                            xs[kt][r] = (P8_SORTABLE(acc[kt][r]) | 127u) ^ base; }
                    P8_SORT16(xs[0]); P8_SORT16(xs[1]); P8_SORT16(xs[2]); P8_SORT16(xs[3]);
                    unsigned m01[16], m23[16], t[16];
                    P8_MERGE16(xs[0], xs[1], m01); P8_MERGE16(xs[2], xs[3], m23); P8_MERGE16(m01, m23, t);
#pragma unroll
                    for (int i = 0; i < 16; ++i) t[i] ^= (unsigned)(hi << 2);
                    unsigned mm[16];
#pragma unroll
                    for (int i = 0; i < 16; ++i) { auto rr = __builtin_amdgcn_permlane32_swap(t[15 - i], t[15 - i], false, false); const unsigned pt = hi ? rr[0] : rr[1]; mm[i] = t[i] > pt ? t[i] : pt; }
#pragma unroll
                    for (int sft = 8; sft >= 1; sft >>= 1)
#pragma unroll
                        for (int i = 0; i < 16; ++i) if ((i & sft) == 0) { const unsigned a_ = mm[i] > mm[i + sft] ? mm[i] : mm[i + sft], b_ = mm[i] > mm[i + sft] ? mm[i + sft] : mm[i]; mm[i] = a_; mm[i + sft] = b_; }
#pragma unroll
                    for (int i = 0; i < 16; ++i) top[p][i] = mm[i];
                }
                float f0[16], f1[16];
#pragma unroll
                for (int i = 0; i < 16; ++i) { f0[i] = P8_UNSORT(top[0][i] & 0xFFFFFF80u); f1[i] = P8_UNSORT(top[1][i] & 0xFFFFFF80u); }
#define P8_CV(a, b) ((P8_SORTABLE(f0[a] + f1[b]) | 255u) ^ (unsigned)((a) * 16 + (b)))
                unsigned l0[16], x1[16], x2[16], x3[16], m1[16], m2[16], cb[16];
#pragma unroll
                for (int b = 0; b < 16; ++b) l0[b] = P8_CV(0, b);
#pragma unroll
                for (int b = 0; b < 8; ++b) x1[b] = P8_CV(1, b);
#pragma unroll
                for (int b = 0; b < 5; ++b) x1[8 + b] = P8_CV(2, b);
#pragma unroll
                for (int b = 0; b < 3; ++b) x1[13 + b] = P8_CV(3, b);
                x2[0] = P8_CV(3, 3);
#pragma unroll
                for (int b = 0; b < 3; ++b) x2[1 + b] = P8_CV(4, b);
#pragma unroll
                for (int b = 0; b < 2; ++b) { x2[4 + b] = P8_CV(5, b); x2[6 + b] = P8_CV(6, b); x2[8 + b] = P8_CV(7, b); }
                x2[10] = P8_CV(8, 0); x2[11] = P8_CV(9, 0); x2[12] = P8_CV(10, 0); x2[13] = P8_CV(11, 0); x2[14] = P8_CV(12, 0); x2[15] = P8_CV(13, 0);
                x3[0] = P8_CV(14, 0); x3[1] = P8_CV(15, 0);
#pragma unroll
                for (int i = 2; i < 16; ++i) x3[i] = 0u;
#undef P8_CV
                P8_SORT16(x1); P8_SORT16(x2);
                P8_MERGE16(l0, x1, m1); P8_MERGE16(x2, x3, m2); P8_MERGE16(m1, m2, cb);
                unsigned char* slot = lds + 65536 + wave * 2048 + lane * 32;
                { u32x4 w0, w1;
#define P8_IDX4(T, i) ((127u - (T[i] & 127u)) | ((127u - (T[(i) + 1] & 127u)) << 8) | ((127u - (T[(i) + 2] & 127u)) << 16) | ((127u - (T[(i) + 3] & 127u)) << 24))
                  w0.x = P8_IDX4(top[0], 0); w0.y = P8_IDX4(top[0], 4); w0.z = P8_IDX4(top[0], 8); w0.w = P8_IDX4(top[0], 12);
                  w1.x = P8_IDX4(top[1], 0); w1.y = P8_IDX4(top[1], 4); w1.z = P8_IDX4(top[1], 8); w1.w = P8_IDX4(top[1], 12);
#undef P8_IDX4
                  *(u32x4*)slot = w0; *(u32x4*)(slot + 16) = w1; }
                asm volatile("s_waitcnt lgkmcnt(0)" ::: "memory");
                float bv[16]; int be[16];
#pragma unroll
                for (int k = 0; k < 16; ++k) { const unsigned pos = (~cb[k]) & 255u; bv[k] = P8_UNSORT(cb[k] & 0xFFFFFF00u);
                    be[k] = (int)slot[pos >> 4] * 128 + (int)slot[16 + (pos & 15)]; }
                { const float b0 = bv[0];
#pragma unroll
                  for (int k = 0; k < 16; ++k) bv[k] = __expf(bv[k] - b0); }
                asm volatile("s_waitcnt lgkmcnt(0)" ::: "memory");
                if (hi == 0) { int* ep = EIDX + (size_t)m * 128 + 2 * h;
#pragma unroll
                    for (int kk = 0; kk < 8; ++kk) { u32x2 w; w.x = (unsigned)be[kk]; w.y = (unsigned)be[kk + 8]; *(u32x2*)(ep + kk * 16) = w; } }
                else { float* gp = EGATE + (size_t)m * 128 + 2 * h; float s2 = 0.f;
#pragma unroll
                    for (int k = 0; k < 16; ++k) s2 += bv[k];
                    const float inv = 1.f / s2;
#pragma unroll
                    for (int kk = 0; kk < 8; ++kk) { u32x2 w; w.x = __float_as_uint(bv[kk] * inv); w.y = __float_as_uint(bv[kk + 8] * inv); *(u32x2*)(gp + kk * 16) = w; } }
            }
            __syncthreads();
        }
#undef P8_SORTABLE
#undef P8_UNSORT
#undef P8_INSERT
#undef P8_CE
#undef P8_SORT16
#undef P8_MERGE16
    }
    SEAM(8);
#define UB(w, e) ((float)(((w) >> (8 * (e))) & 0xffu))
#define DPP_ADD(v, ctrl) v += __builtin_bit_cast(float, __builtin_amdgcn_update_dpp(0, __builtin_bit_cast(int, v), (ctrl), 0xf, 0xf, false))
    volatile unsigned* MISCW = (volatile unsigned*)(lds + MISC_OFF);
    const int x_nloc = (MK_N_LAUNCHES == 1) ? (int)MISCW[8] : G, x_nx = (MK_N_LAUNCHES == 1) ? (int)MISCW[9] : 1, x_rank = (MK_N_LAUNCHES == 1) ? (int)MISCW[10] : (int)blockIdx.x, x_ord = (MK_N_LAUNCHES == 1) ? (int)MISCW[11] : 0;
    if (IN(9)) {
        const int g = lane >> 3, c = lane & 7;
        const int tstep = x_nloc * NWAVES;
        for (int sl = x_ord; sl < 8; sl += x_nx) {
            const unsigned char* ub = UT + (size_t)sl * (16384 * 128) + 16 * c;
            const bf16_t* xbase = X1B + sl * 128 + 16 * c;
#define P9_IDX(I4, XA, XB, tt) do { const int t_ = (tt) < M_ ? (tt) : M_ - 1; const u32x4* ep_ = (const u32x4*)(EIDX + (size_t)t_ * 128 + g * 16); \
            I4[0] = ep_[0]; I4[1] = ep_[1]; I4[2] = ep_[2]; I4[3] = ep_[3]; XA = *(const u32x4*)(xbase + (size_t)t_ * DM); XB = *(const u32x4*)(xbase + (size_t)t_ * DM + 8); } while (0)
#define P9_ROWS(U, I4, hf) do { _Pragma("unroll") for (int i = 0; i < 8; ++i) U[i] = *(const u32x4*)(ub + (size_t)I4[2 * (hf) + (i >> 2)][i & 3] * 128); } while (0)
#define P9_HALF(U, hf) do { _Pragma("unroll") for (int i = 0; i < 8; ++i) { int a = __builtin_amdgcn_sdot4((int)xq[0], (int)U[i][0], 0, false); a = __builtin_amdgcn_sdot4((int)xq[1], (int)U[i][1], a, false); \
                a = __builtin_amdgcn_sdot4((int)xq[2], (int)U[i][2], a, false); a = __builtin_amdgcn_sdot4((int)xq[3], (int)U[i][3], a, false); \
                a += __builtin_amdgcn_update_dpp(0, a, 0xB1, 0xf, 0xf, false); a += __builtin_amdgcn_update_dpp(0, a, 0x4E, 0xf, 0xf, false); a += __builtin_amdgcn_update_dpp(0, a, 0x141, 0xf, 0xf, false); \
                z0 = (8 * (hf) + i == 2 * c) ? a : z0; z1 = (8 * (hf) + i == 2 * c + 1) ? a : z1; } } while (0)
            u32x4 iC[4], iN[4], iNN[4], xaC, xbC, xaN, xbN, xaNN, xbNN, uA[8], uB[8];
            int t = x_rank * NWAVES + wave;
            P9_IDX(iC, xaC, xbC, t); P9_IDX(iN, xaN, xbN, t + tstep); P9_ROWS(uA, iC, 0);
            for (; t < M_; t += tstep) {
                P9_ROWS(uB, iC, 1); P9_IDX(iNN, xaNN, xbNN, t + 2 * tstep);
                float xf[16];
#pragma unroll
                for (int q = 0; q < 4; ++q) { xf[2 * q] = __uint_as_float(xaC[q] << 16); xf[2 * q + 1] = __uint_as_float(xaC[q] & 0xffff0000u); xf[8 + 2 * q] = __uint_as_float(xbC[q] << 16); xf[8 + 2 * q + 1] = __uint_as_float(xbC[q] & 0xffff0000u); }
                float mx = 1e-30f;
#pragma unroll
                for (int j = 0; j < 16; ++j) mx = fmaxf(mx, fabsf(xf[j]));
                mx = fmaxf(mx, __builtin_bit_cast(float, __builtin_amdgcn_update_dpp(0, __builtin_bit_cast(int, mx), 0xB1, 0xf, 0xf, false)));
                mx = fmaxf(mx, __builtin_bit_cast(float, __builtin_amdgcn_update_dpp(0, __builtin_bit_cast(int, mx), 0x4E, 0xf, 0xf, false)));
                mx = fmaxf(mx, __builtin_bit_cast(float, __builtin_amdgcn_update_dpp(0, __builtin_bit_cast(int, mx), 0x141, 0xf, 0xf, false)));
                const float xinv = 127.f * __builtin_amdgcn_rcpf(mx), xsc = mx * (1.f / 127.f);
                unsigned xq[4];
#pragma unroll
                for (int q = 0; q < 4; ++q) { unsigned b = 0;
#pragma unroll
                    for (int e = 0; e < 4; ++e) { const int qi = (int)rintf(xf[4 * q + e] * xinv); b |= ((unsigned)qi & 0xffu) << (8 * e); }
                    xq[q] = b; }
                int z0 = 0, z1 = 0;
                P9_HALF(uA, 0);
                P9_ROWS(uA, iN, 0);
                P9_HALF(uB, 1);
                { u32x2 w; w.x = __float_as_uint((float)z0 * xsc); w.y = __float_as_uint((float)z1 * xsc); *(u32x2*)(ZP + ((size_t)sl * M_ + t) * 128 + g * 16 + 2 * c) = w; }
#pragma unroll
                for (int q = 0; q < 4; ++q) { iC[q] = iN[q]; iN[q] = iNN[q]; }
                xaC = xaN; xbC = xbN; xaN = xaNN; xbN = xbNN;
            }
#undef P9_HALF
#undef P9_IDX
#undef P9_ROWS
        }
    }
    SEAM(9);
    if (IN(10)) {
        for (int t = gw; t < M_; t += NGW) { const float r = rsqrtf(SSX1[t] * (1.f / DM) + EPS); float av[2]; float mx = 1e-30f;
#pragma unroll
            for (int v = 0; v < 2; ++v) { const int p = lane + 64 * v; const int e = EIDX[(size_t)t * 128 + p]; float zs[8];
#pragma unroll
                for (int j = 0; j < 8; ++j) zs[j] = ZP[((size_t)j * M_ + t) * 128 + p];
                float z = ((zs[0] + zs[1]) + (zs[2] + zs[3])) + ((zs[4] + zs[5]) + (zs[6] + zs[7]));
                z *= SU[e] * r;
                av[v] = 0.5f * z * (1.f + erff(z * 0.70710678118654752f)) * EGATE[(size_t)t * 128 + p] * SV[e];
                mx = fmaxf(mx, fabsf(av[v])); }
#pragma unroll
            for (int o = 1; o < 64; o <<= 1) mx = fmaxf(mx, __shfl_xor(mx, o));
            const float inv = 127.f / mx;
            CQ[(size_t)t * 128 + lane] = (signed char)(int)rintf(av[0] * inv); CQ[(size_t)t * 128 + 64 + lane] = (signed char)(int)rintf(av[1] * inv);
            if (lane == 0) CS[t] = mx * (1.f / 127.f); }
    }
    SEAM(10);
    if (IN(11)) {
        const int g = lane >> 3, c = lane & 7;
        const int tstep = x_nloc * NWAVES;
        for (int sl = x_ord; sl < 8; sl += x_nx) {
            const unsigned char* vb = VT + (size_t)sl * (16384 * 128) + 16 * c;
#define P11_IDX(I4, C4, tt) do { const int t_ = (tt) < M_ ? (tt) : M_ - 1; const u32x4* ep_ = (const u32x4*)(EIDX + (size_t)t_ * 128 + g * 16); \
            I4[0] = ep_[0]; I4[1] = ep_[1]; I4[2] = ep_[2]; I4[3] = ep_[3]; C4 = *(const u32x4*)(CQ + (size_t)t_ * 128 + g * 16); } while (0)
#define P11_ROWS(U, I4, hf) do { _Pragma("unroll") for (int i = 0; i < 8; ++i) U[i] = *(const u32x4*)(vb + (size_t)I4[2 * (hf) + (i >> 2)][i & 3] * 128); } while (0)
#define P11_BLK(U, b0, q, CW) do { const unsigned d0_ = U[b0][q], d1_ = U[(b0) + 1][q], d2_ = U[(b0) + 2][q], d3_ = U[(b0) + 3][q]; \
            const unsigned t0_ = __builtin_amdgcn_perm(d1_, d0_, 0x05010400u), t1_ = __builtin_amdgcn_perm(d1_, d0_, 0x07030602u), t2_ = __builtin_amdgcn_perm(d3_, d2_, 0x05010400u), t3_ = __builtin_amdgcn_perm(d3_, d2_, 0x07030602u); \
            acc[4 * (q)] = __builtin_amdgcn_sdot4((int)__builtin_amdgcn_perm(t2_, t0_, 0x05040100u), (int)(CW), acc[4 * (q)], false); \
            acc[4 * (q) + 1] = __builtin_amdgcn_sdot4((int)__builtin_amdgcn_perm(t2_, t0_, 0x07060302u), (int)(CW), acc[4 * (q) + 1], false); \
            acc[4 * (q) + 2] = __builtin_amdgcn_sdot4((int)__builtin_amdgcn_perm(t3_, t1_, 0x05040100u), (int)(CW), acc[4 * (q) + 2], false); \
            acc[4 * (q) + 3] = __builtin_amdgcn_sdot4((int)__builtin_amdgcn_perm(t3_, t1_, 0x07060302u), (int)(CW), acc[4 * (q) + 3], false); } while (0)
#define P11_HALF(U, C4, hf) do { _Pragma("unroll") for (int bb = 0; bb < 2; ++bb) { const unsigned cw_ = C4[2 * (hf) + bb]; \
            _Pragma("unroll") for (int q = 0; q < 4; ++q) P11_BLK(U, 4 * bb, q, cw_); } } while (0)
            u32x4 iC[4], iN[4], iNN[4], uA[8], uB[8], cC, cN, cNN;
            const int hi5 = lane >> 5, b3 = (lane >> 3) & 1;
            int t = x_rank * NWAVES + wave;
            P11_IDX(iC, cC, t); P11_IDX(iN, cN, t + tstep); P11_ROWS(uA, iC, 0);
            for (; t < M_; t += tstep) {
                float* op = out + (size_t)t * DM + sl * 128 + 16 * c + 4 * b3 + 8 * hi5;
                const f32x4 x1v = *(const f32x4*)op; const float cs = CS[t];
                P11_ROWS(uB, iC, 1); P11_IDX(iNN, cNN, t + 2 * tstep);
                int acc[16];
#pragma unroll
                for (int j = 0; j < 16; ++j) acc[j] = 0;
                P11_HALF(uA, cC, 0);
                P11_ROWS(uA, iN, 0);
                P11_HALF(uB, cC, 1);
                int w8[8];
#pragma unroll
                for (int j = 0; j < 8; ++j) { auto rr = __builtin_amdgcn_permlane32_swap((unsigned)acc[j], (unsigned)acc[j + 8], false, false); w8[j] = (int)rr[0] + (int)rr[1]; }
#pragma unroll
                for (int j = 0; j < 8; ++j) w8[j] += __shfl_xor(w8[j], 16);
                f32x4 o; float ss = 0.f;
#pragma unroll
                for (int j = 0; j < 4; ++j) { const int keep = b3 ? w8[j + 4] : w8[j]; const int give = b3 ? w8[j] : w8[j + 4];
                    const int tot = keep + __builtin_amdgcn_update_dpp(0, give, 0x128, 0xf, 0xf, false);
                    o[j] = x1v[j] + (float)tot * cs; ss += o[j] * o[j]; }
                if (((lane >> 4) & 1) == 0) *(f32x4*)op = o;
                DPP_ADD(ss, 0x128); DPP_ADD(ss, 0x124); DPP_ADD(ss, 0x122); DPP_ADD(ss, 0x121);
                { const float s0 = __builtin_bit_cast(float, __builtin_amdgcn_readlane(__builtin_bit_cast(int, ss), 0)), s1 = __builtin_bit_cast(float, __builtin_amdgcn_readlane(__builtin_bit_cast(int, ss), 32));
                  if (lane == 0) atomicAdd(SS2 + t, s0 + s1); }
#pragma unroll
                for (int q = 0; q < 4; ++q) { iC[q] = iN[q]; iN[q] = iNN[q]; }
                cC = cN; cN = cNN;
            }
#undef P11_BLK
#undef P11_HALF
#undef P11_IDX
#undef P11_ROWS
        }
    }
    SEAM(11);
    if (IN(12)) {
        for (int m = gw; m < M_; m += NGW) { const float r2 = rsqrtf(SS2[m] * (1.f / DM) + EPS); float* orow = out + (size_t)m * DM;
#pragma unroll
            for (int j = 0; j < 4; ++j) { const int cix = 4 * (lane + 64 * j); const f32x4 gg = *(const f32x4*)(g_final + cix); f32x4 o = *(const f32x4*)(orow + cix);
                o[0] *= r2 * gg[0]; o[1] *= r2 * gg[1]; o[2] *= r2 * gg[2]; o[3] *= r2 * gg[3]; *(f32x4*)(orow + cix) = o; } }
    }
#undef UB
#undef DPP_ADD
#undef IN
#undef SEAM
}

extern "C" void kernel_launch(void* const* d_in, const int* in_sizes, int n_in, void* d_out, int out_size, void* d_ws, size_t ws_size, hipStream_t stream) {
    static int grid = 0;
    if (grid == 0) {
        if (n_in != 20 || out_size != M_ * DM || ws_size < WS_END) { fprintf(stderr, "kernel_launch: unexpected shapes (n_in %d out %d ws %zu); nothing launched\n", n_in, out_size, ws_size); grid = -1; return; }
        int dev = 0, cus = 0;
        if (hipGetDevice(&dev) != hipSuccess || hipDeviceGetAttribute(&cus, hipDeviceAttributeMultiprocessorCount, dev) != hipSuccess) { grid = -1; return; }
        if (hipFuncSetAttribute((const void*)fwd, hipFuncAttributeMaxDynamicSharedMemorySize, LDS_BYTES) != hipSuccess) { fprintf(stderr, "kernel_launch: hipFuncSetAttribute failed\n"); grid = -1; return; }
        int per_cu = 0;
        if (hipOccupancyMaxActiveBlocksPerMultiprocessor(&per_cu, (const void*)fwd, NWAVES * 64, LDS_BYTES) != hipSuccess || per_cu < 1) fprintf(stderr, "kernel_launch: occupancy query reports %d\n", per_cu);
        (void)hipGetLastError();
        grid = cus;
    }
    if (grid < 0) return;
    (void)hipMemsetAsync((char*)d_ws + WS_CTL, 0, CTL_ZERO_BYTES, stream);
    Args a; memset(&a, 0, sizeof(a));
    for (int i = 0; i < 20; ++i) a.in[i] = d_in[i];
    a.out = (float*)d_out; a.ws = (unsigned char*)d_ws;
    if (MK_N_LAUNCHES == 1) { a.ph_lo = 0; a.ph_hi = N_PHASES; hipLaunchKernelGGL(fwd, dim3(grid), dim3(NWAVES * 64), LDS_BYTES, stream, a); }
    else for (int p = 0; p < N_PHASES; ++p) { a.ph_lo = p; a.ph_hi = p + 1; hipLaunchKernelGGL(fwd, dim3(grid), dim3(NWAVES * 64), LDS_BYTES, stream, a); }
}
```

```cpp
#include <hip/hip_runtime.h>
#include <cstdio>
#include <cstdint>
#include <cstring>
#include <math.h>

#ifndef MK_N_LAUNCHES
#define MK_N_LAUNCHES 1
#endif
constexpr int N_PHASES = 13;

typedef unsigned short bf16_t;
constexpr int SEQ = 8192, DM = 1024, M_ = 16384, NCH = 128;
constexpr float EPS = 1e-6f;
constexpr int PB_LD = 2816, PA_LD = 1536;
constexpr int PB_BR = 0, PB_GOUT = 2048, PB_GQ = 2560;
constexpr int PA_GV = 0, PA_GK = 512, PA_QLAT = 768, PA_KVLAT = 1152, PA_KROPE = 1408, PA_GLR = 1440;
constexpr int NPROJ = 4352;
constexpr float CQ = 0.10206207261596577f * 1.4426950408889634f;

constexpr size_t MiB = 1u << 20;
constexpr size_t WS_CTL = 0, CTL_ZERO_BYTES = 256 * 1024;
constexpr size_t WS_SSQ = 1 * MiB, WS_SSKV = WS_SSQ + 65536, WS_SSX1 = WS_SSKV + 65536, WS_SS2 = WS_SSX1 + 65536, WS_C128 = WS_SS2 + 65536  , WS_CB = 136 * MiB  , WS_ZP = 56 * MiB  , WS_COS = 2 * MiB, WS_SIN = 3 * MiB;
constexpr size_t WS_DECAY = 1 * MiB + 512 * 1024;
constexpr size_t WS_WIN = 4 * MiB, WS_WQB = 13 * MiB, WS_WKVB = 14 * MiB, WS_WA = 15 * MiB, WS_WB = 16 * MiB, WS_WOUT = 17 * MiB, WS_WPQ = 19 * MiB, WS_KEYS = 23 * MiB;
constexpr size_t WS_PROJB = 24 * MiB, WS_PROJA = 112 * MiB, WS_XN = 160 * MiB, WS_Q = 160 * MiB, WS_K = 184 * MiB, WS_V = 208 * MiB, WS_DST = 224 * MiB;
constexpr size_t WS_YA = 112 * MiB, WS_YB = 128 * MiB, WS_MERGED = 160 * MiB, WS_X1B = 24 * MiB, WS_QP = 56 * MiB, WS_EIDX = 120 * MiB, WS_EGATE = 128 * MiB;
constexpr size_t WS_KPE = 208 * MiB  , WS_UT = 224 * MiB, WS_VT = 240 * MiB, WS_SU = 1 * MiB + 768 * 1024, WS_SV = WS_SU + 65536;
constexpr size_t WS_END = 256 * MiB;

#define GAS __attribute__((address_space(1)))
#define LAS __attribute__((address_space(3)))
typedef float f32x4 __attribute__((ext_vector_type(4)));
typedef unsigned u32x4 __attribute__((ext_vector_type(4)));
typedef unsigned u32x2 __attribute__((ext_vector_type(2)));

__device__ __forceinline__ float bf2f(bf16_t h) { return __uint_as_float(((unsigned)h) << 16); }
__device__ __forceinline__ unsigned f2bf_u(float f) { unsigned u = __float_as_uint(f); return (u + 0x7fffu + ((u >> 16) & 1u)) >> 16; }
__device__ __forceinline__ bf16_t f2bf(float f) { return (bf16_t)f2bf_u(f); }
__device__ __forceinline__ unsigned pk2(float lo, float hi) { return f2bf_u(lo) | (f2bf_u(hi) << 16); }
__device__ __forceinline__ float wave_sum(float v) {
#pragma unroll
    for (int o = 1; o < 64; o <<= 1) v += __shfl_xor(v, o);
    return v;
}
__device__ __forceinline__ float sigmoidf_(float x) { return 1.f / (1.f + __expf(-x)); }

namespace pg8 {
#define PG8_LAS __attribute__((address_space(3)))
typedef short bf16x8 __attribute__((ext_vector_type(8)));
constexpr int BM = 256, BK = 64, HALF = 128, HTB = HALF * BK * 2, STAGE_BYTES = 8 * HTB, NXCD = 8, WGM = 8;
__host__ __device__ __forceinline__ int lds_byte(int r, int c) { const int st = (r >> 4) * 2 + (c >> 5), rr = r & 15, cc = c & 31, ob = rr * 64 + cc * 2; return st * 1024 + (ob ^ (((ob >> 9) & 1) << 5)); }
__host__ __device__ __forceinline__ void stage_rc(int b, int& R, int& C) { const int st = b / 1024, sb = b % 1024, swz = sb ^ (((sb >> 9) & 1) << 5); R = (st >> 1) * 16 + swz / 64; C = (st & 1) * 32 + (swz % 64) / 2; }
__host__ __device__ __forceinline__ int perm32(int rho) { const int n = rho >> 4, i = rho & 15; return 8 * (i >> 2) + 4 * n + (i & 3); }

struct Unit { int pm, pn, sub; const char* A; const char* B; };
struct Gemm { const bf16_t* A; const bf16_t* Bt; const bf16_t* A2; const bf16_t* Bt2; int lda, ldb, M, N, K, chain; };
struct StaticOrder {
    int nM, nN, nwg, G, c, chain; const char *A, *B, *A2, *B2; size_t tsA, tsB;
    __device__ __forceinline__ void init(const Gemm& g, int G_, int c_) { nM = g.M / BM; nN = g.N / BM; nwg = nM * nN; G = G_; c = c_; chain = g.chain; A = (const char*)g.A; B = (const char*)g.Bt; A2 = (const char*)g.A2; B2 = (const char*)g.Bt2;
        tsA = (size_t)BM * g.lda * 2; tsB = (size_t)BM * g.ldb * 2; }
    int pair_mode = 0;
    __device__ __forceinline__ bool next(int i, Unit& u) const {
        if (pair_mode) { const int item = c + (i >> 1) * G; if (item >= nwg / 2) return false; u.pm = 2 * (item >> 3) + (i & 1); u.pn = item & 7; u.sub = 0; u.A = A + (size_t)u.pm * tsA; u.B = B + (size_t)u.pn * tsB; return true; }
        const int r = (chain == 2) ? (i >> 1) : i, sub = (chain == 2) ? (i & 1) : 0;
        const long L = (long)r * G + c; if (L >= nwg) return false;
        int wgid = (int)L; { const int q = nwg / NXCD, rr = nwg % NXCD, xcd = wgid % NXCD, off = wgid / NXCD; wgid = (xcd < rr ? xcd * (q + 1) : rr * (q + 1) + (xcd - rr) * q) + off; }
        const int nig = WGM * nN, gid = wgid / nig, fm = gid * WGM, gsz = (nM - fm) < WGM ? (nM - fm) : WGM;
        u.pm = fm + ((wgid % nig) % gsz); u.pn = (wgid % nig) / gsz; u.sub = sub;
        u.A = (sub ? A2 : A) + (size_t)u.pm * tsA; u.B = (sub ? B2 : B) + (size_t)u.pn * tsB; return true;
    }
};
__device__ __forceinline__ unsigned cvt_pk_bf16(float lo, float hi) { unsigned r; asm volatile("v_cvt_pk_bf16_f32 %0, %1, %2" : "=v"(r) : "v"(lo), "v"(hi)); return r; }

typedef f32x4 AccT[2][2][4][2];
template <class Epi, class Sched, bool ALIGN_EPI>
__device__ __forceinline__ void gemm_phase(PG8_LAS unsigned char* lds, const Gemm g, const Sched& S, const Epi& E) {
    const int tid = threadIdx.x, wid = __builtin_amdgcn_readfirstlane(tid >> 6), lane = tid & 63, wr = wid >> 2, wc = wid & 3, fr = lane & 15, fq = lane >> 4;
    const int K = g.K, nt = K / BK;
    unsigned voffA[2], voffB[2];
#pragma unroll
    for (int i = 0; i < 2; ++i) { int R, C; stage_rc(tid * 16 + i * 8192, R, C); const int Rb = Epi::PERM ? ((R & ~31) + perm32(R & 31)) : R;
        voffA[i] = (unsigned)(R * g.lda + C) * 2u; voffB[i] = (unsigned)(Rb * g.ldb + C) * 2u; }
    const size_t kstep = (size_t)(BK * 2);
    const size_t hsA = (size_t)HALF * g.lda * 2, hsB = (size_t)HALF * g.ldb * 2;
    const unsigned ldsw = (unsigned)wid * 1024u;
    const int aoff = lds_byte(wr * 64 + fr, fq * 8), boff = lds_byte(wc * 32 + fr, fq * 8);
#define PG8_SA(b, h) (((b) * 2 + (h)) * HTB)
#define PG8_SB(b, h) ((4 + (b) * 2 + (h)) * HTB)
#define PG8_STAGE(bufoff, gbase, voff) do { _Pragma("unroll") for (int _i = 0; _i < 2; ++_i) \
        __builtin_amdgcn_global_load_lds((const unsigned*)((const char*)(gbase) + (voff)[_i]), (PG8_LAS unsigned*)(lds + (bufoff) + ldsw + _i * 8192), 16, 0, 0); } while (0)
#define PG8_LDA(dst, b, h) do { _Pragma("unroll") for (int m = 0; m < 4; ++m) _Pragma("unroll") for (int k = 0; k < 2; ++k) dst[m][k] = *(const PG8_LAS bf16x8*)(lds + PG8_SA(b, h) + aoff + m * 2048 + k * 1024); } while (0)
#define PG8_LDB(dst, b, h) do { _Pragma("unroll") for (int n = 0; n < 2; ++n) _Pragma("unroll") for (int k = 0; k < 2; ++k) dst[n][k] = *(const PG8_LAS bf16x8*)(lds + PG8_SB(b, h) + boff + n * 2048 + k * 1024); } while (0)
#define PG8_MMA(ai, bj, At, Bt) do { __builtin_amdgcn_s_setprio(1); _Pragma("unroll") for (int m = 0; m < 4; ++m) _Pragma("unroll") for (int n = 0; n < 2; ++n) _Pragma("unroll") for (int k = 0; k < 2; ++k) \
        acc[ai][bj][m][n] = __builtin_amdgcn_mfma_f32_16x16x32_bf16(Bt[n][k], At[m][k], acc[ai][bj][m][n], 0, 0, 0); __builtin_amdgcn_s_setprio(0); } while (0)
#define PG8_WAIT_V(n) asm volatile("s_waitcnt vmcnt(" #n ")" ::: "memory")
#define PG8_WAIT_L(n) asm volatile("s_waitcnt lgkmcnt(" #n ")" ::: "memory")
#define PG8_BAR __builtin_amdgcn_s_barrier()
#define PG8_SCHED __builtin_amdgcn_sched_barrier(0)
    Unit cur, nxt; int ui = 0;
    if (!S.next(0, cur)) return;
    f32x4 acc[2][2][4][2];
#pragma unroll
    for (int a = 0; a < 2; ++a)
#pragma unroll
        for (int b = 0; b < 2; ++b)
#pragma unroll
            for (int m = 0; m < 4; ++m)
#pragma unroll
                for (int n = 0; n < 2; ++n) acc[a][b][m][n] = (f32x4){0.f, 0.f, 0.f, 0.f};
    bf16x8 At[4][2], B0[2][2], B1[2][2];
    const char* cA = cur.A; const char* cB = cur.B;
    PG8_STAGE(PG8_SB(0, 0), cB, voffB); PG8_STAGE(PG8_SB(0, 1), cB + hsB, voffB); PG8_STAGE(PG8_SA(0, 0), cA, voffA); PG8_STAGE(PG8_SA(0, 1), cA + hsA, voffA);
    if (wr == 1) PG8_BAR;
    PG8_WAIT_V(2); PG8_BAR;
    PG8_STAGE(PG8_SB(1, 0), cB + kstep, voffB); PG8_STAGE(PG8_SA(1, 0), cA + kstep, voffA); PG8_STAGE(PG8_SB(1, 1), cB + hsB + kstep, voffB);
    PG8_WAIT_V(6); PG8_BAR;
    for (;;) {
        const bool has_next = S.next(ui + 1, nxt);
        const char* nA = has_next ? nxt.A : cA; const char* nB = has_next ? nxt.B : cB;
        for (int t = 0; t < nt; t += 2) {
            const bool last = (t == nt - 2);
            const char* a1 = cA + (size_t)(t + 1) * kstep;
            const char* a2 = last ? nA : cA + (size_t)(t + 2) * kstep; const char* b2 = last ? nB : cB + (size_t)(t + 2) * kstep;
            const char* a3 = a2 + kstep; const char* b3 = b2 + kstep;
            PG8_LDB(B0, 0, 0); PG8_LDB(B1, 0, 1); PG8_SCHED; PG8_LDA(At, 0, 0); PG8_STAGE(PG8_SA(1, 1), a1 + hsA, voffA);
            PG8_WAIT_V(8); PG8_WAIT_L(0); PG8_BAR; PG8_MMA(0, 0, At, B0); PG8_MMA(0, 1, At, B1); PG8_BAR; PG8_SCHED;
            PG8_LDA(At, 0, 1); PG8_STAGE(PG8_SB(0, 0), b2, voffB); PG8_STAGE(PG8_SB(0, 1), b2 + hsB, voffB); PG8_STAGE(PG8_SA(0, 0), a2, voffA);
            PG8_WAIT_V(8); PG8_WAIT_L(0); PG8_BAR; PG8_MMA(1, 0, At, B0); PG8_MMA(1, 1, At, B1); PG8_BAR; PG8_SCHED;
            PG8_LDB(B0, 1, 0); PG8_LDB(B1, 1, 1); PG8_SCHED; PG8_LDA(At, 1, 0); PG8_STAGE(PG8_SA(0, 1), a2 + hsA, voffA);
            PG8_WAIT_V(8); PG8_WAIT_L(0); PG8_BAR; PG8_MMA(0, 0, At, B0); PG8_MMA(0, 1, At, B1); PG8_BAR; PG8_SCHED;
            PG8_LDA(At, 1, 1); PG8_STAGE(PG8_SB(1, 0), b3, voffB); PG8_STAGE(PG8_SB(1, 1), b3 + hsB, voffB); PG8_STAGE(PG8_SA(1, 0), a3, voffA);
            PG8_WAIT_V(8); PG8_WAIT_L(0); PG8_BAR; PG8_MMA(1, 0, At, B0); PG8_MMA(1, 1, At, B1); PG8_BAR; PG8_SCHED;
        }
        if constexpr (ALIGN_EPI) { if (wr == 0) PG8_BAR; }
        E(acc, cur, wr, wc, fr, fq);
        if (!has_next) break;
        if (!(Epi::CHAIN && nxt.sub != 0)) {
#pragma unroll
            for (int a = 0; a < 2; ++a)
#pragma unroll
                for (int b = 0; b < 2; ++b)
#pragma unroll
                    for (int m = 0; m < 4; ++m)
#pragma unroll
                        for (int n = 0; n < 2; ++n) acc[a][b][m][n] = (f32x4){0.f, 0.f, 0.f, 0.f};
        }
        cur = nxt; cA = nA; cB = nB; ++ui;
        if constexpr (ALIGN_EPI) { if (wr == 1) PG8_BAR; }
    }
    PG8_WAIT_V(0);
    if constexpr (!ALIGN_EPI) { if (wr == 0) PG8_BAR; }
    PG8_BAR;
#undef PG8_SA
#undef PG8_SB
#undef PG8_STAGE
#undef PG8_LDA
#undef PG8_LDB
#undef PG8_MMA
#undef PG8_WAIT_V
#undef PG8_WAIT_L
#undef PG8_BAR
#undef PG8_SCHED
}

struct EpiProj {
    static constexpr bool PERM = true, CHAIN = false;
    bf16_t* pb; bf16_t* pa; float* ssq; float* sskv;
    __device__ __forceinline__ void operator()(AccT& acc, const Unit& u, int wr, int wc, int fr, int fq) const {
        const int row0 = u.pm * BM + wr * 64 + fr;
#pragma unroll
        for (int bj = 0; bj < 2; ++bj) {
            const int hk = u.pn * 2 + bj;
            bf16_t* base; int ld; float* ss = nullptr;
            if (hk < 22) { base = pb + hk * 128; ld = PB_LD; } else { const int ha = hk - 22; base = pa + ha * 128; ld = PA_LD; if (ha >= 6 && ha <= 8) ss = ssq; else if (ha == 9 || ha == 10) ss = sskv; }
            base += wc * 32 + 8 * fq;
#pragma unroll
            for (int ai = 0; ai < 2; ++ai)
#pragma unroll
                for (int m = 0; m < 4; ++m) { const int row = row0 + ai * HALF + m * 16; const f32x4 v0 = acc[ai][bj][m][0], v1 = acc[ai][bj][m][1];
                    u32x4 w; w.x = cvt_pk_bf16(v0[0], v0[1]); w.y = cvt_pk_bf16(v0[2], v0[3]); w.z = cvt_pk_bf16(v1[0], v1[1]); w.w = cvt_pk_bf16(v1[2], v1[3]);
                    *(u32x4*)(base + (size_t)row * ld) = w;
                    if (ss) { float s = (v0[0] * v0[0] + v0[1] * v0[1]) + (v0[2] * v0[2] + v0[3] * v0[3]) + (v1[0] * v1[0] + v1[1] * v1[1]) + (v1[2] * v1[2] + v1[3] * v1[3]);
                        s += __shfl_xor(s, 16); s += __shfl_xor(s, 32); if (fq == 0) atomicAdd(ss + row, s); } }
        }
    }
};
struct EpiQ {
    static constexpr bool PERM = false, CHAIN = false;
    bf16_t* Q; const float* ssq; const float* cs; const float* sn;
    __device__ __forceinline__ void operator()(AccT& acc, const Unit& u, int wr, int wc, int fr, int fq) const {
        const int row0 = u.pm * BM + wr * 64 + fr;
#pragma unroll
        for (int ai = 0; ai < 2; ++ai)
#pragma unroll
            for (int m = 0; m < 4; ++m) { const int row = row0 + ai * HALF + m * 16; const float rr = rsqrtf(ssq[row] * (1.f / 384.f) + EPS) * CQ;
#pragma unroll
                for (int bj = 0; bj < 2; ++bj) { const int G = u.pn * 8 + bj * 4 + wc;
                    f32x4 x0 = acc[ai][bj][m][0], x1 = acc[ai][bj][m][1];
                    if (G % 3 == 2) { const f32x4 c = *(const f32x4*)(cs + (size_t)row * 16 + 4 * fq), s = *(const f32x4*)(sn + (size_t)row * 16 + 4 * fq);
                        const f32x4 o0 = x0 * c - x1 * s, o1 = x1 * c + x0 * s; x0 = o0; x1 = o1; }
                    x0 = x0 * rr; x1 = x1 * rr;
                    bf16_t* p = Q + (size_t)row * 768 + G * 32 + 4 * fq;
                    u32x2 w0, w1; w0.x = cvt_pk_bf16(x0[0], x0[1]); w0.y = cvt_pk_bf16(x0[2], x0[3]); w1.x = cvt_pk_bf16(x1[0], x1[1]); w1.y = cvt_pk_bf16(x1[2], x1[3]);
                    *(u32x2*)p = w0; *(u32x2*)(p + 16) = w1; } }
    }
};
struct EpiKV {
    static constexpr bool PERM = true, CHAIN = false;
    bf16_t* Kb; bf16_t* Vb; const float* sskv;
    __device__ __forceinline__ void operator()(AccT& acc, const Unit& u, int wr, int wc, int fr, int fq) const {
        const int row0 = u.pm * BM + wr * 64 + fr;
#pragma unroll
        for (int ai = 0; ai < 2; ++ai)
#pragma unroll
            for (int m = 0; m < 4; ++m) { const int row = row0 + ai * HALF + m * 16; const float rr = rsqrtf(sskv[row] * (1.f / 256.f) + EPS);
#pragma unroll
                for (int bj = 0; bj < 2; ++bj) { const int head = u.pn * 2 + bj; const f32x4 v0 = acc[ai][bj][m][0] * rr, v1 = acc[ai][bj][m][1] * rr;
                    u32x4 w; w.x = cvt_pk_bf16(v0[0], v0[1]); w.y = cvt_pk_bf16(v0[2], v0[3]); w.z = cvt_pk_bf16(v1[0], v1[1]); w.w = cvt_pk_bf16(v1[2], v1[3]);
                    bf16_t* p = (wc < 2) ? Kb + (size_t)row * 768 + head * 96 + wc * 32 + 8 * fq : Vb + (size_t)row * 512 + head * 64 + (wc - 2) * 32 + 8 * fq;
                    *(u32x4*)p = w; } }
    }
};
struct EpiMerge {
    static constexpr bool PERM = true, CHAIN = true;
    const bf16_t* pb; bf16_t* merged;
    __device__ __forceinline__ void operator()(AccT& acc, const Unit& u, int wr, int wc, int fr, int fq) const {
        const int row0 = u.pm * BM + wr * 64 + fr, col0 = u.pn * BM + wc * 32 + 8 * fq;
#pragma unroll
        for (int ai = 0; ai < 2; ++ai)
#pragma unroll
            for (int m = 0; m < 4; ++m) { const int row = row0 + ai * HALF + m * 16;
#pragma unroll
                for (int bj = 0; bj < 2; ++bj) { const int col = col0 + bj * HALF;
                    const u32x4 gb = *(const u32x4*)(pb + (size_t)row * PB_LD + PB_BR + 1024 + col);
                    float eb[8];
#pragma unroll
                    for (int e = 0; e < 4; ++e) { eb[2 * e] = 1.f + __builtin_amdgcn_exp2f(__uint_as_float(gb[e] << 16) * -1.4426950408889634f); eb[2 * e + 1] = 1.f + __builtin_amdgcn_exp2f(__uint_as_float(gb[e] & 0xffff0000u) * -1.4426950408889634f); }
                    if (u.sub == 0) {
                        const u32x4 ga = *(const u32x4*)(pb + (size_t)row * PB_LD + PB_BR + col);
#pragma unroll
                        for (int e = 0; e < 4; ++e) { const float ea0 = 1.f + __builtin_amdgcn_exp2f(__uint_as_float(ga[e] << 16) * -1.4426950408889634f), ea1 = 1.f + __builtin_amdgcn_exp2f(__uint_as_float(ga[e] & 0xffff0000u) * -1.4426950408889634f);
                            const int i0 = 2 * e, i1 = 2 * e + 1;
                            acc[ai][bj][m][i0 >> 2][i0 & 3] *= eb[i0] * __builtin_amdgcn_rcpf(ea0); acc[ai][bj][m][i1 >> 2][i1 & 3] *= eb[i1] * __builtin_amdgcn_rcpf(ea1); }
                    } else {
                        const f32x4 v0 = acc[ai][bj][m][0], v1 = acc[ai][bj][m][1];
                        float sb[8];
#pragma unroll
                        for (int e = 0; e < 8; ++e) sb[e] = __builtin_amdgcn_rcpf(eb[e]);
                        u32x4 w; w.x = cvt_pk_bf16(v0[0] * sb[0], v0[1] * sb[1]); w.y = cvt_pk_bf16(v0[2] * sb[2], v0[3] * sb[3]); w.z = cvt_pk_bf16(v1[0] * sb[4], v1[1] * sb[5]); w.w = cvt_pk_bf16(v1[2] * sb[6], v1[3] * sb[7]);
                        *(u32x4*)(merged + (size_t)row * DM + col) = w; } } }
    }
};
struct EpiX1 {
    static constexpr bool PERM = false, CHAIN = false;
    const float* x; float* x1; bf16_t* x1b; float* ssx1;
    __device__ __forceinline__ void operator()(AccT& acc, const Unit& u, int wr, int wc, int fr, int fq) const {
        const int row0 = u.pm * BM + wr * 64 + fr, col0 = u.pn * BM + wc * 32 + 4 * fq;
#pragma unroll
        for (int ai = 0; ai < 2; ++ai)
#pragma unroll
            for (int m = 0; m < 4; ++m) { const int row = row0 + ai * HALF + m * 16; const size_t off = (size_t)row * DM + col0; float s = 0.f;
#pragma unroll
                for (int bj = 0; bj < 2; ++bj)
#pragma unroll
                    for (int n = 0; n < 2; ++n) { const size_t o = off + bj * HALF + n * 16; const f32x4 v = *(const f32x4*)(x + o) + acc[ai][bj][m][n];
                        *(f32x4*)(x1 + o) = v; u32x2 w; w.x = cvt_pk_bf16(v[0], v[1]); w.y = cvt_pk_bf16(v[2], v[3]); *(u32x2*)(x1b + o) = w;
                        s += (v[0] * v[0] + v[1] * v[1]) + (v[2] * v[2] + v[3] * v[3]); }
                s += __shfl_xor(s, 16); s += __shfl_xor(s, 32); if (fq == 0) atomicAdd(ssx1 + row, s); }
    }
};
struct EpiQP {
    static constexpr bool PERM = true, CHAIN = false;
    bf16_t* qp; const float* ssx1;
    __device__ __forceinline__ void operator()(AccT& acc, const Unit& u, int wr, int wc, int fr, int fq) const {
        const int row0 = u.pm * BM + wr * 64 + fr, col0 = u.pn * BM + wc * 32 + 8 * fq;
#pragma unroll
        for (int ai = 0; ai < 2; ++ai)
#pragma unroll
            for (int m = 0; m < 4; ++m) { const int row = row0 + ai * HALF + m * 16; const float rr = rsqrtf(ssx1[row] * (1.f / 1024.f) + EPS);
#pragma unroll
                for (int bj = 0; bj < 2; ++bj) { const f32x4 v0 = acc[ai][bj][m][0] * rr, v1 = acc[ai][bj][m][1] * rr;
                    u32x4 w; w.x = cvt_pk_bf16(v0[0], v0[1]); w.y = cvt_pk_bf16(v0[2], v0[3]); w.z = cvt_pk_bf16(v1[0], v1[1]); w.w = cvt_pk_bf16(v1[2], v1[3]);
                    *(u32x4*)(qp + (size_t)row * 2048 + col0 + bj * HALF) = w; } }
    }
};
}


namespace att {
typedef short bf16x8 __attribute__((ext_vector_type(8)));
typedef short s16x4 __attribute__((ext_vector_type(4)));
typedef float f32x16 __attribute__((ext_vector_type(16)));
constexpr int NW = 8, QBLK = 32, KVBLK = 64, QB = NW * QBLK;
constexpr int QS = 768, KS = 768, VS = 512, OS = 512;
constexpr int SHM_V = KVBLK * 64 * 2, SHM_K = KVBLK * 256;
constexpr int LDS_BYTES = 2 * SHM_V + 2 * SHM_K + NW * 64 * 4;
constexpr float THR = 8.f;
#define KSWZ(row, colB) ((row) * 256 + ((colB) ^ (((row) & 15) << 4)))
#define SBAR() __builtin_amdgcn_sched_barrier(0)
__device__ __forceinline__ int v_st(int k, int c) { const int kk = (k & ~0xC) | ((k & 4) << 1) | ((k & 8) >> 1); return ((kk >> 3) * 2 + (c >> 5)) * 512 + ((kk & 7) * 32 + (c & 31)) * 2; }
__device__ __forceinline__ int v_rd_base(int lane) { return ((lane & 3) << 3) | (((lane >> 2) & 3) << 6) | (((lane >> 4) & 1) << 5) | (((lane >> 5) & 1) << 8); }
constexpr int v_rd_off(int d0, int ks, int half) { return d0 * 512 + ks * 2048 + half * 1024; }
__device__ __forceinline__ int crow(int r, int hi) { return (r & 3) + 8 * (r >> 2) + 4 * hi; }
__device__ __forceinline__ unsigned cvtpk(float lo, float hi) { unsigned r; asm volatile("v_cvt_pk_bf16_f32 %0, %1, %2" : "=v"(r) : "v"(lo), "v"(hi)); return r; }
__device__ __forceinline__ bf16x8 load8(const bf16_t* p) { return *reinterpret_cast<const bf16x8*>(p); }
__device__ __forceinline__ void partialSM(f32x16& p0, f32x16& p1, float& m_reg, float& mn, float& alpha) {
    float pmax = p0[0]; for (int r = 1; r < 16; ++r) pmax = fmaxf(pmax, p0[r]); for (int r = 0; r < 16; ++r) pmax = fmaxf(pmax, p1[r]);
    { auto rr = __builtin_amdgcn_permlane32_swap(__float_as_uint(pmax), __float_as_uint(pmax), false, false);
      pmax = fmaxf(__uint_as_float(rr[0]), __uint_as_float(rr[1])); }
    if (__builtin_expect(__all((pmax - m_reg) <= THR), 1)) { mn = m_reg; alpha = 1.f; }
    else { mn = fmaxf(m_reg, pmax); alpha = __builtin_amdgcn_exp2f(m_reg - mn); m_reg = mn; }
    for (int r = 0; r < 16; ++r) p0[r] = p0[r] - mn; for (int r = 0; r < 16; ++r) p1[r] = p1[r] - mn;
    for (int r = 0; r < 16; ++r) p0[r] = __builtin_amdgcn_exp2f(p0[r]);
}
__device__ __forceinline__ void finishSM(f32x16& p0, f32x16& p1, float alpha, float& l_reg, bf16x8& pa0, bf16x8& pa1, bf16x8& pa2, bf16x8& pa3) {
    for (int r = 0; r < 16; ++r) p1[r] = __builtin_amdgcn_exp2f(p1[r]);
    float ps = 0; for (int r = 0; r < 16; ++r) ps += p0[r]; for (int r = 0; r < 16; ++r) ps += p1[r];
    { auto rr = __builtin_amdgcn_permlane32_swap(__float_as_uint(ps), __float_as_uint(ps), false, false);
      ps = __uint_as_float(rr[0]) + __uint_as_float(rr[1]); }
    l_reg = l_reg * alpha + ps;
#define PK4(P, B_, OUT) do { unsigned a0 = cvtpk(P[B_+0], P[B_+1]), a1 = cvtpk(P[B_+2], P[B_+3]);                          \
        unsigned b0 = cvtpk(P[B_+4], P[B_+5]), b1 = cvtpk(P[B_+6], P[B_+7]);                                             \
        auto r0 = __builtin_amdgcn_permlane32_swap(a0, b0, false, false); auto r1 = __builtin_amdgcn_permlane32_swap(a1, b1, false, false); \
        u32x4 w = {r0[0], r1[0], r0[1], r1[1]}; OUT = *reinterpret_cast<bf16x8*>(&w); } while (0)
    PK4(p0, 0, pa0); PK4(p0, 8, pa1); PK4(p1, 0, pa2); PK4(p1, 8, pa3);
#undef PK4
}
template <int KB>
__device__ __forceinline__ void qkt(f32x16& p0, f32x16& p1, const char* K_lds, int r32, int hi, const bf16x8* qr) {
    p0 = f32x16{}; p1 = f32x16{};
#pragma unroll
    for (int d0 = 0; d0 < 6; ++d0) { const char* a = K_lds + KB * SHM_K + KSWZ(r32, (d0 * 16 + hi * 8) * 2);
        bf16x8 b0 = *reinterpret_cast<const bf16x8*>(a);
        bf16x8 b1 = *reinterpret_cast<const bf16x8*>(a + 32 * 256);
        p0 = __builtin_amdgcn_mfma_f32_32x32x16_bf16(b0, qr[d0], p0, 0, 0, 0);
        p1 = __builtin_amdgcn_mfma_f32_32x32x16_bf16(b1, qr[d0], p1, 0, 0, 0); }
}
template <int VB>
__device__ __forceinline__ void pv_tile(f32x16* o, int vb0, bf16x8 pa0, bf16x8 pa1, bf16x8 pa2, bf16x8 pa3) {
#define TRRD(dst, off) asm volatile("ds_read_b64_tr_b16 %0, %1 offset:%2" : "=&v"(dst) : "v"(vb0), "i"(off) : "memory")
#define PV_D0(d0) do { s16x4 l0, l1, l2, l3, h0, h1, h2, h3; constexpr int b_ = VB * SHM_V + v_rd_off(d0, 0, 0);   \
        TRRD(l0, b_); TRRD(h0, b_ + 1024); TRRD(l1, b_ + 2048); TRRD(h1, b_ + 3072); TRRD(l2, b_ + 4096); TRRD(h2, b_ + 5120); TRRD(l3, b_ + 6144); TRRD(h3, b_ + 7168); \
        asm volatile("s_waitcnt lgkmcnt(0)" ::: "memory"); SBAR();   \
        o[d0] = __builtin_amdgcn_mfma_f32_32x32x16_bf16(pa0, (bf16x8){l0[0], l0[1], l0[2], l0[3], h0[0], h0[1], h0[2], h0[3]}, o[d0], 0, 0, 0);   \
        o[d0] = __builtin_amdgcn_mfma_f32_32x32x16_bf16(pa1, (bf16x8){l1[0], l1[1], l1[2], l1[3], h1[0], h1[1], h1[2], h1[3]}, o[d0], 0, 0, 0);   \
        o[d0] = __builtin_amdgcn_mfma_f32_32x32x16_bf16(pa2, (bf16x8){l2[0], l2[1], l2[2], l2[3], h2[0], h2[1], h2[2], h2[3]}, o[d0], 0, 0, 0);   \
        o[d0] = __builtin_amdgcn_mfma_f32_32x32x16_bf16(pa3, (bf16x8){l3[0], l3[1], l3[2], l3[3], h3[0], h3[1], h3[2], h3[3]}, o[d0], 0, 0, 0); } while (0)
    PV_D0(0); PV_D0(1);
#undef PV_D0
#undef TRRD
}
struct BlockRef { const bf16_t* Q; const bf16_t* K; const bf16_t* KPE; const bf16_t* V; bf16_t* O; int P0; };
struct Seam { bf16x8 qr[6]; bf16x8 st_v0, st_v1, st_k0, st_k1; };
#define ROWK(p, k0, rr) ((p) + (size_t)((k0) + (rr)) * kstr)
#define ROWV(p, k0, rr) ((p) + (size_t)((k0) + (rr)) * VS + sc)
#define VMW() asm volatile("s_waitcnt vmcnt(0)" ::: "memory")
#define VMWN(n) asm volatile("s_waitcnt vmcnt(%0)" :: "i"(n) : "memory")
#define SLOAD_H(Kp, Vp, k0) do { if (vact) { S.st_v0 = load8(ROWV(Vp, k0, sr)); S.st_v1 = load8(ROWV(Vp, k0, 32 + sr)); }              \
                                 if (kact) { S.st_k0 = load8(ROWK(Kp, k0, sr)); S.st_k1 = load8(ROWK(Kp, k0, 32 + sr)); } } while (0)
#define SWRITE_HK(bf) do { if (kact) { *(bf16x8*)(K_lds + (bf) * SHM_K + kws) = S.st_k0; *(bf16x8*)(K_lds + (bf) * SHM_K + kws + 32 * 256) = S.st_k1; } } while (0)
#define SWRITE_HV(bf) do { if (vact) { *(bf16x8*)(V_lds + (bf) * SHM_V + vst0) = S.st_v0; *(bf16x8*)(V_lds + (bf) * SHM_V + vst1) = S.st_v1; } } while (0)
#define SWRITE_H(bf) do { SWRITE_HV(bf); SWRITE_HK(bf); } while (0)
__device__ __forceinline__ void attn_prime(const BlockRef& cur, char* lds, Seam& S) {
    const int tid = threadIdx.x, wid = __builtin_amdgcn_readfirstlane(tid >> 6), lane = tid & 63, r32 = lane & 31, hi = lane >> 5;
    const int sr = tid >> 4, sc = (tid & 15) * 8, kws = KSWZ(sr, sc * 2); char* K_lds = lds + 2 * SHM_V;
    const bool kact = (tid & 15) < 12, vact = (tid & 15) < 8;
#pragma unroll
    for (int d0 = 0; d0 < 6; ++d0) S.qr[d0] = load8(cur.Q + (size_t)(wid * QBLK + r32) * QS + d0 * 16 + hi * 8);
    const bf16_t* kp0 = (tid & 15) < 8 ? cur.K + sc : cur.KPE + (sc - 64); const int kstr = (tid & 15) < 8 ? KS : 32;
    SLOAD_H(kp0, cur.V, 0); VMW(); SWRITE_HK(0);
    __syncthreads();
}
__device__ __forceinline__ void attn_block(const BlockRef& cur, const BlockRef& nxt, char* lds, Seam& S) {
    const int tid = threadIdx.x, wid = __builtin_amdgcn_readfirstlane(tid >> 6), lane = tid & 63, r32 = lane & 31, hi = lane >> 5;
    const int NT = (cur.P0 + QB - 1) / KVBLK + 1;
    const int qlo = cur.P0 + wid * QBLK;
    const int qvis = qlo | 63;
    char* V_lds = lds; char* K_lds = lds + 2 * SHM_V;
    float* ws = (float*)(lds + 2 * SHM_V + 2 * SHM_K) + wid * 64; float* li_l = ws, * al_l = ws + 32;
    float m_reg = -1e30f, l_reg = 0; f32x16 o[2] = {};
    const int sr = tid >> 4, sc = (tid & 15) * 8, vst0 = v_st(sr, sc & 63), vst1 = v_st(32 + sr, sc & 63), kws = KSWZ(sr, sc * 2);
    const bool kact = (tid & 15) < 12, vact = (tid & 15) < 8;
    const int vb0 = (int)(uintptr_t)V_lds + v_rd_base(lane);
    const int kstr = (tid & 15) < 8 ? KS : 32;
    const bf16_t* Kh = (tid & 15) < 8 ? cur.K + sc : cur.KPE + (sc - 64); const bf16_t* Vh = cur.V;
    const bf16_t* Knx = (tid & 15) < 8 ? nxt.K + sc : nxt.KPE + (sc - 64);
#define RESC(a) do { if (__any((a) < 1.f)) { if (hi == 0) al_l[r32] = (a); asm volatile("s_waitcnt lgkmcnt(0)" ::: "memory");              \
                     for (int d_ = 0; d_ < 2; ++d_) for (int r = 0; r < 16; ++r) o[d_][r] *= al_l[crow(r, hi)]; } } while (0)
#define KBASE(t) ((t) * KVBLK)
#define MASKT(P0_, P1_, t) do { if (__builtin_amdgcn_readfirstlane((int)(KBASE(t) > qvis))) { const float NEG_ = -__builtin_inff(); _Pragma("unroll") for (int r = 0; r < 16; ++r) { P0_[r] = NEG_; P1_[r] = NEG_; } asm volatile("" : "+v"(P0_), "+v"(P1_)); } } while (0)
    constexpr int NQL = 6;
#define SEAM_K0() do { VMWN(NQL); SWRITE_HK(0); SBAR(); } while (0)
    f32x16 pA0, pA1, pB0, pB1; float mnA, mnB, alA, alB; bf16x8 pa0, pa1, pa2, pa3;
    SWRITE_HV(0); SBAR();
    if (NT > 1) { SLOAD_H(Kh, Vh, KBASE(1)); }
    SBAR(); qkt<0>(pA0, pA1, K_lds, r32, hi, S.qr);
    MASKT(pA0, pA1, 0); partialSM(pA0, pA1, m_reg, mnA, alA);
    if (NT > 1) { VMW(); SWRITE_H(1); }
    __syncthreads();
#define HALF_STEP(PX0, PX1, mnX, alX, PY0, PY1, alY, t, KB, VB, SB) do {                                                      \
        SBAR(); qkt<KB>(PX0, PX1, K_lds, r32, hi, S.qr);                                             \
        finishSM(PY0, PY1, alY, l_reg, pa0, pa1, pa2, pa3); SBAR();                                                           \
        if ((t) + 1 < NT) { SLOAD_H(Kh, Vh, KBASE((t) + 1)); SBAR(); }                                               \
        pv_tile<VB>(o, vb0, pa0, pa1, pa2, pa3); MASKT(PX0, PX1, (t)); partialSM(PX0, PX1, m_reg, mnX, alX);                                        \
        __syncthreads();                                                                                                      \
        if ((t) + 1 < NT) { VMW(); SWRITE_H(SB); }                                                                          \
        RESC(alX); __syncthreads(); } while (0)
    for (int t = 1; t + 1 < NT; t += 2) {
        HALF_STEP(pB0, pB1, mnB, alB, pA0, pA1, alA, t, 1, 0, 0);
        HALF_STEP(pA0, pA1, mnA, alA, pB0, pB1, alB, t + 1, 0, 1, 1);
    }
    const bool even = (NT & 1) == 0;
    if (even) { SBAR(); qkt<1>(pB0, pB1, K_lds, r32, hi, S.qr); SBAR(); }
    SLOAD_H(Knx, nxt.V, 0); SBAR();
#pragma unroll
    for (int d0 = 0; d0 < 6; ++d0) S.qr[d0] = load8(nxt.Q + (size_t)(wid * QBLK + r32) * QS + d0 * 16 + hi * 8);
    SBAR();
    finishSM(pA0, pA1, alA, l_reg, pa0, pa1, pa2, pa3); SBAR();
    pv_tile<0>(o, vb0, pa0, pa1, pa2, pa3);
    if (even) { MASKT(pB0, pB1, NT - 1); partialSM(pB0, pB1, m_reg, mnB, alB); __syncthreads(); RESC(alB);
        finishSM(pB0, pB1, alB, l_reg, pa0, pa1, pa2, pa3); SBAR(); pv_tile<1>(o, vb0, pa0, pa1, pa2, pa3); }
    SBAR(); SEAM_K0();
    if (hi == 0) li_l[r32] = l_reg; asm volatile("s_waitcnt lgkmcnt(0)" ::: "memory");
    float rli[16];
#pragma unroll
    for (int r = 0; r < 16; ++r) rli[r] = __builtin_amdgcn_rcpf(li_l[crow(r, hi)]);
    bf16_t* Ow = cur.O + (size_t)(wid * QBLK) * OS;
#pragma unroll
    for (int r = 0; r < 16; ++r) { const int orow = crow(r, hi);
#pragma unroll
        for (int d0 = 0; d0 < 2; ++d0) { const float v = o[d0][r] * rli[r];
            const float vn = __shfl_xor(v, 1);
            if ((r32 & 1) == 0) *(unsigned*)(Ow + (size_t)orow * OS + d0 * 32 + r32) = cvtpk(v, vn); } }
    __syncthreads();
#undef RESC
#undef KBASE
#undef MASKT
#undef SEAM_K0
#undef HALF_STEP
}

constexpr int D_V = 0, D_K = 4 * SHM_V, D_WS = D_K + 3 * SHM_K, D_BYTES = D_WS + NW * 64 * 4;
__device__ __forceinline__ void qkt_rt(f32x16& p0, f32x16& p1, const char* Kslot, int r32, int hi, const bf16x8* qr) {
    p0 = f32x16{}; p1 = f32x16{};
#pragma unroll
    for (int d0 = 0; d0 < 6; ++d0) { const char* a = Kslot + KSWZ(r32, (d0 * 16 + hi * 8) * 2);
        bf16x8 b0 = *reinterpret_cast<const bf16x8*>(a);
        bf16x8 b1 = *reinterpret_cast<const bf16x8*>(a + 32 * 256);
        p0 = __builtin_amdgcn_mfma_f32_32x32x16_bf16(b0, qr[d0], p0, 0, 0, 0);
        p1 = __builtin_amdgcn_mfma_f32_32x32x16_bf16(b1, qr[d0], p1, 0, 0, 0); }
}
__device__ __forceinline__ void attn_block_dma(const BlockRef& cur, char* lds) {
    typedef __attribute__((address_space(3))) unsigned lds_u32;
    const int tid = threadIdx.x, wid = __builtin_amdgcn_readfirstlane(tid >> 6), lane = tid & 63, r32 = lane & 31, hi = lane >> 5;
    const int NT = (cur.P0 + QB - 1) / KVBLK + 1;
    const int qlo = cur.P0 + wid * QBLK, qvis = qlo | 63;
    float* ws = (float*)(lds + D_WS) + wid * 64; float* li_l = ws, * al_l = ws + 32;
    float m_reg = -1e30f, l_reg = 0; f32x16 o[2] = {};
    const int vb0 = (int)(uintptr_t)(lds + D_V) + v_rd_base(lane);
    const bf16_t* ksrc[2]; int kstep[2];
#pragma unroll
    for (int j = 0; j < 2; ++j) { const int row = 4 * (2 * wid + j) + (lane >> 4), chunk = (lane & 15) ^ (row & 15);
        if (chunk >= 8 && chunk < 12) { ksrc[j] = cur.KPE + (size_t)row * 32 + (chunk - 8) * 8; kstep[j] = KVBLK * 32; }
        else { ksrc[j] = cur.K + (size_t)row * KS + (chunk < 8 ? chunk * 8 : 0); kstep[j] = KVBLK * KS; } }
    const bf16_t* vsrc; { const int kk = wid * 8 + ((lane & 31) >> 2), k = (kk & ~0xC) | ((kk & 4) << 1) | ((kk & 8) >> 1); vsrc = cur.V + (size_t)k * VS + (lane >> 5) * 32 + (lane & 3) * 8; }
#define DMA_TILE(t) do { const int ks_ = (t) % 3, vs_ = (t) & 3; \
        __builtin_amdgcn_global_load_lds((const unsigned*)(ksrc[0] + (size_t)(t) * kstep[0]), (lds_u32*)(lds + D_K + ks_ * SHM_K + (2 * wid) * 1024), 16, 0, 0); \
        __builtin_amdgcn_global_load_lds((const unsigned*)(ksrc[1] + (size_t)(t) * kstep[1]), (lds_u32*)(lds + D_K + ks_ * SHM_K + (2 * wid + 1) * 1024), 16, 0, 0); \
        __builtin_amdgcn_global_load_lds((const unsigned*)(vsrc + (size_t)(t) * KVBLK * VS), (lds_u32*)(lds + D_V + vs_ * SHM_V + wid * 1024), 16, 0, 0); } while (0)
#define WAITV(n) asm volatile("s_waitcnt vmcnt(" #n ")" ::: "memory")
#define BAR() do { asm volatile("s_waitcnt lgkmcnt(0)" ::: "memory"); __builtin_amdgcn_s_barrier(); asm volatile("" ::: "memory"); SBAR(); } while (0)
#define RESC(a) do { if (__any((a) < 1.f)) { if (hi == 0) al_l[r32] = (a); asm volatile("s_waitcnt lgkmcnt(0)" ::: "memory");              \
                     for (int d_ = 0; d_ < 2; ++d_) for (int r = 0; r < 16; ++r) o[d_][r] *= al_l[crow(r, hi)]; } } while (0)
#define MASKT(P0_, P1_, t) do { if (__builtin_amdgcn_readfirstlane((int)((t) * KVBLK > qvis))) { const float NEG_ = -__builtin_inff(); _Pragma("unroll") for (int r = 0; r < 16; ++r) { P0_[r] = NEG_; P1_[r] = NEG_; } asm volatile("" : "+v"(P0_), "+v"(P1_)); } } while (0)
    bf16x8 qr[6];
#pragma unroll
    for (int d0 = 0; d0 < 6; ++d0) qr[d0] = load8(cur.Q + (size_t)(wid * QBLK + r32) * QS + d0 * 16 + hi * 8);
    asm volatile("s_waitcnt vmcnt(0)" ::: "memory");
    DMA_TILE(0); DMA_TILE(1);
    WAITV(3); BAR();
    f32x16 pA0, pA1, pB0, pB1; float mnA, mnB, alA, alB; bf16x8 pa0, pa1, pa2, pa3;
    DMA_TILE(2);
    qkt_rt(pA0, pA1, lds + D_K, r32, hi, qr);
    MASKT(pA0, pA1, 0); partialSM(pA0, pA1, m_reg, mnA, alA);
    WAITV(3); BAR();
#define STEP(PX0, PX1, mnX, alX, PY0, PY1, alY, t) do { \
        if ((t) + 2 < NT) DMA_TILE((t) + 2); \
        SBAR(); qkt_rt(PX0, PX1, lds + D_K + ((t) % 3) * SHM_K, r32, hi, qr); \
        finishSM(PY0, PY1, alY, l_reg, pa0, pa1, pa2, pa3); SBAR(); \
        pv_tile<0>(o, vb0 + (((t) - 1) & 3) * SHM_V, pa0, pa1, pa2, pa3); MASKT(PX0, PX1, (t)); partialSM(PX0, PX1, m_reg, mnX, alX); \
        if ((t) + 2 < NT) { WAITV(3); } else { WAITV(0); } BAR(); \
        RESC(alX); } while (0)
    for (int t = 1; t + 1 < NT; t += 2) {
        STEP(pB0, pB1, mnB, alB, pA0, pA1, alA, t);
        STEP(pA0, pA1, mnA, alA, pB0, pB1, alB, t + 1);
    }
    SBAR(); qkt_rt(pB0, pB1, lds + D_K + ((NT - 1) % 3) * SHM_K, r32, hi, qr);
    finishSM(pA0, pA1, alA, l_reg, pa0, pa1, pa2, pa3); SBAR();
    pv_tile<0>(o, vb0 + ((NT - 2) & 3) * SHM_V, pa0, pa1, pa2, pa3);
    MASKT(pB0, pB1, NT - 1); partialSM(pB0, pB1, m_reg, mnB, alB); RESC(alB);
    finishSM(pB0, pB1, alB, l_reg, pa0, pa1, pa2, pa3); SBAR(); pv_tile<0>(o, vb0 + ((NT - 1) & 3) * SHM_V, pa0, pa1, pa2, pa3);
    if (hi == 0) li_l[r32] = l_reg; asm volatile("s_waitcnt lgkmcnt(0)" ::: "memory");
    float rli[16];
#pragma unroll
    for (int r = 0; r < 16; ++r) rli[r] = __builtin_amdgcn_rcpf(li_l[crow(r, hi)]);
    bf16_t* Ow = cur.O + (size_t)(wid * QBLK) * OS;
#pragma unroll
    for (int r = 0; r < 16; ++r) { const int orow = crow(r, hi);
#pragma unroll
        for (int d0 = 0; d0 < 2; ++d0) { const float v = o[d0][r] * rli[r];
            const float vn = __shfl_xor(v, 1);
            if ((r32 & 1) == 0) *(unsigned*)(Ow + (size_t)orow * OS + d0 * 32 + r32) = cvtpk(v, vn); } }
    asm volatile("s_waitcnt vmcnt(0)" ::: "memory");
    __syncthreads();
#undef DMA_TILE
#undef WAITV
#undef BAR
#undef RESC
#undef MASKT
#undef STEP
}
#undef ROWK
#undef ROWV
#undef VMW
#undef VMWN
#undef SLOAD_H
#undef SWRITE_HK
#undef SWRITE_HV
#undef SWRITE_H
#undef KSWZ
#undef SBAR
}

namespace gla {
typedef short bf16x8 __attribute__((ext_vector_type(8)));
typedef short s16x4 __attribute__((ext_vector_type(4)));
typedef float f32x16 __attribute__((ext_vector_type(16)));
template <int NCB> __device__ __forceinline__ int t_st(int k, int c) { const int kk = (k & ~0xC) | ((k & 4) << 1) | ((k & 8) >> 1); return ((kk >> 3) * NCB + (c >> 5)) * 512 + ((kk & 7) * 32 + (c & 31)) * 2; }
__device__ __forceinline__ int t_rd_base(int lane) { return ((lane & 3) << 3) | (((lane >> 2) & 3) << 6) | (((lane >> 4) & 1) << 5) | (((lane >> 5) & 1) << 8); }
template <int NCB> constexpr int t_rd_off(int d0, int ks, int half) { return d0 * 512 + ks * (NCB * 1024) + half * (NCB * 512); }
#define GLA_TRRD(dst, addr, off) asm volatile("ds_read_b64_tr_b16 %0, %1 offset:%2" : "=&v"(dst) : "v"(addr), "i"(off) : "memory")
__device__ __forceinline__ int crow(int r, int hi) { return (r & 3) + 8 * (r >> 2) + 4 * hi; }
}

#define XB_TMO      128
#define XB_XCNT(j)  (256  + 64 * (j))
#define XB_XSUB(j)  (1280 + 64 * (j))
#define XB_XGEN(j)  (2304 + 64 * (j))
#define XB_TOP      3328
#define XB_TOPGEN   3392
#define XCD_BAR_WORDS 3456
#define XB_SPIN_CAP (1u << 18)
__device__ __forceinline__ unsigned xb_ld(unsigned* p)              { return __hip_atomic_load(p, __ATOMIC_RELAXED, __HIP_MEMORY_SCOPE_AGENT); }
__device__ __forceinline__ unsigned xb_add(unsigned* p, unsigned v) { return __hip_atomic_fetch_add(p, v, __ATOMIC_RELAXED, __HIP_MEMORY_SCOPE_AGENT); }
__device__ __forceinline__ unsigned xb_xcc_id() { return (unsigned)__builtin_amdgcn_s_getreg((3 << 11) | 20) & 0xFu; }
#define XB_SPIN(cond, bar) do { unsigned _sp = 0; while (cond) { __builtin_amdgcn_s_sleep(1); \
    if ((++_sp & 255u) == 0u) { if (xb_ld(&(bar)[XB_TMO])) break; if (_sp > XB_SPIN_CAP) { atomicAdd(&(bar)[XB_TMO], 1u); break; } } } } while (0)
struct XcdBarrier { unsigned* bar; unsigned x; volatile LAS unsigned* st; };
__device__ __forceinline__ XcdBarrier xcd_barrier_post(unsigned* bar, volatile LAS unsigned* st) {
    XcdBarrier b; b.bar = bar; b.x = xb_xcc_id(); b.st = st;
    if (threadIdx.x == 0) st[2] = xb_add(&bar[XB_XCNT(b.x)], 1u);
    return b;
}
__device__ __forceinline__ void xcd_barrier_complete(unsigned* bar, unsigned x, unsigned& nloc, unsigned& nx) {
    const unsigned G = gridDim.x * gridDim.y * gridDim.z;
    unsigned sum, cnt, mine, sp = 0u;
    for (;;) {
        sum = 0u; cnt = 0u; mine = 0u;
#pragma unroll
        for (unsigned j = 0; j < 16; ++j) { const unsigned c = xb_ld(&bar[XB_XCNT(j)]); sum += c; cnt += (c > 0u) ? 1u : 0u; mine = (j == x) ? c : mine; }
        if (sum == G) break;
        __builtin_amdgcn_s_sleep(1);
        if ((++sp & 255u) == 0u) { if (xb_ld(&bar[XB_TMO])) break; if (sp > XB_SPIN_CAP) { atomicAdd(&bar[XB_TMO], 1u); break; } }
    }
    nloc = mine > 0u ? mine : 1u; nx = cnt > 0u ? cnt : 1u;
}
__device__ __forceinline__ void xcd_barrier(const XcdBarrier& b) {
    asm volatile("s_waitcnt vmcnt(0)" ::: "memory");
    __syncthreads();
    if (threadIdx.x == 0) {
        unsigned* bar = b.bar;
        __builtin_amdgcn_s_waitcnt(0);
        unsigned nloc = b.st[0], nx = b.st[1];
        if (nloc == 0u) { xcd_barrier_complete(bar, b.x, nloc, nx); b.st[0] = nloc; b.st[1] = nx; }
        const unsigned old = xb_add(&bar[XB_XSUB(b.x)], 1u);
        const unsigned gen = old / nloc;
        if (old + 1u == (gen + 1u) * nloc) {
            __builtin_amdgcn_fence(__ATOMIC_RELEASE, "agent");
            asm volatile("s_waitcnt vmcnt(0)" ::: "memory");
            const unsigned og = xb_add(&bar[XB_TOP], 1u);
            const unsigned tg = og / nx;
            if (og + 1u == (tg + 1u) * nx) xb_add(&bar[XB_TOPGEN], 1u);
            else XB_SPIN(xb_ld(&bar[XB_TOPGEN]) == tg, bar);
            __builtin_amdgcn_fence(__ATOMIC_ACQUIRE, "agent");
            xb_add(&bar[XB_XGEN(b.x)], 1u);
            asm volatile("s_waitcnt vmcnt(0)" ::: "memory");
        } else {
            XB_SPIN(xb_ld(&bar[XB_XGEN(b.x)]) == gen, bar);
            __builtin_amdgcn_fence(__ATOMIC_ACQUIRE, "agent");
            asm volatile("s_waitcnt vmcnt(0)" ::: "memory");
        }
    }
    __syncthreads();
}

constexpr int NWAVES = 8;
constexpr int RING_BYTES = 131072, LDSCTL_OFF = RING_BYTES, MISC_OFF = LDSCTL_OFF + 320, LDS_BYTES = 147456;
constexpr int CW_BAR = 4096;
constexpr int CW_QCTR = 16384;

struct Args { const void* in[20]; float* out; unsigned char* ws; int ph_lo, ph_hi; };

__device__ __forceinline__ int win_srccol(int n) {
    if (n < 2048) return 2224 + n;
    if (n < 2560) return 1712 + (n - 2048);
    if (n < 2816) return 672 + (n - 2560);
    if (n < 3328) return 1184 + (n - 2816);
    if (n < 3584) return 928 + (n - 3328);
    if (n < 3968) return 0 + (n - 3584);
    if (n < 4224) return 384 + (n - 3968);
    if (n < 4256) return 640 + (n - 4224);
    if (n < 4272) return 1696 + (n - 4256);
    return -1;
}
__device__ __forceinline__ void transpose_item(const float* __restrict__ W, int K, int Nsrc, bf16_t* __restrict__ WT, int Nout, const float* __restrict__ kscale, bool winperm, float* scr, int item, int lane) {
    const int nblk = Nout / 32, kb = item / nblk, nb = item % nblk, k0 = 64 * kb, n0 = 32 * nb;
    const int n = n0 + (lane & 31); const int sc = winperm ? win_srccol(n) : n;
    float tv[32];
#pragma unroll
    for (int i = 0; i < 32; ++i) { const int kk = 2 * i + (lane >> 5); tv[i] = (sc >= 0) ? W[(size_t)(k0 + kk) * Nsrc + sc] : 0.f; }
#pragma unroll
    for (int i = 0; i < 32; ++i) { const int kk = 2 * i + (lane >> 5); float v = tv[i]; if (kscale) v *= kscale[k0 + kk]; scr[kk * 33 + (lane & 31)] = v; }
    asm volatile("s_waitcnt lgkmcnt(0)" ::: "memory");
    const int c = lane & 7;
#pragma unroll
    for (int j = 0; j < 4; ++j) { const int nn = (lane >> 3) + 8 * j; const float* s = scr + (8 * c) * 33 + nn;
        u32x4 o; o.x = pk2(s[0 * 33], s[1 * 33]); o.y = pk2(s[2 * 33], s[3 * 33]); o.z = pk2(s[4 * 33], s[5 * 33]); o.w = pk2(s[6 * 33], s[7 * 33]);
        *(u32x4*)(WT + (size_t)(n0 + nn) * K + k0 + 8 * c) = o; }
    asm volatile("s_waitcnt lgkmcnt(0)" ::: "memory");
}

#define TOPK_INSERT(tv, ti, vv, ii) do { float v_ = (vv); int i_ = (ii); \
    _Pragma("unroll") for (int q_ = 0; q_ < 16; ++q_) { const bool gt_ = (v_ > tv[q_]) || (v_ == tv[q_] && i_ < ti[q_]); const float tv_ = tv[q_]; const int ti_ = ti[q_]; \
        tv[q_] = gt_ ? v_ : tv_; ti[q_] = gt_ ? i_ : ti_; v_ = gt_ ? tv_ : v_; i_ = gt_ ? ti_ : i_; } } while (0)

template <int OFFS> __device__ __forceinline__ void quant_rows2(const float* __restrict__ tab, const float* __restrict__ g, unsigned char* __restrict__ qt, float* __restrict__ sc, int row0, int lane) {
    f32x4 v[2][4];
#pragma unroll
    for (int rr = 0; rr < 2; ++rr)
#pragma unroll
        for (int j = 0; j < 4; ++j) v[rr][j] = *(const f32x4*)(tab + (size_t)(row0 + rr) * 1024 + 16 * lane + 4 * j);
#pragma unroll
    for (int rr = 0; rr < 2; ++rr) {
        float mx = 0.f;
#pragma unroll
        for (int j = 0; j < 4; ++j) { if (g) v[rr][j] = v[rr][j] * *(const f32x4*)(g + 16 * lane + 4 * j);
            mx = fmaxf(mx, fmaxf(fmaxf(fabsf(v[rr][j][0]), fabsf(v[rr][j][1])), fmaxf(fabsf(v[rr][j][2]), fabsf(v[rr][j][3])))); }
#pragma unroll
        for (int o = 1; o < 64; o <<= 1) mx = fmaxf(mx, __shfl_xor(mx, o));
        mx = fmaxf(mx, 1e-30f);
        const float inv = 127.f / mx;
        u32x4 w;
#pragma unroll
        for (int j = 0; j < 4; ++j) { unsigned b = 0;
#pragma unroll
            for (int e = 0; e < 4; ++e) { const int q = (int)rintf(v[rr][j][e] * inv) + OFFS; b |= ((unsigned)q & 0xffu) << (8 * e); }
            w[j] = b; }
        *(u32x4*)(qt + (size_t)(lane >> 3) * (16384 * 128) + (size_t)(row0 + rr) * 128 + 16 * (lane & 7)) = w;
        if (lane == 0) sc[row0 + rr] = mx * (1.f / 127.f);
    }
}
typedef __bf16 bf2_t __attribute__((ext_vector_type(2)));
__device__ __forceinline__ float dot2_bf16(unsigned a, unsigned b, float acc) { return __builtin_amdgcn_fdot2_f32_bf16(__builtin_bit_cast(bf2_t, a), __builtin_bit_cast(bf2_t, b), acc, false); }
__global__ void __launch_bounds__(NWAVES * 64, 2) fwd(Args args) {
    extern __shared__ __attribute__((aligned(16))) unsigned char lds[];
    const int tid = threadIdx.x, lane = tid & 63, wave = __builtin_amdgcn_readfirstlane(tid >> 6);
    const int G = gridDim.x; int vcu; { const int bx = blockIdx.x; vcu = (G % 8 == 0) ? (bx % 8) * (G / 8) + bx / 8 : bx; }
    const int gw = vcu * NWAVES + wave, NGW = G * NWAVES, gtid = vcu * 512 + tid, NT = G * 512;
    unsigned char* ws = args.ws;
    const float* x = (const float*)args.in[0]; const int* positions = (const int*)args.in[1];
    const float* g_mix = (const float*)args.in[2]; const float* w_in = (const float*)args.in[3]; const float* g_q_lat = (const float*)args.in[4]; const float* w_qb = (const float*)args.in[5];
    const float* g_kv_lat = (const float*)args.in[6]; const float* w_kvb = (const float*)args.in[7]; const float* w_a2 = (const float*)args.in[8]; const float* b_a2 = (const float*)args.in[9];
    const float* g_gla = (const float*)args.in[10]; const float* w_branch_a = (const float*)args.in[11]; const float* w_branch_b = (const float*)args.in[12]; const float* w_out = (const float*)args.in[13];
    const float* g_ffn = (const float*)args.in[14]; const float* w_peer_q = (const float*)args.in[15]; const float* sub_keys = (const float*)args.in[16]; const float* peer_u = (const float*)args.in[17];
    const float* peer_v = (const float*)args.in[18]; const float* g_final = (const float*)args.in[19];
    float* out = args.out;
    float* SSQ = (float*)(ws + WS_SSQ); float* SSKV = (float*)(ws + WS_SSKV); float* SSX1 = (float*)(ws + WS_SSX1); float* COS = (float*)(ws + WS_COS); float* SIN = (float*)(ws + WS_SIN);
    float* DECAY = (float*)(ws + WS_DECAY);
    bf16_t* WIN = (bf16_t*)(ws + WS_WIN); bf16_t* WQB = (bf16_t*)(ws + WS_WQB); bf16_t* WKVB = (bf16_t*)(ws + WS_WKVB); bf16_t* WA = (bf16_t*)(ws + WS_WA); bf16_t* WB = (bf16_t*)(ws + WS_WB);
    bf16_t* WOUT = (bf16_t*)(ws + WS_WOUT); bf16_t* WPQ = (bf16_t*)(ws + WS_WPQ); bf16_t* KEYS = (bf16_t*)(ws + WS_KEYS);
    bf16_t* PROJB = (bf16_t*)(ws + WS_PROJB); bf16_t* PROJA = (bf16_t*)(ws + WS_PROJA); bf16_t* XN = (bf16_t*)(ws + WS_XN);
    bf16_t* Q = (bf16_t*)(ws + WS_Q); bf16_t* K = (bf16_t*)(ws + WS_K); bf16_t* KPE = (bf16_t*)(ws + WS_KPE); float* DST = out; bf16_t* V = (bf16_t*)((unsigned char*)out + 32 * MiB);
    bf16_t* YA = (bf16_t*)(ws + WS_YA); bf16_t* YB = (bf16_t*)(ws + WS_YB); bf16_t* MERGED = (bf16_t*)(ws + WS_MERGED); bf16_t* X1B = (bf16_t*)(ws + WS_X1B); bf16_t* QP = (bf16_t*)(ws + WS_QP);
    int* EIDX = (int*)(ws + WS_EIDX); float* EGATE = (float*)(ws + WS_EGATE); unsigned char* UT = ws + WS_UT; unsigned char* VT = ws + WS_VT; float* SU = (float*)(ws + WS_SU); float* SV = (float*)(ws + WS_SV); float* SS2 = (float*)(ws + WS_SS2); float* ZP = (float*)(ws + WS_ZP); float* CS = (float*)(ws + WS_C128); signed char* CQ = (signed char*)(ws + WS_CB);

    for (int u = tid; u < (LDS_BYTES - LDSCTL_OFF) / 4; u += NWAVES * 64) ((unsigned*)(lds + LDSCTL_OFF))[u] = 0u;
    __syncthreads();
    XcdBarrier bar; bar.bar = (unsigned*)(ws + WS_CTL) + CW_BAR; bar.x = 0; bar.st = nullptr;
    if (MK_N_LAUNCHES == 1) bar = xcd_barrier_post((unsigned*)(ws + WS_CTL) + CW_BAR, (volatile LAS unsigned*)(lds + MISC_OFF) + 8);
    const int ph_lo_ = args.ph_lo, ph_hi_ = args.ph_hi;
#define IN(k) (ph_lo_ <= (k) && (k) < ph_hi_)
#define SEAM(k) do { if (MK_N_LAUNCHES == 1) { if (IN(k) && IN((k) + 1)) xcd_barrier(bar); } } while (0)
    PG8_LAS unsigned char* ring = (PG8_LAS unsigned char*)lds;

    if (IN(0)) {
        for (int i = gtid; i < 4 * M_; i += NT) SSQ[i] = 0.f;
        float* scr = (float*)(lds + wave * 16384);
        constexpr int I_WIN = 16 * (NPROJ / 32), I_QB = 6 * 24, I_KVB = 4 * 32, I_A = 8 * 32, I_OUT = 16 * 32, I_PQ = 16 * 64;
        constexpr int NITEMS = I_WIN + I_QB + I_KVB + 2 * I_A + I_OUT + I_PQ;
        for (int it = gw; it < NITEMS; it += NGW) {
            int r = it;
            if (r < I_WIN) { transpose_item(w_in, 1024, 4272, WIN, NPROJ, nullptr, true, scr, r, lane); continue; } r -= I_WIN;
            if (r < I_QB) { transpose_item(w_qb, 384, 768, WQB, 768, g_q_lat, false, scr, r, lane); continue; } r -= I_QB;
            if (r < I_KVB) { transpose_item(w_kvb, 256, 1024, WKVB, 1024, g_kv_lat, false, scr, r, lane); continue; } r -= I_KVB;
            if (r < I_A) { transpose_item(w_branch_a, 512, 1024, WA, 1024, nullptr, false, scr, r, lane); continue; } r -= I_A;
            if (r < I_A) { transpose_item(w_branch_b, 512, 1024, WB, 1024, nullptr, false, scr, r, lane); continue; } r -= I_A;
            if (r < I_OUT) { transpose_item(w_out, 1024, 1024, WOUT, 1024, nullptr, false, scr, r, lane); continue; } r -= I_OUT;
            transpose_item(w_peer_q, 1024, 2048, WPQ, 2048, g_ffn, false, scr, r, lane);
        }
        for (int i = gtid; i < 16 * 128 * 128; i += NT) KEYS[i] = f2bf(sub_keys[i]);
        for (int i = gtid; i < M_ * 16; i += NT) { const int m = i >> 4, f = i & 15;
            const double inv = pow(10000.0, -(double)f / 16.0); const double ang = (double)positions[m] * inv;
            COS[i] = (float)cos(ang); SIN[i] = (float)sin(ang); }
        for (int row = gw * 2; row < M_; row += NGW * 2) {
            f32x4 v[2][4];
#pragma unroll
            for (int rr = 0; rr < 2; ++rr)
#pragma unroll
                for (int j = 0; j < 4; ++j) v[rr][j] = ((const f32x4*)(x + (size_t)(row + rr) * DM))[lane + 64 * j];
#pragma unroll
            for (int rr = 0; rr < 2; ++rr) { float ss = 0.f;
#pragma unroll
                for (int j = 0; j < 4; ++j) ss += (v[rr][j][0] * v[rr][j][0] + v[rr][j][1] * v[rr][j][1]) + (v[rr][j][2] * v[rr][j][2] + v[rr][j][3] * v[rr][j][3]);
                ss = wave_sum(ss); const float r = rsqrtf(ss * (1.f / DM) + EPS);
#pragma unroll
                for (int j = 0; j < 4; ++j) { const int c = 4 * (lane + 64 * j); const f32x4 gg = *(const f32x4*)(g_mix + c);
                    u32x2 w; w.x = pk2(v[rr][j][0] * r * gg[0], v[rr][j][1] * r * gg[1]); w.y = pk2(v[rr][j][2] * r * gg[2], v[rr][j][3] * r * gg[3]);
                    *(u32x2*)(XN + (size_t)(row + rr) * DM + c) = w; } }
        }
    }
    SEAM(0);
    if (MK_N_LAUNCHES == 1 && IN(0) && IN(1)) { if (tid == 0) { unsigned ord = 0; for (unsigned j = 0; j < 16; ++j) if (j < bar.x && xb_ld(&bar.bar[XB_XCNT(j)]) > 0u) ++ord; bar.st[3] = ord; } __syncthreads(); }
    if (IN(1)) {
        pg8::Gemm g{XN, WIN, nullptr, nullptr, DM, DM, M_, NPROJ, DM, 1}; pg8::StaticOrder S; S.init(g, G, (int)blockIdx.x);
        pg8::EpiProj E{PROJB, PROJA, SSQ, SSKV};
        pg8::gemm_phase<pg8::EpiProj, pg8::StaticOrder, true>(ring, g, S, E);
        { const int nwg_ = (M_ / 256) * (NPROJ / 256), rem_ = nwg_ % G, c_ = (int)blockIdx.x; const int nq_ = rem_ ? G - rem_ : G, qi_ = rem_ ? c_ - rem_ : c_;
          if (qi_ >= 0) for (int row = 2 * (qi_ * NWAVES + wave); row < 32768; row += 2 * nq_ * NWAVES) {
              if (row < 16384) quant_rows2<0>(peer_u, g_ffn, UT, SU, row, lane); else quant_rows2<0>(peer_v, nullptr, VT, SV, row - 16384, lane); } }
    }
    SEAM(1);
    if (IN(2)) {
        { pg8::Gemm g{PROJA + PA_QLAT, WQB, nullptr, nullptr, PA_LD, 384, M_, 768, 384, 1}; pg8::StaticOrder S; S.init(g, G, (int)blockIdx.x);
          pg8::EpiQ E{Q, SSQ, COS, SIN}; pg8::gemm_phase<pg8::EpiQ, pg8::StaticOrder, true>(ring, g, S, E); }
        { pg8::Gemm g{PROJA + PA_KVLAT, WKVB, nullptr, nullptr, PA_LD, 256, M_, 1024, 256, 1}; pg8::StaticOrder S; S.init(g, G, (int)blockIdx.x);
          pg8::EpiKV E{K, V, SSKV}; pg8::gemm_phase<pg8::EpiKV, pg8::StaticOrder, true>(ring, g, S, E); }
        for (int i = gtid; i < M_ * 32; i += NT) { const int m = i >> 5, j = i & 31; const bf16_t* kr = PROJA + (size_t)m * PA_LD + PA_KROPE; float o;
            if (j < 16) { const float x1 = bf2f(kr[j]), x2 = bf2f(kr[j + 16]); o = x1 * COS[m * 16 + j] - x2 * SIN[m * 16 + j]; }
            else { const int f = j - 16; const float x2 = bf2f(kr[j]), x1 = bf2f(kr[j - 16]); o = x2 * COS[m * 16 + f] + x1 * SIN[m * 16 + f]; }
            KPE[i] = f2bf(o); }
        __syncthreads();
        {
            const int r32 = lane & 31, hi5 = lane >> 5;
            unsigned char* gvt = lds; unsigned char* kdt = lds + 16384;
            const int tbase = (int)(uintptr_t)lds + gla::t_rd_base(lane);
            for (int unit = vcu; unit < 2 * NCH * 4; unit += G) {
                const int h = unit & 3, bc = unit >> 2, t0 = bc * 64;
                {
                    const int sr = tid >> 4, ch = tid & 15;
#pragma unroll
                    for (int rr = 0; rr < 2; ++rr) { const int row = sr + 32 * rr; const u32x4 v = *(const u32x4*)(PROJA + (size_t)(t0 + row) * PA_LD + PA_GV + h * 128 + ch * 8);
                        *(u32x4*)(gvt + gla::t_st<4>(row, ch * 8)) = v; }
                }
                {
                    const int k0 = wave * 8; const bf16_t* prow = PROJA + (size_t)(t0 + lane) * PA_LD;
                    const u32x4 ga = *(const u32x4*)(prow + PA_GLR), gb = *(const u32x4*)(prow + PA_GLR + 8), gkv = *(const u32x4*)(prow + PA_GK + h * 64 + k0);
                    float glr[16];
#pragma unroll
                    for (int q = 0; q < 4; ++q) { glr[2 * q] = __uint_as_float(ga[q] << 16); glr[2 * q + 1] = __uint_as_float(ga[q] & 0xffff0000u); glr[8 + 2 * q] = __uint_as_float(gb[q] << 16); glr[8 + 2 * q + 1] = __uint_as_float(gb[q] & 0xffff0000u); }
                    float kdv[8];
#pragma unroll
                    for (int j = 0; j < 8; ++j) { const int kc = h * 64 + k0 + j; float z = b_a2[kc];
#pragma unroll
                        for (int r = 0; r < 16; ++r) z += glr[r] * w_a2[r * 256 + kc];
                        float v = (fminf(z, 0.f) - log1pf(expf(-fabsf(z)))) * (1.f / 16.f);
#pragma unroll
                        for (int d = 1; d < 64; d <<= 1) { const float t = __shfl_up(v, d); v += (lane >= d) ? t : 0.f; }
                        const float cl = __builtin_bit_cast(float, __builtin_amdgcn_readlane(__builtin_bit_cast(int, v), 63));
                        const unsigned gw_ = gkv[j >> 1]; const float gk = (j & 1) ? __uint_as_float(gw_ & 0xffff0000u) : __uint_as_float(gw_ << 16);
                        kdv[j] = gk * expf(cl - v);
                        if (lane == 0) DECAY[((size_t)bc * 4 + h) * 64 + k0 + j] = expf(cl); }
                    u32x4 w; w.x = pk2(kdv[0], kdv[1]); w.y = pk2(kdv[2], kdv[3]); w.z = pk2(kdv[4], kdv[5]); w.w = pk2(kdv[6], kdv[7]);
                    *(u32x4*)(kdt + gla::t_st<2>(lane, k0)) = w;
                }
                __syncthreads();
                {
                    const int kt = wave >> 2, vt = wave & 3; gla::f32x16 acc = {};
                    gla::s16x4 al[4], ah[4], bl[4], bh[4];
                    const int abase = tbase + kt * 512, bbase = tbase + vt * 512;
#define GLA_KS(ks) do { GLA_TRRD(al[ks], abase, 16384 + gla::t_rd_off<2>(0, ks, 0)); GLA_TRRD(ah[ks], abase, 16384 + gla::t_rd_off<2>(0, ks, 1)); GLA_TRRD(bl[ks], bbase, gla::t_rd_off<4>(0, ks, 0)); GLA_TRRD(bh[ks], bbase, gla::t_rd_off<4>(0, ks, 1)); } while (0)
                    GLA_KS(0); GLA_KS(1); GLA_KS(2); GLA_KS(3);
#undef GLA_KS
                    asm volatile("s_waitcnt lgkmcnt(0)" ::: "memory"); __builtin_amdgcn_sched_barrier(0);
#pragma unroll
                    for (int ks = 0; ks < 4; ++ks) acc = __builtin_amdgcn_mfma_f32_32x32x16_bf16((gla::bf16x8){al[ks][0], al[ks][1], al[ks][2], al[ks][3], ah[ks][0], ah[ks][1], ah[ks][2], ah[ks][3]},
                                                                                                 (gla::bf16x8){bl[ks][0], bl[ks][1], bl[ks][2], bl[ks][3], bh[ks][0], bh[ks][1], bh[ks][2], bh[ks][3]}, acc, 0, 0, 0);
                    float* dp = DST + (((size_t)bc * 4 + h) * 64 + kt * 32) * 128 + vt * 32 + r32;
#pragma unroll
                    for (int r = 0; r < 16; ++r) dp[(size_t)gla::crow(r, hi5) * 128] = acc[r];
                }
                __syncthreads();
            }
        }
    }
    SEAM(2);
    if (IN(3)) {
        if (tid < 256) for (int i = vcu * 256 + tid; i < 65536; i += G * 256) {
            const int v = i & 127, k = (i >> 7) & 63, h = (i >> 13) & 3, b = i >> 15; float s = 0.f;
            float* dp = DST + (((size_t)b * NCH * 4 + h) * 64 + k) * 128 + v; const float* gp = DECAY + ((size_t)b * NCH * 4 + h) * 64 + k;
            float d[8], g[8], dn[8], gn[8];
#pragma unroll
            for (int j = 0; j < 8; ++j) { d[j] = dp[(size_t)j * 32768]; g[j] = gp[(size_t)j * 256]; }
            for (int c0 = 0; c0 < NCH; c0 += 8) {
                const int cn = (c0 + 8 < NCH) ? c0 + 8 : c0;
#pragma unroll
                for (int j = 0; j < 8; ++j) { dn[j] = dp[(size_t)(cn + j) * 32768]; gn[j] = gp[(size_t)(cn + j) * 256]; }
#pragma unroll
                for (int j = 0; j < 8; ++j) { s = g[j] * s + d[j]; d[j] = s; }
#pragma unroll
                for (int j = 0; j < 8; ++j) dp[(size_t)(c0 + j) * 32768] = d[j];
#pragma unroll
                for (int j = 0; j < 8; ++j) { d[j] = dn[j]; g[j] = gn[j]; } } }
        __syncthreads();
        {
            for (int pr = vcu; pr < 256; pr += G) {
                const int bh = pr >> 4, s16 = pr & 15, b = bh >> 3, h = bh & 7;
                att::BlockRef r0, r1;
                const bf16_t* Kh = K + (size_t)b * SEQ * att::KS + h * 96; const bf16_t* Vh = V + (size_t)b * SEQ * att::VS + h * 64;
                const int qb0 = 31 - s16, qb1 = s16;
                r0.Q = Q + ((size_t)b * SEQ + qb0 * 256) * att::QS + h * 96; r0.O = YA + ((size_t)b * SEQ + qb0 * 256) * att::OS + h * 64; r0.K = Kh; r0.KPE = KPE + (size_t)b * SEQ * 32; r0.V = Vh; r0.P0 = qb0 * 256;
                r1.Q = Q + ((size_t)b * SEQ + qb1 * 256) * att::QS + h * 96; r1.O = YA + ((size_t)b * SEQ + qb1 * 256) * att::OS + h * 64; r1.K = Kh; r1.KPE = KPE + (size_t)b * SEQ * 32; r1.V = Vh; r1.P0 = qb1 * 256;
                att::attn_block_dma(r0, (char*)lds);
                att::attn_block_dma(r1, (char*)lds);
            }
        }
    }
    SEAM(3);
    if (IN(4)) {
        const int r32 = lane & 31, hi5 = lane >> 5;
        unsigned char* stt = lds; float* part = (float*)(lds + 16384);
        const int lt = wave >> 2, vt = wave & 3;
        const int bbase = (int)(uintptr_t)lds + gla::t_rd_base(lane) + vt * 512;
        for (int unit = vcu; unit < 2 * NCH * 4; unit += G) {
            const int h = unit & 3, bc = unit >> 2, t0 = bc * 64;
            {   const int sr = tid >> 4, ch = tid & 15; const float* sp = DST + ((size_t)bc * 4 + h) * 64 * 128;
#pragma unroll
                for (int rr = 0; rr < 2; ++rr) { const int row = sr + 32 * rr; const f32x4 a = *(const f32x4*)(sp + row * 128 + ch * 8), b = *(const f32x4*)(sp + row * 128 + ch * 8 + 4);
                    u32x4 w; w.x = pk2(a[0], a[1]); w.y = pk2(a[2], a[3]); w.z = pk2(b[0], b[1]); w.w = pk2(b[2], b[3]);
                    *(u32x4*)(stt + gla::t_st<4>(row, ch * 8)) = w; } }
            gla::bf16x8 qa[4];
            { const bf16_t* qrow = PROJB + (size_t)(t0 + lt * 32 + r32) * PB_LD + PB_GQ + h * 64 + hi5 * 8;
#pragma unroll
              for (int ks = 0; ks < 4; ++ks) qa[ks] = *(const gla::bf16x8*)(qrow + ks * 16); }
            __syncthreads();
            gla::f32x16 acc = {};
            { gla::s16x4 bl[4], bh[4];
#define GLA_KS(ks) do { GLA_TRRD(bl[ks], bbase, gla::t_rd_off<4>(0, ks, 0)); GLA_TRRD(bh[ks], bbase, gla::t_rd_off<4>(0, ks, 1)); } while (0)
              GLA_KS(0); GLA_KS(1); GLA_KS(2); GLA_KS(3);
#undef GLA_KS
              asm volatile("s_waitcnt lgkmcnt(0)" ::: "memory"); __builtin_amdgcn_sched_barrier(0);
#pragma unroll
              for (int ks = 0; ks < 4; ++ks) acc = __builtin_amdgcn_mfma_f32_32x32x16_bf16(qa[ks], (gla::bf16x8){bl[ks][0], bl[ks][1], bl[ks][2], bl[ks][3], bh[ks][0], bh[ks][1], bh[ks][2], bh[ks][3]}, acc, 0, 0, 0); }
            float rs[16];
#pragma unroll
            for (int r = 0; r < 16; ++r) { acc[r] *= 0.125f; float s2 = acc[r] * acc[r];
                s2 += __builtin_bit_cast(float, __builtin_amdgcn_update_dpp(0, __builtin_bit_cast(int, s2), 0x128, 0xf, 0xf, false));
                s2 += __builtin_bit_cast(float, __builtin_amdgcn_update_dpp(0, __builtin_bit_cast(int, s2), 0x124, 0xf, 0xf, false));
                s2 += __builtin_bit_cast(float, __builtin_amdgcn_update_dpp(0, __builtin_bit_cast(int, s2), 0x122, 0xf, 0xf, false));
                s2 += __builtin_bit_cast(float, __builtin_amdgcn_update_dpp(0, __builtin_bit_cast(int, s2), 0x121, 0xf, 0xf, false));
                s2 += __shfl_xor(s2, 16); rs[r] = s2; }
            if (r32 == 0) {
#pragma unroll
                for (int r = 0; r < 16; ++r) part[(lt * 32 + gla::crow(r, hi5)) * 4 + vt] = rs[r]; }
            __syncthreads();
#pragma unroll
            for (int r = 0; r < 16; ++r) { const int l = lt * 32 + gla::crow(r, hi5); const f32x4 pp = *(const f32x4*)(part + l * 4);
                const float rn = rsqrtf(((pp[0] + pp[1]) + (pp[2] + pp[3])) * (1.f / 128.f) + EPS);
                const int v = vt * 32 + r32; const float go = bf2f(PROJB[(size_t)(t0 + l) * PB_LD + PB_GOUT + h * 128 + v]);
                const float silu = go * __builtin_amdgcn_rcpf(1.f + __expf(-go));
                YB[(size_t)(t0 + l) * 512 + h * 128 + v] = f2bf(acc[r] * rn * g_gla[h * 128 + v] * silu); }
            __syncthreads();
        }
    }
    SEAM(4);
    if (IN(5)) {
        pg8::Gemm g{YA, WA, YB, WB, 512, 512, M_, 1024, 512, 2}; pg8::StaticOrder S; S.init(g, G, (int)blockIdx.x);
        pg8::EpiMerge E{PROJB, MERGED}; pg8::gemm_phase<pg8::EpiMerge, pg8::StaticOrder, true>(ring, g, S, E);
    }
    SEAM(5);
    if (IN(6)) {
        pg8::Gemm g{MERGED, WOUT, nullptr, nullptr, DM, DM, M_, 1024, DM, 1}; pg8::StaticOrder S; S.init(g, G, (int)blockIdx.x);
        pg8::EpiX1 E{x, out, X1B, SSX1}; pg8::gemm_phase<pg8::EpiX1, pg8::StaticOrder, false>(ring, g, S, E);
    }
    SEAM(6);
    if (IN(7)) {
        pg8::Gemm g{X1B, WPQ, nullptr, nullptr, DM, DM, M_, 2048, DM, 1}; pg8::StaticOrder S; S.init(g, G, vcu); S.pair_mode = 1;
        pg8::EpiQP E{QP, SSX1}; pg8::gemm_phase<pg8::EpiQP, pg8::StaticOrder, true>(ring, g, S, E);
        asm volatile("s_waitcnt vmcnt(0)" ::: "memory"); __syncthreads();
    }
    if (IN(7)) {
        typedef short bf16x8_t __attribute__((ext_vector_type(8)));
        typedef float f32x16_t __attribute__((ext_vector_type(16)));
        const int r32 = lane & 31, hi = lane >> 5;
#define P8_SORTABLE(f) ({ const unsigned b_ = __float_as_uint(f); b_ ^ ((unsigned)((int)b_ >> 31) | 0x80000000u); })
#define P8_UNSORT(u) ({ const unsigned u_ = (u); __uint_as_float(u_ ^ (~(unsigned)((int)u_ >> 31) | 0x80000000u)); })
#define P8_CE(a, b) do { const unsigned hi_ = (a) > (b) ? (a) : (b), lo_ = (a) > (b) ? (b) : (a); (a) = hi_; (b) = lo_; } while (0)
#define P8_SORT16(x) do { P8_CE(x[0], x[1]); P8_CE(x[3], x[2]); P8_CE(x[4], x[5]); P8_CE(x[7], x[6]); P8_CE(x[8], x[9]); P8_CE(x[11], x[10]); P8_CE(x[12], x[13]); P8_CE(x[15], x[14]); P8_CE(x[0], x[2]); P8_CE(x[1], x[3]); P8_CE(x[6], x[4]); P8_CE(x[7], x[5]); P8_CE(x[8], x[10]); P8_CE(x[9], x[11]); P8_CE(x[14], x[12]); P8_CE(x[15], x[13]); P8_CE(x[0], x[1]); P8_CE(x[2], x[3]); P8_CE(x[5], x[4]); P8_CE(x[7], x[6]); P8_CE(x[8], x[9]); P8_CE(x[10], x[11]); P8_CE(x[13], x[12]); P8_CE(x[15], x[14]); P8_CE(x[0], x[4]); P8_CE(x[1], x[5]); P8_CE(x[2], x[6]); P8_CE(x[3], x[7]); P8_CE(x[12], x[8]); P8_CE(x[13], x[9]); P8_CE(x[14], x[10]); P8_CE(x[15], x[11]); P8_CE(x[0], x[2]); P8_CE(x[1], x[3]); P8_CE(x[4], x[6]); P8_CE(x[5], x[7]); P8_CE(x[10], x[8]); P8_CE(x[11], x[9]); P8_CE(x[14], x[12]); P8_CE(x[15], x[13]); P8_CE(x[0], x[1]); P8_CE(x[2], x[3]); P8_CE(x[4], x[5]); P8_CE(x[6], x[7]); P8_CE(x[9], x[8]); P8_CE(x[11], x[10]); P8_CE(x[13], x[12]); P8_CE(x[15], x[14]); P8_CE(x[0], x[8]); P8_CE(x[1], x[9]); P8_CE(x[2], x[10]); P8_CE(x[3], x[11]); P8_CE(x[4], x[12]); P8_CE(x[5], x[13]); P8_CE(x[6], x[14]); P8_CE(x[7], x[15]); P8_CE(x[0], x[4]); P8_CE(x[1], x[5]); P8_CE(x[2], x[6]); P8_CE(x[3], x[7]); P8_CE(x[8], x[12]); P8_CE(x[9], x[13]); P8_CE(x[10], x[14]); P8_CE(x[11], x[15]); P8_CE(x[0], x[2]); P8_CE(x[1], x[3]); P8_CE(x[4], x[6]); P8_CE(x[5], x[7]); P8_CE(x[8], x[10]); P8_CE(x[9], x[11]); P8_CE(x[12], x[14]); P8_CE(x[13], x[15]); P8_CE(x[0], x[1]); P8_CE(x[2], x[3]); P8_CE(x[4], x[5]); P8_CE(x[6], x[7]); P8_CE(x[8], x[9]); P8_CE(x[10], x[11]); P8_CE(x[12], x[13]); P8_CE(x[14], x[15]); } while (0)
#define P8_MERGE16(A, B, O) do { _Pragma("unroll") for (int i_ = 0; i_ < 16; ++i_) O[i_] = (A)[i_] > (B)[15 - i_] ? (A)[i_] : (B)[15 - i_]; \
        _Pragma("unroll") for (int s_ = 8; s_ >= 1; s_ >>= 1) _Pragma("unroll") for (int i_ = 0; i_ < 16; ++i_) if ((i_ & s_) == 0) P8_CE(O[i_], O[i_ + s_]); } while (0)
#define P8_INSERT(t, v) do { unsigned v_ = (v); _Pragma("unroll") for (int q_ = 0; q_ < 16; ++q_) { const unsigned a_ = t[q_] > v_ ? t[q_] : v_; v_ = t[q_] > v_ ? v_ : t[q_]; t[q_] = a_; } } while (0)
        for (int item = vcu; item < 256; item += G) {
            const int h = item & 7, tr = item >> 3;
            for (int c = tid; c < 2 * 128 * 16; c += 512) { const int p = c >> 11, row = (c >> 4) & 127, ch = c & 15;
                const u32x4 v = *(const u32x4*)(KEYS + ((size_t)(h * 2 + p) * 128 + row) * 128 + ch * 8);
                *(u32x4*)(lds + p * 32768 + row * 256 + ((ch * 16) ^ ((row & 7) << 4))) = v; }
            __syncthreads();
#pragma unroll 1
            for (int step = 0; step < 2; ++step) {
                const int m = tr * 512 + wave * 64 + step * 32 + r32;
                unsigned top[2][16];
#pragma unroll
                for (int p = 0; p < 2; ++p) {
                    bf16x8_t qf[8];
#pragma unroll
                    for (int ks = 0; ks < 8; ++ks) qf[ks] = *(const bf16x8_t*)(QP + (size_t)m * 2048 + (h * 2 + p) * 128 + ks * 16 + hi * 8);
                    f32x16_t acc[4];
#pragma unroll
                    for (int kt = 0; kt < 4; ++kt) { acc[kt] = f32x16_t{};
                        const int row = kt * 32 + r32; const unsigned char* rb = lds + p * 32768 + row * 256;
#pragma unroll
                        for (int ks = 0; ks < 8; ++ks) { const bf16x8_t a = *(const bf16x8_t*)(rb + (((2 * ks + hi) * 16) ^ ((row & 7) << 4)));
                            acc[kt] = __builtin_amdgcn_mfma_f32_32x32x16_bf16(a, qf[ks], acc[kt], 0, 0, 0); } }
                    unsigned xs[4][16];
#pragma unroll
                    for (int kt = 0; kt < 4; ++kt)
#pragma unroll
                        for (int r = 0; r < 16; ++r) { const unsigned base = 32 * kt + (r & 3) + 8 * (r >> 2);
                            xs[kt][r] = (P8_SORTABLE(acc[kt][r]) | 127u) ^ base; }
                    P8_SORT16(xs[0]); P8_SORT16(xs[1]); P8_SORT16(xs[2]); P8_SORT16(xs[3]);
                    unsigned m01[16], m23[16], t[16];
                    P8_MERGE16(xs[0], xs[1], m01); P8_MERGE16(xs[2], xs[3], m23); P8_MERGE16(m01, m23, t);
#pragma unroll
                    for (int i = 0; i < 16; ++i) t[i] ^= (unsigned)(hi << 2);
                    unsigned mm[16];
#pragma unroll
                    for (int i = 0; i < 16; ++i) { auto rr = __builtin_amdgcn_permlane32_swap(t[15 - i], t[15 - i], false, false); const unsigned pt = hi ? rr[0] : rr[1]; mm[i] = t[i] > pt ? t[i] : pt; }
#pragma unroll
                    for (int sft = 8; sft >= 1; sft >>= 1)
#pragma unroll
                        for (int i = 0; i < 16; ++i) if ((i & sft) == 0) { const unsigned a_ = mm[i] > mm[i + sft] ? mm[i] : mm[i + sft], b_ = mm[i] > mm[i + sft] ? mm[i + sft] : mm[i]; mm[i] = a_; mm[i + sft] = b_; }
#pragma unroll
                    for (int i = 0; i < 16; ++i) top[p][i] = mm[i];
                }
                float f0[16], f1[16];
#pragma unroll
                for (int i = 0; i < 16; ++i) { f0[i] = P8_UNSORT(top[0][i] & 0xFFFFFF80u); f1[i] = P8_UNSORT(top[1][i] & 0xFFFFFF80u); }
#define P8_CV(a, b) ((P8_SORTABLE(f0[a] + f1[b]) | 255u) ^ (unsigned)((a) * 16 + (b)))
                unsigned l0[16], x1[16], x2[16], x3[16], m1[16], m2[16], cb[16];
#pragma unroll
                for (int b = 0; b < 16; ++b) l0[b] = P8_CV(0, b);
#pragma unroll
                for (int b = 0; b < 8; ++b) x1[b] = P8_CV(1, b);
#pragma unroll
                for (int b = 0; b < 5; ++b) x1[8 + b] = P8_CV(2, b);
#pragma unroll
                for (int b = 0; b < 3; ++b) x1[13 + b] = P8_CV(3, b);
                x2[0] = P8_CV(3, 3);
#pragma unroll
                for (int b = 0; b < 3; ++b) x2[1 + b] = P8_CV(4, b);
#pragma unroll
                for (int b = 0; b < 2; ++b) { x2[4 + b] = P8_CV(5, b); x2[6 + b] = P8_CV(6, b); x2[8 + b] = P8_CV(7, b); }
                x2[10] = P8_CV(8, 0); x2[11] = P8_CV(9, 0); x2[12] = P8_CV(10, 0); x2[13] = P8_CV(11, 0); x2[14] = P8_CV(12, 0); x2[15] = P8_CV(13, 0);
                x3[0] = P8_CV(14, 0); x3[1] = P8_CV(15, 0);
#pragma unroll
                for (int i = 2; i < 16; ++i) x3[i] = 0u;
#undef P8_CV
                P8_SORT16(x1); P8_SORT16(x2);
                P8_MERGE16(l0, x1, m1); P8_MERGE16(x2, x3, m2); P8_MERGE16(m1, m2, cb);
                unsigned char* slot = lds + 65536 + wave * 2048 + lane * 32;
                { u32x4 w0, w1;
#define P8_IDX4(T, i) ((127u - (T[i] & 127u)) | ((127u - (T[(i) + 1] & 127u)) << 8) | ((127u - (T[(i) + 2] & 127u)) << 16) | ((127u - (T[(i) + 3] & 127u)) << 24))
                  w0.x = P8_IDX4(top[0], 0); w0.y = P8_IDX4(top[0], 4); w0.z = P8_IDX4(top[0], 8); w0.w = P8_IDX4(top[0], 12);
                  w1.x = P8_IDX4(top[1], 0); w1.y = P8_IDX4(top[1], 4); w1.z = P8_IDX4(top[1], 8); w1.w = P8_IDX4(top[1], 12);
#undef P8_IDX4
                  *(u32x4*)slot = w0; *(u32x4*)(slot + 16) = w1; }
                asm volatile("s_waitcnt lgkmcnt(0)" ::: "memory");
                float bv[16]; int be[16];
#pragma unroll
                for (int k = 0; k < 16; ++k) { const unsigned pos = (~cb[k]) & 255u; bv[k] = P8_UNSORT(cb[k] & 0xFFFFFF00u);
                    be[k] = (int)slot[pos >> 4] * 128 + (int)slot[16 + (pos & 15)]; }
                { const float b0 = bv[0];
#pragma unroll
                  for (int k = 0; k < 16; ++k) bv[k] = __expf(bv[k] - b0); }
                asm volatile("s_waitcnt lgkmcnt(0)" ::: "memory");
                if (hi == 0) { int* ep = EIDX + (size_t)m * 128 + 2 * h;
#pragma unroll
                    for (int kk = 0; kk < 8; ++kk) { u32x2 w; w.x = (unsigned)be[kk]; w.y = (unsigned)be[kk + 8]; *(u32x2*)(ep + kk * 16) = w; } }
                else { float* gp = EGATE + (size_t)m * 128 + 2 * h; float s2 = 0.f;
#pragma unroll
                    for (int k = 0; k < 16; ++k) s2 += bv[k];
                    const float inv = 1.f / s2;
#pragma unroll
                    for (int kk = 0; kk < 8; ++kk) { u32x2 w; w.x = __float_as_uint(bv[kk] * inv); w.y = __float_as_uint(bv[kk + 8] * inv); *(u32x2*)(gp + kk * 16) = w; } }
            }
            __syncthreads();
        }
#undef P8_SORTABLE
#undef P8_UNSORT
#undef P8_INSERT
#undef P8_CE
#undef P8_SORT16
#undef P8_MERGE16
    }
    SEAM(8);
#define UB(w, e) ((float)(((w) >> (8 * (e))) & 0xffu))
#define DPP_ADD(v, ctrl) v += __builtin_bit_cast(float, __builtin_amdgcn_update_dpp(0, __builtin_bit_cast(int, v), (ctrl), 0xf, 0xf, false))
    volatile unsigned* MISCW = (volatile unsigned*)(lds + MISC_OFF);
    const int x_nloc = (MK_N_LAUNCHES == 1) ? (int)MISCW[8] : G, x_nx = (MK_N_LAUNCHES == 1) ? (int)MISCW[9] : 1, x_rank = (MK_N_LAUNCHES == 1) ? (int)MISCW[10] : (int)blockIdx.x, x_ord = (MK_N_LAUNCHES == 1) ? (int)MISCW[11] : 0;
    if (IN(9)) {
        const int g = lane >> 3, c = lane & 7;
        const int tstep = x_nloc * NWAVES;
        for (int sl = x_ord; sl < 8; sl += x_nx) {
            const unsigned char* ub = UT + (size_t)sl * (16384 * 128) + 16 * c;
            const bf16_t* xbase = X1B + sl * 128 + 16 * c;
#define P9_IDX(I4, XA, XB, tt) do { const int t_ = (tt) < M_ ? (tt) : M_ - 1; const u32x4* ep_ = (const u32x4*)(EIDX + (size_t)t_ * 128 + g * 16); \
            I4[0] = ep_[0]; I4[1] = ep_[1]; I4[2] = ep_[2]; I4[3] = ep_[3]; XA = *(const u32x4*)(xbase + (size_t)t_ * DM); XB = *(const u32x4*)(xbase + (size_t)t_ * DM + 8); } while (0)
#define P9_ROWS(U, I4, hf) do { _Pragma("unroll") for (int i = 0; i < 8; ++i) U[i] = *(const u32x4*)(ub + (size_t)I4[2 * (hf) + (i >> 2)][i & 3] * 128); } while (0)
#define P9_HALF(U, hf) do { _Pragma("unroll") for (int i = 0; i < 8; ++i) { int a = __builtin_amdgcn_sdot4((int)xq[0], (int)U[i][0], 0, false); a = __builtin_amdgcn_sdot4((int)xq[1], (int)U[i][1], a, false); \
                a = __builtin_amdgcn_sdot4((int)xq[2], (int)U[i][2], a, false); a = __builtin_amdgcn_sdot4((int)xq[3], (int)U[i][3], a, false); \
                a += __builtin_amdgcn_update_dpp(0, a, 0xB1, 0xf, 0xf, false); a += __builtin_amdgcn_update_dpp(0, a, 0x4E, 0xf, 0xf, false); a += __builtin_amdgcn_update_dpp(0, a, 0x141, 0xf, 0xf, false); \
                z0 = (8 * (hf) + i == 2 * c) ? a : z0; z1 = (8 * (hf) + i == 2 * c + 1) ? a : z1; } } while (0)
            u32x4 iC[4], iN[4], iNN[4], xaC, xbC, xaN, xbN, xaNN, xbNN, uA[8], uB[8];
            int t = x_rank * NWAVES + wave;
            P9_IDX(iC, xaC, xbC, t); P9_IDX(iN, xaN, xbN, t + tstep); P9_ROWS(uA, iC, 0);
            for (; t < M_; t += tstep) {
                P9_ROWS(uB, iC, 1); P9_IDX(iNN, xaNN, xbNN, t + 2 * tstep);
                float xf[16];
#pragma unroll
                for (int q = 0; q < 4; ++q) { xf[2 * q] = __uint_as_float(xaC[q] << 16); xf[2 * q + 1] = __uint_as_float(xaC[q] & 0xffff0000u); xf[8 + 2 * q] = __uint_as_float(xbC[q] << 16); xf[8 + 2 * q + 1] = __uint_as_float(xbC[q] & 0xffff0000u); }
                float mx = 1e-30f;
#pragma unroll
                for (int j = 0; j < 16; ++j) mx = fmaxf(mx, fabsf(xf[j]));
                mx = fmaxf(mx, __builtin_bit_cast(float, __builtin_amdgcn_update_dpp(0, __builtin_bit_cast(int, mx), 0xB1, 0xf, 0xf, false)));
                mx = fmaxf(mx, __builtin_bit_cast(float, __builtin_amdgcn_update_dpp(0, __builtin_bit_cast(int, mx), 0x4E, 0xf, 0xf, false)));
                mx = fmaxf(mx, __builtin_bit_cast(float, __builtin_amdgcn_update_dpp(0, __builtin_bit_cast(int, mx), 0x141, 0xf, 0xf, false)));
                const float xinv = 127.f * __builtin_amdgcn_rcpf(mx), xsc = mx * (1.f / 127.f);
                unsigned xq[4];
#pragma unroll
                for (int q = 0; q < 4; ++q) { unsigned b = 0;
#pragma unroll
                    for (int e = 0; e < 4; ++e) { const int qi = (int)rintf(xf[4 * q + e] * xinv); b |= ((unsigned)qi & 0xffu) << (8 * e); }
                    xq[q] = b; }
                int z0 = 0, z1 = 0;
                P9_HALF(uA, 0);
                P9_ROWS(uA, iN, 0);
                P9_HALF(uB, 1);
                { u32x2 w; w.x = __float_as_uint((float)z0 * xsc); w.y = __float_as_uint((float)z1 * xsc); *(u32x2*)(ZP + ((size_t)sl * M_ + t) * 128 + g * 16 + 2 * c) = w; }
#pragma unroll
                for (int q = 0; q < 4; ++q) { iC[q] = iN[q]; iN[q] = iNN[q]; }
                xaC = xaN; xbC = xbN; xaN = xaNN; xbN = xbNN;
            }
#undef P9_HALF
#undef P9_IDX
#undef P9_ROWS
        }
    }
    SEAM(9);
    if (IN(10)) {
        for (int t = gw; t < M_; t += NGW) { const float r = rsqrtf(SSX1[t] * (1.f / DM) + EPS); float av[2]; float mx = 1e-30f;
#pragma unroll
            for (int v = 0; v < 2; ++v) { const int p = lane + 64 * v; const int e = EIDX[(size_t)t * 128 + p]; float zs[8];
#pragma unroll
                for (int j = 0; j < 8; ++j) zs[j] = ZP[((size_t)j * M_ + t) * 128 + p];
                float z = ((zs[0] + zs[1]) + (zs[2] + zs[3])) + ((zs[4] + zs[5]) + (zs[6] + zs[7]));
                z *= SU[e] * r;
                av[v] = 0.5f * z * (1.f + erff(z * 0.70710678118654752f)) * EGATE[(size_t)t * 128 + p] * SV[e];
                mx = fmaxf(mx, fabsf(av[v])); }
#pragma unroll
            for (int o = 1; o < 64; o <<= 1) mx = fmaxf(mx, __shfl_xor(mx, o));
            const float inv = 127.f / mx;
            CQ[(size_t)t * 128 + lane] = (signed char)(int)rintf(av[0] * inv); CQ[(size_t)t * 128 + 64 + lane] = (signed char)(int)rintf(av[1] * inv);
            if (lane == 0) CS[t] = mx * (1.f / 127.f); }
    }
    SEAM(10);
    if (IN(11)) {
        const int g = lane >> 3, c = lane & 7;
        const int tstep = x_nloc * NWAVES;
        for (int sl = x_ord; sl < 8; sl += x_nx) {
            const unsigned char* vb = VT + (size_t)sl * (16384 * 128) + 16 * c;
#define P11_IDX(I4, C4, tt) do { const int t_ = (tt) < M_ ? (tt) : M_ - 1; const u32x4* ep_ = (const u32x4*)(EIDX + (size_t)t_ * 128 + g * 16); \
            I4[0] = ep_[0]; I4[1] = ep_[1]; I4[2] = ep_[2]; I4[3] = ep_[3]; C4 = *(const u32x4*)(CQ + (size_t)t_ * 128 + g * 16); } while (0)
#define P11_ROWS(U, I4, hf) do { _Pragma("unroll") for (int i = 0; i < 8; ++i) U[i] = *(const u32x4*)(vb + (size_t)I4[2 * (hf) + (i >> 2)][i & 3] * 128); } while (0)
#define P11_BLK(U, b0, q, CW) do { const unsigned d0_ = U[b0][q], d1_ = U[(b0) + 1][q], d2_ = U[(b0) + 2][q], d3_ = U[(b0) + 3][q]; \
            const unsigned t0_ = __builtin_amdgcn_perm(d1_, d0_, 0x05010400u), t1_ = __builtin_amdgcn_perm(d1_, d0_, 0x07030602u), t2_ = __builtin_amdgcn_perm(d3_, d2_, 0x05010400u), t3_ = __builtin_amdgcn_perm(d3_, d2_, 0x07030602u); \
            acc[4 * (q)] = __builtin_amdgcn_sdot4((int)__builtin_amdgcn_perm(t2_, t0_, 0x05040100u), (int)(CW), acc[4 * (q)], false); \
            acc[4 * (q) + 1] = __builtin_amdgcn_sdot4((int)__builtin_amdgcn_perm(t2_, t0_, 0x07060302u), (int)(CW), acc[4 * (q) + 1], false); \
            acc[4 * (q) + 2] = __builtin_amdgcn_sdot4((int)__builtin_amdgcn_perm(t3_, t1_, 0x05040100u), (int)(CW), acc[4 * (q) + 2], false); \
            acc[4 * (q) + 3] = __builtin_amdgcn_sdot4((int)__builtin_amdgcn_perm(t3_, t1_, 0x07060302u), (int)(CW), acc[4 * (q) + 3], false); } while (0)
#define P11_HALF(U, C4, hf) do { _Pragma("unroll") for (int bb = 0; bb < 2; ++bb) { const unsigned cw_ = C4[2 * (hf) + bb]; \
            _Pragma("unroll") for (int q = 0; q < 4; ++q) P11_BLK(U, 4 * bb, q, cw_); } } while (0)
            u32x4 iC[4], iN[4], iNN[4], uA[8], uB[8], cC, cN, cNN;
            const int hi5 = lane >> 5, b3 = (lane >> 3) & 1;
            int t = x_rank * NWAVES + wave;
            P11_IDX(iC, cC, t); P11_IDX(iN, cN, t + tstep); P11_ROWS(uA, iC, 0);
            for (; t < M_; t += tstep) {
                float* op = out + (size_t)t * DM + sl * 128 + 16 * c + 4 * b3 + 8 * hi5;
                const f32x4 x1v = *(const f32x4*)op; const float cs = CS[t];
                P11_ROWS(uB, iC, 1); P11_IDX(iNN, cNN, t + 2 * tstep);
                int acc[16];
#pragma unroll
                for (int j = 0; j < 16; ++j) acc[j] = 0;
                P11_HALF(uA, cC, 0);
                P11_ROWS(uA, iN, 0);
                P11_HALF(uB, cC, 1);
                int w8[8];
#pragma unroll
                for (int j = 0; j < 8; ++j) { auto rr = __builtin_amdgcn_permlane32_swap((unsigned)acc[j], (unsigned)acc[j + 8], false, false); w8[j] = (int)rr[0] + (int)rr[1]; }
#pragma unroll
                for (int j = 0; j < 8; ++j) w8[j] += __shfl_xor(w8[j], 16);
                f32x4 o; float ss = 0.f;
#pragma unroll
                for (int j = 0; j < 4; ++j) { const int keep = b3 ? w8[j + 4] : w8[j]; const int give = b3 ? w8[j] : w8[j + 4];
                    const int tot = keep + __builtin_amdgcn_update_dpp(0, give, 0x128, 0xf, 0xf, false);
                    o[j] = x1v[j] + (float)tot * cs; ss += o[j] * o[j]; }
                if (((lane >> 4) & 1) == 0) *(f32x4*)op = o;
                DPP_ADD(ss, 0x128); DPP_ADD(ss, 0x124); DPP_ADD(ss, 0x122); DPP_ADD(ss, 0x121);
                { const float s0 = __builtin_bit_cast(float, __builtin_amdgcn_readlane(__builtin_bit_cast(int, ss), 0)), s1 = __builtin_bit_cast(float, __builtin_amdgcn_readlane(__builtin_bit_cast(int, ss), 32));
                  if (lane == 0) atomicAdd(SS2 + t, s0 + s1); }
#pragma unroll
                for (int q = 0; q < 4; ++q) { iC[q] = iN[q]; iN[q] = iNN[q]; }
                cC = cN; cN = cNN;
            }
#undef P11_BLK
#undef P11_HALF
#undef P11_IDX
#undef P11_ROWS
        }
    }
    SEAM(11);
    if (IN(12)) {
        for (int m = gw; m < M_; m += NGW) { const float r2 = rsqrtf(SS2[m] * (1.f / DM) + EPS); float* orow = out + (size_t)m * DM;
#pragma unroll
            for (int j = 0; j < 4; ++j) { const int cix = 4 * (lane + 64 * j); const f32x4 gg = *(const f32x4*)(g_final + cix); f32x4 o = *(const f32x4*)(orow + cix);
                o[0] *= r2 * gg[0]; o[1] *= r2 * gg[1]; o[2] *= r2 * gg[2]; o[3] *= r2 * gg[3]; *(f32x4*)(orow + cix) = o; } }
    }
#undef UB
#undef DPP_ADD
#undef IN
#undef SEAM
}

extern "C" void kernel_launch(void* const* d_in, const int* in_sizes, int n_in, void* d_out, int out_size, void* d_ws, size_t ws_size, hipStream_t stream) {
    static int grid = 0;
    if (grid == 0) {
        if (n_in != 20 || out_size != M_ * DM || ws_size < WS_END) { fprintf(stderr, "kernel_launch: unexpected shapes (n_in %d out %d ws %zu); nothing launched\n", n_in, out_size, ws_size); grid = -1; return; }
        int dev = 0, cus = 0;
        if (hipGetDevice(&dev) != hipSuccess || hipDeviceGetAttribute(&cus, hipDeviceAttributeMultiprocessorCount, dev) != hipSuccess) { grid = -1; return; }
        if (hipFuncSetAttribute((const void*)fwd, hipFuncAttributeMaxDynamicSharedMemorySize, LDS_BYTES) != hipSuccess) { fprintf(stderr, "kernel_launch: hipFuncSetAttribute failed\n"); grid = -1; return; }
        int per_cu = 0;
        if (hipOccupancyMaxActiveBlocksPerMultiprocessor(&per_cu, (const void*)fwd, NWAVES * 64, LDS_BYTES) != hipSuccess || per_cu < 1) fprintf(stderr, "kernel_launch: occupancy query reports %d\n", per_cu);
        (void)hipGetLastError();
        grid = cus;
    }
    if (grid < 0) return;
    (void)hipMemsetAsync((char*)d_ws + WS_CTL, 0, CTL_ZERO_BYTES, stream);
    Args a; memset(&a, 0, sizeof(a));
    for (int i = 0; i < 20; ++i) a.in[i] = d_in[i];
    a.out = (float*)d_out; a.ws = (unsigned char*)d_ws;
    if (MK_N_LAUNCHES == 1) { a.ph_lo = 0; a.ph_hi = N_PHASES; hipLaunchKernelGGL(fwd, dim3(grid), dim3(NWAVES * 64), LDS_BYTES, stream, a); }
    else for (int p = 0; p < N_PHASES; ++p) { a.ph_lo = p; a.ph_hi = p + 1; hipLaunchKernelGGL(fwd, dim3(grid), dim3(NWAVES * 64), LDS_BYTES, stream, a); }
}
```

```cpp
#include <hip/hip_runtime.h>
#include <cstdio>
#include <cstdint>
#include <cstring>
#include <math.h>

#ifndef MK_N_LAUNCHES
#define MK_N_LAUNCHES 1
#endif
constexpr int N_PHASES = 13;

typedef unsigned short bf16_t;
constexpr int SEQ = 8192, DM = 1024, M_ = 16384, NCH = 128;
constexpr float EPS = 1e-6f;
constexpr int PB_LD = 2816, PA_LD = 1536;
constexpr int PB_BR = 0, PB_GOUT = 2048, PB_GQ = 2560;
constexpr int PA_GV = 0, PA_GK = 512, PA_QLAT = 768, PA_KVLAT = 1152, PA_KROPE = 1408, PA_GLR = 1440;
constexpr int NPROJ = 4352;
constexpr float CQ = 0.10206207261596577f * 1.4426950408889634f;

constexpr size_t MiB = 1u << 20;
constexpr size_t WS_CTL = 0, CTL_ZERO_BYTES = 256 * 1024;
constexpr size_t WS_SSQ = 1 * MiB, WS_SSKV = WS_SSQ + 65536, WS_SSX1 = WS_SSKV + 65536, WS_SS2 = WS_SSX1 + 65536, WS_C128 = WS_SS2 + 65536  , WS_CB = 136 * MiB  , WS_ZP = 56 * MiB  , WS_COS = 2 * MiB, WS_SIN = 3 * MiB;
constexpr size_t WS_DECAY = 1 * MiB + 512 * 1024;
constexpr size_t WS_WIN = 4 * MiB, WS_WQB = 13 * MiB, WS_WKVB = 14 * MiB, WS_WA = 15 * MiB, WS_WB = 16 * MiB, WS_WOUT = 17 * MiB, WS_WPQ = 19 * MiB, WS_KEYS = 23 * MiB;
constexpr size_t WS_PROJB = 24 * MiB, WS_PROJA = 112 * MiB, WS_XN = 160 * MiB, WS_Q = 160 * MiB, WS_K = 184 * MiB, WS_V = 208 * MiB, WS_DST = 224 * MiB;
constexpr size_t WS_YA = 112 * MiB, WS_YB = 128 * MiB, WS_MERGED = 160 * MiB, WS_X1B = 24 * MiB, WS_QP = 56 * MiB, WS_EIDX = 120 * MiB, WS_EGATE = 128 * MiB;
constexpr size_t WS_KPE = 208 * MiB  , WS_UT = 224 * MiB, WS_VT = 240 * MiB, WS_SU = 1 * MiB + 768 * 1024, WS_SV = WS_SU + 65536;
constexpr size_t WS_END = 256 * MiB;

#define GAS __attribute__((address_space(1)))
#define LAS __attribute__((address_space(3)))
typedef float f32x4 __attribute__((ext_vector_type(4)));
typedef unsigned u32x4 __attribute__((ext_vector_type(4)));
typedef unsigned u32x2 __attribute__((ext_vector_type(2)));

__device__ __forceinline__ float bf2f(bf16_t h) { return __uint_as_float(((unsigned)h) << 16); }
__device__ __forceinline__ unsigned f2bf_u(float f) { unsigned u = __float_as_uint(f); return (u + 0x7fffu + ((u >> 16) & 1u)) >> 16; }
__device__ __forceinline__ bf16_t f2bf(float f) { return (bf16_t)f2bf_u(f); }
__device__ __forceinline__ unsigned pk2(float lo, float hi) { return f2bf_u(lo) | (f2bf_u(hi) << 16); }
__device__ __forceinline__ float wave_sum(float v) {
#pragma unroll
    for (int o = 1; o < 64; o <<= 1) v += __shfl_xor(v, o);
    return v;
}
__device__ __forceinline__ float sigmoidf_(float x) { return 1.f / (1.f + __expf(-x)); }

namespace pg8 {
#define PG8_LAS __attribute__((address_space(3)))
typedef short bf16x8 __attribute__((ext_vector_type(8)));
constexpr int BM = 256, BK = 64, HALF = 128, HTB = HALF * BK * 2, STAGE_BYTES = 8 * HTB, NXCD = 8, WGM = 8;
__host__ __device__ __forceinline__ int lds_byte(int r, int c) { const int st = (r >> 4) * 2 + (c >> 5), rr = r & 15, cc = c & 31, ob = rr * 64 + cc * 2; return st * 1024 + (ob ^ (((ob >> 9) & 1) << 5)); }
__host__ __device__ __forceinline__ void stage_rc(int b, int& R, int& C) { const int st = b / 1024, sb = b % 1024, swz = sb ^ (((sb >> 9) & 1) << 5); R = (st >> 1) * 16 + swz / 64; C = (st & 1) * 32 + (swz % 64) / 2; }
__host__ __device__ __forceinline__ int perm32(int rho) { const int n = rho >> 4, i = rho & 15; return 8 * (i >> 2) + 4 * n + (i & 3); }

struct Unit { int pm, pn, sub; const char* A; const char* B; };
struct Gemm { const bf16_t* A; const bf16_t* Bt; const bf16_t* A2; const bf16_t* Bt2; int lda, ldb, M, N, K, chain; };
struct StaticOrder {
    int nM, nN, nwg, G, c, chain; const char *A, *B, *A2, *B2; size_t tsA, tsB;
    __device__ __forceinline__ void init(const Gemm& g, int G_, int c_) { nM = g.M / BM; nN = g.N / BM; nwg = nM * nN; G = G_; c = c_; chain = g.chain; A = (const char*)g.A; B = (const char*)g.Bt; A2 = (const char*)g.A2; B2 = (const char*)g.Bt2;
        tsA = (size_t)BM * g.lda * 2; tsB = (size_t)BM * g.ldb * 2; }
    int pair_mode = 0;
    __device__ __forceinline__ bool next(int i, Unit& u) const {
        if (pair_mode) { const int item = c + (i >> 1) * G; if (item >= nwg / 2) return false; u.pm = 2 * (item >> 3) + (i & 1); u.pn = item & 7; u.sub = 0; u.A = A + (size_t)u.pm * tsA; u.B = B + (size_t)u.pn * tsB; return true; }
        const int r = (chain == 2) ? (i >> 1) : i, sub = (chain == 2) ? (i & 1) : 0;
        const long L = (long)r * G + c; if (L >= nwg) return false;
        int wgid = (int)L; { const int q = nwg / NXCD, rr = nwg % NXCD, xcd = wgid % NXCD, off = wgid / NXCD; wgid = (xcd < rr ? xcd * (q + 1) : rr * (q + 1) + (xcd - rr) * q) + off; }
        const int nig = WGM * nN, gid = wgid / nig, fm = gid * WGM, gsz = (nM - fm) < WGM ? (nM - fm) : WGM;
        u.pm = fm + ((wgid % nig) % gsz); u.pn = (wgid % nig) / gsz; u.sub = sub;
        u.A = (sub ? A2 : A) + (size_t)u.pm * tsA; u.B = (sub ? B2 : B) + (size_t)u.pn * tsB; return true;
    }
};
__device__ __forceinline__ unsigned cvt_pk_bf16(float lo, float hi) { unsigned r; asm volatile("v_cvt_pk_bf16_f32 %0, %1, %2" : "=v"(r) : "v"(lo), "v"(hi)); return r; }

typedef f32x4 AccT[2][2][4][2];
template <class Epi, class Sched, bool ALIGN_EPI>
__device__ __forceinline__ void gemm_phase(PG8_LAS unsigned char* lds, const Gemm g, const Sched& S, const Epi& E) {
    const int tid = threadIdx.x, wid = __builtin_amdgcn_readfirstlane(tid >> 6), lane = tid & 63, wr = wid >> 2, wc = wid & 3, fr = lane & 15, fq = lane >> 4;
    const int K = g.K, nt = K / BK;
    unsigned voffA[2], voffB[2];
#pragma unroll
    for (int i = 0; i < 2; ++i) { int R, C; stage_rc(tid * 16 + i * 8192, R, C); const int Rb = Epi::PERM ? ((R & ~31) + perm32(R & 31)) : R;
        voffA[i] = (unsigned)(R * g.lda + C) * 2u; voffB[i] = (unsigned)(Rb * g.ldb + C) * 2u; }
    const size_t kstep = (size_t)(BK * 2);
    const size_t hsA = (size_t)HALF * g.lda * 2, hsB = (size_t)HALF * g.ldb * 2;
    const unsigned ldsw = (unsigned)wid * 1024u;
    const int aoff = lds_byte(wr * 64 + fr, fq * 8), boff = lds_byte(wc * 32 + fr, fq * 8);
#define PG8_SA(b, h) (((b) * 2 + (h)) * HTB)
#define PG8_SB(b, h) ((4 + (b) * 2 + (h)) * HTB)
#define PG8_STAGE(bufoff, gbase, voff) do { _Pragma("unroll") for (int _i = 0; _i < 2; ++_i) \
        __builtin_amdgcn_global_load_lds((const unsigned*)((const char*)(gbase) + (voff)[_i]), (PG8_LAS unsigned*)(lds + (bufoff) + ldsw + _i * 8192), 16, 0, 0); } while (0)
#define PG8_LDA(dst, b, h) do { _Pragma("unroll") for (int m = 0; m < 4; ++m) _Pragma("unroll") for (int k = 0; k < 2; ++k) dst[m][k] = *(const PG8_LAS bf16x8*)(lds + PG8_SA(b, h) + aoff + m * 2048 + k * 1024); } while (0)
#define PG8_LDB(dst, b, h) do { _Pragma("unroll") for (int n = 0; n < 2; ++n) _Pragma("unroll") for (int k = 0; k < 2; ++k) dst[n][k] = *(const PG8_LAS bf16x8*)(lds + PG8_SB(b, h) + boff + n * 2048 + k * 1024); } while (0)
#define PG8_MMA(ai, bj, At, Bt) do { __builtin_amdgcn_s_setprio(1); _Pragma("unroll") for (int m = 0; m < 4; ++m) _Pragma("unroll") for (int n = 0; n < 2; ++n) _Pragma("unroll") for (int k = 0; k < 2; ++k) \
        acc[ai][bj][m][n] = __builtin_amdgcn_mfma_f32_16x16x32_bf16(Bt[n][k], At[m][k], acc[ai][bj][m][n], 0, 0, 0); __builtin_amdgcn_s_setprio(0); } while (0)
#define PG8_WAIT_V(n) asm volatile("s_waitcnt vmcnt(" #n ")" ::: "memory")
#define PG8_WAIT_L(n) asm volatile("s_waitcnt lgkmcnt(" #n ")" ::: "memory")
#define PG8_BAR __builtin_amdgcn_s_barrier()
#define PG8_SCHED __builtin_amdgcn_sched_barrier(0)
    Unit cur, nxt; int ui = 0;
    if (!S.next(0, cur)) return;
    f32x4 acc[2][2][4][2];
#pragma unroll
    for (int a = 0; a < 2; ++a)
#pragma unroll
        for (int b = 0; b < 2; ++b)
#pragma unroll
            for (int m = 0; m < 4; ++m)
#pragma unroll
                for (int n = 0; n < 2; ++n) acc[a][b][m][n] = (f32x4){0.f, 0.f, 0.f, 0.f};
    bf16x8 At[4][2], B0[2][2], B1[2][2];
    const char* cA = cur.A; const char* cB = cur.B;
    PG8_STAGE(PG8_SB(0, 0), cB, voffB); PG8_STAGE(PG8_SB(0, 1), cB + hsB, voffB); PG8_STAGE(PG8_SA(0, 0), cA, voffA); PG8_STAGE(PG8_SA(0, 1), cA + hsA, voffA);
    if (wr == 1) PG8_BAR;
    PG8_WAIT_V(2); PG8_BAR;
    PG8_STAGE(PG8_SB(1, 0), cB + kstep, voffB); PG8_STAGE(PG8_SA(1, 0), cA + kstep, voffA); PG8_STAGE(PG8_SB(1, 1), cB + hsB + kstep, voffB);
    PG8_WAIT_V(6); PG8_BAR;
    for (;;) {
        const bool has_next = S.next(ui + 1, nxt);
        const char* nA = has_next ? nxt.A : cA; const char* nB = has_next ? nxt.B : cB;
        for (int t = 0; t < nt; t += 2) {
            const bool last = (t == nt - 2);
            const char* a1 = cA + (size_t)(t + 1) * kstep;
            const char* a2 = last ? nA : cA + (size_t)(t + 2) * kstep; const char* b2 = last ? nB : cB + (size_t)(t + 2) * kstep;
            const char* a3 = a2 + kstep; const char* b3 = b2 + kstep;
            PG8_LDB(B0, 0, 0); PG8_LDB(B1, 0, 1); PG8_SCHED; PG8_LDA(At, 0, 0); PG8_STAGE(PG8_SA(1, 1), a1 + hsA, voffA);
            PG8_WAIT_V(8); PG8_WAIT_L(0); PG8_BAR; PG8_MMA(0, 0, At, B0); PG8_MMA(0, 1, At, B1); PG8_BAR; PG8_SCHED;
            PG8_LDA(At, 0, 1); PG8_STAGE(PG8_SB(0, 0), b2, voffB); PG8_STAGE(PG8_SB(0, 1), b2 + hsB, voffB); PG8_STAGE(PG8_SA(0, 0), a2, voffA);
            PG8_WAIT_V(8); PG8_WAIT_L(0); PG8_BAR; PG8_MMA(1, 0, At, B0); PG8_MMA(1, 1, At, B1); PG8_BAR; PG8_SCHED;
            PG8_LDB(B0, 1, 0); PG8_LDB(B1, 1, 1); PG8_SCHED; PG8_LDA(At, 1, 0); PG8_STAGE(PG8_SA(0, 1), a2 + hsA, voffA);
            PG8_WAIT_V(8); PG8_WAIT_L(0); PG8_BAR; PG8_MMA(0, 0, At, B0); PG8_MMA(0, 1, At, B1); PG8_BAR; PG8_SCHED;
            PG8_LDA(At, 1, 1); PG8_STAGE(PG8_SB(1, 0), b3, voffB); PG8_STAGE(PG8_SB(1, 1), b3 + hsB, voffB); PG8_STAGE(PG8_SA(1, 0), a3, voffA);
            PG8_WAIT_V(8); PG8_WAIT_L(0); PG8_BAR; PG8_MMA(1, 0, At, B0); PG8_MMA(1, 1, At, B1); PG8_BAR; PG8_SCHED;
        }
        if constexpr (ALIGN_EPI) { if (wr == 0) PG8_BAR; }
        E(acc, cur, wr, wc, fr, fq);
        if (!has_next) break;
        if (!(Epi::CHAIN && nxt.sub != 0)) {
#pragma unroll
            for (int a = 0; a < 2; ++a)
#pragma unroll
                for (int b = 0; b < 2; ++b)
#pragma unroll
                    for (int m = 0; m < 4; ++m)
#pragma unroll
                        for (int n = 0; n < 2; ++n) acc[a][b][m][n] = (f32x4){0.f, 0.f, 0.f, 0.f};
        }
        cur = nxt; cA = nA; cB = nB; ++ui;
        if constexpr (ALIGN_EPI) { if (wr == 1) PG8_BAR; }
    }
    PG8_WAIT_V(0);
    if constexpr (!ALIGN_EPI) { if (wr == 0) PG8_BAR; }
    PG8_BAR;
#undef PG8_SA
#undef PG8_SB
#undef PG8_STAGE
#undef PG8_LDA
#undef PG8_LDB
#undef PG8_MMA
#undef PG8_WAIT_V
#undef PG8_WAIT_L
#undef PG8_BAR
#undef PG8_SCHED
}

struct EpiProj {
    static constexpr bool PERM = true, CHAIN = false;
    bf16_t* pb; bf16_t* pa; float* ssq; float* sskv;
    __device__ __forceinline__ void operator()(AccT& acc, const Unit& u, int wr, int wc, int fr, int fq) const {
        const int row0 = u.pm * BM + wr * 64 + fr;
#pragma unroll
        for (int bj = 0; bj < 2; ++bj) {
            const int hk = u.pn * 2 + bj;
            bf16_t* base; int ld; float* ss = nullptr;
            if (hk < 22) { base = pb + hk * 128; ld = PB_LD; } else { const int ha = hk - 22; base = pa + ha * 128; ld = PA_LD; if (ha >= 6 && ha <= 8) ss = ssq; else if (ha == 9 || ha == 10) ss = sskv; }
            base += wc * 32 + 8 * fq;
#pragma unroll
            for (int ai = 0; ai < 2; ++ai)
#pragma unroll
                for (int m = 0; m < 4; ++m) { const int row = row0 + ai * HALF + m * 16; const f32x4 v0 = acc[ai][bj][m][0], v1 = acc[ai][bj][m][1];
                    u32x4 w; w.x = cvt_pk_bf16(v0[0], v0[1]); w.y = cvt_pk_bf16(v0[2], v0[3]); w.z = cvt_pk_bf16(v1[0], v1[1]); w.w = cvt_pk_bf16(v1[2], v1[3]);
                    *(u32x4*)(base + (size_t)row * ld) = w;
                    if (ss) { float s = (v0[0] * v0[0] + v0[1] * v0[1]) + (v0[2] * v0[2] + v0[3] * v0[3]) + (v1[0] * v1[0] + v1[1] * v1[1]) + (v1[2] * v1[2] + v1[3] * v1[3]);
                        s += __shfl_xor(s, 16); s += __shfl_xor(s, 32); if (fq == 0) atomicAdd(ss + row, s); } }
        }
    }
};
struct EpiQ {
    static constexpr bool PERM = false, CHAIN = false;
    bf16_t* Q; const float* ssq; const float* cs; const float* sn;
    __device__ __forceinline__ void operator()(AccT& acc, const Unit& u, int wr, int wc, int fr, int fq) const {
        const int row0 = u.pm * BM + wr * 64 + fr;
#pragma unroll
        for (int ai = 0; ai < 2; ++ai)
#pragma unroll
            for (int m = 0; m < 4; ++m) { const int row = row0 + ai * HALF + m * 16; const float rr = rsqrtf(ssq[row] * (1.f / 384.f) + EPS) * CQ;
#pragma unroll
                for (int bj = 0; bj < 2; ++bj) { const int G = u.pn * 8 + bj * 4 + wc;
                    f32x4 x0 = acc[ai][bj][m][0], x1 = acc[ai][bj][m][1];
                    if (G % 3 == 2) { const f32x4 c = *(const f32x4*)(cs + (size_t)row * 16 + 4 * fq), s = *(const f32x4*)(sn + (size_t)row * 16 + 4 * fq);
                        const f32x4 o0 = x0 * c - x1 * s, o1 = x1 * c + x0 * s; x0 = o0; x1 = o1; }
                    x0 = x0 * rr; x1 = x1 * rr;
                    bf16_t* p = Q + (size_t)row * 768 + G * 32 + 4 * fq;
                    u32x2 w0, w1; w0.x = cvt_pk_bf16(x0[0], x0[1]); w0.y = cvt_pk_bf16(x0[2], x0[3]); w1.x = cvt_pk_bf16(x1[0], x1[1]); w1.y = cvt_pk_bf16(x1[2], x1[3]);
                    *(u32x2*)p = w0; *(u32x2*)(p + 16) = w1; } }
    }
};
struct EpiKV {
    static constexpr bool PERM = true, CHAIN = false;
    bf16_t* Kb; bf16_t* Vb; const float* sskv;
    __device__ __forceinline__ void operator()(AccT& acc, const Unit& u, int wr, int wc, int fr, int fq) const {
        const int row0 = u.pm * BM + wr * 64 + fr;
#pragma unroll
        for (int ai = 0; ai < 2; ++ai)
#pragma unroll
            for (int m = 0; m < 4; ++m) { const int row = row0 + ai * HALF + m * 16; const float rr = rsqrtf(sskv[row] * (1.f / 256.f) + EPS);
#pragma unroll
                for (int bj = 0; bj < 2; ++bj) { const int head = u.pn * 2 + bj; const f32x4 v0 = acc[ai][bj][m][0] * rr, v1 = acc[ai][bj][m][1] * rr;
                    u32x4 w; w.x = cvt_pk_bf16(v0[0], v0[1]); w.y = cvt_pk_bf16(v0[2], v0[3]); w.z = cvt_pk_bf16(v1[0], v1[1]); w.w = cvt_pk_bf16(v1[2], v1[3]);
                    bf16_t* p = (wc < 2) ? Kb + (size_t)row * 768 + head * 96 + wc * 32 + 8 * fq : Vb + (size_t)row * 512 + head * 64 + (wc - 2) * 32 + 8 * fq;
                    *(u32x4*)p = w; } }
    }
};
struct EpiMerge {
    static constexpr bool PERM = true, CHAIN = true;
    const bf16_t* pb; bf16_t* merged;
    __device__ __forceinline__ void operator()(AccT& acc, const Unit& u, int wr, int wc, int fr, int fq) const {
        const int row0 = u.pm * BM + wr * 64 + fr, col0 = u.pn * BM + wc * 32 + 8 * fq;
#pragma unroll
        for (int ai = 0; ai < 2; ++ai)
#pragma unroll
            for (int m = 0; m < 4; ++m) { const int row = row0 + ai * HALF + m * 16;
#pragma unroll
                for (int bj = 0; bj < 2; ++bj) { const int col = col0 + bj * HALF;
                    const u32x4 gb = *(const u32x4*)(pb + (size_t)row * PB_LD + PB_BR + 1024 + col);
                    float eb[8];
#pragma unroll
                    for (int e = 0; e < 4; ++e) { eb[2 * e] = 1.f + __builtin_amdgcn_exp2f(__uint_as_float(gb[e] << 16) * -1.4426950408889634f); eb[2 * e + 1] = 1.f + __builtin_amdgcn_exp2f(__uint_as_float(gb[e] & 0xffff0000u) * -1.4426950408889634f); }
                    if (u.sub == 0) {
                        const u32x4 ga = *(const u32x4*)(pb + (size_t)row * PB_LD + PB_BR + col);
#pragma unroll
                        for (int e = 0; e < 4; ++e) { const float ea0 = 1.f + __builtin_amdgcn_exp2f(__uint_as_float(ga[e] << 16) * -1.4426950408889634f), ea1 = 1.f + __builtin_amdgcn_exp2f(__uint_as_float(ga[e] & 0xffff0000u) * -1.4426950408889634f);
                            const int i0 = 2 * e, i1 = 2 * e + 1;
                            acc[ai][bj][m][i0 >> 2][i0 & 3] *= eb[i0] * __builtin_amdgcn_rcpf(ea0); acc[ai][bj][m][i1 >> 2][i1 & 3] *= eb[i1] * __builtin_amdgcn_rcpf(ea1); }
                    } else {
                        const f32x4 v0 = acc[ai][bj][m][0], v1 = acc[ai][bj][m][1];
                        float sb[8];
#pragma unroll
                        for (int e = 0; e < 8; ++e) sb[e] = __builtin_amdgcn_rcpf(eb[e]);
                        u32x4 w; w.x = cvt_pk_bf16(v0[0] * sb[0], v0[1] * sb[1]); w.y = cvt_pk_bf16(v0[2] * sb[2], v0[3] * sb[3]); w.z = cvt_pk_bf16(v1[0] * sb[4], v1[1] * sb[5]); w.w = cvt_pk_bf16(v1[2] * sb[6], v1[3] * sb[7]);
                        *(u32x4*)(merged + (size_t)row * DM + col) = w; } } }
    }
};
struct EpiX1 {
    static constexpr bool PERM = false, CHAIN = false;
    const float* x; float* x1; bf16_t* x1b; float* ssx1;
    __device__ __forceinline__ void operator()(AccT& acc, const Unit& u, int wr, int wc, int fr, int fq) const {
        const int row0 = u.pm * BM + wr * 64 + fr, col0 = u.pn * BM + wc * 32 + 4 * fq;
#pragma unroll
        for (int ai = 0; ai < 2; ++ai)
#pragma unroll
            for (int m = 0; m < 4; ++m) { const int row = row0 + ai * HALF + m * 16; const size_t off = (size_t)row * DM + col0; float s = 0.f;
#pragma unroll
                for (int bj = 0; bj < 2; ++bj)
#pragma unroll
                    for (int n = 0; n < 2; ++n) { const size_t o = off + bj * HALF + n * 16; const f32x4 v = *(const f32x4*)(x + o) + acc[ai][bj][m][n];
                        *(f32x4*)(x1 + o) = v; u32x2 w; w.x = cvt_pk_bf16(v[0], v[1]); w.y = cvt_pk_bf16(v[2], v[3]); *(u32x2*)(x1b + o) = w;
                        s += (v[0] * v[0] + v[1] * v[1]) + (v[2] * v[2] + v[3] * v[3]); }
                s += __shfl_xor(s, 16); s += __shfl_xor(s, 32); if (fq == 0) atomicAdd(ssx1 + row, s); }
    }
};
struct EpiQP {
    static constexpr bool PERM = true, CHAIN = false;
    bf16_t* qp; const float* ssx1;
    __device__ __forceinline__ void operator()(AccT& acc, const Unit& u, int wr, int wc, int fr, int fq) const {
        const int row0 = u.pm * BM + wr * 64 + fr, col0 = u.pn * BM + wc * 32 + 8 * fq;
#pragma unroll
        for (int ai = 0; ai < 2; ++ai)
#pragma unroll
            for (int m = 0; m < 4; ++m) { const int row = row0 + ai * HALF + m * 16; const float rr = rsqrtf(ssx1[row] * (1.f / 1024.f) + EPS);
#pragma unroll
                for (int bj = 0; bj < 2; ++bj) { const f32x4 v0 = acc[ai][bj][m][0] * rr, v1 = acc[ai][bj][m][1] * rr;
                    u32x4 w; w.x = cvt_pk_bf16(v0[0], v0[1]); w.y = cvt_pk_bf16(v0[2], v0[3]); w.z = cvt_pk_bf16(v1[0], v1[1]); w.w = cvt_pk_bf16(v1[2], v1[3]);
                    *(u32x4*)(qp + (size_t)row * 2048 + col0 + bj * HALF) = w; } }
    }
};
}


namespace att {
typedef short bf16x8 __attribute__((ext_vector_type(8)));
typedef short s16x4 __attribute__((ext_vector_type(4)));
typedef float f32x16 __attribute__((ext_vector_type(16)));
constexpr int NW = 8, QBLK = 32, KVBLK = 64, QB = NW * QBLK;
constexpr int QS = 768, KS = 768, VS = 512, OS = 512;
constexpr int SHM_V = KVBLK * 64 * 2, SHM_K = KVBLK * 256;
constexpr int LDS_BYTES = 2 * SHM_V + 2 * SHM_K + NW * 64 * 4;
constexpr float THR = 8.f;
#define KSWZ(row, colB) ((row) * 256 + ((colB) ^ (((row) & 15) << 4)))
#define SBAR() __builtin_amdgcn_sched_barrier(0)
__device__ __forceinline__ int v_st(int k, int c) { const int kk = (k & ~0xC) | ((k & 4) << 1) | ((k & 8) >> 1); return ((kk >> 3) * 2 + (c >> 5)) * 512 + ((kk & 7) * 32 + (c & 31)) * 2; }
__device__ __forceinline__ int v_rd_base(int lane) { return ((lane & 3) << 3) | (((lane >> 2) & 3) << 6) | (((lane >> 4) & 1) << 5) | (((lane >> 5) & 1) << 8); }
constexpr int v_rd_off(int d0, int ks, int half) { return d0 * 512 + ks * 2048 + half * 1024; }
__device__ __forceinline__ int crow(int r, int hi) { return (r & 3) + 8 * (r >> 2) + 4 * hi; }
__device__ __forceinline__ unsigned cvtpk(float lo, float hi) { unsigned r; asm volatile("v_cvt_pk_bf16_f32 %0, %1, %2" : "=v"(r) : "v"(lo), "v"(hi)); return r; }
__device__ __forceinline__ bf16x8 load8(const bf16_t* p) { return *reinterpret_cast<const bf16x8*>(p); }
__device__ __forceinline__ void partialSM(f32x16& p0, f32x16& p1, float& m_reg, float& mn, float& alpha) {
    float pmax = p0[0]; for (int r = 1; r < 16; ++r) pmax = fmaxf(pmax, p0[r]); for (int r = 0; r < 16; ++r) pmax = fmaxf(pmax, p1[r]);
    { auto rr = __builtin_amdgcn_permlane32_swap(__float_as_uint(pmax), __float_as_uint(pmax), false, false);
      pmax = fmaxf(__uint_as_float(rr[0]), __uint_as_float(rr[1])); }
    if (__builtin_expect(__all((pmax - m_reg) <= THR), 1)) { mn = m_reg; alpha = 1.f; }
    else { mn = fmaxf(m_reg, pmax); alpha = __builtin_amdgcn_exp2f(m_reg - mn); m_reg = mn; }
    for (int r = 0; r < 16; ++r) p0[r] = p0[r] - mn; for (int r = 0; r < 16; ++r) p1[r] = p1[r] - mn;
    for (int r = 0; r < 16; ++r) p0[r] = __builtin_amdgcn_exp2f(p0[r]);
}
__device__ __forceinline__ void finishSM(f32x16& p0, f32x16& p1, float alpha, float& l_reg, bf16x8& pa0, bf16x8& pa1, bf16x8& pa2, bf16x8& pa3) {
    for (int r = 0; r < 16; ++r) p1[r] = __builtin_amdgcn_exp2f(p1[r]);
    float ps = 0; for (int r = 0; r < 16; ++r) ps += p0[r]; for (int r = 0; r < 16; ++r) ps += p1[r];
    { auto rr = __builtin_amdgcn_permlane32_swap(__float_as_uint(ps), __float_as_uint(ps), false, false);
      ps = __uint_as_float(rr[0]) + __uint_as_float(rr[1]); }
    l_reg = l_reg * alpha + ps;
#define PK4(P, B_, OUT) do { unsigned a0 = cvtpk(P[B_+0], P[B_+1]), a1 = cvtpk(P[B_+2], P[B_+3]);                          \
        unsigned b0 = cvtpk(P[B_+4], P[B_+5]), b1 = cvtpk(P[B_+6], P[B_+7]);                                             \
        auto r0 = __builtin_amdgcn_permlane32_swap(a0, b0, false, false); auto r1 = __builtin_amdgcn_permlane32_swap(a1, b1, false, false); \
        u32x4 w = {r0[0], r1[0], r0[1], r1[1]}; OUT = *reinterpret_cast<bf16x8*>(&w); } while (0)
    PK4(p0, 0, pa0); PK4(p0, 8, pa1); PK4(p1, 0, pa2); PK4(p1, 8, pa3);
#undef PK4
}
template <int KB>
__device__ __forceinline__ void qkt(f32x16& p0, f32x16& p1, const char* K_lds, int r32, int hi, const bf16x8* qr) {
    p0 = f32x16{}; p1 = f32x16{};
#pragma unroll
    for (int d0 = 0; d0 < 6; ++d0) { const char* a = K_lds + KB * SHM_K + KSWZ(r32, (d0 * 16 + hi * 8) * 2);
        bf16x8 b0 = *reinterpret_cast<const bf16x8*>(a);
        bf16x8 b1 = *reinterpret_cast<const bf16x8*>(a + 32 * 256);
        p0 = __builtin_amdgcn_mfma_f32_32x32x16_bf16(b0, qr[d0], p0, 0, 0, 0);
        p1 = __builtin_amdgcn_mfma_f32_32x32x16_bf16(b1, qr[d0], p1, 0, 0, 0); }
}
template <int VB>
__device__ __forceinline__ void pv_tile(f32x16* o, int vb0, bf16x8 pa0, bf16x8 pa1, bf16x8 pa2, bf16x8 pa3) {
#define TRRD(dst, off) asm volatile("ds_read_b64_tr_b16 %0, %1 offset:%2" : "=&v"(dst) : "v"(vb0), "i"(off) : "memory")
#define PV_D0(d0) do { s16x4 l0, l1, l2, l3, h0, h1, h2, h3; constexpr int b_ = VB * SHM_V + v_rd_off(d0, 0, 0);   \
        TRRD(l0, b_); TRRD(h0, b_ + 1024); TRRD(l1, b_ + 2048); TRRD(h1, b_ + 3072); TRRD(l2, b_ + 4096); TRRD(h2, b_ + 5120); TRRD(l3, b_ + 6144); TRRD(h3, b_ + 7168); \
        asm volatile("s_waitcnt lgkmcnt(0)" ::: "memory"); SBAR();   \
        o[d0] = __builtin_amdgcn_mfma_f32_32x32x16_bf16(pa0, (bf16x8){l0[0], l0[1], l0[2], l0[3], h0[0], h0[1], h0[2], h0[3]}, o[d0], 0, 0, 0);   \
        o[d0] = __builtin_amdgcn_mfma_f32_32x32x16_bf16(pa1, (bf16x8){l1[0], l1[1], l1[2], l1[3], h1[0], h1[1], h1[2], h1[3]}, o[d0], 0, 0, 0);   \
        o[d0] = __builtin_amdgcn_mfma_f32_32x32x16_bf16(pa2, (bf16x8){l2[0], l2[1], l2[2], l2[3], h2[0], h2[1], h2[2], h2[3]}, o[d0], 0, 0, 0);   \
        o[d0] = __builtin_amdgcn_mfma_f32_32x32x16_bf16(pa3, (bf16x8){l3[0], l3[1], l3[2], l3[3], h3[0], h3[1], h3[2], h3[3]}, o[d0], 0, 0, 0); } while (0)
    PV_D0(0); PV_D0(1);
#undef PV_D0
#undef TRRD
}
struct BlockRef { const bf16_t* Q; const bf16_t* K; const bf16_t* KPE; const bf16_t* V; bf16_t* O; int P0; };
struct Seam { bf16x8 qr[6]; bf16x8 st_v0, st_v1, st_k0, st_k1; };
#define ROWK(p, k0, rr) ((p) + (size_t)((k0) + (rr)) * kstr)
#define ROWV(p, k0, rr) ((p) + (size_t)((k0) + (rr)) * VS + sc)
#define VMW() asm volatile("s_waitcnt vmcnt(0)" ::: "memory")
#define VMWN(n) asm volatile("s_waitcnt vmcnt(%0)" :: "i"(n) : "memory")
#define SLOAD_H(Kp, Vp, k0) do { if (vact) { S.st_v0 = load8(ROWV(Vp, k0, sr)); S.st_v1 = load8(ROWV(Vp, k0, 32 + sr)); }              \
                                 if (kact) { S.st_k0 = load8(ROWK(Kp, k0, sr)); S.st_k1 = load8(ROWK(Kp, k0, 32 + sr)); } } while (0)
#define SWRITE_HK(bf) do { if (kact) { *(bf16x8*)(K_lds + (bf) * SHM_K + kws) = S.st_k0; *(bf16x8*)(K_lds + (bf) * SHM_K + kws + 32 * 256) = S.st_k1; } } while (0)
#define SWRITE_HV(bf) do { if (vact) { *(bf16x8*)(V_lds + (bf) * SHM_V + vst0) = S.st_v0; *(bf16x8*)(V_lds + (bf) * SHM_V + vst1) = S.st_v1; } } while (0)
#define SWRITE_H(bf) do { SWRITE_HV(bf); SWRITE_HK(bf); } while (0)
__device__ __forceinline__ void attn_prime(const BlockRef& cur, char* lds, Seam& S) {
    const int tid = threadIdx.x, wid = __builtin_amdgcn_readfirstlane(tid >> 6), lane = tid & 63, r32 = lane & 31, hi = lane >> 5;
    const int sr = tid >> 4, sc = (tid & 15) * 8, kws = KSWZ(sr, sc * 2); char* K_lds = lds + 2 * SHM_V;
    const bool kact = (tid & 15) < 12, vact = (tid & 15) < 8;
#pragma unroll
    for (int d0 = 0; d0 < 6; ++d0) S.qr[d0] = load8(cur.Q + (size_t)(wid * QBLK + r32) * QS + d0 * 16 + hi * 8);
    const bf16_t* kp0 = (tid & 15) < 8 ? cur.K + sc : cur.KPE + (sc - 64); const int kstr = (tid & 15) < 8 ? KS : 32;
    SLOAD_H(kp0, cur.V, 0); VMW(); SWRITE_HK(0);
    __syncthreads();
}
__device__ __forceinline__ void attn_block(const BlockRef& cur, const BlockRef& nxt, char* lds, Seam& S) {
    const int tid = threadIdx.x, wid = __builtin_amdgcn_readfirstlane(tid >> 6), lane = tid & 63, r32 = lane & 31, hi = lane >> 5;
    const int NT = (cur.P0 + QB - 1) / KVBLK + 1;
    const int qlo = cur.P0 + wid * QBLK;
    const int qvis = qlo | 63;
    char* V_lds = lds; char* K_lds = lds + 2 * SHM_V;
    float* ws = (float*)(lds + 2 * SHM_V + 2 * SHM_K) + wid * 64; float* li_l = ws, * al_l = ws + 32;
    float m_reg = -1e30f, l_reg = 0; f32x16 o[2] = {};
    const int sr = tid >> 4, sc = (tid & 15) * 8, vst0 = v_st(sr, sc & 63), vst1 = v_st(32 + sr, sc & 63), kws = KSWZ(sr, sc * 2);
    const bool kact = (tid & 15) < 12, vact = (tid & 15) < 8;
    const int vb0 = (int)(uintptr_t)V_lds + v_rd_base(lane);
    const int kstr = (tid & 15) < 8 ? KS : 32;
    const bf16_t* Kh = (tid & 15) < 8 ? cur.K + sc : cur.KPE + (sc - 64); const bf16_t* Vh = cur.V;
    const bf16_t* Knx = (tid & 15) < 8 ? nxt.K + sc : nxt.KPE + (sc - 64);
#define RESC(a) do { if (__any((a) < 1.f)) { if (hi == 0) al_l[r32] = (a); asm volatile("s_waitcnt lgkmcnt(0)" ::: "memory");              \
                     for (int d_ = 0; d_ < 2; ++d_) for (int r = 0; r < 16; ++r) o[d_][r] *= al_l[crow(r, hi)]; } } while (0)
#define KBASE(t) ((t) * KVBLK)
#define MASKT(P0_, P1_, t) do { if (__builtin_amdgcn_readfirstlane((int)(KBASE(t) > qvis))) { const float NEG_ = -__builtin_inff(); _Pragma("unroll") for (int r = 0; r < 16; ++r) { P0_[r] = NEG_; P1_[r] = NEG_; } asm volatile("" : "+v"(P0_), "+v"(P1_)); } } while (0)
    constexpr int NQL = 6;
#define SEAM_K0() do { VMWN(NQL); SWRITE_HK(0); SBAR(); } while (0)
    f32x16 pA0, pA1, pB0, pB1; float mnA, mnB, alA, alB; bf16x8 pa0, pa1, pa2, pa3;
    SWRITE_HV(0); SBAR();
    if (NT > 1) { SLOAD_H(Kh, Vh, KBASE(1)); }
    SBAR(); qkt<0>(pA0, pA1, K_lds, r32, hi, S.qr);
    MASKT(pA0, pA1, 0); partialSM(pA0, pA1, m_reg, mnA, alA);
    if (NT > 1) { VMW(); SWRITE_H(1); }
    __syncthreads();
#define HALF_STEP(PX0, PX1, mnX, alX, PY0, PY1, alY, t, KB, VB, SB) do {                                                      \
        SBAR(); qkt<KB>(PX0, PX1, K_lds, r32, hi, S.qr);                                             \
        finishSM(PY0, PY1, alY, l_reg, pa0, pa1, pa2, pa3); SBAR();                                                           \
        if ((t) + 1 < NT) { SLOAD_H(Kh, Vh, KBASE((t) + 1)); SBAR(); }                                               \
        pv_tile<VB>(o, vb0, pa0, pa1, pa2, pa3); MASKT(PX0, PX1, (t)); partialSM(PX0, PX1, m_reg, mnX, alX);                                        \
        __syncthreads();                                                                                                      \
        if ((t) + 1 < NT) { VMW(); SWRITE_H(SB); }                                                                          \
        RESC(alX); __syncthreads(); } while (0)
    for (int t = 1; t + 1 < NT; t += 2) {
        HALF_STEP(pB0, pB1, mnB, alB, pA0, pA1, alA, t, 1, 0, 0);
        HALF_STEP(pA0, pA1, mnA, alA, pB0, pB1, alB, t + 1, 0, 1, 1);
    }
    const bool even = (NT & 1) == 0;
    if (even) { SBAR(); qkt<1>(pB0, pB1, K_lds, r32, hi, S.qr); SBAR(); }
    SLOAD_H(Knx, nxt.V, 0); SBAR();
#pragma unroll
    for (int d0 = 0; d0 < 6; ++d0) S.qr[d0] = load8(nxt.Q + (size_t)(wid * QBLK + r32) * QS + d0 * 16 + hi * 8);
    SBAR();
    finishSM(pA0, pA1, alA, l_reg, pa0, pa1, pa2, pa3); SBAR();
    pv_tile<0>(o, vb0, pa0, pa1, pa2, pa3);
    if (even) { MASKT(pB0, pB1, NT - 1); partialSM(pB0, pB1, m_reg, mnB, alB); __syncthreads(); RESC(alB);
        finishSM(pB0, pB1, alB, l_reg, pa0, pa1, pa2, pa3); SBAR(); pv_tile<1>(o, vb0, pa0, pa1, pa2, pa3); }
    SBAR(); SEAM_K0();
    if (hi == 0) li_l[r32] = l_reg; asm volatile("s_waitcnt lgkmcnt(0)" ::: "memory");
    float rli[16];
#pragma unroll
    for (int r = 0; r < 16; ++r) rli[r] = __builtin_amdgcn_rcpf(li_l[crow(r, hi)]);
    bf16_t* Ow = cur.O + (size_t)(wid * QBLK) * OS;
#pragma unroll
    for (int r = 0; r < 16; ++r) { const int orow = crow(r, hi);
#pragma unroll
        for (int d0 = 0; d0 < 2; ++d0) { const float v = o[d0][r] * rli[r];
            const float vn = __shfl_xor(v, 1);
            if ((r32 & 1) == 0) *(unsigned*)(Ow + (size_t)orow * OS + d0 * 32 + r32) = cvtpk(v, vn); } }
    __syncthreads();
#undef RESC
#undef KBASE
#undef MASKT
#undef SEAM_K0
#undef HALF_STEP
}


__device__ __forceinline__ void partialSM_rel(f32x16& p0, f32x16& p1, float& m_ref, f32x16& negm, float& alpha) {
    float pmax = p0[0]; for (int r = 1; r < 16; ++r) pmax = fmaxf(pmax, p0[r]); for (int r = 0; r < 16; ++r) pmax = fmaxf(pmax, p1[r]);
    { auto rr = __builtin_amdgcn_permlane32_swap(__float_as_uint(pmax), __float_as_uint(pmax), false, false);
      pmax = fmaxf(__uint_as_float(rr[0]), __uint_as_float(rr[1])); }
    if (__builtin_expect(__all(pmax <= THR), 1)) { alpha = 1.f; }
    else { const float d = fmaxf(pmax, 0.f); alpha = __builtin_amdgcn_exp2f(-d); m_ref += d;
        for (int r = 0; r < 16; ++r) { p0[r] -= d; p1[r] -= d; }
        for (int r = 0; r < 16; ++r) negm[r] = -m_ref; asm volatile("" : "+v"(negm)); }
    for (int r = 0; r < 16; ++r) p0[r] = __builtin_amdgcn_exp2f(p0[r]);
}
constexpr int D_V = 0, D_K = 4 * SHM_V, D_WS = D_K + 3 * SHM_K, D_BYTES = D_WS + NW * 64 * 4;
__device__ __forceinline__ void qkt_rt(f32x16& p0, f32x16& p1, const char* Kslot, int r32, int hi, const bf16x8* qr, const f32x16& negm) {
    p0 = negm; p1 = negm;
#pragma unroll
    for (int d0 = 0; d0 < 6; ++d0) { const char* a = Kslot + KSWZ(r32, (d0 * 16 + hi * 8) * 2);
        bf16x8 b0 = *reinterpret_cast<const bf16x8*>(a);
        bf16x8 b1 = *reinterpret_cast<const bf16x8*>(a + 32 * 256);
        p0 = __builtin_amdgcn_mfma_f32_32x32x16_bf16(b0, qr[d0], p0, 0, 0, 0);
        p1 = __builtin_amdgcn_mfma_f32_32x32x16_bf16(b1, qr[d0], p1, 0, 0, 0); }
}
__device__ __forceinline__ void attn_block_dma(const BlockRef& cur, char* lds) {
    typedef __attribute__((address_space(3))) unsigned lds_u32;
    const int tid = threadIdx.x, wid = __builtin_amdgcn_readfirstlane(tid >> 6), lane = tid & 63, r32 = lane & 31, hi = lane >> 5;
    const int NT = (cur.P0 + QB - 1) / KVBLK + 1;
    const int qlo = cur.P0 + wid * QBLK, qvis = qlo | 63;
    float* ws = (float*)(lds + D_WS) + wid * 64; float* li_l = ws, * al_l = ws + 32;
    float m_reg = 0.f, l_reg = 0; f32x16 o[2] = {}; f32x16 negm = {}; asm volatile("" : "+v"(negm));
    const int vb0 = (int)(uintptr_t)(lds + D_V) + v_rd_base(lane);
    const bf16_t* ksrc[2]; int kstep[2];
#pragma unroll
    for (int j = 0; j < 2; ++j) { const int row = 4 * (2 * wid + j) + (lane >> 4), chunk = (lane & 15) ^ (row & 15);
        if (chunk >= 8 && chunk < 12) { ksrc[j] = cur.KPE + (size_t)row * 32 + (chunk - 8) * 8; kstep[j] = KVBLK * 32; }
        else { ksrc[j] = cur.K + (size_t)row * KS + (chunk < 8 ? chunk * 8 : 0); kstep[j] = KVBLK * KS; } }
    const bf16_t* vsrc; { const int kk = wid * 8 + ((lane & 31) >> 2), k = (kk & ~0xC) | ((kk & 4) << 1) | ((kk & 8) >> 1); vsrc = cur.V + (size_t)k * VS + (lane >> 5) * 32 + (lane & 3) * 8; }
#define DMA_TILE(t) do { const int ks_ = (t) % 3, vs_ = (t) & 3; \
        __builtin_amdgcn_global_load_lds((const unsigned*)(ksrc[0] + (size_t)(t) * kstep[0]), (lds_u32*)(lds + D_K + ks_ * SHM_K + (2 * wid) * 1024), 16, 0, 0); \
        __builtin_amdgcn_global_load_lds((const unsigned*)(ksrc[1] + (size_t)(t) * kstep[1]), (lds_u32*)(lds + D_K + ks_ * SHM_K + (2 * wid + 1) * 1024), 16, 0, 0); \
        __builtin_amdgcn_global_load_lds((const unsigned*)(vsrc + (size_t)(t) * KVBLK * VS), (lds_u32*)(lds + D_V + vs_ * SHM_V + wid * 1024), 16, 0, 0); } while (0)
#define WAITV(n) asm volatile("s_waitcnt vmcnt(" #n ")" ::: "memory")
#define BAR() do { asm volatile("s_waitcnt lgkmcnt(0)" ::: "memory"); __builtin_amdgcn_s_barrier(); asm volatile("" ::: "memory"); SBAR(); } while (0)
#define RESC(a) do { if (__any((a) < 1.f)) { if (hi == 0) al_l[r32] = (a); asm volatile("s_waitcnt lgkmcnt(0)" ::: "memory");              \
                     for (int d_ = 0; d_ < 2; ++d_) for (int r = 0; r < 16; ++r) o[d_][r] *= al_l[crow(r, hi)]; } } while (0)
#define MASKT(P0_, P1_, t) do { if (__builtin_amdgcn_readfirstlane((int)((t) * KVBLK > qvis))) { const float NEG_ = -__builtin_inff(); _Pragma("unroll") for (int r = 0; r < 16; ++r) { P0_[r] = NEG_; P1_[r] = NEG_; } asm volatile("" : "+v"(P0_), "+v"(P1_)); } } while (0)
    bf16x8 qr[6];
#pragma unroll
    for (int d0 = 0; d0 < 6; ++d0) qr[d0] = load8(cur.Q + (size_t)(wid * QBLK + r32) * QS + d0 * 16 + hi * 8);
    asm volatile("s_waitcnt vmcnt(0)" ::: "memory");
    DMA_TILE(0); DMA_TILE(1);
    WAITV(3); BAR();
    f32x16 pA0, pA1, pB0, pB1; float mnA, mnB, alA, alB; bf16x8 pa0, pa1, pa2, pa3;
    DMA_TILE(2);
    qkt_rt(pA0, pA1, lds + D_K, r32, hi, qr, negm);
    MASKT(pA0, pA1, 0); partialSM_rel(pA0, pA1, m_reg, negm, alA);
    WAITV(3); BAR();
#define STEP(PX0, PX1, mnX, alX, PY0, PY1, alY, t) do { \
        if ((t) + 2 < NT) DMA_TILE((t) + 2); \
        SBAR(); qkt_rt(PX0, PX1, lds + D_K + ((t) % 3) * SHM_K, r32, hi, qr, negm); \
        finishSM(PY0, PY1, alY, l_reg, pa0, pa1, pa2, pa3); SBAR(); \
        pv_tile<0>(o, vb0 + (((t) - 1) & 3) * SHM_V, pa0, pa1, pa2, pa3); MASKT(PX0, PX1, (t)); partialSM_rel(PX0, PX1, m_reg, negm, alX); \
        if ((t) + 2 < NT) { WAITV(3); } else { WAITV(0); } BAR(); \
        RESC(alX); } while (0)
    for (int t = 1; t + 1 < NT; t += 2) {
        STEP(pB0, pB1, mnB, alB, pA0, pA1, alA, t);
        STEP(pA0, pA1, mnA, alA, pB0, pB1, alB, t + 1);
    }
    SBAR(); qkt_rt(pB0, pB1, lds + D_K + ((NT - 1) % 3) * SHM_K, r32, hi, qr, negm);
    finishSM(pA0, pA1, alA, l_reg, pa0, pa1, pa2, pa3); SBAR();
    pv_tile<0>(o, vb0 + ((NT - 2) & 3) * SHM_V, pa0, pa1, pa2, pa3);
    MASKT(pB0, pB1, NT - 1); partialSM_rel(pB0, pB1, m_reg, negm, alB); RESC(alB);
    finishSM(pB0, pB1, alB, l_reg, pa0, pa1, pa2, pa3); SBAR(); pv_tile<0>(o, vb0 + ((NT - 1) & 3) * SHM_V, pa0, pa1, pa2, pa3);
    if (hi == 0) li_l[r32] = l_reg; asm volatile("s_waitcnt lgkmcnt(0)" ::: "memory");
    float rli[16];
#pragma unroll
    for (int r = 0; r < 16; ++r) rli[r] = __builtin_amdgcn_rcpf(li_l[crow(r, hi)]);
    bf16_t* Ow = cur.O + (size_t)(wid * QBLK) * OS;
#pragma unroll
    for (int r = 0; r < 16; ++r) { const int orow = crow(r, hi);
#pragma unroll
        for (int d0 = 0; d0 < 2; ++d0) { const float v = o[d0][r] * rli[r];
            const float vn = __shfl_xor(v, 1);
            if ((r32 & 1) == 0) *(unsigned*)(Ow + (size_t)orow * OS + d0 * 32 + r32) = cvtpk(v, vn); } }
    asm volatile("s_waitcnt vmcnt(0)" ::: "memory");
    __syncthreads();
#undef DMA_TILE
#undef WAITV
#undef BAR
#undef RESC
#undef MASKT
#undef STEP
}
#undef ROWK
#undef ROWV
#undef VMW
#undef VMWN
#undef SLOAD_H
#undef SWRITE_HK
#undef SWRITE_HV
#undef SWRITE_H
#undef KSWZ
#undef SBAR
}

namespace gla {
typedef short bf16x8 __attribute__((ext_vector_type(8)));
typedef short s16x4 __attribute__((ext_vector_type(4)));
typedef float f32x16 __attribute__((ext_vector_type(16)));
template <int NCB> __device__ __forceinline__ int t_st(int k, int c) { const int kk = (k & ~0xC) | ((k & 4) << 1) | ((k & 8) >> 1); return ((kk >> 3) * NCB + (c >> 5)) * 512 + ((kk & 7) * 32 + (c & 31)) * 2; }
__device__ __forceinline__ int t_rd_base(int lane) { return ((lane & 3) << 3) | (((lane >> 2) & 3) << 6) | (((lane >> 4) & 1) << 5) | (((lane >> 5) & 1) << 8); }
template <int NCB> constexpr int t_rd_off(int d0, int ks, int half) { return d0 * 512 + ks * (NCB * 1024) + half * (NCB * 512); }
#define GLA_TRRD(dst, addr, off) asm volatile("ds_read_b64_tr_b16 %0, %1 offset:%2" : "=&v"(dst) : "v"(addr), "i"(off) : "memory")
__device__ __forceinline__ int crow(int r, int hi) { return (r & 3) + 8 * (r >> 2) + 4 * hi; }
}

#define XB_TMO      128
#define XB_XCNT(j)  (256  + 64 * (j))
#define XB_XSUB(j)  (1280 + 64 * (j))
#define XB_XGEN(j)  (2304 + 64 * (j))
#define XB_TOP      3328
#define XB_TOPGEN   3392
#define XCD_BAR_WORDS 3456
#define XB_SPIN_CAP (1u << 18)
__device__ __forceinline__ unsigned xb_ld(unsigned* p)              { return __hip_atomic_load(p, __ATOMIC_RELAXED, __HIP_MEMORY_SCOPE_AGENT); }
__device__ __forceinline__ unsigned xb_add(unsigned* p, unsigned v) { return __hip_atomic_fetch_add(p, v, __ATOMIC_RELAXED, __HIP_MEMORY_SCOPE_AGENT); }
__device__ __forceinline__ unsigned xb_xcc_id() { return (unsigned)__builtin_amdgcn_s_getreg((3 << 11) | 20) & 0xFu; }
#define XB_SPIN(cond, bar) do { unsigned _sp = 0; while (cond) { __builtin_amdgcn_s_sleep(1); \
    if ((++_sp & 255u) == 0u) { if (xb_ld(&(bar)[XB_TMO])) break; if (_sp > XB_SPIN_CAP) { atomicAdd(&(bar)[XB_TMO], 1u); break; } } } } while (0)
struct XcdBarrier { unsigned* bar; unsigned x; volatile LAS unsigned* st; };
__device__ __forceinline__ XcdBarrier xcd_barrier_post(unsigned* bar, volatile LAS unsigned* st) {
    XcdBarrier b; b.bar = bar; b.x = xb_xcc_id(); b.st = st;
    if (threadIdx.x == 0) st[2] = xb_add(&bar[XB_XCNT(b.x)], 1u);
    return b;
}
__device__ __forceinline__ void xcd_barrier_complete(unsigned* bar, unsigned x, unsigned& nloc, unsigned& nx) {
    const unsigned G = gridDim.x * gridDim.y * gridDim.z;
    unsigned sum, cnt, mine, sp = 0u;
    for (;;) {
        sum = 0u; cnt = 0u; mine = 0u;
#pragma unroll
        for (unsigned j = 0; j < 16; ++j) { const unsigned c = xb_ld(&bar[XB_XCNT(j)]); sum += c; cnt += (c > 0u) ? 1u : 0u; mine = (j == x) ? c : mine; }
        if (sum == G) break;
        __builtin_amdgcn_s_sleep(1);
        if ((++sp & 255u) == 0u) { if (xb_ld(&bar[XB_TMO])) break; if (sp > XB_SPIN_CAP) { atomicAdd(&bar[XB_TMO], 1u); break; } }
    }
    nloc = mine > 0u ? mine : 1u; nx = cnt > 0u ? cnt : 1u;
}
__device__ __forceinline__ void xcd_barrier(const XcdBarrier& b) {
    asm volatile("s_waitcnt vmcnt(0)" ::: "memory");
    __syncthreads();
    if (threadIdx.x == 0) {
        unsigned* bar = b.bar;
        __builtin_amdgcn_s_waitcnt(0);
        unsigned nloc = b.st[0], nx = b.st[1];
        if (nloc == 0u) { xcd_barrier_complete(bar, b.x, nloc, nx); b.st[0] = nloc; b.st[1] = nx; }
        const unsigned old = xb_add(&bar[XB_XSUB(b.x)], 1u);
        const unsigned gen = old / nloc;
        if (old + 1u == (gen + 1u) * nloc) {
            __builtin_amdgcn_fence(__ATOMIC_RELEASE, "agent");
            asm volatile("s_waitcnt vmcnt(0)" ::: "memory");
            const unsigned og = xb_add(&bar[XB_TOP], 1u);
            const unsigned tg = og / nx;
            if (og + 1u == (tg + 1u) * nx) xb_add(&bar[XB_TOPGEN], 1u);
            else XB_SPIN(xb_ld(&bar[XB_TOPGEN]) == tg, bar);
            __builtin_amdgcn_fence(__ATOMIC_ACQUIRE, "agent");
            xb_add(&bar[XB_XGEN(b.x)], 1u);
            asm volatile("s_waitcnt vmcnt(0)" ::: "memory");
        } else {
            XB_SPIN(xb_ld(&bar[XB_XGEN(b.x)]) == gen, bar);
            __builtin_amdgcn_fence(__ATOMIC_ACQUIRE, "agent");
            asm volatile("s_waitcnt vmcnt(0)" ::: "memory");
        }
    }
    __syncthreads();
}

constexpr int NWAVES = 8;
constexpr int RING_BYTES = 131072, LDSCTL_OFF = RING_BYTES, MISC_OFF = LDSCTL_OFF + 320, LDS_BYTES = 147456;
constexpr int CW_BAR = 4096;
constexpr int CW_QCTR = 16384;

struct Args { const void* in[20]; float* out; unsigned char* ws; int ph_lo, ph_hi; };

__device__ __forceinline__ int win_srccol(int n) {
    if (n < 2048) return 2224 + n;
    if (n < 2560) return 1712 + (n - 2048);
    if (n < 2816) return 672 + (n - 2560);
    if (n < 3328) return 1184 + (n - 2816);
    if (n < 3584) return 928 + (n - 3328);
    if (n < 3968) return 0 + (n - 3584);
    if (n < 4224) return 384 + (n - 3968);
    if (n < 4256) return 640 + (n - 4224);
    if (n < 4272) return 1696 + (n - 4256);
    return -1;
}
__device__ __forceinline__ void transpose_item(const float* __restrict__ W, int K, int Nsrc, bf16_t* __restrict__ WT, int Nout, const float* __restrict__ kscale, bool winperm, float* scr, int item, int lane) {
    const int nblk = Nout / 32, kb = item / nblk, nb = item % nblk, k0 = 64 * kb, n0 = 32 * nb;
    const int n = n0 + (lane & 31); const int sc = winperm ? win_srccol(n) : n;
    float tv[32];
#pragma unroll
    for (int i = 0; i < 32; ++i) { const int kk = 2 * i + (lane >> 5); tv[i] = (sc >= 0) ? W[(size_t)(k0 + kk) * Nsrc + sc] : 0.f; }
#pragma unroll
    for (int i = 0; i < 32; ++i) { const int kk = 2 * i + (lane >> 5); float v = tv[i]; if (kscale) v *= kscale[k0 + kk]; scr[kk * 33 + (lane & 31)] = v; }
    asm volatile("s_waitcnt lgkmcnt(0)" ::: "memory");
    const int c = lane & 7;
#pragma unroll
    for (int j = 0; j < 4; ++j) { const int nn = (lane >> 3) + 8 * j; const float* s = scr + (8 * c) * 33 + nn;
        u32x4 o; o.x = pk2(s[0 * 33], s[1 * 33]); o.y = pk2(s[2 * 33], s[3 * 33]); o.z = pk2(s[4 * 33], s[5 * 33]); o.w = pk2(s[6 * 33], s[7 * 33]);
        *(u32x4*)(WT + (size_t)(n0 + nn) * K + k0 + 8 * c) = o; }
    asm volatile("s_waitcnt lgkmcnt(0)" ::: "memory");
}

#define TOPK_INSERT(tv, ti, vv, ii) do { float v_ = (vv); int i_ = (ii); \
    _Pragma("unroll") for (int q_ = 0; q_ < 16; ++q_) { const bool gt_ = (v_ > tv[q_]) || (v_ == tv[q_] && i_ < ti[q_]); const float tv_ = tv[q_]; const int ti_ = ti[q_]; \
        tv[q_] = gt_ ? v_ : tv_; ti[q_] = gt_ ? i_ : ti_; v_ = gt_ ? tv_ : v_; i_ = gt_ ? ti_ : i_; } } while (0)

template <int OFFS> __device__ __forceinline__ void quant_rows2(const float* __restrict__ tab, const float* __restrict__ g, unsigned char* __restrict__ qt, float* __restrict__ sc, int row0, int lane) {
    f32x4 v[2][4];
#pragma unroll
    for (int rr = 0; rr < 2; ++rr)
#pragma unroll
        for (int j = 0; j < 4; ++j) v[rr][j] = *(const f32x4*)(tab + (size_t)(row0 + rr) * 1024 + 16 * lane + 4 * j);
#pragma unroll
    for (int rr = 0; rr < 2; ++rr) {
        float mx = 0.f;
#pragma unroll
        for (int j = 0; j < 4; ++j) { if (g) v[rr][j] = v[rr][j] * *(const f32x4*)(g + 16 * lane + 4 * j);
            mx = fmaxf(mx, fmaxf(fmaxf(fabsf(v[rr][j][0]), fabsf(v[rr][j][1])), fmaxf(fabsf(v[rr][j][2]), fabsf(v[rr][j][3])))); }
#pragma unroll
        for (int o = 1; o < 64; o <<= 1) mx = fmaxf(mx, __shfl_xor(mx, o));
        mx = fmaxf(mx, 1e-30f);
        const float inv = 127.f / mx;
        u32x4 w;
#pragma unroll
        for (int j = 0; j < 4; ++j) { unsigned b = 0;
#pragma unroll
            for (int e = 0; e < 4; ++e) { const int q = (int)rintf(v[rr][j][e] * inv) + OFFS; b |= ((unsigned)q & 0xffu) << (8 * e); }
            w[j] = b; }
        *(u32x4*)(qt + (size_t)(lane >> 3) * (16384 * 128) + (size_t)(row0 + rr) * 128 + 16 * (lane & 7)) = w;
        if (lane == 0) sc[row0 + rr] = mx * (1.f / 127.f);
    }
}
typedef __bf16 bf2_t __attribute__((ext_vector_type(2)));
__device__ __forceinline__ float dot2_bf16(unsigned a, unsigned b, float acc) { return __builtin_amdgcn_fdot2_f32_bf16(__builtin_bit_cast(bf2_t, a), __builtin_bit_cast(bf2_t, b), acc, false); }
__global__ void __launch_bounds__(NWAVES * 64, 2) fwd(Args args) {
    extern __shared__ __attribute__((aligned(16))) unsigned char lds[];
    const int tid = threadIdx.x, lane = tid & 63, wave = __builtin_amdgcn_readfirstlane(tid >> 6);
    const int G = gridDim.x; int vcu; { const int bx = blockIdx.x; vcu = (G % 8 == 0) ? (bx % 8) * (G / 8) + bx / 8 : bx; }
    const int gw = vcu * NWAVES + wave, NGW = G * NWAVES, gtid = vcu * 512 + tid, NT = G * 512;
    unsigned char* ws = args.ws;
    const float* x = (const float*)args.in[0]; const int* positions = (const int*)args.in[1];
    const float* g_mix = (const float*)args.in[2]; const float* w_in = (const float*)args.in[3]; const float* g_q_lat = (const float*)args.in[4]; const float* w_qb = (const float*)args.in[5];
    const float* g_kv_lat = (const float*)args.in[6]; const float* w_kvb = (const float*)args.in[7]; const float* w_a2 = (const float*)args.in[8]; const float* b_a2 = (const float*)args.in[9];
    const float* g_gla = (const float*)args.in[10]; const float* w_branch_a = (const float*)args.in[11]; const float* w_branch_b = (const float*)args.in[12]; const float* w_out = (const float*)args.in[13];
    const float* g_ffn = (const float*)args.in[14]; const float* w_peer_q = (const float*)args.in[15]; const float* sub_keys = (const float*)args.in[16]; const float* peer_u = (const float*)args.in[17];
    const float* peer_v = (const float*)args.in[18]; const float* g_final = (const float*)args.in[19];
    float* out = args.out;
    float* SSQ = (float*)(ws + WS_SSQ); float* SSKV = (float*)(ws + WS_SSKV); float* SSX1 = (float*)(ws + WS_SSX1); float* COS = (float*)(ws + WS_COS); float* SIN = (float*)(ws + WS_SIN);
    float* DECAY = (float*)(ws + WS_DECAY);
    bf16_t* WIN = (bf16_t*)(ws + WS_WIN); bf16_t* WQB = (bf16_t*)(ws + WS_WQB); bf16_t* WKVB = (bf16_t*)(ws + WS_WKVB); bf16_t* WA = (bf16_t*)(ws + WS_WA); bf16_t* WB = (bf16_t*)(ws + WS_WB);
    bf16_t* WOUT = (bf16_t*)(ws + WS_WOUT); bf16_t* WPQ = (bf16_t*)(ws + WS_WPQ); bf16_t* KEYS = (bf16_t*)(ws + WS_KEYS);
    bf16_t* PROJB = (bf16_t*)(ws + WS_PROJB); bf16_t* PROJA = (bf16_t*)(ws + WS_PROJA); bf16_t* XN = (bf16_t*)(ws + WS_XN);
    bf16_t* Q = (bf16_t*)(ws + WS_Q); bf16_t* K = (bf16_t*)(ws + WS_K); bf16_t* KPE = (bf16_t*)(ws + WS_KPE); float* DST = out; bf16_t* V = (bf16_t*)((unsigned char*)out + 32 * MiB);
    bf16_t* YA = (bf16_t*)(ws + WS_YA); bf16_t* YB = (bf16_t*)(ws + WS_YB); bf16_t* MERGED = (bf16_t*)(ws + WS_MERGED); bf16_t* X1B = (bf16_t*)(ws + WS_X1B); bf16_t* QP = (bf16_t*)(ws + WS_QP);
    int* EIDX = (int*)(ws + WS_EIDX); float* EGATE = (float*)(ws + WS_EGATE); unsigned char* UT = ws + WS_UT; unsigned char* VT = ws + WS_VT; float* SU = (float*)(ws + WS_SU); float* SV = (float*)(ws + WS_SV); float* SS2 = (float*)(ws + WS_SS2); float* ZP = (float*)(ws + WS_ZP); float* CS = (float*)(ws + WS_C128); signed char* CQ = (signed char*)(ws + WS_CB);

    for (int u = tid; u < (LDS_BYTES - LDSCTL_OFF) / 4; u += NWAVES * 64) ((unsigned*)(lds + LDSCTL_OFF))[u] = 0u;
    __syncthreads();
    XcdBarrier bar; bar.bar = (unsigned*)(ws + WS_CTL) + CW_BAR; bar.x = 0; bar.st = nullptr;
    if (MK_N_LAUNCHES == 1) bar = xcd_barrier_post((unsigned*)(ws + WS_CTL) + CW_BAR, (volatile LAS unsigned*)(lds + MISC_OFF) + 8);
    const int ph_lo_ = args.ph_lo, ph_hi_ = args.ph_hi;
#define IN(k) (ph_lo_ <= (k) && (k) < ph_hi_)
#define SEAM(k) do { if (MK_N_LAUNCHES == 1) { if (IN(k) && IN((k) + 1)) xcd_barrier(bar); } } while (0)
    PG8_LAS unsigned char* ring = (PG8_LAS unsigned char*)lds;

    if (IN(0)) {
        for (int i = gtid; i < 4 * M_; i += NT) SSQ[i] = 0.f;
        float* scr = (float*)(lds + wave * 16384);
        constexpr int I_WIN = 16 * (NPROJ / 32), I_QB = 6 * 24, I_KVB = 4 * 32, I_A = 8 * 32, I_OUT = 16 * 32, I_PQ = 16 * 64;
        constexpr int NITEMS = I_WIN + I_QB + I_KVB + 2 * I_A + I_OUT + I_PQ;
        for (int it = gw; it < NITEMS; it += NGW) {
            int r = it;
            if (r < I_WIN) { transpose_item(w_in, 1024, 4272, WIN, NPROJ, nullptr, true, scr, r, lane); continue; } r -= I_WIN;
            if (r < I_QB) { transpose_item(w_qb, 384, 768, WQB, 768, g_q_lat, false, scr, r, lane); continue; } r -= I_QB;
            if (r < I_KVB) { transpose_item(w_kvb, 256, 1024, WKVB, 1024, g_kv_lat, false, scr, r, lane); continue; } r -= I_KVB;
            if (r < I_A) { transpose_item(w_branch_a, 512, 1024, WA, 1024, nullptr, false, scr, r, lane); continue; } r -= I_A;
            if (r < I_A) { transpose_item(w_branch_b, 512, 1024, WB, 1024, nullptr, false, scr, r, lane); continue; } r -= I_A;
            if (r < I_OUT) { transpose_item(w_out, 1024, 1024, WOUT, 1024, nullptr, false, scr, r, lane); continue; } r -= I_OUT;
            transpose_item(w_peer_q, 1024, 2048, WPQ, 2048, g_ffn, false, scr, r, lane);
        }
        for (int i = gtid; i < 16 * 128 * 128; i += NT) KEYS[i] = f2bf(sub_keys[i]);
        for (int i = gtid; i < M_ * 16; i += NT) { const int m = i >> 4, f = i & 15;
            const double inv = pow(10000.0, -(double)f / 16.0); const double ang = (double)positions[m] * inv;
            COS[i] = (float)cos(ang); SIN[i] = (float)sin(ang); }
        for (int row = gw * 2; row < M_; row += NGW * 2) {
            f32x4 v[2][4];
#pragma unroll
            for (int rr = 0; rr < 2; ++rr)
#pragma unroll
                for (int j = 0; j < 4; ++j) v[rr][j] = ((const f32x4*)(x + (size_t)(row + rr) * DM))[lane + 64 * j];
#pragma unroll
            for (int rr = 0; rr < 2; ++rr) { float ss = 0.f;
#pragma unroll
                for (int j = 0; j < 4; ++j) ss += (v[rr][j][0] * v[rr][j][0] + v[rr][j][1] * v[rr][j][1]) + (v[rr][j][2] * v[rr][j][2] + v[rr][j][3] * v[rr][j][3]);
                ss = wave_sum(ss); const float r = rsqrtf(ss * (1.f / DM) + EPS);
#pragma unroll
                for (int j = 0; j < 4; ++j) { const int c = 4 * (lane + 64 * j); const f32x4 gg = *(const f32x4*)(g_mix + c);
                    u32x2 w; w.x = pk2(v[rr][j][0] * r * gg[0], v[rr][j][1] * r * gg[1]); w.y = pk2(v[rr][j][2] * r * gg[2], v[rr][j][3] * r * gg[3]);
                    *(u32x2*)(XN + (size_t)(row + rr) * DM + c) = w; } }
        }
    }
    SEAM(0);
    if (MK_N_LAUNCHES == 1 && IN(0) && IN(1)) { if (tid == 0) { unsigned ord = 0; for (unsigned j = 0; j < 16; ++j) if (j < bar.x && xb_ld(&bar.bar[XB_XCNT(j)]) > 0u) ++ord; bar.st[3] = ord; } __syncthreads(); }
    if (IN(1)) {
        pg8::Gemm g{XN, WIN, nullptr, nullptr, DM, DM, M_, NPROJ, DM, 1}; pg8::StaticOrder S; S.init(g, G, (int)blockIdx.x);
        pg8::EpiProj E{PROJB, PROJA, SSQ, SSKV};
        pg8::gemm_phase<pg8::EpiProj, pg8::StaticOrder, true>(ring, g, S, E);
        { const int nwg_ = (M_ / 256) * (NPROJ / 256), rem_ = nwg_ % G, c_ = (int)blockIdx.x; const int nq_ = rem_ ? G - rem_ : G, qi_ = rem_ ? c_ - rem_ : c_;
          if (qi_ >= 0) for (int row = 2 * (qi_ * NWAVES + wave); row < 32768; row += 2 * nq_ * NWAVES) {
              if (row < 16384) quant_rows2<0>(peer_u, g_ffn, UT, SU, row, lane); else quant_rows2<0>(peer_v, nullptr, VT, SV, row - 16384, lane); } }
    }
    SEAM(1);
    if (IN(2)) {
        { pg8::Gemm g{PROJA + PA_QLAT, WQB, nullptr, nullptr, PA_LD, 384, M_, 768, 384, 1}; pg8::StaticOrder S; S.init(g, G, (int)blockIdx.x);
          pg8::EpiQ E{Q, SSQ, COS, SIN}; pg8::gemm_phase<pg8::EpiQ, pg8::StaticOrder, true>(ring, g, S, E); }
        { pg8::Gemm g{PROJA + PA_KVLAT, WKVB, nullptr, nullptr, PA_LD, 256, M_, 1024, 256, 1}; pg8::StaticOrder S; S.init(g, G, (int)blockIdx.x);
          pg8::EpiKV E{K, V, SSKV}; pg8::gemm_phase<pg8::EpiKV, pg8::StaticOrder, true>(ring, g, S, E); }
        for (int i = gtid; i < M_ * 32; i += NT) { const int m = i >> 5, j = i & 31; const bf16_t* kr = PROJA + (size_t)m * PA_LD + PA_KROPE; float o;
            if (j < 16) { const float x1 = bf2f(kr[j]), x2 = bf2f(kr[j + 16]); o = x1 * COS[m * 16 + j] - x2 * SIN[m * 16 + j]; }
            else { const int f = j - 16; const float x2 = bf2f(kr[j]), x1 = bf2f(kr[j - 16]); o = x2 * COS[m * 16 + f] + x1 * SIN[m * 16 + f]; }
            KPE[i] = f2bf(o); }
        __syncthreads();
        {
            const int r32 = lane & 31, hi5 = lane >> 5;
            unsigned char* gvt = lds; unsigned char* kdt = lds + 16384;
            const int tbase = (int)(uintptr_t)lds + gla::t_rd_base(lane);
            for (int unit = vcu; unit < 2 * NCH * 4; unit += G) {
                const int h = unit & 3, bc = unit >> 2, t0 = bc * 64;
                {
                    const int sr = tid >> 4, ch = tid & 15;
#pragma unroll
                    for (int rr = 0; rr < 2; ++rr) { const int row = sr + 32 * rr; const u32x4 v = *(const u32x4*)(PROJA + (size_t)(t0 + row) * PA_LD + PA_GV + h * 128 + ch * 8);
                        *(u32x4*)(gvt + gla::t_st<4>(row, ch * 8)) = v; }
                }
                {
                    const int k0 = wave * 8; const bf16_t* prow = PROJA + (size_t)(t0 + lane) * PA_LD;
                    const u32x4 ga = *(const u32x4*)(prow + PA_GLR), gb = *(const u32x4*)(prow + PA_GLR + 8), gkv = *(const u32x4*)(prow + PA_GK + h * 64 + k0);
                    float glr[16];
#pragma unroll
                    for (int q = 0; q < 4; ++q) { glr[2 * q] = __uint_as_float(ga[q] << 16); glr[2 * q + 1] = __uint_as_float(ga[q] & 0xffff0000u); glr[8 + 2 * q] = __uint_as_float(gb[q] << 16); glr[8 + 2 * q + 1] = __uint_as_float(gb[q] & 0xffff0000u); }
                    float kdv[8];
#pragma unroll
                    for (int j = 0; j < 8; ++j) { const int kc = h * 64 + k0 + j; float z = b_a2[kc];
#pragma unroll
                        for (int r = 0; r < 16; ++r) z += glr[r] * w_a2[r * 256 + kc];
                        float v = (fminf(z, 0.f) - log1pf(expf(-fabsf(z)))) * (1.f / 16.f);
#pragma unroll
                        for (int d = 1; d < 64; d <<= 1) { const float t = __shfl_up(v, d); v += (lane >= d) ? t : 0.f; }
                        const float cl = __builtin_bit_cast(float, __builtin_amdgcn_readlane(__builtin_bit_cast(int, v), 63));
                        const unsigned gw_ = gkv[j >> 1]; const float gk = (j & 1) ? __uint_as_float(gw_ & 0xffff0000u) : __uint_as_float(gw_ << 16);
                        kdv[j] = gk * expf(cl - v);
                        if (lane == 0) DECAY[((size_t)bc * 4 + h) * 64 + k0 + j] = expf(cl); }
                    u32x4 w; w.x = pk2(kdv[0], kdv[1]); w.y = pk2(kdv[2], kdv[3]); w.z = pk2(kdv[4], kdv[5]); w.w = pk2(kdv[6], kdv[7]);
                    *(u32x4*)(kdt + gla::t_st<2>(lane, k0)) = w;
                }
                __syncthreads();
                {
                    const int kt = wave >> 2, vt = wave & 3; gla::f32x16 acc = {};
                    gla::s16x4 al[4], ah[4], bl[4], bh[4];
                    const int abase = tbase + kt * 512, bbase = tbase + vt * 512;
#define GLA_KS(ks) do { GLA_TRRD(al[ks], abase, 16384 + gla::t_rd_off<2>(0, ks, 0)); GLA_TRRD(ah[ks], abase, 16384 + gla::t_rd_off<2>(0, ks, 1)); GLA_TRRD(bl[ks], bbase, gla::t_rd_off<4>(0, ks, 0)); GLA_TRRD(bh[ks], bbase, gla::t_rd_off<4>(0, ks, 1)); } while (0)
                    GLA_KS(0); GLA_KS(1); GLA_KS(2); GLA_KS(3);
#undef GLA_KS
                    asm volatile("s_waitcnt lgkmcnt(0)" ::: "memory"); __builtin_amdgcn_sched_barrier(0);
#pragma unroll
                    for (int ks = 0; ks < 4; ++ks) acc = __builtin_amdgcn_mfma_f32_32x32x16_bf16((gla::bf16x8){al[ks][0], al[ks][1], al[ks][2], al[ks][3], ah[ks][0], ah[ks][1], ah[ks][2], ah[ks][3]},
                                                                                                 (gla::bf16x8){bl[ks][0], bl[ks][1], bl[ks][2], bl[ks][3], bh[ks][0], bh[ks][1], bh[ks][2], bh[ks][3]}, acc, 0, 0, 0);
                    float* dp = DST + (((size_t)bc * 4 + h) * 64 + kt * 32) * 128 + vt * 32 + r32;
#pragma unroll
                    for (int r = 0; r < 16; ++r) dp[(size_t)gla::crow(r, hi5) * 128] = acc[r];
                }
                __syncthreads();
            }
        }
    }
    SEAM(2);
    if (IN(3)) {
        if (tid < 256) for (int i = vcu * 256 + tid; i < 65536; i += G * 256) {
            const int v = i & 127, k = (i >> 7) & 63, h = (i >> 13) & 3, b = i >> 15; float s = 0.f;
            float* dp = DST + (((size_t)b * NCH * 4 + h) * 64 + k) * 128 + v; const float* gp = DECAY + ((size_t)b * NCH * 4 + h) * 64 + k;
            float d[8], g[8], dn[8], gn[8];
#pragma unroll
            for (int j = 0; j < 8; ++j) { d[j] = dp[(size_t)j * 32768]; g[j] = gp[(size_t)j * 256]; }
            for (int c0 = 0; c0 < NCH; c0 += 8) {
                const int cn = (c0 + 8 < NCH) ? c0 + 8 : c0;
#pragma unroll
                for (int j = 0; j < 8; ++j) { dn[j] = dp[(size_t)(cn + j) * 32768]; gn[j] = gp[(size_t)(cn + j) * 256]; }
#pragma unroll
                for (int j = 0; j < 8; ++j) { s = g[j] * s + d[j]; d[j] = s; }
#pragma unroll
                for (int j = 0; j < 8; ++j) dp[(size_t)(c0 + j) * 32768] = d[j];
#pragma unroll
                for (int j = 0; j < 8; ++j) { d[j] = dn[j]; g[j] = gn[j]; } } }
        __syncthreads();
        {
            for (int pr = vcu; pr < 256; pr += G) {
                const int bh = pr >> 4, s16 = pr & 15, b = bh >> 3, h = bh & 7;
                att::BlockRef r0, r1;
                const bf16_t* Kh = K + (size_t)b * SEQ * att::KS + h * 96; const bf16_t* Vh = V + (size_t)b * SEQ * att::VS + h * 64;
                const int qb0 = 31 - s16, qb1 = s16;
                r0.Q = Q + ((size_t)b * SEQ + qb0 * 256) * att::QS + h * 96; r0.O = YA + ((size_t)b * SEQ + qb0 * 256) * att::OS + h * 64; r0.K = Kh; r0.KPE = KPE + (size_t)b * SEQ * 32; r0.V = Vh; r0.P0 = qb0 * 256;
                r1.Q = Q + ((size_t)b * SEQ + qb1 * 256) * att::QS + h * 96; r1.O = YA + ((size_t)b * SEQ + qb1 * 256) * att::OS + h * 64; r1.K = Kh; r1.KPE = KPE + (size_t)b * SEQ * 32; r1.V = Vh; r1.P0 = qb1 * 256;
                att::attn_block_dma(r0, (char*)lds);
                att::attn_block_dma(r1, (char*)lds);
            }
        }
    }
    SEAM(3);
    if (IN(4)) {
        const int r32 = lane & 31, hi5 = lane >> 5;
        unsigned char* stt = lds; float* part = (float*)(lds + 16384);
        const int lt = wave >> 2, vt = wave & 3;
        const int bbase = (int)(uintptr_t)lds + gla::t_rd_base(lane) + vt * 512;
        for (int unit = vcu; unit < 2 * NCH * 4; unit += G) {
            const int h = unit & 3, bc = unit >> 2, t0 = bc * 64;
            {   const int sr = tid >> 4, ch = tid & 15; const float* sp = DST + ((size_t)bc * 4 + h) * 64 * 128;
#pragma unroll
                for (int rr = 0; rr < 2; ++rr) { const int row = sr + 32 * rr; const f32x4 a = *(const f32x4*)(sp + row * 128 + ch * 8), b = *(const f32x4*)(sp + row * 128 + ch * 8 + 4);
                    u32x4 w; w.x = pk2(a[0], a[1]); w.y = pk2(a[2], a[3]); w.z = pk2(b[0], b[1]); w.w = pk2(b[2], b[3]);
                    *(u32x4*)(stt + gla::t_st<4>(row, ch * 8)) = w; } }
            gla::bf16x8 qa[4];
            { const bf16_t* qrow = PROJB + (size_t)(t0 + lt * 32 + r32) * PB_LD + PB_GQ + h * 64 + hi5 * 8;
#pragma unroll
              for (int ks = 0; ks < 4; ++ks) qa[ks] = *(const gla::bf16x8*)(qrow + ks * 16); }
            __syncthreads();
            gla::f32x16 acc = {};
            { gla::s16x4 bl[4], bh[4];
#define GLA_KS(ks) do { GLA_TRRD(bl[ks], bbase, gla::t_rd_off<4>(0, ks, 0)); GLA_TRRD(bh[ks], bbase, gla::t_rd_off<4>(0, ks, 1)); } while (0)
              GLA_KS(0); GLA_KS(1); GLA_KS(2); GLA_KS(3);
#undef GLA_KS
              asm volatile("s_waitcnt lgkmcnt(0)" ::: "memory"); __builtin_amdgcn_sched_barrier(0);
#pragma unroll
              for (int ks = 0; ks < 4; ++ks) acc = __builtin_amdgcn_mfma_f32_32x32x16_bf16(qa[ks], (gla::bf16x8){bl[ks][0], bl[ks][1], bl[ks][2], bl[ks][3], bh[ks][0], bh[ks][1], bh[ks][2], bh[ks][3]}, acc, 0, 0, 0); }
            float rs[16];
#pragma unroll
            for (int r = 0; r < 16; ++r) { acc[r] *= 0.125f; float s2 = acc[r] * acc[r];
                s2 += __builtin_bit_cast(float, __builtin_amdgcn_update_dpp(0, __builtin_bit_cast(int, s2), 0x128, 0xf, 0xf, false));
                s2 += __builtin_bit_cast(float, __builtin_amdgcn_update_dpp(0, __builtin_bit_cast(int, s2), 0x124, 0xf, 0xf, false));
                s2 += __builtin_bit_cast(float, __builtin_amdgcn_update_dpp(0, __builtin_bit_cast(int, s2), 0x122, 0xf, 0xf, false));
                s2 += __builtin_bit_cast(float, __builtin_amdgcn_update_dpp(0, __builtin_bit_cast(int, s2), 0x121, 0xf, 0xf, false));
                s2 += __shfl_xor(s2, 16); rs[r] = s2; }
            if (r32 == 0) {
#pragma unroll
                for (int r = 0; r < 16; ++r) part[(lt * 32 + gla::crow(r, hi5)) * 4 + vt] = rs[r]; }
            __syncthreads();
#pragma unroll
            for (int r = 0; r < 16; ++r) { const int l = lt * 32 + gla::crow(r, hi5); const f32x4 pp = *(const f32x4*)(part + l * 4);
                const float rn = rsqrtf(((pp[0] + pp[1]) + (pp[2] + pp[3])) * (1.f / 128.f) + EPS);
                const int v = vt * 32 + r32; const float go = bf2f(PROJB[(size_t)(t0 + l) * PB_LD + PB_GOUT + h * 128 + v]);
                const float silu = go * __builtin_amdgcn_rcpf(1.f + __expf(-go));
                YB[(size_t)(t0 + l) * 512 + h * 128 + v] = f2bf(acc[r] * rn * g_gla[h * 128 + v] * silu); }
            __syncthreads();
        }
    }
    SEAM(4);
    if (IN(5)) {
        pg8::Gemm g{YA, WA, YB, WB, 512, 512, M_, 1024, 512, 2}; pg8::StaticOrder S; S.init(g, G, (int)blockIdx.x);
        pg8::EpiMerge E{PROJB, MERGED}; pg8::gemm_phase<pg8::EpiMerge, pg8::StaticOrder, true>(ring, g, S, E);
    }
    SEAM(5);
    if (IN(6)) {
        pg8::Gemm g{MERGED, WOUT, nullptr, nullptr, DM, DM, M_, 1024, DM, 1}; pg8::StaticOrder S; S.init(g, G, (int)blockIdx.x);
        pg8::EpiX1 E{x, out, X1B, SSX1}; pg8::gemm_phase<pg8::EpiX1, pg8::StaticOrder, false>(ring, g, S, E);
    }
    SEAM(6);
    if (IN(7)) {
        pg8::Gemm g{X1B, WPQ, nullptr, nullptr, DM, DM, M_, 2048, DM, 1}; pg8::StaticOrder S; S.init(g, G, vcu); S.pair_mode = 1;
        pg8::EpiQP E{QP, SSX1}; pg8::gemm_phase<pg8::EpiQP, pg8::StaticOrder, true>(ring, g, S, E);
        asm volatile("s_waitcnt vmcnt(0)" ::: "memory"); __syncthreads();
    }
    if (IN(7)) {
        typedef short bf16x8_t __attribute__((ext_vector_type(8)));
        typedef float f32x16_t __attribute__((ext_vector_type(16)));
        const int r32 = lane & 31, hi = lane >> 5;
#define P8_SORTABLE(f) ({ const unsigned b_ = __float_as_uint(f); b_ ^ ((unsigned)((int)b_ >> 31) | 0x80000000u); })
#define P8_UNSORT(u) ({ const unsigned u_ = (u); __uint_as_float(u_ ^ (~(unsigned)((int)u_ >> 31) | 0x80000000u)); })
#define P8_CE(a, b) do { const unsigned hi_ = (a) > (b) ? (a) : (b), lo_ = (a) > (b) ? (b) : (a); (a) = hi_; (b) = lo_; } while (0)
#define P8_SORT16(x) do { P8_CE(x[0], x[1]); P8_CE(x[3], x[2]); P8_CE(x[4], x[5]); P8_CE(x[7], x[6]); P8_CE(x[8], x[9]); P8_CE(x[11], x[10]); P8_CE(x[12], x[13]); P8_CE(x[15], x[14]); P8_CE(x[0], x[2]); P8_CE(x[1], x[3]); P8_CE(x[6], x[4]); P8_CE(x[7], x[5]); P8_CE(x[8], x[10]); P8_CE(x[9], x[11]); P8_CE(x[14], x[12]); P8_CE(x[15], x[13]); P8_CE(x[0], x[1]); P8_CE(x[2], x[3]); P8_CE(x[5], x[4]); P8_CE(x[7], x[6]); P8_CE(x[8], x[9]); P8_CE(x[10], x[11]); P8_CE(x[13], x[12]); P8_CE(x[15], x[14]); P8_CE(x[0], x[4]); P8_CE(x[1], x[5]); P8_CE(x[2], x[6]); P8_CE(x[3], x[7]); P8_CE(x[12], x[8]); P8_CE(x[13], x[9]); P8_CE(x[14], x[10]); P8_CE(x[15], x[11]); P8_CE(x[0], x[2]); P8_CE(x[1], x[3]); P8_CE(x[4], x[6]); P8_CE(x[5], x[7]); P8_CE(x[10], x[8]); P8_CE(x[11], x[9]); P8_CE(x[14], x[12]); P8_CE(x[15], x[13]); P8_CE(x[0], x[1]); P8_CE(x[2], x[3]); P8_CE(x[4], x[5]); P8_CE(x[6], x[7]); P8_CE(x[9], x[8]); P8_CE(x[11], x[10]); P8_CE(x[13], x[12]); P8_CE(x[15], x[14]); P8_CE(x[0], x[8]); P8_CE(x[1], x[9]); P8_CE(x[2], x[10]); P8_CE(x[3], x[11]); P8_CE(x[4], x[12]); P8_CE(x[5], x[13]); P8_CE(x[6], x[14]); P8_CE(x[7], x[15]); P8_CE(x[0], x[4]); P8_CE(x[1], x[5]); P8_CE(x[2], x[6]); P8_CE(x[3], x[7]); P8_CE(x[8], x[12]); P8_CE(x[9], x[13]); P8_CE(x[10], x[14]); P8_CE(x[11], x[15]); P8_CE(x[0], x[2]); P8_CE(x[1], x[3]); P8_CE(x[4], x[6]); P8_CE(x[5], x[7]); P8_CE(x[8], x[10]); P8_CE(x[9], x[11]); P8_CE(x[12], x[14]); P8_CE(x[13], x[15]); P8_CE(x[0], x[1]); P8_CE(x[2], x[3]); P8_CE(x[4], x[5]); P8_CE(x[6], x[7]); P8_CE(x[8], x[9]); P8_CE(x[10], x[11]); P8_CE(x[12], x[13]); P8_CE(x[14], x[15]); } while (0)
#define P8_MERGE16(A, B, O) do { _Pragma("unroll") for (int i_ = 0; i_ < 16; ++i_) O[i_] = (A)[i_] > (B)[15 - i_] ? (A)[i_] : (B)[15 - i_]; \
        _Pragma("unroll") for (int s_ = 8; s_ >= 1; s_ >>= 1) _Pragma("unroll") for (int i_ = 0; i_ < 16; ++i_) if ((i_ & s_) == 0) P8_CE(O[i_], O[i_ + s_]); } while (0)
#define P8_INSERT(t, v) do { unsigned v_ = (v); _Pragma("unroll") for (int q_ = 0; q_ < 16; ++q_) { const unsigned a_ = t[q_] > v_ ? t[q_] : v_; v_ = t[q_] > v_ ? v_ : t[q_]; t[q_] = a_; } } while (0)
        for (int item = vcu; item < 256; item += G) {
            const int h = item & 7, tr = item >> 3;
            for (int c = tid; c < 2 * 128 * 16; c += 512) { const int p = c >> 11, row = (c >> 4) & 127, ch = c & 15;
                const u32x4 v = *(const u32x4*)(KEYS + ((size_t)(h * 2 + p) * 128 + row) * 128 + ch * 8);
                *(u32x4*)(lds + p * 32768 + row * 256 + ((ch * 16) ^ ((row & 7) << 4))) = v; }
            __syncthreads();
#pragma unroll 1
            for (int step = 0; step < 2; ++step) {
                const int m = tr * 512 + wave * 64 + step * 32 + r32;
                unsigned top[2][16];
#pragma unroll
                for (int p = 0; p < 2; ++p) {
                    bf16x8_t qf[8];
#pragma unroll
                    for (int ks = 0; ks < 8; ++ks) qf[ks] = *(const bf16x8_t*)(QP + (size_t)m * 2048 + (h * 2 + p) * 128 + ks * 16 + hi * 8);
                    f32x16_t acc[4];
#pragma unroll
                    for (int kt = 0; kt < 4; ++kt) { acc[kt] = f32x16_t{};
                        const int row = kt * 32 + r32; const unsigned char* rb = lds + p * 32768 + row * 256;
#pragma unroll
                        for (int ks = 0; ks < 8; ++ks) { const bf16x8_t a = *(const bf16x8_t*)(rb + (((2 * ks + hi) * 16) ^ ((row & 7) << 4)));
                            acc[kt] = __builtin_amdgcn_mfma_f32_32x32x16_bf16(a, qf[ks], acc[kt], 0, 0, 0); } }
                    unsigned xs[4][16];
#pragma unroll
                    for (int kt = 0; kt < 4; ++kt)
#pragma unroll
                        for (int r = 0; r < 16; ++r) { const unsigned base = 32 * kt + (r & 3) + 8 * (r >> 2);
                            xs[kt][r] = (P8_SORTABLE(acc[kt][r]) | 127u) ^ base; }
                    P8_SORT16(xs[0]); P8_SORT16(xs[1]); P8_SORT16(xs[2]); P8_SORT16(xs[3]);
                    unsigned m01[16], m23[16], t[16];
                    P8_MERGE16(xs[0], xs[1], m01); P8_MERGE16(xs[2], xs[3], m23); P8_MERGE16(m01, m23, t);
#pragma unroll
                    for (int i = 0; i < 16; ++i) t[i] ^= (unsigned)(hi << 2);
                    unsigned mm[16];
#pragma unroll
                    for (int i = 0; i < 16; ++i) { auto rr = __builtin_amdgcn_permlane32_swap(t[15 - i], t[15 - i], false, false); const unsigned pt = hi ? rr[0] : rr[1]; mm[i] = t[i] > pt ? t[i] : pt; }
#pragma unroll
                    for (int sft = 8; sft >= 1; sft >>= 1)
#pragma unroll
                        for (int i = 0; i < 16; ++i) if ((i & sft) == 0) { const unsigned a_ = mm[i] > mm[i + sft] ? mm[i] : mm[i + sft], b_ = mm[i] > mm[i + sft] ? mm[i + sft] : mm[i]; mm[i] = a_; mm[i + sft] = b_; }
#pragma unroll
                    for (int i = 0; i < 16; ++i) top[p][i] = mm[i];
                }
                float f0[16], f1[16];
#pragma unroll
                for (int i = 0; i < 16; ++i) { f0[i] = P8_UNSORT(top[0][i] & 0xFFFFFF80u); f1[i] = P8_UNSORT(top[1][i] & 0xFFFFFF80u); }
#define P8_CV(a, b) ((P8_SORTABLE(f0[a] + f1[b]) | 255u) ^ (unsigned)((a) * 16 + (b)))
                unsigned l0[16], x1[16], x2[16], x3[16], m1[16], m2[16], cb[16];
#pragma unroll
                for (int b = 0; b < 16; ++b) l0[b] = P8_CV(0, b);
#pragma unroll
                for (int b = 0; b < 8; ++b) x1[b] = P8_CV(1, b);
#pragma unroll
                for (int b = 0; b < 5; ++b) x1[8 + b] = P8_CV(2, b);
#pragma unroll
                for (int b = 0; b < 3; ++b) x1[13 + b] = P8_CV(3, b);
                x2[0] = P8_CV(3, 3);
#pragma unroll
                for (int b = 0; b < 3; ++b) x2[1 + b] = P8_CV(4, b);
#pragma unroll
                for (int b = 0; b < 2; ++b) { x2[4 + b] = P8_CV(5, b); x2[6 + b] = P8_CV(6, b); x2[8 + b] = P8_CV(7, b); }
                x2[10] = P8_CV(8, 0); x2[11] = P8_CV(9, 0); x2[12] = P8_CV(10, 0); x2[13] = P8_CV(11, 0); x2[14] = P8_CV(12, 0); x2[15] = P8_CV(13, 0);
                x3[0] = P8_CV(14, 0); x3[1] = P8_CV(15, 0);
#pragma unroll
                for (int i = 2; i < 16; ++i) x3[i] = 0u;
#undef P8_CV
                P8_SORT16(x1); P8_SORT16(x2);
                P8_MERGE16(l0, x1, m1); P8_MERGE16(x2, x3, m2); P8_MERGE16(m1, m2, cb);
                unsigned char* slot = lds + 65536 + wave * 2048 + lane * 32;
                { u32x4 w0, w1;
#define P8_IDX4(T, i) ((127u - (T[i] & 127u)) | ((127u - (T[(i) + 1] & 127u)) << 8) | ((127u - (T[(i) + 2] & 127u)) << 16) | ((127u - (T[(i) + 3] & 127u)) << 24))
                  w0.x = P8_IDX4(top[0], 0); w0.y = P8_IDX4(top[0], 4); w0.z = P8_IDX4(top[0], 8); w0.w = P8_IDX4(top[0], 12);
                  w1.x = P8_IDX4(top[1], 0); w1.y = P8_IDX4(top[1], 4); w1.z = P8_IDX4(top[1], 8); w1.w = P8_IDX4(top[1], 12);
#undef P8_IDX4
                  *(u32x4*)slot = w0; *(u32x4*)(slot + 16) = w1; }
                asm volatile("s_waitcnt lgkmcnt(0)" ::: "memory");
                float bv[16]; int be[16];
#pragma unroll
                for (int k = 0; k < 16; ++k) { const unsigned pos = (~cb[k]) & 255u; bv[k] = P8_UNSORT(cb[k] & 0xFFFFFF00u);
                    be[k] = (int)slot[pos >> 4] * 128 + (int)slot[16 + (pos & 15)]; }
                { const float b0 = bv[0];
#pragma unroll
                  for (int k = 0; k < 16; ++k) bv[k] = __expf(bv[k] - b0); }
                asm volatile("s_waitcnt lgkmcnt(0)" ::: "memory");
                if (hi == 0) { int* ep = EIDX + (size_t)m * 128 + 2 * h;
#pragma unroll
                    for (int kk = 0; kk < 8; ++kk) { u32x2 w; w.x = (unsigned)be[kk]; w.y = (unsigned)be[kk + 8]; *(u32x2*)(ep + kk * 16) = w; } }
                else { float* gp = EGATE + (size_t)m * 128 + 2 * h; float s2 = 0.f;
#pragma unroll
                    for (int k = 0; k < 16; ++k) s2 += bv[k];
                    const float inv = 1.f / s2;
#pragma unroll
                    for (int kk = 0; kk < 8; ++kk) { u32x2 w; w.x = __float_as_uint(bv[kk] * inv); w.y = __float_as_uint(bv[kk + 8] * inv); *(u32x2*)(gp + kk * 16) = w; } }
            }
            __syncthreads();
        }
#undef P8_SORTABLE
#undef P8_UNSORT
#undef P8_INSERT
#undef P8_CE
#undef P8_SORT16
#undef P8_MERGE16
    }
    SEAM(8);
#define UB(w, e) ((float)(((w) >> (8 * (e))) & 0xffu))
#define DPP_ADD(v, ctrl) v += __builtin_bit_cast(float, __builtin_amdgcn_update_dpp(0, __builtin_bit_cast(int, v), (ctrl), 0xf, 0xf, false))
    volatile unsigned* MISCW = (volatile unsigned*)(lds + MISC_OFF);
    const int x_nloc = (MK_N_LAUNCHES == 1) ? (int)MISCW[8] : G, x_nx = (MK_N_LAUNCHES == 1) ? (int)MISCW[9] : 1, x_rank = (MK_N_LAUNCHES == 1) ? (int)MISCW[10] : (int)blockIdx.x, x_ord = (MK_N_LAUNCHES == 1) ? (int)MISCW[11] : 0;
    if (IN(9)) {
        const int g = lane >> 3, c = lane & 7;
        const int tstep = x_nloc * NWAVES;
        for (int sl = x_ord; sl < 8; sl += x_nx) {
            const unsigned char* ub = UT + (size_t)sl * (16384 * 128) + 16 * c;
            const bf16_t* xbase = X1B + sl * 128 + 16 * c;
#define P9_IDX(I4, XA, XB, tt) do { const int t_ = (tt) < M_ ? (tt) : M_ - 1; const u32x4* ep_ = (const u32x4*)(EIDX + (size_t)t_ * 128 + g * 16); \
            I4[0] = ep_[0]; I4[1] = ep_[1]; I4[2] = ep_[2]; I4[3] = ep_[3]; XA = *(const u32x4*)(xbase + (size_t)t_ * DM); XB = *(const u32x4*)(xbase + (size_t)t_ * DM + 8); } while (0)
#define P9_ROWS(U, I4, hf) do { _Pragma("unroll") for (int i = 0; i < 8; ++i) U[i] = *(const u32x4*)(ub + (size_t)I4[2 * (hf) + (i >> 2)][i & 3] * 128); } while (0)
#define P9_HALF(U, hf) do { _Pragma("unroll") for (int i = 0; i < 8; ++i) { int a = __builtin_amdgcn_sdot4((int)xq[0], (int)U[i][0], 0, false); a = __builtin_amdgcn_sdot4((int)xq[1], (int)U[i][1], a, false); \
                a = __builtin_amdgcn_sdot4((int)xq[2], (int)U[i][2], a, false); a = __builtin_amdgcn_sdot4((int)xq[3], (int)U[i][3], a, false); \
                a += __builtin_amdgcn_update_dpp(0, a, 0xB1, 0xf, 0xf, false); a += __builtin_amdgcn_update_dpp(0, a, 0x4E, 0xf, 0xf, false); a += __builtin_amdgcn_update_dpp(0, a, 0x141, 0xf, 0xf, false); \
                z0 = (8 * (hf) + i == 2 * c) ? a : z0; z1 = (8 * (hf) + i == 2 * c + 1) ? a : z1; } } while (0)
            u32x4 iC[4], iN[4], iNN[4], xaC, xbC, xaN, xbN, xaNN, xbNN, uA[8], uB[8];
            int t = x_rank * NWAVES + wave;
            P9_IDX(iC, xaC, xbC, t); P9_IDX(iN, xaN, xbN, t + tstep); P9_ROWS(uA, iC, 0);
            for (; t < M_; t += tstep) {
                P9_ROWS(uB, iC, 1); P9_IDX(iNN, xaNN, xbNN, t + 2 * tstep);
                float xf[16];
#pragma unroll
                for (int q = 0; q < 4; ++q) { xf[2 * q] = __uint_as_float(xaC[q] << 16); xf[2 * q + 1] = __uint_as_float(xaC[q] & 0xffff0000u); xf[8 + 2 * q] = __uint_as_float(xbC[q] << 16); xf[8 + 2 * q + 1] = __uint_as_float(xbC[q] & 0xffff0000u); }
                float mx = 1e-30f;
#pragma unroll
                for (int j = 0; j < 16; ++j) mx = fmaxf(mx, fabsf(xf[j]));
                mx = fmaxf(mx, __builtin_bit_cast(float, __builtin_amdgcn_update_dpp(0, __builtin_bit_cast(int, mx), 0xB1, 0xf, 0xf, false)));
                mx = fmaxf(mx, __builtin_bit_cast(float, __builtin_amdgcn_update_dpp(0, __builtin_bit_cast(int, mx), 0x4E, 0xf, 0xf, false)));
                mx = fmaxf(mx, __builtin_bit_cast(float, __builtin_amdgcn_update_dpp(0, __builtin_bit_cast(int, mx), 0x141, 0xf, 0xf, false)));
                const float xinv = 127.f * __builtin_amdgcn_rcpf(mx), xsc = mx * (1.f / 127.f);
                unsigned xq[4];
#pragma unroll
                for (int q = 0; q < 4; ++q) { unsigned b = 0;
#pragma unroll
                    for (int e = 0; e < 4; ++e) { const int qi = (int)rintf(xf[4 * q + e] * xinv); b |= ((unsigned)qi & 0xffu) << (8 * e); }
                    xq[q] = b; }
                int z0 = 0, z1 = 0;
                P9_HALF(uA, 0);
                P9_ROWS(uA, iN, 0);
                P9_HALF(uB, 1);
                { u32x2 w; w.x = __float_as_uint((float)z0 * xsc); w.y = __float_as_uint((float)z1 * xsc); *(u32x2*)(ZP + ((size_t)sl * M_ + t) * 128 + g * 16 + 2 * c) = w; }
#pragma unroll
                for (int q = 0; q < 4; ++q) { iC[q] = iN[q]; iN[q] = iNN[q]; }
                xaC = xaN; xbC = xbN; xaN = xaNN; xbN = xbNN;
            }
#undef P9_HALF
#undef P9_IDX
#undef P9_ROWS
        }
    }
    SEAM(9);
    if (IN(10)) {
        for (int t = gw; t < M_; t += NGW) { const float r = rsqrtf(SSX1[t] * (1.f / DM) + EPS); float av[2]; float mx = 1e-30f;
#pragma unroll
            for (int v = 0; v < 2; ++v) { const int p = lane + 64 * v; const int e = EIDX[(size_t)t * 128 + p]; float zs[8];
#pragma unroll
                for (int j = 0; j < 8; ++j) zs[j] = ZP[((size_t)j * M_ + t) * 128 + p];
                float z = ((zs[0] + zs[1]) + (zs[2] + zs[3])) + ((zs[4] + zs[5]) + (zs[6] + zs[7]));
                z *= SU[e] * r;
                av[v] = 0.5f * z * (1.f + erff(z * 0.70710678118654752f)) * EGATE[(size_t)t * 128 + p] * SV[e];
                mx = fmaxf(mx, fabsf(av[v])); }
#pragma unroll
            for (int o = 1; o < 64; o <<= 1) mx = fmaxf(mx, __shfl_xor(mx, o));
            const float inv = 127.f / mx;
            CQ[(size_t)t * 128 + lane] = (signed char)(int)rintf(av[0] * inv); CQ[(size_t)t * 128 + 64 + lane] = (signed char)(int)rintf(av[1] * inv);
            if (lane == 0) CS[t] = mx * (1.f / 127.f); }
    }
    SEAM(10);
    if (IN(11)) {
        const int g = lane >> 3, c = lane & 7;
        const int tstep = x_nloc * NWAVES;
        for (int sl = x_ord; sl < 8; sl += x_nx) {
            const unsigned char* vb = VT + (size_t)sl * (16384 * 128) + 16 * c;
#define P11_IDX(I4, C4, tt) do { const int t_ = (tt) < M_ ? (tt) : M_ - 1; const u32x4* ep_ = (const u32x4*)(EIDX + (size_t)t_ * 128 + g * 16); \
            I4[0] = ep_[0]; I4[1] = ep_[1]; I4[2] = ep_[2]; I4[3] = ep_[3]; C4 = *(const u32x4*)(CQ + (size_t)t_ * 128 + g * 16); } while (0)
#define P11_ROWS(U, I4, hf) do { _Pragma("unroll") for (int i = 0; i < 8; ++i) U[i] = *(const u32x4*)(vb + (size_t)I4[2 * (hf) + (i >> 2)][i & 3] * 128); } while (0)
#define P11_BLK(U, b0, q, CW) do { const unsigned d0_ = U[b0][q], d1_ = U[(b0) + 1][q], d2_ = U[(b0) + 2][q], d3_ = U[(b0) + 3][q]; \
            const unsigned t0_ = __builtin_amdgcn_perm(d1_, d0_, 0x05010400u), t1_ = __builtin_amdgcn_perm(d1_, d0_, 0x07030602u), t2_ = __builtin_amdgcn_perm(d3_, d2_, 0x05010400u), t3_ = __builtin_amdgcn_perm(d3_, d2_, 0x07030602u); \
            acc[4 * (q)] = __builtin_amdgcn_sdot4((int)__builtin_amdgcn_perm(t2_, t0_, 0x05040100u), (int)(CW), acc[4 * (q)], false); \
            acc[4 * (q) + 1] = __builtin_amdgcn_sdot4((int)__builtin_amdgcn_perm(t2_, t0_, 0x07060302u), (int)(CW), acc[4 * (q) + 1], false); \
            acc[4 * (q) + 2] = __builtin_amdgcn_sdot4((int)__builtin_amdgcn_perm(t3_, t1_, 0x05040100u), (int)(CW), acc[4 * (q) + 2], false); \
            acc[4 * (q) + 3] = __builtin_amdgcn_sdot4((int)__builtin_amdgcn_perm(t3_, t1_, 0x07060302u), (int)(CW), acc[4 * (q) + 3], false); } while (0)
#define P11_HALF(U, C4, hf) do { _Pragma("unroll") for (int bb = 0; bb < 2; ++bb) { const unsigned cw_ = C4[2 * (hf) + bb]; \
            _Pragma("unroll") for (int q = 0; q < 4; ++q) P11_BLK(U, 4 * bb, q, cw_); } } while (0)
            u32x4 iC[4], iN[4], iNN[4], uA[8], uB[8], cC, cN, cNN;
            const int hi5 = lane >> 5, b3 = (lane >> 3) & 1;
            int t = x_rank * NWAVES + wave;
            P11_IDX(iC, cC, t); P11_IDX(iN, cN, t + tstep); P11_ROWS(uA, iC, 0);
            for (; t < M_; t += tstep) {
                float* op = out + (size_t)t * DM + sl * 128 + 16 * c + 4 * b3 + 8 * hi5;
                const f32x4 x1v = *(const f32x4*)op; const float cs = CS[t];
                P11_ROWS(uB, iC, 1); P11_IDX(iNN, cNN, t + 2 * tstep);
                int acc[16];
#pragma unroll
                for (int j = 0; j < 16; ++j) acc[j] = 0;
                P11_HALF(uA, cC, 0);
                P11_ROWS(uA, iN, 0);
                P11_HALF(uB, cC, 1);
                int w8[8];
#pragma unroll
                for (int j = 0; j < 8; ++j) { auto rr = __builtin_amdgcn_permlane32_swap((unsigned)acc[j], (unsigned)acc[j + 8], false, false); w8[j] = (int)rr[0] + (int)rr[1]; }
#pragma unroll
                for (int j = 0; j < 8; ++j) w8[j] += __shfl_xor(w8[j], 16);
                f32x4 o; float ss = 0.f;
#pragma unroll
                for (int j = 0; j < 4; ++j) { const int keep = b3 ? w8[j + 4] : w8[j]; const int give = b3 ? w8[j] : w8[j + 4];
                    const int tot = keep + __builtin_amdgcn_update_dpp(0, give, 0x128, 0xf, 0xf, false);
                    o[j] = x1v[j] + (float)tot * cs; ss += o[j] * o[j]; }
                if (((lane >> 4) & 1) == 0) *(f32x4*)op = o;
                DPP_ADD(ss, 0x128); DPP_ADD(ss, 0x124); DPP_ADD(ss, 0x122); DPP_ADD(ss, 0x121);
                { const float s0 = __builtin_bit_cast(float, __builtin_amdgcn_readlane(__builtin_bit_cast(int, ss), 0)), s1 = __builtin_bit_cast(float, __builtin_amdgcn_readlane(__builtin_bit_cast(int, ss), 32));
                  if (lane == 0) atomicAdd(SS2 + t, s0 + s1); }
#pragma unroll
                for (int q = 0; q < 4; ++q) { iC[q] = iN[q]; iN[q] = iNN[q]; }
                cC = cN; cN = cNN;
            }
#undef P11_BLK
#undef P11_HALF
#undef P11_IDX
#undef P11_ROWS
        }
    }
    SEAM(11);
    if (IN(12)) {
        for (int m = gw; m < M_; m += NGW) { const float r2 = rsqrtf(SS2[m] * (1.f / DM) + EPS); float* orow = out + (size_t)m * DM;
#pragma unroll
            for (int j = 0; j < 4; ++j) { const int cix = 4 * (lane + 64 * j); const f32x4 gg = *(const f32x4*)(g_final + cix); f32x4 o = *(const f32x4*)(orow + cix);
                o[0] *= r2 * gg[0]; o[1] *= r2 * gg[1]; o[2] *= r2 * gg[2]; o[3] *= r2 * gg[3]; *(f32x4*)(orow + cix) = o; } }
    }
#undef UB
#undef DPP_ADD
#undef IN
#undef SEAM
}

extern "C" void kernel_launch(void* const* d_in, const int* in_sizes, int n_in, void* d_out, int out_size, void* d_ws, size_t ws_size, hipStream_t stream) {
    static int grid = 0;
    if (grid == 0) {
        if (n_in != 20 || out_size != M_ * DM || ws_size < WS_END) { fprintf(stderr, "kernel_launch: unexpected shapes (n_in %d out %d ws %zu); nothing launched\n", n_in, out_size, ws_size); grid = -1; return; }
        int dev = 0, cus = 0;
        if (hipGetDevice(&dev) != hipSuccess || hipDeviceGetAttribute(&cus, hipDeviceAttributeMultiprocessorCount, dev) != hipSuccess) { grid = -1; return; }
        if (hipFuncSetAttribute((const void*)fwd, hipFuncAttributeMaxDynamicSharedMemorySize, LDS_BYTES) != hipSuccess) { fprintf(stderr, "kernel_launch: hipFuncSetAttribute failed\n"); grid = -1; return; }
        int per_cu = 0;
        if (hipOccupancyMaxActiveBlocksPerMultiprocessor(&per_cu, (const void*)fwd, NWAVES * 64, LDS_BYTES) != hipSuccess || per_cu < 1) fprintf(stderr, "kernel_launch: occupancy query reports %d\n", per_cu);
        (void)hipGetLastError();
        grid = cus;
    }
    if (grid < 0) return;
    (void)hipMemsetAsync((char*)d_ws + WS_CTL, 0, CTL_ZERO_BYTES, stream);
    Args a; memset(&a, 0, sizeof(a));
    for (int i = 0; i < 20; ++i) a.in[i] = d_in[i];
    a.out = (float*)d_out; a.ws = (unsigned char*)d_ws;
    if (MK_N_LAUNCHES == 1) { a.ph_lo = 0; a.ph_hi = N_PHASES; hipLaunchKernelGGL(fwd, dim3(grid), dim3(NWAVES * 64), LDS_BYTES, stream, a); }
    else for (int p = 0; p < N_PHASES; ++p) { a.ph_lo = p; a.ph_hi = p + 1; hipLaunchKernelGGL(fwd, dim3(grid), dim3(NWAVES * 64), LDS_BYTES, stream, a); }
}
```

```cpp
#include <hip/hip_runtime.h>
#include <cstdio>
#include <cstdint>
#include <cstring>
#include <math.h>

#ifndef MK_N_LAUNCHES
#define MK_N_LAUNCHES 1
#endif
constexpr int N_PHASES = 13;

typedef unsigned short bf16_t;
constexpr int SEQ = 8192, DM = 1024, M_ = 16384, NCH = 128;
constexpr float EPS = 1e-6f;
constexpr int PB_LD = 2816, PA_LD = 1536;
constexpr int PB_BR = 0, PB_GOUT = 2048, PB_GQ = 2560;
constexpr int PA_GV = 0, PA_GK = 512, PA_QLAT = 768, PA_KVLAT = 1152, PA_KROPE = 1408, PA_GLR = 1440;
constexpr int NPROJ = 4352;
constexpr float CQ = 0.10206207261596577f * 1.4426950408889634f;

constexpr size_t MiB = 1u << 20;
constexpr size_t WS_CTL = 0, CTL_ZERO_BYTES = 256 * 1024;
constexpr size_t WS_SSQ = 1 * MiB, WS_SSKV = WS_SSQ + 65536, WS_SSX1 = WS_SSKV + 65536, WS_SS2 = WS_SSX1 + 65536, WS_C128 = WS_SS2 + 65536  , WS_CB = 136 * MiB  , WS_ZP = 56 * MiB  , WS_COS = 2 * MiB, WS_SIN = 3 * MiB;
constexpr size_t WS_DECAY = 1 * MiB + 512 * 1024;
constexpr size_t WS_WIN = 4 * MiB, WS_WQB = 13 * MiB, WS_WKVB = 14 * MiB, WS_WA = 15 * MiB, WS_WB = 16 * MiB, WS_WOUT = 17 * MiB, WS_WPQ = 19 * MiB, WS_KEYS = 23 * MiB;
constexpr size_t WS_PROJB = 24 * MiB, WS_PROJA = 112 * MiB, WS_XN = 160 * MiB, WS_Q = 160 * MiB, WS_K = 184 * MiB, WS_V = 208 * MiB, WS_DST = 224 * MiB;
constexpr size_t WS_YA = 112 * MiB, WS_YB = 128 * MiB, WS_MERGED = 160 * MiB, WS_X1B = 24 * MiB, WS_QP = 56 * MiB, WS_EIDX = 120 * MiB, WS_EGATE = 128 * MiB;
constexpr size_t WS_KPE = 208 * MiB  , WS_UT = 224 * MiB, WS_VT = 240 * MiB, WS_SU = 1 * MiB + 768 * 1024, WS_SV = WS_SU + 65536;
constexpr size_t WS_END = 256 * MiB;

#define GAS __attribute__((address_space(1)))
#define LAS __attribute__((address_space(3)))
typedef float f32x4 __attribute__((ext_vector_type(4)));
typedef unsigned u32x4 __attribute__((ext_vector_type(4)));
typedef unsigned u32x2 __attribute__((ext_vector_type(2)));

__device__ __forceinline__ float bf2f(bf16_t h) { return __uint_as_float(((unsigned)h) << 16); }
__device__ __forceinline__ unsigned f2bf_u(float f) { unsigned u = __float_as_uint(f); return (u + 0x7fffu + ((u >> 16) & 1u)) >> 16; }
__device__ __forceinline__ bf16_t f2bf(float f) { return (bf16_t)f2bf_u(f); }
__device__ __forceinline__ unsigned pk2(float lo, float hi) { return f2bf_u(lo) | (f2bf_u(hi) << 16); }
__device__ __forceinline__ float wave_sum(float v) {
#pragma unroll
    for (int o = 1; o < 64; o <<= 1) v += __shfl_xor(v, o);
    return v;
}
__device__ __forceinline__ float sigmoidf_(float x) { return 1.f / (1.f + __expf(-x)); }

namespace pg8 {
#define PG8_LAS __attribute__((address_space(3)))
typedef short bf16x8 __attribute__((ext_vector_type(8)));
constexpr int BM = 256, BK = 64, HALF = 128, HTB = HALF * BK * 2, STAGE_BYTES = 8 * HTB, NXCD = 8, WGM = 8;
__host__ __device__ __forceinline__ int lds_byte(int r, int c) { const int st = (r >> 4) * 2 + (c >> 5), rr = r & 15, cc = c & 31, ob = rr * 64 + cc * 2; return st * 1024 + (ob ^ (((ob >> 9) & 1) << 5)); }
__host__ __device__ __forceinline__ void stage_rc(int b, int& R, int& C) { const int st = b / 1024, sb = b % 1024, swz = sb ^ (((sb >> 9) & 1) << 5); R = (st >> 1) * 16 + swz / 64; C = (st & 1) * 32 + (swz % 64) / 2; }
__host__ __device__ __forceinline__ int perm32(int rho) { const int n = rho >> 4, i = rho & 15; return 8 * (i >> 2) + 4 * n + (i & 3); }

struct Unit { int pm, pn, sub; const char* A; const char* B; };
struct Gemm { const bf16_t* A; const bf16_t* Bt; const bf16_t* A2; const bf16_t* Bt2; int lda, ldb, M, N, K, chain; };
struct StaticOrder {
    int nM, nN, nwg, G, c, chain; const char *A, *B, *A2, *B2; size_t tsA, tsB;
    __device__ __forceinline__ void init(const Gemm& g, int G_, int c_) { nM = g.M / BM; nN = g.N / BM; nwg = nM * nN; G = G_; c = c_; chain = g.chain; A = (const char*)g.A; B = (const char*)g.Bt; A2 = (const char*)g.A2; B2 = (const char*)g.Bt2;
        tsA = (size_t)BM * g.lda * 2; tsB = (size_t)BM * g.ldb * 2; }
    int pair_mode = 0;
    __device__ __forceinline__ bool next(int i, Unit& u) const {
        if (pair_mode) { const int item = c + (i >> 1) * G; if (item >= nwg / 2) return false; u.pm = 2 * (item >> 3) + (i & 1); u.pn = item & 7; u.sub = 0; u.A = A + (size_t)u.pm * tsA; u.B = B + (size_t)u.pn * tsB; return true; }
        const int r = (chain == 2) ? (i >> 1) : i, sub = (chain == 2) ? (i & 1) : 0;
        const long L = (long)r * G + c; if (L >= nwg) return false;
        int wgid = (int)L; { const int q = nwg / NXCD, rr = nwg % NXCD, xcd = wgid % NXCD, off = wgid / NXCD; wgid = (xcd < rr ? xcd * (q + 1) : rr * (q + 1) + (xcd - rr) * q) + off; }
        const int nig = WGM * nN, gid = wgid / nig, fm = gid * WGM, gsz = (nM - fm) < WGM ? (nM - fm) : WGM;
        u.pm = fm + ((wgid % nig) % gsz); u.pn = (wgid % nig) / gsz; u.sub = sub;
        u.A = (sub ? A2 : A) + (size_t)u.pm * tsA; u.B = (sub ? B2 : B) + (size_t)u.pn * tsB; return true;
    }
};
__device__ __forceinline__ unsigned cvt_pk_bf16(float lo, float hi) { unsigned r; asm volatile("v_cvt_pk_bf16_f32 %0, %1, %2" : "=v"(r) : "v"(lo), "v"(hi)); return r; }

typedef f32x4 AccT[2][2][4][2];
template <class Epi, class Sched, bool ALIGN_EPI>
__device__ __forceinline__ void gemm_phase(PG8_LAS unsigned char* lds, const Gemm g, const Sched& S, const Epi& E) {
    const int tid = threadIdx.x, wid = __builtin_amdgcn_readfirstlane(tid >> 6), lane = tid & 63, wr = wid >> 2, wc = wid & 3, fr = lane & 15, fq = lane >> 4;
    const int K = g.K, nt = K / BK;
    unsigned voffA[2], voffB[2];
#pragma unroll
    for (int i = 0; i < 2; ++i) { int R, C; stage_rc(tid * 16 + i * 8192, R, C); const int Rb = Epi::PERM ? ((R & ~31) + perm32(R & 31)) : R;
        voffA[i] = (unsigned)(R * g.lda + C) * 2u; voffB[i] = (unsigned)(Rb * g.ldb + C) * 2u; }
    const size_t kstep = (size_t)(BK * 2);
    const size_t hsA = (size_t)HALF * g.lda * 2, hsB = (size_t)HALF * g.ldb * 2;
    const unsigned ldsw = (unsigned)wid * 1024u;
    const int aoff = lds_byte(wr * 64 + fr, fq * 8), boff = lds_byte(wc * 32 + fr, fq * 8);
#define PG8_SA(b, h) (((b) * 2 + (h)) * HTB)
#define PG8_SB(b, h) ((4 + (b) * 2 + (h)) * HTB)
#define PG8_STAGE(bufoff, gbase, voff) do { _Pragma("unroll") for (int _i = 0; _i < 2; ++_i) \
        __builtin_amdgcn_global_load_lds((const unsigned*)((const char*)(gbase) + (voff)[_i]), (PG8_LAS unsigned*)(lds + (bufoff) + ldsw + _i * 8192), 16, 0, 0); } while (0)
#define PG8_LDA(dst, b, h) do { _Pragma("unroll") for (int m = 0; m < 4; ++m) _Pragma("unroll") for (int k = 0; k < 2; ++k) dst[m][k] = *(const PG8_LAS bf16x8*)(lds + PG8_SA(b, h) + aoff + m * 2048 + k * 1024); } while (0)
#define PG8_LDB(dst, b, h) do { _Pragma("unroll") for (int n = 0; n < 2; ++n) _Pragma("unroll") for (int k = 0; k < 2; ++k) dst[n][k] = *(const PG8_LAS bf16x8*)(lds + PG8_SB(b, h) + boff + n * 2048 + k * 1024); } while (0)
#define PG8_MMA(ai, bj, At, Bt) do { __builtin_amdgcn_s_setprio(1); _Pragma("unroll") for (int m = 0; m < 4; ++m) _Pragma("unroll") for (int n = 0; n < 2; ++n) _Pragma("unroll") for (int k = 0; k < 2; ++k) \
        acc[ai][bj][m][n] = __builtin_amdgcn_mfma_f32_16x16x32_bf16(Bt[n][k], At[m][k], acc[ai][bj][m][n], 0, 0, 0); __builtin_amdgcn_s_setprio(0); } while (0)
#define PG8_WAIT_V(n) asm volatile("s_waitcnt vmcnt(" #n ")" ::: "memory")
#define PG8_WAIT_L(n) asm volatile("s_waitcnt lgkmcnt(" #n ")" ::: "memory")
#define PG8_BAR __builtin_amdgcn_s_barrier()
#define PG8_SCHED __builtin_amdgcn_sched_barrier(0)
    Unit cur, nxt; int ui = 0;
    if (!S.next(0, cur)) return;
    f32x4 acc[2][2][4][2];
#pragma unroll
    for (int a = 0; a < 2; ++a)
#pragma unroll
        for (int b = 0; b < 2; ++b)
#pragma unroll
            for (int m = 0; m < 4; ++m)
#pragma unroll
                for (int n = 0; n < 2; ++n) acc[a][b][m][n] = (f32x4){0.f, 0.f, 0.f, 0.f};
    bf16x8 At[4][2], B0[2][2], B1[2][2];
    const char* cA = cur.A; const char* cB = cur.B;
    PG8_STAGE(PG8_SB(0, 0), cB, voffB); PG8_STAGE(PG8_SB(0, 1), cB + hsB, voffB); PG8_STAGE(PG8_SA(0, 0), cA, voffA); PG8_STAGE(PG8_SA(0, 1), cA + hsA, voffA);
    if (wr == 1) PG8_BAR;
    PG8_WAIT_V(2); PG8_BAR;
    PG8_STAGE(PG8_SB(1, 0), cB + kstep, voffB); PG8_STAGE(PG8_SA(1, 0), cA + kstep, voffA); PG8_STAGE(PG8_SB(1, 1), cB + hsB + kstep, voffB);
    PG8_WAIT_V(6); PG8_BAR;
    for (;;) {
        const bool has_next = S.next(ui + 1, nxt);
        const char* nA = has_next ? nxt.A : cA; const char* nB = has_next ? nxt.B : cB;
        for (int t = 0; t < nt; t += 2) {
            const bool last = (t == nt - 2);
            const char* a1 = cA + (size_t)(t + 1) * kstep;
            const char* a2 = last ? nA : cA + (size_t)(t + 2) * kstep; const char* b2 = last ? nB : cB + (size_t)(t + 2) * kstep;
            const char* a3 = a2 + kstep; const char* b3 = b2 + kstep;
            PG8_LDB(B0, 0, 0); PG8_LDB(B1, 0, 1); PG8_SCHED; PG8_LDA(At, 0, 0); PG8_STAGE(PG8_SA(1, 1), a1 + hsA, voffA);
            PG8_WAIT_V(8); PG8_WAIT_L(0); PG8_BAR; PG8_MMA(0, 0, At, B0); PG8_MMA(0, 1, At, B1); PG8_BAR; PG8_SCHED;
            PG8_LDA(At, 0, 1); PG8_STAGE(PG8_SB(0, 0), b2, voffB); PG8_STAGE(PG8_SB(0, 1), b2 + hsB, voffB); PG8_STAGE(PG8_SA(0, 0), a2, voffA);
            PG8_WAIT_V(8); PG8_WAIT_L(0); PG8_BAR; PG8_MMA(1, 0, At, B0); PG8_MMA(1, 1, At, B1); PG8_BAR; PG8_SCHED;
            PG8_LDB(B0, 1, 0); PG8_LDB(B1, 1, 1); PG8_SCHED; PG8_LDA(At, 1, 0); PG8_STAGE(PG8_SA(0, 1), a2 + hsA, voffA);
            PG8_WAIT_V(8); PG8_WAIT_L(0); PG8_BAR; PG8_MMA(0, 0, At, B0); PG8_MMA(0, 1, At, B1); PG8_BAR; PG8_SCHED;
            PG8_LDA(At, 1, 1); PG8_STAGE(PG8_SB(1, 0), b3, voffB); PG8_STAGE(PG8_SB(1, 1), b3 + hsB, voffB); PG8_STAGE(PG8_SA(1, 0), a3, voffA);
            PG8_WAIT_V(8); PG8_WAIT_L(0); PG8_BAR; PG8_MMA(1, 0, At, B0); PG8_MMA(1, 1, At, B1); PG8_BAR; PG8_SCHED;
        }
        if constexpr (ALIGN_EPI) { if (wr == 0) PG8_BAR; }
        E(acc, cur, wr, wc, fr, fq);
        if (!has_next) break;
        if (!(Epi::CHAIN && nxt.sub != 0)) {
#pragma unroll
            for (int a = 0; a < 2; ++a)
#pragma unroll
                for (int b = 0; b < 2; ++b)
#pragma unroll
                    for (int m = 0; m < 4; ++m)
#pragma unroll
                        for (int n = 0; n < 2; ++n) acc[a][b][m][n] = (f32x4){0.f, 0.f, 0.f, 0.f};
        }
        cur = nxt; cA = nA; cB = nB; ++ui;
        if constexpr (ALIGN_EPI) { if (wr == 1) PG8_BAR; }
    }
    PG8_WAIT_V(0);
    if constexpr (!ALIGN_EPI) { if (wr == 0) PG8_BAR; }
    PG8_BAR;
#undef PG8_SA
#undef PG8_SB
#undef PG8_STAGE
#undef PG8_LDA
#undef PG8_LDB
#undef PG8_MMA
#undef PG8_WAIT_V
#undef PG8_WAIT_L
#undef PG8_BAR
#undef PG8_SCHED
}

struct EpiProj {
    static constexpr bool PERM = true, CHAIN = false;
    bf16_t* pb; bf16_t* pa; float* ssq; float* sskv;
    __device__ __forceinline__ void operator()(AccT& acc, const Unit& u, int wr, int wc, int fr, int fq) const {
        const int row0 = u.pm * BM + wr * 64 + fr;
#pragma unroll
        for (int bj = 0; bj < 2; ++bj) {
            const int hk = u.pn * 2 + bj;
            bf16_t* base; int ld; float* ss = nullptr;
            if (hk < 22) { base = pb + hk * 128; ld = PB_LD; } else { const int ha = hk - 22; base = pa + ha * 128; ld = PA_LD; if (ha >= 6 && ha <= 8) ss = ssq; else if (ha == 9 || ha == 10) ss = sskv; }
            base += wc * 32 + 8 * fq;
#pragma unroll
            for (int ai = 0; ai < 2; ++ai)
#pragma unroll
                for (int m = 0; m < 4; ++m) { const int row = row0 + ai * HALF + m * 16; const f32x4 v0 = acc[ai][bj][m][0], v1 = acc[ai][bj][m][1];
                    u32x4 w; w.x = cvt_pk_bf16(v0[0], v0[1]); w.y = cvt_pk_bf16(v0[2], v0[3]); w.z = cvt_pk_bf16(v1[0], v1[1]); w.w = cvt_pk_bf16(v1[2], v1[3]);
                    *(u32x4*)(base + (size_t)row * ld) = w;
                    if (ss) { float s = (v0[0] * v0[0] + v0[1] * v0[1]) + (v0[2] * v0[2] + v0[3] * v0[3]) + (v1[0] * v1[0] + v1[1] * v1[1]) + (v1[2] * v1[2] + v1[3] * v1[3]);
                        s += __shfl_xor(s, 16); s += __shfl_xor(s, 32); if (fq == 0) atomicAdd(ss + row, s); } }
        }
    }
};
struct EpiQ {
    static constexpr bool PERM = false, CHAIN = false;
    bf16_t* Q; const float* ssq; const float* cs; const float* sn;
    __device__ __forceinline__ void operator()(AccT& acc, const Unit& u, int wr, int wc, int fr, int fq) const {
        const int row0 = u.pm * BM + wr * 64 + fr;
#pragma unroll
        for (int ai = 0; ai < 2; ++ai)
#pragma unroll
            for (int m = 0; m < 4; ++m) { const int row = row0 + ai * HALF + m * 16; const float rr = rsqrtf(ssq[row] * (1.f / 384.f) + EPS) * CQ;
#pragma unroll
                for (int bj = 0; bj < 2; ++bj) { const int G = u.pn * 8 + bj * 4 + wc;
                    f32x4 x0 = acc[ai][bj][m][0], x1 = acc[ai][bj][m][1];
                    if (G % 3 == 2) { const f32x4 c = *(const f32x4*)(cs + (size_t)row * 16 + 4 * fq), s = *(const f32x4*)(sn + (size_t)row * 16 + 4 * fq);
                        const f32x4 o0 = x0 * c - x1 * s, o1 = x1 * c + x0 * s; x0 = o0; x1 = o1; }
                    x0 = x0 * rr; x1 = x1 * rr;
                    bf16_t* p = Q + (size_t)row * 768 + G * 32 + 4 * fq;
                    u32x2 w0, w1; w0.x = cvt_pk_bf16(x0[0], x0[1]); w0.y = cvt_pk_bf16(x0[2], x0[3]); w1.x = cvt_pk_bf16(x1[0], x1[1]); w1.y = cvt_pk_bf16(x1[2], x1[3]);
                    *(u32x2*)p = w0; *(u32x2*)(p + 16) = w1; } }
    }
};
struct EpiKV {
    static constexpr bool PERM = true, CHAIN = false;
    bf16_t* Kb; bf16_t* Vb; const float* sskv;
    __device__ __forceinline__ void operator()(AccT& acc, const Unit& u, int wr, int wc, int fr, int fq) const {
        const int row0 = u.pm * BM + wr * 64 + fr;
#pragma unroll
        for (int ai = 0; ai < 2; ++ai)
#pragma unroll
            for (int m = 0; m < 4; ++m) { const int row = row0 + ai * HALF + m * 16; const float rr = rsqrtf(sskv[row] * (1.f / 256.f) + EPS);
#pragma unroll
                for (int bj = 0; bj < 2; ++bj) { const int head = u.pn * 2 + bj; const f32x4 v0 = acc[ai][bj][m][0] * rr, v1 = acc[ai][bj][m][1] * rr;
                    u32x4 w; w.x = cvt_pk_bf16(v0[0], v0[1]); w.y = cvt_pk_bf16(v0[2], v0[3]); w.z = cvt_pk_bf16(v1[0], v1[1]); w.w = cvt_pk_bf16(v1[2], v1[3]);
                    bf16_t* p = (wc < 2) ? Kb + (size_t)row * 768 + head * 96 + wc * 32 + 8 * fq : Vb + (size_t)row * 512 + head * 64 + (wc - 2) * 32 + 8 * fq;
                    *(u32x4*)p = w; } }
    }
};
struct EpiMerge {
    static constexpr bool PERM = true, CHAIN = true;
    const bf16_t* pb; bf16_t* merged;
    __device__ __forceinline__ void operator()(AccT& acc, const Unit& u, int wr, int wc, int fr, int fq) const {
        const int row0 = u.pm * BM + wr * 64 + fr, col0 = u.pn * BM + wc * 32 + 8 * fq;
#pragma unroll
        for (int ai = 0; ai < 2; ++ai)
#pragma unroll
            for (int m = 0; m < 4; ++m) { const int row = row0 + ai * HALF + m * 16;
#pragma unroll
                for (int bj = 0; bj < 2; ++bj) { const int col = col0 + bj * HALF;
                    const u32x4 gb = *(const u32x4*)(pb + (size_t)row * PB_LD + PB_BR + 1024 + col);
                    float eb[8];
#pragma unroll
                    for (int e = 0; e < 4; ++e) { eb[2 * e] = 1.f + __builtin_amdgcn_exp2f(__uint_as_float(gb[e] << 16) * -1.4426950408889634f); eb[2 * e + 1] = 1.f + __builtin_amdgcn_exp2f(__uint_as_float(gb[e] & 0xffff0000u) * -1.4426950408889634f); }
                    if (u.sub == 0) {
                        const u32x4 ga = *(const u32x4*)(pb + (size_t)row * PB_LD + PB_BR + col);
#pragma unroll
                        for (int e = 0; e < 4; ++e) { const float ea0 = 1.f + __builtin_amdgcn_exp2f(__uint_as_float(ga[e] << 16) * -1.4426950408889634f), ea1 = 1.f + __builtin_amdgcn_exp2f(__uint_as_float(ga[e] & 0xffff0000u) * -1.4426950408889634f);
                            const int i0 = 2 * e, i1 = 2 * e + 1;
                            acc[ai][bj][m][i0 >> 2][i0 & 3] *= eb[i0] * __builtin_amdgcn_rcpf(ea0); acc[ai][bj][m][i1 >> 2][i1 & 3] *= eb[i1] * __builtin_amdgcn_rcpf(ea1); }
                    } else {
                        const f32x4 v0 = acc[ai][bj][m][0], v1 = acc[ai][bj][m][1];
                        float sb[8];
#pragma unroll
                        for (int e = 0; e < 8; ++e) sb[e] = __builtin_amdgcn_rcpf(eb[e]);
                        u32x4 w; w.x = cvt_pk_bf16(v0[0] * sb[0], v0[1] * sb[1]); w.y = cvt_pk_bf16(v0[2] * sb[2], v0[3] * sb[3]); w.z = cvt_pk_bf16(v1[0] * sb[4], v1[1] * sb[5]); w.w = cvt_pk_bf16(v1[2] * sb[6], v1[3] * sb[7]);
                        *(u32x4*)(merged + (size_t)row * DM + col) = w; } } }
    }
};
struct EpiX1 {
    static constexpr bool PERM = false, CHAIN = false;
    const float* x; float* x1; bf16_t* x1b; float* ssx1;
    __device__ __forceinline__ void operator()(AccT& acc, const Unit& u, int wr, int wc, int fr, int fq) const {
        const int row0 = u.pm * BM + wr * 64 + fr, col0 = u.pn * BM + wc * 32 + 4 * fq;
#pragma unroll
        for (int ai = 0; ai < 2; ++ai)
#pragma unroll
            for (int m = 0; m < 4; ++m) { const int row = row0 + ai * HALF + m * 16; const size_t off = (size_t)row * DM + col0; float s = 0.f;
#pragma unroll
                for (int bj = 0; bj < 2; ++bj)
#pragma unroll
                    for (int n = 0; n < 2; ++n) { const size_t o = off + bj * HALF + n * 16; const f32x4 v = *(const f32x4*)(x + o) + acc[ai][bj][m][n];
                        *(f32x4*)(x1 + o) = v; u32x2 w; w.x = cvt_pk_bf16(v[0], v[1]); w.y = cvt_pk_bf16(v[2], v[3]); *(u32x2*)(x1b + o) = w;
                        s += (v[0] * v[0] + v[1] * v[1]) + (v[2] * v[2] + v[3] * v[3]); }
                s += __shfl_xor(s, 16); s += __shfl_xor(s, 32); if (fq == 0) atomicAdd(ssx1 + row, s); }
    }
};
struct EpiQP {
    static constexpr bool PERM = true, CHAIN = false;
    bf16_t* qp; const float* ssx1;
    __device__ __forceinline__ void operator()(AccT& acc, const Unit& u, int wr, int wc, int fr, int fq) const {
        const int row0 = u.pm * BM + wr * 64 + fr, col0 = u.pn * BM + wc * 32 + 8 * fq;
#pragma unroll
        for (int ai = 0; ai < 2; ++ai)
#pragma unroll
            for (int m = 0; m < 4; ++m) { const int row = row0 + ai * HALF + m * 16; const float rr = rsqrtf(ssx1[row] * (1.f / 1024.f) + EPS);
#pragma unroll
                for (int bj = 0; bj < 2; ++bj) { const f32x4 v0 = acc[ai][bj][m][0] * rr, v1 = acc[ai][bj][m][1] * rr;
                    u32x4 w; w.x = cvt_pk_bf16(v0[0], v0[1]); w.y = cvt_pk_bf16(v0[2], v0[3]); w.z = cvt_pk_bf16(v1[0], v1[1]); w.w = cvt_pk_bf16(v1[2], v1[3]);
                    *(u32x4*)(qp + (size_t)row * 2048 + col0 + bj * HALF) = w; } }
    }
};
}


namespace att {
typedef short bf16x8 __attribute__((ext_vector_type(8)));
typedef short s16x4 __attribute__((ext_vector_type(4)));
typedef float f32x16 __attribute__((ext_vector_type(16)));
constexpr int NW = 8, QBLK = 32, KVBLK = 64, QB = NW * QBLK;
constexpr int QS = 768, KS = 768, VS = 512, OS = 512;
constexpr int SHM_V = KVBLK * 64 * 2, SHM_K = KVBLK * 256;
constexpr int LDS_BYTES = 2 * SHM_V + 2 * SHM_K + NW * 64 * 4;
constexpr float THR = 8.f;
#define KSWZ(row, colB) ((row) * 256 + ((colB) ^ (((row) & 15) << 4)))
#define SBAR() __builtin_amdgcn_sched_barrier(0)
__device__ __forceinline__ int v_st(int k, int c) { const int kk = (k & ~0xC) | ((k & 4) << 1) | ((k & 8) >> 1); return ((kk >> 3) * 2 + (c >> 5)) * 512 + ((kk & 7) * 32 + (c & 31)) * 2; }
__device__ __forceinline__ int v_rd_base(int lane) { return ((lane & 3) << 3) | (((lane >> 2) & 3) << 6) | (((lane >> 4) & 1) << 5) | (((lane >> 5) & 1) << 8); }
constexpr int v_rd_off(int d0, int ks, int half) { return d0 * 512 + ks * 2048 + half * 1024; }
__device__ __forceinline__ int crow(int r, int hi) { return (r & 3) + 8 * (r >> 2) + 4 * hi; }
__device__ __forceinline__ unsigned cvtpk(float lo, float hi) { unsigned r; asm volatile("v_cvt_pk_bf16_f32 %0, %1, %2" : "=v"(r) : "v"(lo), "v"(hi)); return r; }
__device__ __forceinline__ bf16x8 load8(const bf16_t* p) { return *reinterpret_cast<const bf16x8*>(p); }
__device__ __forceinline__ void partialSM(f32x16& p0, f32x16& p1, float& m_reg, float& mn, float& alpha) {
    float pmax = p0[0]; for (int r = 1; r < 16; ++r) pmax = fmaxf(pmax, p0[r]); for (int r = 0; r < 16; ++r) pmax = fmaxf(pmax, p1[r]);
    { auto rr = __builtin_amdgcn_permlane32_swap(__float_as_uint(pmax), __float_as_uint(pmax), false, false);
      pmax = fmaxf(__uint_as_float(rr[0]), __uint_as_float(rr[1])); }
    if (__builtin_expect(__all((pmax - m_reg) <= THR), 1)) { mn = m_reg; alpha = 1.f; }
    else { mn = fmaxf(m_reg, pmax); alpha = __builtin_amdgcn_exp2f(m_reg - mn); m_reg = mn; }
    for (int r = 0; r < 16; ++r) p0[r] = p0[r] - mn; for (int r = 0; r < 16; ++r) p1[r] = p1[r] - mn;
    for (int r = 0; r < 16; ++r) p0[r] = __builtin_amdgcn_exp2f(p0[r]);
}
__device__ __forceinline__ void finishSM(f32x16& p0, f32x16& p1, float alpha, float& l_reg, bf16x8& pa0, bf16x8& pa1, bf16x8& pa2, bf16x8& pa3) {
    for (int r = 0; r < 16; ++r) p1[r] = __builtin_amdgcn_exp2f(p1[r]);
    float ps = 0; for (int r = 0; r < 16; ++r) ps += p0[r]; for (int r = 0; r < 16; ++r) ps += p1[r];
    { auto rr = __builtin_amdgcn_permlane32_swap(__float_as_uint(ps), __float_as_uint(ps), false, false);
      ps = __uint_as_float(rr[0]) + __uint_as_float(rr[1]); }
    l_reg = l_reg * alpha + ps;
#define PK4(P, B_, OUT) do { unsigned a0 = cvtpk(P[B_+0], P[B_+1]), a1 = cvtpk(P[B_+2], P[B_+3]);                          \
        unsigned b0 = cvtpk(P[B_+4], P[B_+5]), b1 = cvtpk(P[B_+6], P[B_+7]);                                             \
        auto r0 = __builtin_amdgcn_permlane32_swap(a0, b0, false, false); auto r1 = __builtin_amdgcn_permlane32_swap(a1, b1, false, false); \
        u32x4 w = {r0[0], r1[0], r0[1], r1[1]}; OUT = *reinterpret_cast<bf16x8*>(&w); } while (0)
    PK4(p0, 0, pa0); PK4(p0, 8, pa1); PK4(p1, 0, pa2); PK4(p1, 8, pa3);
#undef PK4
}
template <int KB>
__device__ __forceinline__ void qkt(f32x16& p0, f32x16& p1, const char* K_lds, int r32, int hi, const bf16x8* qr) {
    p0 = f32x16{}; p1 = f32x16{};
#pragma unroll
    for (int d0 = 0; d0 < 6; ++d0) { const char* a = K_lds + KB * SHM_K + KSWZ(r32, (d0 * 16 + hi * 8) * 2);
        bf16x8 b0 = *reinterpret_cast<const bf16x8*>(a);
        bf16x8 b1 = *reinterpret_cast<const bf16x8*>(a + 32 * 256);
        p0 = __builtin_amdgcn_mfma_f32_32x32x16_bf16(b0, qr[d0], p0, 0, 0, 0);
        p1 = __builtin_amdgcn_mfma_f32_32x32x16_bf16(b1, qr[d0], p1, 0, 0, 0); }
}
template <int VB>
__device__ __forceinline__ void pv_tile(f32x16* o, int vb0, bf16x8 pa0, bf16x8 pa1, bf16x8 pa2, bf16x8 pa3) {
#define TRRD(dst, off) asm volatile("ds_read_b64_tr_b16 %0, %1 offset:%2" : "=&v"(dst) : "v"(vb0), "i"(off) : "memory")
#define PV_D0(d0) do { s16x4 l0, l1, l2, l3, h0, h1, h2, h3; constexpr int b_ = VB * SHM_V + v_rd_off(d0, 0, 0);   \
        TRRD(l0, b_); TRRD(h0, b_ + 1024); TRRD(l1, b_ + 2048); TRRD(h1, b_ + 3072); TRRD(l2, b_ + 4096); TRRD(h2, b_ + 5120); TRRD(l3, b_ + 6144); TRRD(h3, b_ + 7168); \
        asm volatile("s_waitcnt lgkmcnt(0)" ::: "memory"); SBAR();   \
        o[d0] = __builtin_amdgcn_mfma_f32_32x32x16_bf16(pa0, (bf16x8){l0[0], l0[1], l0[2], l0[3], h0[0], h0[1], h0[2], h0[3]}, o[d0], 0, 0, 0);   \
        o[d0] = __builtin_amdgcn_mfma_f32_32x32x16_bf16(pa1, (bf16x8){l1[0], l1[1], l1[2], l1[3], h1[0], h1[1], h1[2], h1[3]}, o[d0], 0, 0, 0);   \
        o[d0] = __builtin_amdgcn_mfma_f32_32x32x16_bf16(pa2, (bf16x8){l2[0], l2[1], l2[2], l2[3], h2[0], h2[1], h2[2], h2[3]}, o[d0], 0, 0, 0);   \
        o[d0] = __builtin_amdgcn_mfma_f32_32x32x16_bf16(pa3, (bf16x8){l3[0], l3[1], l3[2], l3[3], h3[0], h3[1], h3[2], h3[3]}, o[d0], 0, 0, 0); } while (0)
    PV_D0(0); PV_D0(1);
#undef PV_D0
#undef TRRD
}
struct BlockRef { const bf16_t* Q; const bf16_t* K; const bf16_t* KPE; const bf16_t* V; bf16_t* O; int P0; };
struct Seam { bf16x8 qr[6]; bf16x8 st_v0, st_v1, st_k0, st_k1; };
#define ROWK(p, k0, rr) ((p) + (size_t)((k0) + (rr)) * kstr)
#define ROWV(p, k0, rr) ((p) + (size_t)((k0) + (rr)) * VS + sc)
#define VMW() asm volatile("s_waitcnt vmcnt(0)" ::: "memory")
#define VMWN(n) asm volatile("s_waitcnt vmcnt(%0)" :: "i"(n) : "memory")
#define SLOAD_H(Kp, Vp, k0) do { if (vact) { S.st_v0 = load8(ROWV(Vp, k0, sr)); S.st_v1 = load8(ROWV(Vp, k0, 32 + sr)); }              \
                                 if (kact) { S.st_k0 = load8(ROWK(Kp, k0, sr)); S.st_k1 = load8(ROWK(Kp, k0, 32 + sr)); } } while (0)
#define SWRITE_HK(bf) do { if (kact) { *(bf16x8*)(K_lds + (bf) * SHM_K + kws) = S.st_k0; *(bf16x8*)(K_lds + (bf) * SHM_K + kws + 32 * 256) = S.st_k1; } } while (0)
#define SWRITE_HV(bf) do { if (vact) { *(bf16x8*)(V_lds + (bf) * SHM_V + vst0) = S.st_v0; *(bf16x8*)(V_lds + (bf) * SHM_V + vst1) = S.st_v1; } } while (0)
#define SWRITE_H(bf) do { SWRITE_HV(bf); SWRITE_HK(bf); } while (0)
__device__ __forceinline__ void attn_prime(const BlockRef& cur, char* lds, Seam& S) {
    const int tid = threadIdx.x, wid = __builtin_amdgcn_readfirstlane(tid >> 6), lane = tid & 63, r32 = lane & 31, hi = lane >> 5;
    const int sr = tid >> 4, sc = (tid & 15) * 8, kws = KSWZ(sr, sc * 2); char* K_lds = lds + 2 * SHM_V;
    const bool kact = (tid & 15) < 12, vact = (tid & 15) < 8;
#pragma unroll
    for (int d0 = 0; d0 < 6; ++d0) S.qr[d0] = load8(cur.Q + (size_t)(wid * QBLK + r32) * QS + d0 * 16 + hi * 8);
    const bf16_t* kp0 = (tid & 15) < 8 ? cur.K + sc : cur.KPE + (sc - 64); const int kstr = (tid & 15) < 8 ? KS : 32;
    SLOAD_H(kp0, cur.V, 0); VMW(); SWRITE_HK(0);
    __syncthreads();
}
__device__ __forceinline__ void attn_block(const BlockRef& cur, const BlockRef& nxt, char* lds, Seam& S) {
    const int tid = threadIdx.x, wid = __builtin_amdgcn_readfirstlane(tid >> 6), lane = tid & 63, r32 = lane & 31, hi = lane >> 5;
    const int NT = (cur.P0 + QB - 1) / KVBLK + 1;
    const int qlo = cur.P0 + wid * QBLK;
    const int qvis = qlo | 63;
    char* V_lds = lds; char* K_lds = lds + 2 * SHM_V;
    float* ws = (float*)(lds + 2 * SHM_V + 2 * SHM_K) + wid * 64; float* li_l = ws, * al_l = ws + 32;
    float m_reg = -1e30f, l_reg = 0; f32x16 o[2] = {};
    const int sr = tid >> 4, sc = (tid & 15) * 8, vst0 = v_st(sr, sc & 63), vst1 = v_st(32 + sr, sc & 63), kws = KSWZ(sr, sc * 2);
    const bool kact = (tid & 15) < 12, vact = (tid & 15) < 8;
    const int vb0 = (int)(uintptr_t)V_lds + v_rd_base(lane);
    const int kstr = (tid & 15) < 8 ? KS : 32;
    const bf16_t* Kh = (tid & 15) < 8 ? cur.K + sc : cur.KPE + (sc - 64); const bf16_t* Vh = cur.V;
    const bf16_t* Knx = (tid & 15) < 8 ? nxt.K + sc : nxt.KPE + (sc - 64);
#define RESC(a) do { if (__any((a) < 1.f)) { if (hi == 0) al_l[r32] = (a); asm volatile("s_waitcnt lgkmcnt(0)" ::: "memory");              \
                     for (int d_ = 0; d_ < 2; ++d_) for (int r = 0; r < 16; ++r) o[d_][r] *= al_l[crow(r, hi)]; } } while (0)
#define KBASE(t) ((t) * KVBLK)
#define MASKT(P0_, P1_, t) do { if (__builtin_amdgcn_readfirstlane((int)(KBASE(t) > qvis))) { const float NEG_ = -__builtin_inff(); _Pragma("unroll") for (int r = 0; r < 16; ++r) { P0_[r] = NEG_; P1_[r] = NEG_; } asm volatile("" : "+v"(P0_), "+v"(P1_)); } } while (0)
    constexpr int NQL = 6;
#define SEAM_K0() do { VMWN(NQL); SWRITE_HK(0); SBAR(); } while (0)
    f32x16 pA0, pA1, pB0, pB1; float mnA, mnB, alA, alB; bf16x8 pa0, pa1, pa2, pa3;
    SWRITE_HV(0); SBAR();
    if (NT > 1) { SLOAD_H(Kh, Vh, KBASE(1)); }
    SBAR(); qkt<0>(pA0, pA1, K_lds, r32, hi, S.qr);
    MASKT(pA0, pA1, 0); partialSM(pA0, pA1, m_reg, mnA, alA);
    if (NT > 1) { VMW(); SWRITE_H(1); }
    __syncthreads();
#define HALF_STEP(PX0, PX1, mnX, alX, PY0, PY1, alY, t, KB, VB, SB) do {                                                      \
        SBAR(); qkt<KB>(PX0, PX1, K_lds, r32, hi, S.qr);                                             \
        finishSM(PY0, PY1, alY, l_reg, pa0, pa1, pa2, pa3); SBAR();                                                           \
        if ((t) + 1 < NT) { SLOAD_H(Kh, Vh, KBASE((t) + 1)); SBAR(); }                                               \
        pv_tile<VB>(o, vb0, pa0, pa1, pa2, pa3); MASKT(PX0, PX1, (t)); partialSM(PX0, PX1, m_reg, mnX, alX);                                        \
        __syncthreads();                                                                                                      \
        if ((t) + 1 < NT) { VMW(); SWRITE_H(SB); }                                                                          \
        RESC(alX); __syncthreads(); } while (0)
    for (int t = 1; t + 1 < NT; t += 2) {
        HALF_STEP(pB0, pB1, mnB, alB, pA0, pA1, alA, t, 1, 0, 0);
        HALF_STEP(pA0, pA1, mnA, alA, pB0, pB1, alB, t + 1, 0, 1, 1);
    }
    const bool even = (NT & 1) == 0;
    if (even) { SBAR(); qkt<1>(pB0, pB1, K_lds, r32, hi, S.qr); SBAR(); }
    SLOAD_H(Knx, nxt.V, 0); SBAR();
#pragma unroll
    for (int d0 = 0; d0 < 6; ++d0) S.qr[d0] = load8(nxt.Q + (size_t)(wid * QBLK + r32) * QS + d0 * 16 + hi * 8);
    SBAR();
    finishSM(pA0, pA1, alA, l_reg, pa0, pa1, pa2, pa3); SBAR();
    pv_tile<0>(o, vb0, pa0, pa1, pa2, pa3);
    if (even) { MASKT(pB0, pB1, NT - 1); partialSM(pB0, pB1, m_reg, mnB, alB); __syncthreads(); RESC(alB);
        finishSM(pB0, pB1, alB, l_reg, pa0, pa1, pa2, pa3); SBAR(); pv_tile<1>(o, vb0, pa0, pa1, pa2, pa3); }
    SBAR(); SEAM_K0();
    if (hi == 0) li_l[r32] = l_reg; asm volatile("s_waitcnt lgkmcnt(0)" ::: "memory");
    float rli[16];
#pragma unroll
    for (int r = 0; r < 16; ++r) rli[r] = __builtin_amdgcn_rcpf(li_l[crow(r, hi)]);
    bf16_t* Ow = cur.O + (size_t)(wid * QBLK) * OS;
#pragma unroll
    for (int r = 0; r < 16; ++r) { const int orow = crow(r, hi);
#pragma unroll
        for (int d0 = 0; d0 < 2; ++d0) { const float v = o[d0][r] * rli[r];
            const float vn = __shfl_xor(v, 1);
            if ((r32 & 1) == 0) *(unsigned*)(Ow + (size_t)orow * OS + d0 * 32 + r32) = cvtpk(v, vn); } }
    __syncthreads();
#undef RESC
#undef KBASE
#undef MASKT
#undef SEAM_K0
#undef HALF_STEP
}


__device__ __forceinline__ void partialSM_rel(f32x16& p0, f32x16& p1, float& m_ref, f32x16& negm, float& alpha) {
    float pmax = p0[0]; for (int r = 1; r < 16; ++r) pmax = fmaxf(pmax, p0[r]); for (int r = 0; r < 16; ++r) pmax = fmaxf(pmax, p1[r]);
    { auto rr = __builtin_amdgcn_permlane32_swap(__float_as_uint(pmax), __float_as_uint(pmax), false, false);
      pmax = fmaxf(__uint_as_float(rr[0]), __uint_as_float(rr[1])); }
    if (__builtin_expect(__all(pmax <= THR), 1)) { alpha = 1.f; }
    else { const float d = fmaxf(pmax, 0.f); alpha = __builtin_amdgcn_exp2f(-d); m_ref += d;
        for (int r = 0; r < 16; ++r) { p0[r] -= d; p1[r] -= d; }
        for (int r = 0; r < 16; ++r) negm[r] = -m_ref; asm volatile("" : "+v"(negm)); }
    for (int r = 0; r < 16; ++r) p0[r] = __builtin_amdgcn_exp2f(p0[r]);
}

__device__ __forceinline__ void finishSM_direct(f32x16& p0, f32x16& p1, float alpha, float& l_reg, bf16x8& pa0, bf16x8& pa1, bf16x8& pa2, bf16x8& pa3) {
    for (int r = 0; r < 16; ++r) p1[r] = __builtin_amdgcn_exp2f(p1[r]);
    float ps = 0; for (int r = 0; r < 16; ++r) ps += p0[r]; for (int r = 0; r < 16; ++r) ps += p1[r];
    { auto rr = __builtin_amdgcn_permlane32_swap(__float_as_uint(ps), __float_as_uint(ps), false, false);
      ps = __uint_as_float(rr[0]) + __uint_as_float(rr[1]); }
    l_reg = l_reg * alpha + ps;
#define PK8(P, B_, OUT) do { u32x4 w = {cvtpk(P[B_+0], P[B_+1]), cvtpk(P[B_+2], P[B_+3]), cvtpk(P[B_+4], P[B_+5]), cvtpk(P[B_+6], P[B_+7])}; OUT = *reinterpret_cast<bf16x8*>(&w); } while (0)
    PK8(p0, 0, pa0); PK8(p0, 8, pa1); PK8(p1, 0, pa2); PK8(p1, 8, pa3);
#undef PK8
}

#define TRRD2(dst, vb, off) asm volatile("ds_read_b64_tr_b16 %0, %1 offset:%2" : "=&v"(dst) : "v"(vb), "i"(off) : "memory")
struct VFrag { s16x4 l0, l1, l2, l3, h0, h1, h2, h3; };
__device__ __forceinline__ void pv_issue(VFrag& f, int vb, int d0off) {
    if (d0off == 0) { TRRD2(f.l0, vb, 0); TRRD2(f.h0, vb, 1024); TRRD2(f.l1, vb, 2048); TRRD2(f.h1, vb, 3072); TRRD2(f.l2, vb, 4096); TRRD2(f.h2, vb, 5120); TRRD2(f.l3, vb, 6144); TRRD2(f.h3, vb, 7168); }
    else { TRRD2(f.l0, vb, 512); TRRD2(f.h0, vb, 1536); TRRD2(f.l1, vb, 2560); TRRD2(f.h1, vb, 3584); TRRD2(f.l2, vb, 4608); TRRD2(f.h2, vb, 5632); TRRD2(f.l3, vb, 6656); TRRD2(f.h3, vb, 7680); }
}
#define VF8(f, k) (bf16x8){f.l##k[0], f.l##k[1], f.l##k[2], f.l##k[3], f.h##k[0], f.h##k[1], f.h##k[2], f.h##k[3]}
__device__ __forceinline__ void pv_mma(f32x16& o, const VFrag& f, bf16x8 pa0, bf16x8 pa1, bf16x8 pa2, bf16x8 pa3) {
    o = __builtin_amdgcn_mfma_f32_32x32x16_bf16(pa0, VF8(f, 0), o, 0, 0, 0); o = __builtin_amdgcn_mfma_f32_32x32x16_bf16(pa1, VF8(f, 1), o, 0, 0, 0);
    o = __builtin_amdgcn_mfma_f32_32x32x16_bf16(pa2, VF8(f, 2), o, 0, 0, 0); o = __builtin_amdgcn_mfma_f32_32x32x16_bf16(pa3, VF8(f, 3), o, 0, 0, 0);
}
constexpr int D_V = 0, D_K = 4 * SHM_V, D_WS = D_K + 3 * SHM_K, D_Q = D_WS + NW * 64 * 4, D_BYTES = D_Q + NW * 6144;
__device__ __forceinline__ void qkt_rt(f32x16& p0, f32x16& p1, const char* Kslot, int r32, int hi, const char* qfr  , const f32x16& negm) {
    p0 = negm; p1 = negm;
#pragma unroll
    for (int d0 = 0; d0 < 6; ++d0) { const char* a = Kslot + KSWZ(r32, (d0 * 16 + hi * 8) * 2);
        bf16x8 b0 = *reinterpret_cast<const bf16x8*>(a);
        bf16x8 b1 = *reinterpret_cast<const bf16x8*>(a + 32 * 256);
        const bf16x8 q = *reinterpret_cast<const bf16x8*>(qfr + d0 * 1024);
        p0 = __builtin_amdgcn_mfma_f32_32x32x16_bf16(b0, q, p0, 0, 0, 0);
        p1 = __builtin_amdgcn_mfma_f32_32x32x16_bf16(b1, q, p1, 0, 0, 0); }
}
__device__ __forceinline__ void attn_block_dma(const BlockRef& cur, char* lds) {
    typedef __attribute__((address_space(3))) unsigned lds_u32;
    const int tid = threadIdx.x, wid = __builtin_amdgcn_readfirstlane(tid >> 6), lane = tid & 63, r32 = lane & 31, hi = lane >> 5;
    const int NT = (cur.P0 + QB - 1) / KVBLK + 1;
    const int qlo = cur.P0 + wid * QBLK, qvis = qlo | 63;
    float* ws = (float*)(lds + D_WS) + wid * 64; float* li_l = ws, * al_l = ws + 32;
    float m_reg = 0.f, l_reg = 0; f32x16 o[2] = {}; f32x16 negm = {}; asm volatile("" : "+v"(negm));
    const int vb0 = (int)(uintptr_t)(lds + D_V) + v_rd_base(lane);
    const bf16_t* ksrc[2]; int kstep[2];
#pragma unroll
    for (int j = 0; j < 2; ++j) { const int row = 4 * (2 * wid + j) + (lane >> 4), chunk = (lane & 15) ^ (row & 15);
        if (chunk >= 8 && chunk < 12) { ksrc[j] = cur.KPE + (size_t)row * 32 + (chunk - 8) * 8; kstep[j] = KVBLK * 32; }
        else { ksrc[j] = cur.K + (size_t)row * KS + (chunk < 8 ? chunk * 8 : 0); kstep[j] = KVBLK * KS; } }
    const bf16_t* vsrc; { const int k = wid * 8 + ((lane & 31) >> 2); vsrc = cur.V + (size_t)k * VS + (lane >> 5) * 32 + (lane & 3) * 8; }
#define DMA_TILE(t) do { const int ks_ = (t) % 3, vs_ = (t) & 3; \
        __builtin_amdgcn_global_load_lds((const unsigned*)(ksrc[0] + (size_t)(t) * kstep[0]), (lds_u32*)(lds + D_K + ks_ * SHM_K + (2 * wid) * 1024), 16, 0, 0); \
        __builtin_amdgcn_global_load_lds((const unsigned*)(ksrc[1] + (size_t)(t) * kstep[1]), (lds_u32*)(lds + D_K + ks_ * SHM_K + (2 * wid + 1) * 1024), 16, 0, 0); \
        __builtin_amdgcn_global_load_lds((const unsigned*)(vsrc + (size_t)(t) * KVBLK * VS), (lds_u32*)(lds + D_V + vs_ * SHM_V + wid * 1024), 16, 0, 0); } while (0)
#define WAITV(n) asm volatile("s_waitcnt vmcnt(" #n ")" ::: "memory")
#define BAR() do { asm volatile("s_waitcnt lgkmcnt(0)" ::: "memory"); __builtin_amdgcn_s_barrier(); asm volatile("" ::: "memory"); SBAR(); } while (0)
#define RESC(a) do { if (__any((a) < 1.f)) { if (hi == 0) al_l[r32] = (a); asm volatile("s_waitcnt lgkmcnt(0)" ::: "memory");              \
                     for (int d_ = 0; d_ < 2; ++d_) for (int r = 0; r < 16; ++r) o[d_][r] *= al_l[crow(r, hi)]; } } while (0)
#define MASKT(P0_, P1_, t) do { if (__builtin_amdgcn_readfirstlane((int)((t) * KVBLK > qvis))) { const float NEG_ = -__builtin_inff(); _Pragma("unroll") for (int r = 0; r < 16; ++r) { P0_[r] = NEG_; P1_[r] = NEG_; } asm volatile("" : "+v"(P0_), "+v"(P1_)); } } while (0)
    char* qfr = lds + D_Q + wid * 6144 + lane * 16;
    { bf16x8 qr[6];
#pragma unroll
      for (int d0 = 0; d0 < 6; ++d0) qr[d0] = load8(cur.Q + (size_t)(wid * QBLK + r32) * QS + d0 * 16 + hi * 8);
#pragma unroll
      for (int d0 = 0; d0 < 6; ++d0) *reinterpret_cast<bf16x8*>(qfr + d0 * 1024) = qr[d0]; }
    asm volatile("s_waitcnt vmcnt(0) lgkmcnt(0)" ::: "memory");
    DMA_TILE(0); DMA_TILE(1);
    WAITV(3); BAR();
    f32x16 pA0, pA1, pB0, pB1; float mnA, mnB, alA, alB; bf16x8 pa0, pa1, pa2, pa3;
    DMA_TILE(2);
    qkt_rt(pA0, pA1, lds + D_K, r32, hi, qfr, negm);
    MASKT(pA0, pA1, 0); partialSM_rel(pA0, pA1, m_reg, negm, alA);
    WAITV(3); BAR();
#define STEP(PX0, PX1, mnX, alX, PY0, PY1, alY, t) do { \
        if ((t) + 2 < NT) DMA_TILE((t) + 2); \
        SBAR(); { VFrag f0_, f1_; const int vb_ = vb0 + (((t) - 1) & 3) * SHM_V; \
        qkt_rt(PX0, PX1, lds + D_K + ((t) % 3) * SHM_K, r32, hi, qfr, negm); SBAR(); pv_issue(f0_, vb_, 0); pv_issue(f1_, vb_, 512);     \
        finishSM_direct(PY0, PY1, alY, l_reg, pa0, pa1, pa2, pa3); SBAR(); \
        asm volatile("s_waitcnt lgkmcnt(0)" ::: "memory"); SBAR(); pv_mma(o[0], f0_, pa0, pa1, pa2, pa3); pv_mma(o[1], f1_, pa0, pa1, pa2, pa3); } \
        MASKT(PX0, PX1, (t)); partialSM_rel(PX0, PX1, m_reg, negm, alX); \
        if ((t) + 2 < NT) { WAITV(3); } else { WAITV(0); } BAR(); \
        RESC(alX); } while (0)
    for (int t = 1; t + 1 < NT; t += 2) {
        STEP(pB0, pB1, mnB, alB, pA0, pA1, alA, t);
        STEP(pA0, pA1, mnA, alA, pB0, pB1, alB, t + 1);
    }
    SBAR(); qkt_rt(pB0, pB1, lds + D_K + ((NT - 1) % 3) * SHM_K, r32, hi, qfr, negm);
    finishSM_direct(pA0, pA1, alA, l_reg, pa0, pa1, pa2, pa3); SBAR();
    pv_tile<0>(o, vb0 + ((NT - 2) & 3) * SHM_V, pa0, pa1, pa2, pa3);
    MASKT(pB0, pB1, NT - 1); partialSM_rel(pB0, pB1, m_reg, negm, alB); RESC(alB);
    finishSM_direct(pB0, pB1, alB, l_reg, pa0, pa1, pa2, pa3); SBAR(); pv_tile<0>(o, vb0 + ((NT - 1) & 3) * SHM_V, pa0, pa1, pa2, pa3);
    if (hi == 0) li_l[r32] = l_reg; asm volatile("s_waitcnt lgkmcnt(0)" ::: "memory");
    float rli[16];
#pragma unroll
    for (int r = 0; r < 16; ++r) rli[r] = __builtin_amdgcn_rcpf(li_l[crow(r, hi)]);
    bf16_t* Ow = cur.O + (size_t)(wid * QBLK) * OS;
#pragma unroll
    for (int r = 0; r < 16; ++r) { const int orow = crow(r, hi);
#pragma unroll
        for (int d0 = 0; d0 < 2; ++d0) { const float v = o[d0][r] * rli[r];
            const float vn = __shfl_xor(v, 1);
            if ((r32 & 1) == 0) *(unsigned*)(Ow + (size_t)orow * OS + d0 * 32 + r32) = cvtpk(v, vn); } }
    asm volatile("s_waitcnt vmcnt(0)" ::: "memory");
    __syncthreads();
#undef DMA_TILE
#undef WAITV
#undef BAR
#undef RESC
#undef MASKT
#undef STEP
}
#undef ROWK
#undef ROWV
#undef VMW
#undef VMWN
#undef SLOAD_H
#undef SWRITE_HK
#undef SWRITE_HV
#undef SWRITE_H
#undef KSWZ
#undef SBAR
}

namespace gla {
typedef short bf16x8 __attribute__((ext_vector_type(8)));
typedef short s16x4 __attribute__((ext_vector_type(4)));
typedef float f32x16 __attribute__((ext_vector_type(16)));
template <int NCB> __device__ __forceinline__ int t_st(int k, int c) { const int kk = (k & ~0xC) | ((k & 4) << 1) | ((k & 8) >> 1); return ((kk >> 3) * NCB + (c >> 5)) * 512 + ((kk & 7) * 32 + (c & 31)) * 2; }
__device__ __forceinline__ int t_rd_base(int lane) { return ((lane & 3) << 3) | (((lane >> 2) & 3) << 6) | (((lane >> 4) & 1) << 5) | (((lane >> 5) & 1) << 8); }
template <int NCB> constexpr int t_rd_off(int d0, int ks, int half) { return d0 * 512 + ks * (NCB * 1024) + half * (NCB * 512); }
#define GLA_TRRD(dst, addr, off) asm volatile("ds_read_b64_tr_b16 %0, %1 offset:%2" : "=&v"(dst) : "v"(addr), "i"(off) : "memory")
__device__ __forceinline__ int crow(int r, int hi) { return (r & 3) + 8 * (r >> 2) + 4 * hi; }
}

#define XB_TMO      128
#define XB_XCNT(j)  (256  + 64 * (j))
#define XB_XSUB(j)  (1280 + 64 * (j))
#define XB_XGEN(j)  (2304 + 64 * (j))
#define XB_TOP      3328
#define XB_TOPGEN   3392
#define XCD_BAR_WORDS 3456
#define XB_SPIN_CAP (1u << 18)
__device__ __forceinline__ unsigned xb_ld(unsigned* p)              { return __hip_atomic_load(p, __ATOMIC_RELAXED, __HIP_MEMORY_SCOPE_AGENT); }
__device__ __forceinline__ unsigned xb_add(unsigned* p, unsigned v) { return __hip_atomic_fetch_add(p, v, __ATOMIC_RELAXED, __HIP_MEMORY_SCOPE_AGENT); }
__device__ __forceinline__ unsigned xb_xcc_id() { return (unsigned)__builtin_amdgcn_s_getreg((3 << 11) | 20) & 0xFu; }
#define XB_SPIN(cond, bar) do { unsigned _sp = 0; while (cond) { __builtin_amdgcn_s_sleep(1); \
    if ((++_sp & 255u) == 0u) { if (xb_ld(&(bar)[XB_TMO])) break; if (_sp > XB_SPIN_CAP) { atomicAdd(&(bar)[XB_TMO], 1u); break; } } } } while (0)
struct XcdBarrier { unsigned* bar; unsigned x; volatile LAS unsigned* st; };
__device__ __forceinline__ XcdBarrier xcd_barrier_post(unsigned* bar, volatile LAS unsigned* st) {
    XcdBarrier b; b.bar = bar; b.x = xb_xcc_id(); b.st = st;
    if (threadIdx.x == 0) st[2] = xb_add(&bar[XB_XCNT(b.x)], 1u);
    return b;
}
__device__ __forceinline__ void xcd_barrier_complete(unsigned* bar, unsigned x, unsigned& nloc, unsigned& nx) {
    const unsigned G = gridDim.x * gridDim.y * gridDim.z;
    unsigned sum, cnt, mine, sp = 0u;
    for (;;) {
        sum = 0u; cnt = 0u; mine = 0u;
#pragma unroll
        for (unsigned j = 0; j < 16; ++j) { const unsigned c = xb_ld(&bar[XB_XCNT(j)]); sum += c; cnt += (c > 0u) ? 1u : 0u; mine = (j == x) ? c : mine; }
        if (sum == G) break;
        __builtin_amdgcn_s_sleep(1);
        if ((++sp & 255u) == 0u) { if (xb_ld(&bar[XB_TMO])) break; if (sp > XB_SPIN_CAP) { atomicAdd(&bar[XB_TMO], 1u); break; } }
    }
    nloc = mine > 0u ? mine : 1u; nx = cnt > 0u ? cnt : 1u;
}
__device__ __forceinline__ void xcd_barrier(const XcdBarrier& b) {
    asm volatile("s_waitcnt vmcnt(0)" ::: "memory");
    __syncthreads();
    if (threadIdx.x == 0) {
        unsigned* bar = b.bar;
        __builtin_amdgcn_s_waitcnt(0);
        unsigned nloc = b.st[0], nx = b.st[1];
        if (nloc == 0u) { xcd_barrier_complete(bar, b.x, nloc, nx); b.st[0] = nloc; b.st[1] = nx; }
        const unsigned old = xb_add(&bar[XB_XSUB(b.x)], 1u);
        const unsigned gen = old / nloc;
        if (old + 1u == (gen + 1u) * nloc) {
            __builtin_amdgcn_fence(__ATOMIC_RELEASE, "agent");
            asm volatile("s_waitcnt vmcnt(0)" ::: "memory");
            const unsigned og = xb_add(&bar[XB_TOP], 1u);
            const unsigned tg = og / nx;
            if (og + 1u == (tg + 1u) * nx) xb_add(&bar[XB_TOPGEN], 1u);
            else XB_SPIN(xb_ld(&bar[XB_TOPGEN]) == tg, bar);
            __builtin_amdgcn_fence(__ATOMIC_ACQUIRE, "agent");
            xb_add(&bar[XB_XGEN(b.x)], 1u);
            asm volatile("s_waitcnt vmcnt(0)" ::: "memory");
        } else {
            XB_SPIN(xb_ld(&bar[XB_XGEN(b.x)]) == gen, bar);
            __builtin_amdgcn_fence(__ATOMIC_ACQUIRE, "agent");
            asm volatile("s_waitcnt vmcnt(0)" ::: "memory");
        }
    }
    __syncthreads();
}

constexpr int NWAVES = 8;
constexpr int RING_BYTES = 131072, LDS_BYTES = 147456, LDSCTL_OFF = LDS_BYTES - 1024, MISC_OFF = LDSCTL_OFF + 320;
constexpr int CW_BAR = 4096;
constexpr int CW_QCTR = 16384;

struct Args { const void* in[20]; float* out; unsigned char* ws; int ph_lo, ph_hi; };

__device__ __forceinline__ int win_srccol(int n) {
    if (n < 2048) return 2224 + n;
    if (n < 2560) return 1712 + (n - 2048);
    if (n < 2816) return 672 + (n - 2560);
    if (n < 3328) return 1184 + (n - 2816);
    if (n < 3584) return 928 + (n - 3328);
    if (n < 3968) return 0 + (n - 3584);
    if (n < 4224) return 384 + (n - 3968);
    if (n < 4256) return 640 + (n - 4224);
    if (n < 4272) return 1696 + (n - 4256);
    return -1;
}
__device__ __forceinline__ void transpose_item(const float* __restrict__ W, int K, int Nsrc, bf16_t* __restrict__ WT, int Nout, const float* __restrict__ kscale, bool winperm, float* scr, int item, int lane) {
    const int nblk = Nout / 32, kb = item / nblk, nb = item % nblk, k0 = 64 * kb, n0 = 32 * nb;
    const int n = n0 + (lane & 31); const int sc = winperm ? win_srccol(n) : n;
    float tv[32];
#pragma unroll
    for (int i = 0; i < 32; ++i) { const int kk = 2 * i + (lane >> 5); tv[i] = (sc >= 0) ? W[(size_t)(k0 + kk) * Nsrc + sc] : 0.f; }
#pragma unroll
    for (int i = 0; i < 32; ++i) { const int kk = 2 * i + (lane >> 5); float v = tv[i]; if (kscale) v *= kscale[k0 + kk]; scr[kk * 33 + (lane & 31)] = v; }
    asm volatile("s_waitcnt lgkmcnt(0)" ::: "memory");
    const int c = lane & 7;
#pragma unroll
    for (int j = 0; j < 4; ++j) { const int nn = (lane >> 3) + 8 * j; const float* s = scr + (8 * c) * 33 + nn;
        u32x4 o; o.x = pk2(s[0 * 33], s[1 * 33]); o.y = pk2(s[2 * 33], s[3 * 33]); o.z = pk2(s[4 * 33], s[5 * 33]); o.w = pk2(s[6 * 33], s[7 * 33]);
        *(u32x4*)(WT + (size_t)(n0 + nn) * K + k0 + 8 * c) = o; }
    asm volatile("s_waitcnt lgkmcnt(0)" ::: "memory");
}

#define TOPK_INSERT(tv, ti, vv, ii) do { float v_ = (vv); int i_ = (ii); \
    _Pragma("unroll") for (int q_ = 0; q_ < 16; ++q_) { const bool gt_ = (v_ > tv[q_]) || (v_ == tv[q_] && i_ < ti[q_]); const float tv_ = tv[q_]; const int ti_ = ti[q_]; \
        tv[q_] = gt_ ? v_ : tv_; ti[q_] = gt_ ? i_ : ti_; v_ = gt_ ? tv_ : v_; i_ = gt_ ? ti_ : i_; } } while (0)

template <int OFFS> __device__ __forceinline__ void quant_rows2(const float* __restrict__ tab, const float* __restrict__ g, unsigned char* __restrict__ qt, float* __restrict__ sc, int row0, int lane) {
    f32x4 v[2][4];
#pragma unroll
    for (int rr = 0; rr < 2; ++rr)
#pragma unroll
        for (int j = 0; j < 4; ++j) v[rr][j] = *(const f32x4*)(tab + (size_t)(row0 + rr) * 1024 + 16 * lane + 4 * j);
#pragma unroll
    for (int rr = 0; rr < 2; ++rr) {
        float mx = 0.f;
#pragma unroll
        for (int j = 0; j < 4; ++j) { if (g) v[rr][j] = v[rr][j] * *(const f32x4*)(g + 16 * lane + 4 * j);
            mx = fmaxf(mx, fmaxf(fmaxf(fabsf(v[rr][j][0]), fabsf(v[rr][j][1])), fmaxf(fabsf(v[rr][j][2]), fabsf(v[rr][j][3])))); }
#pragma unroll
        for (int o = 1; o < 64; o <<= 1) mx = fmaxf(mx, __shfl_xor(mx, o));
        mx = fmaxf(mx, 1e-30f);
        const float inv = 127.f / mx;
        u32x4 w;
#pragma unroll
        for (int j = 0; j < 4; ++j) { unsigned b = 0;
#pragma unroll
            for (int e = 0; e < 4; ++e) { const int q = (int)rintf(v[rr][j][e] * inv) + OFFS; b |= ((unsigned)q & 0xffu) << (8 * e); }
            w[j] = b; }
        *(u32x4*)(qt + (size_t)(lane >> 3) * (16384 * 128) + (size_t)(row0 + rr) * 128 + 16 * (lane & 7)) = w;
        if (lane == 0) sc[row0 + rr] = mx * (1.f / 127.f);
    }
}
typedef __bf16 bf2_t __attribute__((ext_vector_type(2)));
__device__ __forceinline__ float dot2_bf16(unsigned a, unsigned b, float acc) { return __builtin_amdgcn_fdot2_f32_bf16(__builtin_bit_cast(bf2_t, a), __builtin_bit_cast(bf2_t, b), acc, false); }
__global__ void __launch_bounds__(NWAVES * 64, 2) fwd(Args args) {
    extern __shared__ __attribute__((aligned(16))) unsigned char lds[];
    const int tid = threadIdx.x, lane = tid & 63, wave = __builtin_amdgcn_readfirstlane(tid >> 6);
    const int G = gridDim.x; int vcu; { const int bx = blockIdx.x; vcu = (G % 8 == 0) ? (bx % 8) * (G / 8) + bx / 8 : bx; }
    const int gw = vcu * NWAVES + wave, NGW = G * NWAVES, gtid = vcu * 512 + tid, NT = G * 512;
    unsigned char* ws = args.ws;
    const float* x = (const float*)args.in[0]; const int* positions = (const int*)args.in[1];
    const float* g_mix = (const float*)args.in[2]; const float* w_in = (const float*)args.in[3]; const float* g_q_lat = (const float*)args.in[4]; const float* w_qb = (const float*)args.in[5];
    const float* g_kv_lat = (const float*)args.in[6]; const float* w_kvb = (const float*)args.in[7]; const float* w_a2 = (const float*)args.in[8]; const float* b_a2 = (const float*)args.in[9];
    const float* g_gla = (const float*)args.in[10]; const float* w_branch_a = (const float*)args.in[11]; const float* w_branch_b = (const float*)args.in[12]; const float* w_out = (const float*)args.in[13];
    const float* g_ffn = (const float*)args.in[14]; const float* w_peer_q = (const float*)args.in[15]; const float* sub_keys = (const float*)args.in[16]; const float* peer_u = (const float*)args.in[17];
    const float* peer_v = (const float*)args.in[18]; const float* g_final = (const float*)args.in[19];
    float* out = args.out;
    float* SSQ = (float*)(ws + WS_SSQ); float* SSKV = (float*)(ws + WS_SSKV); float* SSX1 = (float*)(ws + WS_SSX1); float* COS = (float*)(ws + WS_COS); float* SIN = (float*)(ws + WS_SIN);
    float* DECAY = (float*)(ws + WS_DECAY);
    bf16_t* WIN = (bf16_t*)(ws + WS_WIN); bf16_t* WQB = (bf16_t*)(ws + WS_WQB); bf16_t* WKVB = (bf16_t*)(ws + WS_WKVB); bf16_t* WA = (bf16_t*)(ws + WS_WA); bf16_t* WB = (bf16_t*)(ws + WS_WB);
    bf16_t* WOUT = (bf16_t*)(ws + WS_WOUT); bf16_t* WPQ = (bf16_t*)(ws + WS_WPQ); bf16_t* KEYS = (bf16_t*)(ws + WS_KEYS);
    bf16_t* PROJB = (bf16_t*)(ws + WS_PROJB); bf16_t* PROJA = (bf16_t*)(ws + WS_PROJA); bf16_t* XN = (bf16_t*)(ws + WS_XN);
    bf16_t* Q = (bf16_t*)(ws + WS_Q); bf16_t* K = (bf16_t*)(ws + WS_K); bf16_t* KPE = (bf16_t*)(ws + WS_KPE); float* DST = out; bf16_t* V = (bf16_t*)((unsigned char*)out + 32 * MiB); bf16_t* STB = (bf16_t*)((unsigned char*)out + 48 * MiB);
    bf16_t* YA = (bf16_t*)(ws + WS_YA); bf16_t* YB = (bf16_t*)(ws + WS_YB); bf16_t* MERGED = (bf16_t*)(ws + WS_MERGED); bf16_t* X1B = (bf16_t*)(ws + WS_X1B); bf16_t* QP = (bf16_t*)(ws + WS_QP);
    int* EIDX = (int*)(ws + WS_EIDX); float* EGATE = (float*)(ws + WS_EGATE); unsigned char* UT = ws + WS_UT; unsigned char* VT = ws + WS_VT; float* SU = (float*)(ws + WS_SU); float* SV = (float*)(ws + WS_SV); float* SS2 = (float*)(ws + WS_SS2); float* ZP = (float*)(ws + WS_ZP); float* CS = (float*)(ws + WS_C128); signed char* CQ = (signed char*)(ws + WS_CB);

    for (int u = tid; u < (LDS_BYTES - LDSCTL_OFF) / 4; u += NWAVES * 64) ((unsigned*)(lds + LDSCTL_OFF))[u] = 0u;
    __syncthreads();
    XcdBarrier bar; bar.bar = (unsigned*)(ws + WS_CTL) + CW_BAR; bar.x = 0; bar.st = nullptr;
    if (MK_N_LAUNCHES == 1) bar = xcd_barrier_post((unsigned*)(ws + WS_CTL) + CW_BAR, (volatile LAS unsigned*)(lds + MISC_OFF) + 8);
    const int ph_lo_ = args.ph_lo, ph_hi_ = args.ph_hi;
#define IN(k) (ph_lo_ <= (k) && (k) < ph_hi_)
#define SEAM(k) do { if (MK_N_LAUNCHES == 1) { if (IN(k) && IN((k) + 1)) xcd_barrier(bar); } } while (0)
    PG8_LAS unsigned char* ring = (PG8_LAS unsigned char*)lds;

    if (IN(0)) {
        for (int i = gtid; i < 4 * M_; i += NT) SSQ[i] = 0.f;
        float* scr = (float*)(lds + wave * 16384);
        constexpr int I_WIN = 16 * (NPROJ / 32), I_QB = 6 * 24, I_KVB = 4 * 32, I_A = 8 * 32, I_OUT = 16 * 32, I_PQ = 16 * 64;
        constexpr int NITEMS = I_WIN + I_QB + I_KVB + 2 * I_A + I_OUT + I_PQ;
        for (int it = gw; it < NITEMS; it += NGW) {
            int r = it;
            if (r < I_WIN) { transpose_item(w_in, 1024, 4272, WIN, NPROJ, nullptr, true, scr, r, lane); continue; } r -= I_WIN;
            if (r < I_QB) { transpose_item(w_qb, 384, 768, WQB, 768, g_q_lat, false, scr, r, lane); continue; } r -= I_QB;
            if (r < I_KVB) { transpose_item(w_kvb, 256, 1024, WKVB, 1024, g_kv_lat, false, scr, r, lane); continue; } r -= I_KVB;
            if (r < I_A) { transpose_item(w_branch_a, 512, 1024, WA, 1024, nullptr, false, scr, r, lane); continue; } r -= I_A;
            if (r < I_A) { transpose_item(w_branch_b, 512, 1024, WB, 1024, nullptr, false, scr, r, lane); continue; } r -= I_A;
            if (r < I_OUT) { transpose_item(w_out, 1024, 1024, WOUT, 1024, nullptr, false, scr, r, lane); continue; } r -= I_OUT;
            transpose_item(w_peer_q, 1024, 2048, WPQ, 2048, g_ffn, false, scr, r, lane);
        }
        for (int i = gtid; i < 16 * 128 * 128; i += NT) KEYS[i] = f2bf(sub_keys[i]);
        for (int i = gtid; i < M_ * 16; i += NT) { const int m = i >> 4, f = i & 15;
            const double inv = pow(10000.0, -(double)f / 16.0); const double ang = (double)positions[m] * inv;
            COS[i] = (float)cos(ang); SIN[i] = (float)sin(ang); }
        for (int row = gw * 2; row < M_; row += NGW * 2) {
            f32x4 v[2][4];
#pragma unroll
            for (int rr = 0; rr < 2; ++rr)
#pragma unroll
                for (int j = 0; j < 4; ++j) v[rr][j] = ((const f32x4*)(x + (size_t)(row + rr) * DM))[lane + 64 * j];
#pragma unroll
            for (int rr = 0; rr < 2; ++rr) { float ss = 0.f;
#pragma unroll
                for (int j = 0; j < 4; ++j) ss += (v[rr][j][0] * v[rr][j][0] + v[rr][j][1] * v[rr][j][1]) + (v[rr][j][2] * v[rr][j][2] + v[rr][j][3] * v[rr][j][3]);
                ss = wave_sum(ss); const float r = rsqrtf(ss * (1.f / DM) + EPS);
#pragma unroll
                for (int j = 0; j < 4; ++j) { const int c = 4 * (lane + 64 * j); const f32x4 gg = *(const f32x4*)(g_mix + c);
                    u32x2 w; w.x = pk2(v[rr][j][0] * r * gg[0], v[rr][j][1] * r * gg[1]); w.y = pk2(v[rr][j][2] * r * gg[2], v[rr][j][3] * r * gg[3]);
                    *(u32x2*)(XN + (size_t)(row + rr) * DM + c) = w; } }
        }
    }
    SEAM(0);
    if (MK_N_LAUNCHES == 1 && IN(0) && IN(1)) { if (tid == 0) { unsigned ord = 0; for (unsigned j = 0; j < 16; ++j) if (j < bar.x && xb_ld(&bar.bar[XB_XCNT(j)]) > 0u) ++ord; bar.st[3] = ord; } __syncthreads(); }
    if (IN(1)) {
        pg8::Gemm g{XN, WIN, nullptr, nullptr, DM, DM, M_, NPROJ, DM, 1}; pg8::StaticOrder S; S.init(g, G, (int)blockIdx.x);
        pg8::EpiProj E{PROJB, PROJA, SSQ, SSKV};
        pg8::gemm_phase<pg8::EpiProj, pg8::StaticOrder, true>(ring, g, S, E);
        { const int nwg_ = (M_ / 256) * (NPROJ / 256), rem_ = nwg_ % G, c_ = (int)blockIdx.x; const int nq_ = rem_ ? G - rem_ : G, qi_ = rem_ ? c_ - rem_ : c_;
          if (qi_ >= 0) for (int row = 2 * (qi_ * NWAVES + wave); row < 32768; row += 2 * nq_ * NWAVES) {
              if (row < 16384) quant_rows2<0>(peer_u, g_ffn, UT, SU, row, lane); else quant_rows2<0>(peer_v, nullptr, VT, SV, row - 16384, lane); } }
    }
    SEAM(1);
    if (IN(2)) {
        { pg8::Gemm g{PROJA + PA_QLAT, WQB, nullptr, nullptr, PA_LD, 384, M_, 768, 384, 1}; pg8::StaticOrder S; S.init(g, G, (int)blockIdx.x);
          pg8::EpiQ E{Q, SSQ, COS, SIN}; pg8::gemm_phase<pg8::EpiQ, pg8::StaticOrder, true>(ring, g, S, E); }
        { pg8::Gemm g{PROJA + PA_KVLAT, WKVB, nullptr, nullptr, PA_LD, 256, M_, 1024, 256, 1}; pg8::StaticOrder S; S.init(g, G, (int)blockIdx.x);
          pg8::EpiKV E{K, V, SSKV}; pg8::gemm_phase<pg8::EpiKV, pg8::StaticOrder, true>(ring, g, S, E); }
        for (int i = gtid; i < M_ * 32; i += NT) { const int m = i >> 5, j = i & 31; const bf16_t* kr = PROJA + (size_t)m * PA_LD + PA_KROPE; float o;
            if (j < 16) { const float x1 = bf2f(kr[j]), x2 = bf2f(kr[j + 16]); o = x1 * COS[m * 16 + j] - x2 * SIN[m * 16 + j]; }
            else { const int f = j - 16; const float x2 = bf2f(kr[j]), x1 = bf2f(kr[j - 16]); o = x2 * COS[m * 16 + f] + x1 * SIN[m * 16 + f]; }
            KPE[i] = f2bf(o); }
        __syncthreads();
        {
            const int r32 = lane & 31, hi5 = lane >> 5;
            unsigned char* gvt = lds; unsigned char* kdt = lds + 16384;
            const int tbase = (int)(uintptr_t)lds + gla::t_rd_base(lane);
            for (int unit = vcu; unit < 2 * NCH * 4; unit += G) {
                const int h = unit & 3, bc = unit >> 2, t0 = bc * 64;
                {
                    const int sr = tid >> 4, ch = tid & 15;
#pragma unroll
                    for (int rr = 0; rr < 2; ++rr) { const int row = sr + 32 * rr; const u32x4 v = *(const u32x4*)(PROJA + (size_t)(t0 + row) * PA_LD + PA_GV + h * 128 + ch * 8);
                        *(u32x4*)(gvt + gla::t_st<4>(row, ch * 8)) = v; }
                }
                {
                    const int k0 = wave * 8; const bf16_t* prow = PROJA + (size_t)(t0 + lane) * PA_LD;
                    const u32x4 ga = *(const u32x4*)(prow + PA_GLR), gb = *(const u32x4*)(prow + PA_GLR + 8), gkv = *(const u32x4*)(prow + PA_GK + h * 64 + k0);
                    float glr[16];
#pragma unroll
                    for (int q = 0; q < 4; ++q) { glr[2 * q] = __uint_as_float(ga[q] << 16); glr[2 * q + 1] = __uint_as_float(ga[q] & 0xffff0000u); glr[8 + 2 * q] = __uint_as_float(gb[q] << 16); glr[8 + 2 * q + 1] = __uint_as_float(gb[q] & 0xffff0000u); }
                    float kdv[8];
#pragma unroll
                    for (int j = 0; j < 8; ++j) { const int kc = h * 64 + k0 + j; float z = b_a2[kc];
#pragma unroll
                        for (int r = 0; r < 16; ++r) z += glr[r] * w_a2[r * 256 + kc];
                        float v = (fminf(z, 0.f) - log1pf(expf(-fabsf(z)))) * (1.f / 16.f);
#pragma unroll
                        for (int d = 1; d < 64; d <<= 1) { const float t = __shfl_up(v, d); v += (lane >= d) ? t : 0.f; }
                        const float cl = __builtin_bit_cast(float, __builtin_amdgcn_readlane(__builtin_bit_cast(int, v), 63));
                        const unsigned gw_ = gkv[j >> 1]; const float gk = (j & 1) ? __uint_as_float(gw_ & 0xffff0000u) : __uint_as_float(gw_ << 16);
                        kdv[j] = gk * expf(cl - v);
                        if (lane == 0) DECAY[((size_t)bc * 4 + h) * 64 + k0 + j] = expf(cl); }
                    u32x4 w; w.x = pk2(kdv[0], kdv[1]); w.y = pk2(kdv[2], kdv[3]); w.z = pk2(kdv[4], kdv[5]); w.w = pk2(kdv[6], kdv[7]);
                    *(u32x4*)(kdt + gla::t_st<2>(lane, k0)) = w;
                }
                __syncthreads();
                {
                    const int kt = wave >> 2, vt = wave & 3; gla::f32x16 acc = {};
                    gla::s16x4 al[4], ah[4], bl[4], bh[4];
                    const int abase = tbase + kt * 512, bbase = tbase + vt * 512;
#define GLA_KS(ks) do { GLA_TRRD(al[ks], abase, 16384 + gla::t_rd_off<2>(0, ks, 0)); GLA_TRRD(ah[ks], abase, 16384 + gla::t_rd_off<2>(0, ks, 1)); GLA_TRRD(bl[ks], bbase, gla::t_rd_off<4>(0, ks, 0)); GLA_TRRD(bh[ks], bbase, gla::t_rd_off<4>(0, ks, 1)); } while (0)
                    GLA_KS(0); GLA_KS(1); GLA_KS(2); GLA_KS(3);
#undef GLA_KS
                    asm volatile("s_waitcnt lgkmcnt(0)" ::: "memory"); __builtin_amdgcn_sched_barrier(0);
#pragma unroll
                    for (int ks = 0; ks < 4; ++ks) acc = __builtin_amdgcn_mfma_f32_32x32x16_bf16((gla::bf16x8){al[ks][0], al[ks][1], al[ks][2], al[ks][3], ah[ks][0], ah[ks][1], ah[ks][2], ah[ks][3]},
                                                                                                 (gla::bf16x8){bl[ks][0], bl[ks][1], bl[ks][2], bl[ks][3], bh[ks][0], bh[ks][1], bh[ks][2], bh[ks][3]}, acc, 0, 0, 0);
                    float* dp = DST + (((size_t)bc * 4 + h) * 64 + kt * 32) * 128 + vt * 32 + r32;
#pragma unroll
                    for (int r = 0; r < 16; ++r) dp[(size_t)gla::crow(r, hi5) * 128] = acc[r];
                }
                __syncthreads();
            }
        }
    }
    SEAM(2);
    if (IN(3)) {
        if (tid < 256) for (int i = vcu * 256 + tid; i < 65536; i += G * 256) {
            const int v = i & 127, k = (i >> 7) & 63, h = (i >> 13) & 3, b = i >> 15; float s = 0.f;
            const float* dp = DST + (((size_t)b * NCH * 4 + h) * 64 + k) * 128 + v; const float* gp = DECAY + ((size_t)b * NCH * 4 + h) * 64 + k;
            bf16_t* sbp = STB + (((size_t)b * NCH * 4 + h) * 64 + k) * 128 + v;
            float d[8], g[8], dn[8], gn[8];
#pragma unroll
            for (int j = 0; j < 8; ++j) { d[j] = dp[(size_t)j * 32768]; g[j] = gp[(size_t)j * 256]; }
            for (int c0 = 0; c0 < NCH; c0 += 8) {
                const int cn = (c0 + 8 < NCH) ? c0 + 8 : c0;
#pragma unroll
                for (int j = 0; j < 8; ++j) { dn[j] = dp[(size_t)(cn + j) * 32768]; gn[j] = gp[(size_t)(cn + j) * 256]; }
#pragma unroll
                for (int j = 0; j < 8; ++j) { s = g[j] * s + d[j]; d[j] = s; }
#pragma unroll
                for (int j = 0; j < 8; ++j) sbp[(size_t)(c0 + j) * 32768] = f2bf(d[j]);
#pragma unroll
                for (int j = 0; j < 8; ++j) { d[j] = dn[j]; g[j] = gn[j]; } } }
        __syncthreads();
        {
            for (int pr = vcu; pr < 256; pr += G) {
                const int bh = pr >> 4, s16 = pr & 15, b = bh >> 3, h = bh & 7;
                att::BlockRef r0, r1;
                const bf16_t* Kh = K + (size_t)b * SEQ * att::KS + h * 96; const bf16_t* Vh = V + (size_t)b * SEQ * att::VS + h * 64;
                const int qb0 = 31 - s16, qb1 = s16;
                r0.Q = Q + ((size_t)b * SEQ + qb0 * 256) * att::QS + h * 96; r0.O = YA + ((size_t)b * SEQ + qb0 * 256) * att::OS + h * 64; r0.K = Kh; r0.KPE = KPE + (size_t)b * SEQ * 32; r0.V = Vh; r0.P0 = qb0 * 256;
                r1.Q = Q + ((size_t)b * SEQ + qb1 * 256) * att::QS + h * 96; r1.O = YA + ((size_t)b * SEQ + qb1 * 256) * att::OS + h * 64; r1.K = Kh; r1.KPE = KPE + (size_t)b * SEQ * 32; r1.V = Vh; r1.P0 = qb1 * 256;
                att::attn_block_dma(r0, (char*)lds);
                att::attn_block_dma(r1, (char*)lds);
            }
        }
    }
    SEAM(3);
    if (IN(4)) {
        const int r32 = lane & 31, hi5 = lane >> 5;
        unsigned char* stt = lds; float* part = (float*)(lds + 16384);
        const int lt = wave >> 2, vt = wave & 3;
        const int bbase = (int)(uintptr_t)lds + gla::t_rd_base(lane) + vt * 512;
        for (int unit = vcu; unit < 2 * NCH * 4; unit += G) {
            const int h = unit & 3, bc = unit >> 2, t0 = bc * 64;
            {   const int sr = tid >> 4, ch = tid & 15; const bf16_t* sp = STB + ((size_t)bc * 4 + h) * 64 * 128;
#pragma unroll
                for (int rr = 0; rr < 2; ++rr) { const int row = sr + 32 * rr; *(u32x4*)(stt + gla::t_st<4>(row, ch * 8)) = *(const u32x4*)(sp + row * 128 + ch * 8); } }
            gla::bf16x8 qa[4];
            { const bf16_t* qrow = PROJB + (size_t)(t0 + lt * 32 + r32) * PB_LD + PB_GQ + h * 64 + hi5 * 8;
#pragma unroll
              for (int ks = 0; ks < 4; ++ks) qa[ks] = *(const gla::bf16x8*)(qrow + ks * 16); }
            __syncthreads();
            gla::f32x16 acc = {};
            { gla::s16x4 bl[4], bh[4];
#define GLA_KS(ks) do { GLA_TRRD(bl[ks], bbase, gla::t_rd_off<4>(0, ks, 0)); GLA_TRRD(bh[ks], bbase, gla::t_rd_off<4>(0, ks, 1)); } while (0)
              GLA_KS(0); GLA_KS(1); GLA_KS(2); GLA_KS(3);
#undef GLA_KS
              asm volatile("s_waitcnt lgkmcnt(0)" ::: "memory"); __builtin_amdgcn_sched_barrier(0);
#pragma unroll
              for (int ks = 0; ks < 4; ++ks) acc = __builtin_amdgcn_mfma_f32_32x32x16_bf16(qa[ks], (gla::bf16x8){bl[ks][0], bl[ks][1], bl[ks][2], bl[ks][3], bh[ks][0], bh[ks][1], bh[ks][2], bh[ks][3]}, acc, 0, 0, 0); }
            float rs[16];
#pragma unroll
            for (int r = 0; r < 16; ++r) { acc[r] *= 0.125f; float s2 = acc[r] * acc[r];
                s2 += __builtin_bit_cast(float, __builtin_amdgcn_update_dpp(0, __builtin_bit_cast(int, s2), 0x128, 0xf, 0xf, false));
                s2 += __builtin_bit_cast(float, __builtin_amdgcn_update_dpp(0, __builtin_bit_cast(int, s2), 0x124, 0xf, 0xf, false));
                s2 += __builtin_bit_cast(float, __builtin_amdgcn_update_dpp(0, __builtin_bit_cast(int, s2), 0x122, 0xf, 0xf, false));
                s2 += __builtin_bit_cast(float, __builtin_amdgcn_update_dpp(0, __builtin_bit_cast(int, s2), 0x121, 0xf, 0xf, false));
                s2 += __shfl_xor(s2, 16); rs[r] = s2; }
            if (r32 == 0) {
#pragma unroll
                for (int r = 0; r < 16; ++r) part[(lt * 32 + gla::crow(r, hi5)) * 4 + vt] = rs[r]; }
            __syncthreads();
#pragma unroll
            for (int r = 0; r < 16; ++r) { const int l = lt * 32 + gla::crow(r, hi5); const f32x4 pp = *(const f32x4*)(part + l * 4);
                const float rn = rsqrtf(((pp[0] + pp[1]) + (pp[2] + pp[3])) * (1.f / 128.f) + EPS);
                const int v = vt * 32 + r32; const float go = bf2f(PROJB[(size_t)(t0 + l) * PB_LD + PB_GOUT + h * 128 + v]);
                const float silu = go * __builtin_amdgcn_rcpf(1.f + __expf(-go));
                YB[(size_t)(t0 + l) * 512 + h * 128 + v] = f2bf(acc[r] * rn * g_gla[h * 128 + v] * silu); }
            __syncthreads();
        }
    }
    SEAM(4);
    if (IN(5)) {
        pg8::Gemm g{YA, WA, YB, WB, 512, 512, M_, 1024, 512, 2}; pg8::StaticOrder S; S.init(g, G, (int)blockIdx.x);
        pg8::EpiMerge E{PROJB, MERGED}; pg8::gemm_phase<pg8::EpiMerge, pg8::StaticOrder, true>(ring, g, S, E);
    }
    SEAM(5);
    if (IN(6)) {
        pg8::Gemm g{MERGED, WOUT, nullptr, nullptr, DM, DM, M_, 1024, DM, 1}; pg8::StaticOrder S; S.init(g, G, (int)blockIdx.x);
        pg8::EpiX1 E{x, out, X1B, SSX1}; pg8::gemm_phase<pg8::EpiX1, pg8::StaticOrder, false>(ring, g, S, E);
    }
    SEAM(6);
    if (IN(7)) {
        pg8::Gemm g{X1B, WPQ, nullptr, nullptr, DM, DM, M_, 2048, DM, 1}; pg8::StaticOrder S; S.init(g, G, vcu); S.pair_mode = 1;
        pg8::EpiQP E{QP, SSX1}; pg8::gemm_phase<pg8::EpiQP, pg8::StaticOrder, true>(ring, g, S, E);
        asm volatile("s_waitcnt vmcnt(0)" ::: "memory"); __syncthreads();
    }
    if (IN(7)) {
        typedef short bf16x8_t __attribute__((ext_vector_type(8)));
        typedef float f32x16_t __attribute__((ext_vector_type(16)));
        const int r32 = lane & 31, hi = lane >> 5;
#define P8_SORTABLE(f) ({ const unsigned b_ = __float_as_uint(f); b_ ^ ((unsigned)((int)b_ >> 31) | 0x80000000u); })
#define P8_UNSORT(u) ({ const unsigned u_ = (u); __uint_as_float(u_ ^ (~(unsigned)((int)u_ >> 31) | 0x80000000u)); })
#define P8_CE(a, b) do { const unsigned hi_ = (a) > (b) ? (a) : (b), lo_ = (a) > (b) ? (b) : (a); (a) = hi_; (b) = lo_; } while (0)
#define P8_SORT16(x) do { P8_CE(x[0], x[1]); P8_CE(x[3], x[2]); P8_CE(x[4], x[5]); P8_CE(x[7], x[6]); P8_CE(x[8], x[9]); P8_CE(x[11], x[10]); P8_CE(x[12], x[13]); P8_CE(x[15], x[14]); P8_CE(x[0], x[2]); P8_CE(x[1], x[3]); P8_CE(x[6], x[4]); P8_CE(x[7], x[5]); P8_CE(x[8], x[10]); P8_CE(x[9], x[11]); P8_CE(x[14], x[12]); P8_CE(x[15], x[13]); P8_CE(x[0], x[1]); P8_CE(x[2], x[3]); P8_CE(x[5], x[4]); P8_CE(x[7], x[6]); P8_CE(x[8], x[9]); P8_CE(x[10], x[11]); P8_CE(x[13], x[12]); P8_CE(x[15], x[14]); P8_CE(x[0], x[4]); P8_CE(x[1], x[5]); P8_CE(x[2], x[6]); P8_CE(x[3], x[7]); P8_CE(x[12], x[8]); P8_CE(x[13], x[9]); P8_CE(x[14], x[10]); P8_CE(x[15], x[11]); P8_CE(x[0], x[2]); P8_CE(x[1], x[3]); P8_CE(x[4], x[6]); P8_CE(x[5], x[7]); P8_CE(x[10], x[8]); P8_CE(x[11], x[9]); P8_CE(x[14], x[12]); P8_CE(x[15], x[13]); P8_CE(x[0], x[1]); P8_CE(x[2], x[3]); P8_CE(x[4], x[5]); P8_CE(x[6], x[7]); P8_CE(x[9], x[8]); P8_CE(x[11], x[10]); P8_CE(x[13], x[12]); P8_CE(x[15], x[14]); P8_CE(x[0], x[8]); P8_CE(x[1], x[9]); P8_CE(x[2], x[10]); P8_CE(x[3], x[11]); P8_CE(x[4], x[12]); P8_CE(x[5], x[13]); P8_CE(x[6], x[14]); P8_CE(x[7], x[15]); P8_CE(x[0], x[4]); P8_CE(x[1], x[5]); P8_CE(x[2], x[6]); P8_CE(x[3], x[7]); P8_CE(x[8], x[12]); P8_CE(x[9], x[13]); P8_CE(x[10], x[14]); P8_CE(x[11], x[15]); P8_CE(x[0], x[2]); P8_CE(x[1], x[3]); P8_CE(x[4], x[6]); P8_CE(x[5], x[7]); P8_CE(x[8], x[10]); P8_CE(x[9], x[11]); P8_CE(x[12], x[14]); P8_CE(x[13], x[15]); P8_CE(x[0], x[1]); P8_CE(x[2], x[3]); P8_CE(x[4], x[5]); P8_CE(x[6], x[7]); P8_CE(x[8], x[9]); P8_CE(x[10], x[11]); P8_CE(x[12], x[13]); P8_CE(x[14], x[15]); } while (0)
#define P8_MERGE16(A, B, O) do { _Pragma("unroll") for (int i_ = 0; i_ < 16; ++i_) O[i_] = (A)[i_] > (B)[15 - i_] ? (A)[i_] : (B)[15 - i_]; \
        _Pragma("unroll") for (int s_ = 8; s_ >= 1; s_ >>= 1) _Pragma("unroll") for (int i_ = 0; i_ < 16; ++i_) if ((i_ & s_) == 0) P8_CE(O[i_], O[i_ + s_]); } while (0)
#define P8_INSERT(t, v) do { unsigned v_ = (v); _Pragma("unroll") for (int q_ = 0; q_ < 16; ++q_) { const unsigned a_ = t[q_] > v_ ? t[q_] : v_; v_ = t[q_] > v_ ? v_ : t[q_]; t[q_] = a_; } } while (0)
        for (int item = vcu; item < 256; item += G) {
            const int h = item & 7, tr = item >> 3;
            for (int c = tid; c < 2 * 128 * 16; c += 512) { const int p = c >> 11, row = (c >> 4) & 127, ch = c & 15;
                const u32x4 v = *(const u32x4*)(KEYS + ((size_t)(h * 2 + p) * 128 + row) * 128 + ch * 8);
                *(u32x4*)(lds + p * 32768 + row * 256 + ((ch * 16) ^ ((row & 7) << 4))) = v; }
            __syncthreads();
#pragma unroll 1
            for (int step = 0; step < 2; ++step) {
                const int m = tr * 512 + wave * 64 + step * 32 + r32;
                unsigned top[2][16];
#pragma unroll
                for (int p = 0; p < 2; ++p) {
                    bf16x8_t qf[8];
#pragma unroll
                    for (int ks = 0; ks < 8; ++ks) qf[ks] = *(const bf16x8_t*)(QP + (size_t)m * 2048 + (h * 2 + p) * 128 + ks * 16 + hi * 8);
                    f32x16_t acc[4];
#pragma unroll
                    for (int kt = 0; kt < 4; ++kt) { acc[kt] = f32x16_t{};
                        const int row = kt * 32 + r32; const unsigned char* rb = lds + p * 32768 + row * 256;
#pragma unroll
                        for (int ks = 0; ks < 8; ++ks) { const bf16x8_t a = *(const bf16x8_t*)(rb + (((2 * ks + hi) * 16) ^ ((row & 7) << 4)));
                            acc[kt] = __builtin_amdgcn_mfma_f32_32x32x16_bf16(a, qf[ks], acc[kt], 0, 0, 0); } }
                    unsigned xs[4][16];
#pragma unroll
                    for (int kt = 0; kt < 4; ++kt)
#pragma unroll
                        for (int r = 0; r < 16; ++r) { const unsigned base = 32 * kt + (r & 3) + 8 * (r >> 2);
                            xs[kt][r] = (P8_SORTABLE(acc[kt][r]) | 127u) ^ base; }
                    P8_SORT16(xs[0]); P8_SORT16(xs[1]); P8_SORT16(xs[2]); P8_SORT16(xs[3]);
                    unsigned m01[16], m23[16], t[16];
                    P8_MERGE16(xs[0], xs[1], m01); P8_MERGE16(xs[2], xs[3], m23); P8_MERGE16(m01, m23, t);
#pragma unroll
                    for (int i = 0; i < 16; ++i) t[i] ^= (unsigned)(hi << 2);
                    unsigned mm[16];
#pragma unroll
                    for (int i = 0; i < 16; ++i) { auto rr = __builtin_amdgcn_permlane32_swap(t[15 - i], t[15 - i], false, false); const unsigned pt = hi ? rr[0] : rr[1]; mm[i] = t[i] > pt ? t[i] : pt; }
#pragma unroll
                    for (int sft = 8; sft >= 1; sft >>= 1)
#pragma unroll
                        for (int i = 0; i < 16; ++i) if ((i & sft) == 0) { const unsigned a_ = mm[i] > mm[i + sft] ? mm[i] : mm[i + sft], b_ = mm[i] > mm[i + sft] ? mm[i + sft] : mm[i]; mm[i] = a_; mm[i + sft] = b_; }
#pragma unroll
                    for (int i = 0; i < 16; ++i) top[p][i] = mm[i];
                }
                float f0[16], f1[16];
#pragma unroll
                for (int i = 0; i < 16; ++i) { f0[i] = P8_UNSORT(top[0][i] & 0xFFFFFF80u); f1[i] = P8_UNSORT(top[1][i] & 0xFFFFFF80u); }
#define P8_CV(a, b) ((P8_SORTABLE(f0[a] + f1[b]) | 255u) ^ (unsigned)((a) * 16 + (b)))
                unsigned l0[16], x1[16], x2[16], x3[16], m1[16], m2[16], cb[16];
#pragma unroll
                for (int b = 0; b < 16; ++b) l0[b] = P8_CV(0, b);
#pragma unroll
                for (int b = 0; b < 8; ++b) x1[b] = P8_CV(1, b);
#pragma unroll
                for (int b = 0; b < 5; ++b) x1[8 + b] = P8_CV(2, b);
#pragma unroll
                for (int b = 0; b < 3; ++b) x1[13 + b] = P8_CV(3, b);
                x2[0] = P8_CV(3, 3);
#pragma unroll
                for (int b = 0; b < 3; ++b) x2[1 + b] = P8_CV(4, b);
#pragma unroll
                for (int b = 0; b < 2; ++b) { x2[4 + b] = P8_CV(5, b); x2[6 + b] = P8_CV(6, b); x2[8 + b] = P8_CV(7, b); }
                x2[10] = P8_CV(8, 0); x2[11] = P8_CV(9, 0); x2[12] = P8_CV(10, 0); x2[13] = P8_CV(11, 0); x2[14] = P8_CV(12, 0); x2[15] = P8_CV(13, 0);
                x3[0] = P8_CV(14, 0); x3[1] = P8_CV(15, 0);
#pragma unroll
                for (int i = 2; i < 16; ++i) x3[i] = 0u;
#undef P8_CV
                P8_SORT16(x1); P8_SORT16(x2);
                P8_MERGE16(l0, x1, m1); P8_MERGE16(x2, x3, m2); P8_MERGE16(m1, m2, cb);
                unsigned char* slot = lds + 65536 + wave * 2048 + lane * 32;
                { u32x4 w0, w1;
#define P8_IDX4(T, i) ((127u - (T[i] & 127u)) | ((127u - (T[(i) + 1] & 127u)) << 8) | ((127u - (T[(i) + 2] & 127u)) << 16) | ((127u - (T[(i) + 3] & 127u)) << 24))
                  w0.x = P8_IDX4(top[0], 0); w0.y = P8_IDX4(top[0], 4); w0.z = P8_IDX4(top[0], 8); w0.w = P8_IDX4(top[0], 12);
                  w1.x = P8_IDX4(top[1], 0); w1.y = P8_IDX4(top[1], 4); w1.z = P8_IDX4(top[1], 8); w1.w = P8_IDX4(top[1], 12);
#undef P8_IDX4
                  *(u32x4*)slot = w0; *(u32x4*)(slot + 16) = w1; }
                asm volatile("s_waitcnt lgkmcnt(0)" ::: "memory");
                float bv[16]; int be[16];
#pragma unroll
                for (int k = 0; k < 16; ++k) { const unsigned pos = (~cb[k]) & 255u; bv[k] = P8_UNSORT(cb[k] & 0xFFFFFF00u);
                    be[k] = (int)slot[pos >> 4] * 128 + (int)slot[16 + (pos & 15)]; }
                { const float b0 = bv[0];
#pragma unroll
                  for (int k = 0; k < 16; ++k) bv[k] = __expf(bv[k] - b0); }
                asm volatile("s_waitcnt lgkmcnt(0)" ::: "memory");
                if (hi == 0) { int* ep = EIDX + (size_t)m * 128 + 2 * h;
#pragma unroll
                    for (int kk = 0; kk < 8; ++kk) { u32x2 w; w.x = (unsigned)be[kk]; w.y = (unsigned)be[kk + 8]; *(u32x2*)(ep + kk * 16) = w; } }
                else { float* gp = EGATE + (size_t)m * 128 + 2 * h; float s2 = 0.f;
#pragma unroll
                    for (int k = 0; k < 16; ++k) s2 += bv[k];
                    const float inv = 1.f / s2;
#pragma unroll
                    for (int kk = 0; kk < 8; ++kk) { u32x2 w; w.x = __float_as_uint(bv[kk] * inv); w.y = __float_as_uint(bv[kk + 8] * inv); *(u32x2*)(gp + kk * 16) = w; } }
            }
            __syncthreads();
        }
#undef P8_SORTABLE
#undef P8_UNSORT
#undef P8_INSERT
#undef P8_CE
#undef P8_SORT16
#undef P8_MERGE16
    }
    SEAM(8);
#define UB(w, e) ((float)(((w) >> (8 * (e))) & 0xffu))
#define DPP_ADD(v, ctrl) v += __builtin_bit_cast(float, __builtin_amdgcn_update_dpp(0, __builtin_bit_cast(int, v), (ctrl), 0xf, 0xf, false))
    volatile unsigned* MISCW = (volatile unsigned*)(lds + MISC_OFF);
    const int x_nloc = (MK_N_LAUNCHES == 1) ? (int)MISCW[8] : G, x_nx = (MK_N_LAUNCHES == 1) ? (int)MISCW[9] : 1, x_rank = (MK_N_LAUNCHES == 1) ? (int)MISCW[10] : (int)blockIdx.x, x_ord = (MK_N_LAUNCHES == 1) ? (int)MISCW[11] : 0;
    if (IN(9)) {
        const int g = lane >> 3, c = lane & 7;
        const int tstep = x_nloc * NWAVES;
        for (int sl = x_ord; sl < 8; sl += x_nx) {
            const unsigned char* ub = UT + (size_t)sl * (16384 * 128) + 16 * c;
            const bf16_t* xbase = X1B + sl * 128 + 16 * c;
#define P9_IDX(I4, XA, XB, tt) do { const int t_ = (tt) < M_ ? (tt) : M_ - 1; const u32x4* ep_ = (const u32x4*)(EIDX + (size_t)t_ * 128 + g * 16); \
            I4[0] = ep_[0]; I4[1] = ep_[1]; I4[2] = ep_[2]; I4[3] = ep_[3]; XA = *(const u32x4*)(xbase + (size_t)t_ * DM); XB = *(const u32x4*)(xbase + (size_t)t_ * DM + 8); } while (0)
#define P9_ROWS(U, I4, hf) do { _Pragma("unroll") for (int i = 0; i < 8; ++i) U[i] = *(const u32x4*)(ub + (size_t)I4[2 * (hf) + (i >> 2)][i & 3] * 128); } while (0)
#define P9_HALF(U, hf) do { _Pragma("unroll") for (int i = 0; i < 8; ++i) { int a = __builtin_amdgcn_sdot4((int)xq[0], (int)U[i][0], 0, false); a = __builtin_amdgcn_sdot4((int)xq[1], (int)U[i][1], a, false); \
                a = __builtin_amdgcn_sdot4((int)xq[2], (int)U[i][2], a, false); a = __builtin_amdgcn_sdot4((int)xq[3], (int)U[i][3], a, false); \
                a += __builtin_amdgcn_update_dpp(0, a, 0xB1, 0xf, 0xf, false); a += __builtin_amdgcn_update_dpp(0, a, 0x4E, 0xf, 0xf, false); a += __builtin_amdgcn_update_dpp(0, a, 0x141, 0xf, 0xf, false); \
                z0 = (8 * (hf) + i == 2 * c) ? a : z0; z1 = (8 * (hf) + i == 2 * c + 1) ? a : z1; } } while (0)
            u32x4 iC[4], iN[4], iNN[4], xaC, xbC, xaN, xbN, xaNN, xbNN, uA[8], uB[8];
            int t = x_rank * NWAVES + wave;
            P9_IDX(iC, xaC, xbC, t); P9_IDX(iN, xaN, xbN, t + tstep); P9_ROWS(uA, iC, 0);
            for (; t < M_; t += tstep) {
                P9_ROWS(uB, iC, 1); P9_IDX(iNN, xaNN, xbNN, t + 2 * tstep);
                float xf[16];
#pragma unroll
                for (int q = 0; q < 4; ++q) { xf[2 * q] = __uint_as_float(xaC[q] << 16); xf[2 * q + 1] = __uint_as_float(xaC[q] & 0xffff0000u); xf[8 + 2 * q] = __uint_as_float(xbC[q] << 16); xf[8 + 2 * q + 1] = __uint_as_float(xbC[q] & 0xffff0000u); }
                float mx = 1e-30f;
#pragma unroll
                for (int j = 0; j < 16; ++j) mx = fmaxf(mx, fabsf(xf[j]));
                mx = fmaxf(mx, __builtin_bit_cast(float, __builtin_amdgcn_update_dpp(0, __builtin_bit_cast(int, mx), 0xB1, 0xf, 0xf, false)));
                mx = fmaxf(mx, __builtin_bit_cast(float, __builtin_amdgcn_update_dpp(0, __builtin_bit_cast(int, mx), 0x4E, 0xf, 0xf, false)));
                mx = fmaxf(mx, __builtin_bit_cast(float, __builtin_amdgcn_update_dpp(0, __builtin_bit_cast(int, mx), 0x141, 0xf, 0xf, false)));
                const float xinv = 127.f * __builtin_amdgcn_rcpf(mx), xsc = mx * (1.f / 127.f);
                unsigned xq[4];
#pragma unroll
                for (int q = 0; q < 4; ++q) { unsigned b = 0;
#pragma unroll
                    for (int e = 0; e < 4; ++e) { const int qi = (int)rintf(xf[4 * q + e] * xinv); b |= ((unsigned)qi & 0xffu) << (8 * e); }
                    xq[q] = b; }
                int z0 = 0, z1 = 0;
                P9_HALF(uA, 0);
                P9_ROWS(uA, iN, 0);
                P9_HALF(uB, 1);
                { u32x2 w; w.x = __float_as_uint((float)z0 * xsc); w.y = __float_as_uint((float)z1 * xsc); *(u32x2*)(ZP + ((size_t)sl * M_ + t) * 128 + g * 16 + 2 * c) = w; }
#pragma unroll
                for (int q = 0; q < 4; ++q) { iC[q] = iN[q]; iN[q] = iNN[q]; }
                xaC = xaN; xbC = xbN; xaN = xaNN; xbN = xbNN;
            }
#undef P9_HALF
#undef P9_IDX
#undef P9_ROWS
        }
    }
    SEAM(9);
    if (IN(10)) {
        for (int t = gw; t < M_; t += NGW) { const float r = rsqrtf(SSX1[t] * (1.f / DM) + EPS); float av[2]; float mx = 1e-30f;
#pragma unroll
            for (int v = 0; v < 2; ++v) { const int p = lane + 64 * v; const int e = EIDX[(size_t)t * 128 + p]; float zs[8];
#pragma unroll
                for (int j = 0; j < 8; ++j) zs[j] = ZP[((size_t)j * M_ + t) * 128 + p];
                float z = ((zs[0] + zs[1]) + (zs[2] + zs[3])) + ((zs[4] + zs[5]) + (zs[6] + zs[7]));
                z *= SU[e] * r;
                av[v] = 0.5f * z * (1.f + erff(z * 0.70710678118654752f)) * EGATE[(size_t)t * 128 + p] * SV[e];
                mx = fmaxf(mx, fabsf(av[v])); }
#pragma unroll
            for (int o = 1; o < 64; o <<= 1) mx = fmaxf(mx, __shfl_xor(mx, o));
            const float inv = 127.f / mx;
            CQ[(size_t)t * 128 + lane] = (signed char)(int)rintf(av[0] * inv); CQ[(size_t)t * 128 + 64 + lane] = (signed char)(int)rintf(av[1] * inv);
            if (lane == 0) CS[t] = mx * (1.f / 127.f); }
    }
    SEAM(10);
    if (IN(11)) {
        const int g = lane >> 3, c = lane & 7;
        const int tstep = x_nloc * NWAVES;
        for (int sl = x_ord; sl < 8; sl += x_nx) {
            const unsigned char* vb = VT + (size_t)sl * (16384 * 128) + 16 * c;
#define P11_IDX(I4, C4, tt) do { const int t_ = (tt) < M_ ? (tt) : M_ - 1; const u32x4* ep_ = (const u32x4*)(EIDX + (size_t)t_ * 128 + g * 16); \
            I4[0] = ep_[0]; I4[1] = ep_[1]; I4[2] = ep_[2]; I4[3] = ep_[3]; C4 = *(const u32x4*)(CQ + (size_t)t_ * 128 + g * 16); } while (0)
#define P11_ROWS(U, I4, hf) do { _Pragma("unroll") for (int i = 0; i < 8; ++i) U[i] = *(const u32x4*)(vb + (size_t)I4[2 * (hf) + (i >> 2)][i & 3] * 128); } while (0)
#define P11_BLK(U, b0, q, CW) do { const unsigned d0_ = U[b0][q], d1_ = U[(b0) + 1][q], d2_ = U[(b0) + 2][q], d3_ = U[(b0) + 3][q]; \
            const unsigned t0_ = __builtin_amdgcn_perm(d1_, d0_, 0x05010400u), t1_ = __builtin_amdgcn_perm(d1_, d0_, 0x07030602u), t2_ = __builtin_amdgcn_perm(d3_, d2_, 0x05010400u), t3_ = __builtin_amdgcn_perm(d3_, d2_, 0x07030602u); \
            acc[4 * (q)] = __builtin_amdgcn_sdot4((int)__builtin_amdgcn_perm(t2_, t0_, 0x05040100u), (int)(CW), acc[4 * (q)], false); \
            acc[4 * (q) + 1] = __builtin_amdgcn_sdot4((int)__builtin_amdgcn_perm(t2_, t0_, 0x07060302u), (int)(CW), acc[4 * (q) + 1], false); \
            acc[4 * (q) + 2] = __builtin_amdgcn_sdot4((int)__builtin_amdgcn_perm(t3_, t1_, 0x05040100u), (int)(CW), acc[4 * (q) + 2], false); \
            acc[4 * (q) + 3] = __builtin_amdgcn_sdot4((int)__builtin_amdgcn_perm(t3_, t1_, 0x07060302u), (int)(CW), acc[4 * (q) + 3], false); } while (0)
#define P11_HALF(U, C4, hf) do { _Pragma("unroll") for (int bb = 0; bb < 2; ++bb) { const unsigned cw_ = C4[2 * (hf) + bb]; \
            _Pragma("unroll") for (int q = 0; q < 4; ++q) P11_BLK(U, 4 * bb, q, cw_); } } while (0)
            u32x4 iC[4], iN[4], iNN[4], uA[8], uB[8], cC, cN, cNN;
            const int hi5 = lane >> 5, b3 = (lane >> 3) & 1;
            int t = x_rank * NWAVES + wave;
            P11_IDX(iC, cC, t); P11_IDX(iN, cN, t + tstep); P11_ROWS(uA, iC, 0);
            for (; t < M_; t += tstep) {
                float* op = out + (size_t)t * DM + sl * 128 + 16 * c + 4 * b3 + 8 * hi5;
                const f32x4 x1v = *(const f32x4*)op; const float cs = CS[t];
                P11_ROWS(uB, iC, 1); P11_IDX(iNN, cNN, t + 2 * tstep);
                int acc[16];
#pragma unroll
                for (int j = 0; j < 16; ++j) acc[j] = 0;
                P11_HALF(uA, cC, 0);
                P11_ROWS(uA, iN, 0);
                P11_HALF(uB, cC, 1);
                int w8[8];
#pragma unroll
                for (int j = 0; j < 8; ++j) { auto rr = __builtin_amdgcn_permlane32_swap((unsigned)acc[j], (unsigned)acc[j + 8], false, false); w8[j] = (int)rr[0] + (int)rr[1]; }
#pragma unroll
                for (int j = 0; j < 8; ++j) w8[j] += __shfl_xor(w8[j], 16);
                f32x4 o; float ss = 0.f;
#pragma unroll
                for (int j = 0; j < 4; ++j) { const int keep = b3 ? w8[j + 4] : w8[j]; const int give = b3 ? w8[j] : w8[j + 4];
                    const int tot = keep + __builtin_amdgcn_update_dpp(0, give, 0x128, 0xf, 0xf, false);
                    o[j] = x1v[j] + (float)tot * cs; ss += o[j] * o[j]; }
                if (((lane >> 4) & 1) == 0) *(f32x4*)op = o;
                DPP_ADD(ss, 0x128); DPP_ADD(ss, 0x124); DPP_ADD(ss, 0x122); DPP_ADD(ss, 0x121);
                { const float s0 = __builtin_bit_cast(float, __builtin_amdgcn_readlane(__builtin_bit_cast(int, ss), 0)), s1 = __builtin_bit_cast(float, __builtin_amdgcn_readlane(__builtin_bit_cast(int, ss), 32));
                  if (lane == 0) atomicAdd(SS2 + t, s0 + s1); }
#pragma unroll
                for (int q = 0; q < 4; ++q) { iC[q] = iN[q]; iN[q] = iNN[q]; }
                cC = cN; cN = cNN;
            }
#undef P11_BLK
#undef P11_HALF
#undef P11_IDX
#undef P11_ROWS
        }
    }
    SEAM(11);
    if (IN(12)) {
        for (int m = gw; m < M_; m += NGW) { const float r2 = rsqrtf(SS2[m] * (1.f / DM) + EPS); float* orow = out + (size_t)m * DM;
#pragma unroll
            for (int j = 0; j < 4; ++j) { const int cix = 4 * (lane + 64 * j); const f32x4 gg = *(const f32x4*)(g_final + cix); f32x4 o = *(const f32x4*)(orow + cix);
                o[0] *= r2 * gg[0]; o[1] *= r2 * gg[1]; o[2] *= r2 * gg[2]; o[3] *= r2 * gg[3]; *(f32x4*)(orow + cix) = o; } }
    }
#undef UB
#undef DPP_ADD
#undef IN
#undef SEAM
}

extern "C" void kernel_launch(void* const* d_in, const int* in_sizes, int n_in, void* d_out, int out_size, void* d_ws, size_t ws_size, hipStream_t stream) {
    static int grid = 0;
    if (grid == 0) {
        if (n_in != 20 || out_size != M_ * DM || ws_size < WS_END) { fprintf(stderr, "kernel_launch: unexpected shapes (n_in %d out %d ws %zu); nothing launched\n", n_in, out_size, ws_size); grid = -1; return; }
        int dev = 0, cus = 0;
        if (hipGetDevice(&dev) != hipSuccess || hipDeviceGetAttribute(&cus, hipDeviceAttributeMultiprocessorCount, dev) != hipSuccess) { grid = -1; return; }
        if (hipFuncSetAttribute((const void*)fwd, hipFuncAttributeMaxDynamicSharedMemorySize, LDS_BYTES) != hipSuccess) { fprintf(stderr, "kernel_launch: hipFuncSetAttribute failed\n"); grid = -1; return; }
        int per_cu = 0;
        if (hipOccupancyMaxActiveBlocksPerMultiprocessor(&per_cu, (const void*)fwd, NWAVES * 64, LDS_BYTES) != hipSuccess || per_cu < 1) fprintf(stderr, "kernel_launch: occupancy query reports %d\n", per_cu);
        (void)hipGetLastError();
        grid = cus;
    }
    if (grid < 0) return;
    (void)hipMemsetAsync((char*)d_ws + WS_CTL, 0, CTL_ZERO_BYTES, stream);
    Args a; memset(&a, 0, sizeof(a));
    for (int i = 0; i < 20; ++i) a.in[i] = d_in[i];
    a.out = (float*)d_out; a.ws = (unsigned char*)d_ws;
    if (MK_N_LAUNCHES == 1) { a.ph_lo = 0; a.ph_hi = N_PHASES; hipLaunchKernelGGL(fwd, dim3(grid), dim3(NWAVES * 64), LDS_BYTES, stream, a); }
    else for (int p = 0; p < N_PHASES; ++p) { a.ph_lo = p; a.ph_hi = p + 1; hipLaunchKernelGGL(fwd, dim3(grid), dim3(NWAVES * 64), LDS_BYTES, stream, a); }
}
```

```cpp
#include <hip/hip_runtime.h>
#include <cstdio>
#include <cstdint>
#include <cstring>
#include <math.h>

#ifndef MK_N_LAUNCHES
#define MK_N_LAUNCHES 1
#endif
constexpr int N_PHASES = 13;

typedef unsigned short bf16_t;
constexpr int SEQ = 8192, DM = 1024, M_ = 16384, NCH = 128;
constexpr float EPS = 1e-6f;
constexpr int PB_LD = 2816, PA_LD = 1536;
constexpr int PB_BR = 0, PB_GOUT = 2048, PB_GQ = 2560;
constexpr int PA_GV = 0, PA_GK = 512, PA_QLAT = 768, PA_KVLAT = 1152, PA_KROPE = 1408, PA_GLR = 1440;
constexpr int NPROJ = 4352;
constexpr float CQ = 0.10206207261596577f * 1.4426950408889634f;

constexpr size_t MiB = 1u << 20;
constexpr size_t WS_CTL = 0, CTL_ZERO_BYTES = 256 * 1024;
constexpr size_t WS_SSQ = 1 * MiB, WS_SSKV = WS_SSQ + 65536, WS_SSX1 = WS_SSKV + 65536, WS_SS2 = WS_SSX1 + 65536, WS_C128 = WS_SS2 + 65536  , WS_CB = 136 * MiB  , WS_ZP = 56 * MiB  , WS_COS = 2 * MiB, WS_SIN = 3 * MiB;
constexpr size_t WS_DECAY = 1 * MiB + 512 * 1024;
constexpr size_t WS_WIN = 4 * MiB, WS_WQB = 13 * MiB, WS_WKVB = 14 * MiB, WS_WA = 15 * MiB, WS_WB = 16 * MiB, WS_WOUT = 17 * MiB, WS_WPQ = 19 * MiB, WS_KEYS = 23 * MiB;
constexpr size_t WS_PROJB = 24 * MiB, WS_PROJA = 112 * MiB, WS_XN = 160 * MiB, WS_Q = 160 * MiB, WS_K = 184 * MiB, WS_V = 208 * MiB, WS_DST = 224 * MiB;
constexpr size_t WS_YA = 112 * MiB, WS_YB = 128 * MiB, WS_MERGED = 160 * MiB, WS_X1B = 24 * MiB, WS_QP = 56 * MiB, WS_EIDX = 120 * MiB, WS_EGATE = 128 * MiB;
constexpr size_t WS_KPE = 208 * MiB  , WS_UT = 224 * MiB, WS_VT = 240 * MiB, WS_SU = 1 * MiB + 768 * 1024, WS_SV = WS_SU + 65536;
constexpr size_t WS_END = 256 * MiB;

#define GAS __attribute__((address_space(1)))
#define LAS __attribute__((address_space(3)))
typedef float f32x4 __attribute__((ext_vector_type(4)));
typedef unsigned u32x4 __attribute__((ext_vector_type(4)));
typedef unsigned u32x2 __attribute__((ext_vector_type(2)));

__device__ __forceinline__ float bf2f(bf16_t h) { return __uint_as_float(((unsigned)h) << 16); }
__device__ __forceinline__ unsigned f2bf_u(float f) { unsigned u = __float_as_uint(f); return (u + 0x7fffu + ((u >> 16) & 1u)) >> 16; }
__device__ __forceinline__ bf16_t f2bf(float f) { return (bf16_t)f2bf_u(f); }
__device__ __forceinline__ unsigned pk2(float lo, float hi) { return f2bf_u(lo) | (f2bf_u(hi) << 16); }
__device__ __forceinline__ float wave_sum(float v) {
#pragma unroll
    for (int o = 1; o < 64; o <<= 1) v += __shfl_xor(v, o);
    return v;
}
__device__ __forceinline__ float sigmoidf_(float x) { return 1.f / (1.f + __expf(-x)); }

namespace pg8 {
#define PG8_LAS __attribute__((address_space(3)))
typedef short bf16x8 __attribute__((ext_vector_type(8)));
constexpr int BM = 256, BK = 64, HALF = 128, HTB = HALF * BK * 2, STAGE_BYTES = 8 * HTB, NXCD = 8, WGM = 8;
__host__ __device__ __forceinline__ int lds_byte(int r, int c) { const int st = (r >> 4) * 2 + (c >> 5), rr = r & 15, cc = c & 31, ob = rr * 64 + cc * 2; return st * 1024 + (ob ^ (((ob >> 9) & 1) << 5)); }
__host__ __device__ __forceinline__ void stage_rc(int b, int& R, int& C) { const int st = b / 1024, sb = b % 1024, swz = sb ^ (((sb >> 9) & 1) << 5); R = (st >> 1) * 16 + swz / 64; C = (st & 1) * 32 + (swz % 64) / 2; }
__host__ __device__ __forceinline__ int perm32(int rho) { const int n = rho >> 4, i = rho & 15; return 8 * (i >> 2) + 4 * n + (i & 3); }

struct Unit { int pm, pn, sub; const char* A; const char* B; };
struct Gemm { const bf16_t* A; const bf16_t* Bt; const bf16_t* A2; const bf16_t* Bt2; int lda, ldb, M, N, K, chain; };
struct StaticOrder {
    int nM, nN, nwg, G, c, chain; const char *A, *B, *A2, *B2; size_t tsA, tsB;
    __device__ __forceinline__ void init(const Gemm& g, int G_, int c_) { nM = g.M / BM; nN = g.N / BM; nwg = nM * nN; G = G_; c = c_; chain = g.chain; A = (const char*)g.A; B = (const char*)g.Bt; A2 = (const char*)g.A2; B2 = (const char*)g.Bt2;
        tsA = (size_t)BM * g.lda * 2; tsB = (size_t)BM * g.ldb * 2; }
    int pair_mode = 0;
    __device__ __forceinline__ bool next(int i, Unit& u) const {
        if (pair_mode) { const int item = c + (i >> 1) * G; if (item >= nwg / 2) return false; u.pm = 2 * (item >> 3) + (i & 1); u.pn = item & 7; u.sub = 0; u.A = A + (size_t)u.pm * tsA; u.B = B + (size_t)u.pn * tsB; return true; }
        const int r = (chain == 2) ? (i >> 1) : i, sub = (chain == 2) ? (i & 1) : 0;
        const long L = (long)r * G + c; if (L >= nwg) return false;
        int wgid = (int)L; { const int q = nwg / NXCD, rr = nwg % NXCD, xcd = wgid % NXCD, off = wgid / NXCD; wgid = (xcd < rr ? xcd * (q + 1) : rr * (q + 1) + (xcd - rr) * q) + off; }
        const int nig = WGM * nN, gid = wgid / nig, fm = gid * WGM, gsz = (nM - fm) < WGM ? (nM - fm) : WGM;
        u.pm = fm + ((wgid % nig) % gsz); u.pn = (wgid % nig) / gsz; u.sub = sub;
        u.A = (sub ? A2 : A) + (size_t)u.pm * tsA; u.B = (sub ? B2 : B) + (size_t)u.pn * tsB; return true;
    }
};
__device__ __forceinline__ unsigned cvt_pk_bf16(float lo, float hi) { unsigned r; asm volatile("v_cvt_pk_bf16_f32 %0, %1, %2" : "=v"(r) : "v"(lo), "v"(hi)); return r; }

typedef f32x4 AccT[2][2][4][2];
template <class Epi, class Sched, bool ALIGN_EPI>
__device__ __forceinline__ void gemm_phase(PG8_LAS unsigned char* lds, const Gemm g, const Sched& S, const Epi& E) {
    const int tid = threadIdx.x, wid = __builtin_amdgcn_readfirstlane(tid >> 6), lane = tid & 63, wr = wid >> 2, wc = wid & 3, fr = lane & 15, fq = lane >> 4;
    const int K = g.K, nt = K / BK;
    unsigned voffA[2], voffB[2];
#pragma unroll
    for (int i = 0; i < 2; ++i) { int R, C; stage_rc(tid * 16 + i * 8192, R, C); const int Rb = Epi::PERM ? ((R & ~31) + perm32(R & 31)) : R;
        voffA[i] = (unsigned)(R * g.lda + C) * 2u; voffB[i] = (unsigned)(Rb * g.ldb + C) * 2u; }
    const size_t kstep = (size_t)(BK * 2);
    const size_t hsA = (size_t)HALF * g.lda * 2, hsB = (size_t)HALF * g.ldb * 2;
    const unsigned ldsw = (unsigned)wid * 1024u;
    const int aoff = lds_byte(wr * 64 + fr, fq * 8), boff = lds_byte(wc * 32 + fr, fq * 8);
#define PG8_SA(b, h) (((b) * 2 + (h)) * HTB)
#define PG8_SB(b, h) ((4 + (b) * 2 + (h)) * HTB)
#define PG8_STAGE(bufoff, gbase, voff) do { _Pragma("unroll") for (int _i = 0; _i < 2; ++_i) \
        __builtin_amdgcn_global_load_lds((const unsigned*)((const char*)(gbase) + (voff)[_i]), (PG8_LAS unsigned*)(lds + (bufoff) + ldsw + _i * 8192), 16, 0, 0); } while (0)
#define PG8_LDA(dst, b, h) do { _Pragma("unroll") for (int m = 0; m < 4; ++m) _Pragma("unroll") for (int k = 0; k < 2; ++k) dst[m][k] = *(const PG8_LAS bf16x8*)(lds + PG8_SA(b, h) + aoff + m * 2048 + k * 1024); } while (0)
#define PG8_LDB(dst, b, h) do { _Pragma("unroll") for (int n = 0; n < 2; ++n) _Pragma("unroll") for (int k = 0; k < 2; ++k) dst[n][k] = *(const PG8_LAS bf16x8*)(lds + PG8_SB(b, h) + boff + n * 2048 + k * 1024); } while (0)
#define PG8_MMA(ai, bj, At, Bt) do { __builtin_amdgcn_s_setprio(1); _Pragma("unroll") for (int m = 0; m < 4; ++m) _Pragma("unroll") for (int n = 0; n < 2; ++n) _Pragma("unroll") for (int k = 0; k < 2; ++k) \
        acc[ai][bj][m][n] = __builtin_amdgcn_mfma_f32_16x16x32_bf16(Bt[n][k], At[m][k], acc[ai][bj][m][n], 0, 0, 0); __builtin_amdgcn_s_setprio(0); } while (0)
#define PG8_WAIT_V(n) asm volatile("s_waitcnt vmcnt(" #n ")" ::: "memory")
#define PG8_WAIT_L(n) asm volatile("s_waitcnt lgkmcnt(" #n ")" ::: "memory")
#define PG8_BAR __builtin_amdgcn_s_barrier()
#define PG8_SCHED __builtin_amdgcn_sched_barrier(0)
    Unit cur, nxt; int ui = 0;
    if (!S.next(0, cur)) return;
    f32x4 acc[2][2][4][2];
#pragma unroll
    for (int a = 0; a < 2; ++a)
#pragma unroll
        for (int b = 0; b < 2; ++b)
#pragma unroll
            for (int m = 0; m < 4; ++m)
#pragma unroll
                for (int n = 0; n < 2; ++n) acc[a][b][m][n] = (f32x4){0.f, 0.f, 0.f, 0.f};
    bf16x8 At[4][2], B0[2][2], B1[2][2];
    const char* cA = cur.A; const char* cB = cur.B;
    PG8_STAGE(PG8_SB(0, 0), cB, voffB); PG8_STAGE(PG8_SB(0, 1), cB + hsB, voffB); PG8_STAGE(PG8_SA(0, 0), cA, voffA); PG8_STAGE(PG8_SA(0, 1), cA + hsA, voffA);
    if (wr == 1) PG8_BAR;
    PG8_WAIT_V(2); PG8_BAR;
    PG8_STAGE(PG8_SB(1, 0), cB + kstep, voffB); PG8_STAGE(PG8_SA(1, 0), cA + kstep, voffA); PG8_STAGE(PG8_SB(1, 1), cB + hsB + kstep, voffB);
    PG8_WAIT_V(6); PG8_BAR;
    for (;;) {
        const bool has_next = S.next(ui + 1, nxt);
        const char* nA = has_next ? nxt.A : cA; const char* nB = has_next ? nxt.B : cB;
        for (int t = 0; t < nt; t += 2) {
            const bool last = (t == nt - 2);
            const char* a1 = cA + (size_t)(t + 1) * kstep;
            const char* a2 = last ? nA : cA + (size_t)(t + 2) * kstep; const char* b2 = last ? nB : cB + (size_t)(t + 2) * kstep;
            const char* a3 = a2 + kstep; const char* b3 = b2 + kstep;
            PG8_LDB(B0, 0, 0); PG8_LDB(B1, 0, 1); PG8_SCHED; PG8_LDA(At, 0, 0); PG8_STAGE(PG8_SA(1, 1), a1 + hsA, voffA);
            PG8_WAIT_V(8); PG8_WAIT_L(0); PG8_BAR; PG8_MMA(0, 0, At, B0); PG8_MMA(0, 1, At, B1); PG8_BAR; PG8_SCHED;
            PG8_LDA(At, 0, 1); PG8_STAGE(PG8_SB(0, 0), b2, voffB); PG8_STAGE(PG8_SB(0, 1), b2 + hsB, voffB); PG8_STAGE(PG8_SA(0, 0), a2, voffA);
            PG8_WAIT_V(8); PG8_WAIT_L(0); PG8_BAR; PG8_MMA(1, 0, At, B0); PG8_MMA(1, 1, At, B1); PG8_BAR; PG8_SCHED;
            PG8_LDB(B0, 1, 0); PG8_LDB(B1, 1, 1); PG8_SCHED; PG8_LDA(At, 1, 0); PG8_STAGE(PG8_SA(0, 1), a2 + hsA, voffA);
            PG8_WAIT_V(8); PG8_WAIT_L(0); PG8_BAR; PG8_MMA(0, 0, At, B0); PG8_MMA(0, 1, At, B1); PG8_BAR; PG8_SCHED;
            PG8_LDA(At, 1, 1); PG8_STAGE(PG8_SB(1, 0), b3, voffB); PG8_STAGE(PG8_SB(1, 1), b3 + hsB, voffB); PG8_STAGE(PG8_SA(1, 0), a3, voffA);
            PG8_WAIT_V(8); PG8_WAIT_L(0); PG8_BAR; PG8_MMA(1, 0, At, B0); PG8_MMA(1, 1, At, B1); PG8_BAR; PG8_SCHED;
        }
        if constexpr (ALIGN_EPI) { if (wr == 0) PG8_BAR; }
        E(acc, cur, wr, wc, fr, fq);
        if (!has_next) break;
        if (!(Epi::CHAIN && nxt.sub != 0)) {
#pragma unroll
            for (int a = 0; a < 2; ++a)
#pragma unroll
                for (int b = 0; b < 2; ++b)
#pragma unroll
                    for (int m = 0; m < 4; ++m)
#pragma unroll
                        for (int n = 0; n < 2; ++n) acc[a][b][m][n] = (f32x4){0.f, 0.f, 0.f, 0.f};
        }
        cur = nxt; cA = nA; cB = nB; ++ui;
        if constexpr (ALIGN_EPI) { if (wr == 1) PG8_BAR; }
    }
    PG8_WAIT_V(0);
    if constexpr (!ALIGN_EPI) { if (wr == 0) PG8_BAR; }
    PG8_BAR;
#undef PG8_SA
#undef PG8_SB
#undef PG8_STAGE
#undef PG8_LDA
#undef PG8_LDB
#undef PG8_MMA
#undef PG8_WAIT_V
#undef PG8_WAIT_L
#undef PG8_BAR
#undef PG8_SCHED
}

struct EpiProj {
    static constexpr bool PERM = true, CHAIN = false;
    bf16_t* pb; bf16_t* pa; float* ssq; float* sskv;
    __device__ __forceinline__ void operator()(AccT& acc, const Unit& u, int wr, int wc, int fr, int fq) const {
        const int row0 = u.pm * BM + wr * 64 + fr;
#pragma unroll
        for (int bj = 0; bj < 2; ++bj) {
            const int hk = u.pn * 2 + bj;
            bf16_t* base; int ld; float* ss = nullptr;
            if (hk < 22) { base = pb + hk * 128; ld = PB_LD; } else { const int ha = hk - 22; base = pa + ha * 128; ld = PA_LD; if (ha >= 6 && ha <= 8) ss = ssq; else if (ha == 9 || ha == 10) ss = sskv; }
            base += wc * 32 + 8 * fq;
#pragma unroll
            for (int ai = 0; ai < 2; ++ai)
#pragma unroll
                for (int m = 0; m < 4; ++m) { const int row = row0 + ai * HALF + m * 16; const f32x4 v0 = acc[ai][bj][m][0], v1 = acc[ai][bj][m][1];
                    u32x4 w; w.x = cvt_pk_bf16(v0[0], v0[1]); w.y = cvt_pk_bf16(v0[2], v0[3]); w.z = cvt_pk_bf16(v1[0], v1[1]); w.w = cvt_pk_bf16(v1[2], v1[3]);
                    *(u32x4*)(base + (size_t)row * ld) = w;
                    if (ss) { float s = (v0[0] * v0[0] + v0[1] * v0[1]) + (v0[2] * v0[2] + v0[3] * v0[3]) + (v1[0] * v1[0] + v1[1] * v1[1]) + (v1[2] * v1[2] + v1[3] * v1[3]);
                        s += __shfl_xor(s, 16); s += __shfl_xor(s, 32); if (fq == 0) atomicAdd(ss + row, s); } }
        }
    }
};
struct EpiQ {
    static constexpr bool PERM = false, CHAIN = false;
    bf16_t* Q; const float* ssq; const float* cs; const float* sn;
    __device__ __forceinline__ void operator()(AccT& acc, const Unit& u, int wr, int wc, int fr, int fq) const {
        const int row0 = u.pm * BM + wr * 64 + fr;
#pragma unroll
        for (int ai = 0; ai < 2; ++ai)
#pragma unroll
            for (int m = 0; m < 4; ++m) { const int row = row0 + ai * HALF + m * 16; const float rr = rsqrtf(ssq[row] * (1.f / 384.f) + EPS) * CQ;
#pragma unroll
                for (int bj = 0; bj < 2; ++bj) { const int G = u.pn * 8 + bj * 4 + wc;
                    f32x4 x0 = acc[ai][bj][m][0], x1 = acc[ai][bj][m][1];
                    if (G % 3 == 2) { const f32x4 c = *(const f32x4*)(cs + (size_t)row * 16 + 4 * fq), s = *(const f32x4*)(sn + (size_t)row * 16 + 4 * fq);
                        const f32x4 o0 = x0 * c - x1 * s, o1 = x1 * c + x0 * s; x0 = o0; x1 = o1; }
                    x0 = x0 * rr; x1 = x1 * rr;
                    bf16_t* p = Q + (size_t)row * 768 + G * 32 + 4 * fq;
                    u32x2 w0, w1; w0.x = cvt_pk_bf16(x0[0], x0[1]); w0.y = cvt_pk_bf16(x0[2], x0[3]); w1.x = cvt_pk_bf16(x1[0], x1[1]); w1.y = cvt_pk_bf16(x1[2], x1[3]);
                    *(u32x2*)p = w0; *(u32x2*)(p + 16) = w1; } }
    }
};
struct EpiKV {
    static constexpr bool PERM = true, CHAIN = false;
    bf16_t* Kb; bf16_t* Vb; const float* sskv;
    __device__ __forceinline__ void operator()(AccT& acc, const Unit& u, int wr, int wc, int fr, int fq) const {
        const int row0 = u.pm * BM + wr * 64 + fr;
#pragma unroll
        for (int ai = 0; ai < 2; ++ai)
#pragma unroll
            for (int m = 0; m < 4; ++m) { const int row = row0 + ai * HALF + m * 16; const float rr = rsqrtf(sskv[row] * (1.f / 256.f) + EPS);
#pragma unroll
                for (int bj = 0; bj < 2; ++bj) { const int head = u.pn * 2 + bj; const f32x4 v0 = acc[ai][bj][m][0] * rr, v1 = acc[ai][bj][m][1] * rr;
                    u32x4 w; w.x = cvt_pk_bf16(v0[0], v0[1]); w.y = cvt_pk_bf16(v0[2], v0[3]); w.z = cvt_pk_bf16(v1[0], v1[1]); w.w = cvt_pk_bf16(v1[2], v1[3]);
                    bf16_t* p = (wc < 2) ? Kb + (size_t)row * 768 + head * 96 + wc * 32 + 8 * fq : Vb + (size_t)row * 512 + head * 64 + (wc - 2) * 32 + 8 * fq;
                    *(u32x4*)p = w; } }
    }
};
struct EpiMerge {
    static constexpr bool PERM = true, CHAIN = true;
    const bf16_t* pb; bf16_t* merged;
    __device__ __forceinline__ void operator()(AccT& acc, const Unit& u, int wr, int wc, int fr, int fq) const {
        const int row0 = u.pm * BM + wr * 64 + fr, col0 = u.pn * BM + wc * 32 + 8 * fq;
#pragma unroll
        for (int ai = 0; ai < 2; ++ai)
#pragma unroll
            for (int m = 0; m < 4; ++m) { const int row = row0 + ai * HALF + m * 16;
#pragma unroll
                for (int bj = 0; bj < 2; ++bj) { const int col = col0 + bj * HALF;
                    const u32x4 gb = *(const u32x4*)(pb + (size_t)row * PB_LD + PB_BR + 1024 + col);
                    float eb[8];
#pragma unroll
                    for (int e = 0; e < 4; ++e) { eb[2 * e] = 1.f + __builtin_amdgcn_exp2f(__uint_as_float(gb[e] << 16) * -1.4426950408889634f); eb[2 * e + 1] = 1.f + __builtin_amdgcn_exp2f(__uint_as_float(gb[e] & 0xffff0000u) * -1.4426950408889634f); }
                    if (u.sub == 0) {
                        const u32x4 ga = *(const u32x4*)(pb + (size_t)row * PB_LD + PB_BR + col);
#pragma unroll
                        for (int e = 0; e < 4; ++e) { const float ea0 = 1.f + __builtin_amdgcn_exp2f(__uint_as_float(ga[e] << 16) * -1.4426950408889634f), ea1 = 1.f + __builtin_amdgcn_exp2f(__uint_as_float(ga[e] & 0xffff0000u) * -1.4426950408889634f);
                            const int i0 = 2 * e, i1 = 2 * e + 1;
                            acc[ai][bj][m][i0 >> 2][i0 & 3] *= eb[i0] * __builtin_amdgcn_rcpf(ea0); acc[ai][bj][m][i1 >> 2][i1 & 3] *= eb[i1] * __builtin_amdgcn_rcpf(ea1); }
                    } else {
                        const f32x4 v0 = acc[ai][bj][m][0], v1 = acc[ai][bj][m][1];
                        float sb[8];
#pragma unroll
                        for (int e = 0; e < 8; ++e) sb[e] = __builtin_amdgcn_rcpf(eb[e]);
                        u32x4 w; w.x = cvt_pk_bf16(v0[0] * sb[0], v0[1] * sb[1]); w.y = cvt_pk_bf16(v0[2] * sb[2], v0[3] * sb[3]); w.z = cvt_pk_bf16(v1[0] * sb[4], v1[1] * sb[5]); w.w = cvt_pk_bf16(v1[2] * sb[6], v1[3] * sb[7]);
                        *(u32x4*)(merged + (size_t)row * DM + col) = w; } } }
    }
};
struct EpiX1 {
    static constexpr bool PERM = false, CHAIN = false;
    const float* x; float* x1; bf16_t* x1b; float* ssx1;
    __device__ __forceinline__ void operator()(AccT& acc, const Unit& u, int wr, int wc, int fr, int fq) const {
        const int row0 = u.pm * BM + wr * 64 + fr, col0 = u.pn * BM + wc * 32 + 4 * fq;
#pragma unroll
        for (int ai = 0; ai < 2; ++ai)
#pragma unroll
            for (int m = 0; m < 4; ++m) { const int row = row0 + ai * HALF + m * 16; const size_t off = (size_t)row * DM + col0; float s = 0.f;
#pragma unroll
                for (int bj = 0; bj < 2; ++bj)
#pragma unroll
                    for (int n = 0; n < 2; ++n) { const size_t o = off + bj * HALF + n * 16; const f32x4 v = *(const f32x4*)(x + o) + acc[ai][bj][m][n];
                        *(f32x4*)(x1 + o) = v; u32x2 w; w.x = cvt_pk_bf16(v[0], v[1]); w.y = cvt_pk_bf16(v[2], v[3]); *(u32x2*)(x1b + o) = w;
                        s += (v[0] * v[0] + v[1] * v[1]) + (v[2] * v[2] + v[3] * v[3]); }
                s += __shfl_xor(s, 16); s += __shfl_xor(s, 32); if (fq == 0) atomicAdd(ssx1 + row, s); }
    }
};
struct EpiQP {
    static constexpr bool PERM = true, CHAIN = false;
    bf16_t* qp; const float* ssx1;
    __device__ __forceinline__ void operator()(AccT& acc, const Unit& u, int wr, int wc, int fr, int fq) const {
        const int row0 = u.pm * BM + wr * 64 + fr, col0 = u.pn * BM + wc * 32 + 8 * fq;
#pragma unroll
        for (int ai = 0; ai < 2; ++ai)
#pragma unroll
            for (int m = 0; m < 4; ++m) { const int row = row0 + ai * HALF + m * 16; const float rr = rsqrtf(ssx1[row] * (1.f / 1024.f) + EPS);
#pragma unroll
                for (int bj = 0; bj < 2; ++bj) { const f32x4 v0 = acc[ai][bj][m][0] * rr, v1 = acc[ai][bj][m][1] * rr;
                    u32x4 w; w.x = cvt_pk_bf16(v0[0], v0[1]); w.y = cvt_pk_bf16(v0[2], v0[3]); w.z = cvt_pk_bf16(v1[0], v1[1]); w.w = cvt_pk_bf16(v1[2], v1[3]);
                    *(u32x4*)(qp + (size_t)row * 2048 + col0 + bj * HALF) = w; } }
    }
};
}


namespace att {
typedef short bf16x8 __attribute__((ext_vector_type(8)));
typedef short s16x4 __attribute__((ext_vector_type(4)));
typedef float f32x16 __attribute__((ext_vector_type(16)));
constexpr int NW = 8, QBLK = 32, KVBLK = 64, QB = NW * QBLK;
constexpr int QS = 768, KS = 768, VS = 512, OS = 512;
constexpr int SHM_V = KVBLK * 64 * 2, SHM_K = KVBLK * 256;
constexpr int LDS_BYTES = 2 * SHM_V + 2 * SHM_K + NW * 64 * 4;
constexpr float THR = 8.f;
#define KSWZ(row, colB) ((row) * 256 + ((colB) ^ (((row) & 15) << 4)))
#define SBAR() __builtin_amdgcn_sched_barrier(0)
__device__ __forceinline__ int v_st(int k, int c) { const int kk = (k & ~0xC) | ((k & 4) << 1) | ((k & 8) >> 1); return ((kk >> 3) * 2 + (c >> 5)) * 512 + ((kk & 7) * 32 + (c & 31)) * 2; }
__device__ __forceinline__ int v_rd_base(int lane) { return ((lane & 3) << 3) | (((lane >> 2) & 3) << 6) | (((lane >> 4) & 1) << 5) | (((lane >> 5) & 1) << 8); }
constexpr int v_rd_off(int d0, int ks, int half) { return d0 * 512 + ks * 2048 + half * 1024; }
__device__ __forceinline__ int crow(int r, int hi) { return (r & 3) + 8 * (r >> 2) + 4 * hi; }
__device__ __forceinline__ unsigned cvtpk(float lo, float hi) { unsigned r; asm volatile("v_cvt_pk_bf16_f32 %0, %1, %2" : "=v"(r) : "v"(lo), "v"(hi)); return r; }
__device__ __forceinline__ bf16x8 load8(const bf16_t* p) { return *reinterpret_cast<const bf16x8*>(p); }
__device__ __forceinline__ void partialSM(f32x16& p0, f32x16& p1, float& m_reg, float& mn, float& alpha) {
    float pmax = p0[0]; for (int r = 1; r < 16; ++r) pmax = fmaxf(pmax, p0[r]); for (int r = 0; r < 16; ++r) pmax = fmaxf(pmax, p1[r]);
    { auto rr = __builtin_amdgcn_permlane32_swap(__float_as_uint(pmax), __float_as_uint(pmax), false, false);
      pmax = fmaxf(__uint_as_float(rr[0]), __uint_as_float(rr[1])); }
    if (__builtin_expect(__all((pmax - m_reg) <= THR), 1)) { mn = m_reg; alpha = 1.f; }
    else { mn = fmaxf(m_reg, pmax); alpha = __builtin_amdgcn_exp2f(m_reg - mn); m_reg = mn; }
    for (int r = 0; r < 16; ++r) p0[r] = p0[r] - mn; for (int r = 0; r < 16; ++r) p1[r] = p1[r] - mn;
    for (int r = 0; r < 16; ++r) p0[r] = __builtin_amdgcn_exp2f(p0[r]);
}
__device__ __forceinline__ void finishSM(f32x16& p0, f32x16& p1, float alpha, float& l_reg, bf16x8& pa0, bf16x8& pa1, bf16x8& pa2, bf16x8& pa3) {
    for (int r = 0; r < 16; ++r) p1[r] = __builtin_amdgcn_exp2f(p1[r]);
    float ps = 0; for (int r = 0; r < 16; ++r) ps += p0[r]; for (int r = 0; r < 16; ++r) ps += p1[r];
    { auto rr = __builtin_amdgcn_permlane32_swap(__float_as_uint(ps), __float_as_uint(ps), false, false);
      ps = __uint_as_float(rr[0]) + __uint_as_float(rr[1]); }
    l_reg = l_reg * alpha + ps;
#define PK4(P, B_, OUT) do { unsigned a0 = cvtpk(P[B_+0], P[B_+1]), a1 = cvtpk(P[B_+2], P[B_+3]);                          \
        unsigned b0 = cvtpk(P[B_+4], P[B_+5]), b1 = cvtpk(P[B_+6], P[B_+7]);                                             \
        auto r0 = __builtin_amdgcn_permlane32_swap(a0, b0, false, false); auto r1 = __builtin_amdgcn_permlane32_swap(a1, b1, false, false); \
        u32x4 w = {r0[0], r1[0], r0[1], r1[1]}; OUT = *reinterpret_cast<bf16x8*>(&w); } while (0)
    PK4(p0, 0, pa0); PK4(p0, 8, pa1); PK4(p1, 0, pa2); PK4(p1, 8, pa3);
#undef PK4
}
template <int KB>
__device__ __forceinline__ void qkt(f32x16& p0, f32x16& p1, const char* K_lds, int r32, int hi, const bf16x8* qr) {
    p0 = f32x16{}; p1 = f32x16{};
#pragma unroll
    for (int d0 = 0; d0 < 6; ++d0) { const char* a = K_lds + KB * SHM_K + KSWZ(r32, (d0 * 16 + hi * 8) * 2);
        bf16x8 b0 = *reinterpret_cast<const bf16x8*>(a);
        bf16x8 b1 = *reinterpret_cast<const bf16x8*>(a + 32 * 256);
        p0 = __builtin_amdgcn_mfma_f32_32x32x16_bf16(b0, qr[d0], p0, 0, 0, 0);
        p1 = __builtin_amdgcn_mfma_f32_32x32x16_bf16(b1, qr[d0], p1, 0, 0, 0); }
}
template <int VB>
__device__ __forceinline__ void pv_tile(f32x16* o, int vb0, bf16x8 pa0, bf16x8 pa1, bf16x8 pa2, bf16x8 pa3) {
#define TRRD(dst, off) asm volatile("ds_read_b64_tr_b16 %0, %1 offset:%2" : "=&v"(dst) : "v"(vb0), "i"(off) : "memory")
#define PV_D0(d0) do { s16x4 l0, l1, l2, l3, h0, h1, h2, h3; constexpr int b_ = VB * SHM_V + v_rd_off(d0, 0, 0);   \
        TRRD(l0, b_); TRRD(h0, b_ + 1024); TRRD(l1, b_ + 2048); TRRD(h1, b_ + 3072); TRRD(l2, b_ + 4096); TRRD(h2, b_ + 5120); TRRD(l3, b_ + 6144); TRRD(h3, b_ + 7168); \
        asm volatile("s_waitcnt lgkmcnt(0)" ::: "memory"); SBAR();   \
        o[d0] = __builtin_amdgcn_mfma_f32_32x32x16_bf16(pa0, (bf16x8){l0[0], l0[1], l0[2], l0[3], h0[0], h0[1], h0[2], h0[3]}, o[d0], 0, 0, 0);   \
        o[d0] = __builtin_amdgcn_mfma_f32_32x32x16_bf16(pa1, (bf16x8){l1[0], l1[1], l1[2], l1[3], h1[0], h1[1], h1[2], h1[3]}, o[d0], 0, 0, 0);   \
        o[d0] = __builtin_amdgcn_mfma_f32_32x32x16_bf16(pa2, (bf16x8){l2[0], l2[1], l2[2], l2[3], h2[0], h2[1], h2[2], h2[3]}, o[d0], 0, 0, 0);   \
        o[d0] = __builtin_amdgcn_mfma_f32_32x32x16_bf16(pa3, (bf16x8){l3[0], l3[1], l3[2], l3[3], h3[0], h3[1], h3[2], h3[3]}, o[d0], 0, 0, 0); } while (0)
    PV_D0(0); PV_D0(1);
#undef PV_D0
#undef TRRD
}
struct BlockRef { const bf16_t* Q; const bf16_t* K; const bf16_t* KPE; const bf16_t* V; bf16_t* O; int P0; };
struct Seam { bf16x8 qr[6]; bf16x8 st_v0, st_v1, st_k0, st_k1; };
#define ROWK(p, k0, rr) ((p) + (size_t)((k0) + (rr)) * kstr)
#define ROWV(p, k0, rr) ((p) + (size_t)((k0) + (rr)) * VS + sc)
#define VMW() asm volatile("s_waitcnt vmcnt(0)" ::: "memory")
#define VMWN(n) asm volatile("s_waitcnt vmcnt(%0)" :: "i"(n) : "memory")
#define SLOAD_H(Kp, Vp, k0) do { if (vact) { S.st_v0 = load8(ROWV(Vp, k0, sr)); S.st_v1 = load8(ROWV(Vp, k0, 32 + sr)); }              \
                                 if (kact) { S.st_k0 = load8(ROWK(Kp, k0, sr)); S.st_k1 = load8(ROWK(Kp, k0, 32 + sr)); } } while (0)
#define SWRITE_HK(bf) do { if (kact) { *(bf16x8*)(K_lds + (bf) * SHM_K + kws) = S.st_k0; *(bf16x8*)(K_lds + (bf) * SHM_K + kws + 32 * 256) = S.st_k1; } } while (0)
#define SWRITE_HV(bf) do { if (vact) { *(bf16x8*)(V_lds + (bf) * SHM_V + vst0) = S.st_v0; *(bf16x8*)(V_lds + (bf) * SHM_V + vst1) = S.st_v1; } } while (0)
#define SWRITE_H(bf) do { SWRITE_HV(bf); SWRITE_HK(bf); } while (0)
__device__ __forceinline__ void attn_prime(const BlockRef& cur, char* lds, Seam& S) {
    const int tid = threadIdx.x, wid = __builtin_amdgcn_readfirstlane(tid >> 6), lane = tid & 63, r32 = lane & 31, hi = lane >> 5;
    const int sr = tid >> 4, sc = (tid & 15) * 8, kws = KSWZ(sr, sc * 2); char* K_lds = lds + 2 * SHM_V;
    const bool kact = (tid & 15) < 12, vact = (tid & 15) < 8;
#pragma unroll
    for (int d0 = 0; d0 < 6; ++d0) S.qr[d0] = load8(cur.Q + (size_t)(wid * QBLK + r32) * QS + d0 * 16 + hi * 8);
    const bf16_t* kp0 = (tid & 15) < 8 ? cur.K + sc : cur.KPE + (sc - 64); const int kstr = (tid & 15) < 8 ? KS : 32;
    SLOAD_H(kp0, cur.V, 0); VMW(); SWRITE_HK(0);
    __syncthreads();
}
__device__ __forceinline__ void attn_block(const BlockRef& cur, const BlockRef& nxt, char* lds, Seam& S) {
    const int tid = threadIdx.x, wid = __builtin_amdgcn_readfirstlane(tid >> 6), lane = tid & 63, r32 = lane & 31, hi = lane >> 5;
    const int NT = (cur.P0 + QB - 1) / KVBLK + 1;
    const int qlo = cur.P0 + wid * QBLK;
    const int qvis = qlo | 63;
    char* V_lds = lds; char* K_lds = lds + 2 * SHM_V;
    float* ws = (float*)(lds + 2 * SHM_V + 2 * SHM_K) + wid * 64; float* li_l = ws, * al_l = ws + 32;
    float m_reg = -1e30f, l_reg = 0; f32x16 o[2] = {};
    const int sr = tid >> 4, sc = (tid & 15) * 8, vst0 = v_st(sr, sc & 63), vst1 = v_st(32 + sr, sc & 63), kws = KSWZ(sr, sc * 2);
    const bool kact = (tid & 15) < 12, vact = (tid & 15) < 8;
    const int vb0 = (int)(uintptr_t)V_lds + v_rd_base(lane);
    const int kstr = (tid & 15) < 8 ? KS : 32;
    const bf16_t* Kh = (tid & 15) < 8 ? cur.K + sc : cur.KPE + (sc - 64); const bf16_t* Vh = cur.V;
    const bf16_t* Knx = (tid & 15) < 8 ? nxt.K + sc : nxt.KPE + (sc - 64);
#define RESC(a) do { if (__any((a) < 1.f)) { if (hi == 0) al_l[r32] = (a); asm volatile("s_waitcnt lgkmcnt(0)" ::: "memory");              \
                     for (int d_ = 0; d_ < 2; ++d_) for (int r = 0; r < 16; ++r) o[d_][r] *= al_l[crow(r, hi)]; } } while (0)
#define KBASE(t) ((t) * KVBLK)
#define MASKT(P0_, P1_, t) do { if (__builtin_amdgcn_readfirstlane((int)(KBASE(t) > qvis))) { const float NEG_ = -__builtin_inff(); _Pragma("unroll") for (int r = 0; r < 16; ++r) { P0_[r] = NEG_; P1_[r] = NEG_; } asm volatile("" : "+v"(P0_), "+v"(P1_)); } } while (0)
    constexpr int NQL = 6;
#define SEAM_K0() do { VMWN(NQL); SWRITE_HK(0); SBAR(); } while (0)
    f32x16 pA0, pA1, pB0, pB1; float mnA, mnB, alA, alB; bf16x8 pa0, pa1, pa2, pa3;
    SWRITE_HV(0); SBAR();
    if (NT > 1) { SLOAD_H(Kh, Vh, KBASE(1)); }
    SBAR(); qkt<0>(pA0, pA1, K_lds, r32, hi, S.qr);
    MASKT(pA0, pA1, 0); partialSM(pA0, pA1, m_reg, mnA, alA);
    if (NT > 1) { VMW(); SWRITE_H(1); }
    __syncthreads();
#define HALF_STEP(PX0, PX1, mnX, alX, PY0, PY1, alY, t, KB, VB, SB) do {                                                      \
        SBAR(); qkt<KB>(PX0, PX1, K_lds, r32, hi, S.qr);                                             \
        finishSM(PY0, PY1, alY, l_reg, pa0, pa1, pa2, pa3); SBAR();                                                           \
        if ((t) + 1 < NT) { SLOAD_H(Kh, Vh, KBASE((t) + 1)); SBAR(); }                                               \
        pv_tile<VB>(o, vb0, pa0, pa1, pa2, pa3); MASKT(PX0, PX1, (t)); partialSM(PX0, PX1, m_reg, mnX, alX);                                        \
        __syncthreads();                                                                                                      \
        if ((t) + 1 < NT) { VMW(); SWRITE_H(SB); }                                                                          \
        RESC(alX); __syncthreads(); } while (0)
    for (int t = 1; t + 1 < NT; t += 2) {
        HALF_STEP(pB0, pB1, mnB, alB, pA0, pA1, alA, t, 1, 0, 0);
        HALF_STEP(pA0, pA1, mnA, alA, pB0, pB1, alB, t + 1, 0, 1, 1);
    }
    const bool even = (NT & 1) == 0;
    if (even) { SBAR(); qkt<1>(pB0, pB1, K_lds, r32, hi, S.qr); SBAR(); }
    SLOAD_H(Knx, nxt.V, 0); SBAR();
#pragma unroll
    for (int d0 = 0; d0 < 6; ++d0) S.qr[d0] = load8(nxt.Q + (size_t)(wid * QBLK + r32) * QS + d0 * 16 + hi * 8);
    SBAR();
    finishSM(pA0, pA1, alA, l_reg, pa0, pa1, pa2, pa3); SBAR();
    pv_tile<0>(o, vb0, pa0, pa1, pa2, pa3);
    if (even) { MASKT(pB0, pB1, NT - 1); partialSM(pB0, pB1, m_reg, mnB, alB); __syncthreads(); RESC(alB);
        finishSM(pB0, pB1, alB, l_reg, pa0, pa1, pa2, pa3); SBAR(); pv_tile<1>(o, vb0, pa0, pa1, pa2, pa3); }
    SBAR(); SEAM_K0();
    if (hi == 0) li_l[r32] = l_reg; asm volatile("s_waitcnt lgkmcnt(0)" ::: "memory");
    float rli[16];
#pragma unroll
    for (int r = 0; r < 16; ++r) rli[r] = __builtin_amdgcn_rcpf(li_l[crow(r, hi)]);
    bf16_t* Ow = cur.O + (size_t)(wid * QBLK) * OS;
#pragma unroll
    for (int r = 0; r < 16; ++r) { const int orow = crow(r, hi);
#pragma unroll
        for (int d0 = 0; d0 < 2; ++d0) { const float v = o[d0][r] * rli[r];
            const float vn = __shfl_xor(v, 1);
            if ((r32 & 1) == 0) *(unsigned*)(Ow + (size_t)orow * OS + d0 * 32 + r32) = cvtpk(v, vn); } }
    __syncthreads();
#undef RESC
#undef KBASE
#undef MASKT
#undef SEAM_K0
#undef HALF_STEP
}


__device__ __forceinline__ void partialSM_rel(f32x16& p0, f32x16& p1, float& m_ref, f32x16& negm, float& alpha) {
    float pmax = p0[0]; for (int r = 1; r < 16; ++r) pmax = fmaxf(pmax, p0[r]); for (int r = 0; r < 16; ++r) pmax = fmaxf(pmax, p1[r]);
    { auto rr = __builtin_amdgcn_permlane32_swap(__float_as_uint(pmax), __float_as_uint(pmax), false, false);
      pmax = fmaxf(__uint_as_float(rr[0]), __uint_as_float(rr[1])); }
    if (__builtin_expect(__all(pmax <= THR), 1)) { alpha = 1.f; }
    else { const float d = fmaxf(pmax, 0.f); alpha = __builtin_amdgcn_exp2f(-d); m_ref += d;
        for (int r = 0; r < 16; ++r) { p0[r] -= d; p1[r] -= d; }
        for (int r = 0; r < 16; ++r) negm[r] = -m_ref; asm volatile("" : "+v"(negm)); }
    for (int r = 0; r < 16; ++r) p0[r] = __builtin_amdgcn_exp2f(p0[r]);
}

__device__ __forceinline__ void finishSM_direct(f32x16& p0, f32x16& p1, float alpha, float& l_reg, bf16x8& pa0, bf16x8& pa1, bf16x8& pa2, bf16x8& pa3) {
    for (int r = 0; r < 16; ++r) p1[r] = __builtin_amdgcn_exp2f(p1[r]);
    float ps = 0; for (int r = 0; r < 16; ++r) ps += p0[r]; for (int r = 0; r < 16; ++r) ps += p1[r];
    { auto rr = __builtin_amdgcn_permlane32_swap(__float_as_uint(ps), __float_as_uint(ps), false, false);
      ps = __uint_as_float(rr[0]) + __uint_as_float(rr[1]); }
    l_reg = l_reg * alpha + ps;
#define PK8(P, B_, OUT) do { u32x4 w = {cvtpk(P[B_+0], P[B_+1]), cvtpk(P[B_+2], P[B_+3]), cvtpk(P[B_+4], P[B_+5]), cvtpk(P[B_+6], P[B_+7])}; OUT = *reinterpret_cast<bf16x8*>(&w); } while (0)
    PK8(p0, 0, pa0); PK8(p0, 8, pa1); PK8(p1, 0, pa2); PK8(p1, 8, pa3);
#undef PK8
}

#define TRRD2(dst, vb, off) asm volatile("ds_read_b64_tr_b16 %0, %1 offset:%2" : "=&v"(dst) : "v"(vb), "i"(off) : "memory")
struct VFrag { s16x4 l0, l1, l2, l3, h0, h1, h2, h3; };
__device__ __forceinline__ void pv_issue(VFrag& f, int vb, int d0off) {
    if (d0off == 0) { TRRD2(f.l0, vb, 0); TRRD2(f.h0, vb, 1024); TRRD2(f.l1, vb, 2048); TRRD2(f.h1, vb, 3072); TRRD2(f.l2, vb, 4096); TRRD2(f.h2, vb, 5120); TRRD2(f.l3, vb, 6144); TRRD2(f.h3, vb, 7168); }
    else { TRRD2(f.l0, vb, 512); TRRD2(f.h0, vb, 1536); TRRD2(f.l1, vb, 2560); TRRD2(f.h1, vb, 3584); TRRD2(f.l2, vb, 4608); TRRD2(f.h2, vb, 5632); TRRD2(f.l3, vb, 6656); TRRD2(f.h3, vb, 7680); }
}
#define VF8(f, k) (bf16x8){f.l##k[0], f.l##k[1], f.l##k[2], f.l##k[3], f.h##k[0], f.h##k[1], f.h##k[2], f.h##k[3]}
__device__ __forceinline__ void pv_mma(f32x16& o, const VFrag& f, bf16x8 pa0, bf16x8 pa1, bf16x8 pa2, bf16x8 pa3) {
    o = __builtin_amdgcn_mfma_f32_32x32x16_bf16(pa0, VF8(f, 0), o, 0, 0, 0); o = __builtin_amdgcn_mfma_f32_32x32x16_bf16(pa1, VF8(f, 1), o, 0, 0, 0);
    o = __builtin_amdgcn_mfma_f32_32x32x16_bf16(pa2, VF8(f, 2), o, 0, 0, 0); o = __builtin_amdgcn_mfma_f32_32x32x16_bf16(pa3, VF8(f, 3), o, 0, 0, 0);
}
constexpr int D_V = 0, D_K = 4 * SHM_V, D_WS = D_K + 3 * SHM_K, D_Q = D_WS + NW * 64 * 4, D_BYTES = D_Q + NW * 6144;
__device__ __forceinline__ void qkt_rt(f32x16& p0, f32x16& p1, const char* Kslot, int r32, int hi, const char* qfr  , const f32x16& negm) {
    p0 = negm; p1 = negm;
#pragma unroll
    for (int d0 = 0; d0 < 6; ++d0) { const char* a = Kslot + KSWZ(r32, (d0 * 16 + hi * 8) * 2);
        bf16x8 b0 = *reinterpret_cast<const bf16x8*>(a);
        bf16x8 b1 = *reinterpret_cast<const bf16x8*>(a + 32 * 256);
        const bf16x8 q = *reinterpret_cast<const bf16x8*>(qfr + d0 * 1024);
        p0 = __builtin_amdgcn_mfma_f32_32x32x16_bf16(b0, q, p0, 0, 0, 0);
        p1 = __builtin_amdgcn_mfma_f32_32x32x16_bf16(b1, q, p1, 0, 0, 0); }
}

__device__ __forceinline__ void qkt_pipe(f32x16& p0, f32x16& p1, int kbase  , const int (&koff)[6], int qaddr, const f32x16& negm) {
    p0 = negm; p1 = negm;
    bf16x8 ka[3], kb[3], qq[3];
#define QK_LD(set, d0) asm volatile("ds_read_b128 %0, %3\n\tds_read_b128 %1, %3 offset:8192\n\tds_read_b128 %2, %4 offset:%5" : "=&v"(ka[set]), "=&v"(kb[set]), "=&v"(qq[set]) : "v"(kbase + koff[d0]), "v"(qaddr), "i"((d0) * 1024) : "memory")
#define QK_MM(set) do { p0 = __builtin_amdgcn_mfma_f32_32x32x16_bf16(ka[set], qq[set], p0, 0, 0, 0); p1 = __builtin_amdgcn_mfma_f32_32x32x16_bf16(kb[set], qq[set], p1, 0, 0, 0); } while (0)
    QK_LD(0, 0); QK_LD(1, 1); QK_LD(2, 2);
    asm volatile("s_waitcnt lgkmcnt(6)" ::: "memory"); SBAR(); QK_MM(0); SBAR(); QK_LD(0, 3);
    asm volatile("s_waitcnt lgkmcnt(6)" ::: "memory"); SBAR(); QK_MM(1); SBAR(); QK_LD(1, 4);
    asm volatile("s_waitcnt lgkmcnt(6)" ::: "memory"); SBAR(); QK_MM(2); SBAR(); QK_LD(2, 5);
    asm volatile("s_waitcnt lgkmcnt(6)" ::: "memory"); SBAR(); QK_MM(0); SBAR();
    asm volatile("s_waitcnt lgkmcnt(3)" ::: "memory"); SBAR(); QK_MM(1); SBAR();
    asm volatile("s_waitcnt lgkmcnt(0)" ::: "memory"); SBAR(); QK_MM(2); SBAR();
#undef QK_LD
#undef QK_MM
}
__device__ __forceinline__ void attn_block_dma(const BlockRef& cur, char* lds) {
    typedef __attribute__((address_space(3))) unsigned lds_u32;
    const int tid = threadIdx.x, wid = __builtin_amdgcn_readfirstlane(tid >> 6), lane = tid & 63, r32 = lane & 31, hi = lane >> 5;
    const int NT = (cur.P0 + QB - 1) / KVBLK + 1;
    const int qlo = cur.P0 + wid * QBLK, qvis = qlo | 63;
    float* ws = (float*)(lds + D_WS) + wid * 64; float* li_l = ws, * al_l = ws + 32;
    float m_reg = 0.f, l_reg = 0; f32x16 o[2] = {}; f32x16 negm = {}; asm volatile("" : "+v"(negm));
    const int vb0 = (int)(uintptr_t)(lds + D_V) + v_rd_base(lane);
    const bf16_t* ksrc[2]; int kstep[2];
#pragma unroll
    for (int j = 0; j < 2; ++j) { const int row = 4 * (2 * wid + j) + (lane >> 4), chunk = (lane & 15) ^ (row & 15);
        if (chunk >= 8 && chunk < 12) { ksrc[j] = cur.KPE + (size_t)row * 32 + (chunk - 8) * 8; kstep[j] = KVBLK * 32; }
        else { ksrc[j] = cur.K + (size_t)row * KS + (chunk < 8 ? chunk * 8 : 0); kstep[j] = KVBLK * KS; } }
    const bf16_t* vsrc; { const int k = wid * 8 + ((lane & 31) >> 2); vsrc = cur.V + (size_t)k * VS + (lane >> 5) * 32 + (lane & 3) * 8; }
#define DMA_TILE(t) do { const int ks_ = (t) % 3, vs_ = (t) & 3; \
        __builtin_amdgcn_global_load_lds((const unsigned*)(ksrc[0] + (size_t)(t) * kstep[0]), (lds_u32*)(lds + D_K + ks_ * SHM_K + (2 * wid) * 1024), 16, 0, 0); \
        __builtin_amdgcn_global_load_lds((const unsigned*)(ksrc[1] + (size_t)(t) * kstep[1]), (lds_u32*)(lds + D_K + ks_ * SHM_K + (2 * wid + 1) * 1024), 16, 0, 0); \
        __builtin_amdgcn_global_load_lds((const unsigned*)(vsrc + (size_t)(t) * KVBLK * VS), (lds_u32*)(lds + D_V + vs_ * SHM_V + wid * 1024), 16, 0, 0); } while (0)
#define WAITV(n) asm volatile("s_waitcnt vmcnt(" #n ")" ::: "memory")
#define BAR() do { asm volatile("s_waitcnt lgkmcnt(0)" ::: "memory"); __builtin_amdgcn_s_barrier(); asm volatile("" ::: "memory"); SBAR(); } while (0)
#define RESC(a) do { if (__any((a) < 1.f)) { if (hi == 0) al_l[r32] = (a); asm volatile("s_waitcnt lgkmcnt(0)" ::: "memory");              \
                     for (int d_ = 0; d_ < 2; ++d_) for (int r = 0; r < 16; ++r) o[d_][r] *= al_l[crow(r, hi)]; } } while (0)
#define MASKT(P0_, P1_, t) do { if (__builtin_amdgcn_readfirstlane((int)((t) * KVBLK > qvis))) { const float NEG_ = -__builtin_inff(); _Pragma("unroll") for (int r = 0; r < 16; ++r) { P0_[r] = NEG_; P1_[r] = NEG_; } asm volatile("" : "+v"(P0_), "+v"(P1_)); } } while (0)
    char* qfr = lds + D_Q + wid * 6144 + lane * 16; const int qaddr = (int)(uintptr_t)qfr; const int kbase0 = (int)(uintptr_t)(lds + D_K);
    int koff[6];
#pragma unroll
    for (int d0 = 0; d0 < 6; ++d0) koff[d0] = KSWZ(r32, (d0 * 16 + hi * 8) * 2);
    { bf16x8 qr[6];
#pragma unroll
      for (int d0 = 0; d0 < 6; ++d0) qr[d0] = load8(cur.Q + (size_t)(wid * QBLK + r32) * QS + d0 * 16 + hi * 8);
#pragma unroll
      for (int d0 = 0; d0 < 6; ++d0) *reinterpret_cast<bf16x8*>(qfr + d0 * 1024) = qr[d0]; }
    asm volatile("s_waitcnt vmcnt(0) lgkmcnt(0)" ::: "memory");
    DMA_TILE(0); DMA_TILE(1);
    WAITV(3); BAR();
    f32x16 pA0, pA1, pB0, pB1; float mnA, mnB, alA, alB; bf16x8 pa0, pa1, pa2, pa3;
    DMA_TILE(2);
    qkt_pipe(pA0, pA1, kbase0, koff, qaddr, negm);
    MASKT(pA0, pA1, 0); partialSM_rel(pA0, pA1, m_reg, negm, alA);
    WAITV(3); BAR();
#define STEP(PX0, PX1, mnX, alX, PY0, PY1, alY, t) do { \
        if ((t) + 2 < NT) DMA_TILE((t) + 2); \
        SBAR(); { VFrag f0_, f1_; const int vb_ = vb0 + (((t) - 1) & 3) * SHM_V; \
        qkt_pipe(PX0, PX1, kbase0 + ((t) % 3) * SHM_K, koff, qaddr, negm); SBAR(); pv_issue(f0_, vb_, 0); pv_issue(f1_, vb_, 512);     \
        finishSM_direct(PY0, PY1, alY, l_reg, pa0, pa1, pa2, pa3); SBAR(); \
        asm volatile("s_waitcnt lgkmcnt(0)" ::: "memory"); SBAR(); pv_mma(o[0], f0_, pa0, pa1, pa2, pa3); pv_mma(o[1], f1_, pa0, pa1, pa2, pa3); } \
        MASKT(PX0, PX1, (t)); partialSM_rel(PX0, PX1, m_reg, negm, alX); \
        if ((t) + 2 < NT) { WAITV(3); } else { WAITV(0); } BAR(); \
        RESC(alX); } while (0)
    for (int t = 1; t + 1 < NT; t += 2) {
        STEP(pB0, pB1, mnB, alB, pA0, pA1, alA, t);
        STEP(pA0, pA1, mnA, alA, pB0, pB1, alB, t + 1);
    }
    SBAR(); qkt_pipe(pB0, pB1, kbase0 + ((NT - 1) % 3) * SHM_K, koff, qaddr, negm);
    finishSM_direct(pA0, pA1, alA, l_reg, pa0, pa1, pa2, pa3); SBAR();
    pv_tile<0>(o, vb0 + ((NT - 2) & 3) * SHM_V, pa0, pa1, pa2, pa3);
    MASKT(pB0, pB1, NT - 1); partialSM_rel(pB0, pB1, m_reg, negm, alB); RESC(alB);
    finishSM_direct(pB0, pB1, alB, l_reg, pa0, pa1, pa2, pa3); SBAR(); pv_tile<0>(o, vb0 + ((NT - 1) & 3) * SHM_V, pa0, pa1, pa2, pa3);
    if (hi == 0) li_l[r32] = l_reg; asm volatile("s_waitcnt lgkmcnt(0)" ::: "memory");
    float rli[16];
#pragma unroll
    for (int r = 0; r < 16; ++r) rli[r] = __builtin_amdgcn_rcpf(li_l[crow(r, hi)]);
    bf16_t* Ow = cur.O + (size_t)(wid * QBLK) * OS;
#pragma unroll
    for (int r = 0; r < 16; ++r) { const int orow = crow(r, hi);
#pragma unroll
        for (int d0 = 0; d0 < 2; ++d0) { const float v = o[d0][r] * rli[r];
            const float vn = __shfl_xor(v, 1);
            if ((r32 & 1) == 0) *(unsigned*)(Ow + (size_t)orow * OS + d0 * 32 + r32) = cvtpk(v, vn); } }
    asm volatile("s_waitcnt vmcnt(0)" ::: "memory");
    __syncthreads();
#undef DMA_TILE
#undef WAITV
#undef BAR
#undef RESC
#undef MASKT
#undef STEP
}
#undef ROWK
#undef ROWV
#undef VMW
#undef VMWN
#undef SLOAD_H
#undef SWRITE_HK
#undef SWRITE_HV
#undef SWRITE_H
#undef KSWZ
#undef SBAR
}

namespace gla {
typedef short bf16x8 __attribute__((ext_vector_type(8)));
typedef short s16x4 __attribute__((ext_vector_type(4)));
typedef float f32x16 __attribute__((ext_vector_type(16)));
template <int NCB> __device__ __forceinline__ int t_st(int k, int c) { const int kk = (k & ~0xC) | ((k & 4) << 1) | ((k & 8) >> 1); return ((kk >> 3) * NCB + (c >> 5)) * 512 + ((kk & 7) * 32 + (c & 31)) * 2; }
__device__ __forceinline__ int t_rd_base(int lane) { return ((lane & 3) << 3) | (((lane >> 2) & 3) << 6) | (((lane >> 4) & 1) << 5) | (((lane >> 5) & 1) << 8); }
template <int NCB> constexpr int t_rd_off(int d0, int ks, int half) { return d0 * 512 + ks * (NCB * 1024) + half * (NCB * 512); }
#define GLA_TRRD(dst, addr, off) asm volatile("ds_read_b64_tr_b16 %0, %1 offset:%2" : "=&v"(dst) : "v"(addr), "i"(off) : "memory")
__device__ __forceinline__ int crow(int r, int hi) { return (r & 3) + 8 * (r >> 2) + 4 * hi; }
}

#define XB_TMO      128
#define XB_XCNT(j)  (256  + 64 * (j))
#define XB_XSUB(j)  (1280 + 64 * (j))
#define XB_XGEN(j)  (2304 + 64 * (j))
#define XB_TOP      3328
#define XB_TOPGEN   3392
#define XCD_BAR_WORDS 3456
#define XB_SPIN_CAP (1u << 18)
__device__ __forceinline__ unsigned xb_ld(unsigned* p)              { return __hip_atomic_load(p, __ATOMIC_RELAXED, __HIP_MEMORY_SCOPE_AGENT); }
__device__ __forceinline__ unsigned xb_add(unsigned* p, unsigned v) { return __hip_atomic_fetch_add(p, v, __ATOMIC_RELAXED, __HIP_MEMORY_SCOPE_AGENT); }
__device__ __forceinline__ unsigned xb_xcc_id() { return (unsigned)__builtin_amdgcn_s_getreg((3 << 11) | 20) & 0xFu; }
#define XB_SPIN(cond, bar) do { unsigned _sp = 0; while (cond) { __builtin_amdgcn_s_sleep(1); \
    if ((++_sp & 255u) == 0u) { if (xb_ld(&(bar)[XB_TMO])) break; if (_sp > XB_SPIN_CAP) { atomicAdd(&(bar)[XB_TMO], 1u); break; } } } } while (0)
struct XcdBarrier { unsigned* bar; unsigned x; volatile LAS unsigned* st; };
__device__ __forceinline__ XcdBarrier xcd_barrier_post(unsigned* bar, volatile LAS unsigned* st) {
    XcdBarrier b; b.bar = bar; b.x = xb_xcc_id(); b.st = st;
    if (threadIdx.x == 0) st[2] = xb_add(&bar[XB_XCNT(b.x)], 1u);
    return b;
}
__device__ __forceinline__ void xcd_barrier_complete(unsigned* bar, unsigned x, unsigned& nloc, unsigned& nx) {
    const unsigned G = gridDim.x * gridDim.y * gridDim.z;
    unsigned sum, cnt, mine, sp = 0u;
    for (;;) {
        sum = 0u; cnt = 0u; mine = 0u;
#pragma unroll
        for (unsigned j = 0; j < 16; ++j) { const unsigned c = xb_ld(&bar[XB_XCNT(j)]); sum += c; cnt += (c > 0u) ? 1u : 0u; mine = (j == x) ? c : mine; }
        if (sum == G) break;
        __builtin_amdgcn_s_sleep(1);
        if ((++sp & 255u) == 0u) { if (xb_ld(&bar[XB_TMO])) break; if (sp > XB_SPIN_CAP) { atomicAdd(&bar[XB_TMO], 1u); break; } }
    }
    nloc = mine > 0u ? mine : 1u; nx = cnt > 0u ? cnt : 1u;
}
__device__ __forceinline__ void xcd_barrier(const XcdBarrier& b) {
    asm volatile("s_waitcnt vmcnt(0)" ::: "memory");
    __syncthreads();
    if (threadIdx.x == 0) {
        unsigned* bar = b.bar;
        __builtin_amdgcn_s_waitcnt(0);
        unsigned nloc = b.st[0], nx = b.st[1];
        if (nloc == 0u) { xcd_barrier_complete(bar, b.x, nloc, nx); b.st[0] = nloc; b.st[1] = nx; }
        const unsigned old = xb_add(&bar[XB_XSUB(b.x)], 1u);
        const unsigned gen = old / nloc;
        if (old + 1u == (gen + 1u) * nloc) {
            __builtin_amdgcn_fence(__ATOMIC_RELEASE, "agent");
            asm volatile("s_waitcnt vmcnt(0)" ::: "memory");
            const unsigned og = xb_add(&bar[XB_TOP], 1u);
            const unsigned tg = og / nx;
            if (og + 1u == (tg + 1u) * nx) xb_add(&bar[XB_TOPGEN], 1u);
            else XB_SPIN(xb_ld(&bar[XB_TOPGEN]) == tg, bar);
            __builtin_amdgcn_fence(__ATOMIC_ACQUIRE, "agent");
            xb_add(&bar[XB_XGEN(b.x)], 1u);
            asm volatile("s_waitcnt vmcnt(0)" ::: "memory");
        } else {
            XB_SPIN(xb_ld(&bar[XB_XGEN(b.x)]) == gen, bar);
            __builtin_amdgcn_fence(__ATOMIC_ACQUIRE, "agent");
            asm volatile("s_waitcnt vmcnt(0)" ::: "memory");
        }
    }
    __syncthreads();
}

constexpr int NWAVES = 8;
constexpr int RING_BYTES = 131072, LDS_BYTES = 147456, LDSCTL_OFF = LDS_BYTES - 1024, MISC_OFF = LDSCTL_OFF + 320;
constexpr int CW_BAR = 4096;
constexpr int CW_QCTR = 16384;

struct Args { const void* in[20]; float* out; unsigned char* ws; int ph_lo, ph_hi; };

__device__ __forceinline__ int win_srccol(int n) {
    if (n < 2048) return 2224 + n;
    if (n < 2560) return 1712 + (n - 2048);
    if (n < 2816) return 672 + (n - 2560);
    if (n < 3328) return 1184 + (n - 2816);
    if (n < 3584) return 928 + (n - 3328);
    if (n < 3968) return 0 + (n - 3584);
    if (n < 4224) return 384 + (n - 3968);
    if (n < 4256) return 640 + (n - 4224);
    if (n < 4272) return 1696 + (n - 4256);
    return -1;
}
__device__ __forceinline__ void transpose_item(const float* __restrict__ W, int K, int Nsrc, bf16_t* __restrict__ WT, int Nout, const float* __restrict__ kscale, bool winperm, float* scr, int item, int lane) {
    const int nblk = Nout / 32, kb = item / nblk, nb = item % nblk, k0 = 64 * kb, n0 = 32 * nb;
    const int n = n0 + (lane & 31); const int sc = winperm ? win_srccol(n) : n;
    float tv[32];
#pragma unroll
    for (int i = 0; i < 32; ++i) { const int kk = 2 * i + (lane >> 5); tv[i] = (sc >= 0) ? W[(size_t)(k0 + kk) * Nsrc + sc] : 0.f; }
#pragma unroll
    for (int i = 0; i < 32; ++i) { const int kk = 2 * i + (lane >> 5); float v = tv[i]; if (kscale) v *= kscale[k0 + kk]; scr[kk * 33 + (lane & 31)] = v; }
    asm volatile("s_waitcnt lgkmcnt(0)" ::: "memory");
    const int c = lane & 7;
#pragma unroll
    for (int j = 0; j < 4; ++j) { const int nn = (lane >> 3) + 8 * j; const float* s = scr + (8 * c) * 33 + nn;
        u32x4 o; o.x = pk2(s[0 * 33], s[1 * 33]); o.y = pk2(s[2 * 33], s[3 * 33]); o.z = pk2(s[4 * 33], s[5 * 33]); o.w = pk2(s[6 * 33], s[7 * 33]);
        *(u32x4*)(WT + (size_t)(n0 + nn) * K + k0 + 8 * c) = o; }
    asm volatile("s_waitcnt lgkmcnt(0)" ::: "memory");
}

#define TOPK_INSERT(tv, ti, vv, ii) do { float v_ = (vv); int i_ = (ii); \
    _Pragma("unroll") for (int q_ = 0; q_ < 16; ++q_) { const bool gt_ = (v_ > tv[q_]) || (v_ == tv[q_] && i_ < ti[q_]); const float tv_ = tv[q_]; const int ti_ = ti[q_]; \
        tv[q_] = gt_ ? v_ : tv_; ti[q_] = gt_ ? i_ : ti_; v_ = gt_ ? tv_ : v_; i_ = gt_ ? ti_ : i_; } } while (0)

template <int OFFS> __device__ __forceinline__ void quant_rows2(const float* __restrict__ tab, const float* __restrict__ g, unsigned char* __restrict__ qt, float* __restrict__ sc, int row0, int lane) {
    f32x4 v[2][4];
#pragma unroll
    for (int rr = 0; rr < 2; ++rr)
#pragma unroll
        for (int j = 0; j < 4; ++j) v[rr][j] = *(const f32x4*)(tab + (size_t)(row0 + rr) * 1024 + 16 * lane + 4 * j);
#pragma unroll
    for (int rr = 0; rr < 2; ++rr) {
        float mx = 0.f;
#pragma unroll
        for (int j = 0; j < 4; ++j) { if (g) v[rr][j] = v[rr][j] * *(const f32x4*)(g + 16 * lane + 4 * j);
            mx = fmaxf(mx, fmaxf(fmaxf(fabsf(v[rr][j][0]), fabsf(v[rr][j][1])), fmaxf(fabsf(v[rr][j][2]), fabsf(v[rr][j][3])))); }
#pragma unroll
        for (int o = 1; o < 64; o <<= 1) mx = fmaxf(mx, __shfl_xor(mx, o));
        mx = fmaxf(mx, 1e-30f);
        const float inv = 127.f / mx;
        u32x4 w;
#pragma unroll
        for (int j = 0; j < 4; ++j) { unsigned b = 0;
#pragma unroll
            for (int e = 0; e < 4; ++e) { const int q = (int)rintf(v[rr][j][e] * inv) + OFFS; b |= ((unsigned)q & 0xffu) << (8 * e); }
            w[j] = b; }
        *(u32x4*)(qt + (size_t)(lane >> 3) * (16384 * 128) + (size_t)(row0 + rr) * 128 + 16 * (lane & 7)) = w;
        if (lane == 0) sc[row0 + rr] = mx * (1.f / 127.f);
    }
}
typedef __bf16 bf2_t __attribute__((ext_vector_type(2)));
__device__ __forceinline__ float dot2_bf16(unsigned a, unsigned b, float acc) { return __builtin_amdgcn_fdot2_f32_bf16(__builtin_bit_cast(bf2_t, a), __builtin_bit_cast(bf2_t, b), acc, false); }
__global__ void __launch_bounds__(NWAVES * 64, 2) fwd(Args args) {
    extern __shared__ __attribute__((aligned(16))) unsigned char lds[];
    const int tid = threadIdx.x, lane = tid & 63, wave = __builtin_amdgcn_readfirstlane(tid >> 6);
    const int G = gridDim.x; int vcu; { const int bx = blockIdx.x; vcu = (G % 8 == 0) ? (bx % 8) * (G / 8) + bx / 8 : bx; }
    const int gw = vcu * NWAVES + wave, NGW = G * NWAVES, gtid = vcu * 512 + tid, NT = G * 512;
    unsigned char* ws = args.ws;
    const float* x = (const float*)args.in[0]; const int* positions = (const int*)args.in[1];
    const float* g_mix = (const float*)args.in[2]; const float* w_in = (const float*)args.in[3]; const float* g_q_lat = (const float*)args.in[4]; const float* w_qb = (const float*)args.in[5];
    const float* g_kv_lat = (const float*)args.in[6]; const float* w_kvb = (const float*)args.in[7]; const float* w_a2 = (const float*)args.in[8]; const float* b_a2 = (const float*)args.in[9];
    const float* g_gla = (const float*)args.in[10]; const float* w_branch_a = (const float*)args.in[11]; const float* w_branch_b = (const float*)args.in[12]; const float* w_out = (const float*)args.in[13];
    const float* g_ffn = (const float*)args.in[14]; const float* w_peer_q = (const float*)args.in[15]; const float* sub_keys = (const float*)args.in[16]; const float* peer_u = (const float*)args.in[17];
    const float* peer_v = (const float*)args.in[18]; const float* g_final = (const float*)args.in[19];
    float* out = args.out;
    float* SSQ = (float*)(ws + WS_SSQ); float* SSKV = (float*)(ws + WS_SSKV); float* SSX1 = (float*)(ws + WS_SSX1); float* COS = (float*)(ws + WS_COS); float* SIN = (float*)(ws + WS_SIN);
    float* DECAY = (float*)(ws + WS_DECAY);
    bf16_t* WIN = (bf16_t*)(ws + WS_WIN); bf16_t* WQB = (bf16_t*)(ws + WS_WQB); bf16_t* WKVB = (bf16_t*)(ws + WS_WKVB); bf16_t* WA = (bf16_t*)(ws + WS_WA); bf16_t* WB = (bf16_t*)(ws + WS_WB);
    bf16_t* WOUT = (bf16_t*)(ws + WS_WOUT); bf16_t* WPQ = (bf16_t*)(ws + WS_WPQ); bf16_t* KEYS = (bf16_t*)(ws + WS_KEYS);
    bf16_t* PROJB = (bf16_t*)(ws + WS_PROJB); bf16_t* PROJA = (bf16_t*)(ws + WS_PROJA); bf16_t* XN = (bf16_t*)(ws + WS_XN);
    bf16_t* Q = (bf16_t*)(ws + WS_Q); bf16_t* K = (bf16_t*)(ws + WS_K); bf16_t* KPE = (bf16_t*)(ws + WS_KPE); float* DST = out; bf16_t* V = (bf16_t*)((unsigned char*)out + 32 * MiB); bf16_t* STB = (bf16_t*)((unsigned char*)out + 48 * MiB);
    bf16_t* YA = (bf16_t*)(ws + WS_YA); bf16_t* YB = (bf16_t*)(ws + WS_YB); bf16_t* MERGED = (bf16_t*)(ws + WS_MERGED); bf16_t* X1B = (bf16_t*)(ws + WS_X1B); bf16_t* QP = (bf16_t*)(ws + WS_QP);
    int* EIDX = (int*)(ws + WS_EIDX); float* EGATE = (float*)(ws + WS_EGATE); unsigned char* UT = ws + WS_UT; unsigned char* VT = ws + WS_VT; float* SU = (float*)(ws + WS_SU); float* SV = (float*)(ws + WS_SV); float* SS2 = (float*)(ws + WS_SS2); float* ZP = (float*)(ws + WS_ZP); float* CS = (float*)(ws + WS_C128); signed char* CQ = (signed char*)(ws + WS_CB);

    for (int u = tid; u < (LDS_BYTES - LDSCTL_OFF) / 4; u += NWAVES * 64) ((unsigned*)(lds + LDSCTL_OFF))[u] = 0u;
    __syncthreads();
    XcdBarrier bar; bar.bar = (unsigned*)(ws + WS_CTL) + CW_BAR; bar.x = 0; bar.st = nullptr;
    if (MK_N_LAUNCHES == 1) bar = xcd_barrier_post((unsigned*)(ws + WS_CTL) + CW_BAR, (volatile LAS unsigned*)(lds + MISC_OFF) + 8);
    const int ph_lo_ = args.ph_lo, ph_hi_ = args.ph_hi;
#define IN(k) (ph_lo_ <= (k) && (k) < ph_hi_)
#define SEAM(k) do { if (MK_N_LAUNCHES == 1) { if (IN(k) && IN((k) + 1)) xcd_barrier(bar); } } while (0)
    PG8_LAS unsigned char* ring = (PG8_LAS unsigned char*)lds;

    if (IN(0)) {
        for (int i = gtid; i < 4 * M_; i += NT) SSQ[i] = 0.f;
        float* scr = (float*)(lds + wave * 16384);
        constexpr int I_WIN = 16 * (NPROJ / 32), I_QB = 6 * 24, I_KVB = 4 * 32, I_A = 8 * 32, I_OUT = 16 * 32, I_PQ = 16 * 64;
        constexpr int NITEMS = I_WIN + I_QB + I_KVB + 2 * I_A + I_OUT + I_PQ;
        for (int it = gw; it < NITEMS; it += NGW) {
            int r = it;
            if (r < I_WIN) { transpose_item(w_in, 1024, 4272, WIN, NPROJ, nullptr, true, scr, r, lane); continue; } r -= I_WIN;
            if (r < I_QB) { transpose_item(w_qb, 384, 768, WQB, 768, g_q_lat, false, scr, r, lane); continue; } r -= I_QB;
            if (r < I_KVB) { transpose_item(w_kvb, 256, 1024, WKVB, 1024, g_kv_lat, false, scr, r, lane); continue; } r -= I_KVB;
            if (r < I_A) { transpose_item(w_branch_a, 512, 1024, WA, 1024, nullptr, false, scr, r, lane); continue; } r -= I_A;
            if (r < I_A) { transpose_item(w_branch_b, 512, 1024, WB, 1024, nullptr, false, scr, r, lane); continue; } r -= I_A;
            if (r < I_OUT) { transpose_item(w_out, 1024, 1024, WOUT, 1024, nullptr, false, scr, r, lane); continue; } r -= I_OUT;
            transpose_item(w_peer_q, 1024, 2048, WPQ, 2048, g_ffn, false, scr, r, lane);
        }
        for (int i = gtid; i < 16 * 128 * 128; i += NT) KEYS[i] = f2bf(sub_keys[i]);
        for (int i = gtid; i < M_ * 16; i += NT) { const int m = i >> 4, f = i & 15;
            const double inv = pow(10000.0, -(double)f / 16.0); const double ang = (double)positions[m] * inv;
            COS[i] = (float)cos(ang); SIN[i] = (float)sin(ang); }
        for (int row = gw * 2; row < M_; row += NGW * 2) {
            f32x4 v[2][4];
#pragma unroll
            for (int rr = 0; rr < 2; ++rr)
#pragma unroll
                for (int j = 0; j < 4; ++j) v[rr][j] = ((const f32x4*)(x + (size_t)(row + rr) * DM))[lane + 64 * j];
#pragma unroll
            for (int rr = 0; rr < 2; ++rr) { float ss = 0.f;
#pragma unroll
                for (int j = 0; j < 4; ++j) ss += (v[rr][j][0] * v[rr][j][0] + v[rr][j][1] * v[rr][j][1]) + (v[rr][j][2] * v[rr][j][2] + v[rr][j][3] * v[rr][j][3]);
                ss = wave_sum(ss); const float r = rsqrtf(ss * (1.f / DM) + EPS);
#pragma unroll
                for (int j = 0; j < 4; ++j) { const int c = 4 * (lane + 64 * j); const f32x4 gg = *(const f32x4*)(g_mix + c);
                    u32x2 w; w.x = pk2(v[rr][j][0] * r * gg[0], v[rr][j][1] * r * gg[1]); w.y = pk2(v[rr][j][2] * r * gg[2], v[rr][j][3] * r * gg[3]);
                    *(u32x2*)(XN + (size_t)(row + rr) * DM + c) = w; } }
        }
    }
    SEAM(0);
    if (MK_N_LAUNCHES == 1 && IN(0) && IN(1)) { if (tid == 0) { unsigned ord = 0; for (unsigned j = 0; j < 16; ++j) if (j < bar.x && xb_ld(&bar.bar[XB_XCNT(j)]) > 0u) ++ord; bar.st[3] = ord; } __syncthreads(); }
    if (IN(1)) {
        pg8::Gemm g{XN, WIN, nullptr, nullptr, DM, DM, M_, NPROJ, DM, 1}; pg8::StaticOrder S; S.init(g, G, (int)blockIdx.x);
        pg8::EpiProj E{PROJB, PROJA, SSQ, SSKV};
        pg8::gemm_phase<pg8::EpiProj, pg8::StaticOrder, true>(ring, g, S, E);
        { const int nwg_ = (M_ / 256) * (NPROJ / 256), rem_ = nwg_ % G, c_ = (int)blockIdx.x; const int nq_ = rem_ ? G - rem_ : G, qi_ = rem_ ? c_ - rem_ : c_;
          if (qi_ >= 0) for (int row = 2 * (qi_ * NWAVES + wave); row < 32768; row += 2 * nq_ * NWAVES) {
              if (row < 16384) quant_rows2<0>(peer_u, g_ffn, UT, SU, row, lane); else quant_rows2<0>(peer_v, nullptr, VT, SV, row - 16384, lane); } }
    }
    SEAM(1);
    if (IN(2)) {
        { pg8::Gemm g{PROJA + PA_QLAT, WQB, nullptr, nullptr, PA_LD, 384, M_, 768, 384, 1}; pg8::StaticOrder S; S.init(g, G, (int)blockIdx.x);
          pg8::EpiQ E{Q, SSQ, COS, SIN}; pg8::gemm_phase<pg8::EpiQ, pg8::StaticOrder, true>(ring, g, S, E); }
        { pg8::Gemm g{PROJA + PA_KVLAT, WKVB, nullptr, nullptr, PA_LD, 256, M_, 1024, 256, 1}; pg8::StaticOrder S; S.init(g, G, (int)blockIdx.x);
          pg8::EpiKV E{K, V, SSKV}; pg8::gemm_phase<pg8::EpiKV, pg8::StaticOrder, true>(ring, g, S, E); }
        for (int i = gtid; i < M_ * 32; i += NT) { const int m = i >> 5, j = i & 31; const bf16_t* kr = PROJA + (size_t)m * PA_LD + PA_KROPE; float o;
            if (j < 16) { const float x1 = bf2f(kr[j]), x2 = bf2f(kr[j + 16]); o = x1 * COS[m * 16 + j] - x2 * SIN[m * 16 + j]; }
            else { const int f = j - 16; const float x2 = bf2f(kr[j]), x1 = bf2f(kr[j - 16]); o = x2 * COS[m * 16 + f] + x1 * SIN[m * 16 + f]; }
            KPE[i] = f2bf(o); }
        __syncthreads();
        {
            const int r32 = lane & 31, hi5 = lane >> 5;
            unsigned char* gvt = lds; unsigned char* kdt = lds + 16384;
            const int tbase = (int)(uintptr_t)lds + gla::t_rd_base(lane);
            for (int unit = vcu; unit < 2 * NCH * 4; unit += G) {
                const int h = unit & 3, bc = unit >> 2, t0 = bc * 64;
                {
                    const int sr = tid >> 4, ch = tid & 15;
#pragma unroll
                    for (int rr = 0; rr < 2; ++rr) { const int row = sr + 32 * rr; const u32x4 v = *(const u32x4*)(PROJA + (size_t)(t0 + row) * PA_LD + PA_GV + h * 128 + ch * 8);
                        *(u32x4*)(gvt + gla::t_st<4>(row, ch * 8)) = v; }
                }
                {
                    const int k0 = wave * 8; const bf16_t* prow = PROJA + (size_t)(t0 + lane) * PA_LD;
                    const u32x4 ga = *(const u32x4*)(prow + PA_GLR), gb = *(const u32x4*)(prow + PA_GLR + 8), gkv = *(const u32x4*)(prow + PA_GK + h * 64 + k0);
                    float glr[16];
#pragma unroll
                    for (int q = 0; q < 4; ++q) { glr[2 * q] = __uint_as_float(ga[q] << 16); glr[2 * q + 1] = __uint_as_float(ga[q] & 0xffff0000u); glr[8 + 2 * q] = __uint_as_float(gb[q] << 16); glr[8 + 2 * q + 1] = __uint_as_float(gb[q] & 0xffff0000u); }
                    float kdv[8];
#pragma unroll
                    for (int j = 0; j < 8; ++j) { const int kc = h * 64 + k0 + j; float z = b_a2[kc];
#pragma unroll
                        for (int r = 0; r < 16; ++r) z += glr[r] * w_a2[r * 256 + kc];
                        float v = (fminf(z, 0.f) - log1pf(expf(-fabsf(z)))) * (1.f / 16.f);
#pragma unroll
                        for (int d = 1; d < 64; d <<= 1) { const float t = __shfl_up(v, d); v += (lane >= d) ? t : 0.f; }
                        const float cl = __builtin_bit_cast(float, __builtin_amdgcn_readlane(__builtin_bit_cast(int, v), 63));
                        const unsigned gw_ = gkv[j >> 1]; const float gk = (j & 1) ? __uint_as_float(gw_ & 0xffff0000u) : __uint_as_float(gw_ << 16);
                        kdv[j] = gk * expf(cl - v);
                        if (lane == 0) DECAY[((size_t)bc * 4 + h) * 64 + k0 + j] = expf(cl); }
                    u32x4 w; w.x = pk2(kdv[0], kdv[1]); w.y = pk2(kdv[2], kdv[3]); w.z = pk2(kdv[4], kdv[5]); w.w = pk2(kdv[6], kdv[7]);
                    *(u32x4*)(kdt + gla::t_st<2>(lane, k0)) = w;
                }
                __syncthreads();
                {
                    const int kt = wave >> 2, vt = wave & 3; gla::f32x16 acc = {};
                    gla::s16x4 al[4], ah[4], bl[4], bh[4];
                    const int abase = tbase + kt * 512, bbase = tbase + vt * 512;
#define GLA_KS(ks) do { GLA_TRRD(al[ks], abase, 16384 + gla::t_rd_off<2>(0, ks, 0)); GLA_TRRD(ah[ks], abase, 16384 + gla::t_rd_off<2>(0, ks, 1)); GLA_TRRD(bl[ks], bbase, gla::t_rd_off<4>(0, ks, 0)); GLA_TRRD(bh[ks], bbase, gla::t_rd_off<4>(0, ks, 1)); } while (0)
                    GLA_KS(0); GLA_KS(1); GLA_KS(2); GLA_KS(3);
#undef GLA_KS
                    asm volatile("s_waitcnt lgkmcnt(0)" ::: "memory"); __builtin_amdgcn_sched_barrier(0);
#pragma unroll
                    for (int ks = 0; ks < 4; ++ks) acc = __builtin_amdgcn_mfma_f32_32x32x16_bf16((gla::bf16x8){al[ks][0], al[ks][1], al[ks][2], al[ks][3], ah[ks][0], ah[ks][1], ah[ks][2], ah[ks][3]},
                                                                                                 (gla::bf16x8){bl[ks][0], bl[ks][1], bl[ks][2], bl[ks][3], bh[ks][0], bh[ks][1], bh[ks][2], bh[ks][3]}, acc, 0, 0, 0);
                    float* dp = DST + (((size_t)bc * 4 + h) * 64 + kt * 32) * 128 + vt * 32 + r32;
#pragma unroll
                    for (int r = 0; r < 16; ++r) dp[(size_t)gla::crow(r, hi5) * 128] = acc[r];
                }
                __syncthreads();
            }
        }
    }
    SEAM(2);
    if (IN(3)) {
        if (tid < 256) for (int i = vcu * 256 + tid; i < 65536; i += G * 256) {
            const int v = i & 127, k = (i >> 7) & 63, h = (i >> 13) & 3, b = i >> 15; float s = 0.f;
            const float* dp = DST + (((size_t)b * NCH * 4 + h) * 64 + k) * 128 + v; const float* gp = DECAY + ((size_t)b * NCH * 4 + h) * 64 + k;
            bf16_t* sbp = STB + (((size_t)b * NCH * 4 + h) * 64 + k) * 128 + v;
            float d[8], g[8], dn[8], gn[8];
#pragma unroll
            for (int j = 0; j < 8; ++j) { d[j] = dp[(size_t)j * 32768]; g[j] = gp[(size_t)j * 256]; }
            for (int c0 = 0; c0 < NCH; c0 += 8) {
                const int cn = (c0 + 8 < NCH) ? c0 + 8 : c0;
#pragma unroll
                for (int j = 0; j < 8; ++j) { dn[j] = dp[(size_t)(cn + j) * 32768]; gn[j] = gp[(size_t)(cn + j) * 256]; }
#pragma unroll
                for (int j = 0; j < 8; ++j) { s = g[j] * s + d[j]; d[j] = s; }
#pragma unroll
                for (int j = 0; j < 8; ++j) sbp[(size_t)(c0 + j) * 32768] = f2bf(d[j]);
#pragma unroll
                for (int j = 0; j < 8; ++j) { d[j] = dn[j]; g[j] = gn[j]; } } }
        __syncthreads();
        {
            for (int pr = vcu; pr < 256; pr += G) {
                const int bh = pr >> 4, s16 = pr & 15, b = bh >> 3, h = bh & 7;
                att::BlockRef r0, r1;
                const bf16_t* Kh = K + (size_t)b * SEQ * att::KS + h * 96; const bf16_t* Vh = V + (size_t)b * SEQ * att::VS + h * 64;
                const int qb0 = 31 - s16, qb1 = s16;
                r0.Q = Q + ((size_t)b * SEQ + qb0 * 256) * att::QS + h * 96; r0.O = YA + ((size_t)b * SEQ + qb0 * 256) * att::OS + h * 64; r0.K = Kh; r0.KPE = KPE + (size_t)b * SEQ * 32; r0.V = Vh; r0.P0 = qb0 * 256;
                r1.Q = Q + ((size_t)b * SEQ + qb1 * 256) * att::QS + h * 96; r1.O = YA + ((size_t)b * SEQ + qb1 * 256) * att::OS + h * 64; r1.K = Kh; r1.KPE = KPE + (size_t)b * SEQ * 32; r1.V = Vh; r1.P0 = qb1 * 256;
                att::attn_block_dma(r0, (char*)lds);
                att::attn_block_dma(r1, (char*)lds);
            }
        }
    }
    SEAM(3);
    if (IN(4)) {
        const int r32 = lane & 31, hi5 = lane >> 5;
        unsigned char* stt = lds; float* part = (float*)(lds + 16384);
        const int lt = wave >> 2, vt = wave & 3;
        const int bbase = (int)(uintptr_t)lds + gla::t_rd_base(lane) + vt * 512;
        for (int unit = vcu; unit < 2 * NCH * 4; unit += G) {
            const int h = unit & 3, bc = unit >> 2, t0 = bc * 64;
            {   const int sr = tid >> 4, ch = tid & 15; const bf16_t* sp = STB + ((size_t)bc * 4 + h) * 64 * 128;
#pragma unroll
                for (int rr = 0; rr < 2; ++rr) { const int row = sr + 32 * rr; *(u32x4*)(stt + gla::t_st<4>(row, ch * 8)) = *(const u32x4*)(sp + row * 128 + ch * 8); } }
            gla::bf16x8 qa[4];
            { const bf16_t* qrow = PROJB + (size_t)(t0 + lt * 32 + r32) * PB_LD + PB_GQ + h * 64 + hi5 * 8;
#pragma unroll
              for (int ks = 0; ks < 4; ++ks) qa[ks] = *(const gla::bf16x8*)(qrow + ks * 16); }
            __syncthreads();
            gla::f32x16 acc = {};
            { gla::s16x4 bl[4], bh[4];
#define GLA_KS(ks) do { GLA_TRRD(bl[ks], bbase, gla::t_rd_off<4>(0, ks, 0)); GLA_TRRD(bh[ks], bbase, gla::t_rd_off<4>(0, ks, 1)); } while (0)
              GLA_KS(0); GLA_KS(1); GLA_KS(2); GLA_KS(3);
#undef GLA_KS
              asm volatile("s_waitcnt lgkmcnt(0)" ::: "memory"); __builtin_amdgcn_sched_barrier(0);
#pragma unroll
              for (int ks = 0; ks < 4; ++ks) acc = __builtin_amdgcn_mfma_f32_32x32x16_bf16(qa[ks], (gla::bf16x8){bl[ks][0], bl[ks][1], bl[ks][2], bl[ks][3], bh[ks][0], bh[ks][1], bh[ks][2], bh[ks][3]}, acc, 0, 0, 0); }
            float rs[16];
#pragma unroll
            for (int r = 0; r < 16; ++r) { acc[r] *= 0.125f; float s2 = acc[r] * acc[r];
                s2 += __builtin_bit_cast(float, __builtin_amdgcn_update_dpp(0, __builtin_bit_cast(int, s2), 0x128, 0xf, 0xf, false));
                s2 += __builtin_bit_cast(float, __builtin_amdgcn_update_dpp(0, __builtin_bit_cast(int, s2), 0x124, 0xf, 0xf, false));
                s2 += __builtin_bit_cast(float, __builtin_amdgcn_update_dpp(0, __builtin_bit_cast(int, s2), 0x122, 0xf, 0xf, false));
                s2 += __builtin_bit_cast(float, __builtin_amdgcn_update_dpp(0, __builtin_bit_cast(int, s2), 0x121, 0xf, 0xf, false));
                s2 += __shfl_xor(s2, 16); rs[r] = s2; }
            if (r32 == 0) {
#pragma unroll
                for (int r = 0; r < 16; ++r) part[(lt * 32 + gla::crow(r, hi5)) * 4 + vt] = rs[r]; }
            __syncthreads();
#pragma unroll
            for (int r = 0; r < 16; ++r) { const int l = lt * 32 + gla::crow(r, hi5); const f32x4 pp = *(const f32x4*)(part + l * 4);
                const float rn = rsqrtf(((pp[0] + pp[1]) + (pp[2] + pp[3])) * (1.f / 128.f) + EPS);
                const int v = vt * 32 + r32; const float go = bf2f(PROJB[(size_t)(t0 + l) * PB_LD + PB_GOUT + h * 128 + v]);
                const float silu = go * __builtin_amdgcn_rcpf(1.f + __expf(-go));
                YB[(size_t)(t0 + l) * 512 + h * 128 + v] = f2bf(acc[r] * rn * g_gla[h * 128 + v] * silu); }
            __syncthreads();
        }
    }
    SEAM(4);
    if (IN(5)) {
        pg8::Gemm g{YA, WA, YB, WB, 512, 512, M_, 1024, 512, 2}; pg8::StaticOrder S; S.init(g, G, (int)blockIdx.x);
        pg8::EpiMerge E{PROJB, MERGED}; pg8::gemm_phase<pg8::EpiMerge, pg8::StaticOrder, true>(ring, g, S, E);
    }
    SEAM(5);
    if (IN(6)) {
        pg8::Gemm g{MERGED, WOUT, nullptr, nullptr, DM, DM, M_, 1024, DM, 1}; pg8::StaticOrder S; S.init(g, G, (int)blockIdx.x);
        pg8::EpiX1 E{x, out, X1B, SSX1}; pg8::gemm_phase<pg8::EpiX1, pg8::StaticOrder, false>(ring, g, S, E);
    }
    SEAM(6);
    if (IN(7)) {
        pg8::Gemm g{X1B, WPQ, nullptr, nullptr, DM, DM, M_, 2048, DM, 1}; pg8::StaticOrder S; S.init(g, G, vcu); S.pair_mode = 1;
        pg8::EpiQP E{QP, SSX1}; pg8::gemm_phase<pg8::EpiQP, pg8::StaticOrder, true>(ring, g, S, E);
        asm volatile("s_waitcnt vmcnt(0)" ::: "memory"); __syncthreads();
    }
    if (IN(7)) {
        typedef short bf16x8_t __attribute__((ext_vector_type(8)));
        typedef float f32x16_t __attribute__((ext_vector_type(16)));
        const int r32 = lane & 31, hi = lane >> 5;
#define P8_SORTABLE(f) ({ const unsigned b_ = __float_as_uint(f); b_ ^ ((unsigned)((int)b_ >> 31) | 0x80000000u); })
#define P8_UNSORT(u) ({ const unsigned u_ = (u); __uint_as_float(u_ ^ (~(unsigned)((int)u_ >> 31) | 0x80000000u)); })
#define P8_CE(a, b) do { const unsigned hi_ = (a) > (b) ? (a) : (b), lo_ = (a) > (b) ? (b) : (a); (a) = hi_; (b) = lo_; } while (0)
#define P8_SORT16(x) do { P8_CE(x[0], x[1]); P8_CE(x[3], x[2]); P8_CE(x[4], x[5]); P8_CE(x[7], x[6]); P8_CE(x[8], x[9]); P8_CE(x[11], x[10]); P8_CE(x[12], x[13]); P8_CE(x[15], x[14]); P8_CE(x[0], x[2]); P8_CE(x[1], x[3]); P8_CE(x[6], x[4]); P8_CE(x[7], x[5]); P8_CE(x[8], x[10]); P8_CE(x[9], x[11]); P8_CE(x[14], x[12]); P8_CE(x[15], x[13]); P8_CE(x[0], x[1]); P8_CE(x[2], x[3]); P8_CE(x[5], x[4]); P8_CE(x[7], x[6]); P8_CE(x[8], x[9]); P8_CE(x[10], x[11]); P8_CE(x[13], x[12]); P8_CE(x[15], x[14]); P8_CE(x[0], x[4]); P8_CE(x[1], x[5]); P8_CE(x[2], x[6]); P8_CE(x[3], x[7]); P8_CE(x[12], x[8]); P8_CE(x[13], x[9]); P8_CE(x[14], x[10]); P8_CE(x[15], x[11]); P8_CE(x[0], x[2]); P8_CE(x[1], x[3]); P8_CE(x[4], x[6]); P8_CE(x[5], x[7]); P8_CE(x[10], x[8]); P8_CE(x[11], x[9]); P8_CE(x[14], x[12]); P8_CE(x[15], x[13]); P8_CE(x[0], x[1]); P8_CE(x[2], x[3]); P8_CE(x[4], x[5]); P8_CE(x[6], x[7]); P8_CE(x[9], x[8]); P8_CE(x[11], x[10]); P8_CE(x[13], x[12]); P8_CE(x[15], x[14]); P8_CE(x[0], x[8]); P8_CE(x[1], x[9]); P8_CE(x[2], x[10]); P8_CE(x[3], x[11]); P8_CE(x[4], x[12]); P8_CE(x[5], x[13]); P8_CE(x[6], x[14]); P8_CE(x[7], x[15]); P8_CE(x[0], x[4]); P8_CE(x[1], x[5]); P8_CE(x[2], x[6]); P8_CE(x[3], x[7]); P8_CE(x[8], x[12]); P8_CE(x[9], x[13]); P8_CE(x[10], x[14]); P8_CE(x[11], x[15]); P8_CE(x[0], x[2]); P8_CE(x[1], x[3]); P8_CE(x[4], x[6]); P8_CE(x[5], x[7]); P8_CE(x[8], x[10]); P8_CE(x[9], x[11]); P8_CE(x[12], x[14]); P8_CE(x[13], x[15]); P8_CE(x[0], x[1]); P8_CE(x[2], x[3]); P8_CE(x[4], x[5]); P8_CE(x[6], x[7]); P8_CE(x[8], x[9]); P8_CE(x[10], x[11]); P8_CE(x[12], x[13]); P8_CE(x[14], x[15]); } while (0)
#define P8_MERGE16(A, B, O) do { _Pragma("unroll") for (int i_ = 0; i_ < 16; ++i_) O[i_] = (A)[i_] > (B)[15 - i_] ? (A)[i_] : (B)[15 - i_]; \
        _Pragma("unroll") for (int s_ = 8; s_ >= 1; s_ >>= 1) _Pragma("unroll") for (int i_ = 0; i_ < 16; ++i_) if ((i_ & s_) == 0) P8_CE(O[i_], O[i_ + s_]); } while (0)
#define P8_INSERT(t, v) do { unsigned v_ = (v); _Pragma("unroll") for (int q_ = 0; q_ < 16; ++q_) { const unsigned a_ = t[q_] > v_ ? t[q_] : v_; v_ = t[q_] > v_ ? v_ : t[q_]; t[q_] = a_; } } while (0)
        for (int item = vcu; item < 256; item += G) {
            const int h = item & 7, tr = item >> 3;
            for (int c = tid; c < 2 * 128 * 16; c += 512) { const int p = c >> 11, row = (c >> 4) & 127, ch = c & 15;
                const u32x4 v = *(const u32x4*)(KEYS + ((size_t)(h * 2 + p) * 128 + row) * 128 + ch * 8);
                *(u32x4*)(lds + p * 32768 + row * 256 + ((ch * 16) ^ ((row & 7) << 4))) = v; }
            __syncthreads();
#pragma unroll 1
            for (int step = 0; step < 2; ++step) {
                const int m = tr * 512 + wave * 64 + step * 32 + r32;
                unsigned top[2][16];
#pragma unroll
                for (int p = 0; p < 2; ++p) {
                    bf16x8_t qf[8];
#pragma unroll
                    for (int ks = 0; ks < 8; ++ks) qf[ks] = *(const bf16x8_t*)(QP + (size_t)m * 2048 + (h * 2 + p) * 128 + ks * 16 + hi * 8);
                    f32x16_t acc[4];
#pragma unroll
                    for (int kt = 0; kt < 4; ++kt) { acc[kt] = f32x16_t{};
                        const int row = kt * 32 + r32; const unsigned char* rb = lds + p * 32768 + row * 256;
#pragma unroll
                        for (int ks = 0; ks < 8; ++ks) { const bf16x8_t a = *(const bf16x8_t*)(rb + (((2 * ks + hi) * 16) ^ ((row & 7) << 4)));
                            acc[kt] = __builtin_amdgcn_mfma_f32_32x32x16_bf16(a, qf[ks], acc[kt], 0, 0, 0); } }
                    unsigned xs[4][16];
#pragma unroll
                    for (int kt = 0; kt < 4; ++kt)
#pragma unroll
                        for (int r = 0; r < 16; ++r) { const unsigned base = 32 * kt + (r & 3) + 8 * (r >> 2);
                            xs[kt][r] = (P8_SORTABLE(acc[kt][r]) | 127u) ^ base; }
                    P8_SORT16(xs[0]); P8_SORT16(xs[1]); P8_SORT16(xs[2]); P8_SORT16(xs[3]);
                    unsigned m01[16], m23[16], t[16];
                    P8_MERGE16(xs[0], xs[1], m01); P8_MERGE16(xs[2], xs[3], m23); P8_MERGE16(m01, m23, t);
#pragma unroll
                    for (int i = 0; i < 16; ++i) t[i] ^= (unsigned)(hi << 2);
                    unsigned mm[16];
#pragma unroll
                    for (int i = 0; i < 16; ++i) { auto rr = __builtin_amdgcn_permlane32_swap(t[15 - i], t[15 - i], false, false); const unsigned pt = hi ? rr[0] : rr[1]; mm[i] = t[i] > pt ? t[i] : pt; }
#pragma unroll
                    for (int sft = 8; sft >= 1; sft >>= 1)
#pragma unroll
                        for (int i = 0; i < 16; ++i) if ((i & sft) == 0) { const unsigned a_ = mm[i] > mm[i + sft] ? mm[i] : mm[i + sft], b_ = mm[i] > mm[i + sft] ? mm[i + sft] : mm[i]; mm[i] = a_; mm[i + sft] = b_; }
#pragma unroll
                    for (int i = 0; i < 16; ++i) top[p][i] = mm[i];
                }
                float f0[16], f1[16];
#pragma unroll
                for (int i = 0; i < 16; ++i) { f0[i] = P8_UNSORT(top[0][i] & 0xFFFFFF80u); f1[i] = P8_UNSORT(top[1][i] & 0xFFFFFF80u); }
#define P8_CV(a, b) ((P8_SORTABLE(f0[a] + f1[b]) | 255u) ^ (unsigned)((a) * 16 + (b)))
                unsigned l0[16], x1[16], x2[16], x3[16], m1[16], m2[16], cb[16];
#pragma unroll
                for (int b = 0; b < 16; ++b) l0[b] = P8_CV(0, b);
#pragma unroll
                for (int b = 0; b < 8; ++b) x1[b] = P8_CV(1, b);
#pragma unroll
                for (int b = 0; b < 5; ++b) x1[8 + b] = P8_CV(2, b);
#pragma unroll
                for (int b = 0; b < 3; ++b) x1[13 + b] = P8_CV(3, b);
                x2[0] = P8_CV(3, 3);
#pragma unroll
                for (int b = 0; b < 3; ++b) x2[1 + b] = P8_CV(4, b);
#pragma unroll
                for (int b = 0; b < 2; ++b) { x2[4 + b] = P8_CV(5, b); x2[6 + b] = P8_CV(6, b); x2[8 + b] = P8_CV(7, b); }
                x2[10] = P8_CV(8, 0); x2[11] = P8_CV(9, 0); x2[12] = P8_CV(10, 0); x2[13] = P8_CV(11, 0); x2[14] = P8_CV(12, 0); x2[15] = P8_CV(13, 0);
                x3[0] = P8_CV(14, 0); x3[1] = P8_CV(15, 0);
#pragma unroll
                for (int i = 2; i < 16; ++i) x3[i] = 0u;
#undef P8_CV
                P8_SORT16(x1); P8_SORT16(x2);
                P8_MERGE16(l0, x1, m1); P8_MERGE16(x2, x3, m2); P8_MERGE16(m1, m2, cb);
                unsigned char* slot = lds + 65536 + wave * 2048 + lane * 32;
                { u32x4 w0, w1;
#define P8_IDX4(T, i) ((127u - (T[i] & 127u)) | ((127u - (T[(i) + 1] & 127u)) << 8) | ((127u - (T[(i) + 2] & 127u)) << 16) | ((127u - (T[(i) + 3] & 127u)) << 24))
                  w0.x = P8_IDX4(top[0], 0); w0.y = P8_IDX4(top[0], 4); w0.z = P8_IDX4(top[0], 8); w0.w = P8_IDX4(top[0], 12);
                  w1.x = P8_IDX4(top[1], 0); w1.y = P8_IDX4(top[1], 4); w1.z = P8_IDX4(top[1], 8); w1.w = P8_IDX4(top[1], 12);
#undef P8_IDX4
                  *(u32x4*)slot = w0; *(u32x4*)(slot + 16) = w1; }
                asm volatile("s_waitcnt lgkmcnt(0)" ::: "memory");
                float bv[16]; int be[16];
#pragma unroll
                for (int k = 0; k < 16; ++k) { const unsigned pos = (~cb[k]) & 255u; bv[k] = P8_UNSORT(cb[k] & 0xFFFFFF00u);
                    be[k] = (int)slot[pos >> 4] * 128 + (int)slot[16 + (pos & 15)]; }
                { const float b0 = bv[0];
#pragma unroll
                  for (int k = 0; k < 16; ++k) bv[k] = __expf(bv[k] - b0); }
                asm volatile("s_waitcnt lgkmcnt(0)" ::: "memory");
                if (hi == 0) { int* ep = EIDX + (size_t)m * 128 + 2 * h;
#pragma unroll
                    for (int kk = 0; kk < 8; ++kk) { u32x2 w; w.x = (unsigned)be[kk]; w.y = (unsigned)be[kk + 8]; *(u32x2*)(ep + kk * 16) = w; } }
                else { float* gp = EGATE + (size_t)m * 128 + 2 * h; float s2 = 0.f;
#pragma unroll
                    for (int k = 0; k < 16; ++k) s2 += bv[k];
                    const float inv = 1.f / s2;
#pragma unroll
                    for (int kk = 0; kk < 8; ++kk) { u32x2 w; w.x = __float_as_uint(bv[kk] * inv); w.y = __float_as_uint(bv[kk + 8] * inv); *(u32x2*)(gp + kk * 16) = w; } }
            }
            __syncthreads();
        }
#undef P8_SORTABLE
#undef P8_UNSORT
#undef P8_INSERT
#undef P8_CE
#undef P8_SORT16
#undef P8_MERGE16
    }
    SEAM(8);
#define UB(w, e) ((float)(((w) >> (8 * (e))) & 0xffu))
#define DPP_ADD(v, ctrl) v += __builtin_bit_cast(float, __builtin_amdgcn_update_dpp(0, __builtin_bit_cast(int, v), (ctrl), 0xf, 0xf, false))
    volatile unsigned* MISCW = (volatile unsigned*)(lds + MISC_OFF);
    const int x_nloc = (MK_N_LAUNCHES == 1) ? (int)MISCW[8] : G, x_nx = (MK_N_LAUNCHES == 1) ? (int)MISCW[9] : 1, x_rank = (MK_N_LAUNCHES == 1) ? (int)MISCW[10] : (int)blockIdx.x, x_ord = (MK_N_LAUNCHES == 1) ? (int)MISCW[11] : 0;
    if (IN(9)) {
        const int g = lane >> 3, c = lane & 7;
        const int tstep = x_nloc * NWAVES;
        for (int sl = x_ord; sl < 8; sl += x_nx) {
            const unsigned char* ub = UT + (size_t)sl * (16384 * 128) + 16 * c;
            const bf16_t* xbase = X1B + sl * 128 + 16 * c;
#define P9_IDX(I4, XA, XB, tt) do { const int t_ = (tt) < M_ ? (tt) : M_ - 1; const u32x4* ep_ = (const u32x4*)(EIDX + (size_t)t_ * 128 + g * 16); \
            I4[0] = ep_[0]; I4[1] = ep_[1]; I4[2] = ep_[2]; I4[3] = ep_[3]; XA = *(const u32x4*)(xbase + (size_t)t_ * DM); XB = *(const u32x4*)(xbase + (size_t)t_ * DM + 8); } while (0)
#define P9_ROWS(U, I4, hf) do { _Pragma("unroll") for (int i = 0; i < 8; ++i) U[i] = *(const u32x4*)(ub + (size_t)I4[2 * (hf) + (i >> 2)][i & 3] * 128); } while (0)
#define P9_HALF(U, hf) do { _Pragma("unroll") for (int i = 0; i < 8; ++i) { int a = __builtin_amdgcn_sdot4((int)xq[0], (int)U[i][0], 0, false); a = __builtin_amdgcn_sdot4((int)xq[1], (int)U[i][1], a, false); \
                a = __builtin_amdgcn_sdot4((int)xq[2], (int)U[i][2], a, false); a = __builtin_amdgcn_sdot4((int)xq[3], (int)U[i][3], a, false); \
                a += __builtin_amdgcn_update_dpp(0, a, 0xB1, 0xf, 0xf, false); a += __builtin_amdgcn_update_dpp(0, a, 0x4E, 0xf, 0xf, false); a += __builtin_amdgcn_update_dpp(0, a, 0x141, 0xf, 0xf, false); \
                z0 = (8 * (hf) + i == 2 * c) ? a : z0; z1 = (8 * (hf) + i == 2 * c + 1) ? a : z1; } } while (0)
            u32x4 iC[4], iN[4], iNN[4], xaC, xbC, xaN, xbN, xaNN, xbNN, uA[8], uB[8];
            int t = x_rank * NWAVES + wave;
            P9_IDX(iC, xaC, xbC, t); P9_IDX(iN, xaN, xbN, t + tstep); P9_ROWS(uA, iC, 0);
            for (; t < M_; t += tstep) {
                P9_ROWS(uB, iC, 1); P9_IDX(iNN, xaNN, xbNN, t + 2 * tstep);
                float xf[16];
#pragma unroll
                for (int q = 0; q < 4; ++q) { xf[2 * q] = __uint_as_float(xaC[q] << 16); xf[2 * q + 1] = __uint_as_float(xaC[q] & 0xffff0000u); xf[8 + 2 * q] = __uint_as_float(xbC[q] << 16); xf[8 + 2 * q + 1] = __uint_as_float(xbC[q] & 0xffff0000u); }
                float mx = 1e-30f;
#pragma unroll
                for (int j = 0; j < 16; ++j) mx = fmaxf(mx, fabsf(xf[j]));
                mx = fmaxf(mx, __builtin_bit_cast(float, __builtin_amdgcn_update_dpp(0, __builtin_bit_cast(int, mx), 0xB1, 0xf, 0xf, false)));
                mx = fmaxf(mx, __builtin_bit_cast(float, __builtin_amdgcn_update_dpp(0, __builtin_bit_cast(int, mx), 0x4E, 0xf, 0xf, false)));
                mx = fmaxf(mx, __builtin_bit_cast(float, __builtin_amdgcn_update_dpp(0, __builtin_bit_cast(int, mx), 0x141, 0xf, 0xf, false)));
                const float xinv = 127.f * __builtin_amdgcn_rcpf(mx), xsc = mx * (1.f / 127.f);
                unsigned xq[4];
#pragma unroll
                for (int q = 0; q < 4; ++q) { unsigned b = 0;
#pragma unroll
                    for (int e = 0; e < 4; ++e) { const int qi = (int)rintf(xf[4 * q + e] * xinv); b |= ((unsigned)qi & 0xffu) << (8 * e); }
                    xq[q] = b; }
                int z0 = 0, z1 = 0;
                P9_HALF(uA, 0);
                P9_ROWS(uA, iN, 0);
                P9_HALF(uB, 1);
                { u32x2 w; w.x = __float_as_uint((float)z0 * xsc); w.y = __float_as_uint((float)z1 * xsc); *(u32x2*)(ZP + ((size_t)sl * M_ + t) * 128 + g * 16 + 2 * c) = w; }
#pragma unroll
                for (int q = 0; q < 4; ++q) { iC[q] = iN[q]; iN[q] = iNN[q]; }
                xaC = xaN; xbC = xbN; xaN = xaNN; xbN = xbNN;
            }
#undef P9_HALF
#undef P9_IDX
#undef P9_ROWS
        }
    }
    SEAM(9);
    if (IN(10)) {
        for (int t = gw; t < M_; t += NGW) { const float r = rsqrtf(SSX1[t] * (1.f / DM) + EPS); float av[2]; float mx = 1e-30f;
#pragma unroll
            for (int v = 0; v < 2; ++v) { const int p = lane + 64 * v; const int e = EIDX[(size_t)t * 128 + p]; float zs[8];
#pragma unroll
                for (int j = 0; j < 8; ++j) zs[j] = ZP[((size_t)j * M_ + t) * 128 + p];
                float z = ((zs[0] + zs[1]) + (zs[2] + zs[3])) + ((zs[4] + zs[5]) + (zs[6] + zs[7]));
                z *= SU[e] * r;
                av[v] = 0.5f * z * (1.f + erff(z * 0.70710678118654752f)) * EGATE[(size_t)t * 128 + p] * SV[e];
                mx = fmaxf(mx, fabsf(av[v])); }
#pragma unroll
            for (int o = 1; o < 64; o <<= 1) mx = fmaxf(mx, __shfl_xor(mx, o));
            const float inv = 127.f / mx;
            CQ[(size_t)t * 128 + lane] = (signed char)(int)rintf(av[0] * inv); CQ[(size_t)t * 128 + 64 + lane] = (signed char)(int)rintf(av[1] * inv);
            if (lane == 0) CS[t] = mx * (1.f / 127.f); }
    }
    SEAM(10);
    if (IN(11)) {
        const int g = lane >> 3, c = lane & 7;
        const int tstep = x_nloc * NWAVES;
        for (int sl = x_ord; sl < 8; sl += x_nx) {
            const unsigned char* vb = VT + (size_t)sl * (16384 * 128) + 16 * c;
#define P11_IDX(I4, C4, tt) do { const int t_ = (tt) < M_ ? (tt) : M_ - 1; const u32x4* ep_ = (const u32x4*)(EIDX + (size_t)t_ * 128 + g * 16); \
            I4[0] = ep_[0]; I4[1] = ep_[1]; I4[2] = ep_[2]; I4[3] = ep_[3]; C4 = *(const u32x4*)(CQ + (size_t)t_ * 128 + g * 16); } while (0)
#define P11_ROWS(U, I4, hf) do { _Pragma("unroll") for (int i = 0; i < 8; ++i) U[i] = *(const u32x4*)(vb + (size_t)I4[2 * (hf) + (i >> 2)][i & 3] * 128); } while (0)
#define P11_BLK(U, b0, q, CW) do { const unsigned d0_ = U[b0][q], d1_ = U[(b0) + 1][q], d2_ = U[(b0) + 2][q], d3_ = U[(b0) + 3][q]; \
            const unsigned t0_ = __builtin_amdgcn_perm(d1_, d0_, 0x05010400u), t1_ = __builtin_amdgcn_perm(d1_, d0_, 0x07030602u), t2_ = __builtin_amdgcn_perm(d3_, d2_, 0x05010400u), t3_ = __builtin_amdgcn_perm(d3_, d2_, 0x07030602u); \
            acc[4 * (q)] = __builtin_amdgcn_sdot4((int)__builtin_amdgcn_perm(t2_, t0_, 0x05040100u), (int)(CW), acc[4 * (q)], false); \
            acc[4 * (q) + 1] = __builtin_amdgcn_sdot4((int)__builtin_amdgcn_perm(t2_, t0_, 0x07060302u), (int)(CW), acc[4 * (q) + 1], false); \
            acc[4 * (q) + 2] = __builtin_amdgcn_sdot4((int)__builtin_amdgcn_perm(t3_, t1_, 0x05040100u), (int)(CW), acc[4 * (q) + 2], false); \
            acc[4 * (q) + 3] = __builtin_amdgcn_sdot4((int)__builtin_amdgcn_perm(t3_, t1_, 0x07060302u), (int)(CW), acc[4 * (q) + 3], false); } while (0)
#define P11_HALF(U, C4, hf) do { _Pragma("unroll") for (int bb = 0; bb < 2; ++bb) { const unsigned cw_ = C4[2 * (hf) + bb]; \
            _Pragma("unroll") for (int q = 0; q < 4; ++q) P11_BLK(U, 4 * bb, q, cw_); } } while (0)
            u32x4 iC[4], iN[4], iNN[4], uA[8], uB[8], cC, cN, cNN;
            const int hi5 = lane >> 5, b3 = (lane >> 3) & 1;
            int t = x_rank * NWAVES + wave;
            P11_IDX(iC, cC, t); P11_IDX(iN, cN, t + tstep); P11_ROWS(uA, iC, 0);
            for (; t < M_; t += tstep) {
                float* op = out + (size_t)t * DM + sl * 128 + 16 * c + 4 * b3 + 8 * hi5;
                const f32x4 x1v = *(const f32x4*)op; const float cs = CS[t];
                P11_ROWS(uB, iC, 1); P11_IDX(iNN, cNN, t + 2 * tstep);
                int acc[16];
#pragma unroll
                for (int j = 0; j < 16; ++j) acc[j] = 0;
                P11_HALF(uA, cC, 0);
                P11_ROWS(uA, iN, 0);
                P11_HALF(uB, cC, 1);
                int w8[8];
#pragma unroll
                for (int j = 0; j < 8; ++j) { auto rr = __builtin_amdgcn_permlane32_swap((unsigned)acc[j], (unsigned)acc[j + 8], false, false); w8[j] = (int)rr[0] + (int)rr[1]; }
#pragma unroll
                for (int j = 0; j < 8; ++j) w8[j] += __shfl_xor(w8[j], 16);
                f32x4 o; float ss = 0.f;
#pragma unroll
                for (int j = 0; j < 4; ++j) { const int keep = b3 ? w8[j + 4] : w8[j]; const int give = b3 ? w8[j] : w8[j + 4];
                    const int tot = keep + __builtin_amdgcn_update_dpp(0, give, 0x128, 0xf, 0xf, false);
                    o[j] = x1v[j] + (float)tot * cs; ss += o[j] * o[j]; }
                if (((lane >> 4) & 1) == 0) *(f32x4*)op = o;
                DPP_ADD(ss, 0x128); DPP_ADD(ss, 0x124); DPP_ADD(ss, 0x122); DPP_ADD(ss, 0x121);
                { const float s0 = __builtin_bit_cast(float, __builtin_amdgcn_readlane(__builtin_bit_cast(int, ss), 0)), s1 = __builtin_bit_cast(float, __builtin_amdgcn_readlane(__builtin_bit_cast(int, ss), 32));
                  if (lane == 0) atomicAdd(SS2 + t, s0 + s1); }
#pragma unroll
                for (int q = 0; q < 4; ++q) { iC[q] = iN[q]; iN[q] = iNN[q]; }
                cC = cN; cN = cNN;
            }
#undef P11_BLK
#undef P11_HALF
#undef P11_IDX
#undef P11_ROWS
        }
    }
    SEAM(11);
    if (IN(12)) {
        for (int m = gw; m < M_; m += NGW) { const float r2 = rsqrtf(SS2[m] * (1.f / DM) + EPS); float* orow = out + (size_t)m * DM;
#pragma unroll
            for (int j = 0; j < 4; ++j) { const int cix = 4 * (lane + 64 * j); const f32x4 gg = *(const f32x4*)(g_final + cix); f32x4 o = *(const f32x4*)(orow + cix);
                o[0] *= r2 * gg[0]; o[1] *= r2 * gg[1]; o[2] *= r2 * gg[2]; o[3] *= r2 * gg[3]; *(f32x4*)(orow + cix) = o; } }
    }
#undef UB
#undef DPP_ADD
#undef IN
#undef SEAM
}

extern "C" void kernel_launch(void* const* d_in, const int* in_sizes, int n_in, void* d_out, int out_size, void* d_ws, size_t ws_size, hipStream_t stream) {
    static int grid = 0;
    if (grid == 0) {
        if (n_in != 20 || out_size != M_ * DM || ws_size < WS_END) { fprintf(stderr, "kernel_launch: unexpected shapes (n_in %d out %d ws %zu); nothing launched\n", n_in, out_size, ws_size); grid = -1; return; }
        int dev = 0, cus = 0;
        if (hipGetDevice(&dev) != hipSuccess || hipDeviceGetAttribute(&cus, hipDeviceAttributeMultiprocessorCount, dev) != hipSuccess) { grid = -1; return; }
        if (hipFuncSetAttribute((const void*)fwd, hipFuncAttributeMaxDynamicSharedMemorySize, LDS_BYTES) != hipSuccess) { fprintf(stderr, "kernel_launch: hipFuncSetAttribute failed\n"); grid = -1; return; }
        int per_cu = 0;
        if (hipOccupancyMaxActiveBlocksPerMultiprocessor(&per_cu, (const void*)fwd, NWAVES * 64, LDS_BYTES) != hipSuccess || per_cu < 1) fprintf(stderr, "kernel_launch: occupancy query reports %d\n", per_cu);
        (void)hipGetLastError();
        grid = cus;
    }
    if (grid < 0) return;
    (void)hipMemsetAsync((char*)d_ws + WS_CTL, 0, CTL_ZERO_BYTES, stream);
    Args a; memset(&a, 0, sizeof(a));
    for (int i = 0; i < 20; ++i) a.in[i] = d_in[i];
    a.out = (float*)d_out; a.ws = (unsigned char*)d_ws;
    if (MK_N_LAUNCHES == 1) { a.ph_lo = 0; a.ph_hi = N_PHASES; hipLaunchKernelGGL(fwd, dim3(grid), dim3(NWAVES * 64), LDS_BYTES, stream, a); }
    else for (int p = 0; p < N_PHASES; ++p) { a.ph_lo = p; a.ph_hi = p + 1; hipLaunchKernelGGL(fwd, dim3(grid), dim3(NWAVES * 64), LDS_BYTES, stream, a); }
}
```

```cpp
#include <hip/hip_runtime.h>
#include <cstdio>
#include <cstdint>
#include <cstring>
#include <math.h>

#ifndef MK_N_LAUNCHES
#define MK_N_LAUNCHES 1
#endif
constexpr int N_PHASES = 13;

typedef unsigned short bf16_t;
constexpr int SEQ = 8192, DM = 1024, M_ = 16384, NCH = 128;
constexpr float EPS = 1e-6f;
constexpr int PB_LD = 2816, PA_LD = 1536;
constexpr int PB_BR = 0, PB_GOUT = 2048, PB_GQ = 2560;
constexpr int PA_GV = 0, PA_GK = 512, PA_QLAT = 768, PA_KVLAT = 1152, PA_KROPE = 1408, PA_GLR = 1440;
constexpr int NPROJ = 4352;
constexpr float CQ = 0.10206207261596577f * 1.4426950408889634f;

constexpr size_t MiB = 1u << 20;
constexpr size_t WS_CTL = 0, CTL_ZERO_BYTES = 256 * 1024;
constexpr size_t WS_SSQ = 1 * MiB, WS_SSKV = WS_SSQ + 65536, WS_SSX1 = WS_SSKV + 65536, WS_SS2 = WS_SSX1 + 65536, WS_C128 = WS_SS2 + 65536  , WS_CB = 136 * MiB  , WS_ZP = 56 * MiB  , WS_COS = 2 * MiB, WS_SIN = 3 * MiB;
constexpr size_t WS_DECAY = 1 * MiB + 512 * 1024;
constexpr size_t WS_WIN = 4 * MiB, WS_WQB = 13 * MiB, WS_WKVB = 14 * MiB, WS_WA = 15 * MiB, WS_WB = 16 * MiB, WS_WOUT = 17 * MiB, WS_WPQ = 19 * MiB, WS_KEYS = 23 * MiB;
constexpr size_t WS_PROJB = 24 * MiB, WS_PROJA = 112 * MiB, WS_XN = 160 * MiB, WS_Q = 160 * MiB, WS_K = 184 * MiB, WS_V = 208 * MiB, WS_DST = 224 * MiB;
constexpr size_t WS_YA = 112 * MiB, WS_YB = 128 * MiB, WS_MERGED = 160 * MiB, WS_X1B = 24 * MiB, WS_QP = 56 * MiB, WS_EIDX = 120 * MiB, WS_EGATE = 128 * MiB;
constexpr size_t WS_KPE = 208 * MiB  , WS_UT = 224 * MiB, WS_VT = 240 * MiB, WS_SU = 1 * MiB + 768 * 1024, WS_SV = WS_SU + 65536;
constexpr size_t WS_END = 256 * MiB;

#define GAS __attribute__((address_space(1)))
#define LAS __attribute__((address_space(3)))
typedef float f32x4 __attribute__((ext_vector_type(4)));
typedef unsigned u32x4 __attribute__((ext_vector_type(4)));
typedef unsigned u32x2 __attribute__((ext_vector_type(2)));

__device__ __forceinline__ float bf2f(bf16_t h) { return __uint_as_float(((unsigned)h) << 16); }
__device__ __forceinline__ unsigned f2bf_u(float f) { unsigned u = __float_as_uint(f); return (u + 0x7fffu + ((u >> 16) & 1u)) >> 16; }
__device__ __forceinline__ bf16_t f2bf(float f) { return (bf16_t)f2bf_u(f); }
__device__ __forceinline__ unsigned pk2(float lo, float hi) { return f2bf_u(lo) | (f2bf_u(hi) << 16); }
__device__ __forceinline__ float wave_sum(float v) {
#pragma unroll
    for (int o = 1; o < 64; o <<= 1) v += __shfl_xor(v, o);
    return v;
}
__device__ __forceinline__ float sigmoidf_(float x) { return 1.f / (1.f + __expf(-x)); }

namespace pg8 {
#define PG8_LAS __attribute__((address_space(3)))
typedef short bf16x8 __attribute__((ext_vector_type(8)));
constexpr int BM = 256, BK = 64, HALF = 128, HTB = HALF * BK * 2, STAGE_BYTES = 8 * HTB, NXCD = 8, WGM = 8;
__host__ __device__ __forceinline__ int lds_byte(int r, int c) { const int st = (r >> 4) * 2 + (c >> 5), rr = r & 15, cc = c & 31, ob = rr * 64 + cc * 2; return st * 1024 + (ob ^ (((ob >> 9) & 1) << 5)); }
__host__ __device__ __forceinline__ void stage_rc(int b, int& R, int& C) { const int st = b / 1024, sb = b % 1024, swz = sb ^ (((sb >> 9) & 1) << 5); R = (st >> 1) * 16 + swz / 64; C = (st & 1) * 32 + (swz % 64) / 2; }
__host__ __device__ __forceinline__ int perm32(int rho) { const int n = rho >> 4, i = rho & 15; return 8 * (i >> 2) + 4 * n + (i & 3); }

struct Unit { int pm, pn, sub; const char* A; const char* B; };
struct Gemm { const bf16_t* A; const bf16_t* Bt; const bf16_t* A2; const bf16_t* Bt2; int lda, ldb, M, N, K, chain; };
struct StaticOrder {
    int nM, nN, nwg, G, c, chain; const char *A, *B, *A2, *B2; size_t tsA, tsB;
    __device__ __forceinline__ void init(const Gemm& g, int G_, int c_) { nM = g.M / BM; nN = g.N / BM; nwg = nM * nN; G = G_; c = c_; chain = g.chain; A = (const char*)g.A; B = (const char*)g.Bt; A2 = (const char*)g.A2; B2 = (const char*)g.Bt2;
        tsA = (size_t)BM * g.lda * 2; tsB = (size_t)BM * g.ldb * 2; }
    int pair_mode = 0;
    __device__ __forceinline__ bool next(int i, Unit& u) const {
        if (pair_mode) { const int item = c + (i >> 1) * G; if (item >= nwg / 2) return false; u.pm = 2 * (item >> 3) + (i & 1); u.pn = item & 7; u.sub = 0; u.A = A + (size_t)u.pm * tsA; u.B = B + (size_t)u.pn * tsB; return true; }
        const int r = (chain == 2) ? (i >> 1) : i, sub = (chain == 2) ? (i & 1) : 0;
        const long L = (long)r * G + c; if (L >= nwg) return false;
        int wgid = (int)L; { const int q = nwg / NXCD, rr = nwg % NXCD, xcd = wgid % NXCD, off = wgid / NXCD; wgid = (xcd < rr ? xcd * (q + 1) : rr * (q + 1) + (xcd - rr) * q) + off; }
        const int nig = WGM * nN, gid = wgid / nig, fm = gid * WGM, gsz = (nM - fm) < WGM ? (nM - fm) : WGM;
        u.pm = fm + ((wgid % nig) % gsz); u.pn = (wgid % nig) / gsz; u.sub = sub;
        u.A = (sub ? A2 : A) + (size_t)u.pm * tsA; u.B = (sub ? B2 : B) + (size_t)u.pn * tsB; return true;
    }
};
__device__ __forceinline__ unsigned cvt_pk_bf16(float lo, float hi) { unsigned r; asm volatile("v_cvt_pk_bf16_f32 %0, %1, %2" : "=v"(r) : "v"(lo), "v"(hi)); return r; }

typedef f32x4 AccT[2][2][4][2];
template <class Epi, class Sched, bool ALIGN_EPI>
__device__ __forceinline__ void gemm_phase(PG8_LAS unsigned char* lds, const Gemm g, const Sched& S, const Epi& E) {
    const int tid = threadIdx.x, wid = __builtin_amdgcn_readfirstlane(tid >> 6), lane = tid & 63, wr = wid >> 2, wc = wid & 3, fr = lane & 15, fq = lane >> 4;
    const int K = g.K, nt = K / BK;
    unsigned voffA[2], voffB[2];
#pragma unroll
    for (int i = 0; i < 2; ++i) { int R, C; stage_rc(tid * 16 + i * 8192, R, C); const int Rb = Epi::PERM ? ((R & ~31) + perm32(R & 31)) : R;
        voffA[i] = (unsigned)(R * g.lda + C) * 2u; voffB[i] = (unsigned)(Rb * g.ldb + C) * 2u; }
    const size_t kstep = (size_t)(BK * 2);
    const size_t hsA = (size_t)HALF * g.lda * 2, hsB = (size_t)HALF * g.ldb * 2;
    const unsigned ldsw = (unsigned)wid * 1024u;
    const int aoff = lds_byte(wr * 64 + fr, fq * 8), boff = lds_byte(wc * 32 + fr, fq * 8);
#define PG8_SA(b, h) (((b) * 2 + (h)) * HTB)
#define PG8_SB(b, h) ((4 + (b) * 2 + (h)) * HTB)
#define PG8_STAGE(bufoff, gbase, voff) do { _Pragma("unroll") for (int _i = 0; _i < 2; ++_i) \
        __builtin_amdgcn_global_load_lds((const unsigned*)((const char*)(gbase) + (voff)[_i]), (PG8_LAS unsigned*)(lds + (bufoff) + ldsw + _i * 8192), 16, 0, 0); } while (0)
#define PG8_LDA(dst, b, h) do { _Pragma("unroll") for (int m = 0; m < 4; ++m) _Pragma("unroll") for (int k = 0; k < 2; ++k) dst[m][k] = *(const PG8_LAS bf16x8*)(lds + PG8_SA(b, h) + aoff + m * 2048 + k * 1024); } while (0)
#define PG8_LDB(dst, b, h) do { _Pragma("unroll") for (int n = 0; n < 2; ++n) _Pragma("unroll") for (int k = 0; k < 2; ++k) dst[n][k] = *(const PG8_LAS bf16x8*)(lds + PG8_SB(b, h) + boff + n * 2048 + k * 1024); } while (0)
#define PG8_MMA(ai, bj, At, Bt) do { __builtin_amdgcn_s_setprio(1); _Pragma("unroll") for (int m = 0; m < 4; ++m) _Pragma("unroll") for (int n = 0; n < 2; ++n) _Pragma("unroll") for (int k = 0; k < 2; ++k) \
        acc[ai][bj][m][n] = __builtin_amdgcn_mfma_f32_16x16x32_bf16(Bt[n][k], At[m][k], acc[ai][bj][m][n], 0, 0, 0); __builtin_amdgcn_s_setprio(0); } while (0)
#define PG8_WAIT_V(n) asm volatile("s_waitcnt vmcnt(" #n ")" ::: "memory")
#define PG8_WAIT_L(n) asm volatile("s_waitcnt lgkmcnt(" #n ")" ::: "memory")
#define PG8_BAR __builtin_amdgcn_s_barrier()
#define PG8_SCHED __builtin_amdgcn_sched_barrier(0)
    Unit cur, nxt; int ui = 0;
    if (!S.next(0, cur)) return;
    f32x4 acc[2][2][4][2];
#pragma unroll
    for (int a = 0; a < 2; ++a)
#pragma unroll
        for (int b = 0; b < 2; ++b)
#pragma unroll
            for (int m = 0; m < 4; ++m)
#pragma unroll
                for (int n = 0; n < 2; ++n) acc[a][b][m][n] = (f32x4){0.f, 0.f, 0.f, 0.f};
    bf16x8 At[4][2], B0[2][2], B1[2][2];
    const char* cA = cur.A; const char* cB = cur.B;
    PG8_STAGE(PG8_SB(0, 0), cB, voffB); PG8_STAGE(PG8_SB(0, 1), cB + hsB, voffB); PG8_STAGE(PG8_SA(0, 0), cA, voffA); PG8_STAGE(PG8_SA(0, 1), cA + hsA, voffA);
    if (wr == 1) PG8_BAR;
    PG8_WAIT_V(2); PG8_BAR;
    PG8_STAGE(PG8_SB(1, 0), cB + kstep, voffB); PG8_STAGE(PG8_SA(1, 0), cA + kstep, voffA); PG8_STAGE(PG8_SB(1, 1), cB + hsB + kstep, voffB);
    PG8_WAIT_V(6); PG8_BAR;
    for (;;) {
        const bool has_next = S.next(ui + 1, nxt);
        const char* nA = has_next ? nxt.A : cA; const char* nB = has_next ? nxt.B : cB;
        for (int t = 0; t < nt; t += 2) {
            const bool last = (t == nt - 2);
            const char* a1 = cA + (size_t)(t + 1) * kstep;
            const char* a2 = last ? nA : cA + (size_t)(t + 2) * kstep; const char* b2 = last ? nB : cB + (size_t)(t + 2) * kstep;
            const char* a3 = a2 + kstep; const char* b3 = b2 + kstep;
            PG8_LDB(B0, 0, 0); PG8_LDB(B1, 0, 1); PG8_SCHED; PG8_LDA(At, 0, 0); PG8_STAGE(PG8_SA(1, 1), a1 + hsA, voffA);
            PG8_WAIT_V(8); PG8_WAIT_L(0); PG8_BAR; PG8_MMA(0, 0, At, B0); PG8_MMA(0, 1, At, B1); PG8_BAR; PG8_SCHED;
            PG8_LDA(At, 0, 1); PG8_STAGE(PG8_SB(0, 0), b2, voffB); PG8_STAGE(PG8_SB(0, 1), b2 + hsB, voffB); PG8_STAGE(PG8_SA(0, 0), a2, voffA);
            PG8_WAIT_V(8); PG8_WAIT_L(0); PG8_BAR; PG8_MMA(1, 0, At, B0); PG8_MMA(1, 1, At, B1); PG8_BAR; PG8_SCHED;
            PG8_LDB(B0, 1, 0); PG8_LDB(B1, 1, 1); PG8_SCHED; PG8_LDA(At, 1, 0); PG8_STAGE(PG8_SA(0, 1), a2 + hsA, voffA);
            PG8_WAIT_V(8); PG8_WAIT_L(0); PG8_BAR; PG8_MMA(0, 0, At, B0); PG8_MMA(0, 1, At, B1); PG8_BAR; PG8_SCHED;
            PG8_LDA(At, 1, 1); PG8_STAGE(PG8_SB(1, 0), b3, voffB); PG8_STAGE(PG8_SB(1, 1), b3 + hsB, voffB); PG8_STAGE(PG8_SA(1, 0), a3, voffA);
            PG8_WAIT_V(8); PG8_WAIT_L(0); PG8_BAR; PG8_MMA(1, 0, At, B0); PG8_MMA(1, 1, At, B1); PG8_BAR; PG8_SCHED;
        }
        if constexpr (ALIGN_EPI) { if (wr == 0) PG8_BAR; }
        E(acc, cur, wr, wc, fr, fq);
        if (!has_next) break;
        if (!(Epi::CHAIN && nxt.sub != 0)) {
#pragma unroll
            for (int a = 0; a < 2; ++a)
#pragma unroll
                for (int b = 0; b < 2; ++b)
#pragma unroll
                    for (int m = 0; m < 4; ++m)
#pragma unroll
                        for (int n = 0; n < 2; ++n) acc[a][b][m][n] = (f32x4){0.f, 0.f, 0.f, 0.f};
        }
        cur = nxt; cA = nA; cB = nB; ++ui;
        if constexpr (ALIGN_EPI) { if (wr == 1) PG8_BAR; }
    }
    PG8_WAIT_V(0);
    if constexpr (!ALIGN_EPI) { if (wr == 0) PG8_BAR; }
    PG8_BAR;
#undef PG8_SA
#undef PG8_SB
#undef PG8_STAGE
#undef PG8_LDA
#undef PG8_LDB
#undef PG8_MMA
#undef PG8_WAIT_V
#undef PG8_WAIT_L
#undef PG8_BAR
#undef PG8_SCHED
}

struct EpiProj {
    static constexpr bool PERM = true, CHAIN = false;
    bf16_t* pb; bf16_t* pa; float* ssq; float* sskv;
    __device__ __forceinline__ void operator()(AccT& acc, const Unit& u, int wr, int wc, int fr, int fq) const {
        const int row0 = u.pm * BM + wr * 64 + fr;
#pragma unroll
        for (int bj = 0; bj < 2; ++bj) {
            const int hk = u.pn * 2 + bj;
            bf16_t* base; int ld; float* ss = nullptr;
            if (hk < 22) { base = pb + hk * 128; ld = PB_LD; } else { const int ha = hk - 22; base = pa + ha * 128; ld = PA_LD; if (ha >= 6 && ha <= 8) ss = ssq; else if (ha == 9 || ha == 10) ss = sskv; }
            base += wc * 32 + 8 * fq;
#pragma unroll
            for (int ai = 0; ai < 2; ++ai)
#pragma unroll
                for (int m = 0; m < 4; ++m) { const int row = row0 + ai * HALF + m * 16; const f32x4 v0 = acc[ai][bj][m][0], v1 = acc[ai][bj][m][1];
                    u32x4 w; w.x = cvt_pk_bf16(v0[0], v0[1]); w.y = cvt_pk_bf16(v0[2], v0[3]); w.z = cvt_pk_bf16(v1[0], v1[1]); w.w = cvt_pk_bf16(v1[2], v1[3]);
                    *(u32x4*)(base + (size_t)row * ld) = w;
                    if (ss) { float s = (v0[0] * v0[0] + v0[1] * v0[1]) + (v0[2] * v0[2] + v0[3] * v0[3]) + (v1[0] * v1[0] + v1[1] * v1[1]) + (v1[2] * v1[2] + v1[3] * v1[3]);
                        s += __shfl_xor(s, 16); s += __shfl_xor(s, 32); if (fq == 0) atomicAdd(ss + row, s); } }
        }
    }
};
struct EpiQ {
    static constexpr bool PERM = false, CHAIN = false;
    bf16_t* Q; const float* ssq; const float* cs; const float* sn;
    __device__ __forceinline__ void operator()(AccT& acc, const Unit& u, int wr, int wc, int fr, int fq) const {
        const int row0 = u.pm * BM + wr * 64 + fr;
#pragma unroll
        for (int ai = 0; ai < 2; ++ai)
#pragma unroll
            for (int m = 0; m < 4; ++m) { const int row = row0 + ai * HALF + m * 16; const float rr = rsqrtf(ssq[row] * (1.f / 384.f) + EPS) * CQ;
#pragma unroll
                for (int bj = 0; bj < 2; ++bj) { const int G = u.pn * 8 + bj * 4 + wc;
                    f32x4 x0 = acc[ai][bj][m][0], x1 = acc[ai][bj][m][1];
                    if (G % 3 == 2) { const f32x4 c = *(const f32x4*)(cs + (size_t)row * 16 + 4 * fq), s = *(const f32x4*)(sn + (size_t)row * 16 + 4 * fq);
                        const f32x4 o0 = x0 * c - x1 * s, o1 = x1 * c + x0 * s; x0 = o0; x1 = o1; }
                    x0 = x0 * rr; x1 = x1 * rr;
                    bf16_t* p = Q + (size_t)row * 768 + G * 32 + 4 * fq;
                    u32x2 w0, w1; w0.x = cvt_pk_bf16(x0[0], x0[1]); w0.y = cvt_pk_bf16(x0[2], x0[3]); w1.x = cvt_pk_bf16(x1[0], x1[1]); w1.y = cvt_pk_bf16(x1[2], x1[3]);
                    *(u32x2*)p = w0; *(u32x2*)(p + 16) = w1; } }
    }
};
struct EpiKV {
    static constexpr bool PERM = true, CHAIN = false;
    bf16_t* Kb; bf16_t* Vb; const float* sskv;
    __device__ __forceinline__ void operator()(AccT& acc, const Unit& u, int wr, int wc, int fr, int fq) const {
        const int row0 = u.pm * BM + wr * 64 + fr;
#pragma unroll
        for (int ai = 0; ai < 2; ++ai)
#pragma unroll
            for (int m = 0; m < 4; ++m) { const int row = row0 + ai * HALF + m * 16; const float rr = rsqrtf(sskv[row] * (1.f / 256.f) + EPS);
#pragma unroll
                for (int bj = 0; bj < 2; ++bj) { const int head = u.pn * 2 + bj; const f32x4 v0 = acc[ai][bj][m][0] * rr, v1 = acc[ai][bj][m][1] * rr;
                    u32x4 w; w.x = cvt_pk_bf16(v0[0], v0[1]); w.y = cvt_pk_bf16(v0[2], v0[3]); w.z = cvt_pk_bf16(v1[0], v1[1]); w.w = cvt_pk_bf16(v1[2], v1[3]);
                    bf16_t* p = (wc < 2) ? Kb + (size_t)row * 768 + head * 96 + wc * 32 + 8 * fq : Vb + (size_t)row * 512 + head * 64 + (wc - 2) * 32 + 8 * fq;
                    *(u32x4*)p = w; } }
    }
};
struct EpiMerge {
    static constexpr bool PERM = true, CHAIN = true;
    const bf16_t* pb; bf16_t* merged;
    __device__ __forceinline__ void operator()(AccT& acc, const Unit& u, int wr, int wc, int fr, int fq) const {
        const int row0 = u.pm * BM + wr * 64 + fr, col0 = u.pn * BM + wc * 32 + 8 * fq;
#pragma unroll
        for (int ai = 0; ai < 2; ++ai)
#pragma unroll
            for (int m = 0; m < 4; ++m) { const int row = row0 + ai * HALF + m * 16;
#pragma unroll
                for (int bj = 0; bj < 2; ++bj) { const int col = col0 + bj * HALF;
                    const u32x4 gb = *(const u32x4*)(pb + (size_t)row * PB_LD + PB_BR + 1024 + col);
                    float eb[8];
#pragma unroll
                    for (int e = 0; e < 4; ++e) { eb[2 * e] = 1.f + __builtin_amdgcn_exp2f(__uint_as_float(gb[e] << 16) * -1.4426950408889634f); eb[2 * e + 1] = 1.f + __builtin_amdgcn_exp2f(__uint_as_float(gb[e] & 0xffff0000u) * -1.4426950408889634f); }
                    if (u.sub == 0) {
                        const u32x4 ga = *(const u32x4*)(pb + (size_t)row * PB_LD + PB_BR + col);
#pragma unroll
                        for (int e = 0; e < 4; ++e) { const float ea0 = 1.f + __builtin_amdgcn_exp2f(__uint_as_float(ga[e] << 16) * -1.4426950408889634f), ea1 = 1.f + __builtin_amdgcn_exp2f(__uint_as_float(ga[e] & 0xffff0000u) * -1.4426950408889634f);
                            const int i0 = 2 * e, i1 = 2 * e + 1;
                            acc[ai][bj][m][i0 >> 2][i0 & 3] *= eb[i0] * __builtin_amdgcn_rcpf(ea0); acc[ai][bj][m][i1 >> 2][i1 & 3] *= eb[i1] * __builtin_amdgcn_rcpf(ea1); }
                    } else {
                        const f32x4 v0 = acc[ai][bj][m][0], v1 = acc[ai][bj][m][1];
                        float sb[8];
#pragma unroll
                        for (int e = 0; e < 8; ++e) sb[e] = __builtin_amdgcn_rcpf(eb[e]);
                        u32x4 w; w.x = cvt_pk_bf16(v0[0] * sb[0], v0[1] * sb[1]); w.y = cvt_pk_bf16(v0[2] * sb[2], v0[3] * sb[3]); w.z = cvt_pk_bf16(v1[0] * sb[4], v1[1] * sb[5]); w.w = cvt_pk_bf16(v1[2] * sb[6], v1[3] * sb[7]);
                        *(u32x4*)(merged + (size_t)row * DM + col) = w; } } }
    }
};
struct EpiX1 {
    static constexpr bool PERM = false, CHAIN = false;
    const float* x; float* x1; bf16_t* x1b; float* ssx1;
    __device__ __forceinline__ void operator()(AccT& acc, const Unit& u, int wr, int wc, int fr, int fq) const {
        const int row0 = u.pm * BM + wr * 64 + fr, col0 = u.pn * BM + wc * 32 + 4 * fq;
#pragma unroll
        for (int ai = 0; ai < 2; ++ai)
#pragma unroll
            for (int m = 0; m < 4; ++m) { const int row = row0 + ai * HALF + m * 16; const size_t off = (size_t)row * DM + col0; float s = 0.f;
#pragma unroll
                for (int bj = 0; bj < 2; ++bj)
#pragma unroll
                    for (int n = 0; n < 2; ++n) { const size_t o = off + bj * HALF + n * 16; const f32x4 v = *(const f32x4*)(x + o) + acc[ai][bj][m][n];
                        *(f32x4*)(x1 + o) = v; u32x2 w; w.x = cvt_pk_bf16(v[0], v[1]); w.y = cvt_pk_bf16(v[2], v[3]); *(u32x2*)(x1b + o) = w;
                        s += (v[0] * v[0] + v[1] * v[1]) + (v[2] * v[2] + v[3] * v[3]); }
                s += __shfl_xor(s, 16); s += __shfl_xor(s, 32); if (fq == 0) atomicAdd(ssx1 + row, s); }
    }
};
struct EpiQP {
    static constexpr bool PERM = true, CHAIN = false;
    bf16_t* qp; const float* ssx1;
    __device__ __forceinline__ void operator()(AccT& acc, const Unit& u, int wr, int wc, int fr, int fq) const {
        const int row0 = u.pm * BM + wr * 64 + fr, col0 = u.pn * BM + wc * 32 + 8 * fq;
#pragma unroll
        for (int ai = 0; ai < 2; ++ai)
#pragma unroll
            for (int m = 0; m < 4; ++m) { const int row = row0 + ai * HALF + m * 16; const float rr = rsqrtf(ssx1[row] * (1.f / 1024.f) + EPS);
#pragma unroll
                for (int bj = 0; bj < 2; ++bj) { const f32x4 v0 = acc[ai][bj][m][0] * rr, v1 = acc[ai][bj][m][1] * rr;
                    u32x4 w; w.x = cvt_pk_bf16(v0[0], v0[1]); w.y = cvt_pk_bf16(v0[2], v0[3]); w.z = cvt_pk_bf16(v1[0], v1[1]); w.w = cvt_pk_bf16(v1[2], v1[3]);
                    *(u32x4*)(qp + (size_t)row * 2048 + col0 + bj * HALF) = w; } }
    }
};
}


namespace att {
typedef short bf16x8 __attribute__((ext_vector_type(8)));
typedef short s16x4 __attribute__((ext_vector_type(4)));
typedef float f32x16 __attribute__((ext_vector_type(16)));
constexpr int NW = 8, QBLK = 32, KVBLK = 64, QB = NW * QBLK;
constexpr int QS = 768, KS = 768, VS = 512, OS = 512;
constexpr int SHM_V = KVBLK * 64 * 2, SHM_K = KVBLK * 256;
constexpr int LDS_BYTES = 2 * SHM_V + 2 * SHM_K + NW * 64 * 4;
constexpr float THR = 8.f;
#define KSWZ(row, colB) ((row) * 256 + ((colB) ^ (((row) & 15) << 4)))
#define SBAR() __builtin_amdgcn_sched_barrier(0)
__device__ __forceinline__ int v_st(int k, int c) { const int kk = (k & ~0xC) | ((k & 4) << 1) | ((k & 8) >> 1); return ((kk >> 3) * 2 + (c >> 5)) * 512 + ((kk & 7) * 32 + (c & 31)) * 2; }
__device__ __forceinline__ int v_rd_base(int lane) { return ((lane & 3) << 3) | (((lane >> 2) & 3) << 6) | (((lane >> 4) & 1) << 5) | (((lane >> 5) & 1) << 8); }
constexpr int v_rd_off(int d0, int ks, int half) { return d0 * 512 + ks * 2048 + half * 1024; }
__device__ __forceinline__ int crow(int r, int hi) { return (r & 3) + 8 * (r >> 2) + 4 * hi; }
__device__ __forceinline__ unsigned cvtpk(float lo, float hi) { unsigned r; asm volatile("v_cvt_pk_bf16_f32 %0, %1, %2" : "=v"(r) : "v"(lo), "v"(hi)); return r; }
__device__ __forceinline__ bf16x8 load8(const bf16_t* p) { return *reinterpret_cast<const bf16x8*>(p); }
__device__ __forceinline__ void partialSM(f32x16& p0, f32x16& p1, float& m_reg, float& mn, float& alpha) {
    float pmax = p0[0]; for (int r = 1; r < 16; ++r) pmax = fmaxf(pmax, p0[r]); for (int r = 0; r < 16; ++r) pmax = fmaxf(pmax, p1[r]);
    { auto rr = __builtin_amdgcn_permlane32_swap(__float_as_uint(pmax), __float_as_uint(pmax), false, false);
      pmax = fmaxf(__uint_as_float(rr[0]), __uint_as_float(rr[1])); }
    if (__builtin_expect(__all((pmax - m_reg) <= THR), 1)) { mn = m_reg; alpha = 1.f; }
    else { mn = fmaxf(m_reg, pmax); alpha = __builtin_amdgcn_exp2f(m_reg - mn); m_reg = mn; }
    for (int r = 0; r < 16; ++r) p0[r] = p0[r] - mn; for (int r = 0; r < 16; ++r) p1[r] = p1[r] - mn;
    for (int r = 0; r < 16; ++r) p0[r] = __builtin_amdgcn_exp2f(p0[r]);
}
__device__ __forceinline__ void finishSM(f32x16& p0, f32x16& p1, float alpha, float& l_reg, bf16x8& pa0, bf16x8& pa1, bf16x8& pa2, bf16x8& pa3) {
    for (int r = 0; r < 16; ++r) p1[r] = __builtin_amdgcn_exp2f(p1[r]);
    float ps = 0; for (int r = 0; r < 16; ++r) ps += p0[r]; for (int r = 0; r < 16; ++r) ps += p1[r];
    { auto rr = __builtin_amdgcn_permlane32_swap(__float_as_uint(ps), __float_as_uint(ps), false, false);
      ps = __uint_as_float(rr[0]) + __uint_as_float(rr[1]); }
    l_reg = l_reg * alpha + ps;
#define PK4(P, B_, OUT) do { unsigned a0 = cvtpk(P[B_+0], P[B_+1]), a1 = cvtpk(P[B_+2], P[B_+3]);                          \
        unsigned b0 = cvtpk(P[B_+4], P[B_+5]), b1 = cvtpk(P[B_+6], P[B_+7]);                                             \
        auto r0 = __builtin_amdgcn_permlane32_swap(a0, b0, false, false); auto r1 = __builtin_amdgcn_permlane32_swap(a1, b1, false, false); \
        u32x4 w = {r0[0], r1[0], r0[1], r1[1]}; OUT = *reinterpret_cast<bf16x8*>(&w); } while (0)
    PK4(p0, 0, pa0); PK4(p0, 8, pa1); PK4(p1, 0, pa2); PK4(p1, 8, pa3);
#undef PK4
}
template <int KB>
__device__ __forceinline__ void qkt(f32x16& p0, f32x16& p1, const char* K_lds, int r32, int hi, const bf16x8* qr) {
    p0 = f32x16{}; p1 = f32x16{};
#pragma unroll
    for (int d0 = 0; d0 < 6; ++d0) { const char* a = K_lds + KB * SHM_K + KSWZ(r32, (d0 * 16 + hi * 8) * 2);
        bf16x8 b0 = *reinterpret_cast<const bf16x8*>(a);
        bf16x8 b1 = *reinterpret_cast<const bf16x8*>(a + 32 * 256);
        p0 = __builtin_amdgcn_mfma_f32_32x32x16_bf16(b0, qr[d0], p0, 0, 0, 0);
        p1 = __builtin_amdgcn_mfma_f32_32x32x16_bf16(b1, qr[d0], p1, 0, 0, 0); }
}
template <int VB>
__device__ __forceinline__ void pv_tile(f32x16* o, int vb0, bf16x8 pa0, bf16x8 pa1, bf16x8 pa2, bf16x8 pa3) {
#define TRRD(dst, off) asm volatile("ds_read_b64_tr_b16 %0, %1 offset:%2" : "=&v"(dst) : "v"(vb0), "i"(off) : "memory")
#define PV_D0(d0) do { s16x4 l0, l1, l2, l3, h0, h1, h2, h3; constexpr int b_ = VB * SHM_V + v_rd_off(d0, 0, 0);   \
        TRRD(l0, b_); TRRD(h0, b_ + 1024); TRRD(l1, b_ + 2048); TRRD(h1, b_ + 3072); TRRD(l2, b_ + 4096); TRRD(h2, b_ + 5120); TRRD(l3, b_ + 6144); TRRD(h3, b_ + 7168); \
        asm volatile("s_waitcnt lgkmcnt(0)" ::: "memory"); SBAR();   \
        o[d0] = __builtin_amdgcn_mfma_f32_32x32x16_bf16(pa0, (bf16x8){l0[0], l0[1], l0[2], l0[3], h0[0], h0[1], h0[2], h0[3]}, o[d0], 0, 0, 0);   \
        o[d0] = __builtin_amdgcn_mfma_f32_32x32x16_bf16(pa1, (bf16x8){l1[0], l1[1], l1[2], l1[3], h1[0], h1[1], h1[2], h1[3]}, o[d0], 0, 0, 0);   \
        o[d0] = __builtin_amdgcn_mfma_f32_32x32x16_bf16(pa2, (bf16x8){l2[0], l2[1], l2[2], l2[3], h2[0], h2[1], h2[2], h2[3]}, o[d0], 0, 0, 0);   \
        o[d0] = __builtin_amdgcn_mfma_f32_32x32x16_bf16(pa3, (bf16x8){l3[0], l3[1], l3[2], l3[3], h3[0], h3[1], h3[2], h3[3]}, o[d0], 0, 0, 0); } while (0)
    PV_D0(0); PV_D0(1);
#undef PV_D0
#undef TRRD
}
struct BlockRef { const bf16_t* Q; const bf16_t* K; const bf16_t* KPE; const bf16_t* V; bf16_t* O; int P0; };
struct Seam { bf16x8 qr[6]; bf16x8 st_v0, st_v1, st_k0, st_k1; };
#define ROWK(p, k0, rr) ((p) + (size_t)((k0) + (rr)) * kstr)
#define ROWV(p, k0, rr) ((p) + (size_t)((k0) + (rr)) * VS + sc)
#define VMW() asm volatile("s_waitcnt vmcnt(0)" ::: "memory")
#define VMWN(n) asm volatile("s_waitcnt vmcnt(%0)" :: "i"(n) : "memory")
#define SLOAD_H(Kp, Vp, k0) do { if (vact) { S.st_v0 = load8(ROWV(Vp, k0, sr)); S.st_v1 = load8(ROWV(Vp, k0, 32 + sr)); }              \
                                 if (kact) { S.st_k0 = load8(ROWK(Kp, k0, sr)); S.st_k1 = load8(ROWK(Kp, k0, 32 + sr)); } } while (0)
#define SWRITE_HK(bf) do { if (kact) { *(bf16x8*)(K_lds + (bf) * SHM_K + kws) = S.st_k0; *(bf16x8*)(K_lds + (bf) * SHM_K + kws + 32 * 256) = S.st_k1; } } while (0)
#define SWRITE_HV(bf) do { if (vact) { *(bf16x8*)(V_lds + (bf) * SHM_V + vst0) = S.st_v0; *(bf16x8*)(V_lds + (bf) * SHM_V + vst1) = S.st_v1; } } while (0)
#define SWRITE_H(bf) do { SWRITE_HV(bf); SWRITE_HK(bf); } while (0)
__device__ __forceinline__ void attn_prime(const BlockRef& cur, char* lds, Seam& S) {
    const int tid = threadIdx.x, wid = __builtin_amdgcn_readfirstlane(tid >> 6), lane = tid & 63, r32 = lane & 31, hi = lane >> 5;
    const int sr = tid >> 4, sc = (tid & 15) * 8, kws = KSWZ(sr, sc * 2); char* K_lds = lds + 2 * SHM_V;
    const bool kact = (tid & 15) < 12, vact = (tid & 15) < 8;
#pragma unroll
    for (int d0 = 0; d0 < 6; ++d0) S.qr[d0] = load8(cur.Q + (size_t)(wid * QBLK + r32) * QS + d0 * 16 + hi * 8);
    const bf16_t* kp0 = (tid & 15) < 8 ? cur.K + sc : cur.KPE + (sc - 64); const int kstr = (tid & 15) < 8 ? KS : 32;
    SLOAD_H(kp0, cur.V, 0); VMW(); SWRITE_HK(0);
    __syncthreads();
}
__device__ __forceinline__ void attn_block(const BlockRef& cur, const BlockRef& nxt, char* lds, Seam& S) {
    const int tid = threadIdx.x, wid = __builtin_amdgcn_readfirstlane(tid >> 6), lane = tid & 63, r32 = lane & 31, hi = lane >> 5;
    const int NT = (cur.P0 + QB - 1) / KVBLK + 1;
    const int qlo = cur.P0 + wid * QBLK;
    const int qvis = qlo | 63;
    char* V_lds = lds; char* K_lds = lds + 2 * SHM_V;
    float* ws = (float*)(lds + 2 * SHM_V + 2 * SHM_K) + wid * 64; float* li_l = ws, * al_l = ws + 32;
    float m_reg = -1e30f, l_reg = 0; f32x16 o[2] = {};
    const int sr = tid >> 4, sc = (tid & 15) * 8, vst0 = v_st(sr, sc & 63), vst1 = v_st(32 + sr, sc & 63), kws = KSWZ(sr, sc * 2);
    const bool kact = (tid & 15) < 12, vact = (tid & 15) < 8;
    const int vb0 = (int)(uintptr_t)V_lds + v_rd_base(lane);
    const int kstr = (tid & 15) < 8 ? KS : 32;
    const bf16_t* Kh = (tid & 15) < 8 ? cur.K + sc : cur.KPE + (sc - 64); const bf16_t* Vh = cur.V;
    const bf16_t* Knx = (tid & 15) < 8 ? nxt.K + sc : nxt.KPE + (sc - 64);
#define RESC(a) do { if (__any((a) < 1.f)) { if (hi == 0) al_l[r32] = (a); asm volatile("s_waitcnt lgkmcnt(0)" ::: "memory");              \
                     for (int d_ = 0; d_ < 2; ++d_) for (int r = 0; r < 16; ++r) o[d_][r] *= al_l[crow(r, hi)]; } } while (0)
#define KBASE(t) ((t) * KVBLK)
#define MASKT(P0_, P1_, t) do { if (__builtin_amdgcn_readfirstlane((int)(KBASE(t) > qvis))) { const float NEG_ = -__builtin_inff(); _Pragma("unroll") for (int r = 0; r < 16; ++r) { P0_[r] = NEG_; P1_[r] = NEG_; } asm volatile("" : "+v"(P0_), "+v"(P1_)); } } while (0)
    constexpr int NQL = 6;
#define SEAM_K0() do { VMWN(NQL); SWRITE_HK(0); SBAR(); } while (0)
    f32x16 pA0, pA1, pB0, pB1; float mnA, mnB, alA, alB; bf16x8 pa0, pa1, pa2, pa3;
    SWRITE_HV(0); SBAR();
    if (NT > 1) { SLOAD_H(Kh, Vh, KBASE(1)); }
    SBAR(); qkt<0>(pA0, pA1, K_lds, r32, hi, S.qr);
    MASKT(pA0, pA1, 0); partialSM(pA0, pA1, m_reg, mnA, alA);
    if (NT > 1) { VMW(); SWRITE_H(1); }
    __syncthreads();
#define HALF_STEP(PX0, PX1, mnX, alX, PY0, PY1, alY, t, KB, VB, SB) do {                                                      \
        SBAR(); qkt<KB>(PX0, PX1, K_lds, r32, hi, S.qr);                                             \
        finishSM(PY0, PY1, alY, l_reg, pa0, pa1, pa2, pa3); SBAR();                                                           \
        if ((t) + 1 < NT) { SLOAD_H(Kh, Vh, KBASE((t) + 1)); SBAR(); }                                               \
        pv_tile<VB>(o, vb0, pa0, pa1, pa2, pa3); MASKT(PX0, PX1, (t)); partialSM(PX0, PX1, m_reg, mnX, alX);                                        \
        __syncthreads();                                                                                                      \
        if ((t) + 1 < NT) { VMW(); SWRITE_H(SB); }                                                                          \
        RESC(alX); __syncthreads(); } while (0)
    for (int t = 1; t + 1 < NT; t += 2) {
        HALF_STEP(pB0, pB1, mnB, alB, pA0, pA1, alA, t, 1, 0, 0);
        HALF_STEP(pA0, pA1, mnA, alA, pB0, pB1, alB, t + 1, 0, 1, 1);
    }
    const bool even = (NT & 1) == 0;
    if (even) { SBAR(); qkt<1>(pB0, pB1, K_lds, r32, hi, S.qr); SBAR(); }
    SLOAD_H(Knx, nxt.V, 0); SBAR();
#pragma unroll
    for (int d0 = 0; d0 < 6; ++d0) S.qr[d0] = load8(nxt.Q + (size_t)(wid * QBLK + r32) * QS + d0 * 16 + hi * 8);
    SBAR();
    finishSM(pA0, pA1, alA, l_reg, pa0, pa1, pa2, pa3); SBAR();
    pv_tile<0>(o, vb0, pa0, pa1, pa2, pa3);
    if (even) { MASKT(pB0, pB1, NT - 1); partialSM(pB0, pB1, m_reg, mnB, alB); __syncthreads(); RESC(alB);
        finishSM(pB0, pB1, alB, l_reg, pa0, pa1, pa2, pa3); SBAR(); pv_tile<1>(o, vb0, pa0, pa1, pa2, pa3); }
    SBAR(); SEAM_K0();
    if (hi == 0) li_l[r32] = l_reg; asm volatile("s_waitcnt lgkmcnt(0)" ::: "memory");
    float rli[16];
#pragma unroll
    for (int r = 0; r < 16; ++r) rli[r] = __builtin_amdgcn_rcpf(li_l[crow(r, hi)]);
    bf16_t* Ow = cur.O + (size_t)(wid * QBLK) * OS;
#pragma unroll
    for (int r = 0; r < 16; ++r) { const int orow = crow(r, hi);
#pragma unroll
        for (int d0 = 0; d0 < 2; ++d0) { const float v = o[d0][r] * rli[r];
            const float vn = __shfl_xor(v, 1);
            if ((r32 & 1) == 0) *(unsigned*)(Ow + (size_t)orow * OS + d0 * 32 + r32) = cvtpk(v, vn); } }
    __syncthreads();
#undef RESC
#undef KBASE
#undef MASKT
#undef SEAM_K0
#undef HALF_STEP
}


__device__ __forceinline__ void partialSM_rel(f32x16& p0, f32x16& p1, float& m_ref, f32x16& negm, float& alpha) {
    float pmax = p0[0]; for (int r = 1; r < 16; ++r) pmax = fmaxf(pmax, p0[r]); for (int r = 0; r < 16; ++r) pmax = fmaxf(pmax, p1[r]);
    { auto rr = __builtin_amdgcn_permlane32_swap(__float_as_uint(pmax), __float_as_uint(pmax), false, false);
      pmax = fmaxf(__uint_as_float(rr[0]), __uint_as_float(rr[1])); }
    if (__builtin_expect(__all(pmax <= THR), 1)) { alpha = 1.f; }
    else { const float d = fmaxf(pmax, 0.f); alpha = __builtin_amdgcn_exp2f(-d); m_ref += d;
        for (int r = 0; r < 16; ++r) { p0[r] -= d; p1[r] -= d; }
        for (int r = 0; r < 16; ++r) negm[r] = -m_ref; asm volatile("" : "+v"(negm)); }
    for (int r = 0; r < 16; ++r) p0[r] = __builtin_amdgcn_exp2f(p0[r]);
}

__device__ __forceinline__ void finishSM_direct(f32x16& p0, f32x16& p1, float alpha, float& l_reg, bf16x8& pa0, bf16x8& pa1, bf16x8& pa2, bf16x8& pa3) {
    for (int r = 0; r < 16; ++r) p1[r] = __builtin_amdgcn_exp2f(p1[r]);
    float ps = 0; for (int r = 0; r < 16; ++r) ps += p0[r]; for (int r = 0; r < 16; ++r) ps += p1[r];
    { auto rr = __builtin_amdgcn_permlane32_swap(__float_as_uint(ps), __float_as_uint(ps), false, false);
      ps = __uint_as_float(rr[0]) + __uint_as_float(rr[1]); }
    l_reg = l_reg * alpha + ps;
#define PK8(P, B_, OUT) do { u32x4 w = {cvtpk(P[B_+0], P[B_+1]), cvtpk(P[B_+2], P[B_+3]), cvtpk(P[B_+4], P[B_+5]), cvtpk(P[B_+6], P[B_+7])}; OUT = *reinterpret_cast<bf16x8*>(&w); } while (0)
    PK8(p0, 0, pa0); PK8(p0, 8, pa1); PK8(p1, 0, pa2); PK8(p1, 8, pa3);
#undef PK8
}

#define TRRD2(dst, vb, off) asm volatile("ds_read_b64_tr_b16 %0, %1 offset:%2" : "=&v"(dst) : "v"(vb), "i"(off) : "memory")
struct VFrag { s16x4 l0, l1, l2, l3, h0, h1, h2, h3; };
__device__ __forceinline__ void pv_issue(VFrag& f, int vb, int d0off) {
    if (d0off == 0) { TRRD2(f.l0, vb, 0); TRRD2(f.h0, vb, 1024); TRRD2(f.l1, vb, 2048); TRRD2(f.h1, vb, 3072); TRRD2(f.l2, vb, 4096); TRRD2(f.h2, vb, 5120); TRRD2(f.l3, vb, 6144); TRRD2(f.h3, vb, 7168); }
    else { TRRD2(f.l0, vb, 512); TRRD2(f.h0, vb, 1536); TRRD2(f.l1, vb, 2560); TRRD2(f.h1, vb, 3584); TRRD2(f.l2, vb, 4608); TRRD2(f.h2, vb, 5632); TRRD2(f.l3, vb, 6656); TRRD2(f.h3, vb, 7680); }
}
#define VF8(f, k) (bf16x8){f.l##k[0], f.l##k[1], f.l##k[2], f.l##k[3], f.h##k[0], f.h##k[1], f.h##k[2], f.h##k[3]}
__device__ __forceinline__ void pv_mma(f32x16& o, const VFrag& f, bf16x8 pa0, bf16x8 pa1, bf16x8 pa2, bf16x8 pa3) {
    o = __builtin_amdgcn_mfma_f32_32x32x16_bf16(pa0, VF8(f, 0), o, 0, 0, 0); o = __builtin_amdgcn_mfma_f32_32x32x16_bf16(pa1, VF8(f, 1), o, 0, 0, 0);
    o = __builtin_amdgcn_mfma_f32_32x32x16_bf16(pa2, VF8(f, 2), o, 0, 0, 0); o = __builtin_amdgcn_mfma_f32_32x32x16_bf16(pa3, VF8(f, 3), o, 0, 0, 0);
}
constexpr int D_V = 0, D_K = 4 * SHM_V, D_WS = D_K + 3 * SHM_K, D_Q = D_WS + NW * 64 * 4, D_BYTES = D_Q + NW * 6144;
__device__ __forceinline__ void qkt_rt(f32x16& p0, f32x16& p1, const char* Kslot, int r32, int hi, const char* qfr  , const f32x16& negm) {
    p0 = negm; p1 = negm;
#pragma unroll
    for (int d0 = 0; d0 < 6; ++d0) { const char* a = Kslot + KSWZ(r32, (d0 * 16 + hi * 8) * 2);
        bf16x8 b0 = *reinterpret_cast<const bf16x8*>(a);
        bf16x8 b1 = *reinterpret_cast<const bf16x8*>(a + 32 * 256);
        const bf16x8 q = *reinterpret_cast<const bf16x8*>(qfr + d0 * 1024);
        p0 = __builtin_amdgcn_mfma_f32_32x32x16_bf16(b0, q, p0, 0, 0, 0);
        p1 = __builtin_amdgcn_mfma_f32_32x32x16_bf16(b1, q, p1, 0, 0, 0); }
}

__device__ __forceinline__ void qkt_pipe(f32x16& p0, f32x16& p1, int kbase  , const int (&koff)[6], int qaddr, const f32x16& negm) {
    p0 = negm; p1 = negm;
    bf16x8 ka[3], kb[3], qq[3];
#define QK_LD(set, d0) asm volatile("ds_read_b128 %0, %3\n\tds_read_b128 %1, %3 offset:8192\n\tds_read_b128 %2, %4 offset:%5" : "=&v"(ka[set]), "=&v"(kb[set]), "=&v"(qq[set]) : "v"(kbase + koff[d0]), "v"(qaddr), "i"((d0) * 1024) : "memory")
#define QK_MM(set) do { p0 = __builtin_amdgcn_mfma_f32_32x32x16_bf16(ka[set], qq[set], p0, 0, 0, 0); p1 = __builtin_amdgcn_mfma_f32_32x32x16_bf16(kb[set], qq[set], p1, 0, 0, 0); } while (0)
    QK_LD(0, 0); QK_LD(1, 1); QK_LD(2, 2);
    asm volatile("s_waitcnt lgkmcnt(6)" ::: "memory"); SBAR(); QK_MM(0); SBAR(); QK_LD(0, 3);
    asm volatile("s_waitcnt lgkmcnt(6)" ::: "memory"); SBAR(); QK_MM(1); SBAR(); QK_LD(1, 4);
    asm volatile("s_waitcnt lgkmcnt(6)" ::: "memory"); SBAR(); QK_MM(2); SBAR(); QK_LD(2, 5);
    asm volatile("s_waitcnt lgkmcnt(6)" ::: "memory"); SBAR(); QK_MM(0); SBAR();
    asm volatile("s_waitcnt lgkmcnt(3)" ::: "memory"); SBAR(); QK_MM(1); SBAR();
    asm volatile("s_waitcnt lgkmcnt(0)" ::: "memory"); SBAR(); QK_MM(2); SBAR();
#undef QK_LD
#undef QK_MM
}
__device__ __forceinline__ void attn_block_dma(const BlockRef& cur, char* lds) {
    typedef __attribute__((address_space(3))) unsigned lds_u32;
    const int tid = threadIdx.x, wid = __builtin_amdgcn_readfirstlane(tid >> 6), lane = tid & 63, r32 = lane & 31, hi = lane >> 5;
    const int NT = (cur.P0 + QB - 1) / KVBLK + 1;
    const int qlo = cur.P0 + wid * QBLK, qvis = qlo | 63;
    float* ws = (float*)(lds + D_WS) + wid * 64; float* li_l = ws, * al_l = ws + 32;
    float m_reg = 0.f, l_reg = 0; f32x16 o[2] = {}; f32x16 negm = {}; asm volatile("" : "+v"(negm));
    const int vb0 = (int)(uintptr_t)(lds + D_V) + v_rd_base(lane);
    const bf16_t* ksrc[2]; int kstep[2];
#pragma unroll
    for (int j = 0; j < 2; ++j) { const int row = 4 * (2 * wid + j) + (lane >> 4), chunk = (lane & 15) ^ (row & 15);
        if (chunk >= 8 && chunk < 12) { ksrc[j] = cur.KPE + (size_t)row * 32 + (chunk - 8) * 8; kstep[j] = KVBLK * 32; }
        else { ksrc[j] = cur.K + (size_t)row * KS + (chunk < 8 ? chunk * 8 : 0); kstep[j] = KVBLK * KS; } }
    const bf16_t* vsrc; { const int k = wid * 8 + ((lane & 31) >> 2); vsrc = cur.V + (size_t)k * VS + (lane >> 5) * 32 + (lane & 3) * 8; }
#define DMA_TILE(t) do { const int ks_ = (t) % 3, vs_ = (t) & 3; \
        __builtin_amdgcn_global_load_lds((const unsigned*)(ksrc[0] + (size_t)(t) * kstep[0]), (lds_u32*)(lds + D_K + ks_ * SHM_K + (2 * wid) * 1024), 16, 0, 0); \
        __builtin_amdgcn_global_load_lds((const unsigned*)(ksrc[1] + (size_t)(t) * kstep[1]), (lds_u32*)(lds + D_K + ks_ * SHM_K + (2 * wid + 1) * 1024), 16, 0, 0); \
        __builtin_amdgcn_global_load_lds((const unsigned*)(vsrc + (size_t)(t) * KVBLK * VS), (lds_u32*)(lds + D_V + vs_ * SHM_V + wid * 1024), 16, 0, 0); } while (0)
#define WAITV(n) asm volatile("s_waitcnt vmcnt(" #n ")" ::: "memory")
#define BAR() do { asm volatile("s_waitcnt lgkmcnt(0)" ::: "memory"); __builtin_amdgcn_s_barrier(); asm volatile("" ::: "memory"); SBAR(); } while (0)
#define RESC(a) do { if (__any((a) < 1.f)) { if (hi == 0) al_l[r32] = (a); asm volatile("s_waitcnt lgkmcnt(0)" ::: "memory");              \
                     for (int d_ = 0; d_ < 2; ++d_) for (int r = 0; r < 16; ++r) o[d_][r] *= al_l[crow(r, hi)]; } } while (0)
#define MASKT(P0_, P1_, t) do { if (__builtin_amdgcn_readfirstlane((int)((t) * KVBLK > qvis))) { const float NEG_ = -__builtin_inff(); _Pragma("unroll") for (int r = 0; r < 16; ++r) { P0_[r] = NEG_; P1_[r] = NEG_; } asm volatile("" : "+v"(P0_), "+v"(P1_)); } } while (0)
    char* qfr = lds + D_Q + wid * 6144 + lane * 16; const int qaddr = (int)(uintptr_t)qfr; const int kbase0 = (int)(uintptr_t)(lds + D_K);
    int koff[6];
#pragma unroll
    for (int d0 = 0; d0 < 6; ++d0) koff[d0] = KSWZ(r32, (d0 * 16 + hi * 8) * 2);
    { bf16x8 qr[6];
#pragma unroll
      for (int d0 = 0; d0 < 6; ++d0) qr[d0] = load8(cur.Q + (size_t)(wid * QBLK + r32) * QS + d0 * 16 + hi * 8);
#pragma unroll
      for (int d0 = 0; d0 < 6; ++d0) *reinterpret_cast<bf16x8*>(qfr + d0 * 1024) = qr[d0]; }
    asm volatile("s_waitcnt vmcnt(0) lgkmcnt(0)" ::: "memory");
    DMA_TILE(0); DMA_TILE(1);
    WAITV(3); BAR();
    f32x16 pA0, pA1, pB0, pB1; float alA, alB; bf16x8 pa0, pa1, pa2, pa3;
#define SCORES(PX0, PX1, t) do { int ks_ = kbase0 + ((t) % 3) * SHM_K; asm volatile("" : "+s"(ks_));     \
        qkt_pipe(PX0, PX1, ks_, koff, qaddr, negm); } while (0)
#define TAIL_PV(PY0, PY1, alY, t1) do { VFrag f0_, f1_; int vs_ = ((t1) & 3) * SHM_V; asm volatile("" : "+s"(vs_)); const int vb_ = vb0 + vs_; pv_issue(f0_, vb_, 0); pv_issue(f1_, vb_, 512);     \
        finishSM_direct(PY0, PY1, alY, l_reg, pa0, pa1, pa2, pa3); SBAR(); \
        asm volatile("s_waitcnt lgkmcnt(0)" ::: "memory"); SBAR(); pv_mma(o[0], f0_, pa0, pa1, pa2, pa3); pv_mma(o[1], f1_, pa0, pa1, pa2, pa3); } while (0)
#define HEAD_SM(PX0, PX1, alX, t) do { MASKT(PX0, PX1, (t)); partialSM_rel(PX0, PX1, m_reg, negm, alX); } while (0)
#define END_STEP(t) do { if ((t) + 2 < NT) { WAITV(3); } else { WAITV(0); } BAR(); } while (0)
    if (wid < 4) {
        DMA_TILE(2);
        SCORES(pA0, pA1, 0); HEAD_SM(pA0, pA1, alA, 0);
        WAITV(3); BAR();
#define STEP_A(PX0, PX1, alX, PY0, PY1, alY, t) do { \
            if ((t) + 2 < NT) DMA_TILE((t) + 2); \
            SBAR(); SCORES(PX0, PX1, (t)); SBAR(); TAIL_PV(PY0, PY1, alY, (t) - 1); HEAD_SM(PX0, PX1, alX, (t)); \
            END_STEP(t); RESC(alX); } while (0)
        for (int t = 1; t + 1 < NT; t += 2) { STEP_A(pB0, pB1, alB, pA0, pA1, alA, t); STEP_A(pA0, pA1, alA, pB0, pB1, alB, t + 1); }
#undef STEP_A
        SBAR(); SCORES(pB0, pB1, NT - 1); SBAR(); TAIL_PV(pA0, pA1, alA, NT - 2);
        HEAD_SM(pB0, pB1, alB, NT - 1); RESC(alB); TAIL_PV(pB0, pB1, alB, NT - 1);
    } else {
        DMA_TILE(2);
        SCORES(pA0, pA1, 0);
        WAITV(3); BAR();
#define STEP_B(PX0, PX1, PY0, PY1, alY, t) do { \
            if ((t) + 2 < NT) DMA_TILE((t) + 2); \
            SBAR(); HEAD_SM(PY0, PY1, alY, (t) - 1); RESC(alY); SBAR(); SCORES(PX0, PX1, (t)); SBAR(); TAIL_PV(PY0, PY1, alY, (t) - 1); \
            END_STEP(t); } while (0)
        for (int t = 1; t + 1 < NT; t += 2) { STEP_B(pB0, pB1, pA0, pA1, alA, t); STEP_B(pA0, pA1, pB0, pB1, alB, t + 1); }
#undef STEP_B
        SBAR(); HEAD_SM(pA0, pA1, alA, NT - 2); RESC(alA); SBAR(); SCORES(pB0, pB1, NT - 1); SBAR(); TAIL_PV(pA0, pA1, alA, NT - 2);
        HEAD_SM(pB0, pB1, alB, NT - 1); RESC(alB); TAIL_PV(pB0, pB1, alB, NT - 1);
    }
#undef SCORES
#undef TAIL_PV
#undef HEAD_SM
#undef END_STEP
    if (hi == 0) li_l[r32] = l_reg; asm volatile("s_waitcnt lgkmcnt(0)" ::: "memory");
    float rli[16];
#pragma unroll
    for (int r = 0; r < 16; ++r) rli[r] = __builtin_amdgcn_rcpf(li_l[crow(r, hi)]);
    bf16_t* Ow = cur.O + (size_t)(wid * QBLK) * OS;
#pragma unroll
    for (int r = 0; r < 16; ++r) { const int orow = crow(r, hi);
#pragma unroll
        for (int d0 = 0; d0 < 2; ++d0) { const float v = o[d0][r] * rli[r];
            const float vn = __shfl_xor(v, 1);
            if ((r32 & 1) == 0) *(unsigned*)(Ow + (size_t)orow * OS + d0 * 32 + r32) = cvtpk(v, vn); } }
    asm volatile("s_waitcnt vmcnt(0)" ::: "memory");
    __syncthreads();
#undef DMA_TILE
#undef WAITV
#undef BAR
#undef RESC
#undef MASKT
}
#undef ROWK
#undef ROWV
#undef VMW
#undef VMWN
#undef SLOAD_H
#undef SWRITE_HK
#undef SWRITE_HV
#undef SWRITE_H
#undef KSWZ
#undef SBAR
}

namespace gla {
typedef short bf16x8 __attribute__((ext_vector_type(8)));
typedef short s16x4 __attribute__((ext_vector_type(4)));
typedef float f32x16 __attribute__((ext_vector_type(16)));
template <int NCB> __device__ __forceinline__ int t_st(int k, int c) { const int kk = (k & ~0xC) | ((k & 4) << 1) | ((k & 8) >> 1); return ((kk >> 3) * NCB + (c >> 5)) * 512 + ((kk & 7) * 32 + (c & 31)) * 2; }
__device__ __forceinline__ int t_rd_base(int lane) { return ((lane & 3) << 3) | (((lane >> 2) & 3) << 6) | (((lane >> 4) & 1) << 5) | (((lane >> 5) & 1) << 8); }
template <int NCB> constexpr int t_rd_off(int d0, int ks, int half) { return d0 * 512 + ks * (NCB * 1024) + half * (NCB * 512); }
#define GLA_TRRD(dst, addr, off) asm volatile("ds_read_b64_tr_b16 %0, %1 offset:%2" : "=&v"(dst) : "v"(addr), "i"(off) : "memory")
__device__ __forceinline__ int crow(int r, int hi) { return (r & 3) + 8 * (r >> 2) + 4 * hi; }
}

#define XB_TMO      128
#define XB_XCNT(j)  (256  + 64 * (j))
#define XB_XSUB(j)  (1280 + 64 * (j))
#define XB_XGEN(j)  (2304 + 64 * (j))
#define XB_TOP      3328
#define XB_TOPGEN   3392
#define XCD_BAR_WORDS 3456
#define XB_SPIN_CAP (1u << 18)
__device__ __forceinline__ unsigned xb_ld(unsigned* p)              { return __hip_atomic_load(p, __ATOMIC_RELAXED, __HIP_MEMORY_SCOPE_AGENT); }
__device__ __forceinline__ unsigned xb_add(unsigned* p, unsigned v) { return __hip_atomic_fetch_add(p, v, __ATOMIC_RELAXED, __HIP_MEMORY_SCOPE_AGENT); }
__device__ __forceinline__ unsigned xb_xcc_id() { return (unsigned)__builtin_amdgcn_s_getreg((3 << 11) | 20) & 0xFu; }
#define XB_SPIN(cond, bar) do { unsigned _sp = 0; while (cond) { __builtin_amdgcn_s_sleep(1); \
    if ((++_sp & 255u) == 0u) { if (xb_ld(&(bar)[XB_TMO])) break; if (_sp > XB_SPIN_CAP) { atomicAdd(&(bar)[XB_TMO], 1u); break; } } } } while (0)
struct XcdBarrier { unsigned* bar; unsigned x; volatile LAS unsigned* st; };
__device__ __forceinline__ XcdBarrier xcd_barrier_post(unsigned* bar, volatile LAS unsigned* st) {
    XcdBarrier b; b.bar = bar; b.x = xb_xcc_id(); b.st = st;
    if (threadIdx.x == 0) st[2] = xb_add(&bar[XB_XCNT(b.x)], 1u);
    return b;
}
__device__ __forceinline__ void xcd_barrier_complete(unsigned* bar, unsigned x, unsigned& nloc, unsigned& nx) {
    const unsigned G = gridDim.x * gridDim.y * gridDim.z;
    unsigned sum, cnt, mine, sp = 0u;
    for (;;) {
        sum = 0u; cnt = 0u; mine = 0u;
#pragma unroll
        for (unsigned j = 0; j < 16; ++j) { const unsigned c = xb_ld(&bar[XB_XCNT(j)]); sum += c; cnt += (c > 0u) ? 1u : 0u; mine = (j == x) ? c : mine; }
        if (sum == G) break;
        __builtin_amdgcn_s_sleep(1);
        if ((++sp & 255u) == 0u) { if (xb_ld(&bar[XB_TMO])) break; if (sp > XB_SPIN_CAP) { atomicAdd(&bar[XB_TMO], 1u); break; } }
    }
    nloc = mine > 0u ? mine : 1u; nx = cnt > 0u ? cnt : 1u;
}
__device__ __forceinline__ void xcd_barrier(const XcdBarrier& b) {
    asm volatile("s_waitcnt vmcnt(0)" ::: "memory");
    __syncthreads();
    if (threadIdx.x == 0) {
        unsigned* bar = b.bar;
        __builtin_amdgcn_s_waitcnt(0);
        unsigned nloc = b.st[0], nx = b.st[1];
        if (nloc == 0u) { xcd_barrier_complete(bar, b.x, nloc, nx); b.st[0] = nloc; b.st[1] = nx; }
        const unsigned old = xb_add(&bar[XB_XSUB(b.x)], 1u);
        const unsigned gen = old / nloc;
        if (old + 1u == (gen + 1u) * nloc) {
            __builtin_amdgcn_fence(__ATOMIC_RELEASE, "agent");
            asm volatile("s_waitcnt vmcnt(0)" ::: "memory");
            const unsigned og = xb_add(&bar[XB_TOP], 1u);
            const unsigned tg = og / nx;
            if (og + 1u == (tg + 1u) * nx) xb_add(&bar[XB_TOPGEN], 1u);
            else XB_SPIN(xb_ld(&bar[XB_TOPGEN]) == tg, bar);
            __builtin_amdgcn_fence(__ATOMIC_ACQUIRE, "agent");
            xb_add(&bar[XB_XGEN(b.x)], 1u);
            asm volatile("s_waitcnt vmcnt(0)" ::: "memory");
        } else {
            XB_SPIN(xb_ld(&bar[XB_XGEN(b.x)]) == gen, bar);
            __builtin_amdgcn_fence(__ATOMIC_ACQUIRE, "agent");
            asm volatile("s_waitcnt vmcnt(0)" ::: "memory");
        }
    }
    __syncthreads();
}

constexpr int NWAVES = 8;
constexpr int RING_BYTES = 131072, LDS_BYTES = 147456, LDSCTL_OFF = LDS_BYTES - 1024, MISC_OFF = LDSCTL_OFF + 320;
constexpr int CW_BAR = 4096;
constexpr int CW_QCTR = 16384;

struct Args { const void* in[20]; float* out; unsigned char* ws; int ph_lo, ph_hi; };

__device__ __forceinline__ int win_srccol(int n) {
    if (n < 2048) return 2224 + n;
    if (n < 2560) return 1712 + (n - 2048);
    if (n < 2816) return 672 + (n - 2560);
    if (n < 3328) return 1184 + (n - 2816);
    if (n < 3584) return 928 + (n - 3328);
    if (n < 3968) return 0 + (n - 3584);
    if (n < 4224) return 384 + (n - 3968);
    if (n < 4256) return 640 + (n - 4224);
    if (n < 4272) return 1696 + (n - 4256);
    return -1;
}
__device__ __forceinline__ void transpose_item(const float* __restrict__ W, int K, int Nsrc, bf16_t* __restrict__ WT, int Nout, const float* __restrict__ kscale, bool winperm, float* scr, int item, int lane) {
    const int nblk = Nout / 32, kb = item / nblk, nb = item % nblk, k0 = 64 * kb, n0 = 32 * nb;
    const int n = n0 + (lane & 31); const int sc = winperm ? win_srccol(n) : n;
    float tv[32];
#pragma unroll
    for (int i = 0; i < 32; ++i) { const int kk = 2 * i + (lane >> 5); tv[i] = (sc >= 0) ? W[(size_t)(k0 + kk) * Nsrc + sc] : 0.f; }
#pragma unroll
    for (int i = 0; i < 32; ++i) { const int kk = 2 * i + (lane >> 5); float v = tv[i]; if (kscale) v *= kscale[k0 + kk]; scr[kk * 33 + (lane & 31)] = v; }
    asm volatile("s_waitcnt lgkmcnt(0)" ::: "memory");
    const int c = lane & 7;
#pragma unroll
    for (int j = 0; j < 4; ++j) { const int nn = (lane >> 3) + 8 * j; const float* s = scr + (8 * c) * 33 + nn;
        u32x4 o; o.x = pk2(s[0 * 33], s[1 * 33]); o.y = pk2(s[2 * 33], s[3 * 33]); o.z = pk2(s[4 * 33], s[5 * 33]); o.w = pk2(s[6 * 33], s[7 * 33]);
        *(u32x4*)(WT + (size_t)(n0 + nn) * K + k0 + 8 * c) = o; }
    asm volatile("s_waitcnt lgkmcnt(0)" ::: "memory");
}

#define TOPK_INSERT(tv, ti, vv, ii) do { float v_ = (vv); int i_ = (ii); \
    _Pragma("unroll") for (int q_ = 0; q_ < 16; ++q_) { const bool gt_ = (v_ > tv[q_]) || (v_ == tv[q_] && i_ < ti[q_]); const float tv_ = tv[q_]; const int ti_ = ti[q_]; \
        tv[q_] = gt_ ? v_ : tv_; ti[q_] = gt_ ? i_ : ti_; v_ = gt_ ? tv_ : v_; i_ = gt_ ? ti_ : i_; } } while (0)

template <int OFFS> __device__ __forceinline__ void quant_rows2(const float* __restrict__ tab, const float* __restrict__ g, unsigned char* __restrict__ qt, float* __restrict__ sc, int row0, int lane) {
    f32x4 v[2][4];
#pragma unroll
    for (int rr = 0; rr < 2; ++rr)
#pragma unroll
        for (int j = 0; j < 4; ++j) v[rr][j] = *(const f32x4*)(tab + (size_t)(row0 + rr) * 1024 + 16 * lane + 4 * j);
#pragma unroll
    for (int rr = 0; rr < 2; ++rr) {
        float mx = 0.f;
#pragma unroll
        for (int j = 0; j < 4; ++j) { if (g) v[rr][j] = v[rr][j] * *(const f32x4*)(g + 16 * lane + 4 * j);
            mx = fmaxf(mx, fmaxf(fmaxf(fabsf(v[rr][j][0]), fabsf(v[rr][j][1])), fmaxf(fabsf(v[rr][j][2]), fabsf(v[rr][j][3])))); }
#pragma unroll
        for (int o = 1; o < 64; o <<= 1) mx = fmaxf(mx, __shfl_xor(mx, o));
        mx = fmaxf(mx, 1e-30f);
        const float inv = 127.f / mx;
        u32x4 w;
#pragma unroll
        for (int j = 0; j < 4; ++j) { unsigned b = 0;
#pragma unroll
            for (int e = 0; e < 4; ++e) { const int q = (int)rintf(v[rr][j][e] * inv) + OFFS; b |= ((unsigned)q & 0xffu) << (8 * e); }
            w[j] = b; }
        *(u32x4*)(qt + (size_t)(lane >> 3) * (16384 * 128) + (size_t)(row0 + rr) * 128 + 16 * (lane & 7)) = w;
        if (lane == 0) sc[row0 + rr] = mx * (1.f / 127.f);
    }
}
typedef __bf16 bf2_t __attribute__((ext_vector_type(2)));
__device__ __forceinline__ float dot2_bf16(unsigned a, unsigned b, float acc) { return __builtin_amdgcn_fdot2_f32_bf16(__builtin_bit_cast(bf2_t, a), __builtin_bit_cast(bf2_t, b), acc, false); }
#define DECL_PTRS const float* x = (const float*)args.in[0]; const int* positions = (const int*)args.in[1]; \
    const float* g_mix = (const float*)args.in[2]; const float* w_in = (const float*)args.in[3]; const float* g_q_lat = (const float*)args.in[4]; const float* w_qb = (const float*)args.in[5]; \
    const float* g_kv_lat = (const float*)args.in[6]; const float* w_kvb = (const float*)args.in[7]; const float* w_a2 = (const float*)args.in[8]; const float* b_a2 = (const float*)args.in[9]; \
    const float* g_gla = (const float*)args.in[10]; const float* w_branch_a = (const float*)args.in[11]; const float* w_branch_b = (const float*)args.in[12]; const float* w_out = (const float*)args.in[13]; \
    const float* g_ffn = (const float*)args.in[14]; const float* w_peer_q = (const float*)args.in[15]; const float* sub_keys = (const float*)args.in[16]; const float* peer_u = (const float*)args.in[17]; \
    const float* peer_v = (const float*)args.in[18]; const float* g_final = (const float*)args.in[19]; \
    float* out = args.out; \
    float* SSQ = (float*)(ws + WS_SSQ); float* SSKV = (float*)(ws + WS_SSKV); float* SSX1 = (float*)(ws + WS_SSX1); float* COS = (float*)(ws + WS_COS); float* SIN = (float*)(ws + WS_SIN); \
    float* DECAY = (float*)(ws + WS_DECAY); \
    bf16_t* WIN = (bf16_t*)(ws + WS_WIN); bf16_t* WQB = (bf16_t*)(ws + WS_WQB); bf16_t* WKVB = (bf16_t*)(ws + WS_WKVB); bf16_t* WA = (bf16_t*)(ws + WS_WA); bf16_t* WB = (bf16_t*)(ws + WS_WB); \
    bf16_t* WOUT = (bf16_t*)(ws + WS_WOUT); bf16_t* WPQ = (bf16_t*)(ws + WS_WPQ); bf16_t* KEYS = (bf16_t*)(ws + WS_KEYS); \
    bf16_t* PROJB = (bf16_t*)(ws + WS_PROJB); bf16_t* PROJA = (bf16_t*)(ws + WS_PROJA); bf16_t* XN = (bf16_t*)(ws + WS_XN); \
    bf16_t* Q = (bf16_t*)(ws + WS_Q); bf16_t* K = (bf16_t*)(ws + WS_K); bf16_t* KPE = (bf16_t*)(ws + WS_KPE); float* DST = out; bf16_t* V = (bf16_t*)((unsigned char*)out + 32 * MiB); bf16_t* STB = (bf16_t*)((unsigned char*)out + 48 * MiB); \
    bf16_t* YA = (bf16_t*)(ws + WS_YA); bf16_t* YB = (bf16_t*)(ws + WS_YB); bf16_t* MERGED = (bf16_t*)(ws + WS_MERGED); bf16_t* X1B = (bf16_t*)(ws + WS_X1B); bf16_t* QP = (bf16_t*)(ws + WS_QP); \
    int* EIDX = (int*)(ws + WS_EIDX); float* EGATE = (float*)(ws + WS_EGATE); unsigned char* UT = ws + WS_UT; unsigned char* VT = ws + WS_VT; float* SU = (float*)(ws + WS_SU); float* SV = (float*)(ws + WS_SV); float* SS2 = (float*)(ws + WS_SS2); float* ZP = (float*)(ws + WS_ZP); float* CS = (float*)(ws + WS_C128); signed char* CQ = (signed char*)(ws + WS_CB);
__global__ void __launch_bounds__(NWAVES * 64, 2) fwd(Args args) {
    extern __shared__ __attribute__((aligned(16))) unsigned char lds[];
    const int tid = threadIdx.x, lane = tid & 63, wave = __builtin_amdgcn_readfirstlane(tid >> 6);
    const int G = gridDim.x; int vcu; { const int bx = blockIdx.x; vcu = (G % 8 == 0) ? (bx % 8) * (G / 8) + bx / 8 : bx; }
    const int gw = vcu * NWAVES + wave, NGW = G * NWAVES, gtid = vcu * 512 + tid, NT = G * 512;
    unsigned char* ws = args.ws;
    for (int u = tid; u < (LDS_BYTES - LDSCTL_OFF) / 4; u += NWAVES * 64) ((unsigned*)(lds + LDSCTL_OFF))[u] = 0u;
    __syncthreads();
    XcdBarrier bar; bar.bar = (unsigned*)(ws + WS_CTL) + CW_BAR; bar.x = 0; bar.st = nullptr;
    if (MK_N_LAUNCHES == 1) bar = xcd_barrier_post((unsigned*)(ws + WS_CTL) + CW_BAR, (volatile LAS unsigned*)(lds + MISC_OFF) + 8);
    const int ph_lo_ = args.ph_lo, ph_hi_ = args.ph_hi;
#define IN(k) (ph_lo_ <= (k) && (k) < ph_hi_)
#define SEAM(k) do { if (MK_N_LAUNCHES == 1) { if (IN(k) && IN((k) + 1)) xcd_barrier(bar); } } while (0)
    PG8_LAS unsigned char* ring = (PG8_LAS unsigned char*)lds;

    if (IN(0)) { DECL_PTRS
        for (int i = gtid; i < 4 * M_; i += NT) SSQ[i] = 0.f;
        float* scr = (float*)(lds + wave * 16384);
        constexpr int I_WIN = 16 * (NPROJ / 32), I_QB = 6 * 24, I_KVB = 4 * 32, I_A = 8 * 32, I_OUT = 16 * 32, I_PQ = 16 * 64;
        constexpr int NITEMS = I_WIN + I_QB + I_KVB + 2 * I_A + I_OUT + I_PQ;
        for (int it = gw; it < NITEMS; it += NGW) {
            int r = it;
            if (r < I_WIN) { transpose_item(w_in, 1024, 4272, WIN, NPROJ, nullptr, true, scr, r, lane); continue; } r -= I_WIN;
            if (r < I_QB) { transpose_item(w_qb, 384, 768, WQB, 768, g_q_lat, false, scr, r, lane); continue; } r -= I_QB;
            if (r < I_KVB) { transpose_item(w_kvb, 256, 1024, WKVB, 1024, g_kv_lat, false, scr, r, lane); continue; } r -= I_KVB;
            if (r < I_A) { transpose_item(w_branch_a, 512, 1024, WA, 1024, nullptr, false, scr, r, lane); continue; } r -= I_A;
            if (r < I_A) { transpose_item(w_branch_b, 512, 1024, WB, 1024, nullptr, false, scr, r, lane); continue; } r -= I_A;
            if (r < I_OUT) { transpose_item(w_out, 1024, 1024, WOUT, 1024, nullptr, false, scr, r, lane); continue; } r -= I_OUT;
            transpose_item(w_peer_q, 1024, 2048, WPQ, 2048, g_ffn, false, scr, r, lane);
        }
        for (int i = gtid; i < 16 * 128 * 128; i += NT) KEYS[i] = f2bf(sub_keys[i]);
        for (int i = gtid; i < M_ * 16; i += NT) { const int m = i >> 4, f = i & 15;
            const double inv = pow(10000.0, -(double)f / 16.0); const double ang = (double)positions[m] * inv;
            COS[i] = (float)cos(ang); SIN[i] = (float)sin(ang); }
        for (int row = gw * 2; row < M_; row += NGW * 2) {
            f32x4 v[2][4];
#pragma unroll
            for (int rr = 0; rr < 2; ++rr)
#pragma unroll
                for (int j = 0; j < 4; ++j) v[rr][j] = ((const f32x4*)(x + (size_t)(row + rr) * DM))[lane + 64 * j];
#pragma unroll
            for (int rr = 0; rr < 2; ++rr) { float ss = 0.f;
#pragma unroll
                for (int j = 0; j < 4; ++j) ss += (v[rr][j][0] * v[rr][j][0] + v[rr][j][1] * v[rr][j][1]) + (v[rr][j][2] * v[rr][j][2] + v[rr][j][3] * v[rr][j][3]);
                ss = wave_sum(ss); const float r = rsqrtf(ss * (1.f / DM) + EPS);
#pragma unroll
                for (int j = 0; j < 4; ++j) { const int c = 4 * (lane + 64 * j); const f32x4 gg = *(const f32x4*)(g_mix + c);
                    u32x2 w; w.x = pk2(v[rr][j][0] * r * gg[0], v[rr][j][1] * r * gg[1]); w.y = pk2(v[rr][j][2] * r * gg[2], v[rr][j][3] * r * gg[3]);
                    *(u32x2*)(XN + (size_t)(row + rr) * DM + c) = w; } }
        }
    }
    SEAM(0);
    if (MK_N_LAUNCHES == 1 && IN(0) && IN(1)) { if (tid == 0) { unsigned ord = 0; for (unsigned j = 0; j < 16; ++j) if (j < bar.x && xb_ld(&bar.bar[XB_XCNT(j)]) > 0u) ++ord; bar.st[3] = ord; } __syncthreads(); }
    if (IN(1)) { DECL_PTRS
        pg8::Gemm g{XN, WIN, nullptr, nullptr, DM, DM, M_, NPROJ, DM, 1}; pg8::StaticOrder S; S.init(g, G, (int)blockIdx.x);
        pg8::EpiProj E{PROJB, PROJA, SSQ, SSKV};
        pg8::gemm_phase<pg8::EpiProj, pg8::StaticOrder, true>(ring, g, S, E);
        { const int nwg_ = (M_ / 256) * (NPROJ / 256), rem_ = nwg_ % G, c_ = (int)blockIdx.x; const int nq_ = rem_ ? G - rem_ : G, qi_ = rem_ ? c_ - rem_ : c_;
          if (qi_ >= 0) for (int row = 2 * (qi_ * NWAVES + wave); row < 32768; row += 2 * nq_ * NWAVES) {
              if (row < 16384) quant_rows2<0>(peer_u, g_ffn, UT, SU, row, lane); else quant_rows2<0>(peer_v, nullptr, VT, SV, row - 16384, lane); } }
    }
    SEAM(1);
    if (IN(2)) { DECL_PTRS
        { pg8::Gemm g{PROJA + PA_QLAT, WQB, nullptr, nullptr, PA_LD, 384, M_, 768, 384, 1}; pg8::StaticOrder S; S.init(g, G, (int)blockIdx.x);
          pg8::EpiQ E{Q, SSQ, COS, SIN}; pg8::gemm_phase<pg8::EpiQ, pg8::StaticOrder, true>(ring, g, S, E); }
        { pg8::Gemm g{PROJA + PA_KVLAT, WKVB, nullptr, nullptr, PA_LD, 256, M_, 1024, 256, 1}; pg8::StaticOrder S; S.init(g, G, (int)blockIdx.x);
          pg8::EpiKV E{K, V, SSKV}; pg8::gemm_phase<pg8::EpiKV, pg8::StaticOrder, true>(ring, g, S, E); }
        for (int i = gtid; i < M_ * 32; i += NT) { const int m = i >> 5, j = i & 31; const bf16_t* kr = PROJA + (size_t)m * PA_LD + PA_KROPE; float o;
            if (j < 16) { const float x1 = bf2f(kr[j]), x2 = bf2f(kr[j + 16]); o = x1 * COS[m * 16 + j] - x2 * SIN[m * 16 + j]; }
            else { const int f = j - 16; const float x2 = bf2f(kr[j]), x1 = bf2f(kr[j - 16]); o = x2 * COS[m * 16 + f] + x1 * SIN[m * 16 + f]; }
            KPE[i] = f2bf(o); }
        __syncthreads();
        {
            const int r32 = lane & 31, hi5 = lane >> 5;
            unsigned char* gvt = lds; unsigned char* kdt = lds + 16384;
            const int tbase = (int)(uintptr_t)lds + gla::t_rd_base(lane);
            for (int unit = vcu; unit < 2 * NCH * 4; unit += G) {
                const int h = unit & 3, bc = unit >> 2, t0 = bc * 64;
                {
                    const int sr = tid >> 4, ch = tid & 15;
#pragma unroll
                    for (int rr = 0; rr < 2; ++rr) { const int row = sr + 32 * rr; const u32x4 v = *(const u32x4*)(PROJA + (size_t)(t0 + row) * PA_LD + PA_GV + h * 128 + ch * 8);
                        *(u32x4*)(gvt + gla::t_st<4>(row, ch * 8)) = v; }
                }
                {
                    const int k0 = wave * 8; const bf16_t* prow = PROJA + (size_t)(t0 + lane) * PA_LD;
                    const u32x4 ga = *(const u32x4*)(prow + PA_GLR), gb = *(const u32x4*)(prow + PA_GLR + 8), gkv = *(const u32x4*)(prow + PA_GK + h * 64 + k0);
                    float glr[16];
#pragma unroll
                    for (int q = 0; q < 4; ++q) { glr[2 * q] = __uint_as_float(ga[q] << 16); glr[2 * q + 1] = __uint_as_float(ga[q] & 0xffff0000u); glr[8 + 2 * q] = __uint_as_float(gb[q] << 16); glr[8 + 2 * q + 1] = __uint_as_float(gb[q] & 0xffff0000u); }
                    float kdv[8];
#pragma unroll
                    for (int j = 0; j < 8; ++j) { const int kc = h * 64 + k0 + j; float z = b_a2[kc];
#pragma unroll
                        for (int r = 0; r < 16; ++r) z += glr[r] * w_a2[r * 256 + kc];
                        float v = (fminf(z, 0.f) - log1pf(expf(-fabsf(z)))) * (1.f / 16.f);
#pragma unroll
                        for (int d = 1; d < 64; d <<= 1) { const float t = __shfl_up(v, d); v += (lane >= d) ? t : 0.f; }
                        const float cl = __builtin_bit_cast(float, __builtin_amdgcn_readlane(__builtin_bit_cast(int, v), 63));
                        const unsigned gw_ = gkv[j >> 1]; const float gk = (j & 1) ? __uint_as_float(gw_ & 0xffff0000u) : __uint_as_float(gw_ << 16);
                        kdv[j] = gk * expf(cl - v);
                        if (lane == 0) DECAY[((size_t)bc * 4 + h) * 64 + k0 + j] = expf(cl); }
                    u32x4 w; w.x = pk2(kdv[0], kdv[1]); w.y = pk2(kdv[2], kdv[3]); w.z = pk2(kdv[4], kdv[5]); w.w = pk2(kdv[6], kdv[7]);
                    *(u32x4*)(kdt + gla::t_st<2>(lane, k0)) = w;
                }
                __syncthreads();
                {
                    const int kt = wave >> 2, vt = wave & 3; gla::f32x16 acc = {};
                    gla::s16x4 al[4], ah[4], bl[4], bh[4];
                    const int abase = tbase + kt * 512, bbase = tbase + vt * 512;
#define GLA_KS(ks) do { GLA_TRRD(al[ks], abase, 16384 + gla::t_rd_off<2>(0, ks, 0)); GLA_TRRD(ah[ks], abase, 16384 + gla::t_rd_off<2>(0, ks, 1)); GLA_TRRD(bl[ks], bbase, gla::t_rd_off<4>(0, ks, 0)); GLA_TRRD(bh[ks], bbase, gla::t_rd_off<4>(0, ks, 1)); } while (0)
                    GLA_KS(0); GLA_KS(1); GLA_KS(2); GLA_KS(3);
#undef GLA_KS
                    asm volatile("s_waitcnt lgkmcnt(0)" ::: "memory"); __builtin_amdgcn_sched_barrier(0);
#pragma unroll
                    for (int ks = 0; ks < 4; ++ks) acc = __builtin_amdgcn_mfma_f32_32x32x16_bf16((gla::bf16x8){al[ks][0], al[ks][1], al[ks][2], al[ks][3], ah[ks][0], ah[ks][1], ah[ks][2], ah[ks][3]},
                                                                                                 (gla::bf16x8){bl[ks][0], bl[ks][1], bl[ks][2], bl[ks][3], bh[ks][0], bh[ks][1], bh[ks][2], bh[ks][3]}, acc, 0, 0, 0);
                    float* dp = DST + (((size_t)bc * 4 + h) * 64 + kt * 32) * 128 + vt * 32 + r32;
#pragma unroll
                    for (int r = 0; r < 16; ++r) dp[(size_t)gla::crow(r, hi5) * 128] = acc[r];
                }
                __syncthreads();
            }
        }
    }
    SEAM(2);
    if (IN(3)) { DECL_PTRS
        if (tid < 256) for (int i = vcu * 256 + tid; i < 65536; i += G * 256) {
            const int v = i & 127, k = (i >> 7) & 63, h = (i >> 13) & 3, b = i >> 15; float s = 0.f;
            const float* dp = DST + (((size_t)b * NCH * 4 + h) * 64 + k) * 128 + v; const float* gp = DECAY + ((size_t)b * NCH * 4 + h) * 64 + k;
            bf16_t* sbp = STB + (((size_t)b * NCH * 4 + h) * 64 + k) * 128 + v;
            float d[8], g[8], dn[8], gn[8];
#pragma unroll
            for (int j = 0; j < 8; ++j) { d[j] = dp[(size_t)j * 32768]; g[j] = gp[(size_t)j * 256]; }
            for (int c0 = 0; c0 < NCH; c0 += 8) {
                const int cn = (c0 + 8 < NCH) ? c0 + 8 : c0;
#pragma unroll
                for (int j = 0; j < 8; ++j) { dn[j] = dp[(size_t)(cn + j) * 32768]; gn[j] = gp[(size_t)(cn + j) * 256]; }
#pragma unroll
                for (int j = 0; j < 8; ++j) { s = g[j] * s + d[j]; d[j] = s; }
#pragma unroll
                for (int j = 0; j < 8; ++j) sbp[(size_t)(c0 + j) * 32768] = f2bf(d[j]);
#pragma unroll
                for (int j = 0; j < 8; ++j) { d[j] = dn[j]; g[j] = gn[j]; } } }
        __syncthreads();
        {
            for (int pr = vcu; pr < 256; pr += G) {
                const int bh = pr >> 4, s16 = pr & 15, b = bh >> 3, h = bh & 7;
                att::BlockRef r0, r1;
                const bf16_t* Kh = K + (size_t)b * SEQ * att::KS + h * 96; const bf16_t* Vh = V + (size_t)b * SEQ * att::VS + h * 64;
                const int qb0 = 31 - s16, qb1 = s16;
                r0.Q = Q + ((size_t)b * SEQ + qb0 * 256) * att::QS + h * 96; r0.O = YA + ((size_t)b * SEQ + qb0 * 256) * att::OS + h * 64; r0.K = Kh; r0.KPE = KPE + (size_t)b * SEQ * 32; r0.V = Vh; r0.P0 = qb0 * 256;
                r1.Q = Q + ((size_t)b * SEQ + qb1 * 256) * att::QS + h * 96; r1.O = YA + ((size_t)b * SEQ + qb1 * 256) * att::OS + h * 64; r1.K = Kh; r1.KPE = KPE + (size_t)b * SEQ * 32; r1.V = Vh; r1.P0 = qb1 * 256;
                att::attn_block_dma(r0, (char*)lds);
                att::attn_block_dma(r1, (char*)lds);
            }
        }
    }
    SEAM(3);
    if (IN(4)) { DECL_PTRS
        const int r32 = lane & 31, hi5 = lane >> 5;
        unsigned char* stt = lds; float* part = (float*)(lds + 16384);
        const int lt = wave >> 2, vt = wave & 3;
        const int bbase = (int)(uintptr_t)lds + gla::t_rd_base(lane) + vt * 512;
        for (int unit = vcu; unit < 2 * NCH * 4; unit += G) {
            const int h = unit & 3, bc = unit >> 2, t0 = bc * 64;
            {   const int sr = tid >> 4, ch = tid & 15; const bf16_t* sp = STB + ((size_t)bc * 4 + h) * 64 * 128;
#pragma unroll
                for (int rr = 0; rr < 2; ++rr) { const int row = sr + 32 * rr; *(u32x4*)(stt + gla::t_st<4>(row, ch * 8)) = *(const u32x4*)(sp + row * 128 + ch * 8); } }
            gla::bf16x8 qa[4];
            { const bf16_t* qrow = PROJB + (size_t)(t0 + lt * 32 + r32) * PB_LD + PB_GQ + h * 64 + hi5 * 8;
#pragma unroll
              for (int ks = 0; ks < 4; ++ks) qa[ks] = *(const gla::bf16x8*)(qrow + ks * 16); }
            __syncthreads();
            gla::f32x16 acc = {};
            { gla::s16x4 bl[4], bh[4];
#define GLA_KS(ks) do { GLA_TRRD(bl[ks], bbase, gla::t_rd_off<4>(0, ks, 0)); GLA_TRRD(bh[ks], bbase, gla::t_rd_off<4>(0, ks, 1)); } while (0)
              GLA_KS(0); GLA_KS(1); GLA_KS(2); GLA_KS(3);
#undef GLA_KS
              asm volatile("s_waitcnt lgkmcnt(0)" ::: "memory"); __builtin_amdgcn_sched_barrier(0);
#pragma unroll
              for (int ks = 0; ks < 4; ++ks) acc = __builtin_amdgcn_mfma_f32_32x32x16_bf16(qa[ks], (gla::bf16x8){bl[ks][0], bl[ks][1], bl[ks][2], bl[ks][3], bh[ks][0], bh[ks][1], bh[ks][2], bh[ks][3]}, acc, 0, 0, 0); }
            float rs[16];
#pragma unroll
            for (int r = 0; r < 16; ++r) { acc[r] *= 0.125f; float s2 = acc[r] * acc[r];
                s2 += __builtin_bit_cast(float, __builtin_amdgcn_update_dpp(0, __builtin_bit_cast(int, s2), 0x128, 0xf, 0xf, false));
                s2 += __builtin_bit_cast(float, __builtin_amdgcn_update_dpp(0, __builtin_bit_cast(int, s2), 0x124, 0xf, 0xf, false));
                s2 += __builtin_bit_cast(float, __builtin_amdgcn_update_dpp(0, __builtin_bit_cast(int, s2), 0x122, 0xf, 0xf, false));
                s2 += __builtin_bit_cast(float, __builtin_amdgcn_update_dpp(0, __builtin_bit_cast(int, s2), 0x121, 0xf, 0xf, false));
                s2 += __shfl_xor(s2, 16); rs[r] = s2; }
            if (r32 == 0) {
#pragma unroll
                for (int r = 0; r < 16; ++r) part[(lt * 32 + gla::crow(r, hi5)) * 4 + vt] = rs[r]; }
            __syncthreads();
#pragma unroll
            for (int r = 0; r < 16; ++r) { const int l = lt * 32 + gla::crow(r, hi5); const f32x4 pp = *(const f32x4*)(part + l * 4);
                const float rn = rsqrtf(((pp[0] + pp[1]) + (pp[2] + pp[3])) * (1.f / 128.f) + EPS);
                const int v = vt * 32 + r32; const float go = bf2f(PROJB[(size_t)(t0 + l) * PB_LD + PB_GOUT + h * 128 + v]);
                const float silu = go * __builtin_amdgcn_rcpf(1.f + __expf(-go));
                YB[(size_t)(t0 + l) * 512 + h * 128 + v] = f2bf(acc[r] * rn * g_gla[h * 128 + v] * silu); }
            __syncthreads();
        }
    }
    SEAM(4);
    if (IN(5)) { DECL_PTRS
        pg8::Gemm g{YA, WA, YB, WB, 512, 512, M_, 1024, 512, 2}; pg8::StaticOrder S; S.init(g, G, (int)blockIdx.x);
        pg8::EpiMerge E{PROJB, MERGED}; pg8::gemm_phase<pg8::EpiMerge, pg8::StaticOrder, true>(ring, g, S, E);
    }
    SEAM(5);
    if (IN(6)) { DECL_PTRS
        pg8::Gemm g{MERGED, WOUT, nullptr, nullptr, DM, DM, M_, 1024, DM, 1}; pg8::StaticOrder S; S.init(g, G, (int)blockIdx.x);
        pg8::EpiX1 E{x, out, X1B, SSX1}; pg8::gemm_phase<pg8::EpiX1, pg8::StaticOrder, false>(ring, g, S, E);
    }
    SEAM(6);
    if (IN(7)) { DECL_PTRS
        pg8::Gemm g{X1B, WPQ, nullptr, nullptr, DM, DM, M_, 2048, DM, 1}; pg8::StaticOrder S; S.init(g, G, vcu); S.pair_mode = 1;
        pg8::EpiQP E{QP, SSX1}; pg8::gemm_phase<pg8::EpiQP, pg8::StaticOrder, true>(ring, g, S, E);
        asm volatile("s_waitcnt vmcnt(0)" ::: "memory"); __syncthreads();
    }
    if (IN(7)) { DECL_PTRS
        typedef short bf16x8_t __attribute__((ext_vector_type(8)));
        typedef float f32x16_t __attribute__((ext_vector_type(16)));
        const int r32 = lane & 31, hi = lane >> 5;
#define P8_SORTABLE(f) ({ const unsigned b_ = __float_as_uint(f); b_ ^ ((unsigned)((int)b_ >> 31) | 0x80000000u); })
#define P8_UNSORT(u) ({ const unsigned u_ = (u); __uint_as_float(u_ ^ (~(unsigned)((int)u_ >> 31) | 0x80000000u)); })
#define P8_CE(a, b) do { const unsigned hi_ = (a) > (b) ? (a) : (b), lo_ = (a) > (b) ? (b) : (a); (a) = hi_; (b) = lo_; } while (0)
#define P8_SORT16(x) do { P8_CE(x[0], x[1]); P8_CE(x[3], x[2]); P8_CE(x[4], x[5]); P8_CE(x[7], x[6]); P8_CE(x[8], x[9]); P8_CE(x[11], x[10]); P8_CE(x[12], x[13]); P8_CE(x[15], x[14]); P8_CE(x[0], x[2]); P8_CE(x[1], x[3]); P8_CE(x[6], x[4]); P8_CE(x[7], x[5]); P8_CE(x[8], x[10]); P8_CE(x[9], x[11]); P8_CE(x[14], x[12]); P8_CE(x[15], x[13]); P8_CE(x[0], x[1]); P8_CE(x[2], x[3]); P8_CE(x[5], x[4]); P8_CE(x[7], x[6]); P8_CE(x[8], x[9]); P8_CE(x[10], x[11]); P8_CE(x[13], x[12]); P8_CE(x[15], x[14]); P8_CE(x[0], x[4]); P8_CE(x[1], x[5]); P8_CE(x[2], x[6]); P8_CE(x[3], x[7]); P8_CE(x[12], x[8]); P8_CE(x[13], x[9]); P8_CE(x[14], x[10]); P8_CE(x[15], x[11]); P8_CE(x[0], x[2]); P8_CE(x[1], x[3]); P8_CE(x[4], x[6]); P8_CE(x[5], x[7]); P8_CE(x[10], x[8]); P8_CE(x[11], x[9]); P8_CE(x[14], x[12]); P8_CE(x[15], x[13]); P8_CE(x[0], x[1]); P8_CE(x[2], x[3]); P8_CE(x[4], x[5]); P8_CE(x[6], x[7]); P8_CE(x[9], x[8]); P8_CE(x[11], x[10]); P8_CE(x[13], x[12]); P8_CE(x[15], x[14]); P8_CE(x[0], x[8]); P8_CE(x[1], x[9]); P8_CE(x[2], x[10]); P8_CE(x[3], x[11]); P8_CE(x[4], x[12]); P8_CE(x[5], x[13]); P8_CE(x[6], x[14]); P8_CE(x[7], x[15]); P8_CE(x[0], x[4]); P8_CE(x[1], x[5]); P8_CE(x[2], x[6]); P8_CE(x[3], x[7]); P8_CE(x[8], x[12]); P8_CE(x[9], x[13]); P8_CE(x[10], x[14]); P8_CE(x[11], x[15]); P8_CE(x[0], x[2]); P8_CE(x[1], x[3]); P8_CE(x[4], x[6]); P8_CE(x[5], x[7]); P8_CE(x[8], x[10]); P8_CE(x[9], x[11]); P8_CE(x[12], x[14]); P8_CE(x[13], x[15]); P8_CE(x[0], x[1]); P8_CE(x[2], x[3]); P8_CE(x[4], x[5]); P8_CE(x[6], x[7]); P8_CE(x[8], x[9]); P8_CE(x[10], x[11]); P8_CE(x[12], x[13]); P8_CE(x[14], x[15]); } while (0)
#define P8_MERGE16(A, B, O) do { _Pragma("unroll") for (int i_ = 0; i_ < 16; ++i_) O[i_] = (A)[i_] > (B)[15 - i_] ? (A)[i_] : (B)[15 - i_]; \
        _Pragma("unroll") for (int s_ = 8; s_ >= 1; s_ >>= 1) _Pragma("unroll") for (int i_ = 0; i_ < 16; ++i_) if ((i_ & s_) == 0) P8_CE(O[i_], O[i_ + s_]); } while (0)
#define P8_INSERT(t, v) do { unsigned v_ = (v); _Pragma("unroll") for (int q_ = 0; q_ < 16; ++q_) { const unsigned a_ = t[q_] > v_ ? t[q_] : v_; v_ = t[q_] > v_ ? v_ : t[q_]; t[q_] = a_; } } while (0)
        for (int item = vcu; item < 256; item += G) {
            const int h = item & 7, tr = item >> 3;
            for (int c = tid; c < 2 * 128 * 16; c += 512) { const int p = c >> 11, row = (c >> 4) & 127, ch = c & 15;
                const u32x4 v = *(const u32x4*)(KEYS + ((size_t)(h * 2 + p) * 128 + row) * 128 + ch * 8);
                *(u32x4*)(lds + p * 32768 + row * 256 + ((ch * 16) ^ ((row & 7) << 4))) = v; }
            __syncthreads();
#pragma unroll 1
            for (int step = 0; step < 2; ++step) {
                const int m = tr * 512 + wave * 64 + step * 32 + r32;
                unsigned top[2][16];
#pragma unroll
                for (int p = 0; p < 2; ++p) {
                    bf16x8_t qf[8];
#pragma unroll
                    for (int ks = 0; ks < 8; ++ks) qf[ks] = *(const bf16x8_t*)(QP + (size_t)m * 2048 + (h * 2 + p) * 128 + ks * 16 + hi * 8);
                    f32x16_t acc[4];
#pragma unroll
                    for (int kt = 0; kt < 4; ++kt) { acc[kt] = f32x16_t{};
                        const int row = kt * 32 + r32; const unsigned char* rb = lds + p * 32768 + row * 256;
#pragma unroll
                        for (int ks = 0; ks < 8; ++ks) { const bf16x8_t a = *(const bf16x8_t*)(rb + (((2 * ks + hi) * 16) ^ ((row & 7) << 4)));
                            acc[kt] = __builtin_amdgcn_mfma_f32_32x32x16_bf16(a, qf[ks], acc[kt], 0, 0, 0); } }
                    unsigned xs[4][16];
#pragma unroll
                    for (int kt = 0; kt < 4; ++kt)
#pragma unroll
                        for (int r = 0; r < 16; ++r) { const unsigned base = 32 * kt + (r & 3) + 8 * (r >> 2);
                            xs[kt][r] = (P8_SORTABLE(acc[kt][r]) | 127u) ^ base; }
                    P8_SORT16(xs[0]); P8_SORT16(xs[1]); P8_SORT16(xs[2]); P8_SORT16(xs[3]);
                    unsigned m01[16], m23[16], t[16];
                    P8_MERGE16(xs[0], xs[1], m01); P8_MERGE16(xs[2], xs[3], m23); P8_MERGE16(m01, m23, t);
#pragma unroll
                    for (int i = 0; i < 16; ++i) t[i] ^= (unsigned)(hi << 2);
                    unsigned mm[16];
#pragma unroll
                    for (int i = 0; i < 16; ++i) { auto rr = __builtin_amdgcn_permlane32_swap(t[15 - i], t[15 - i], false, false); const unsigned pt = hi ? rr[0] : rr[1]; mm[i] = t[i] > pt ? t[i] : pt; }
#pragma unroll
                    for (int sft = 8; sft >= 1; sft >>= 1)
#pragma unroll
                        for (int i = 0; i < 16; ++i) if ((i & sft) == 0) { const unsigned a_ = mm[i] > mm[i + sft] ? mm[i] : mm[i + sft], b_ = mm[i] > mm[i + sft] ? mm[i + sft] : mm[i]; mm[i] = a_; mm[i + sft] = b_; }
#pragma unroll
                    for (int i = 0; i < 16; ++i) top[p][i] = mm[i];
                }
                float f0[16], f1[16];
#pragma unroll
                for (int i = 0; i < 16; ++i) { f0[i] = P8_UNSORT(top[0][i] & 0xFFFFFF80u); f1[i] = P8_UNSORT(top[1][i] & 0xFFFFFF80u); }
#define P8_CV(a, b) ((P8_SORTABLE(f0[a] + f1[b]) | 255u) ^ (unsigned)((a) * 16 + (b)))
                unsigned l0[16], x1[16], x2[16], x3[16], m1[16], m2[16], cb[16];
#pragma unroll
                for (int b = 0; b < 16; ++b) l0[b] = P8_CV(0, b);
#pragma unroll
                for (int b = 0; b < 8; ++b) x1[b] = P8_CV(1, b);
#pragma unroll
                for (int b = 0; b < 5; ++b) x1[8 + b] = P8_CV(2, b);
#pragma unroll
                for (int b = 0; b < 3; ++b) x1[13 + b] = P8_CV(3, b);
                x2[0] = P8_CV(3, 3);
#pragma unroll
                for (int b = 0; b < 3; ++b) x2[1 + b] = P8_CV(4, b);
#pragma unroll
                for (int b = 0; b < 2; ++b) { x2[4 + b] = P8_CV(5, b); x2[6 + b] = P8_CV(6, b); x2[8 + b] = P8_CV(7, b); }
                x2[10] = P8_CV(8, 0); x2[11] = P8_CV(9, 0); x2[12] = P8_CV(10, 0); x2[13] = P8_CV(11, 0); x2[14] = P8_CV(12, 0); x2[15] = P8_CV(13, 0);
                x3[0] = P8_CV(14, 0); x3[1] = P8_CV(15, 0);
#pragma unroll
                for (int i = 2; i < 16; ++i) x3[i] = 0u;
#undef P8_CV
                P8_SORT16(x1); P8_SORT16(x2);
                P8_MERGE16(l0, x1, m1); P8_MERGE16(x2, x3, m2); P8_MERGE16(m1, m2, cb);
                unsigned char* slot = lds + 65536 + wave * 2048 + lane * 32;
                { u32x4 w0, w1;
#define P8_IDX4(T, i) ((127u - (T[i] & 127u)) | ((127u - (T[(i) + 1] & 127u)) << 8) | ((127u - (T[(i) + 2] & 127u)) << 16) | ((127u - (T[(i) + 3] & 127u)) << 24))
                  w0.x = P8_IDX4(top[0], 0); w0.y = P8_IDX4(top[0], 4); w0.z = P8_IDX4(top[0], 8); w0.w = P8_IDX4(top[0], 12);
                  w1.x = P8_IDX4(top[1], 0); w1.y = P8_IDX4(top[1], 4); w1.z = P8_IDX4(top[1], 8); w1.w = P8_IDX4(top[1], 12);
#undef P8_IDX4
                  *(u32x4*)slot = w0; *(u32x4*)(slot + 16) = w1; }
                asm volatile("s_waitcnt lgkmcnt(0)" ::: "memory");
                float bv[16]; int be[16];
#pragma unroll
                for (int k = 0; k < 16; ++k) { const unsigned pos = (~cb[k]) & 255u; bv[k] = P8_UNSORT(cb[k] & 0xFFFFFF00u);
                    be[k] = (int)slot[pos >> 4] * 128 + (int)slot[16 + (pos & 15)]; }
                { const float b0 = bv[0];
#pragma unroll
                  for (int k = 0; k < 16; ++k) bv[k] = __expf(bv[k] - b0); }
                asm volatile("s_waitcnt lgkmcnt(0)" ::: "memory");
                if (hi == 0) { int* ep = EIDX + (size_t)m * 128 + 2 * h;
#pragma unroll
                    for (int kk = 0; kk < 8; ++kk) { u32x2 w; w.x = (unsigned)be[kk]; w.y = (unsigned)be[kk + 8]; *(u32x2*)(ep + kk * 16) = w; } }
                else { float* gp = EGATE + (size_t)m * 128 + 2 * h; float s2 = 0.f;
#pragma unroll
                    for (int k = 0; k < 16; ++k) s2 += bv[k];
                    const float inv = 1.f / s2;
#pragma unroll
                    for (int kk = 0; kk < 8; ++kk) { u32x2 w; w.x = __float_as_uint(bv[kk] * inv); w.y = __float_as_uint(bv[kk + 8] * inv); *(u32x2*)(gp + kk * 16) = w; } }
            }
            __syncthreads();
        }
#undef P8_SORTABLE
#undef P8_UNSORT
#undef P8_INSERT
#undef P8_CE
#undef P8_SORT16
#undef P8_MERGE16
    }
    SEAM(8);
#define UB(w, e) ((float)(((w) >> (8 * (e))) & 0xffu))
#define DPP_ADD(v, ctrl) v += __builtin_bit_cast(float, __builtin_amdgcn_update_dpp(0, __builtin_bit_cast(int, v), (ctrl), 0xf, 0xf, false))
    volatile unsigned* MISCW = (volatile unsigned*)(lds + MISC_OFF);
    const int x_nloc = (MK_N_LAUNCHES == 1) ? (int)MISCW[8] : G, x_nx = (MK_N_LAUNCHES == 1) ? (int)MISCW[9] : 1, x_rank = (MK_N_LAUNCHES == 1) ? (int)MISCW[10] : (int)blockIdx.x, x_ord = (MK_N_LAUNCHES == 1) ? (int)MISCW[11] : 0;
    if (IN(9)) { DECL_PTRS
        const int g = lane >> 3, c = lane & 7;
        const int tstep = x_nloc * NWAVES;
        for (int sl = x_ord; sl < 8; sl += x_nx) {
            const unsigned char* ub = UT + (size_t)sl * (16384 * 128) + 16 * c;
            const bf16_t* xbase = X1B + sl * 128 + 16 * c;
#define P9_IDX(I4, XA, XB, tt) do { const int t_ = (tt) < M_ ? (tt) : M_ - 1; const u32x4* ep_ = (const u32x4*)(EIDX + (size_t)t_ * 128 + g * 16); \
            I4[0] = ep_[0]; I4[1] = ep_[1]; I4[2] = ep_[2]; I4[3] = ep_[3]; XA = *(const u32x4*)(xbase + (size_t)t_ * DM); XB = *(const u32x4*)(xbase + (size_t)t_ * DM + 8); } while (0)
#define P9_ROWS(U, I4, hf) do { _Pragma("unroll") for (int i = 0; i < 8; ++i) U[i] = *(const u32x4*)(ub + (size_t)I4[2 * (hf) + (i >> 2)][i & 3] * 128); } while (0)
#define P9_HALF(U, hf) do { _Pragma("unroll") for (int i = 0; i < 8; ++i) { int a = __builtin_amdgcn_sdot4((int)xq[0], (int)U[i][0], 0, false); a = __builtin_amdgcn_sdot4((int)xq[1], (int)U[i][1], a, false); \
                a = __builtin_amdgcn_sdot4((int)xq[2], (int)U[i][2], a, false); a = __builtin_amdgcn_sdot4((int)xq[3], (int)U[i][3], a, false); \
                a += __builtin_amdgcn_update_dpp(0, a, 0xB1, 0xf, 0xf, false); a += __builtin_amdgcn_update_dpp(0, a, 0x4E, 0xf, 0xf, false); a += __builtin_amdgcn_update_dpp(0, a, 0x141, 0xf, 0xf, false); \
                z0 = (8 * (hf) + i == 2 * c) ? a : z0; z1 = (8 * (hf) + i == 2 * c + 1) ? a : z1; } } while (0)
            u32x4 iC[4], iN[4], iNN[4], xaC, xbC, xaN, xbN, xaNN, xbNN, uA[8], uB[8];
            int t = x_rank * NWAVES + wave;
            P9_IDX(iC, xaC, xbC, t); P9_IDX(iN, xaN, xbN, t + tstep); P9_ROWS(uA, iC, 0);
            for (; t < M_; t += tstep) {
                P9_ROWS(uB, iC, 1); P9_IDX(iNN, xaNN, xbNN, t + 2 * tstep);
                float xf[16];
#pragma unroll
                for (int q = 0; q < 4; ++q) { xf[2 * q] = __uint_as_float(xaC[q] << 16); xf[2 * q + 1] = __uint_as_float(xaC[q] & 0xffff0000u); xf[8 + 2 * q] = __uint_as_float(xbC[q] << 16); xf[8 + 2 * q + 1] = __uint_as_float(xbC[q] & 0xffff0000u); }
                float mx = 1e-30f;
#pragma unroll
                for (int j = 0; j < 16; ++j) mx = fmaxf(mx, fabsf(xf[j]));
                mx = fmaxf(mx, __builtin_bit_cast(float, __builtin_amdgcn_update_dpp(0, __builtin_bit_cast(int, mx), 0xB1, 0xf, 0xf, false)));
                mx = fmaxf(mx, __builtin_bit_cast(float, __builtin_amdgcn_update_dpp(0, __builtin_bit_cast(int, mx), 0x4E, 0xf, 0xf, false)));
                mx = fmaxf(mx, __builtin_bit_cast(float, __builtin_amdgcn_update_dpp(0, __builtin_bit_cast(int, mx), 0x141, 0xf, 0xf, false)));
                const float xinv = 127.f * __builtin_amdgcn_rcpf(mx), xsc = mx * (1.f / 127.f);
                unsigned xq[4];
#pragma unroll
                for (int q = 0; q < 4; ++q) { unsigned b = 0;
#pragma unroll
                    for (int e = 0; e < 4; ++e) { const int qi = (int)rintf(xf[4 * q + e] * xinv); b |= ((unsigned)qi & 0xffu) << (8 * e); }
                    xq[q] = b; }
                int z0 = 0, z1 = 0;
                P9_HALF(uA, 0);
                P9_ROWS(uA, iN, 0);
                P9_HALF(uB, 1);
                { u32x2 w; w.x = __float_as_uint((float)z0 * xsc); w.y = __float_as_uint((float)z1 * xsc); *(u32x2*)(ZP + ((size_t)sl * M_ + t) * 128 + g * 16 + 2 * c) = w; }
#pragma unroll
                for (int q = 0; q < 4; ++q) { iC[q] = iN[q]; iN[q] = iNN[q]; }
                xaC = xaN; xbC = xbN; xaN = xaNN; xbN = xbNN;
            }
#undef P9_HALF
#undef P9_IDX
#undef P9_ROWS
        }
    }
    SEAM(9);
    if (IN(10)) { DECL_PTRS
        for (int t = gw; t < M_; t += NGW) { const float r = rsqrtf(SSX1[t] * (1.f / DM) + EPS); float av[2]; float mx = 1e-30f;
#pragma unroll
            for (int v = 0; v < 2; ++v) { const int p = lane + 64 * v; const int e = EIDX[(size_t)t * 128 + p]; float zs[8];
#pragma unroll
                for (int j = 0; j < 8; ++j) zs[j] = ZP[((size_t)j * M_ + t) * 128 + p];
                float z = ((zs[0] + zs[1]) + (zs[2] + zs[3])) + ((zs[4] + zs[5]) + (zs[6] + zs[7]));
                z *= SU[e] * r;
                av[v] = 0.5f * z * (1.f + erff(z * 0.70710678118654752f)) * EGATE[(size_t)t * 128 + p] * SV[e];
                mx = fmaxf(mx, fabsf(av[v])); }
#pragma unroll
            for (int o = 1; o < 64; o <<= 1) mx = fmaxf(mx, __shfl_xor(mx, o));
            const float inv = 127.f / mx;
            CQ[(size_t)t * 128 + lane] = (signed char)(int)rintf(av[0] * inv); CQ[(size_t)t * 128 + 64 + lane] = (signed char)(int)rintf(av[1] * inv);
            if (lane == 0) CS[t] = mx * (1.f / 127.f); }
    }
    SEAM(10);
    if (IN(11)) { DECL_PTRS
        const int g = lane >> 3, c = lane & 7;
        const int tstep = x_nloc * NWAVES;
        for (int sl = x_ord; sl < 8; sl += x_nx) {
            const unsigned char* vb = VT + (size_t)sl * (16384 * 128) + 16 * c;
#define P11_IDX(I4, C4, tt) do { const int t_ = (tt) < M_ ? (tt) : M_ - 1; const u32x4* ep_ = (const u32x4*)(EIDX + (size_t)t_ * 128 + g * 16); \
            I4[0] = ep_[0]; I4[1] = ep_[1]; I4[2] = ep_[2]; I4[3] = ep_[3]; C4 = *(const u32x4*)(CQ + (size_t)t_ * 128 + g * 16); } while (0)
#define P11_ROWS(U, I4, hf) do { _Pragma("unroll") for (int i = 0; i < 8; ++i) U[i] = *(const u32x4*)(vb + (size_t)I4[2 * (hf) + (i >> 2)][i & 3] * 128); } while (0)
#define P11_BLK(U, b0, q, CW) do { const unsigned d0_ = U[b0][q], d1_ = U[(b0) + 1][q], d2_ = U[(b0) + 2][q], d3_ = U[(b0) + 3][q]; \
            const unsigned t0_ = __builtin_amdgcn_perm(d1_, d0_, 0x05010400u), t1_ = __builtin_amdgcn_perm(d1_, d0_, 0x07030602u), t2_ = __builtin_amdgcn_perm(d3_, d2_, 0x05010400u), t3_ = __builtin_amdgcn_perm(d3_, d2_, 0x07030602u); \
            acc[4 * (q)] = __builtin_amdgcn_sdot4((int)__builtin_amdgcn_perm(t2_, t0_, 0x05040100u), (int)(CW), acc[4 * (q)], false); \
            acc[4 * (q) + 1] = __builtin_amdgcn_sdot4((int)__builtin_amdgcn_perm(t2_, t0_, 0x07060302u), (int)(CW), acc[4 * (q) + 1], false); \
            acc[4 * (q) + 2] = __builtin_amdgcn_sdot4((int)__builtin_amdgcn_perm(t3_, t1_, 0x05040100u), (int)(CW), acc[4 * (q) + 2], false); \
            acc[4 * (q) + 3] = __builtin_amdgcn_sdot4((int)__builtin_amdgcn_perm(t3_, t1_, 0x07060302u), (int)(CW), acc[4 * (q) + 3], false); } while (0)
#define P11_HALF(U, C4, hf) do { _Pragma("unroll") for (int bb = 0; bb < 2; ++bb) { const unsigned cw_ = C4[2 * (hf) + bb]; \
            _Pragma("unroll") for (int q = 0; q < 4; ++q) P11_BLK(U, 4 * bb, q, cw_); } } while (0)
            u32x4 iC[4], iN[4], iNN[4], uA[8], uB[8], cC, cN, cNN;
            const int hi5 = lane >> 5, b3 = (lane >> 3) & 1;
            int t = x_rank * NWAVES + wave;
            P11_IDX(iC, cC, t); P11_IDX(iN, cN, t + tstep); P11_ROWS(uA, iC, 0);
            for (; t < M_; t += tstep) {
                float* op = out + (size_t)t * DM + sl * 128 + 16 * c + 4 * b3 + 8 * hi5;
                const f32x4 x1v = *(const f32x4*)op; const float cs = CS[t];
                P11_ROWS(uB, iC, 1); P11_IDX(iNN, cNN, t + 2 * tstep);
                int acc[16];
#pragma unroll
                for (int j = 0; j < 16; ++j) acc[j] = 0;
                P11_HALF(uA, cC, 0);
                P11_ROWS(uA, iN, 0);
                P11_HALF(uB, cC, 1);
                int w8[8];
#pragma unroll
                for (int j = 0; j < 8; ++j) { auto rr = __builtin_amdgcn_permlane32_swap((unsigned)acc[j], (unsigned)acc[j + 8], false, false); w8[j] = (int)rr[0] + (int)rr[1]; }
#pragma unroll
                for (int j = 0; j < 8; ++j) w8[j] += __shfl_xor(w8[j], 16);
                f32x4 o; float ss = 0.f;
#pragma unroll
                for (int j = 0; j < 4; ++j) { const int keep = b3 ? w8[j + 4] : w8[j]; const int give = b3 ? w8[j] : w8[j + 4];
                    const int tot = keep + __builtin_amdgcn_update_dpp(0, give, 0x128, 0xf, 0xf, false);
                    o[j] = x1v[j] + (float)tot * cs; ss += o[j] * o[j]; }
                if (((lane >> 4) & 1) == 0) *(f32x4*)op = o;
                DPP_ADD(ss, 0x128); DPP_ADD(ss, 0x124); DPP_ADD(ss, 0x122); DPP_ADD(ss, 0x121);
                { const float s0 = __builtin_bit_cast(float, __builtin_amdgcn_readlane(__builtin_bit_cast(int, ss), 0)), s1 = __builtin_bit_cast(float, __builtin_amdgcn_readlane(__builtin_bit_cast(int, ss), 32));
                  if (lane == 0) atomicAdd(SS2 + t, s0 + s1); }
#pragma unroll
                for (int q = 0; q < 4; ++q) { iC[q] = iN[q]; iN[q] = iNN[q]; }
                cC = cN; cN = cNN;
            }
#undef P11_BLK
#undef P11_HALF
#undef P11_IDX
#undef P11_ROWS
        }
    }
    SEAM(11);
    if (IN(12)) { DECL_PTRS
        for (int m = gw; m < M_; m += NGW) { const float r2 = rsqrtf(SS2[m] * (1.f / DM) + EPS); float* orow = out + (size_t)m * DM;
#pragma unroll
            for (int j = 0; j < 4; ++j) { const int cix = 4 * (lane + 64 * j); const f32x4 gg = *(const f32x4*)(g_final + cix); f32x4 o = *(const f32x4*)(orow + cix);
                o[0] *= r2 * gg[0]; o[1] *= r2 * gg[1]; o[2] *= r2 * gg[2]; o[3] *= r2 * gg[3]; *(f32x4*)(orow + cix) = o; } }
    }
#undef UB
#undef DPP_ADD
#undef IN
#undef SEAM
}

extern "C" void kernel_launch(void* const* d_in, const int* in_sizes, int n_in, void* d_out, int out_size, void* d_ws, size_t ws_size, hipStream_t stream) {
    static int grid = 0;
    if (grid == 0) {
        if (n_in != 20 || out_size != M_ * DM || ws_size < WS_END) { fprintf(stderr, "kernel_launch: unexpected shapes (n_in %d out %d ws %zu); nothing launched\n", n_in, out_size, ws_size); grid = -1; return; }
        int dev = 0, cus = 0;
        if (hipGetDevice(&dev) != hipSuccess || hipDeviceGetAttribute(&cus, hipDeviceAttributeMultiprocessorCount, dev) != hipSuccess) { grid = -1; return; }
        if (hipFuncSetAttribute((const void*)fwd, hipFuncAttributeMaxDynamicSharedMemorySize, LDS_BYTES) != hipSuccess) { fprintf(stderr, "kernel_launch: hipFuncSetAttribute failed\n"); grid = -1; return; }
        int per_cu = 0;
        if (hipOccupancyMaxActiveBlocksPerMultiprocessor(&per_cu, (const void*)fwd, NWAVES * 64, LDS_BYTES) != hipSuccess || per_cu < 1) fprintf(stderr, "kernel_launch: occupancy query reports %d\n", per_cu);
        (void)hipGetLastError();
        grid = cus;
    }
    if (grid < 0) return;
    (void)hipMemsetAsync((char*)d_ws + WS_CTL, 0, CTL_ZERO_BYTES, stream);
    Args a; memset(&a, 0, sizeof(a));
    for (int i = 0; i < 20; ++i) a.in[i] = d_in[i];
    a.out = (float*)d_out; a.ws = (unsigned char*)d_ws;
    if (MK_N_LAUNCHES == 1) { a.ph_lo = 0; a.ph_hi = N_PHASES; hipLaunchKernelGGL(fwd, dim3(grid), dim3(NWAVES * 64), LDS_BYTES, stream, a); }
    else for (int p = 0; p < N_PHASES; ++p) { a.ph_lo = p; a.ph_hi = p + 1; hipLaunchKernelGGL(fwd, dim3(grid), dim3(NWAVES * 64), LDS_BYTES, stream, a); }
}
```
